# Optimizing an MI355X kernel written in HIP

```python
import math
import jax, jax.numpy as jnp
from jax import lax
import numpy as np

D_MODEL = 2048
BATCH = 1
SEQ = 16384
DEPTH = 2

F32 = jnp.float32
Q_BLOCK = 128
A_HEADS = 4
A_HEAD_DIM = 128
MOBA_BLOCK = 256
MOBA_TOPK = 3
B_HEADS = 8
B_KV_HEADS = 2
B_HEAD_DIM = 64
SWA_WINDOW = 128
C_HEADS = 4
C_HEAD_DIM = 64
D_HEADS = 4
D_Q_LORA = 512
D_KV_LORA = 256
D_NOPE = 128
D_ROPE = 64
D_V = 128
ROPE_THETA = 10000.0
N_BRANCHES = 4
BRANCH_W = 512
T5_BUCKETS = 32
T5_MAX_EXACT = T5_BUCKETS // 2
T5_MAX_DISTANCE = 1024
BIAS_HEADS = A_HEADS + B_HEADS + C_HEADS
PEER_HEADS = 8
PEER_N_KEYS = 128
PEER_N_EXPERTS = PEER_N_KEYS * PEER_N_KEYS
PEER_D_KEY = 128
PEER_TOPK = 16
PEER_TOKEN_CHUNK = 128
DEEPNORM_ALPHA = (2.0 * DEPTH) ** 0.25
DEEPNORM_BETA = (8.0 * DEPTH) ** -0.25
LN_EPS = 1e-5
RMS_EPS = 1e-6
IN_WIDTHS = (A_HEADS * A_HEAD_DIM, A_HEADS * A_HEAD_DIM, A_HEADS * A_HEAD_DIM,
             B_HEADS * B_HEAD_DIM, B_KV_HEADS * B_HEAD_DIM, B_KV_HEADS * B_HEAD_DIM,
             C_HEADS * 2 * C_HEAD_DIM, C_HEADS * 2 * C_HEAD_DIM, C_HEADS * 2 * C_HEAD_DIM,
             D_Q_LORA, D_KV_LORA, D_ROPE)
IN_W = sum(IN_WIDTHS)
IN_SPLITS = tuple(int(v) for v in np.cumsum(IN_WIDTHS)[:-1])

kernel_name = 'hybrid_moba_swa_diff_mla_peer_deepnorm'


def layer_norm(x, g, b):
    xf = x.astype(F32)
    mu = jnp.mean(xf, -1, keepdims=True)
    var = jnp.mean(jnp.square(xf - mu), -1, keepdims=True)
    return ((xf - mu) * lax.rsqrt(var + LN_EPS) * g.astype(F32) + b.astype(F32)).astype(x.dtype)


def rms_norm(x, g):
    xf = x.astype(F32)
    return (xf * lax.rsqrt(jnp.mean(xf * xf, -1, keepdims=True) + RMS_EPS) * g.astype(F32)).astype(x.dtype)


def rope(x, pos):
    half = x.shape[-1] // 2
    inv = ROPE_THETA ** (-jnp.arange(half, dtype=F32) / half)
    ang = pos.astype(F32)[..., None] * inv
    ang = ang.reshape(ang.shape[:2] + (1,) * (x.ndim - 3) + (half,))
    cos, sin = jnp.cos(ang), jnp.sin(ang)
    x1, x2 = x[..., :half].astype(F32), x[..., half:].astype(F32)
    return jnp.concatenate([x1 * cos - x2 * sin, x1 * sin + x2 * cos], -1).astype(x.dtype)


def t5_bucket(rel):
    n = jnp.maximum(rel, 0)
    nf = jnp.maximum(n, 1).astype(F32)
    large = T5_MAX_EXACT + (jnp.log(nf / T5_MAX_EXACT) / math.log(T5_MAX_DISTANCE / T5_MAX_EXACT)
                            * (T5_BUCKETS - T5_MAX_EXACT)).astype(jnp.int32)
    large = jnp.minimum(large, T5_BUCKETS - 1)
    return jnp.where(n < T5_MAX_EXACT, n, large)


def t5_bias(tab, bucket_bh):
    H = tab.shape[1]
    h_idx = jnp.arange(H).reshape((1, H) + (1,) * (bucket_bh.ndim - 2))
    return tab.T[h_idx, bucket_bh].astype(F32)


def moba_attention(q, k, v, pos, tab):
    B, S, H, dh = q.shape
    n_blk = -(-S // MOBA_BLOCK)
    pad = n_blk * MOBA_BLOCK - S
    kp = jnp.pad(k, ((0, 0), (0, pad), (0, 0), (0, 0)))
    vp = jnp.pad(v, ((0, 0), (0, pad), (0, 0), (0, 0)))
    pp = jnp.pad(pos, ((0, 0), (0, pad)))
    k_blk = kp.reshape(B, n_blk, MOBA_BLOCK, H, dh).transpose(0, 3, 1, 2, 4)
    v_blk = vp.reshape(B, n_blk, MOBA_BLOCK, H, dh).transpose(0, 3, 1, 2, 4)
    p_blk = pp.reshape(B, n_blk, MOBA_BLOCK)
    k_mean = jnp.mean(k_blk.astype(F32), axis=3)
    topk = min(MOBA_TOPK, n_blk)
    scale = dh ** -0.5
    gather_blocks = jax.vmap(jax.vmap(lambda t, i: t[i]))
    gather_pos = jax.vmap(lambda t, i: t[i])

    def chunk(c):
        q0 = c * Q_BLOCK
        own = q0 // MOBA_BLOCK
        qc = lax.dynamic_slice_in_dim(q, q0, Q_BLOCK, axis=1).transpose(0, 2, 1, 3)
        pq = lax.dynamic_slice_in_dim(pos, q0, Q_BLOCK, axis=1)
        gate = jnp.einsum('bhqd,bhnd->bhqn', qc.astype(F32), k_mean)
        gate = jnp.where(jnp.arange(n_blk) < own, gate, -jnp.inf)
        _, idx = lax.top_k(gate, topk)
        sel_valid = idx < own
        k_sel = gather_blocks(k_blk, idx)
        v_sel = gather_blocks(v_blk, idx)
        pk_sel = gather_pos(p_blk, idx)
        s_sel = jnp.einsum('bhqd,bhqnkd->bhqnk', qc, k_sel).astype(F32) * scale
        b_sel = t5_bias(tab, t5_bucket(pq[:, None, :, None, None] - pk_sel))
        s_sel = jnp.where(sel_valid[..., None], s_sel + b_sel, -jnp.inf)
        k_own = lax.dynamic_slice_in_dim(kp, own * MOBA_BLOCK, MOBA_BLOCK, axis=1)
        v_own = lax.dynamic_slice_in_dim(vp, own * MOBA_BLOCK, MOBA_BLOCK, axis=1)
        p_own = lax.dynamic_slice_in_dim(pp, own * MOBA_BLOCK, MOBA_BLOCK, axis=1)
        s_own = jnp.einsum('bhqd,bkhd->bhqk', qc, k_own).astype(F32) * scale
        b_own = t5_bias(tab, t5_bucket(pq[:, None, :, None] - p_own[:, None, None, :]))
        qi = q0 + jnp.arange(Q_BLOCK)
        ki = own * MOBA_BLOCK + jnp.arange(MOBA_BLOCK)
        s_own = jnp.where(ki[None, :] <= qi[:, None], s_own + b_own, -jnp.inf)
        n_sel = topk * MOBA_BLOCK
        logits = jnp.concatenate([s_sel.reshape(B, H, Q_BLOCK, n_sel), s_own], -1)
        p = jax.nn.softmax(logits, -1)
        p_sel = p[..., :n_sel].reshape(B, H, Q_BLOCK, topk, MOBA_BLOCK).astype(v.dtype)
        p_ow = p[..., n_sel:].astype(v.dtype)
        o = (jnp.einsum('bhqnk,bhqnkd->bhqd', p_sel, v_sel)
             + jnp.einsum('bhqk,bkhd->bhqd', p_ow, v_own))
        return o.transpose(0, 2, 1, 3)

    out = lax.map(chunk, jnp.arange(S // Q_BLOCK))
    return out.transpose(1, 0, 2, 3, 4).reshape(B, S, H * dh)


def sliding_window_attention(q, k, v, pos, tab, sinks):
    B, S, Hq, dh = q.shape
    G = k.shape[2]
    R = Hq // G
    nb = S // Q_BLOCK

    def band(t):
        tb = t.reshape((B, nb, Q_BLOCK) + t.shape[2:])
        prev = jnp.concatenate([jnp.zeros_like(tb[:, :1]), tb[:, :-1]], axis=1)
        return jnp.concatenate([prev, tb], axis=2)

    kb, vb, pk = band(k), band(v), band(pos)
    qb = q.reshape(B, nb, Q_BLOCK, G, R, dh)
    pq = pos.reshape(B, nb, Q_BLOCK)
    s = jnp.einsum('bnqgrd,bnkgd->bngrqk', qb, kb).astype(F32) * dh ** -0.5
    bias = t5_bias(tab, t5_bucket(pq[..., :, None] - pk[..., None, :])[:, None])
    bias = bias.reshape(B, G, R, nb, Q_BLOCK, 2 * Q_BLOCK).transpose(0, 3, 1, 2, 4, 5)
    qq = jnp.arange(Q_BLOCK)[:, None]
    kk = jnp.arange(2 * Q_BLOCK)[None, :]
    dist = Q_BLOCK + qq - kk
    in_win = (dist >= 0) & (dist < SWA_WINDOW)
    not_pad = (jnp.arange(nb)[:, None, None] * Q_BLOCK - Q_BLOCK + kk[None]) >= 0
    mask = in_win[None] & not_pad
    s = jnp.where(mask[None, :, None, None], s + bias, -jnp.inf)
    sink = jnp.broadcast_to(sinks.astype(F32).reshape(1, 1, G, R, 1, 1), s.shape[:-1] + (1,))
    p = jax.nn.softmax(jnp.concatenate([s, sink], -1), -1)[..., :-1]
    o = jnp.einsum('bngrqk,bnkgd->bnqgrd', p.astype(v.dtype), vb)
    return o.reshape(B, S, Hq * dh)


def diff_attention(q, k, v, pos, tab, lam_q1, lam_k1, lam_q2, lam_k2, subln_g, lambda_init):
    B, S, H, _, dh = q.shape
    lam = (jnp.exp(jnp.sum(lam_q1.astype(F32) * lam_k1.astype(F32)))
           - jnp.exp(jnp.sum(lam_q2.astype(F32) * lam_k2.astype(F32))) + lambda_init)
    scale = dh ** -0.5
    kt = k.transpose(0, 2, 3, 1, 4)
    vt = v.transpose(0, 2, 1, 3)
    ki = jnp.arange(S)

    def block(c):
        q0 = c * Q_BLOCK
        qc = lax.dynamic_slice_in_dim(q, q0, Q_BLOCK, axis=1)
        pq = lax.dynamic_slice_in_dim(pos, q0, Q_BLOCK, axis=1)
        s = jnp.einsum('bqhmd,bhmkd->bhmqk', qc, kt).astype(F32) * scale
        bias = t5_bias(tab, t5_bucket(pq[:, None, :, None] - pos[:, None, None, :]))
        causal = ki[None, :] <= (q0 + jnp.arange(Q_BLOCK))[:, None]
        a = jax.nn.softmax(jnp.where(causal, s + bias[:, :, None], -jnp.inf), -1)
        w = a[:, :, 0] - lam * a[:, :, 1]
        o = jnp.einsum('bhqk,bhkd->bqhd', w.astype(v.dtype), vt)
        return rms_norm(o, subln_g) * (1.0 - lambda_init)

    out = lax.map(block, jnp.arange(S // Q_BLOCK))
    return out.transpose(1, 0, 2, 3, 4).reshape(B, S, H * 2 * dh)


def mla_attention(c_q, c_kv, k_rope, pos, q_norm_g, kv_norm_g, w_uq, w_ukv):
    B, S, _ = c_q.shape
    qh = (rms_norm(c_q, q_norm_g) @ w_uq).reshape(B, S, D_HEADS, D_NOPE + D_ROPE)
    q_nope, q_pe = qh[..., :D_NOPE], rope(qh[..., D_NOPE:], pos)
    kv = (rms_norm(c_kv, kv_norm_g) @ w_ukv).reshape(B, S, D_HEADS, D_NOPE + D_V)
    k_nope, v = kv[..., :D_NOPE], kv[..., D_NOPE:]
    k_pe = rope(k_rope, pos)
    scale = (D_NOPE + D_ROPE) ** -0.5
    ki = jnp.arange(S)

    def block(c):
        q0 = c * Q_BLOCK
        qn = lax.dynamic_slice_in_dim(q_nope, q0, Q_BLOCK, axis=1)
        qp = lax.dynamic_slice_in_dim(q_pe, q0, Q_BLOCK, axis=1)
        s = (jnp.einsum('bqhd,bkhd->bhqk', qn, k_nope).astype(F32)
             + jnp.einsum('bqhd,bkd->bhqk', qp, k_pe).astype(F32)) * scale
        causal = ki[None, :] <= (q0 + jnp.arange(Q_BLOCK))[:, None]
        p = jax.nn.softmax(jnp.where(causal, s, -jnp.inf), -1)
        return jnp.einsum('bhqk,bkhd->bqhd', p.astype(v.dtype), v)

    out = lax.map(block, jnp.arange(S // Q_BLOCK))
    return out.transpose(1, 0, 2, 3, 4).reshape(B, S, D_HEADS * D_V)


def peer_ffn(x, w_pq, sub_keys, u_tab, v_tab):
    B, S, D = x.shape
    H, K = PEER_HEADS, PEER_TOPK
    q = (x @ w_pq).reshape(B, S, H, 2, PEER_D_KEY)
    s = jnp.einsum('bshmd,hmnd->bshmn', q, sub_keys).astype(F32)
    v_top, i_top = lax.top_k(s, K)
    cand = (v_top[..., 0, :, None] + v_top[..., 1, None, :]).reshape(B, S, H, K * K)
    cand_idx = (i_top[..., 0, :, None] * PEER_N_KEYS + i_top[..., 1, None, :]).reshape(B, S, H, K * K)
    best, pick = lax.top_k(cand, K)
    experts = jnp.take_along_axis(cand_idx, pick, -1)
    gate = jax.nn.softmax(best, -1)
    T = B * S
    nc = T // PEER_TOKEN_CHUNK

    def chunk(args):
        xc, ec, gc = args
        u = u_tab[ec]
        h = jax.nn.gelu(jnp.einsum('cd,chkd->chk', xc, u).astype(F32), approximate=False)
        return jnp.einsum('chk,chkd->cd', (gc * h).astype(x.dtype), v_tab[ec])

    out = lax.map(chunk, (x.reshape(nc, PEER_TOKEN_CHUNK, D),
                          experts.reshape(nc, PEER_TOKEN_CHUNK, H, K),
                          gate.reshape(nc, PEER_TOKEN_CHUNK, H, K)))
    return out.reshape(B, S, D)


def setup_inputs(seed: int = 0) -> dict:
    key = jax.random.key(seed)
    ks = jax.random.split(key, 26)
    L = DEPTH

    def nrm(k, shape, scale):
        return jax.random.normal(k, shape, F32) * scale

    def gain(k, shape):
        return 1.0 + 0.02 * jax.random.normal(k, shape, F32)

    return {
        'x': nrm(ks[0], (BATCH, SEQ, D_MODEL), 1.0),
        'positions': jnp.broadcast_to(jnp.arange(SEQ, dtype=jnp.int32), (BATCH, SEQ)),
        't5_table': nrm(ks[1], (T5_BUCKETS, BIAS_HEADS), 0.5),
        'w_in': nrm(ks[2], (L, D_MODEL, IN_W), D_MODEL ** -0.5),
        'w_gate': nrm(ks[3], (L, N_BRANCHES, D_MODEL, D_MODEL), D_MODEL ** -0.5),
        'b_gate': nrm(ks[4], (L, N_BRANCHES, D_MODEL), 0.1),
        'w_branch': nrm(ks[5], (L, N_BRANCHES, BRANCH_W, D_MODEL), DEEPNORM_BETA * BRANCH_W ** -0.5),
        'w_out': nrm(ks[6], (L, D_MODEL, D_MODEL), DEEPNORM_BETA * D_MODEL ** -0.5),
        'swa_sinks': nrm(ks[7], (L, B_HEADS), 0.5),
        'diff_lambda_q1': nrm(ks[8], (L, C_HEAD_DIM), 0.1),
        'diff_lambda_k1': nrm(ks[9], (L, C_HEAD_DIM), 0.1),
        'diff_lambda_q2': nrm(ks[10], (L, C_HEAD_DIM), 0.1),
        'diff_lambda_k2': nrm(ks[11], (L, C_HEAD_DIM), 0.1),
        'diff_subln_g': gain(ks[12], (L, 2 * C_HEAD_DIM)),
        'mla_q_norm_g': gain(ks[13], (L, D_Q_LORA)),
        'mla_kv_norm_g': gain(ks[14], (L, D_KV_LORA)),
        'mla_w_uq': nrm(ks[15], (L, D_Q_LORA, D_HEADS * (D_NOPE + D_ROPE)), D_Q_LORA ** -0.5),
        'mla_w_ukv': nrm(ks[16], (L, D_KV_LORA, D_HEADS * (D_NOPE + D_V)), D_KV_LORA ** -0.5),
        'ln1_g': gain(ks[17], (L, D_MODEL)),
        'ln1_b': nrm(ks[18], (L, D_MODEL), 0.02),
        'peer_w_q': nrm(ks[19], (L, D_MODEL, PEER_HEADS * 2 * PEER_D_KEY), D_MODEL ** -0.5),
        'peer_sub_keys': nrm(ks[20], (L, PEER_HEADS, 2, PEER_N_KEYS, PEER_D_KEY), PEER_D_KEY ** -0.5),
        'peer_u': nrm(ks[21], (L, PEER_N_EXPERTS, D_MODEL), D_MODEL ** -0.5),
        'peer_v': nrm(ks[22], (L, PEER_N_EXPERTS, D_MODEL), DEEPNORM_BETA),
        'ln2_g': gain(ks[23], (L, D_MODEL)),
        'ln2_b': nrm(ks[24], (L, D_MODEL), 0.02),
    }


def reference(x, positions, t5_table, w_in, w_gate, b_gate, w_branch, w_out, swa_sinks,
              diff_lambda_q1, diff_lambda_k1, diff_lambda_q2, diff_lambda_k2, diff_subln_g,
              mla_q_norm_g, mla_kv_norm_g, mla_w_uq, mla_w_ukv, ln1_g, ln1_b,
              peer_w_q, peer_sub_keys, peer_u, peer_v, ln2_g, ln2_b):
    B, S, _ = x.shape
    tab_a = t5_table[:, :A_HEADS]
    tab_b = t5_table[:, A_HEADS:A_HEADS + B_HEADS]
    tab_c = t5_table[:, A_HEADS + B_HEADS:]
    for layer in range(DEPTH):
        lambda_init = 0.8 - 0.6 * math.exp(-0.3 * layer)
        h = x @ w_in[layer]
        (a_q, a_k, a_v, b_q, b_k, b_v, c_q, c_k, c_v,
         d_cq, d_ckv, d_kr) = jnp.split(h, IN_SPLITS, axis=-1)
        o_a = moba_attention(a_q.reshape(B, S, A_HEADS, A_HEAD_DIM),
                             a_k.reshape(B, S, A_HEADS, A_HEAD_DIM),
                             a_v.reshape(B, S, A_HEADS, A_HEAD_DIM), positions, tab_a)
        o_b = sliding_window_attention(b_q.reshape(B, S, B_HEADS, B_HEAD_DIM),
                                       b_k.reshape(B, S, B_KV_HEADS, B_HEAD_DIM),
                                       b_v.reshape(B, S, B_KV_HEADS, B_HEAD_DIM),
                                       positions, tab_b, swa_sinks[layer])
        o_c = diff_attention(c_q.reshape(B, S, C_HEADS, 2, C_HEAD_DIM),
                             c_k.reshape(B, S, C_HEADS, 2, C_HEAD_DIM),
                             c_v.reshape(B, S, C_HEADS, 2 * C_HEAD_DIM), positions, tab_c,
                             diff_lambda_q1[layer], diff_lambda_k1[layer],
                             diff_lambda_q2[layer], diff_lambda_k2[layer],
                             diff_subln_g[layer], lambda_init)
        o_d = mla_attention(d_cq, d_ckv, d_kr, positions, mla_q_norm_g[layer], mla_kv_norm_g[layer],
                            mla_w_uq[layer], mla_w_ukv[layer])
        branches = (o_a, o_b, o_c, o_d)
        merged = sum(jax.nn.sigmoid(x @ w_gate[layer, n] + b_gate[layer, n]) * (branches[n] @ w_branch[layer, n])
                     for n in range(N_BRANCHES))
        x = layer_norm(DEEPNORM_ALPHA * x + merged @ w_out[layer], ln1_g[layer], ln1_b[layer])
        y = peer_ffn(x, peer_w_q[layer], peer_sub_keys[layer], peer_u[layer], peer_v[layer])
        x = layer_norm(DEEPNORM_ALPHA * x + y, ln2_g[layer], ln2_b[layer])
    return x
```

```cpp
#include <hip/hip_runtime.h>
#include <cstdio>
#include <cstdint>
#include <cmath>

#define DI __device__ __forceinline__
#define LAS __attribute__((address_space(3)))
#define GAS __attribute__((address_space(1)))
typedef unsigned short bf16_t;
typedef short bf16x8 __attribute__((ext_vector_type(8)));
typedef float f32x4 __attribute__((ext_vector_type(4)));
typedef float f32x2 __attribute__((ext_vector_type(2)));
typedef float f32x16 __attribute__((ext_vector_type(16)));
typedef unsigned u32x4 __attribute__((ext_vector_type(4)));
typedef unsigned u32x2 __attribute__((ext_vector_type(2)));
typedef int i32x4 __attribute__((ext_vector_type(4)));
typedef __bf16 bf16x2_t __attribute__((ext_vector_type(2)));

DI unsigned cvtpk(float lo, float hi) { f32x2 v = {lo, hi}; bf16x2_t b = __builtin_convertvector(v, bf16x2_t); return __builtin_bit_cast(unsigned, b); }
DI float bf_lo(unsigned u) { return __uint_as_float(u << 16); }
DI float bf_hi(unsigned u) { return __uint_as_float(u & 0xffff0000u); }
DI float bf1(bf16_t u) { return __uint_as_float((unsigned)u << 16); }
DI float ex2(float x) { return __builtin_amdgcn_exp2f(x); }
DI float wave_sum(float v) {
#pragma unroll
    for (int o = 1; o < 64; o <<= 1) v += __shfl_xor(v, o);
    return v;
}
DI float xhalf(float v) { return __shfl_xor(v, 32); }

namespace pg8 {
#define PG8_LAS __attribute__((address_space(3)))
#ifndef PG8_WGM
#define PG8_WGM 8
#endif
constexpr int BM = 256, BK = 64, HALF = 128, HTB = HALF * BK * 2  , STAGE_BYTES = 8 * HTB, NXCD = 8, WGM = PG8_WGM;

__host__ __device__ __forceinline__ int lds_byte(int r, int c) { const int st = (r >> 4) * 2 + (c >> 5), rr = r & 15, cc = c & 31, ob = rr * 64 + cc * 2; return st * 1024 + (ob ^ (((ob >> 9) & 1) << 5)); }
__host__ __device__ __forceinline__ void stage_rc(int b, int& R, int& C) { const int st = b / 1024, sb = b % 1024, swz = sb ^ (((sb >> 9) & 1) << 5); R = (st >> 1) * 16 + swz / 64; C = (st & 1) * 32 + (swz % 64) / 2; }
__host__ __device__ __forceinline__ int perm32(int rho) { const int n = rho >> 4, i = rho & 15; return 8 * (i >> 2) + 4 * n + (i & 3); }

struct Unit { int pm, pn; };
struct Gemm { const bf16_t* A; const bf16_t* Bt; int M, N, K, lda, ldb; long apn; };

struct StaticOrder {
    int nM, nN, nwg, G, c;
    __host__ __device__ void init(int M, int N, int G_, int c_) { nM = M / BM; nN = N / BM; nwg = nM * nN; G = G_; c = c_; }
    __host__ __device__ bool next(int i, Unit& u) const {
        const long L = (long)i * G + c; if (L >= nwg) return false;
        int wgid = (int)L; { const int q = nwg / NXCD, r = nwg % NXCD, xcd = wgid % NXCD, off = wgid / NXCD; wgid = (xcd < r ? xcd * (q + 1) : r * (q + 1) + (xcd - r) * q) + off; }
        const int nig = WGM * nN, gid = wgid / nig, fm = gid * WGM, gsz = (nM - fm) < WGM ? (nM - fm) : WGM;
        u.pm = fm + ((wgid % nig) % gsz); u.pn = (wgid % nig) / gsz; return true;
    }
    __device__ __forceinline__ void a_ready(const Unit&) const {}
    __device__ __forceinline__ void done(const Unit&) const {}
};

template <int MODE> struct Epi {
    static constexpr bool PERM = true, AFTER_DRAIN = false;
    void* O; int ldc; int grp; const float* bias; const bf16_t* G; int ldg; const void* X; float alpha; int first; unsigned char* O8;
    __device__ __forceinline__ void operator()(const f32x4 (&acc)[2][2][4][2], const Unit& u, int wr, int wc, int fr, int fq) const {
        const int row0 = u.pm * BM + wr * 64 + fr, colb = u.pn * BM + wc * 32 + 8 * fq;
#pragma unroll
        for (int ai = 0; ai < 2; ++ai)
#pragma unroll
            for (int m = 0; m < 4; ++m) {
                const size_t r = (size_t)(row0 + ai * HALF + m * 16);
#pragma unroll
                for (int bj = 0; bj < 2; ++bj) {
                    const int c = colb + bj * HALF;
                    f32x4 v0 = acc[ai][bj][m][0], v1 = acc[ai][bj][m][1];
                    if constexpr (MODE == 0) {
                        const int dc = (c >> 7) * grp + (c & 127);
                        u32x4 w; w.x = cvtpk(v0[0], v0[1]); w.y = cvtpk(v0[2], v0[3]); w.z = cvtpk(v1[0], v1[1]); w.w = cvtpk(v1[2], v1[3]);
                        *(u32x4*)((bf16_t*)O + r * ldc + dc) = w;
                    } else if constexpr (MODE == 1) {
                        const f32x4 b0 = *(const f32x4*)(bias + c), b1 = *(const f32x4*)(bias + c + 4);
                        v0 = v0 + b0; v1 = v1 + b1;
#pragma unroll
                        for (int e = 0; e < 4; ++e) { v0[e] = __builtin_amdgcn_rcpf(1.0f + ex2(-1.4426950408889634f * v0[e])); v1[e] = __builtin_amdgcn_rcpf(1.0f + ex2(-1.4426950408889634f * v1[e])); }
                        int lo = __builtin_amdgcn_cvt_pk_fp8_f32(v0[0], v0[1], 0, false); lo = __builtin_amdgcn_cvt_pk_fp8_f32(v0[2], v0[3], lo, true);
                        int hi = __builtin_amdgcn_cvt_pk_fp8_f32(v1[0], v1[1], 0, false); hi = __builtin_amdgcn_cvt_pk_fp8_f32(v1[2], v1[3], hi, true);
                        *(u32x2*)((unsigned char*)O + r * ldc + c) = (u32x2){(unsigned)lo, (unsigned)hi};
                    } else if constexpr (MODE == 2) {
                        const u32x2 gq = *(const u32x2*)((const unsigned char*)G + r * ldg + c);
                        const f32x2 g0 = __builtin_amdgcn_cvt_pk_f32_fp8((int)gq.x, false), g1 = __builtin_amdgcn_cvt_pk_f32_fp8((int)gq.x, true), g2 = __builtin_amdgcn_cvt_pk_f32_fp8((int)gq.y, false), g3 = __builtin_amdgcn_cvt_pk_f32_fp8((int)gq.y, true);
                        bf16_t* op = (bf16_t*)O + r * ldc + c;
                        u32x4 old = (u32x4){0u, 0u, 0u, 0u};
                        if (!first) old = *(const u32x4*)op;
                        const float r0 = bf_lo(old.x) + g0.x * v0[0], r1 = bf_hi(old.x) + g0.y * v0[1], r2 = bf_lo(old.y) + g1.x * v0[2], r3 = bf_hi(old.y) + g1.y * v0[3];
                        const float r4 = bf_lo(old.z) + g2.x * v1[0], r5 = bf_hi(old.z) + g2.y * v1[1], r6 = bf_lo(old.w) + g3.x * v1[2], r7 = bf_hi(old.w) + g3.y * v1[3];
                        u32x4 w; w.x = cvtpk(r0, r1); w.y = cvtpk(r2, r3); w.z = cvtpk(r4, r5); w.w = cvtpk(r6, r7);
                        *(u32x4*)op = w;
                        if (O8) {
                            int lo = __builtin_amdgcn_cvt_pk_fp8_f32(r0 * 8.0f, r1 * 8.0f, 0, false); lo = __builtin_amdgcn_cvt_pk_fp8_f32(r2 * 8.0f, r3 * 8.0f, lo, true);
                            int hi = __builtin_amdgcn_cvt_pk_fp8_f32(r4 * 8.0f, r5 * 8.0f, 0, false); hi = __builtin_amdgcn_cvt_pk_fp8_f32(r6 * 8.0f, r7 * 8.0f, hi, true);
                            *(u32x2*)(O8 + r * ldc + c) = (u32x2){(unsigned)lo, (unsigned)hi}; }
                    } else if constexpr (MODE == 3) {
                        const u32x4 xx = *(const u32x4*)((const bf16_t*)X + r * ldc + c);
                        u32x4 w;
                        w.x = cvtpk(bf_lo(xx.x) * alpha + v0[0], bf_hi(xx.x) * alpha + v0[1]); w.y = cvtpk(bf_lo(xx.y) * alpha + v0[2], bf_hi(xx.y) * alpha + v0[3]);
                        w.z = cvtpk(bf_lo(xx.z) * alpha + v1[0], bf_hi(xx.z) * alpha + v1[1]); w.w = cvtpk(bf_lo(xx.w) * alpha + v1[2], bf_hi(xx.w) * alpha + v1[3]);
                        *(u32x4*)((bf16_t*)O + r * ldc + c) = w;
                    } else {
                        *(f32x4*)((float*)O + r * ldc + c) = v0; *(f32x4*)((float*)O + r * ldc + c + 4) = v1;
                    }
                }
            }
    }
};

template <class Epi, class Sched, bool ALIGN_EPI = false, bool SP2 = false, bool F8 = false, int SC0 = 127, int SC1 = 127, bool F4 = false>
__device__ __forceinline__ void gemm_phase(PG8_LAS unsigned char* lds, const Gemm g, const Sched& S, const Epi& E) {
    int tid_ = threadIdx.x; asm volatile("" : "+v"(tid_));
    const int tid = tid_, wid = __builtin_amdgcn_readfirstlane(tid >> 6), lane = tid & 63, wr = wid >> 2, wc = wid & 3, fr = lane & 15, fq = lane >> 4;
    const int K = g.K, nt = K / BK;
    unsigned voffA[2], voffB[2];
#pragma unroll
    for (int i = 0; i < 2; ++i) { int R, C; stage_rc(tid * 16 + i * 8192, R, C); const int Rb = Epi::PERM ? ((R & ~31) + perm32(R & 31)) : R;
        voffA[i] = (unsigned)(R * g.lda + C) * 2u; voffB[i] = (unsigned)(Rb * g.ldb + C) * 2u; }
    const size_t kstep = (size_t)(BK * 2);
    const size_t hstepA = (size_t)HALF * g.lda * 2, hstepB = (size_t)HALF * g.ldb * 2;
    const size_t tstepA = 2 * hstepA, tstepB = 2 * hstepB;
    const unsigned ldsw = (unsigned)wid * 1024u;
    const int aoff = lds_byte(wr * 64 + fr, fq * 8), boff = lds_byte(wc * 32 + fr, fq * 8);

#define PG8_SA(b, h) (((b) * 2 + (h)) * HTB)
#define PG8_SB(b, h) ((4 + (b) * 2 + (h)) * HTB)
#define PG8_STAGE(bufoff, gbase, voff) do { _Pragma("unroll") for (int _i = 0; _i < 2; ++_i) \
        __builtin_amdgcn_global_load_lds((const unsigned*)((const char*)(gbase) + (voff)[_i]), (PG8_LAS unsigned*)(lds + (bufoff) + ldsw + _i * 8192), 16, 0, 0); } while (0)
#define PG8_LDA(dst, b, h) do { _Pragma("unroll") for (int m = 0; m < 4; ++m) { if constexpr (F8) { const v4i_t lo_ = *(const PG8_LAS v4i_t*)(lds + PG8_SA(b, h) + aoff + m * 2048), hi_ = *(const PG8_LAS v4i_t*)(lds + PG8_SA(b, h) + aoff + m * 2048 + 1024); dst##8[m] = __builtin_shufflevector(lo_, hi_, 0, 1, 2, 3, 4, 5, 6, 7); } else { _Pragma("unroll") for (int k = 0; k < 2; ++k) dst[m][k] = *(const PG8_LAS bf16x8*)(lds + PG8_SA(b, h) + aoff + m * 2048 + k * 1024); } } } while (0)
#define PG8_LDB(dst, b, h) do { _Pragma("unroll") for (int n = 0; n < 2; ++n) { if constexpr (F8) { const v4i_t lo_ = *(const PG8_LAS v4i_t*)(lds + PG8_SB(b, h) + boff + n * 2048), hi_ = *(const PG8_LAS v4i_t*)(lds + PG8_SB(b, h) + boff + n * 2048 + 1024); dst##8[n] = __builtin_shufflevector(lo_, hi_, 0, 1, 2, 3, 4, 5, 6, 7); } else { _Pragma("unroll") for (int k = 0; k < 2; ++k) dst[n][k] = *(const PG8_LAS bf16x8*)(lds + PG8_SB(b, h) + boff + n * 2048 + k * 1024); } } } while (0)
#define PG8_MMA(ai, bj, At, Bt) do { __builtin_amdgcn_s_setprio(1); \
        if constexpr (F8) {   \
            asm volatile("s_nop 1\n\t" \
            "v_mfma_scale_f32_16x16x128_f8f6f4 %0, %12, %8, %0, %14, %15 op_sel_hi:[0,0,0]\n\t"  \
            "v_mfma_scale_f32_16x16x128_f8f6f4 %1, %13, %8, %1, %14, %15 op_sel_hi:[0,0,0]\n\t"  \
            "v_mfma_scale_f32_16x16x128_f8f6f4 %2, %12, %9, %2, %14, %15 op_sel_hi:[0,0,0]\n\t"  \
            "v_mfma_scale_f32_16x16x128_f8f6f4 %3, %13, %9, %3, %14, %15 op_sel_hi:[0,0,0]\n\t"  \
            "v_mfma_scale_f32_16x16x128_f8f6f4 %4, %12, %10, %4, %14, %15 op_sel_hi:[0,0,0]\n\t"  \
            "v_mfma_scale_f32_16x16x128_f8f6f4 %5, %13, %10, %5, %14, %15 op_sel_hi:[0,0,0]\n\t"  \
            "v_mfma_scale_f32_16x16x128_f8f6f4 %6, %12, %11, %6, %14, %15 op_sel_hi:[0,0,0]\n\t"  \
            "v_mfma_scale_f32_16x16x128_f8f6f4 %7, %13, %11, %7, %14, %15 op_sel_hi:[0,0,0]\n\t"  \
                : "+v"(acc[ai][bj][0][0]), "+v"(acc[ai][bj][0][1]), "+v"(acc[ai][bj][1][0]), "+v"(acc[ai][bj][1][1]), "+v"(acc[ai][bj][2][0]), "+v"(acc[ai][bj][2][1]), "+v"(acc[ai][bj][3][0]), "+v"(acc[ai][bj][3][1]) \
                : "v"(At##8[0]), "v"(At##8[1]), "v"(At##8[2]), "v"(At##8[3]), "v"(Bt##8[0]), "v"(Bt##8[1]), "v"(sc0), "v"(sc1)); \
        } else if constexpr (F4) { \
            asm volatile("s_nop 1\n\t" \
            "v_mfma_scale_f32_16x16x128_f8f6f4 %0, %16, %8, %0, %20, %21 op_sel_hi:[0,0,0] cbsz:4 blgp:4\n\t"  \
            "v_mfma_scale_f32_16x16x128_f8f6f4 %0, %17, %9, %0, %20, %21 op_sel_hi:[0,0,0] cbsz:4 blgp:4\n\t"  \
            "v_mfma_scale_f32_16x16x128_f8f6f4 %1, %18, %8, %1, %20, %21 op_sel_hi:[0,0,0] cbsz:4 blgp:4\n\t"  \
            "v_mfma_scale_f32_16x16x128_f8f6f4 %1, %19, %9, %1, %20, %21 op_sel_hi:[0,0,0] cbsz:4 blgp:4\n\t"  \
            "v_mfma_scale_f32_16x16x128_f8f6f4 %2, %16, %10, %2, %20, %21 op_sel_hi:[0,0,0] cbsz:4 blgp:4\n\t"  \
            "v_mfma_scale_f32_16x16x128_f8f6f4 %2, %17, %11, %2, %20, %21 op_sel_hi:[0,0,0] cbsz:4 blgp:4\n\t"  \
            "v_mfma_scale_f32_16x16x128_f8f6f4 %3, %18, %10, %3, %20, %21 op_sel_hi:[0,0,0] cbsz:4 blgp:4\n\t"  \
            "v_mfma_scale_f32_16x16x128_f8f6f4 %3, %19, %11, %3, %20, %21 op_sel_hi:[0,0,0] cbsz:4 blgp:4\n\t"  \
            "v_mfma_scale_f32_16x16x128_f8f6f4 %4, %16, %12, %4, %20, %21 op_sel_hi:[0,0,0] cbsz:4 blgp:4\n\t"  \
            "v_mfma_scale_f32_16x16x128_f8f6f4 %4, %17, %13, %4, %20, %21 op_sel_hi:[0,0,0] cbsz:4 blgp:4\n\t"  \
            "v_mfma_scale_f32_16x16x128_f8f6f4 %5, %18, %12, %5, %20, %21 op_sel_hi:[0,0,0] cbsz:4 blgp:4\n\t"  \
            "v_mfma_scale_f32_16x16x128_f8f6f4 %5, %19, %13, %5, %20, %21 op_sel_hi:[0,0,0] cbsz:4 blgp:4\n\t"  \
            "v_mfma_scale_f32_16x16x128_f8f6f4 %6, %16, %14, %6, %20, %21 op_sel_hi:[0,0,0] cbsz:4 blgp:4\n\t"  \
            "v_mfma_scale_f32_16x16x128_f8f6f4 %6, %17, %15, %6, %20, %21 op_sel_hi:[0,0,0] cbsz:4 blgp:4\n\t"  \
            "v_mfma_scale_f32_16x16x128_f8f6f4 %7, %18, %14, %7, %20, %21 op_sel_hi:[0,0,0] cbsz:4 blgp:4\n\t"  \
            "v_mfma_scale_f32_16x16x128_f8f6f4 %7, %19, %15, %7, %20, %21 op_sel_hi:[0,0,0] cbsz:4 blgp:4\n\t"  \
                : "+v"(acc[ai][bj][0][0]), "+v"(acc[ai][bj][0][1]), "+v"(acc[ai][bj][1][0]), "+v"(acc[ai][bj][1][1]), "+v"(acc[ai][bj][2][0]), "+v"(acc[ai][bj][2][1]), "+v"(acc[ai][bj][3][0]), "+v"(acc[ai][bj][3][1]) \
                : "v"(At[0][0]), "v"(At[0][1]), "v"(At[1][0]), "v"(At[1][1]), "v"(At[2][0]), "v"(At[2][1]), "v"(At[3][0]), "v"(At[3][1]), "v"(Bt[0][0]), "v"(Bt[0][1]), "v"(Bt[1][0]), "v"(Bt[1][1]), "v"(sc0), "v"(sc1)); \
        } else { _Pragma("unroll") for (int m = 0; m < 4; ++m) _Pragma("unroll") for (int n = 0; n < 2; ++n) _Pragma("unroll") for (int k = 0; k < 2; ++k) \
            acc[ai][bj][m][n] = __builtin_amdgcn_mfma_f32_16x16x32_bf16(Bt[n][k], At[m][k], acc[ai][bj][m][n], 0, 0, 0); } \
        __builtin_amdgcn_s_setprio(0); } while (0)
#define PG8_WAIT_V(n) asm volatile("s_waitcnt vmcnt(" #n ")" ::: "memory")
#define PG8_WAIT_L(n) asm volatile("s_waitcnt lgkmcnt(" #n ")" ::: "memory")
#define PG8_BAR __builtin_amdgcn_s_barrier()
#define PG8_SCHED __builtin_amdgcn_sched_barrier(0)
    Unit cur, nxt; int ui = 0;
    if (!S.next(0, cur)) return;
    f32x4 acc[2][2][4][2];
#pragma unroll
    for (int a = 0; a < 2; ++a)
#pragma unroll
        for (int b = 0; b < 2; ++b)
#pragma unroll
            for (int m = 0; m < 4; ++m)
#pragma unroll
                for (int n = 0; n < 2; ++n) acc[a][b][m][n] = (f32x4){0.f, 0.f, 0.f, 0.f};
    bf16x8 At[4][2], B0[2][2], B1[2][2];
    typedef int v8i_t __attribute__((ext_vector_type(8))); typedef int v4i_t __attribute__((ext_vector_type(4)));
    v8i_t At8[4], B08[2], B18[2];
    int sc0 = SC0 * 0x01010101, sc1 = SC1 * 0x01010101; asm volatile("" : "+v"(sc0), "+v"(sc1));
    const char* cA = (const char*)g.A + (size_t)cur.pm * tstepA + (size_t)cur.pn * g.apn; const char* cB = (const char*)g.Bt + (size_t)cur.pn * tstepB;
    S.a_ready(cur);
    if constexpr (SP2) {
        PG8_STAGE(PG8_SB(0, 0), cB, voffB); PG8_STAGE(PG8_SB(0, 1), cB + hstepB, voffB); PG8_STAGE(PG8_SA(0, 0), cA, voffA); PG8_STAGE(PG8_SA(0, 1), cA + hstepA, voffA);
        if (wr == 1) PG8_BAR;
        PG8_WAIT_V(2); PG8_BAR;
        PG8_STAGE(PG8_SB(1, 0), cB + kstep, voffB); PG8_STAGE(PG8_SA(1, 0), cA + kstep, voffA); PG8_STAGE(PG8_SB(1, 1), cB + hstepB + kstep, voffB);
        PG8_WAIT_V(6); PG8_BAR;
    } else {
        PG8_STAGE(PG8_SB(0, 0), cB, voffB); PG8_STAGE(PG8_SA(0, 0), cA, voffA); PG8_STAGE(PG8_SB(0, 1), cB + hstepB, voffB); PG8_STAGE(PG8_SA(0, 1), cA + hstepA, voffA);
        if (wr == 1) PG8_BAR;
        PG8_WAIT_V(4); PG8_BAR;
        PG8_STAGE(PG8_SB(1, 0), cB + kstep, voffB); PG8_STAGE(PG8_SA(1, 0), cA + kstep, voffA); PG8_STAGE(PG8_SB(1, 1), cB + hstepB + kstep, voffB);
        PG8_WAIT_V(6); PG8_BAR;
    }
    for (;;) {
        const bool has_next = S.next(ui + 1, nxt);
        const char* nA = has_next ? (const char*)g.A + (size_t)nxt.pm * tstepA + (size_t)nxt.pn * g.apn : cA; const char* nB = has_next ? (const char*)g.Bt + (size_t)nxt.pn * tstepB : cB;
        for (int t = 0; t < nt; t += 2) {
            const bool last = (t == nt - 2);
            const char* a1 = cA + (size_t)(t + 1) * kstep;
            const char* a2 = last ? nA : cA + (size_t)(t + 2) * kstep; const char* b2 = last ? nB : cB + (size_t)(t + 2) * kstep;
            const char* a3 = a2 + kstep; const char* b3 = b2 + kstep;
            if (last && has_next) S.a_ready(nxt);
            if constexpr (SP2) {
            PG8_LDB(B0, 0, 0); PG8_LDB(B1, 0, 1); PG8_SCHED; PG8_LDA(At, 0, 0); PG8_STAGE(PG8_SA(1, 1), a1 + hstepA, voffA);
            PG8_WAIT_V(8); PG8_WAIT_L(0); PG8_BAR; PG8_MMA(0, 0, At, B0); PG8_MMA(0, 1, At, B1); PG8_BAR; PG8_SCHED;
            PG8_LDA(At, 0, 1); PG8_STAGE(PG8_SB(0, 0), b2, voffB); PG8_STAGE(PG8_SB(0, 1), b2 + hstepB, voffB); PG8_STAGE(PG8_SA(0, 0), a2, voffA);
            PG8_WAIT_V(8); PG8_WAIT_L(0); PG8_BAR; PG8_MMA(1, 0, At, B0); PG8_MMA(1, 1, At, B1); PG8_BAR; PG8_SCHED;
            PG8_LDB(B0, 1, 0); PG8_LDB(B1, 1, 1); PG8_SCHED; PG8_LDA(At, 1, 0); PG8_STAGE(PG8_SA(0, 1), a2 + hstepA, voffA);
            PG8_WAIT_V(8); PG8_WAIT_L(0); PG8_BAR; PG8_MMA(0, 0, At, B0); PG8_MMA(0, 1, At, B1); PG8_BAR; PG8_SCHED;
            PG8_LDA(At, 1, 1); PG8_STAGE(PG8_SB(1, 0), b3, voffB); PG8_STAGE(PG8_SB(1, 1), b3 + hstepB, voffB); PG8_STAGE(PG8_SA(1, 0), a3, voffA);
            PG8_WAIT_V(8); PG8_WAIT_L(0); PG8_BAR; PG8_MMA(1, 0, At, B0); PG8_MMA(1, 1, At, B1); PG8_BAR; PG8_SCHED;
            } else {
            PG8_LDB(B0, 0, 0); PG8_SCHED; PG8_LDA(At, 0, 0); PG8_STAGE(PG8_SA(1, 1), a1 + hstepA, voffA);
            PG8_WAIT_L(8); PG8_BAR; PG8_WAIT_L(0); PG8_MMA(0, 0, At, B0); PG8_BAR; PG8_SCHED;
            PG8_LDB(B1, 0, 1); PG8_STAGE(PG8_SB(0, 0), b2, voffB);
            PG8_BAR; PG8_WAIT_L(0); PG8_MMA(0, 1, At, B1); PG8_BAR;
            PG8_LDA(At, 0, 1); PG8_STAGE(PG8_SA(0, 0), a2, voffA);
            PG8_BAR; PG8_WAIT_L(0); PG8_MMA(1, 0, At, B0); PG8_BAR; PG8_SCHED;
            PG8_STAGE(PG8_SB(0, 1), b2 + hstepB, voffB);
            PG8_WAIT_V(6); PG8_BAR; PG8_MMA(1, 1, At, B1); PG8_BAR;
            PG8_LDB(B0, 1, 0); PG8_SCHED; PG8_LDA(At, 1, 0); PG8_STAGE(PG8_SA(0, 1), a2 + hstepA, voffA);
            PG8_WAIT_L(8); PG8_BAR; PG8_WAIT_L(0); PG8_MMA(0, 0, At, B0); PG8_BAR; PG8_SCHED;
            PG8_LDB(B1, 1, 1); PG8_STAGE(PG8_SB(1, 0), b3, voffB);
            PG8_BAR; PG8_WAIT_L(0); PG8_MMA(0, 1, At, B1); PG8_BAR;
            PG8_LDA(At, 1, 1); PG8_STAGE(PG8_SA(1, 0), a3, voffA);
            PG8_BAR; PG8_WAIT_L(0); PG8_MMA(1, 0, At, B0); PG8_BAR; PG8_SCHED;
            PG8_STAGE(PG8_SB(1, 1), b3 + hstepB, voffB);
            PG8_WAIT_V(6); PG8_BAR; PG8_MMA(1, 1, At, B1); PG8_BAR;
            }
        }
        if constexpr (F8 || F4) {
#pragma unroll
            for (int a_ = 0; a_ < 2; ++a_) asm volatile("s_nop 15\n\ts_nop 7" : "+v"(acc[a_][0][0][0]), "+v"(acc[a_][0][0][1]), "+v"(acc[a_][0][1][0]), "+v"(acc[a_][0][1][1]), "+v"(acc[a_][0][2][0]), "+v"(acc[a_][0][2][1]), "+v"(acc[a_][0][3][0]), "+v"(acc[a_][0][3][1]),
                "+v"(acc[a_][1][0][0]), "+v"(acc[a_][1][0][1]), "+v"(acc[a_][1][1][0]), "+v"(acc[a_][1][1][1]), "+v"(acc[a_][1][2][0]), "+v"(acc[a_][1][2][1]), "+v"(acc[a_][1][3][0]), "+v"(acc[a_][1][3][1]));
        }
        if constexpr (ALIGN_EPI) { if (wr == 0) PG8_BAR; }
        if constexpr (!Epi::AFTER_DRAIN) { E(acc, cur, wr, wc, fr, fq); S.done(cur); }
        if (!has_next) break;
#pragma unroll
        for (int a = 0; a < 2; ++a)
#pragma unroll
            for (int b = 0; b < 2; ++b)
#pragma unroll
                for (int m = 0; m < 4; ++m)
#pragma unroll
                    for (int n = 0; n < 2; ++n) acc[a][b][m][n] = (f32x4){0.f, 0.f, 0.f, 0.f};
        cur = nxt; cA = nA; cB = nB; ++ui;
        if constexpr (ALIGN_EPI) { if (wr == 1) PG8_BAR; }
    }
    PG8_WAIT_V(0);
    if constexpr (!ALIGN_EPI) { if (wr == 0) PG8_BAR; }
    PG8_BAR;
    if constexpr (Epi::AFTER_DRAIN) { E.fused(acc, cur, wr, wc, fr, fq, lds, wid, lane); S.done(cur); }
#undef PG8_SA
#undef PG8_SB
#undef PG8_STAGE
#undef PG8_LDA
#undef PG8_LDB
#undef PG8_MMA
#undef PG8_WAIT_V
#undef PG8_WAIT_L
#undef PG8_BAR
#undef PG8_SCHED
}
}

constexpr int S = 16384, DM = 2048, NL = 2, NWAVES = 8;
constexpr int HW = 3584;
constexpr int H_AQ = 0, H_AK = 512, H_BQ = 1024, H_BK = 1536, H_CQ = 1664, H_CK = 2176, H_DCQ = 2688, H_DCKV = 3200, H_DKR = 3456;
constexpr int VT_A = 0, VT_B = 512, VT_C = 640, VT_ROWS = 1280;
constexpr int WIN_ROWS = HW + VT_ROWS;
constexpr float LOG2E = 1.4426950408889634f;
constexpr float DN_ALPHA = 1.4142135623730951f;
constexpr size_t MiB = 1u << 20;
constexpr size_t WS_CTL = 0, CTL_ZERO_BYTES = 1 * MiB;
constexpr size_t WS_W = 1 * MiB, WL_STRIDE = 78 * MiB;
constexpr size_t W_IN = 0, W_G = 19 * MiB, W_BR = 51 * MiB, W_O = 59 * MiB, W_UQ = 67 * MiB, W_UKV = 68 * MiB, W_PQ = 69 * MiB, W_SK = 77 * MiB;
constexpr size_t WS_UB = 157 * MiB, WS_VB = 221 * MiB;
constexpr size_t WS_MLIST = 189 * MiB;
constexpr int MCAP_F = 16384, MCAP = MCAP_F + 4096;
constexpr size_t WS_PART = 926 * MiB;
constexpr size_t WS_CS = 245 * MiB;
constexpr size_t WS_XB8 = 253 * MiB;
constexpr size_t WS_XB = 285 * MiB;
constexpr size_t WS_H = 349 * MiB;
constexpr size_t WS_VT = 461 * MiB;
constexpr size_t WS_GT = 501 * MiB;
constexpr size_t WS_O8 = 629 * MiB;
constexpr size_t WS_XB4 = 661 * MiB;
constexpr size_t WS_O = 757 * MiB;
constexpr size_t WS_QD = 821 * MiB, WS_KD = 845 * MiB, WS_VDT = 869 * MiB, WS_CQN = 885 * MiB, WS_CKVN = 901 * MiB;
constexpr size_t WS_SELE = 909 * MiB, WS_SELG = 917 * MiB, WS_KMEAN = 925 * MiB, WS_TPMAX = 925 * MiB + 512 * 1024, WS_OC2 = 994 * MiB, WS_END = 1010 * MiB;
constexpr int CW_BAR = 4096, CW_Q = 16384, CW_CHK = 20480, CW_MOBA = 24576;
constexpr int RING_BYTES = 131072;
constexpr int MISC_OFF = RING_BYTES;
constexpr int TR_OFF = 0;
constexpr int LDS_BYTES = 147456;

constexpr float U_SCALE = 90.0f, V_SCALE = 4.0f;
#define XB_TMO      128
#define XB_XCNT(j)  (256  + 64 * (j))
#define XB_XSUB(j)  (1280 + 64 * (j))
#define XB_XGEN(j)  (2304 + 64 * (j))
#define XB_TOP      3328
#define XB_TOPGEN   3392
#define XCD_BAR_WORDS 3456
#define XB_SPIN_CAP (1u << 18)

__device__ __forceinline__ unsigned xb_ld(unsigned* p)              { return __hip_atomic_load(p, __ATOMIC_RELAXED, __HIP_MEMORY_SCOPE_AGENT); }
__device__ __forceinline__ unsigned xb_add(unsigned* p, unsigned v) { return __hip_atomic_fetch_add(p, v, __ATOMIC_RELAXED, __HIP_MEMORY_SCOPE_AGENT); }
__device__ __forceinline__ unsigned xb_xcc_id() { return (unsigned)__builtin_amdgcn_s_getreg((3 << 11) | 20) & 0xFu; }
#define XB_SPIN(cond, bar) do { unsigned _sp = 0; while (cond) { __builtin_amdgcn_s_sleep(1); \
    if ((++_sp & 255u) == 0u) { if (xb_ld(&(bar)[XB_TMO])) break; if (_sp > XB_SPIN_CAP) { atomicAdd(&(bar)[XB_TMO], 1u); break; } } } } while (0)

struct XcdBarrier {
    unsigned* bar; unsigned x;
    volatile LAS unsigned* st;
};

__device__ __forceinline__ XcdBarrier xcd_barrier_post(unsigned* bar, volatile LAS unsigned* st) {
    XcdBarrier b; b.bar = bar; b.x = xb_xcc_id(); b.st = st;
    if (threadIdx.x == 0) (void)xb_add(&bar[XB_XCNT(b.x)], 1u);
    return b;
}
__device__ __forceinline__ void xcd_barrier_complete(unsigned* bar, unsigned x, unsigned& nloc, unsigned& nx) {
    const unsigned G = gridDim.x * gridDim.y * gridDim.z;
    unsigned sum, cnt, mine, sp = 0u;
    for (;;) {
        sum = 0u; cnt = 0u; mine = 0u;
#pragma unroll
        for (unsigned j = 0; j < 16; ++j) { const unsigned c = xb_ld(&bar[XB_XCNT(j)]); sum += c; cnt += (c > 0u) ? 1u : 0u; mine = (j == x) ? c : mine; }
        if (sum == G) break;
        __builtin_amdgcn_s_sleep(1);
        if ((++sp & 255u) == 0u) { if (xb_ld(&bar[XB_TMO])) break; if (sp > XB_SPIN_CAP) { atomicAdd(&bar[XB_TMO], 1u); break; } }
    }
    nloc = mine > 0u ? mine : 1u; nx = cnt > 0u ? cnt : 1u;
}

__device__ __forceinline__ void xcd_barrier(const XcdBarrier& b) {
    asm volatile("s_waitcnt vmcnt(0)" ::: "memory");
    __syncthreads();
    if (threadIdx.x == 0) {
        unsigned* bar = b.bar;
        __builtin_amdgcn_s_waitcnt(0);
        unsigned nloc = b.st[0], nx = b.st[1];
        if (nloc == 0u) { xcd_barrier_complete(bar, b.x, nloc, nx); b.st[0] = nloc; b.st[1] = nx; }
        const unsigned old = xb_add(&bar[XB_XSUB(b.x)], 1u);
        const unsigned gen = old / nloc;
        if (old + 1u == (gen + 1u) * nloc) {
            __builtin_amdgcn_fence(__ATOMIC_RELEASE, "agent");
            asm volatile("s_waitcnt vmcnt(0)" ::: "memory");
            const unsigned og = xb_add(&bar[XB_TOP], 1u);
            const unsigned tg = og / nx;
            if (og + 1u == (tg + 1u) * nx) xb_add(&bar[XB_TOPGEN], 1u);
            else XB_SPIN(xb_ld(&bar[XB_TOPGEN]) == tg, bar);
            __builtin_amdgcn_fence(__ATOMIC_ACQUIRE, "agent");
            xb_add(&bar[XB_XGEN(b.x)], 1u);
            asm volatile("s_waitcnt vmcnt(0)" ::: "memory");
        } else {
            XB_SPIN(xb_ld(&bar[XB_XGEN(b.x)]) == gen, bar);
            __builtin_amdgcn_fence(__ATOMIC_ACQUIRE, "agent");
            asm volatile("s_waitcnt vmcnt(0)" ::: "memory");
        }
    }
    __syncthreads();
}

struct Args { const float* in[26]; float* out; unsigned char* ws; int ph_lo, ph_hi; };
struct Frame {
    LAS unsigned char* lds; volatile LAS unsigned* MISC;
    int tid, lane, wave, vcu, G;
    unsigned char* ws; float* out;
};
DI bf16_t* wsb(const Frame& F, size_t off) { return (bf16_t*)(F.ws + off); }

DI void transpose_item(const float* W, int ldw, bf16_t* WT, int ldt, int k0, int n0, int drow0, LAS float* scr, int lane) {
#pragma unroll 8
    for (int i = 0; i < 32; ++i) { const int kk = 2 * i + (lane >> 5); scr[kk * 33 + (lane & 31)] = W[(size_t)(k0 + kk) * ldw + n0 + (lane & 31)]; }
    asm volatile("s_waitcnt lgkmcnt(0)" ::: "memory");
    const int c = lane & 7;
#pragma unroll
    for (int j = 0; j < 4; ++j) { const int n = (lane >> 3) + 8 * j; const LAS float* s = scr + (8 * c) * 33 + n;
        u32x4 o; o.x = cvtpk(s[0 * 33], s[1 * 33]); o.y = cvtpk(s[2 * 33], s[3 * 33]); o.z = cvtpk(s[4 * 33], s[5 * 33]); o.w = cvtpk(s[6 * 33], s[7 * 33]);
        *(u32x4*)(WT + (size_t)(drow0 + n) * ldt + k0 + 8 * c) = o; }
    asm volatile("s_waitcnt lgkmcnt(0)" ::: "memory");
}
DI void transpose_item8(const float* W, int ldw, unsigned char* WT, int ldt, int k0, int n0, int drow0, LAS float* scr, int lane, float scale) {
#pragma unroll 8
    for (int i = 0; i < 32; ++i) { const int kk = 2 * i + (lane >> 5); scr[kk * 33 + (lane & 31)] = W[(size_t)(k0 + kk) * ldw + n0 + (lane & 31)]; }
    asm volatile("s_waitcnt lgkmcnt(0)" ::: "memory");
    const int c = lane & 7;
#pragma unroll
    for (int j = 0; j < 4; ++j) { const int n = (lane >> 3) + 8 * j; const LAS float* s = scr + (8 * c) * 33 + n;
        int lo = __builtin_amdgcn_cvt_pk_fp8_f32(s[0 * 33] * scale, s[1 * 33] * scale, 0, false); lo = __builtin_amdgcn_cvt_pk_fp8_f32(s[2 * 33] * scale, s[3 * 33] * scale, lo, true);
        int hi = __builtin_amdgcn_cvt_pk_fp8_f32(s[4 * 33] * scale, s[5 * 33] * scale, 0, false); hi = __builtin_amdgcn_cvt_pk_fp8_f32(s[6 * 33] * scale, s[7 * 33] * scale, hi, true);
        *(u32x2*)(WT + (size_t)(drow0 + n) * ldt + k0 + 8 * c) = (u32x2){(unsigned)lo, (unsigned)hi}; }
    asm volatile("s_waitcnt lgkmcnt(0)" ::: "memory");
}
DI void transpose_item4(const float* W, int ldw, unsigned char* WT, int ldt, int k0, int n0, int drow0, LAS float* scr, int lane, float scale) {
#pragma unroll 8
    for (int i = 0; i < 32; ++i) { const int kk = 2 * i + (lane >> 5); scr[kk * 33 + (lane & 31)] = W[(size_t)(k0 + kk) * ldw + n0 + (lane & 31)]; }
    asm volatile("s_waitcnt lgkmcnt(0)" ::: "memory");
    const int c = lane & 7;
#pragma unroll
    for (int j = 0; j < 4; ++j) { const int n = (lane >> 3) + 8 * j; const LAS float* s = scr + (8 * c) * 33 + n;
        unsigned d = 0u;
        d = __builtin_amdgcn_cvt_scalef32_pk_fp4_f32(d, s[0 * 33] * scale, s[1 * 33] * scale, 1.0f, 0); d = __builtin_amdgcn_cvt_scalef32_pk_fp4_f32(d, s[2 * 33] * scale, s[3 * 33] * scale, 1.0f, 1);
        d = __builtin_amdgcn_cvt_scalef32_pk_fp4_f32(d, s[4 * 33] * scale, s[5 * 33] * scale, 1.0f, 2); d = __builtin_amdgcn_cvt_scalef32_pk_fp4_f32(d, s[6 * 33] * scale, s[7 * 33] * scale, 1.0f, 3);
        *(unsigned*)(WT + (size_t)(drow0 + n) * ldt + (k0 >> 1) + 4 * c) = d; }
    asm volatile("s_waitcnt lgkmcnt(0)" ::: "memory");
}
DI int win_map(int c) {
    if (c < 1024) return c;
    if (c < 1536) return HW + VT_A + (c - 1024);
    if (c < 2176) return H_BQ + (c - 1536);
    if (c < 2304) return HW + VT_B + (c - 2176);
    if (c < 3328) return H_CQ + (c - 2304);
    if (c < 3840) return HW + VT_C + (c - 3328);
    return H_DCQ + (c - 3840);
}
template <int MAP, bool F8 = false, bool F4 = false> DI void transpose_matrix(const Frame& F, const float* W, int K, int N, bf16_t* WT, int roff) {
    LAS float* scr = (LAS float*)(F.lds + TR_OFF + F.wave * 8704);
    const int gw = F.vcu * NWAVES + F.wave, NGW = F.G * NWAVES, nblk = N / 32, items = (K / 64) * nblk;
    int lane = F.lane; asm volatile("" : "+v"(lane));
    for (int it = gw; it < items; it += NGW) {
        const int kb = it / nblk, nb = it % nblk, n0 = 32 * nb;
        int drow = roff + n0;
        if (MAP == 1) drow = win_map(n0);
        if (MAP == 2) { const int h = n0 >> 8, j = n0 & 255; drow = (j < 128) ? h * 128 + j : 512 + h * 128 + (j - 128); }
        if (F4) transpose_item4(W, N, (unsigned char*)WT, K / 2, 64 * kb, n0, drow, scr, lane, 64.0f); else if (F8) transpose_item8(W, N, (unsigned char*)WT, K, 64 * kb, n0, drow, scr, lane, 64.0f); else transpose_item(W, N, WT, K, 64 * kb, n0, drow, scr, lane);
    }
}
DI void convert_bf16(const Frame& F, const float* src, bf16_t* dst, size_t n) {
    const size_t nth = (size_t)F.G * 512, t0 = (size_t)F.vcu * 512 + F.tid;
    for (size_t i = t0; i < n / 8; i += nth) { const f32x4 a = *(const f32x4*)(src + 8 * i), b = *(const f32x4*)(src + 8 * i + 4);
        u32x4 w; w.x = cvtpk(a[0], a[1]); w.y = cvtpk(a[2], a[3]); w.z = cvtpk(b[0], b[1]); w.w = cvtpk(b[2], b[3]); *(u32x4*)(dst + 8 * i) = w; }
}

typedef float v16f __attribute__((ext_vector_type(16)));
typedef float v32f __attribute__((ext_vector_type(32)));
typedef unsigned v6u __attribute__((ext_vector_type(6)));
DI void convert_fp6(const Frame& F, const float* src, unsigned char* dst, int rows, float scale) {
    const size_t nth = (size_t)F.G * 512, t0 = (size_t)F.vcu * 512 + F.tid;
    for (size_t i = t0; i < (size_t)rows * 64; i += nth) {
        const size_t row = i >> 6; const int l = (int)(i & 63);
        const float* p = src + row * 2048 + 32 * l;
        v16f a, b;
#pragma unroll
        for (int q = 0; q < 8; ++q) { const f32x4 x = *(const f32x4*)(p + 4 * q) * scale;
            a[2 * q] = x[0]; b[2 * q] = x[1]; a[2 * q + 1] = x[2]; b[2 * q + 1] = x[3]; }
        const v6u w = __builtin_amdgcn_cvt_scalef32_2xpk16_fp6_f32(a, b, 1.0f);
        *(u32x4*)(dst + row * 1536 + 16 * l) = (u32x4){w[0], w[1], w[2], w[3]};
        *(u32x2*)(dst + row * 1536 + 1024 + 8 * l) = (u32x2){w[4], w[5]};
    }
}

DI void convert_fp4(const Frame& F, const float* src, unsigned char* dst, int rows, float scale) {
    const size_t nth = (size_t)F.G * 512, t0 = (size_t)F.vcu * 512 + F.tid;
    for (size_t i = t0; i < (size_t)rows * 64; i += nth) {
        const float* p = src + i * 32;
        u32x4 w = (u32x4){0u, 0u, 0u, 0u};
#define FP4_PK(q) { const f32x4 x = *(const f32x4*)(p + 4 * (q)) * scale; unsigned d = w[(q) >> 1];         \
            d = __builtin_amdgcn_cvt_scalef32_pk_fp4_f32(d, x[0], x[1], 1.0f, (2 * (q)) & 3); d = __builtin_amdgcn_cvt_scalef32_pk_fp4_f32(d, x[2], x[3], 1.0f, (2 * (q) + 1) & 3); w[(q) >> 1] = d; }
        FP4_PK(0) FP4_PK(1) FP4_PK(2) FP4_PK(3) FP4_PK(4) FP4_PK(5) FP4_PK(6) FP4_PK(7)
#undef FP4_PK
        *(u32x4*)(dst + i * 16) = w;
    }
}

DI void convert_weights(const Frame& F, const Args& a, int l_lo, int l_hi) {
    for (int l = l_lo; l < l_hi; ++l) {
        unsigned char* wl = F.ws + WS_W + (size_t)l * WL_STRIDE;
        transpose_matrix<1, true>(F, a.in[3] + (size_t)l * DM * 4672, DM, 4672, (bf16_t*)(wl + W_IN), 0);
        for (int n = 0; n < 4; ++n) transpose_matrix<0, false, true>(F, a.in[4] + ((size_t)l * 4 + n) * DM * DM, DM, DM, (bf16_t*)(wl + W_G), n * DM);
        for (int n = 0; n < 4; ++n) transpose_matrix<0, true>(F, a.in[6] + ((size_t)l * 4 + n) * 512 * DM, 512, DM, (bf16_t*)(wl + W_BR) + (size_t)n * DM * 512, 0);
        transpose_matrix<0, true>(F, a.in[7] + (size_t)l * DM * DM, DM, DM, (bf16_t*)(wl + W_O), 0);
        transpose_matrix<0>(F, a.in[16] + (size_t)l * 512 * 768, 512, 768, (bf16_t*)(wl + W_UQ), 0);
        transpose_matrix<2>(F, a.in[17] + (size_t)l * 256 * 1024, 256, 1024, (bf16_t*)(wl + W_UKV), 0);
        transpose_matrix<0>(F, a.in[20] + (size_t)l * DM * DM, DM, DM, (bf16_t*)(wl + W_PQ), 0);
        convert_bf16(F, a.in[21] + (size_t)l * 8 * 2 * 128 * 128, (bf16_t*)(wl + W_SK), (size_t)8 * 2 * 128 * 128);
    }
}
DI void build_rope_table(const Frame& F, const Args& a) {
    f32x2* CS = (f32x2*)(F.ws + WS_CS); const int* pos = (const int*)a.in[1];
    for (size_t i = (size_t)F.vcu * 512 + F.tid; i < (size_t)S * 32; i += (size_t)F.G * 512) {
        const int j = (int)(i & 31); const float inv = exp2f(-(float)j * (13.287712379549449f / 32.0f));
        const float ang = (float)pos[i >> 5] * inv;
        CS[i] = (f32x2){cosf(ang), sinf(ang)};
    }
}
DI void phase_prologue(const Frame& F, const Args& a) {
    convert_weights(F, a, 0, 1);
    convert_bf16(F, a.in[0], wsb(F, WS_XB), (size_t)S * DM);
    {
        const size_t nth = (size_t)F.G * 512, t0 = (size_t)F.vcu * 512 + F.tid; const float* src = a.in[0]; unsigned char* dst = F.ws + WS_XB4;
        for (size_t i = t0; i < (size_t)S * DM / 8; i += nth) { const f32x4 x = *(const f32x4*)(src + 8 * i) * 2.0f, y = *(const f32x4*)(src + 8 * i + 4) * 2.0f;
            unsigned d = 0u; d = __builtin_amdgcn_cvt_scalef32_pk_fp4_f32(d, x[0], x[1], 1.0f, 0); d = __builtin_amdgcn_cvt_scalef32_pk_fp4_f32(d, x[2], x[3], 1.0f, 1); d = __builtin_amdgcn_cvt_scalef32_pk_fp4_f32(d, y[0], y[1], 1.0f, 2); d = __builtin_amdgcn_cvt_scalef32_pk_fp4_f32(d, y[2], y[3], 1.0f, 3);
            *(unsigned*)(dst + 4 * i) = d; }
    }
    {
        const size_t nth = (size_t)F.G * 512, t0 = (size_t)F.vcu * 512 + F.tid; const float* src = a.in[0]; unsigned char* dst = F.ws + WS_XB8;
        for (size_t i = t0; i < (size_t)S * DM / 8; i += nth) { const f32x4 x = *(const f32x4*)(src + 8 * i), y = *(const f32x4*)(src + 8 * i + 4);
            int lo = __builtin_amdgcn_cvt_pk_fp8_f32(x[0], x[1], 0, false); lo = __builtin_amdgcn_cvt_pk_fp8_f32(x[2], x[3], lo, true); int hi = __builtin_amdgcn_cvt_pk_fp8_f32(y[0], y[1], 0, false); hi = __builtin_amdgcn_cvt_pk_fp8_f32(y[2], y[3], hi, true);
            *(u32x2*)(dst + 8 * i) = (u32x2){(unsigned)lo, (unsigned)hi}; }
    }
    build_rope_table(F, a);
}

DI float rope64(float x, int lane, const f32x2* cs_row) {
    const float other = xhalf(x);
    const f32x2 cs = cs_row[lane & 31];
    return (lane < 32) ? x * cs.x - other * cs.y : other * cs.y + x * cs.x;
}
DI void phase_prep(const Frame& F, const Args& a, int layer) {
    const bf16_t* H = wsb(F, WS_H); bf16_t* CQN = wsb(F, WS_CQN); bf16_t* CKVN = wsb(F, WS_CKVN); bf16_t* KD = wsb(F, WS_KD);
    const float* gq = a.in[14] + layer * 512; const float* gkv = a.in[15] + layer * 256; const int* pos = (const int*)a.in[1];
    const int gw = F.vcu * NWAVES + F.wave, NGW = F.G * NWAVES, lane = F.lane;
    for (int t = gw; t < S; t += NGW) {
        const bf16_t* hr = H + (size_t)t * HW;
        const u32x4 q = *(const u32x4*)(hr + H_DCQ + 8 * lane);
        float v[8] = {bf_lo(q.x), bf_hi(q.x), bf_lo(q.y), bf_hi(q.y), bf_lo(q.z), bf_hi(q.z), bf_lo(q.w), bf_hi(q.w)};
        float ss = 0.f;
#pragma unroll
        for (int e = 0; e < 8; ++e) ss += v[e] * v[e];
        const float rq = rsqrtf(wave_sum(ss) * (1.0f / 512.0f) + 1e-6f);
        const f32x4 g0 = *(const f32x4*)(gq + 8 * lane), g1 = *(const f32x4*)(gq + 8 * lane + 4);
        u32x4 w; w.x = cvtpk(v[0] * rq * g0[0], v[1] * rq * g0[1]); w.y = cvtpk(v[2] * rq * g0[2], v[3] * rq * g0[3]); w.z = cvtpk(v[4] * rq * g1[0], v[5] * rq * g1[1]); w.w = cvtpk(v[6] * rq * g1[2], v[7] * rq * g1[3]);
        *(u32x4*)(CQN + (size_t)t * 512 + 8 * lane) = w;
        const u32x2 k2 = *(const u32x2*)(hr + H_DCKV + 4 * lane);
        const float u0 = bf_lo(k2.x), u1 = bf_hi(k2.x), u2 = bf_lo(k2.y), u3 = bf_hi(k2.y);
        const float rk = rsqrtf(wave_sum(u0 * u0 + u1 * u1 + u2 * u2 + u3 * u3) * (1.0f / 256.0f) + 1e-6f);
        const f32x4 gk = *(const f32x4*)(gkv + 4 * lane);
        u32x2 w2; w2.x = cvtpk(u0 * rk * gk[0], u1 * rk * gk[1]); w2.y = cvtpk(u2 * rk * gk[2], u3 * rk * gk[3]);
        *(u32x2*)(CKVN + (size_t)t * 256 + 4 * lane) = w2;
        const float kr = bf1(hr[H_DKR + lane]);
        const float ro = rope64(kr, lane, (const f32x2*)(F.ws + WS_CS) + (size_t)t * 32);
        const bf16_t rb = (bf16_t)(cvtpk(ro, 0.f) & 0xffffu);
#pragma unroll
        for (int h = 0; h < 4; ++h) KD[(size_t)t * 768 + h * 192 + 128 + lane] = rb;
    }
    for (int t = gw; t < S / 64; t += NGW) { int pm = pos[t * 64 + lane];
#pragma unroll
        for (int o = 1; o < 64; o <<= 1) { const int other = __shfl_xor(pm, o); pm = other > pm ? other : pm; }
        if (lane == 0) ((int*)(F.ws + WS_TPMAX))[t] = pm; }
    float* KM = (float*)(F.ws + WS_KMEAN);
    for (int it = gw; it < 64 * 8; it += NGW) {
        const int n = it >> 3, cc = it & 7; const bf16_t* p = H + (size_t)(n * 256) * HW + H_AK + cc * 64 + lane;
        float s0 = 0.f, s1 = 0.f, s2 = 0.f, s3 = 0.f;
        for (int r = 0; r < 256; r += 4) { s0 += bf1(p[(size_t)r * HW]); s1 += bf1(p[(size_t)(r + 1) * HW]); s2 += bf1(p[(size_t)(r + 2) * HW]); s3 += bf1(p[(size_t)(r + 3) * HW]); }
        KM[n * 512 + cc * 64 + lane] = ((s0 + s1) + (s2 + s3)) * (1.0f / 256.0f);
    }
}
DI void phase_ropeq(const Frame& F, const Args& a) {
    bf16_t* QD = wsb(F, WS_QD); const int* pos = (const int*)a.in[1];
    const int gw = F.vcu * NWAVES + F.wave, NGW = F.G * NWAVES, lane = F.lane;
    for (int t = gw; t < S; t += NGW) {
        const f32x2* cs = (const f32x2*)(F.ws + WS_CS) + (size_t)t * 32;
#pragma unroll
        for (int h = 0; h < 4; ++h) { bf16_t* p = QD + (size_t)t * 768 + h * 192 + 128 + lane; const float ro = rope64(bf1(*p), lane, cs); *p = (bf16_t)(cvtpk(ro, 0.f) & 0xffffu); }
    }
}
DI void phase_moba_select(const Frame& F, const Args& a, int layer) {
    const bf16_t* H = wsb(F, WS_H); const float* KM = (const float*)(F.ws + WS_KMEAN); const int* pos = (const int*)a.in[1]; const int* TP = (const int*)(F.ws + WS_TPMAX);
    unsigned* cnt = (unsigned*)(F.ws + WS_CTL) + CW_MOBA + layer * 1024; int* lists = (int*)(F.ws + WS_MLIST);
    const int gw = F.vcu * NWAVES + F.wave, NGW = F.G * NWAVES;
    int lane = F.lane; asm volatile("" : "+v"(lane));
    const int r = lane & 31, hi = lane >> 5;
    for (int it = gw; it < (S / 32) * 4; it += NGW) {
        const int h = it & 3, q0 = (it >> 2) * 32, q = q0 + r, own = q0 >> 8;
        if (own == 0) continue;
        const bf16_t* qp = H + (size_t)q * HW + H_AQ + h * 128 + hi * 8;
        const bool two = own > 32;
        f32x16 g0, g1;
#pragma unroll
        for (int i = 0; i < 16; ++i) { g0[i] = 0.f; g1[i] = 0.f; }
#pragma unroll
        for (int kk = 0; kk < 8; ++kk) {
            const bf16x8 qf = *(const bf16x8*)(qp + kk * 16);
#pragma unroll
            for (int rb = 0; rb < 2; ++rb) {
                if (rb == 1 && !two) continue;
                const float* kp = KM + (size_t)(rb * 32 + r) * 512 + h * 128 + kk * 16 + hi * 8;
                const f32x4 x = *(const f32x4*)kp, y = *(const f32x4*)(kp + 4);
                u32x4 wh, wl;
                wh.x = cvtpk(x[0], x[1]); wh.y = cvtpk(x[2], x[3]); wh.z = cvtpk(y[0], y[1]); wh.w = cvtpk(y[2], y[3]);
                wl.x = cvtpk(x[0] - bf_lo(wh.x), x[1] - bf_hi(wh.x)); wl.y = cvtpk(x[2] - bf_lo(wh.y), x[3] - bf_hi(wh.y)); wl.z = cvtpk(y[0] - bf_lo(wh.z), y[1] - bf_hi(wh.z)); wl.w = cvtpk(y[2] - bf_lo(wh.w), y[3] - bf_hi(wh.w));
                if (rb == 0) { g0 = __builtin_amdgcn_mfma_f32_32x32x16_bf16(__builtin_bit_cast(bf16x8, wh), qf, g0, 0, 0, 0); g0 = __builtin_amdgcn_mfma_f32_32x32x16_bf16(__builtin_bit_cast(bf16x8, wl), qf, g0, 0, 0, 0); }
                else { g1 = __builtin_amdgcn_mfma_f32_32x32x16_bf16(__builtin_bit_cast(bf16x8, wh), qf, g1, 0, 0, 0); g1 = __builtin_amdgcn_mfma_f32_32x32x16_bf16(__builtin_bit_cast(bf16x8, wl), qf, g1, 0, 0, 0); }
            }
        }
        float v1 = -INFINITY, v2 = -INFINITY, v3 = -INFINITY; int i1 = -1, i2 = -1, i3 = -1;
#pragma unroll
        for (int rb = 0; rb < 2; ++rb)
#pragma unroll
            for (int i = 0; i < 16; ++i) {
                const int n = rb * 32 + (i & 3) + 8 * (i >> 2) + 4 * hi; const float g = (rb == 0) ? g0[i] : g1[i];
                if (n < own) {
                    if (g > v1) { v3 = v2; i3 = i2; v2 = v1; i2 = i1; v1 = g; i1 = n; }
                    else if (g > v2) { v3 = v2; i3 = i2; v2 = g; i2 = n; }
                    else if (g > v3) { v3 = g; i3 = n; }
                }
            }
        const float p1 = xhalf(v1), p2 = xhalf(v2), p3 = xhalf(v3);
        const int j1 = __shfl_xor(i1, 32), j2 = __shfl_xor(i2, 32), j3 = __shfl_xor(i3, 32);
#pragma unroll
        for (int c = 0; c < 3; ++c) { const float g = c == 0 ? p1 : (c == 1 ? p2 : p3); const int n = c == 0 ? j1 : (c == 1 ? j2 : j3);
            if (n >= 0) {
                if (g > v1 || (g == v1 && n < i1)) { v3 = v2; i3 = i2; v2 = v1; i2 = i1; v1 = g; i1 = n; }
                else if (g > v2 || (g == v2 && n < i2)) { v3 = v2; i3 = i2; v2 = g; i2 = n; }
                else if (g > v3 || (g == v3 && n < i3)) { v3 = g; i3 = n; }
            } }
        if (hi == 0) {
            const int pq = pos[q];
#pragma unroll
            for (int sl = 0; sl < 3; ++sl) { const int n = sl == 0 ? i1 : (sl == 1 ? i2 : i3);
                if (n >= 0) { const int bm = max(max(TP[4 * n], TP[4 * n + 1]), max(TP[4 * n + 2], TP[4 * n + 3])); const int near = (pq - bm < 790) ? 1 : 0;
                    const unsigned p = atomicAdd(cnt + near * 256 + h * 64 + n, 1u);
                    if (p < (unsigned)(near ? MCAP - MCAP_F : MCAP_F)) lists[(size_t)(h * 64 + n) * MCAP + (near ? MCAP_F : 0) + p] = q * 4 + sl; } }
        }
    }
}
DI void phase_mixer_combine(const Frame& F, const Args& a, int layer) {
    const unsigned char* PART = F.ws + WS_PART; bf16_t* OA = wsb(F, WS_O);
    const int gw = F.vcu * NWAVES + F.wave, NGW = F.G * NWAVES, lane = F.lane;
    for (size_t i = (size_t)F.vcu * 512 + F.tid; i < (size_t)2 * S * 64; i += (size_t)F.G * 512) {
        const size_t br = (i >= (size_t)S * 64) ? 3 : 1, e = (i - (br == 3 ? (size_t)S * 64 : 0)) * 8;
        const u32x4 w = *(const u32x4*)(wsb(F, WS_O) + br * S * 512 + e);
        int lo = __builtin_amdgcn_cvt_pk_fp8_f32(bf_lo(w.x) * 8.0f, bf_hi(w.x) * 8.0f, 0, false); lo = __builtin_amdgcn_cvt_pk_fp8_f32(bf_lo(w.y) * 8.0f, bf_hi(w.y) * 8.0f, lo, true);
        int hi = __builtin_amdgcn_cvt_pk_fp8_f32(bf_lo(w.z) * 8.0f, bf_hi(w.z) * 8.0f, 0, false); hi = __builtin_amdgcn_cvt_pk_fp8_f32(bf_lo(w.w) * 8.0f, bf_hi(w.w) * 8.0f, hi, true);
        *(u32x2*)(F.ws + WS_O8 + br * S * 512 + e) = (u32x2){(unsigned)lo, (unsigned)hi};
    }
    for (int it = gw; it < S * 4; it += NGW) {
        const int q = it >> 2, h = it & 3, nsel = (q >> 8) < 3 ? (q >> 8) : 3;
        const unsigned char* pp = PART + ((size_t)q * 16 + h * 4) * 272;
        float mm[4], ll[4]; unsigned ov[4];
#pragma unroll
        for (int s = 0; s < 4; ++s) { const bool use = (s == 3) || (s < nsel); const f32x2 ml = *(const f32x2*)(pp + s * 272 + 256); mm[s] = use ? ml.x : -1e30f; ll[s] = use ? ml.y : 0.f; ov[s] = *(const unsigned*)(pp + s * 272 + lane * 4); }
        const float M = fmaxf(fmaxf(mm[0], mm[1]), fmaxf(mm[2], mm[3]));
        float wsum = 0.f, x0 = 0.f, x1 = 0.f;
#pragma unroll
        for (int s = 0; s < 4; ++s) { const float w = ll[s] * ex2(mm[s] - M); wsum += w; x0 += w * bf_lo(ov[s]); x1 += w * bf_hi(ov[s]); }
        const float inv = 1.0f / wsum;
        *(unsigned*)(OA + (size_t)q * 512 + h * 128 + lane * 2) = cvtpk(x0 * inv, x1 * inv);
        *(unsigned short*)(F.ws + WS_O8 + (size_t)q * 512 + h * 128 + lane * 2) = (unsigned short)__builtin_amdgcn_cvt_pk_fp8_f32(x0 * inv * 8.0f, x1 * inv * 8.0f, 0, false);
    }
    float d1 = 0.f, d2 = 0.f;
    for (int i = 0; i < 64; ++i) { d1 += a.in[9][layer * 64 + i] * a.in[10][layer * 64 + i]; d2 += a.in[11][layer * 64 + i] * a.in[12][layer * 64 + i]; }
    const float lambda_init = 0.8f - 0.6f * expf(-0.3f * (float)layer), lam = expf(d1) - expf(d2) + lambda_init;
    bf16_t* OC = wsb(F, WS_O) + (size_t)2 * S * 512; const bf16_t* OC2 = wsb(F, WS_OC2);
    const f32x2 sg = *(const f32x2*)(a.in[13] + layer * 128 + lane * 2);
    for (int it = gw; it < S * 4; it += NGW) {
        const size_t off = (size_t)(it >> 2) * 512 + (it & 3) * 128 + lane * 2;
        const unsigned w1 = *(const unsigned*)(OC + off), w2 = *(const unsigned*)(OC2 + off);
        const float x0 = bf_lo(w1) - lam * bf_lo(w2), x1 = bf_hi(w1) - lam * bf_hi(w2);
        const float rn = rsqrtf(wave_sum(x0 * x0 + x1 * x1) * (1.0f / 128.0f) + 1e-6f) * (1.0f - lambda_init);
        *(unsigned*)(OC + off) = cvtpk(x0 * rn * sg.x, x1 * rn * sg.y);
        *(unsigned short*)(F.ws + WS_O8 + (size_t)2 * S * 512 + off) = (unsigned short)__builtin_amdgcn_cvt_pk_fp8_f32(x0 * rn * sg.x * 8.0f, x1 * rn * sg.y * 8.0f, 0, false);
    }
}
template <int NJ, int NE> DI void ln_store(float (&v)[NJ][NE], const float* g, const float* b, float* of, bf16_t* ob, int lane, unsigned char* o8 = nullptr, unsigned char* o4 = nullptr) {
    static_assert(NJ * NE == 32 && NE % 8 == 0, "row layout");
    float s = 0.f;
#pragma unroll
    for (int j = 0; j < NJ; ++j)
#pragma unroll
        for (int e = 0; e < NE; ++e) s += v[j][e];
    const float mean = wave_sum(s) * (1.0f / DM);
    float q = 0.f;
#pragma unroll
    for (int j = 0; j < NJ; ++j)
#pragma unroll
        for (int e = 0; e < NE; ++e) { v[j][e] -= mean; q += v[j][e] * v[j][e]; }
    const float rstd = rsqrtf(wave_sum(q) * (1.0f / DM) + 1e-5f);
#pragma unroll
    for (int j = 0; j < NJ; ++j)
#pragma unroll
        for (int e8 = 0; e8 < NE; e8 += 8) {
            const int c = (DM / NJ) * j + NE * lane + e8;
            const f32x4 g0 = *(const f32x4*)(g + c), g1 = *(const f32x4*)(g + c + 4), b0 = *(const f32x4*)(b + c), b1 = *(const f32x4*)(b + c + 4);
            f32x4 o0, o1;
#pragma unroll
            for (int e = 0; e < 4; ++e) { o0[e] = v[j][e8 + e] * rstd * g0[e] + b0[e]; o1[e] = v[j][e8 + 4 + e] * rstd * g1[e] + b1[e]; }
            if (of) { *(f32x4*)(of + c) = o0; *(f32x4*)(of + c + 4) = o1; }
            u32x4 w; w.x = cvtpk(o0[0], o0[1]); w.y = cvtpk(o0[2], o0[3]); w.z = cvtpk(o1[0], o1[1]); w.w = cvtpk(o1[2], o1[3]);
            *(u32x4*)(ob + c) = w;
            if (o8) { int lo = __builtin_amdgcn_cvt_pk_fp8_f32(o0[0], o0[1], 0, false); lo = __builtin_amdgcn_cvt_pk_fp8_f32(o0[2], o0[3], lo, true); int hi = __builtin_amdgcn_cvt_pk_fp8_f32(o1[0], o1[1], 0, false); hi = __builtin_amdgcn_cvt_pk_fp8_f32(o1[2], o1[3], hi, true);
                *(u32x2*)(o8 + c) = (u32x2){(unsigned)lo, (unsigned)hi}; }
            if (o4) { unsigned d = 0u; d = __builtin_amdgcn_cvt_scalef32_pk_fp4_f32(d, o0[0] * 2.0f, o0[1] * 2.0f, 1.0f, 0); d = __builtin_amdgcn_cvt_scalef32_pk_fp4_f32(d, o0[2] * 2.0f, o0[3] * 2.0f, 1.0f, 1);
                d = __builtin_amdgcn_cvt_scalef32_pk_fp4_f32(d, o1[0] * 2.0f, o1[1] * 2.0f, 1.0f, 2); d = __builtin_amdgcn_cvt_scalef32_pk_fp4_f32(d, o1[2] * 2.0f, o1[3] * 2.0f, 1.0f, 3); *(unsigned*)(o4 + (c >> 1)) = d; }
        }
}
DI void phase_ln1(const Frame& F, const Args& a, int layer) {
    const bf16_t* Y = wsb(F, WS_GT); bf16_t* XB = wsb(F, WS_XB);
    const int gw = F.vcu * NWAVES + F.wave, NGW = F.G * NWAVES, lane = F.lane;
    for (int t = gw; t < S; t += NGW) {
        float v[4][8];
#pragma unroll
        for (int j = 0; j < 4; ++j) { const u32x4 w = *(const u32x4*)(Y + (size_t)t * DM + 512 * j + 8 * lane);
            v[j][0] = bf_lo(w.x); v[j][1] = bf_hi(w.x); v[j][2] = bf_lo(w.y); v[j][3] = bf_hi(w.y); v[j][4] = bf_lo(w.z); v[j][5] = bf_hi(w.z); v[j][6] = bf_lo(w.w); v[j][7] = bf_hi(w.w); }
        ln_store<4, 8>(v, a.in[18] + layer * DM, a.in[19] + layer * DM, (float*)nullptr, XB + (size_t)t * DM, lane);
    }
}

namespace att {
constexpr int TBL = RING_BYTES - 4096;
constexpr int TPMO = TBL - 1024;
constexpr int KMO = 0;
constexpr float NEG = -1e30f;
enum { MIX_A = 0, MIX_B = 1, MIX_C = 2, MIX_D = 3 };

struct Ctx { int qi, pq, own; float c, cb; unsigned long long sel; };

DI int t5_bucket(int rel) {
    if (rel < 16) return rel;
    return 15 + (rel >= 16) + (rel >= 21) + (rel >= 27) + (rel >= 35) + (rel >= 46) + (rel >= 59) + (rel >= 77) + (rel >= 99) + (rel >= 128) + (rel >= 166) + (rel >= 216) + (rel >= 280) + (rel >= 363) + (rel >= 470) + (rel >= 609) + (rel >= 790);
}
DI void build_tbl(LAS unsigned char* lds, const float* t5, int col, const int* tpmax) {
    if (threadIdx.x < 256) *(LAS int*)(lds + TPMO + threadIdx.x * 4) = tpmax[threadIdx.x];
    for (int rel = threadIdx.x; rel < 1024; rel += 512) *(LAS float*)(lds + TBL + rel * 4) = t5[t5_bucket(rel) * 16 + col] * LOG2E;
}

#define ATT_SB() __builtin_amdgcn_sched_barrier(0)
#ifndef ATT_CONV_INTERLEAVE
#define ATT_CONV_INTERLEAVE 1
#endif
#ifndef ATT_CP_D
#define ATT_CP_D 0
#endif
#ifndef ATT_CP
#define ATT_CP 0
#endif
#ifndef ATT_X_LDS2
#define ATT_X_LDS2 0
#endif
#ifndef ATT_NOPRIO
#define ATT_NOPRIO 0
#endif
#if ATT_NOPRIO
#define ATT_PRIO(x) do { } while (0)
#else
#define ATT_PRIO(x) __builtin_amdgcn_s_setprio(x)
#endif
#if defined(ATT_X_NOSM)
#define ATT_SM(...) do { l_run = 1.0f; st0.resc = false; st1.resc = false; st0.alpha = 1.f; st1.alpha = 1.f; pf0[0] = qf[0]; pf0[1] = qf[1]; pf1[0] = qf[2]; pf1[1] = qf[3]; } while (0)
#else
#define ATT_SM(...) __VA_ARGS__
#endif
#ifndef ATT_PD
#define ATT_PD 4
#endif
DI float hmax32(float v) { auto rr = __builtin_amdgcn_permlane32_swap(__float_as_uint(v), __float_as_uint(v), false, false); return fmaxf(__uint_as_float(rr[0]), __uint_as_float(rr[1])); }
struct SmState { float mx, cc, dd, rs; bool resc; float alpha; };
template <int MIX, bool FAST, int W>
DI void sm_item(f32x16& s, SmState& st, float& m_run, float& l_run, bf16x8 (&pf)[2], const Ctx& cx, const LAS unsigned char* pkp, const LAS unsigned char* lds, int k0, int kmax, int kmin, int hi, bool lv) {
    constexpr bool BIAS = (MIX != MIX_D);
    if constexpr (W == 0 || W == 1) {
        constexpr int sg = W;
        if constexpr (FAST) {
            float a = fmaxf(fmaxf(s[sg * 8 + 0], s[sg * 8 + 1]), s[sg * 8 + 2]), b = fmaxf(fmaxf(s[sg * 8 + 3], s[sg * 8 + 4]), s[sg * 8 + 5]);
            a = fmaxf(fmaxf(a, s[sg * 8 + 6]), s[sg * 8 + 7]);
            st.mx = (W == 0) ? fmaxf(a, b) : fmaxf(st.mx, fmaxf(a, b));
            asm volatile("" : "+v"(st.mx));
        } else {
            i32x4 pk0 = (i32x4){0, 0, 0, 0}, pk1 = (i32x4){0, 0, 0, 0};
            if (BIAS) { const LAS i32x4* pp = (const LAS i32x4*)(pkp + (sg * 16 + hi * 8) * 4); pk0 = pp[0]; pk1 = pp[1]; }
            float mx = (W == 0) ? NEG : st.mx;
#pragma unroll
            for (int j = 0; j < 8; ++j) {
                const int i = sg * 8 + j, key = k0 + sg * 16 + hi * 8 + j;
                float tv = s[i] * cx.c;
                if (BIAS) { int rel = cx.pq - (j < 4 ? pk0[j & 3] : pk1[j & 3]); rel = rel < 0 ? 0 : (rel > 1023 ? 1023 : rel); tv += *(const LAS float*)(lds + TBL + rel * 4); }
                bool valid = key <= kmax;
                if (MIX == MIX_B) valid = valid && (key >= kmin);
                tv = valid ? tv : NEG;
                s[i] = tv; mx = fmaxf(mx, tv);
            }
            st.mx = mx;
        }
        if constexpr (W == 1) {
            float mx = hmax32(st.mx);
            if constexpr (FAST) mx = lv ? mx * cx.c + cx.cb : NEG;
            const bool need = mx > m_run + 8.0f;
            const float mn = need ? mx : m_run;
            st.alpha = ex2(m_run - mn); m_run = mn; l_run *= st.alpha;
            st.resc = (__ballot(need) != 0ull);
            st.cc = FAST ? (lv ? cx.c : 0.f) : 1.0f; st.dd = FAST ? (lv ? cx.cb - mn : NEG) : -mn; st.rs = 0.f;
            asm volatile("" : "+v"(st.alpha), "+v"(m_run), "+v"(l_run), "+v"(st.dd));
        }
    } else if constexpr (W >= 2 && W <= 5) {
        constexpr int e0 = (W - 2) * 4;
#pragma unroll
        for (int e = e0; e < e0 + 4; ++e) { float p = ex2(s[e] * st.cc + st.dd); asm volatile("" : "+v"(p)); s[e] = p; st.rs += p; }
        asm volatile("" : "+v"(st.rs));
        if constexpr (W == 5) l_run += st.rs;
    } else {
        constexpr int sg = W - 6;
        u32x4 w; w.x = cvtpk(s[sg * 8 + 0], s[sg * 8 + 1]); w.y = cvtpk(s[sg * 8 + 2], s[sg * 8 + 3]); w.z = cvtpk(s[sg * 8 + 4], s[sg * 8 + 5]); w.w = cvtpk(s[sg * 8 + 6], s[sg * 8 + 7]); asm volatile("" : "+v"(w)); pf[sg] = __builtin_bit_cast(bf16x8, w);
    }
}
template <int DQK, int DV, int MIX, bool FAST>
DI void tile_body(const LAS unsigned char* sb, const LAS unsigned char* lds, const bf16x8 (&qf)[DQK / 16], f32x16 (&o)[DV / 32], float& m_run, float& l_run, const Ctx& cx,
                  int k0, int kmax, int kmin, int pr, int xk, int xv, int r, int hi, bool lv) {
    constexpr int KCH = DQK / 8, NQ = DQK / 16, NP = DV / 16, KBUF = 64 * KCH * 16, VBUF = DV * 128;
    const LAS unsigned char* kb0 = sb + pr * (KCH * 16); const LAS unsigned char* kb1 = kb0 + 32 * (KCH * 16);
    const LAS unsigned char* vb = sb + KBUF + r * 128; const LAS unsigned char* pkp = sb + KBUF + VBUF;
    f32x16 s0, s1;
#pragma unroll
    for (int i = 0; i < 16; ++i) { s0[i] = 0.f; s1[i] = 0.f; }
    bf16x8 kf[NQ], kg[NQ], vf[2 * NP], pf0[2], pf1[2];
    SmState st0, st1;
#if defined(ATT_X_NOLDS)
#define ATT_KF(base, kk) (qf[(kk) % NQ])
#else
#define ATT_KF(base, kk) (*(const LAS bf16x8*)((base) + (((2 * (kk) + hi) ^ xk) << 4)))
#endif
#if defined(ATT_X_NOLDS)
#define ATT_VF(f) (qf[(f) % NQ])
#else
#define ATT_VF(f) (*(const LAS bf16x8*)(vb + (((f) % NP) >> 1) * 32 * 128 + (((((f) / NP) * 4 + ((f) & 1) * 2 + hi) ^ xv) << 4)))
#endif
#define ATT_PRE_K(W) do { _Pragma("unroll") for (int kk = ((W) * NQ) / 8; kk < (((W) + 1) * NQ) / 8; ++kk) { kg[kk] = ATT_KF(kb1, kk); if (ATT_X_LDS2) { bf16x8 dm_ = ATT_KF(kb1 + 16, kk); asm volatile("" :: "v"(dm_)); } } } while (0)
#define ATT_PRE_V(W) do { _Pragma("unroll") for (int f = ((W) * NP) / 8; f < (((W) + 1) * NP) / 8; ++f) { vf[f] = ATT_VF(f); if (ATT_X_LDS2) { bf16x8 dm_ = ATT_VF(f ^ 1); asm volatile("" :: "v"(dm_)); } } } while (0)
#pragma unroll
    for (int kk = 0; kk < NQ; ++kk) kf[kk] = ATT_KF(kb0, kk);
    ATT_SB();
#pragma unroll
    for (int kk = 0; kk < NQ; ++kk) s0 = __builtin_amdgcn_mfma_f32_32x32x16_bf16(kf[kk], qf[kk], s0, 0, 0, 0);
    ATT_PRE_K(0); ATT_PRE_K(1); if (ATT_PD > 2) ATT_PRE_K(2); if (ATT_PD > 3) ATT_PRE_K(3);
    ATT_SB();
#define ATT_STEP2(W) do { \
        ATT_PRIO(1); _Pragma("unroll") for (int kk = ((W) * NQ) / 8; kk < (((W) + 1) * NQ) / 8; ++kk) s1 = __builtin_amdgcn_mfma_f32_32x32x16_bf16(kg[kk], qf[kk], s1, 0, 0, 0); ATT_PRIO(0); \
        if ((W) + ATT_PD < 8) ATT_PRE_K((W) + ATT_PD); else ATT_PRE_V((W) + ATT_PD - 8); \
        ATT_SM(sm_item<MIX, FAST, W>(s0, st0, m_run, l_run, pf0, cx, pkp, lds, k0, kmax, kmin, hi, lv)); ATT_SB(); } while (0)
    ATT_STEP2(0); ATT_STEP2(1); ATT_STEP2(2); ATT_STEP2(3); ATT_STEP2(4); ATT_STEP2(5); ATT_STEP2(6); ATT_STEP2(7);
#undef ATT_STEP2
    if (st0.resc) {
#pragma unroll
        for (int d = 0; d < DV / 32; ++d)
#pragma unroll
            for (int i = 0; i < 16; ++i) o[d][i] *= st0.alpha;
    }
    ATT_SB();
#define ATT_STEP3(W) do { \
        ATT_PRIO(1); _Pragma("unroll") for (int f = ((W) * NP) / 8; f < (((W) + 1) * NP) / 8; ++f) o[f >> 1] = __builtin_amdgcn_mfma_f32_32x32x16_bf16(vf[f], pf0[f & 1], o[f >> 1], 0, 0, 0); ATT_PRIO(0); \
        ATT_PRE_V((W) + ATT_PD); \
        ATT_SM(sm_item<MIX, FAST, W>(s1, st1, m_run, l_run, pf1, cx, pkp + 128, lds, k0 + 32, kmax, kmin, hi, lv)); ATT_SB(); } while (0)
    ATT_STEP3(0); ATT_STEP3(1); ATT_STEP3(2); ATT_STEP3(3); ATT_STEP3(4); ATT_STEP3(5); ATT_STEP3(6); ATT_STEP3(7);
#undef ATT_STEP3
    if (st1.resc) {
#pragma unroll
        for (int d = 0; d < DV / 32; ++d)
#pragma unroll
            for (int i = 0; i < 16; ++i) o[d][i] *= st1.alpha;
    }
    ATT_SB();
#define ATT_STEP4(W) do { \
        _Pragma("unroll") for (int f = ((W) * NP) / 8; f < (((W) + 1) * NP) / 8; ++f) o[(f - NP) >> 1] = __builtin_amdgcn_mfma_f32_32x32x16_bf16(vf[f], pf1[f & 1], o[(f - NP) >> 1], 0, 0, 0); \
        if ((W) + ATT_PD < 16) ATT_PRE_V((W) + ATT_PD); ATT_SB(); } while (0)
    ATT_STEP4(8); ATT_STEP4(9); ATT_STEP4(10); ATT_STEP4(11); ATT_STEP4(12); ATT_STEP4(13); ATT_STEP4(14); ATT_STEP4(15);
#undef ATT_STEP4
#undef ATT_KF
#undef ATT_VF
#undef ATT_PRE_K
#undef ATT_PRE_V
}
template <int DQK, int DV, int MIX>
DI void flash_pass(LAS unsigned char* lds, const bf16x8 (&qf)[DQK / 16], const bf16_t* __restrict__ Kg, int ldk, const bf16_t* __restrict__ VTg, int ldvt,
                   const int* __restrict__ pos, int t0, int t1, int q0, int qpmin, const Ctx& cx, f32x16 (&o)[DV / 32], float& m_run, float& l_run, int ts_force = -1) {
    constexpr int KCH = DQK / 8, NKL = KCH / 8, NVL = DV / 64;
    constexpr bool BIAS = (MIX != MIX_D);
    constexpr int KBUF = 64 * KCH * 16, VBUF = DV * 128, PBUF = BIAS ? 2048 : 0, SLOT = KBUF + VBUF + PBUF, NV = NKL + NVL + (BIAS ? 1 : 0);
    static_assert(3 * SLOT <= TPMO, "attention ring");
    static_assert(DQK % 128 == 0 || DQK == 64 || DQK == 192, "QK MFMAs per softmax work item");
    int tid = threadIdx.x; asm volatile("" : "+v"(tid));
    const int lane = tid & 63, r = lane & 31, hi = lane >> 5, wave = __builtin_amdgcn_readfirstlane(tid >> 6);
    const int pr = (r & 0x13) | ((r & 4) << 1) | ((r & 8) >> 1);
    const int xk = (KCH == 16) ? (((pr & 1) << 3) | ((pr >> 1) & 7)) : ((pr >> 1) & 7);
    const int xv = (r >> 1) & 7;
    unsigned koff[NKL], voff[NVL];
#pragma unroll
    for (int i = 0; i < NKL; ++i) { const int p = (i * 8 + wave) * 64 + lane, row = p / KCH, cs = p % KCH; const int x = (KCH == 16) ? (((row & 1) << 3) | ((row >> 1) & 7)) : ((row >> 1) & 7); koff[i] = (unsigned)(row * ldk + (cs ^ x) * 8) * 2u; }
#pragma unroll
    for (int i = 0; i < NVL; ++i) { const int p = (i * 8 + wave) * 64 + lane, row = p >> 3, cs = p & 7; voff[i] = (unsigned)(row * ldvt + (cs ^ ((row >> 1) & 7)) * 8) * 2u; }
#define ATT_ISSUE(t, sl) do { LAS unsigned char* sb_ = lds + (sl) * SLOT; \
    _Pragma("unroll") for (int i_ = 0; i_ < NKL; ++i_) __builtin_amdgcn_global_load_lds((const unsigned*)((const char*)Kg + (size_t)(t) * 64 * ldk * 2 + koff[i_]), (LAS unsigned*)(sb_ + (i_ * 8 + wave) * 1024), 16, 0, 0); \
    _Pragma("unroll") for (int i_ = 0; i_ < NVL; ++i_) __builtin_amdgcn_global_load_lds((const unsigned*)((const char*)VTg + (size_t)(t) * 128 + voff[i_]), (LAS unsigned*)(sb_ + KBUF + (i_ * 8 + wave) * 1024), 16, 0, 0); \
    if (BIAS) __builtin_amdgcn_global_load_lds((const unsigned*)(pos + (t) * 64 + lane), (LAS unsigned*)(sb_ + KBUF + VBUF + wave * 256), 4, 0, 0); } while (0)
#ifndef ATT_X_DMA2
#define ATT_X_DMA2 0
#endif
#if ATT_X_DMA2
#define ATT_ISSUE2(t, sl) do { ATT_ISSUE(t, sl); ATT_ISSUE(t, sl); } while (0)
#else
#define ATT_ISSUE2(t, sl) ATT_ISSUE(t, sl)
#endif
#if defined(ATT_X_NODMA)
#define ATT_ISSUE_LOOP(t, sl) do { (void)(sl); } while (0)
#define ATT_NEXT_SLOT(sl) ((sl) ^ 1)
#else
#define ATT_ISSUE_LOOP(t, sl) ATT_ISSUE2(t, sl)
#define ATT_NEXT_SLOT(sl) (((sl) == 2) ? 0 : (sl) + 1)
#endif
#define ATT_WAITBAR(N) asm volatile("s_waitcnt vmcnt(%0) lgkmcnt(0)\n\ts_barrier" :: "n"(N) : "memory")
    int ts = t0;
    if (ts_force >= 0) ts = ts_force;
    else if (MIX != MIX_B) { const int tlim = (q0 >> 6) < t1 ? (q0 >> 6) : t1;
        if (!BIAS) ts = tlim > t0 ? tlim : t0;
        else {
            ts = tlim > t0 ? tlim : t0;
            for (int base = t0; base < tlim; base += 64) { const int idx = base + lane; const bool stop = (idx >= tlim) || (qpmin - *(const LAS int*)(lds + TPMO + (idx < 256 ? idx : 255) * 4) < 790);
                const unsigned long long mk = __ballot(stop); if (mk != 0ull) { const int f = base + (int)__builtin_ctzll(mk); ts = f < tlim ? f : tlim; break; } } } }
    ATT_ISSUE2(t0, 0);
    if (t0 + 1 < t1) ATT_ISSUE2(t0 + 1, 1);
    int sl = 0;
#define ATT_TILES(TA, TB, FASTV) \
    for (int t = (TA); t < (TB); ++t) { \
        if (t + 1 < t1) ATT_WAITBAR(NV * (ATT_X_DMA2 ? 2 : 1)); else ATT_WAITBAR(0);            \
        if (t + 2 < t1) { const int s2 = (sl >= 1) ? sl - 1 : 2; ATT_ISSUE_LOOP(t + 2, s2); } \
        const LAS unsigned char* sb = lds + sl * SLOT; \
        int kmax, kmin = 0; \
        kmax = cx.qi; \
        if (MIX == MIX_B) kmin = cx.qi - 127; \
        const int k0 = t * 64; \
        const bool lv = (kmax >= k0) && (kmin <= k0 + 63); \
        if (__ballot(lv) != 0ull) tile_body<DQK, DV, MIX, FASTV>(sb, lds, qf, o, m_run, l_run, cx, k0, kmax, kmin, pr, xk, xv, r, hi, lv); \
        sl = ATT_NEXT_SLOT(sl); \
    }
    ATT_TILES(t0, ts, true)
    ATT_TILES(ts, t1, false)
#undef ATT_TILES
    asm volatile("s_waitcnt lgkmcnt(0)\n\ts_barrier" ::: "memory");
#undef ATT_ISSUE
#undef ATT_WAITBAR
}
DI int fast_split(const LAS unsigned char* lds, int t0, int t1, int q0, int qpmin, int lane) {
    const int tlim = (q0 >> 6) < t1 ? (q0 >> 6) : t1;
    int ts = tlim > t0 ? tlim : t0;
    for (int base = t0; base < tlim; base += 64) { const int idx = base + lane; const bool stop = (idx >= tlim) || (qpmin - *(const LAS int*)(lds + TPMO + (idx < 256 ? idx : 255) * 4) < 790);
        const unsigned long long mk = __ballot(stop); if (mk != 0ull) { const int f = base + (int)__builtin_ctzll(mk); ts = f < tlim ? f : tlim; break; } }
    return ts;
}
template <int DQK, int DV, int MIX>
DI void flash_pass_cp(LAS unsigned char* lds, const bf16x8 (&qf)[DQK / 16], const bf16_t* __restrict__ Kg, int ldk, const bf16_t* __restrict__ VTg, int ldvt,
                      int t0, int ts, const Ctx& cx, f32x16 (&o)[DV / 32], float& m_run, float& l_run) {
    constexpr int KCH = DQK / 8, NKL = KCH / 8, NVL = DV / 64, NQ = DQK / 16, NP = DV / 16;
    constexpr int KBUF = 64 * KCH * 16, VBUF = DV * 128;
    static_assert(3 * (KBUF + VBUF) <= TPMO, "attention rings");
    int tid = threadIdx.x; asm volatile("" : "+v"(tid));
    const int lane = tid & 63, r = lane & 31, hi = lane >> 5, wave = __builtin_amdgcn_readfirstlane(tid >> 6);
    const int pr = (r & 0x13) | ((r & 4) << 1) | ((r & 8) >> 1);
    const int xk = (KCH == 16) ? (((pr & 1) << 3) | ((pr >> 1) & 7)) : ((pr >> 1) & 7);
    const int xv = (r >> 1) & 7;
    unsigned koff[NKL], voff[NVL];
#pragma unroll
    for (int i = 0; i < NKL; ++i) { const int p = (i * 8 + wave) * 64 + lane, row = p / KCH, cs = p % KCH; const int x = (KCH == 16) ? (((row & 1) << 3) | ((row >> 1) & 7)) : ((row >> 1) & 7); koff[i] = (unsigned)(row * ldk + (cs ^ x) * 8) * 2u; }
#pragma unroll
    for (int i = 0; i < NVL; ++i) { const int p = (i * 8 + wave) * 64 + lane, row = p >> 3, cs = p & 7; voff[i] = (unsigned)(row * ldvt + (cs ^ ((row >> 1) & 7)) * 8) * 2u; }
#define CP_ISSUE_K(t, sl) do { _Pragma("unroll") for (int i_ = 0; i_ < NKL; ++i_) __builtin_amdgcn_global_load_lds((const unsigned*)((const char*)Kg + (size_t)(t) * 64 * ldk * 2 + koff[i_]), (LAS unsigned*)(lds + (sl) * KBUF + (i_ * 8 + wave) * 1024), 16, 0, 0); } while (0)
#define CP_ISSUE_V(t, sl) do { _Pragma("unroll") for (int i_ = 0; i_ < NVL; ++i_) __builtin_amdgcn_global_load_lds((const unsigned*)((const char*)VTg + (size_t)(t) * 128 + voff[i_]), (LAS unsigned*)(lds + 3 * KBUF + (sl) * VBUF + (i_ * 8 + wave) * 1024), 16, 0, 0); } while (0)
#define CP_KF(base, kk) (*(const LAS bf16x8*)((base) + (((2 * (kk) + hi) ^ xk) << 4)))
#define CP_VF(base, hf, j) (*(const LAS bf16x8*)((base) + ((j) >> 1) * 32 * 128 + (((((hf) * 4 + ((j) & 1) * 2 + hi) ^ xv)) << 4)))
    const int n = ts - t0;
    CP_ISSUE_K(t0, 0); CP_ISSUE_V(t0, 0);
    if (n > 1) CP_ISSUE_K(t0 + 1, 1);
    asm volatile("s_waitcnt vmcnt(0) lgkmcnt(0)\n\ts_barrier" ::: "memory");
    const LAS unsigned char* kl = lds + pr * (KCH * 16);
    const LAS unsigned char* vl = lds + 3 * KBUF + r * 128;
    f32x16 sc, sn;
    bf16x8 kfr[NQ], vfr[NP], pp[2], pc[2];
    SmState st;
#pragma unroll
    for (int i = 0; i < 16; ++i) sc[i] = 0.f;
#pragma unroll
    for (int kk = 0; kk < NQ; ++kk) kfr[kk] = CP_KF(kl, kk);
    ATT_SB();
#pragma unroll
    for (int kk = 0; kk < NQ; ++kk) sc = __builtin_amdgcn_mfma_f32_32x32x16_bf16(kfr[kk], qf[kk], sc, 0, 0, 0);
#define CP_PRE(W, KB, HFK_UNUSED, VB, HFV, DOK, DOV) do { \
        if (DOK) { _Pragma("unroll") for (int kk = ((W) * NQ) / 8; kk < (((W) + 1) * NQ) / 8; ++kk) kfr[kk] = CP_KF(KB, kk); } \
        if (DOV) { _Pragma("unroll") for (int j = ((W) * NP) / 8; j < (((W) + 1) * NP) / 8; ++j) vfr[j] = CP_VF(VB, HFV, j); } } while (0)
#define CP_ITEM(W, DOK, DOV, KB, VB, HFV, KBN, VBN, HFVN) do { \
        ATT_PRIO(1); \
        if (DOK) { _Pragma("unroll") for (int kk = ((W) * NQ) / 8; kk < (((W) + 1) * NQ) / 8; ++kk) sn = __builtin_amdgcn_mfma_f32_32x32x16_bf16(kfr[kk], qf[kk], sn, 0, 0, 0); } \
        if (DOV) { _Pragma("unroll") for (int j = ((W) * NP) / 8; j < (((W) + 1) * NP) / 8; ++j) o[j >> 1] = __builtin_amdgcn_mfma_f32_32x32x16_bf16(vfr[j], pp[j & 1], o[j >> 1], 0, 0, 0); } \
        ATT_PRIO(0); \
        if ((W) + 2 < 8) CP_PRE((W) + 2, KB, 0, VB, HFV, DOK, DOV); else CP_PRE((W) - 6, KBN, 0, VBN, HFVN, true, true); \
        sm_item<MIX, true, W>(sc, st, m_run, l_run, pc, cx, lds, lds, 0, 0, 0, hi, true); ATT_SB(); } while (0)
#define CP_STEP(DOK, DOV, KB, VB, HFV, KBN, VBN, HFVN) do { \
        _Pragma("unroll") for (int i = 0; i < 16; ++i) sn[i] = 0.f; \
        CP_ITEM(0, DOK, DOV, KB, VB, HFV, KBN, VBN, HFVN); CP_ITEM(1, DOK, DOV, KB, VB, HFV, KBN, VBN, HFVN); CP_ITEM(2, DOK, DOV, KB, VB, HFV, KBN, VBN, HFVN); CP_ITEM(3, DOK, DOV, KB, VB, HFV, KBN, VBN, HFVN); \
        CP_ITEM(4, DOK, DOV, KB, VB, HFV, KBN, VBN, HFVN); CP_ITEM(5, DOK, DOV, KB, VB, HFV, KBN, VBN, HFVN); CP_ITEM(6, DOK, DOV, KB, VB, HFV, KBN, VBN, HFVN); CP_ITEM(7, DOK, DOV, KB, VB, HFV, KBN, VBN, HFVN); \
        if (st.resc) { _Pragma("unroll") for (int d = 0; d < DV / 32; ++d) _Pragma("unroll") for (int i = 0; i < 16; ++i) o[d][i] *= st.alpha; } \
        pp[0] = pc[0]; pp[1] = pc[1]; sc = sn; ATT_SB(); } while (0)
    int ks = 0, vs = 0;
    for (int i = 0; i < n; ++i) {
        const int t = t0 + i;
        const int ks1 = (ks == 2) ? 0 : ks + 1, ks2 = (ks == 0) ? 2 : ks - 1, vs1 = (vs == 2) ? 0 : vs + 1, vsp = (vs == 0) ? 2 : vs - 1;
        if (i > 0) asm volatile("s_waitcnt vmcnt(0) lgkmcnt(0)\n\ts_barrier" ::: "memory");
        if (t + 2 < ts) CP_ISSUE_K(t + 2, ks2);
        if (t + 1 < ts) CP_ISSUE_V(t + 1, vs1);
        const LAS unsigned char* kA = kl + ks * KBUF + 32 * (KCH * 16); const LAS unsigned char* kB = kl + ks1 * KBUF; const LAS unsigned char* kAn = kl + ks1 * KBUF + 32 * (KCH * 16);
        const LAS unsigned char* vP = vl + vsp * VBUF; const LAS unsigned char* vC = vl + vs * VBUF;
        if (i == 0) {
            CP_PRE(0, kA, 0, vP, 1, true, false); CP_PRE(1, kA, 0, vP, 1, true, false);
            CP_STEP(true, false, kA, vP, 1, kB, vC, 0);
        } else {
            CP_STEP(true, true, kA, vP, 1, kB, vC, 0);
        }
        CP_STEP(true, true, kB, vC, 0, kAn, vC, 1);
        ks = ks1; vs = vs1;
    }
    {
        const int vsp = (vs == 0) ? 2 : vs - 1; const LAS unsigned char* vP = vl + vsp * VBUF;
#pragma unroll
        for (int j = (2 * NP) / 8; j < NP; ++j) vfr[j] = CP_VF(vP, 1, j);
        ATT_SB();
#pragma unroll
        for (int j = 0; j < NP; ++j) o[j >> 1] = __builtin_amdgcn_mfma_f32_32x32x16_bf16(vfr[j], pp[j & 1], o[j >> 1], 0, 0, 0);
    }
    asm volatile("s_waitcnt lgkmcnt(0)\n\ts_barrier" ::: "memory");
#undef CP_ISSUE_K
#undef CP_ISSUE_V
#undef CP_KF
#undef CP_VF
#undef CP_PRE
#undef CP_ITEM
#undef CP_STEP
}
template <int DV> DI void store_o(const f32x16 (&o)[DV / 32], float scale, bf16_t* orow, int hi) {
#pragma unroll
    for (int d = 0; d < DV / 32; ++d)
#pragma unroll
        for (int a = 0; a < 4; ++a) { u32x2 w; w.x = cvtpk(o[d][4 * a] * scale, o[d][4 * a + 1] * scale); w.y = cvtpk(o[d][4 * a + 2] * scale, o[d][4 * a + 3] * scale); *(u32x2*)(orow + d * 32 + 8 * a + 4 * hi) = w; }
}

DI int wg_min_pos(const Frame& F, int pq) {
#pragma unroll
    for (int o = 1; o < 64; o <<= 1) { const int other = __shfl_xor(pq, o); pq = other < pq ? other : pq; }
    if (F.tid == 0) F.MISC[5] = 0x7fffffffu;
    __syncthreads();
    if (F.lane == 0) atomicMin((int*)&F.MISC[5], pq);
    __syncthreads();
    const int v = (int)F.MISC[5];
    __syncthreads();
    return v;
}
DI void unit_D(const Frame& F, const Args& a, int h, int qt) {
    const int lane = F.lane, r = lane & 31, hi = lane >> 5, qi = qt * 256 + F.wave * 32 + r;
    const bf16_t* QD = wsb(F, WS_QD) + (size_t)qi * 768 + h * 192 + hi * 8;
    bf16x8 qf[12];
#pragma unroll
    for (int kk = 0; kk < 12; ++kk) qf[kk] = *(const bf16x8*)(QD + kk * 16);
    f32x16 o[4];
#pragma unroll
    for (int d = 0; d < 4; ++d)
#pragma unroll
        for (int i = 0; i < 16; ++i) o[d][i] = 0.f;
    float m = NEG, l = 0.f;
    Ctx cx; cx.qi = qi; cx.pq = 0; cx.own = 0; cx.sel = 0ull; cx.cb = 0.f; cx.c = 0.07216878364870322f * LOG2E;
    const int ts = qt * 4;
    if (ATT_CP_D && ts > 0) flash_pass_cp<192, 128, MIX_D>(F.lds, qf, wsb(F, WS_KD) + h * 192, 768, wsb(F, WS_VDT) + (size_t)(h * 128) * S, S, 0, ts, cx, o, m, l);
    flash_pass<192, 128, MIX_D>(F.lds, qf, wsb(F, WS_KD) + h * 192, 768, wsb(F, WS_VDT) + (size_t)(h * 128) * S, S, (const int*)a.in[1], ATT_CP_D ? ts : 0, (qt + 1) * 4, qt * 256, 0, cx, o, m, l, ATT_CP_D ? ts : -1);
    l += xhalf(l);
    store_o<128>(o, 1.0f / l, wsb(F, WS_O) + (size_t)3 * S * 512 + (size_t)qi * 512 + h * 128, hi);
}
DI void unit_C(const Frame& F, const Args& a, int h, int qt, int mp) {
    const int lane = F.lane, r = lane & 31, hi = lane >> 5, qi = qt * 256 + F.wave * 32 + r;
    const int* pos = (const int*)a.in[1];
    build_tbl(F.lds, a.in[2], 12 + h, (const int*)(F.ws + WS_TPMAX));
    Ctx cx; cx.qi = qi; cx.pq = pos[qi]; cx.own = 0; cx.sel = 0ull; cx.c = 0.125f * LOG2E; cx.cb = a.in[2][31 * 16 + 12 + h] * LOG2E;
    const int qpmin = wg_min_pos(F, cx.pq);
    const bf16_t* H = wsb(F, WS_H);
    const bf16_t* Q = H + (size_t)qi * HW + H_CQ + h * 128 + mp * 64 + hi * 8;
    bf16x8 qf[4];
#pragma unroll
    for (int kk = 0; kk < 4; ++kk) qf[kk] = *(const bf16x8*)(Q + kk * 16);
    f32x16 o[4];
#pragma unroll
    for (int d = 0; d < 4; ++d)
#pragma unroll
        for (int i = 0; i < 16; ++i) o[d][i] = 0.f;
    float m = NEG, l = 0.f;
    const int ts = ATT_CP ? fast_split(F.lds, 0, (qt + 1) * 4, qt * 256, qpmin, lane) : 0;
    if (ATT_CP && ts > 0) flash_pass_cp<64, 128, MIX_C>(F.lds, qf, H + H_CK + h * 128 + mp * 64, HW, wsb(F, WS_VT) + (size_t)(VT_C + h * 128) * S, S, 0, ts, cx, o, m, l);
    flash_pass<64, 128, MIX_C>(F.lds, qf, H + H_CK + h * 128 + mp * 64, HW, wsb(F, WS_VT) + (size_t)(VT_C + h * 128) * S, S, pos, ATT_CP ? ts : 0, (qt + 1) * 4, qt * 256, qpmin, cx, o, m, l, ATT_CP ? ts : -1);
    l += xhalf(l);
    bf16_t* orow = (mp == 0 ? wsb(F, WS_O) + (size_t)2 * S * 512 : wsb(F, WS_OC2)) + (size_t)qi * 512 + h * 128;
    store_o<128>(o, 1.0f / l, orow, hi);
}
DI void unit_B(const Frame& F, const Args& a, int layer, int hq, int qt) {
    const int lane = F.lane, r = lane & 31, hi = lane >> 5, qi = qt * 256 + F.wave * 32 + r, g = hq >> 2;
    const int* pos = (const int*)a.in[1];
    build_tbl(F.lds, a.in[2], 4 + hq, (const int*)(F.ws + WS_TPMAX));
    const bf16_t* H = wsb(F, WS_H);
    const bf16_t* Q = H + (size_t)qi * HW + H_BQ + hq * 64 + hi * 8;
    bf16x8 qf[4];
#pragma unroll
    for (int kk = 0; kk < 4; ++kk) qf[kk] = *(const bf16x8*)(Q + kk * 16);
    f32x16 o[2];
#pragma unroll
    for (int d = 0; d < 2; ++d)
#pragma unroll
        for (int i = 0; i < 16; ++i) o[d][i] = 0.f;
    float m = NEG, l = 0.f;
    Ctx cx; cx.qi = qi; cx.pq = pos[qi]; cx.own = 0; cx.sel = 0ull; cx.c = 0.125f * LOG2E; cx.cb = a.in[2][31 * 16 + 4 + hq] * LOG2E;
    const int t0 = (qt * 4 - 2) < 0 ? 0 : (qt * 4 - 2);
    flash_pass<64, 64, MIX_B>(F.lds, qf, H + H_BK + g * 64, HW, wsb(F, WS_VT) + (size_t)(VT_B + g * 64) * S, S, pos, t0, (qt + 1) * 4, qt * 256, 0, cx, o, m, l);
    l += xhalf(l);
    l += ex2(a.in[8][layer * 8 + hq] * LOG2E - m);
    store_o<64>(o, 1.0f / l, wsb(F, WS_O) + (size_t)1 * S * 512 + (size_t)qi * 512 + hq * 64, hi);
}
DI void store_part(const f32x16 (&o)[4], float m, float l, unsigned char* prow, int hi) {
    l += xhalf(l);
    store_o<128>(o, 1.0f / l, (bf16_t*)prow, hi);
    if (hi == 0) *(f32x2*)(prow + 256) = (f32x2){m, l};
}
DI void unit_A_own(const Frame& F, const Args& a, int h, int qt) {
    const int lane = F.lane, r = lane & 31, hi = lane >> 5, qi = qt * 256 + F.wave * 32 + r;
    const int* pos = (const int*)a.in[1];
    build_tbl(F.lds, a.in[2], h, (const int*)(F.ws + WS_TPMAX));
    const bf16_t* H = wsb(F, WS_H);
    const bf16_t* Q = H + (size_t)qi * HW + H_AQ + h * 128 + hi * 8;
    bf16x8 qf[8];
#pragma unroll
    for (int kk = 0; kk < 8; ++kk) qf[kk] = *(const bf16x8*)(Q + kk * 16);
    f32x16 o[4];
#pragma unroll
    for (int d = 0; d < 4; ++d)
#pragma unroll
        for (int i = 0; i < 16; ++i) o[d][i] = 0.f;
    float m = NEG, l = 0.f;
    Ctx cx; cx.qi = qi; cx.pq = pos[qi]; cx.own = qt; cx.sel = 0ull; cx.c = 0.08838834764831845f * LOG2E; cx.cb = a.in[2][31 * 16 + h] * LOG2E;
    flash_pass<128, 128, MIX_C>(F.lds, qf, H + H_AK + h * 128, HW, wsb(F, WS_VT) + (size_t)(VT_A + h * 128) * S, S, pos, qt * 4, (qt + 1) * 4, 0, 0, cx, o, m, l);
    store_part(o, m, l, F.ws + WS_PART + ((size_t)qi * 16 + h * 4 + 3) * 272, hi);
}
DI void unit_A_gather(const Frame& F, const Args& a, int h, int n, int near, int chunk, int count) {
    const int lane = F.lane, r = lane & 31, hi = lane >> 5;
    const int* pos = (const int*)a.in[1];
    if (near) build_tbl(F.lds, a.in[2], h, (const int*)(F.ws + WS_TPMAX));
    const int* list = (const int*)(F.ws + WS_MLIST) + (size_t)(h * 64 + n) * MCAP + (near ? MCAP_F : 0);
    const int idx = chunk * 256 + F.wave * 32 + r; const bool live = idx < count;
    const int e = list[live ? idx : chunk * 256];
    const int qi = e >> 2, slot = e & 3;
    const bf16_t* H = wsb(F, WS_H);
    const bf16_t* Q = H + (size_t)qi * HW + H_AQ + h * 128 + hi * 8;
    bf16x8 qf[8];
#pragma unroll
    for (int kk = 0; kk < 8; ++kk) qf[kk] = *(const bf16x8*)(Q + kk * 16);
    f32x16 o[4];
#pragma unroll
    for (int d = 0; d < 4; ++d)
#pragma unroll
        for (int i = 0; i < 16; ++i) o[d][i] = 0.f;
    float m = NEG, l = 0.f;
    Ctx cx; cx.qi = 0x7fffffff; cx.pq = pos[qi]; cx.own = 0; cx.sel = 0ull; cx.c = 0.08838834764831845f * LOG2E; cx.cb = a.in[2][31 * 16 + h] * LOG2E;
    flash_pass<128, 128, MIX_C>(F.lds, qf, H + H_AK + h * 128, HW, wsb(F, WS_VT) + (size_t)(VT_A + h * 128) * S, S, pos, n * 4, (n + 1) * 4, 0, 0, cx, o, m, l, near ? n * 4 : (n + 1) * 4);
    if (live) store_part(o, m, l, F.ws + WS_PART + ((size_t)qi * 16 + h * 4 + slot) * 272, hi);
    else { l += xhalf(l); }
}
}

DI int next_unit(const Frame& F, unsigned* head) {
    if (F.tid == 0) F.MISC[4] = __hip_atomic_fetch_add(head, 1u, __ATOMIC_RELAXED, __HIP_MEMORY_SCOPE_AGENT);
    __syncthreads();
    const int u = (int)F.MISC[4];
    __syncthreads();
    return u;
}
DI void convert_chunk(const Frame& F, const Args& a, int layer, int c) {
    const bool isv = c >= 256; const int row0 = (c & 255) * 64 + F.wave * 8;
    const float* src = (isv ? a.in[23] : a.in[22]) + (size_t)layer * 16384 * DM + (size_t)row0 * DM;
    unsigned char* dst = F.ws + (isv ? WS_VB : WS_UB) + (size_t)row0 * 1024;
    const float scale = isv ? V_SCALE : U_SCALE;
    int lane = F.lane; asm volatile("" : "+v"(lane));
    for (int j = 0; j < 8; ++j) {
        const float* p = src + (size_t)j * DM + 4 * lane; unsigned char* q = dst + (size_t)j * 1024 + 2 * lane;
        f32x4 x[8];
#pragma unroll
        for (int k = 0; k < 8; ++k) x[k] = *(const f32x4*)(p + 256 * k);
#pragma unroll
        for (int k = 0; k < 8; ++k) { unsigned d = 0u; const f32x4 y = x[k] * scale;
            d = __builtin_amdgcn_cvt_scalef32_pk_fp4_f32(d, y[0], y[1], 1.0f, 0); d = __builtin_amdgcn_cvt_scalef32_pk_fp4_f32(d, y[2], y[3], 1.0f, 1);
            *(unsigned short*)(q + 128 * k) = (unsigned short)d; }
    }
}
DI void conv_step(const Frame& F, const Args& a, int layer, int c) {
    if (c < 512) convert_chunk(F, a, layer, c);
    else if (layer + 1 < NL && c < 768) { Frame F2 = F; F2.vcu = c - 512; F2.G = 256; convert_weights(F2, a, layer + 1, layer + 2); }
}
template <int PART> DI void phase_attention(const Frame& F, const Args& a, int layer, int rep = 0) {
    unsigned* q = (unsigned*)(F.ws + WS_CTL) + CW_Q + layer * 256 + rep * 512;
    if constexpr (PART == 0) {
#if !defined(NO_D) && !defined(NO_C)
    for (;;) { const int u = next_unit(F, q + 0); if (u >= 768) break;
        const int qt = 63 - u / 12, k = u % 12;
        if (k < 4) att::unit_D(F, a, k, qt);
        else att::unit_C(F, a, (k - 4) >> 1, qt, (k - 4) & 1);
        if (ATT_CONV_INTERLEAVE) { const int c = next_unit(F, q + 32); conv_step(F, a, layer, c); } }
    if (ATT_CONV_INTERLEAVE) for (;;) { const int c = next_unit(F, q + 32); if (c >= 512 + ((layer + 1 < NL) ? 256 : 0)) break; conv_step(F, a, layer, c); }
#endif
    } else {
#ifndef NO_A
    {
        const unsigned* cnt = (const unsigned*)(F.ws + WS_CTL) + CW_MOBA + layer * 1024;
        LAS int* pre = (LAS int*)(F.lds + att::TBL - 4096);
        __syncthreads();
        if (F.tid == 0) { int acc = 0; for (int i = 0; i < 512; ++i) { pre[i] = acc; const unsigned c = cnt[i], cap = (i >= 256) ? (unsigned)(MCAP - MCAP_F) : (unsigned)MCAP_F; acc += (int)(((c < cap ? c : cap) + 255u) >> 8); } pre[512] = acc; }
        __syncthreads();
        const int ntot = 256 + pre[512];
        for (;;) { const int u = next_unit(F, q + 128); if (u >= ntot) break;
            if (u < 256) { att::unit_A_own(F, a, u & 3, 63 - (u >> 2)); continue; }
            const int g = u - 256; int lo_ = 0, hi_ = 511;
            while (lo_ < hi_) { const int mid = (lo_ + hi_ + 1) >> 1; if (pre[mid] <= g) lo_ = mid; else hi_ = mid - 1; }
            const unsigned c = cnt[lo_], cap = (lo_ >= 256) ? (unsigned)(MCAP - MCAP_F) : (unsigned)MCAP_F;
            att::unit_A_gather(F, a, (lo_ >> 6) & 3, lo_ & 63, lo_ >> 8, g - pre[lo_], (int)(c < cap ? c : cap)); }
    }
#endif
#ifndef NO_B
    for (;;) { const int u = next_unit(F, q + 192); if (u >= 512) break; att::unit_B(F, a, layer, u & 7, u >> 3); }
#endif
    }
}

DI void ins16(float (&v)[16], float x) {
#pragma unroll
    for (int k = 0; k < 16; ++k) { const float t = fmaxf(v[k], x); x = fminf(v[k], x); v[k] = t; }
}
DI float pack_idx(float s, int idx, unsigned mask) { return __uint_as_float((__float_as_uint(s) & ~mask) | (unsigned)idx); }
DI void peer_select_group(const Frame& F, const bf16_t* SK, int grp, LAS unsigned char* sel) {
    const bf16_t* QP = wsb(F, WS_H);
    int lane = F.lane; asm volatile("" : "+v"(lane));
    const int r = lane & 31, hi = lane >> 5;
    {
        const int h = F.wave, t = grp * 32 + r;
        float L[2][16];
#pragma unroll
        for (int m = 0; m < 2; ++m) {
            const bf16_t* qrow = QP + (size_t)t * DM + h * 256 + m * 128 + hi * 8;
            bf16x8 qf[8];
#pragma unroll
            for (int kk = 0; kk < 8; ++kk) qf[kk] = *(const bf16x8*)(qrow + kk * 16);
            const bf16_t* kb = SK + ((size_t)(h * 2 + m) * 128 + r) * 128 + hi * 8;
            float v[16];
#pragma unroll
            for (int k = 0; k < 16; ++k) v[k] = -3.0e38f;
#pragma unroll
            for (int rb = 0; rb < 4; ++rb) {
                f32x16 s;
#pragma unroll
                for (int i = 0; i < 16; ++i) s[i] = 0.f;
#pragma unroll
                for (int kk = 0; kk < 8; ++kk) { const bf16x8 kf = *(const bf16x8*)(kb + (size_t)rb * 32 * 128 + kk * 16); s = __builtin_amdgcn_mfma_f32_32x32x16_bf16(kf, qf[kk], s, 0, 0, 0); }
#pragma unroll
                for (int i = 0; i < 16; ++i) ins16(v, pack_idx(s[i], rb * 32 + (i & 3) + 8 * (i >> 2) + 4 * hi, 127u));
                asm volatile("" : "+v"(v[0]), "+v"(v[1]), "+v"(v[2]), "+v"(v[3]), "+v"(v[4]), "+v"(v[5]), "+v"(v[6]), "+v"(v[7]), "+v"(v[8]), "+v"(v[9]), "+v"(v[10]), "+v"(v[11]), "+v"(v[12]), "+v"(v[13]), "+v"(v[14]), "+v"(v[15]));
                asm volatile("" : "+v"(kb));
            }
            float ov[16];
#pragma unroll
            for (int k = 0; k < 16; ++k) ov[k] = xhalf(v[k]);
#pragma unroll
            for (int k = 0; k < 16; ++k) ins16(v, ov[k]);
#pragma unroll
            for (int k = 0; k < 16; ++k) L[m][k] = v[k];
        }
        int i0[16], i1[16];
#pragma unroll
        for (int k = 0; k < 16; ++k) { i0[k] = (int)(__float_as_uint(L[0][k]) & 127u); i1[k] = (int)(__float_as_uint(L[1][k]) & 127u); L[0][k] = __uint_as_float(__float_as_uint(L[0][k]) & ~127u); L[1][k] = __uint_as_float(__float_as_uint(L[1][k]) & ~127u); }
        float b[16];
#pragma unroll
        for (int k = 0; k < 16; ++k) b[k] = -3.0e38f;
#pragma unroll
        for (int i = 0; i < 16; ++i)
#pragma unroll
            for (int j = 0; j < 16; ++j) if ((i + 1) * (j + 1) <= 16) ins16(b, pack_idx(L[0][i] + L[1][j], i * 16 + j, 255u));
        float g[16]; int e[16]; float den = 0.f;
        const float b0 = __uint_as_float(__float_as_uint(b[0]) & ~255u);
#pragma unroll
        for (int k = 0; k < 16; ++k) {
            const unsigned bits = __float_as_uint(b[k]); const int ci = (int)((bits >> 4) & 15u), cj = (int)(bits & 15u);
            int e0 = i0[0], e1 = i1[0];
#pragma unroll
            for (int c = 1; c < 16; ++c) { e0 = (ci == c) ? i0[c] : e0; e1 = (cj == c) ? i1[c] : e1; }
            e[k] = e0 * 128 + e1;
            g[k] = ex2((__uint_as_float(bits & ~255u) - b0) * LOG2E); den += g[k];
        }
        const float inv = 1.0f / den;
        if (hi == 0) {
#pragma unroll
            for (int k = 0; k < 16; k += 4) *(LAS i32x4*)(sel + (r * 128 + h * 16 + k) * 4) = (i32x4){e[k], e[k + 1], e[k + 2], e[k + 3]};
        } else {
#pragma unroll
            for (int k = 0; k < 16; k += 4) *(LAS f32x4*)(sel + 16384 + (r * 128 + h * 16 + k) * 4) = (f32x4){g[k] * inv, g[k + 1] * inv, g[k + 2] * inv, g[k + 3] * inv};
        }
    }
}
DI float gelu_as(float v) {
    const float av = fabsf(v), t = __builtin_amdgcn_rcpf(av * 0.2316418882f + 1.0f);
    float q = t * 0.5307027145f + (-0.7265760135f); q = q * t + 0.7107068705f; q = q * t + (-0.142248368f); q = q * t + 0.127414796f; q = q * t;
    const float e = ex2((v * v) * (-0.72134752044f));
    const float m = v * (q * e);
    return v < 0.f ? m : v - m;
}
template <int CTRL, int RM> DI float dpp_add(float v) { return v + __builtin_bit_cast(float, __builtin_amdgcn_update_dpp(0, __builtin_bit_cast(int, v), CTRL, RM, 0xf, RM == 0xf)); }
DI float wave_total(float v) {
    v = dpp_add<0x111, 0xf>(v); v = dpp_add<0x112, 0xf>(v); v = dpp_add<0x114, 0xf>(v); v = dpp_add<0x118, 0xf>(v);
    v = dpp_add<0x142, 0xa>(v); v = dpp_add<0x143, 0xc>(v);
    return __uint_as_float(__builtin_amdgcn_readlane(__float_as_uint(v), 63));
}
DI void reduce4(float (&d)[4], int lane) {
#pragma unroll
    for (int i = 0; i < 4; ++i) d[i] = wave_total(d[i]);
}
DI void peer_gather_group(const Frame& F, const Args& a, int layer, float* outf, bf16_t* XB, int grp, const LAS unsigned char* sel) {
    typedef int v8i_t __attribute__((ext_vector_type(8)));
    const unsigned char* UB = F.ws + WS_UB; const unsigned char* VB = F.ws + WS_VB;
    int lane = F.lane; asm volatile("" : "+v"(lane));
    const int m16 = lane & 15, g4 = lane >> 4;
    LAS unsigned char* x8 = F.lds + 65536 + F.wave * 2048;
    int sc = 0x7f7f7f7f; asm volatile("" : "+v"(sc));
    for (int ti = 0; ti < 4; ++ti) {
        const int tl = F.wave * 4 + ti, t = grp * 32 + tl;
        const bf16_t* xr = XB + (size_t)t * DM + 32 * lane;
        {
            u32x4 w8[2];
#pragma unroll
            for (int c = 0; c < 4; ++c) { const u32x4 w = *(const u32x4*)(xr + 8 * c);
#if PEER_X_SWAP
                int lo = __builtin_amdgcn_cvt_pk_fp8_f32(bf_hi(w.x), bf_lo(w.x), 0, false); lo = __builtin_amdgcn_cvt_pk_fp8_f32(bf_hi(w.y), bf_lo(w.y), lo, true);
                int hi = __builtin_amdgcn_cvt_pk_fp8_f32(bf_hi(w.z), bf_lo(w.z), 0, false); hi = __builtin_amdgcn_cvt_pk_fp8_f32(bf_hi(w.w), bf_lo(w.w), hi, true);
#else
                int lo = __builtin_amdgcn_cvt_pk_fp8_f32(bf_lo(w.x), bf_hi(w.x), 0, false); lo = __builtin_amdgcn_cvt_pk_fp8_f32(bf_lo(w.y), bf_hi(w.y), lo, true);
                int hi = __builtin_amdgcn_cvt_pk_fp8_f32(bf_lo(w.z), bf_hi(w.z), 0, false); hi = __builtin_amdgcn_cvt_pk_fp8_f32(bf_lo(w.w), bf_hi(w.w), hi, true);
#endif
                w8[c >> 1][(c & 1) * 2] = (unsigned)lo; w8[c >> 1][(c & 1) * 2 + 1] = (unsigned)hi; }
            *(LAS u32x4*)(x8 + 32 * lane) = w8[0]; *(LAS u32x4*)(x8 + 32 * lane + 16) = w8[1];
        }
        f32x2 acc[16];
#pragma unroll
        for (int e = 0; e < 16; ++e) acc[e] = (f32x2){0.f, 0.f};
        for (int half = 0; half < 2; ++half) {
            const int ev = *(const LAS int*)(sel + (tl * 128 + half * 64 + lane) * 4); const float gv = *(const LAS float*)(sel + 16384 + (tl * 128 + half * 64 + lane) * 4);
            for (int bb = 0; bb < 4; ++bb) {
                const int em = __builtin_amdgcn_ds_bpermute((16 * bb + m16) << 2, ev);
                const unsigned char* up = UB + (size_t)em * 1024 + 16 * g4;
                u32x4 ua[16], va[16];
#pragma unroll
                for (int s = 0; s < 16; ++s) ua[s] = *(const u32x4*)(up + 64 * s);
#pragma unroll
                for (int j = 0; j < 16; ++j) { const int e = __builtin_amdgcn_readlane(ev, 16 * bb + j); va[j] = *(const u32x4*)(VB + (size_t)e * 1024 + 16 * lane); }
                f32x4 h = (f32x4){0.f, 0.f, 0.f, 0.f};
#pragma unroll
                for (int s = 0; s < 16; ++s) {
                    const u32x4 x0 = *(const LAS u32x4*)(x8 + 128 * s + 16 * g4), x1 = *(const LAS u32x4*)(x8 + 128 * s + 64 + 16 * g4);
                    const v8i_t xb = (v8i_t){(int)x0.x, (int)x0.y, (int)x0.z, (int)x0.w, (int)x1.x, (int)x1.y, (int)x1.z, (int)x1.w};
                    asm volatile("s_nop 1\n\tv_mfma_scale_f32_16x16x128_f8f6f4 %0, %1, %2, %0, %3, %3 op_sel_hi:[0,0,0] cbsz:4" : "+v"(h) : "v"(ua[s]), "v"(xb), "v"(sc));
                }
                asm volatile("s_nop 15" : "+v"(h));
                float hv[4];
#pragma unroll
                for (int i = 0; i < 4; ++i) { const float gq = __int_as_float(__builtin_amdgcn_ds_bpermute((16 * bb + 4 * g4 + i) << 2, __float_as_int(gv)));
                    hv[i] = gq * gelu_as(h[i] * (1.0f / U_SCALE)) * (1.0f / V_SCALE); }
#pragma unroll
                for (int j = 0; j < 16; ++j) {
                    const float wk = __uint_as_float(__builtin_amdgcn_readlane(__float_as_uint(hv[j & 3]), 16 * (j >> 2)));
                    const f32x2 wk2 = (f32x2){wk, wk}; const u32x4 w_ = va[j];
#define FP4_ACC(b) acc[b] += __builtin_amdgcn_cvt_scalef32_pk_f32_fp4(w_[(b) >> 2], 1.0f, (b) & 3) * wk2;
                    FP4_ACC(0) FP4_ACC(1) FP4_ACC(2) FP4_ACC(3) FP4_ACC(4) FP4_ACC(5) FP4_ACC(6) FP4_ACC(7) FP4_ACC(8) FP4_ACC(9) FP4_ACC(10) FP4_ACC(11) FP4_ACC(12) FP4_ACC(13) FP4_ACC(14) FP4_ACC(15)
#undef FP4_ACC
                }
            }
        }
        float z[1][32];
#pragma unroll
        for (int c = 0; c < 4; ++c) { const u32x4 w = *(const u32x4*)(xr + 8 * c);
            z[0][8 * c + 0] = acc[4 * c].x + DN_ALPHA * bf_lo(w.x); z[0][8 * c + 1] = acc[4 * c].y + DN_ALPHA * bf_hi(w.x); z[0][8 * c + 2] = acc[4 * c + 1].x + DN_ALPHA * bf_lo(w.y); z[0][8 * c + 3] = acc[4 * c + 1].y + DN_ALPHA * bf_hi(w.y);
            z[0][8 * c + 4] = acc[4 * c + 2].x + DN_ALPHA * bf_lo(w.z); z[0][8 * c + 5] = acc[4 * c + 2].y + DN_ALPHA * bf_hi(w.z); z[0][8 * c + 6] = acc[4 * c + 3].x + DN_ALPHA * bf_lo(w.w); z[0][8 * c + 7] = acc[4 * c + 3].y + DN_ALPHA * bf_hi(w.w); }
        ln_store<1, 32>(z, a.in[24] + layer * DM, a.in[25] + layer * DM, outf ? outf + (size_t)t * DM : (float*)nullptr, XB + (size_t)t * DM, lane, outf ? (unsigned char*)nullptr : F.ws + WS_XB8 + (size_t)t * DM, outf ? (unsigned char*)nullptr : F.ws + WS_XB4 + (size_t)t * (DM / 2));
    }
}
DI void phase_peer(const Frame& F, const Args& a, int layer, const bf16_t* SK, float* outf) {
    LAS unsigned char* sel = F.lds;
    bf16_t* XB = wsb(F, WS_XB);
    const int g0 = F.vcu, g1 = F.vcu + F.G, ng = S / 32;
    if (F.vcu & 1) {
        if (g0 < ng) peer_select_group(F, SK, g0, sel);
        if (g1 < ng) peer_select_group(F, SK, g1, sel + 32768);
        __syncthreads();
        if (g0 < ng) peer_gather_group(F, a, layer, outf, XB, g0, sel);
        if (g1 < ng) peer_gather_group(F, a, layer, outf, XB, g1, sel + 32768);
    } else {
        if (g0 < ng) peer_select_group(F, SK, g0, sel);
        __syncthreads();
        if (g0 < ng) peer_gather_group(F, a, layer, outf, XB, g0, sel);
        if (g1 < ng) peer_select_group(F, SK, g1, sel + 32768);
        __syncthreads();
        if (g1 < ng) peer_gather_group(F, a, layer, outf, XB, g1, sel + 32768);
    }
    for (int g = F.vcu + 2 * F.G; g < ng; g += F.G) { __syncthreads(); peer_select_group(F, SK, g, sel); __syncthreads(); peer_gather_group(F, a, layer, outf, XB, g, sel); }
}

#ifndef GEMM_SP2
#define GEMM_SP2 true
#endif
#ifndef GEMM_ALIGN_EPI
#define GEMM_ALIGN_EPI true
#endif
template <int MODE, bool F8 = false, int SC0 = 127, int SC1 = 127, bool F4 = false> DI void run_gemm(const Frame& F, const bf16_t* A, int lda, const bf16_t* Bt, int ldb, int M, int N, int K, long apn, const pg8::Epi<MODE>& E, int rot = 0) {
    pg8::Gemm g{A, Bt, M, N, K, lda, ldb, apn}; pg8::StaticOrder So; So.init(M, N, F.G, (F.G == 256) ? (int)((blockIdx.x + (unsigned)rot) & 255u) : (int)blockIdx.x);
    pg8::gemm_phase<pg8::Epi<MODE>, pg8::StaticOrder, GEMM_ALIGN_EPI, GEMM_SP2, F8, SC0, SC1, F4>(F.lds, g, So, E);
}
#ifndef MK_CHECK
#define MK_CHECK 0
#endif
#ifndef MK_CHECK_WORD
#define MK_CHECK_WORD 0
#endif

#if MK_CHECK
namespace chk {
constexpr int NS = 64;
__device__ const int SAMPLES[NS] = {0, 1, 2, 31, 32, 63, 64, 127, 128, 129, 255, 256, 257, 300, 383, 384, 511, 512, 513, 767, 768, 1000, 1023, 1024, 1025, 1279, 1280, 2047, 2048, 2049, 3071, 3072,
    4095, 4096, 5000, 6143, 6144, 7777, 8191, 8192, 8193, 9999, 10239, 10240, 11111, 12287, 12288, 12289, 13000, 13311, 13312, 14000, 14335, 14336, 15000, 15359, 15360, 15871, 16127, 16128, 16129, 16255, 16256, 16383};
DI float bsum(const Frame& F, float v) {
    v = wave_sum(v);
    __syncthreads();
    if (F.lane == 0) F.MISC[16 + F.wave] = __float_as_uint(v);
    __syncthreads();
    float s = 0.f;
    for (int w = 0; w < 8; ++w) s += __uint_as_float(F.MISC[16 + w]);
    return s;
}
DI float bmax(const Frame& F, float v) {
#pragma unroll
    for (int o = 1; o < 64; o <<= 1) v = fmaxf(v, __shfl_xor(v, o));
    __syncthreads();
    if (F.lane == 0) F.MISC[16 + F.wave] = __float_as_uint(v);
    __syncthreads();
    float s = -INFINITY;
    for (int w = 0; w < 8; ++w) s = fmaxf(s, __uint_as_float(F.MISC[16 + w]));
    return s;
}
DI void verdict(const Frame& F, float err, float nrm, float tol, int code) {
    const float e = bsum(F, err), n = bsum(F, nrm);
    if (F.tid == 0) { const bool bad = !(e <= tol * tol * n + 1e-12f); if (bad) { atomicAdd((unsigned*)(F.ws + WS_CTL) + CW_CHK, 1u); atomicAdd((unsigned*)(F.ws + WS_CTL) + CW_CHK + 64 * (1 + code), 1u); } }
}
DI float sigm(float z) { return 1.0f / (1.0f + expf(-z)); }
DI float rope_inv(int j) { return powf(10000.0f, -(float)j / 32.0f); }
DI float t5_naive(const float* t5, int col, int rel) {
    int n = rel > 0 ? rel : 0; int b;
    if (n < 16) b = n; else { b = 16 + (int)(logf((float)n / 16.0f) / logf(64.0f) * 16.0f); if (b > 31) b = 31; }
    return t5[b * 16 + col];
}
DI void s1(const Frame& F, const Args& a, int layer) {
    const bf16_t* X = wsb(F, WS_XB); const float* W = a.in[3] + (size_t)layer * DM * 4672;
    const bf16_t* H = wsb(F, WS_H); const bf16_t* VT = wsb(F, WS_VT);
    for (int u = F.vcu; u < NS; u += F.G) { const int t = SAMPLES[u]; float err = 0.f, nrm = 0.f;
        for (int c = F.tid; c < 4672; c += 512) { float ref = 0.f; for (int k = 0; k < DM; ++k) ref += bf1(X[(size_t)t * DM + k]) * W[(size_t)k * 4672 + c];
            const int d = win_map(c); const float got = d < HW ? bf1(H[(size_t)t * HW + d]) : bf1(VT[(size_t)(d - HW) * S + t]); err += (ref - got) * (ref - got); nrm += ref * ref; }
        verdict(F, err, nrm, 0.06f, 0); }
}
DI void s2(const Frame& F, const Args& a, int layer) {
    const bf16_t* H = wsb(F, WS_H); const int* pos = (const int*)a.in[1];
    for (int u = F.vcu; u < NS; u += F.G) { const int t = SAMPLES[u]; float err = 0.f, nrm = 0.f;
        float ssq = 0.f; for (int k = 0; k < 512; ++k) { const float v = bf1(H[(size_t)t * HW + H_DCQ + k]); ssq += v * v; }
        const float rq = 1.0f / sqrtf(ssq / 512.0f + 1e-6f);
        float ssk = 0.f; for (int k = 0; k < 256; ++k) { const float v = bf1(H[(size_t)t * HW + H_DCKV + k]); ssk += v * v; }
        const float rk = 1.0f / sqrtf(ssk / 256.0f + 1e-6f);
        for (int c = F.tid; c < 512; c += 512) { const float ref = bf1(H[(size_t)t * HW + H_DCQ + c]) * rq * a.in[14][layer * 512 + c]; const float got = bf1(wsb(F, WS_CQN)[(size_t)t * 512 + c]); err += (ref - got) * (ref - got); nrm += ref * ref; }
        for (int c = F.tid; c < 256; c += 512) { const float ref = bf1(H[(size_t)t * HW + H_DCKV + c]) * rk * a.in[15][layer * 256 + c]; const float got = bf1(wsb(F, WS_CKVN)[(size_t)t * 256 + c]); err += (ref - got) * (ref - got); nrm += ref * ref; }
        for (int c = F.tid; c < 256; c += 512) { const int h = c >> 6, j = c & 63, jj = j & 31; const float x1 = bf1(H[(size_t)t * HW + H_DKR + jj]), x2 = bf1(H[(size_t)t * HW + H_DKR + jj + 32]);
            const float ang = (float)pos[t] * rope_inv(jj); const float ref = j < 32 ? x1 * cosf(ang) - x2 * sinf(ang) : x1 * sinf(ang) + x2 * cosf(ang);
            const float got = bf1(wsb(F, WS_KD)[(size_t)t * 768 + h * 192 + 128 + j]); err += (ref - got) * (ref - got); nrm += ref * ref; }
        verdict(F, err, nrm, 0.02f, 1); }
}
DI void s3(const Frame& F, const Args& a, int layer) {
    const int* pos = (const int*)a.in[1]; const float* Wq = a.in[16] + (size_t)layer * 512 * 768; const float* Wkv = a.in[17] + (size_t)layer * 256 * 1024;
    LAS float* pre = (LAS float*)F.lds;
    for (int u = F.vcu; u < NS; u += F.G) { const int t = SAMPLES[u]; float err = 0.f, nrm = 0.f;
        __syncthreads();
        for (int n = F.tid; n < 768; n += 512) { float r = 0.f; for (int k = 0; k < 512; ++k) r += bf1(wsb(F, WS_CQN)[(size_t)t * 512 + k]) * Wq[(size_t)k * 768 + n]; pre[n] = r; }
        __syncthreads();
        for (int n = F.tid; n < 768; n += 512) { const int h = n / 192, j = n % 192; float ref = pre[n];
            if (j >= 128) { const int jj = (j - 128) & 31; const float x1 = pre[h * 192 + 128 + jj], x2 = pre[h * 192 + 128 + jj + 32]; const float ang = (float)pos[t] * rope_inv(jj);
                ref = (j - 128) < 32 ? x1 * cosf(ang) - x2 * sinf(ang) : x1 * sinf(ang) + x2 * cosf(ang); }
            const float got = bf1(wsb(F, WS_QD)[(size_t)t * 768 + n]); err += (ref - got) * (ref - got); nrm += ref * ref; }
        for (int n = F.tid; n < 1024; n += 512) { float ref = 0.f; for (int k = 0; k < 256; ++k) ref += bf1(wsb(F, WS_CKVN)[(size_t)t * 256 + k]) * Wkv[(size_t)k * 1024 + n];
            const int h = n >> 8, j = n & 255; const float got = j < 128 ? bf1(wsb(F, WS_KD)[(size_t)t * 768 + h * 192 + j]) : bf1(wsb(F, WS_VDT)[(size_t)(h * 128 + j - 128) * S + t]);
            err += (ref - got) * (ref - got); nrm += ref * ref; }
        verdict(F, err, nrm, 0.02f, 2); }
}
DI void s4(const Frame& F, const Args& a, int layer) {
    const int* pos = (const int*)a.in[1]; const float* t5 = a.in[2]; const bf16_t* H = wsb(F, WS_H);
    LAS float* lg = (LAS float*)F.lds;
    LAS float* qv = (LAS float*)(F.lds + 65536);
    LAS float* ga = (LAS float*)(F.lds + 65536 + 1024);
    LAS float* op = (LAS float*)(F.lds + 65536 + 2048);
    LAS float* o1 = (LAS float*)(F.lds + 65536 + 2048 + 2048);
    LAS int* selb = (LAS int*)(F.lds + 65536 + 8192);
    for (int u = F.vcu; u < NS * 20; u += F.G) {
        const int q = SAMPLES[u / 20], mh = u % 20;
        int mix, h; if (mh < 4) { mix = 0; h = mh; } else if (mh < 12) { mix = 1; h = mh - 4; } else if (mh < 16) { mix = 2; h = mh - 12; } else { mix = 3; h = mh - 16; }
        const int DQ = mix == 0 ? 128 : (mix == 3 ? 192 : 64), DVV = mix == 1 ? 64 : 128;
        const int nmaps = mix == 2 ? 2 : 1;
        const float scale = 1.0f / sqrtf((float)DQ);
        const int bcol = mix == 0 ? h : (mix == 1 ? 4 + h : 12 + h);
        float errs = 0.f, nrms = 0.f;
        for (int mp = 0; mp < nmaps; ++mp) {
            const bf16_t* Qp; const bf16_t* Kp; int ldk; const bf16_t* Vp;
            if (mix == 0) { Qp = H + (size_t)q * HW + H_AQ + h * 128; Kp = H + H_AK + h * 128; ldk = HW; Vp = wsb(F, WS_VT) + (size_t)(VT_A + h * 128) * S; }
            else if (mix == 1) { Qp = H + (size_t)q * HW + H_BQ + h * 64; Kp = H + H_BK + (h >> 2) * 64; ldk = HW; Vp = wsb(F, WS_VT) + (size_t)(VT_B + (h >> 2) * 64) * S; }
            else if (mix == 2) { Qp = H + (size_t)q * HW + H_CQ + h * 128 + mp * 64; Kp = H + H_CK + h * 128 + mp * 64; ldk = HW; Vp = wsb(F, WS_VT) + (size_t)(VT_C + h * 128) * S; }
            else { Qp = wsb(F, WS_QD) + (size_t)q * 768 + h * 192; Kp = wsb(F, WS_KD) + h * 192; ldk = 768; Vp = wsb(F, WS_VDT) + (size_t)(h * 128) * S; }
            __syncthreads();
            for (int d = F.tid; d < DQ; d += 512) qv[d] = bf1(Qp[d]);
            if (F.tid < 64) { ga[F.tid] = 0.f; selb[F.tid] = 0; }
            __syncthreads();
            const int own = q >> 8;
            if (mix == 0) {
                for (int idx = F.tid; idx < own * 128; idx += 512) { const int n = idx >> 7, d = idx & 127; float sm = 0.f; for (int i = 0; i < 256; ++i) sm += bf1(Kp[(size_t)(n * 256 + i) * ldk + d]); atomicAdd((float*)&ga[n], qv[d] * (sm / 256.0f)); }
                __syncthreads();
                if (F.tid == 0) { for (int rnk = 0; rnk < 3 && rnk < own; ++rnk) { int best = -1; float bv = -INFINITY; for (int n = 0; n < own; ++n) if (!selb[n] && ga[n] > bv) { bv = ga[n]; best = n; } if (best >= 0) selb[best] = 1; } }
                __syncthreads();
            }
            float mx = -INFINITY;
            for (int k = F.tid; k <= q; k += 512) {
                bool valid = true;
                if (mix == 0) { const int blk = k >> 8; valid = (blk == own) ? true : (selb[blk] != 0); }
                if (mix == 1) valid = (q - k) < 128;
                float l = -INFINITY;
                if (valid) { float dot = 0.f; for (int d = 0; d < DQ; ++d) dot += qv[d] * bf1(Kp[(size_t)k * ldk + d]); l = dot * scale; if (mix != 3) l += t5_naive(t5, bcol, pos[q] - pos[k]); }
                lg[k] = l; mx = fmaxf(mx, l);
            }
            mx = bmax(F, mx);
            const float sink = (mix == 1) ? a.in[8][layer * 8 + h] : -INFINITY;
            if (mix == 1) mx = fmaxf(mx, sink);
            float sm = 0.f;
            for (int k = F.tid; k <= q; k += 512) { const float p = expf(lg[k] - mx); lg[k] = p; sm += p; }
            sm = bsum(F, sm);
            if (mix == 1) sm += expf(sink - mx);
            __syncthreads();
            { const int dv = F.tid % 128, part = F.tid / 128; float acc = 0.f;
              if (dv < DVV) for (int k = part; k <= q; k += 4) acc += lg[k] * bf1(Vp[(size_t)dv * S + k]);
              op[part * 128 + dv] = acc; }
            __syncthreads();
            float val = 0.f;
            if (F.tid < DVV) val = (op[F.tid] + op[128 + F.tid] + op[256 + F.tid] + op[384 + F.tid]) / sm;
            if (mix == 2 && mp == 0) { if (F.tid < 128) o1[F.tid] = val; __syncthreads(); continue; }
            if (mix == 2) {
                float d1 = 0.f, d2 = 0.f; for (int i = 0; i < 64; ++i) { d1 += a.in[9][layer * 64 + i] * a.in[10][layer * 64 + i]; d2 += a.in[11][layer * 64 + i] * a.in[12][layer * 64 + i]; }
                const float li = 0.8f - 0.6f * expf(-0.3f * (float)layer), lam = expf(d1) - expf(d2) + li;
                float x = (F.tid < 128) ? (o1[F.tid] - lam * val) : 0.f;
                const float ms = bsum(F, x * x) / 128.0f;
                val = x / sqrtf(ms + 1e-6f) * ((F.tid < 128) ? a.in[13][layer * 128 + F.tid] : 0.f) * (1.0f - li);
            }
            if (F.tid < DVV) { const int ocol = (mix == 1) ? h * 64 + F.tid : h * 128 + F.tid; const float got = bf1(wsb(F, WS_O)[(size_t)mix * S * 512 + (size_t)q * 512 + ocol]); errs = (val - got) * (val - got); nrms = val * val; }
        }
        verdict(F, errs, nrms, 0.03f, 3 + mix);
    }
}
DI void s5(const Frame& F, const Args& a, int layer) {
    const bf16_t* X = wsb(F, WS_XB);
    for (int u = F.vcu; u < NS; u += F.G) { const int t = SAMPLES[u]; float err = 0.f, nrm = 0.f, err2 = 0.f, nrm2 = 0.f;
        for (int c = F.tid; c < 8192; c += 512) { const int n = c >> 11, cc = c & 2047; const float* W = a.in[4] + ((size_t)layer * 4 + n) * DM * DM; float z = a.in[5][(size_t)layer * 8192 + c];
            for (int k = 0; k < DM; ++k) z += bf1(X[(size_t)t * DM + k]) * W[(size_t)k * DM + cc];
            const float ref = sigm(z), got = __builtin_amdgcn_cvt_pk_f32_fp8((int)(F.ws + WS_GT)[(size_t)t * 8192 + c], false)[0]; err += (ref - got) * (ref - got); nrm += ref * ref; }
        for (int c = F.tid; c < DM; c += 512) { float ref = 0.f;
            for (int n = 0; n < 4; ++n) { const float* W = a.in[6] + ((size_t)layer * 4 + n) * 512 * DM; float br = 0.f; for (int j = 0; j < 512; ++j) br += bf1(wsb(F, WS_O)[(size_t)n * S * 512 + (size_t)t * 512 + j]) * W[(size_t)j * DM + c];
                ref += __builtin_amdgcn_cvt_pk_f32_fp8((int)(F.ws + WS_GT)[(size_t)t * 8192 + n * DM + c], false)[0] * br; }
            const float got = bf1(wsb(F, WS_H)[(size_t)t * DM + c]); err2 += (ref - got) * (ref - got); nrm2 += ref * ref; }
        verdict(F, err, nrm, 0.12f, 7); verdict(F, err2, nrm2, 0.12f, 8); }
}
DI void s6(const Frame& F, const Args& a, int layer) {
    const bf16_t* X = wsb(F, WS_XB); const float* W = a.in[7] + (size_t)layer * DM * DM; const bf16_t* Y = wsb(F, WS_GT);
    for (int u = F.vcu; u < NS; u += F.G) { const int t = SAMPLES[u]; float err = 0.f, nrm = 0.f;
        for (int c = F.tid; c < DM; c += 512) { float ref = 0.f; for (int j = 0; j < DM; ++j) ref += bf1(wsb(F, WS_H)[(size_t)t * DM + j]) * W[(size_t)j * DM + c];
            const float full = DN_ALPHA * bf1(X[(size_t)t * DM + c]) + ref, got = bf1(Y[(size_t)t * DM + c]); err += (full - got) * (full - got); nrm += full * full; }
        verdict(F, err, nrm, 0.006f, 9); }
}
DI void poison(const Frame& F) {
    const unsigned bad = __hip_atomic_load((unsigned*)(F.ws + WS_CTL) + CW_CHK + 64 * MK_CHECK_WORD, __ATOMIC_RELAXED, __HIP_MEMORY_SCOPE_AGENT);
    const float sc = 1.0f + (float)bad / 256.0f;
    for (size_t i = (size_t)F.vcu * 512 + F.tid; i < (size_t)S * DM / 4; i += (size_t)F.G * 512) { f32x4 v = ((f32x4*)F.out)[i]; v = v * sc; ((f32x4*)F.out)[i] = v; }
}
}
#endif

#ifndef MK_CHECK
#define MK_CHECK 0
#endif
#ifndef MK_CHECK_WORD
#define MK_CHECK_WORD 0
#endif
#ifndef MK_CHECK_LAYER
#define MK_CHECK_LAYER 0
#endif
#ifndef MK_PROBE_REL
#define MK_PROBE_REL (-2)
#endif
#ifndef MK_PROBE_REPS
#define MK_PROBE_REPS 1
#endif
#ifndef MK_PER_PHASE
#define MK_PER_PHASE 0
#endif
constexpr int NPL = 11, NPHASES = 1 + NL * NPL;
DI void run_layer(const Frame& F, const Args& args, const XcdBarrier& bar, const int layer, const int lo, const int hi) {
#define PH(k) (lo <= (k) && (k) < hi)
#define SEAM(k) do { if (PH(k) && PH((k) + 1)) xcd_barrier(bar); } while (0)
        const int pb = 1 + layer * NPL;
        unsigned char* wl = F.ws + WS_W + (size_t)layer * WL_STRIDE;
        if (PH(pb + 0)) {
            { pg8::Epi<0> E{}; E.O = wsb(F, WS_H); E.ldc = HW; E.grp = 128; run_gemm<0, true, 121, 127>(F, (const bf16_t*)(F.ws + WS_XB8), DM / 2, (const bf16_t*)(wl + W_IN), DM / 2, S, HW, DM / 2, 0, E); }
            { pg8::Epi<0> E{}; E.O = wsb(F, WS_VT); E.ldc = S; E.grp = 128; run_gemm<0, true, 127, 121>(F, (const bf16_t*)(wl + W_IN + (size_t)HW * DM), DM / 2, (const bf16_t*)(F.ws + WS_XB8), DM / 2, VT_ROWS, S, DM / 2, 0, E, 128); }
            { pg8::Epi<1> E{}; E.O = wsb(F, WS_GT); E.ldc = 8192; E.bias = args.in[5] + (size_t)layer * 8192; run_gemm<1, false, 121, 126, true>(F, (const bf16_t*)(F.ws + WS_XB4), DM / 4, (const bf16_t*)(wl + W_G), DM / 4, S, 8192, DM / 4, 0, E); }
        }
        SEAM(pb + 0);
        if (PH(pb + 1)) phase_prep(F, args, layer);
        SEAM(pb + 1);
        if (PH(pb + 2)) {
            { pg8::Epi<0> E{}; E.O = wsb(F, WS_QD); E.ldc = 768; E.grp = 128; run_gemm<0>(F, wsb(F, WS_CQN), 512, (const bf16_t*)(wl + W_UQ), 512, S, 768, 512, 0, E); }
            { pg8::Epi<0> E{}; E.O = wsb(F, WS_KD); E.ldc = 768; E.grp = 192; run_gemm<0>(F, wsb(F, WS_CKVN), 256, (const bf16_t*)(wl + W_UKV), 256, S, 512, 256, 0, E, 64); }
            { pg8::Epi<0> E{}; E.O = wsb(F, WS_VDT); E.ldc = S; E.grp = 128; run_gemm<0>(F, (const bf16_t*)(wl + W_UKV) + (size_t)512 * 256, 256, wsb(F, WS_CKVN), 256, 512, S, 256, 0, E, 192); }
        }
        SEAM(pb + 2);
        if (PH(pb + 3)) { phase_ropeq(F, args); phase_moba_select(F, args, layer); }
        SEAM(pb + 3);
        if (PH(pb + 4)) {
            phase_attention<0>(F, args, layer);
            if (!ATT_CONV_INTERLEAVE) { convert_fp4(F, args.in[22] + (size_t)layer * 16384 * DM, F.ws + WS_UB, 16384, U_SCALE); convert_fp4(F, args.in[23] + (size_t)layer * 16384 * DM, F.ws + WS_VB, 16384, V_SCALE); }
            if (!ATT_CONV_INTERLEAVE && layer + 1 < NL) convert_weights(F, args, layer + 1, layer + 2);
            __syncthreads();
            phase_attention<1>(F, args, layer);
        }
        SEAM(pb + 4);
        if (PH(pb + 5)) phase_mixer_combine(F, args, layer);
        SEAM(pb + 5);
        if (PH(pb + 6)) {
            for (int n = 0; n < 4; ++n) { pg8::Epi<2> E{}; E.O = wsb(F, WS_H); E.ldc = DM; E.G = (const bf16_t*)(F.ws + WS_GT + n * DM); E.ldg = 8192; E.first = (n == 0); E.O8 = (n == 3) ? F.ws + WS_XB8 : (unsigned char*)nullptr;
                run_gemm<2, true, 121, 124>(F, (const bf16_t*)(F.ws + WS_O8 + (size_t)n * S * 512), 256, (const bf16_t*)(wl + W_BR) + (size_t)n * DM * 512, 256, S, DM, 256, 0, E); }
        }
        SEAM(pb + 6);
        if (PH(pb + 7)) { pg8::Epi<3> E{}; E.O = F.ws + WS_GT; E.ldc = DM; E.X = wsb(F, WS_XB); E.alpha = DN_ALPHA;
            run_gemm<3, true, 121, 124>(F, (const bf16_t*)(F.ws + WS_XB8), DM / 2, (const bf16_t*)(wl + W_O), DM / 2, S, DM, DM / 2, 0, E); }
        SEAM(pb + 7);
        if (PH(pb + 8)) phase_ln1(F, args, layer);
        SEAM(pb + 8);
        if (PH(pb + 9)) { pg8::Epi<0> E{}; E.O = wsb(F, WS_H); E.ldc = DM; E.grp = 128; run_gemm<0>(F, wsb(F, WS_XB), DM, (const bf16_t*)(wl + W_PQ), DM, S, DM, DM, 0, E); }
        SEAM(pb + 9);
        if (PH(pb + 10)) phase_peer(F, args, layer, (const bf16_t*)(wl + W_SK), (layer == NL - 1) ? F.out : (float*)nullptr);
        SEAM(pb + 10);
#undef PH
#undef SEAM
}
__global__ void __launch_bounds__(512, 2) fwd_kernel(Args args) {
    extern __shared__ __attribute__((aligned(16))) unsigned char lds_raw[];
    Frame F;
    F.lds = (LAS unsigned char*)lds_raw; F.MISC = (volatile LAS unsigned*)(F.lds + MISC_OFF);
    F.tid = threadIdx.x; F.lane = F.tid & 63; F.wave = __builtin_amdgcn_readfirstlane(F.tid >> 6);
    F.G = gridDim.x; { const int bx = blockIdx.x; F.vcu = (F.G % 8 == 0) ? (bx % 8) * (F.G / 8) + bx / 8 : bx; }
    F.ws = args.ws; F.out = args.out;
    if (F.tid < 64) F.MISC[F.tid] = 0u;
    __syncthreads();
    const int lo = args.ph_lo, hi = args.ph_hi;
    unsigned* barw = (unsigned*)(F.ws + WS_CTL) + CW_BAR + (lo > 0 ? XCD_BAR_WORDS : 0);
    XcdBarrier bar; bar.bar = barw; bar.x = 0; bar.st = F.MISC;
    if (hi - lo > 1) bar = xcd_barrier_post(barw, F.MISC);
#define PH(k) (lo <= (k) && (k) < hi)
#define SEAM(k) do { if (PH(k) && PH((k) + 1)) xcd_barrier(bar); } while (0)
    if (PH(0)) phase_prologue(F, args);
    SEAM(0);
    run_layer(F, args, bar, 0, lo, hi);
    run_layer(F, args, bar, 1, lo, hi);
#undef PH
#undef SEAM
}


#if MK_CHECK
__global__ void __launch_bounds__(512, 1) chk_kernel(Args args, int stage, int layer) {
    extern __shared__ __attribute__((aligned(16))) unsigned char lds_raw[];
    Frame F;
    F.lds = (LAS unsigned char*)lds_raw; F.MISC = (volatile LAS unsigned*)(F.lds + MISC_OFF);
    F.tid = threadIdx.x; F.lane = F.tid & 63; F.wave = __builtin_amdgcn_readfirstlane(F.tid >> 6);
    F.G = gridDim.x; { const int bx = blockIdx.x; F.vcu = (F.G % 8 == 0) ? (bx % 8) * (F.G / 8) + bx / 8 : bx; }
    F.ws = args.ws; F.out = args.out;
    if (stage == 1) { chk::s1(F, args, layer); chk::s2(F, args, layer); chk::s3(F, args, layer); }
    if (stage == 4) chk::s4(F, args, layer);
    if (stage == 5) chk::s5(F, args, layer);
    if (stage == 6) chk::s6(F, args, layer);
    if (stage == 99) chk::poison(F);
}
#endif
extern "C" void kernel_launch(void* const* d_in, const int* in_sizes, int n_in, void* d_out, int out_size, void* d_ws, size_t ws_size, hipStream_t stream) {
    static int grid = 0;
    if (grid == 0) {
        if (n_in != 26 || out_size != S * DM || ws_size < WS_END) { fprintf(stderr, "kernel_launch: unexpected problem (n_in %d, out %d, ws %zu); nothing launched\n", n_in, out_size, ws_size); grid = -1; return; }
        int dev = 0, cus = 0, per_cu = 0;
        if (hipGetDevice(&dev) != hipSuccess || hipDeviceGetAttribute(&cus, hipDeviceAttributeMultiprocessorCount, dev) != hipSuccess) { grid = -1; return; }
        if (hipFuncSetAttribute((const void*)fwd_kernel, hipFuncAttributeMaxDynamicSharedMemorySize, LDS_BYTES) != hipSuccess) { fprintf(stderr, "kernel_launch: hipFuncSetAttribute failed\n"); grid = -1; return; }
        if (hipOccupancyMaxActiveBlocksPerMultiprocessor(&per_cu, (const void*)fwd_kernel, 512, LDS_BYTES) != hipSuccess || per_cu < 1) { fprintf(stderr, "kernel_launch: occupancy query says %d blocks per CU\n", per_cu); }
        (void)hipGetLastError();
        grid = cus;
    }
    if (grid < 0) return;
    (void)hipMemsetAsync((char*)d_ws + WS_CTL, 0, CTL_ZERO_BYTES, stream);
    Args a{};
    for (int i = 0; i < 26; ++i) a.in[i] = (const float*)d_in[i];
    a.out = (float*)d_out; a.ws = (unsigned char*)d_ws;
#if MK_CHECK
    {
        static bool once = false; if (!once) { once = true; (void)hipFuncSetAttribute((const void*)chk_kernel, hipFuncAttributeMaxDynamicSharedMemorySize, LDS_BYTES); }
        const int pb = 1 + MK_CHECK_LAYER * NPL; const int cuts[6] = {0, pb + 4, pb + 6, pb + 7, pb + 8, NPHASES}; const int stg[5] = {1, 4, 5, 6, 0};
        for (int i = 0; i < 5; ++i) { (void)hipMemsetAsync((unsigned*)((char*)d_ws + WS_CTL) + CW_BAR, 0, 2 * XCD_BAR_WORDS * 4, stream); a.ph_lo = cuts[i]; a.ph_hi = cuts[i + 1]; hipLaunchKernelGGL(fwd_kernel, dim3(grid), dim3(512), LDS_BYTES, stream, a);
            if (stg[i]) hipLaunchKernelGGL(chk_kernel, dim3(grid), dim3(512), LDS_BYTES, stream, a, stg[i], MK_CHECK_LAYER); }
        hipLaunchKernelGGL(chk_kernel, dim3(grid), dim3(512), LDS_BYTES, stream, a, 99, 0);
    }
#elif MK_PROBE_REL > -2
    {
        unsigned* ctl = (unsigned*)((char*)d_ws + WS_CTL);
        auto launch = [&](int lo, int hi) { if (hi <= lo) return; (void)hipMemsetAsync(ctl + CW_BAR, 0, 2 * XCD_BAR_WORDS * 4, stream); a.ph_lo = lo; a.ph_hi = hi; hipLaunchKernelGGL(fwd_kernel, dim3(grid), dim3(512), LDS_BYTES, stream, a); };
        int cur = 0;
        const int nl = (MK_PROBE_REL == -1) ? 1 : NL;
        for (int layer = 0; layer < nl; ++layer) {
            const int p = (MK_PROBE_REL == -1) ? 0 : 1 + layer * NPL + MK_PROBE_REL;
            launch(cur, p);
            for (int r = 0; r <= MK_PROBE_REPS; ++r) {
                (void)hipMemsetAsync(ctl + CW_Q, 0, 4096 * 4, stream);
#ifdef MK_PROBE_MIXER
                if (r > 0) { (void)hipMemsetAsync(ctl + CW_Q, 0x04, 4096 * 4, stream); (void)hipMemsetAsync(ctl + CW_Q + layer * 256 + 64 * MK_PROBE_MIXER, 0, 4, stream); }
#endif
                if (MK_PROBE_REL == 10 && r == 0) (void)hipMemcpyAsync((char*)d_ws + WS_GT, (char*)d_ws + WS_XB, (size_t)S * DM * 2, hipMemcpyDeviceToDevice, stream);
                if (MK_PROBE_REL == 10 && r > 0) (void)hipMemcpyAsync((char*)d_ws + WS_XB, (char*)d_ws + WS_GT, (size_t)S * DM * 2, hipMemcpyDeviceToDevice, stream);
                if (MK_PROBE_REL == 3 && r == 0) (void)hipMemcpyAsync((char*)d_ws + WS_PART, (char*)d_ws + WS_QD, (size_t)S * 768 * 2, hipMemcpyDeviceToDevice, stream);
                if (MK_PROBE_REL == 3 && r > 0) { (void)hipMemcpyAsync((char*)d_ws + WS_QD, (char*)d_ws + WS_PART, (size_t)S * 768 * 2, hipMemcpyDeviceToDevice, stream); (void)hipMemsetAsync(ctl + CW_MOBA, 0, 2048 * 4, stream); }
                launch(p, p + 1);
            }
            cur = p + 1;
        }
        launch(cur, NPHASES);
    }
#elif MK_PER_PHASE
    for (int p = 0; p < NPHASES; ++p) { a.ph_lo = p; a.ph_hi = p + 1; hipLaunchKernelGGL(fwd_kernel, dim3(grid), dim3(512), LDS_BYTES, stream, a); }
#else
    a.ph_lo = 0; a.ph_hi = NPHASES;
    hipLaunchKernelGGL(fwd_kernel, dim3(grid), dim3(512), LDS_BYTES, stream, a);
#endif
}
```

```cpp
#include <hip/hip_runtime.h>
#include <cstdio>
#include <cstdint>
#include <cmath>

#define DI __device__ __forceinline__
#define LAS __attribute__((address_space(3)))
#define GAS __attribute__((address_space(1)))
typedef unsigned short bf16_t;
typedef short bf16x8 __attribute__((ext_vector_type(8)));
typedef float f32x4 __attribute__((ext_vector_type(4)));
typedef float f32x2 __attribute__((ext_vector_type(2)));
typedef float f32x16 __attribute__((ext_vector_type(16)));
typedef unsigned u32x4 __attribute__((ext_vector_type(4)));
typedef unsigned u32x2 __attribute__((ext_vector_type(2)));
typedef int i32x4 __attribute__((ext_vector_type(4)));
typedef __bf16 bf16x2_t __attribute__((ext_vector_type(2)));

DI unsigned cvtpk(float lo, float hi) { f32x2 v = {lo, hi}; bf16x2_t b = __builtin_convertvector(v, bf16x2_t); return __builtin_bit_cast(unsigned, b); }
DI float bf_lo(unsigned u) { return __uint_as_float(u << 16); }
DI float bf_hi(unsigned u) { return __uint_as_float(u & 0xffff0000u); }
DI float bf1(bf16_t u) { return __uint_as_float((unsigned)u << 16); }
DI float ex2(float x) { return __builtin_amdgcn_exp2f(x); }
DI float wave_sum(float v) {
#pragma unroll
    for (int o = 1; o < 64; o <<= 1) v += __shfl_xor(v, o);
    return v;
}
DI float xhalf(float v) { return __shfl_xor(v, 32); }

namespace pg8 {
#define PG8_LAS __attribute__((address_space(3)))
#ifndef PG8_WGM
#define PG8_WGM 8
#endif
constexpr int BM = 256, BK = 64, HALF = 128, HTB = HALF * BK * 2  , STAGE_BYTES = 8 * HTB, NXCD = 8, WGM = PG8_WGM;

__host__ __device__ __forceinline__ int lds_byte(int r, int c) { const int st = (r >> 4) * 2 + (c >> 5), rr = r & 15, cc = c & 31, ob = rr * 64 + cc * 2; return st * 1024 + (ob ^ (((ob >> 9) & 1) << 5)); }
__host__ __device__ __forceinline__ void stage_rc(int b, int& R, int& C) { const int st = b / 1024, sb = b % 1024, swz = sb ^ (((sb >> 9) & 1) << 5); R = (st >> 1) * 16 + swz / 64; C = (st & 1) * 32 + (swz % 64) / 2; }
__host__ __device__ __forceinline__ int perm32(int rho) { const int n = rho >> 4, i = rho & 15; return 8 * (i >> 2) + 4 * n + (i & 3); }

struct Unit { int pm, pn; };
struct Gemm { const bf16_t* A; const bf16_t* Bt; int M, N, K, lda, ldb; long apn; };

struct StaticOrder {
    int nM, nN, nwg, G, c;
    __host__ __device__ void init(int M, int N, int G_, int c_) { nM = M / BM; nN = N / BM; nwg = nM * nN; G = G_; c = c_; }
    __host__ __device__ bool next(int i, Unit& u) const {
        const long L = (long)i * G + c; if (L >= nwg) return false;
        int wgid = (int)L; { const int q = nwg / NXCD, r = nwg % NXCD, xcd = wgid % NXCD, off = wgid / NXCD; wgid = (xcd < r ? xcd * (q + 1) : r * (q + 1) + (xcd - r) * q) + off; }
        const int nig = WGM * nN, gid = wgid / nig, fm = gid * WGM, gsz = (nM - fm) < WGM ? (nM - fm) : WGM;
        u.pm = fm + ((wgid % nig) % gsz); u.pn = (wgid % nig) / gsz; return true;
    }
    __device__ __forceinline__ void a_ready(const Unit&) const {}
    __device__ __forceinline__ void done(const Unit&) const {}
};

template <int MODE> struct Epi {
    static constexpr bool PERM = true, AFTER_DRAIN = false;
    void* O; int ldc; int grp; const float* bias; const bf16_t* G; int ldg; const void* X; float alpha; int first; unsigned char* O8;
    __device__ __forceinline__ void operator()(const f32x4 (&acc)[2][2][4][2], const Unit& u, int wr, int wc, int fr, int fq) const {
        const int row0 = u.pm * BM + wr * 64 + fr, colb = u.pn * BM + wc * 32 + 8 * fq;
#pragma unroll
        for (int ai = 0; ai < 2; ++ai)
#pragma unroll
            for (int m = 0; m < 4; ++m) {
                const size_t r = (size_t)(row0 + ai * HALF + m * 16);
#pragma unroll
                for (int bj = 0; bj < 2; ++bj) {
                    const int c = colb + bj * HALF;
                    f32x4 v0 = acc[ai][bj][m][0], v1 = acc[ai][bj][m][1];
                    if constexpr (MODE == 0) {
                        const int dc = (c >> 7) * grp + (c & 127);
                        u32x4 w; w.x = cvtpk(v0[0], v0[1]); w.y = cvtpk(v0[2], v0[3]); w.z = cvtpk(v1[0], v1[1]); w.w = cvtpk(v1[2], v1[3]);
                        *(u32x4*)((bf16_t*)O + r * ldc + dc) = w;
                    } else if constexpr (MODE == 1) {
                        const f32x4 b0 = *(const f32x4*)(bias + c), b1 = *(const f32x4*)(bias + c + 4);
                        v0 = v0 + b0; v1 = v1 + b1;
#pragma unroll
                        for (int e = 0; e < 4; ++e) { v0[e] = __builtin_amdgcn_rcpf(1.0f + ex2(-1.4426950408889634f * v0[e])); v1[e] = __builtin_amdgcn_rcpf(1.0f + ex2(-1.4426950408889634f * v1[e])); }
                        int lo = __builtin_amdgcn_cvt_pk_fp8_f32(v0[0], v0[1], 0, false); lo = __builtin_amdgcn_cvt_pk_fp8_f32(v0[2], v0[3], lo, true);
                        int hi = __builtin_amdgcn_cvt_pk_fp8_f32(v1[0], v1[1], 0, false); hi = __builtin_amdgcn_cvt_pk_fp8_f32(v1[2], v1[3], hi, true);
                        *(u32x2*)((unsigned char*)O + r * ldc + c) = (u32x2){(unsigned)lo, (unsigned)hi};
                    } else if constexpr (MODE == 2) {
                        const u32x2 gq = *(const u32x2*)((const unsigned char*)G + r * ldg + c);
                        const f32x2 g0 = __builtin_amdgcn_cvt_pk_f32_fp8((int)gq.x, false), g1 = __builtin_amdgcn_cvt_pk_f32_fp8((int)gq.x, true), g2 = __builtin_amdgcn_cvt_pk_f32_fp8((int)gq.y, false), g3 = __builtin_amdgcn_cvt_pk_f32_fp8((int)gq.y, true);
                        bf16_t* op = (bf16_t*)O + r * ldc + c;
                        u32x4 old = (u32x4){0u, 0u, 0u, 0u};
                        if (!first) old = *(const u32x4*)op;
                        const float r0 = bf_lo(old.x) + g0.x * v0[0], r1 = bf_hi(old.x) + g0.y * v0[1], r2 = bf_lo(old.y) + g1.x * v0[2], r3 = bf_hi(old.y) + g1.y * v0[3];
                        const float r4 = bf_lo(old.z) + g2.x * v1[0], r5 = bf_hi(old.z) + g2.y * v1[1], r6 = bf_lo(old.w) + g3.x * v1[2], r7 = bf_hi(old.w) + g3.y * v1[3];
                        u32x4 w; w.x = cvtpk(r0, r1); w.y = cvtpk(r2, r3); w.z = cvtpk(r4, r5); w.w = cvtpk(r6, r7);
                        *(u32x4*)op = w;
                        if (O8) {
                            int lo = __builtin_amdgcn_cvt_pk_fp8_f32(r0 * 8.0f, r1 * 8.0f, 0, false); lo = __builtin_amdgcn_cvt_pk_fp8_f32(r2 * 8.0f, r3 * 8.0f, lo, true);
                            int hi = __builtin_amdgcn_cvt_pk_fp8_f32(r4 * 8.0f, r5 * 8.0f, 0, false); hi = __builtin_amdgcn_cvt_pk_fp8_f32(r6 * 8.0f, r7 * 8.0f, hi, true);
                            *(u32x2*)(O8 + r * ldc + c) = (u32x2){(unsigned)lo, (unsigned)hi}; }
                    } else if constexpr (MODE == 3) {
                        const u32x4 xx = *(const u32x4*)((const bf16_t*)X + r * ldc + c);
                        u32x4 w;
                        w.x = cvtpk(bf_lo(xx.x) * alpha + v0[0], bf_hi(xx.x) * alpha + v0[1]); w.y = cvtpk(bf_lo(xx.y) * alpha + v0[2], bf_hi(xx.y) * alpha + v0[3]);
                        w.z = cvtpk(bf_lo(xx.z) * alpha + v1[0], bf_hi(xx.z) * alpha + v1[1]); w.w = cvtpk(bf_lo(xx.w) * alpha + v1[2], bf_hi(xx.w) * alpha + v1[3]);
                        *(u32x4*)((bf16_t*)O + r * ldc + c) = w;
                    } else {
                        *(f32x4*)((float*)O + r * ldc + c) = v0; *(f32x4*)((float*)O + r * ldc + c + 4) = v1;
                    }
                }
            }
    }
};

template <class Epi, class Sched, bool ALIGN_EPI = false, bool SP2 = false, bool F8 = false, int SC0 = 127, int SC1 = 127, bool F4 = false>
__device__ __forceinline__ void gemm_phase(PG8_LAS unsigned char* lds, const Gemm g, const Sched& S, const Epi& E) {
    int tid_ = threadIdx.x; asm volatile("" : "+v"(tid_));
    const int tid = tid_, wid = __builtin_amdgcn_readfirstlane(tid >> 6), lane = tid & 63, wr = wid >> 2, wc = wid & 3, fr = lane & 15, fq = lane >> 4;
    const int K = g.K, nt = K / BK;
    unsigned voffA[2], voffB[2];
#pragma unroll
    for (int i = 0; i < 2; ++i) { int R, C; stage_rc(tid * 16 + i * 8192, R, C); const int Rb = Epi::PERM ? ((R & ~31) + perm32(R & 31)) : R;
        voffA[i] = (unsigned)(R * g.lda + C) * 2u; voffB[i] = (unsigned)(Rb * g.ldb + C) * 2u; }
    const size_t kstep = (size_t)(BK * 2);
    const size_t hstepA = (size_t)HALF * g.lda * 2, hstepB = (size_t)HALF * g.ldb * 2;
    const size_t tstepA = 2 * hstepA, tstepB = 2 * hstepB;
    const unsigned ldsw = (unsigned)wid * 1024u;
    const int aoff = lds_byte(wr * 64 + fr, fq * 8), boff = lds_byte(wc * 32 + fr, fq * 8);

#define PG8_SA(b, h) (((b) * 2 + (h)) * HTB)
#define PG8_SB(b, h) ((4 + (b) * 2 + (h)) * HTB)
#define PG8_STAGE(bufoff, gbase, voff) do { _Pragma("unroll") for (int _i = 0; _i < 2; ++_i) \
        __builtin_amdgcn_global_load_lds((const unsigned*)((const char*)(gbase) + (voff)[_i]), (PG8_LAS unsigned*)(lds + (bufoff) + ldsw + _i * 8192), 16, 0, 0); } while (0)
#define PG8_LDA(dst, b, h) do { _Pragma("unroll") for (int m = 0; m < 4; ++m) { if constexpr (F8) { const v4i_t lo_ = *(const PG8_LAS v4i_t*)(lds + PG8_SA(b, h) + aoff + m * 2048), hi_ = *(const PG8_LAS v4i_t*)(lds + PG8_SA(b, h) + aoff + m * 2048 + 1024); dst##8[m] = __builtin_shufflevector(lo_, hi_, 0, 1, 2, 3, 4, 5, 6, 7); } else { _Pragma("unroll") for (int k = 0; k < 2; ++k) dst[m][k] = *(const PG8_LAS bf16x8*)(lds + PG8_SA(b, h) + aoff + m * 2048 + k * 1024); } } } while (0)
#define PG8_LDB(dst, b, h) do { _Pragma("unroll") for (int n = 0; n < 2; ++n) { if constexpr (F8) { const v4i_t lo_ = *(const PG8_LAS v4i_t*)(lds + PG8_SB(b, h) + boff + n * 2048), hi_ = *(const PG8_LAS v4i_t*)(lds + PG8_SB(b, h) + boff + n * 2048 + 1024); dst##8[n] = __builtin_shufflevector(lo_, hi_, 0, 1, 2, 3, 4, 5, 6, 7); } else { _Pragma("unroll") for (int k = 0; k < 2; ++k) dst[n][k] = *(const PG8_LAS bf16x8*)(lds + PG8_SB(b, h) + boff + n * 2048 + k * 1024); } } } while (0)
#define PG8_MMA(ai, bj, At, Bt) do { __builtin_amdgcn_s_setprio(1); \
        if constexpr (F8) {   \
            asm volatile("s_nop 1\n\t" \
            "v_mfma_scale_f32_16x16x128_f8f6f4 %0, %12, %8, %0, %14, %15 op_sel_hi:[0,0,0]\n\t"  \
            "v_mfma_scale_f32_16x16x128_f8f6f4 %1, %13, %8, %1, %14, %15 op_sel_hi:[0,0,0]\n\t"  \
            "v_mfma_scale_f32_16x16x128_f8f6f4 %2, %12, %9, %2, %14, %15 op_sel_hi:[0,0,0]\n\t"  \
            "v_mfma_scale_f32_16x16x128_f8f6f4 %3, %13, %9, %3, %14, %15 op_sel_hi:[0,0,0]\n\t"  \
            "v_mfma_scale_f32_16x16x128_f8f6f4 %4, %12, %10, %4, %14, %15 op_sel_hi:[0,0,0]\n\t"  \
            "v_mfma_scale_f32_16x16x128_f8f6f4 %5, %13, %10, %5, %14, %15 op_sel_hi:[0,0,0]\n\t"  \
            "v_mfma_scale_f32_16x16x128_f8f6f4 %6, %12, %11, %6, %14, %15 op_sel_hi:[0,0,0]\n\t"  \
            "v_mfma_scale_f32_16x16x128_f8f6f4 %7, %13, %11, %7, %14, %15 op_sel_hi:[0,0,0]\n\t"  \
                : "+v"(acc[ai][bj][0][0]), "+v"(acc[ai][bj][0][1]), "+v"(acc[ai][bj][1][0]), "+v"(acc[ai][bj][1][1]), "+v"(acc[ai][bj][2][0]), "+v"(acc[ai][bj][2][1]), "+v"(acc[ai][bj][3][0]), "+v"(acc[ai][bj][3][1]) \
                : "v"(At##8[0]), "v"(At##8[1]), "v"(At##8[2]), "v"(At##8[3]), "v"(Bt##8[0]), "v"(Bt##8[1]), "v"(sc0), "v"(sc1)); \
        } else if constexpr (F4) { \
            asm volatile("s_nop 1\n\t" \
            "v_mfma_scale_f32_16x16x128_f8f6f4 %0, %16, %8, %0, %20, %21 op_sel_hi:[0,0,0] cbsz:4 blgp:4\n\t"  \
            "v_mfma_scale_f32_16x16x128_f8f6f4 %0, %17, %9, %0, %20, %21 op_sel_hi:[0,0,0] cbsz:4 blgp:4\n\t"  \
            "v_mfma_scale_f32_16x16x128_f8f6f4 %1, %18, %8, %1, %20, %21 op_sel_hi:[0,0,0] cbsz:4 blgp:4\n\t"  \
            "v_mfma_scale_f32_16x16x128_f8f6f4 %1, %19, %9, %1, %20, %21 op_sel_hi:[0,0,0] cbsz:4 blgp:4\n\t"  \
            "v_mfma_scale_f32_16x16x128_f8f6f4 %2, %16, %10, %2, %20, %21 op_sel_hi:[0,0,0] cbsz:4 blgp:4\n\t"  \
            "v_mfma_scale_f32_16x16x128_f8f6f4 %2, %17, %11, %2, %20, %21 op_sel_hi:[0,0,0] cbsz:4 blgp:4\n\t"  \
            "v_mfma_scale_f32_16x16x128_f8f6f4 %3, %18, %10, %3, %20, %21 op_sel_hi:[0,0,0] cbsz:4 blgp:4\n\t"  \
            "v_mfma_scale_f32_16x16x128_f8f6f4 %3, %19, %11, %3, %20, %21 op_sel_hi:[0,0,0] cbsz:4 blgp:4\n\t"  \
            "v_mfma_scale_f32_16x16x128_f8f6f4 %4, %16, %12, %4, %20, %21 op_sel_hi:[0,0,0] cbsz:4 blgp:4\n\t"  \
            "v_mfma_scale_f32_16x16x128_f8f6f4 %4, %17, %13, %4, %20, %21 op_sel_hi:[0,0,0] cbsz:4 blgp:4\n\t"  \
            "v_mfma_scale_f32_16x16x128_f8f6f4 %5, %18, %12, %5, %20, %21 op_sel_hi:[0,0,0] cbsz:4 blgp:4\n\t"  \
            "v_mfma_scale_f32_16x16x128_f8f6f4 %5, %19, %13, %5, %20, %21 op_sel_hi:[0,0,0] cbsz:4 blgp:4\n\t"  \
            "v_mfma_scale_f32_16x16x128_f8f6f4 %6, %16, %14, %6, %20, %21 op_sel_hi:[0,0,0] cbsz:4 blgp:4\n\t"  \
            "v_mfma_scale_f32_16x16x128_f8f6f4 %6, %17, %15, %6, %20, %21 op_sel_hi:[0,0,0] cbsz:4 blgp:4\n\t"  \
            "v_mfma_scale_f32_16x16x128_f8f6f4 %7, %18, %14, %7, %20, %21 op_sel_hi:[0,0,0] cbsz:4 blgp:4\n\t"  \
            "v_mfma_scale_f32_16x16x128_f8f6f4 %7, %19, %15, %7, %20, %21 op_sel_hi:[0,0,0] cbsz:4 blgp:4\n\t"  \
                : "+v"(acc[ai][bj][0][0]), "+v"(acc[ai][bj][0][1]), "+v"(acc[ai][bj][1][0]), "+v"(acc[ai][bj][1][1]), "+v"(acc[ai][bj][2][0]), "+v"(acc[ai][bj][2][1]), "+v"(acc[ai][bj][3][0]), "+v"(acc[ai][bj][3][1]) \
                : "v"(At[0][0]), "v"(At[0][1]), "v"(At[1][0]), "v"(At[1][1]), "v"(At[2][0]), "v"(At[2][1]), "v"(At[3][0]), "v"(At[3][1]), "v"(Bt[0][0]), "v"(Bt[0][1]), "v"(Bt[1][0]), "v"(Bt[1][1]), "v"(sc0), "v"(sc1)); \
        } else { _Pragma("unroll") for (int m = 0; m < 4; ++m) _Pragma("unroll") for (int n = 0; n < 2; ++n) _Pragma("unroll") for (int k = 0; k < 2; ++k) \
            acc[ai][bj][m][n] = __builtin_amdgcn_mfma_f32_16x16x32_bf16(Bt[n][k], At[m][k], acc[ai][bj][m][n], 0, 0, 0); } \
        __builtin_amdgcn_s_setprio(0); } while (0)
#define PG8_WAIT_V(n) asm volatile("s_waitcnt vmcnt(" #n ")" ::: "memory")
#define PG8_WAIT_L(n) asm volatile("s_waitcnt lgkmcnt(" #n ")" ::: "memory")
#define PG8_BAR __builtin_amdgcn_s_barrier()
#define PG8_SCHED __builtin_amdgcn_sched_barrier(0)
    Unit cur, nxt; int ui = 0;
    if (!S.next(0, cur)) return;
    f32x4 acc[2][2][4][2];
#pragma unroll
    for (int a = 0; a < 2; ++a)
#pragma unroll
        for (int b = 0; b < 2; ++b)
#pragma unroll
            for (int m = 0; m < 4; ++m)
#pragma unroll
                for (int n = 0; n < 2; ++n) acc[a][b][m][n] = (f32x4){0.f, 0.f, 0.f, 0.f};
    bf16x8 At[4][2], B0[2][2], B1[2][2];
    typedef int v8i_t __attribute__((ext_vector_type(8))); typedef int v4i_t __attribute__((ext_vector_type(4)));
    v8i_t At8[4], B08[2], B18[2];
    int sc0 = SC0 * 0x01010101, sc1 = SC1 * 0x01010101; asm volatile("" : "+v"(sc0), "+v"(sc1));
    const char* cA = (const char*)g.A + (size_t)cur.pm * tstepA + (size_t)cur.pn * g.apn; const char* cB = (const char*)g.Bt + (size_t)cur.pn * tstepB;
    S.a_ready(cur);
    if constexpr (SP2) {
        PG8_STAGE(PG8_SB(0, 0), cB, voffB); PG8_STAGE(PG8_SB(0, 1), cB + hstepB, voffB); PG8_STAGE(PG8_SA(0, 0), cA, voffA); PG8_STAGE(PG8_SA(0, 1), cA + hstepA, voffA);
        if (wr == 1) PG8_BAR;
        PG8_WAIT_V(2); PG8_BAR;
        PG8_STAGE(PG8_SB(1, 0), cB + kstep, voffB); PG8_STAGE(PG8_SA(1, 0), cA + kstep, voffA); PG8_STAGE(PG8_SB(1, 1), cB + hstepB + kstep, voffB);
        PG8_WAIT_V(6); PG8_BAR;
    } else {
        PG8_STAGE(PG8_SB(0, 0), cB, voffB); PG8_STAGE(PG8_SA(0, 0), cA, voffA); PG8_STAGE(PG8_SB(0, 1), cB + hstepB, voffB); PG8_STAGE(PG8_SA(0, 1), cA + hstepA, voffA);
        if (wr == 1) PG8_BAR;
        PG8_WAIT_V(4); PG8_BAR;
        PG8_STAGE(PG8_SB(1, 0), cB + kstep, voffB); PG8_STAGE(PG8_SA(1, 0), cA + kstep, voffA); PG8_STAGE(PG8_SB(1, 1), cB + hstepB + kstep, voffB);
        PG8_WAIT_V(6); PG8_BAR;
    }
    for (;;) {
        const bool has_next = S.next(ui + 1, nxt);
        const char* nA = has_next ? (const char*)g.A + (size_t)nxt.pm * tstepA + (size_t)nxt.pn * g.apn : cA; const char* nB = has_next ? (const char*)g.Bt + (size_t)nxt.pn * tstepB : cB;
        for (int t = 0; t < nt; t += 2) {
            const bool last = (t == nt - 2);
            const char* a1 = cA + (size_t)(t + 1) * kstep;
            const char* a2 = last ? nA : cA + (size_t)(t + 2) * kstep; const char* b2 = last ? nB : cB + (size_t)(t + 2) * kstep;
            const char* a3 = a2 + kstep; const char* b3 = b2 + kstep;
            if (last && has_next) S.a_ready(nxt);
            if constexpr (SP2) {
            PG8_LDB(B0, 0, 0); PG8_LDB(B1, 0, 1); PG8_SCHED; PG8_LDA(At, 0, 0); PG8_STAGE(PG8_SA(1, 1), a1 + hstepA, voffA);
            PG8_WAIT_V(8); PG8_WAIT_L(0); PG8_BAR; PG8_MMA(0, 0, At, B0); PG8_MMA(0, 1, At, B1); PG8_BAR; PG8_SCHED;
            PG8_LDA(At, 0, 1); PG8_STAGE(PG8_SB(0, 0), b2, voffB); PG8_STAGE(PG8_SB(0, 1), b2 + hstepB, voffB); PG8_STAGE(PG8_SA(0, 0), a2, voffA);
            PG8_WAIT_V(8); PG8_WAIT_L(0); PG8_BAR; PG8_MMA(1, 0, At, B0); PG8_MMA(1, 1, At, B1); PG8_BAR; PG8_SCHED;
            PG8_LDB(B0, 1, 0); PG8_LDB(B1, 1, 1); PG8_SCHED; PG8_LDA(At, 1, 0); PG8_STAGE(PG8_SA(0, 1), a2 + hstepA, voffA);
            PG8_WAIT_V(8); PG8_WAIT_L(0); PG8_BAR; PG8_MMA(0, 0, At, B0); PG8_MMA(0, 1, At, B1); PG8_BAR; PG8_SCHED;
            PG8_LDA(At, 1, 1); PG8_STAGE(PG8_SB(1, 0), b3, voffB); PG8_STAGE(PG8_SB(1, 1), b3 + hstepB, voffB); PG8_STAGE(PG8_SA(1, 0), a3, voffA);
            PG8_WAIT_V(8); PG8_WAIT_L(0); PG8_BAR; PG8_MMA(1, 0, At, B0); PG8_MMA(1, 1, At, B1); PG8_BAR; PG8_SCHED;
            } else {
            PG8_LDB(B0, 0, 0); PG8_SCHED; PG8_LDA(At, 0, 0); PG8_STAGE(PG8_SA(1, 1), a1 + hstepA, voffA);
            PG8_WAIT_L(8); PG8_BAR; PG8_WAIT_L(0); PG8_MMA(0, 0, At, B0); PG8_BAR; PG8_SCHED;
            PG8_LDB(B1, 0, 1); PG8_STAGE(PG8_SB(0, 0), b2, voffB);
            PG8_BAR; PG8_WAIT_L(0); PG8_MMA(0, 1, At, B1); PG8_BAR;
            PG8_LDA(At, 0, 1); PG8_STAGE(PG8_SA(0, 0), a2, voffA);
            PG8_BAR; PG8_WAIT_L(0); PG8_MMA(1, 0, At, B0); PG8_BAR; PG8_SCHED;
            PG8_STAGE(PG8_SB(0, 1), b2 + hstepB, voffB);
            PG8_WAIT_V(6); PG8_BAR; PG8_MMA(1, 1, At, B1); PG8_BAR;
            PG8_LDB(B0, 1, 0); PG8_SCHED; PG8_LDA(At, 1, 0); PG8_STAGE(PG8_SA(0, 1), a2 + hstepA, voffA);
            PG8_WAIT_L(8); PG8_BAR; PG8_WAIT_L(0); PG8_MMA(0, 0, At, B0); PG8_BAR; PG8_SCHED;
            PG8_LDB(B1, 1, 1); PG8_STAGE(PG8_SB(1, 0), b3, voffB);
            PG8_BAR; PG8_WAIT_L(0); PG8_MMA(0, 1, At, B1); PG8_BAR;
            PG8_LDA(At, 1, 1); PG8_STAGE(PG8_SA(1, 0), a3, voffA);
            PG8_BAR; PG8_WAIT_L(0); PG8_MMA(1, 0, At, B0); PG8_BAR; PG8_SCHED;
            PG8_STAGE(PG8_SB(1, 1), b3 + hstepB, voffB);
            PG8_WAIT_V(6); PG8_BAR; PG8_MMA(1, 1, At, B1); PG8_BAR;
            }
        }
        if constexpr (F8 || F4) {
#pragma unroll
            for (int a_ = 0; a_ < 2; ++a_) asm volatile("s_nop 15\n\ts_nop 7" : "+v"(acc[a_][0][0][0]), "+v"(acc[a_][0][0][1]), "+v"(acc[a_][0][1][0]), "+v"(acc[a_][0][1][1]), "+v"(acc[a_][0][2][0]), "+v"(acc[a_][0][2][1]), "+v"(acc[a_][0][3][0]), "+v"(acc[a_][0][3][1]),
                "+v"(acc[a_][1][0][0]), "+v"(acc[a_][1][0][1]), "+v"(acc[a_][1][1][0]), "+v"(acc[a_][1][1][1]), "+v"(acc[a_][1][2][0]), "+v"(acc[a_][1][2][1]), "+v"(acc[a_][1][3][0]), "+v"(acc[a_][1][3][1]));
        }
        if constexpr (ALIGN_EPI) { if (wr == 0) PG8_BAR; }
        if constexpr (!Epi::AFTER_DRAIN) { E(acc, cur, wr, wc, fr, fq); S.done(cur); }
        if (!has_next) break;
#pragma unroll
        for (int a = 0; a < 2; ++a)
#pragma unroll
            for (int b = 0; b < 2; ++b)
#pragma unroll
                for (int m = 0; m < 4; ++m)
#pragma unroll
                    for (int n = 0; n < 2; ++n) acc[a][b][m][n] = (f32x4){0.f, 0.f, 0.f, 0.f};
        cur = nxt; cA = nA; cB = nB; ++ui;
        if constexpr (ALIGN_EPI) { if (wr == 1) PG8_BAR; }
    }
    PG8_WAIT_V(0);
    if constexpr (!ALIGN_EPI) { if (wr == 0) PG8_BAR; }
    PG8_BAR;
    if constexpr (Epi::AFTER_DRAIN) { E.fused(acc, cur, wr, wc, fr, fq, lds, wid, lane); S.done(cur); }
#undef PG8_SA
#undef PG8_SB
#undef PG8_STAGE
#undef PG8_LDA
#undef PG8_LDB
#undef PG8_MMA
#undef PG8_WAIT_V
#undef PG8_WAIT_L
#undef PG8_BAR
#undef PG8_SCHED
}
}

constexpr int S = 16384, DM = 2048, NL = 2, NWAVES = 8;
constexpr int HW = 3584;
constexpr int H_AQ = 0, H_AK = 512, H_BQ = 1024, H_BK = 1536, H_CQ = 1664, H_CK = 2176, H_DCQ = 2688, H_DCKV = 3200, H_DKR = 3456;
constexpr int VT_A = 0, VT_B = 512, VT_C = 640, VT_ROWS = 1280;
constexpr int WIN_ROWS = HW + VT_ROWS;
constexpr float LOG2E = 1.4426950408889634f;
constexpr float DN_ALPHA = 1.4142135623730951f;
constexpr size_t MiB = 1u << 20;
constexpr size_t WS_CTL = 0, CTL_ZERO_BYTES = 1 * MiB;
constexpr size_t WS_W = 1 * MiB, WL_STRIDE = 78 * MiB;
constexpr size_t W_IN = 0, W_G = 19 * MiB, W_BR = 51 * MiB, W_O = 59 * MiB, W_UQ = 67 * MiB, W_UKV = 68 * MiB, W_PQ = 69 * MiB, W_SK = 77 * MiB;
constexpr size_t WS_UB = 157 * MiB, WS_VB = 221 * MiB;
constexpr size_t WS_MLIST = 189 * MiB;
constexpr int MCAP_F = 16384, MCAP = MCAP_F + 4096;
constexpr size_t WS_PART = 926 * MiB;
constexpr size_t WS_CS = 245 * MiB;
constexpr size_t WS_XB8 = 253 * MiB;
constexpr size_t WS_XB = 285 * MiB;
constexpr size_t WS_H = 349 * MiB;
constexpr size_t WS_VT = 461 * MiB;
constexpr size_t WS_GT = 501 * MiB;
constexpr size_t WS_O8 = 629 * MiB;
constexpr size_t WS_XB4 = 661 * MiB;
constexpr size_t WS_O = 757 * MiB;
constexpr size_t WS_QD = 821 * MiB, WS_KD = 845 * MiB, WS_VDT = 869 * MiB, WS_CQN = 885 * MiB, WS_CKVN = 901 * MiB;
constexpr size_t WS_SELE = 909 * MiB, WS_SELG = 917 * MiB, WS_KMEAN = 925 * MiB, WS_TPMAX = 925 * MiB + 512 * 1024, WS_OC2 = 994 * MiB, WS_END = 1010 * MiB;
constexpr int CW_BAR = 4096, CW_Q = 16384, CW_CHK = 20480, CW_MOBA = 24576;
constexpr int RING_BYTES = 131072;
constexpr int MISC_OFF = RING_BYTES;
constexpr int TR_OFF = 0;
constexpr int LDS_BYTES = 147456;

constexpr float U_SCALE = 90.0f, V_SCALE = 4.0f;
#define XB_TMO      128
#define XB_XCNT(j)  (256  + 64 * (j))
#define XB_XSUB(j)  (1280 + 64 * (j))
#define XB_XGEN(j)  (2304 + 64 * (j))
#define XB_TOP      3328
#define XB_TOPGEN   3392
#define XCD_BAR_WORDS 3456
#define XB_SPIN_CAP (1u << 18)

__device__ __forceinline__ unsigned xb_ld(unsigned* p)              { return __hip_atomic_load(p, __ATOMIC_RELAXED, __HIP_MEMORY_SCOPE_AGENT); }
__device__ __forceinline__ unsigned xb_add(unsigned* p, unsigned v) { return __hip_atomic_fetch_add(p, v, __ATOMIC_RELAXED, __HIP_MEMORY_SCOPE_AGENT); }
__device__ __forceinline__ unsigned xb_xcc_id() { return (unsigned)__builtin_amdgcn_s_getreg((3 << 11) | 20) & 0xFu; }
#define XB_SPIN(cond, bar) do { unsigned _sp = 0; while (cond) { __builtin_amdgcn_s_sleep(1); \
    if ((++_sp & 255u) == 0u) { if (xb_ld(&(bar)[XB_TMO])) break; if (_sp > XB_SPIN_CAP) { atomicAdd(&(bar)[XB_TMO], 1u); break; } } } } while (0)

struct XcdBarrier {
    unsigned* bar; unsigned x;
    volatile LAS unsigned* st;
};

__device__ __forceinline__ XcdBarrier xcd_barrier_post(unsigned* bar, volatile LAS unsigned* st) {
    XcdBarrier b; b.bar = bar; b.x = xb_xcc_id(); b.st = st;
    if (threadIdx.x == 0) (void)xb_add(&bar[XB_XCNT(b.x)], 1u);
    return b;
}
__device__ __forceinline__ void xcd_barrier_complete(unsigned* bar, unsigned x, unsigned& nloc, unsigned& nx) {
    const unsigned G = gridDim.x * gridDim.y * gridDim.z;
    unsigned sum, cnt, mine, sp = 0u;
    for (;;) {
        sum = 0u; cnt = 0u; mine = 0u;
#pragma unroll
        for (unsigned j = 0; j < 16; ++j) { const unsigned c = xb_ld(&bar[XB_XCNT(j)]); sum += c; cnt += (c > 0u) ? 1u : 0u; mine = (j == x) ? c : mine; }
        if (sum == G) break;
        __builtin_amdgcn_s_sleep(1);
        if ((++sp & 255u) == 0u) { if (xb_ld(&bar[XB_TMO])) break; if (sp > XB_SPIN_CAP) { atomicAdd(&bar[XB_TMO], 1u); break; } }
    }
    nloc = mine > 0u ? mine : 1u; nx = cnt > 0u ? cnt : 1u;
}

__device__ __forceinline__ void xcd_barrier(const XcdBarrier& b) {
    asm volatile("s_waitcnt vmcnt(0)" ::: "memory");
    __syncthreads();
    if (threadIdx.x == 0) {
        unsigned* bar = b.bar;
        __builtin_amdgcn_s_waitcnt(0);
        unsigned nloc = b.st[0], nx = b.st[1];
        if (nloc == 0u) { xcd_barrier_complete(bar, b.x, nloc, nx); b.st[0] = nloc; b.st[1] = nx; }
        const unsigned old = xb_add(&bar[XB_XSUB(b.x)], 1u);
        const unsigned gen = old / nloc;
        if (old + 1u == (gen + 1u) * nloc) {
            __builtin_amdgcn_fence(__ATOMIC_RELEASE, "agent");
            asm volatile("s_waitcnt vmcnt(0)" ::: "memory");
            const unsigned og = xb_add(&bar[XB_TOP], 1u);
            const unsigned tg = og / nx;
            if (og + 1u == (tg + 1u) * nx) xb_add(&bar[XB_TOPGEN], 1u);
            else XB_SPIN(xb_ld(&bar[XB_TOPGEN]) == tg, bar);
            __builtin_amdgcn_fence(__ATOMIC_ACQUIRE, "agent");
            xb_add(&bar[XB_XGEN(b.x)], 1u);
            asm volatile("s_waitcnt vmcnt(0)" ::: "memory");
        } else {
            XB_SPIN(xb_ld(&bar[XB_XGEN(b.x)]) == gen, bar);
            __builtin_amdgcn_fence(__ATOMIC_ACQUIRE, "agent");
            asm volatile("s_waitcnt vmcnt(0)" ::: "memory");
        }
    }
    __syncthreads();
}

struct Args { const float* in[26]; float* out; unsigned char* ws; int ph_lo, ph_hi; };
struct Frame {
    LAS unsigned char* lds; volatile LAS unsigned* MISC;
    int tid, lane, wave, vcu, G;
    unsigned char* ws; float* out;
};
DI bf16_t* wsb(const Frame& F, size_t off) { return (bf16_t*)(F.ws + off); }

DI void transpose_item(const float* W, int ldw, bf16_t* WT, int ldt, int k0, int n0, int drow0, LAS float* scr, int lane) {
#pragma unroll 8
    for (int i = 0; i < 32; ++i) { const int kk = 2 * i + (lane >> 5); scr[kk * 33 + (lane & 31)] = W[(size_t)(k0 + kk) * ldw + n0 + (lane & 31)]; }
    asm volatile("s_waitcnt lgkmcnt(0)" ::: "memory");
    const int c = lane & 7;
#pragma unroll
    for (int j = 0; j < 4; ++j) { const int n = (lane >> 3) + 8 * j; const LAS float* s = scr + (8 * c) * 33 + n;
        u32x4 o; o.x = cvtpk(s[0 * 33], s[1 * 33]); o.y = cvtpk(s[2 * 33], s[3 * 33]); o.z = cvtpk(s[4 * 33], s[5 * 33]); o.w = cvtpk(s[6 * 33], s[7 * 33]);
        *(u32x4*)(WT + (size_t)(drow0 + n) * ldt + k0 + 8 * c) = o; }
    asm volatile("s_waitcnt lgkmcnt(0)" ::: "memory");
}
DI void transpose_item8(const float* W, int ldw, unsigned char* WT, int ldt, int k0, int n0, int drow0, LAS float* scr, int lane, float scale) {
#pragma unroll 8
    for (int i = 0; i < 32; ++i) { const int kk = 2 * i + (lane >> 5); scr[kk * 33 + (lane & 31)] = W[(size_t)(k0 + kk) * ldw + n0 + (lane & 31)]; }
    asm volatile("s_waitcnt lgkmcnt(0)" ::: "memory");
    const int c = lane & 7;
#pragma unroll
    for (int j = 0; j < 4; ++j) { const int n = (lane >> 3) + 8 * j; const LAS float* s = scr + (8 * c) * 33 + n;
        int lo = __builtin_amdgcn_cvt_pk_fp8_f32(s[0 * 33] * scale, s[1 * 33] * scale, 0, false); lo = __builtin_amdgcn_cvt_pk_fp8_f32(s[2 * 33] * scale, s[3 * 33] * scale, lo, true);
        int hi = __builtin_amdgcn_cvt_pk_fp8_f32(s[4 * 33] * scale, s[5 * 33] * scale, 0, false); hi = __builtin_amdgcn_cvt_pk_fp8_f32(s[6 * 33] * scale, s[7 * 33] * scale, hi, true);
        *(u32x2*)(WT + (size_t)(drow0 + n) * ldt + k0 + 8 * c) = (u32x2){(unsigned)lo, (unsigned)hi}; }
    asm volatile("s_waitcnt lgkmcnt(0)" ::: "memory");
}
DI void transpose_item4(const float* W, int ldw, unsigned char* WT, int ldt, int k0, int n0, int drow0, LAS float* scr, int lane, float scale) {
#pragma unroll 8
    for (int i = 0; i < 32; ++i) { const int kk = 2 * i + (lane >> 5); scr[kk * 33 + (lane & 31)] = W[(size_t)(k0 + kk) * ldw + n0 + (lane & 31)]; }
    asm volatile("s_waitcnt lgkmcnt(0)" ::: "memory");
    const int c = lane & 7;
#pragma unroll
    for (int j = 0; j < 4; ++j) { const int n = (lane >> 3) + 8 * j; const LAS float* s = scr + (8 * c) * 33 + n;
        unsigned d = 0u;
        d = __builtin_amdgcn_cvt_scalef32_pk_fp4_f32(d, s[0 * 33] * scale, s[1 * 33] * scale, 1.0f, 0); d = __builtin_amdgcn_cvt_scalef32_pk_fp4_f32(d, s[2 * 33] * scale, s[3 * 33] * scale, 1.0f, 1);
        d = __builtin_amdgcn_cvt_scalef32_pk_fp4_f32(d, s[4 * 33] * scale, s[5 * 33] * scale, 1.0f, 2); d = __builtin_amdgcn_cvt_scalef32_pk_fp4_f32(d, s[6 * 33] * scale, s[7 * 33] * scale, 1.0f, 3);
        *(unsigned*)(WT + (size_t)(drow0 + n) * ldt + (k0 >> 1) + 4 * c) = d; }
    asm volatile("s_waitcnt lgkmcnt(0)" ::: "memory");
}
DI int win_map(int c) {
    if (c < 1024) return c;
    if (c < 1536) return HW + VT_A + (c - 1024);
    if (c < 2176) return H_BQ + (c - 1536);
    if (c < 2304) return HW + VT_B + (c - 2176);
    if (c < 3328) return H_CQ + (c - 2304);
    if (c < 3840) return HW + VT_C + (c - 3328);
    return H_DCQ + (c - 3840);
}
template <int MAP, bool F8 = false, bool F4 = false> DI void transpose_matrix(const Frame& F, const float* W, int K, int N, bf16_t* WT, int roff) {
    LAS float* scr = (LAS float*)(F.lds + TR_OFF + F.wave * 8704);
    const int gw = F.vcu * NWAVES + F.wave, NGW = F.G * NWAVES, nblk = N / 32, items = (K / 64) * nblk;
    int lane = F.lane; asm volatile("" : "+v"(lane));
    for (int it = gw; it < items; it += NGW) {
        const int kb = it / nblk, nb = it % nblk, n0 = 32 * nb;
        int drow = roff + n0;
        if (MAP == 1) drow = win_map(n0);
        if (MAP == 2) { const int h = n0 >> 8, j = n0 & 255; drow = (j < 128) ? h * 128 + j : 512 + h * 128 + (j - 128); }
        if (F4) transpose_item4(W, N, (unsigned char*)WT, K / 2, 64 * kb, n0, drow, scr, lane, 64.0f); else if (F8) transpose_item8(W, N, (unsigned char*)WT, K, 64 * kb, n0, drow, scr, lane, 64.0f); else transpose_item(W, N, WT, K, 64 * kb, n0, drow, scr, lane);
    }
}
DI void convert_bf16(const Frame& F, const float* src, bf16_t* dst, size_t n) {
    const size_t nth = (size_t)F.G * 512, t0 = (size_t)F.vcu * 512 + F.tid;
    for (size_t i = t0; i < n / 8; i += nth) { const f32x4 a = *(const f32x4*)(src + 8 * i), b = *(const f32x4*)(src + 8 * i + 4);
        u32x4 w; w.x = cvtpk(a[0], a[1]); w.y = cvtpk(a[2], a[3]); w.z = cvtpk(b[0], b[1]); w.w = cvtpk(b[2], b[3]); *(u32x4*)(dst + 8 * i) = w; }
}

typedef float v16f __attribute__((ext_vector_type(16)));
typedef float v32f __attribute__((ext_vector_type(32)));
typedef unsigned v6u __attribute__((ext_vector_type(6)));
DI void convert_fp6(const Frame& F, const float* src, unsigned char* dst, int rows, float scale) {
    const size_t nth = (size_t)F.G * 512, t0 = (size_t)F.vcu * 512 + F.tid;
    for (size_t i = t0; i < (size_t)rows * 64; i += nth) {
        const size_t row = i >> 6; const int l = (int)(i & 63);
        const float* p = src + row * 2048 + 32 * l;
        v16f a, b;
#pragma unroll
        for (int q = 0; q < 8; ++q) { const f32x4 x = *(const f32x4*)(p + 4 * q) * scale;
            a[2 * q] = x[0]; b[2 * q] = x[1]; a[2 * q + 1] = x[2]; b[2 * q + 1] = x[3]; }
        const v6u w = __builtin_amdgcn_cvt_scalef32_2xpk16_fp6_f32(a, b, 1.0f);
        *(u32x4*)(dst + row * 1536 + 16 * l) = (u32x4){w[0], w[1], w[2], w[3]};
        *(u32x2*)(dst + row * 1536 + 1024 + 8 * l) = (u32x2){w[4], w[5]};
    }
}

DI void convert_fp4(const Frame& F, const float* src, unsigned char* dst, int rows, float scale) {
    const size_t nth = (size_t)F.G * 512, t0 = (size_t)F.vcu * 512 + F.tid;
    for (size_t i = t0; i < (size_t)rows * 64; i += nth) {
        const float* p = src + i * 32;
        u32x4 w = (u32x4){0u, 0u, 0u, 0u};
#define FP4_PK(q) { const f32x4 x = *(const f32x4*)(p + 4 * (q)) * scale; unsigned d = w[(q) >> 1];         \
            d = __builtin_amdgcn_cvt_scalef32_pk_fp4_f32(d, x[0], x[1], 1.0f, (2 * (q)) & 3); d = __builtin_amdgcn_cvt_scalef32_pk_fp4_f32(d, x[2], x[3], 1.0f, (2 * (q) + 1) & 3); w[(q) >> 1] = d; }
        FP4_PK(0) FP4_PK(1) FP4_PK(2) FP4_PK(3) FP4_PK(4) FP4_PK(5) FP4_PK(6) FP4_PK(7)
#undef FP4_PK
        *(u32x4*)(dst + i * 16) = w;
    }
}

DI void convert_weights(const Frame& F, const Args& a, int l_lo, int l_hi) {
    for (int l = l_lo; l < l_hi; ++l) {
        unsigned char* wl = F.ws + WS_W + (size_t)l * WL_STRIDE;
        transpose_matrix<1, true>(F, a.in[3] + (size_t)l * DM * 4672, DM, 4672, (bf16_t*)(wl + W_IN), 0);
        for (int n = 0; n < 4; ++n) transpose_matrix<0, false, true>(F, a.in[4] + ((size_t)l * 4 + n) * DM * DM, DM, DM, (bf16_t*)(wl + W_G), n * DM);
        for (int n = 0; n < 4; ++n) transpose_matrix<0, true>(F, a.in[6] + ((size_t)l * 4 + n) * 512 * DM, 512, DM, (bf16_t*)(wl + W_BR) + (size_t)n * DM * 512, 0);
        transpose_matrix<0, true>(F, a.in[7] + (size_t)l * DM * DM, DM, DM, (bf16_t*)(wl + W_O), 0);
        transpose_matrix<0>(F, a.in[16] + (size_t)l * 512 * 768, 512, 768, (bf16_t*)(wl + W_UQ), 0);
        transpose_matrix<2>(F, a.in[17] + (size_t)l * 256 * 1024, 256, 1024, (bf16_t*)(wl + W_UKV), 0);
        transpose_matrix<0>(F, a.in[20] + (size_t)l * DM * DM, DM, DM, (bf16_t*)(wl + W_PQ), 0);
        convert_bf16(F, a.in[21] + (size_t)l * 8 * 2 * 128 * 128, (bf16_t*)(wl + W_SK), (size_t)8 * 2 * 128 * 128);
    }
}
DI void build_rope_table(const Frame& F, const Args& a) {
    f32x2* CS = (f32x2*)(F.ws + WS_CS); const int* pos = (const int*)a.in[1];
    for (size_t i = (size_t)F.vcu * 512 + F.tid; i < (size_t)S * 32; i += (size_t)F.G * 512) {
        const int j = (int)(i & 31); const float inv = exp2f(-(float)j * (13.287712379549449f / 32.0f));
        const float ang = (float)pos[i >> 5] * inv;
        CS[i] = (f32x2){cosf(ang), sinf(ang)};
    }
}
DI void phase_prologue(const Frame& F, const Args& a) {
    convert_weights(F, a, 0, 1);
    convert_bf16(F, a.in[0], wsb(F, WS_XB), (size_t)S * DM);
    {
        const size_t nth = (size_t)F.G * 512, t0 = (size_t)F.vcu * 512 + F.tid; const float* src = a.in[0]; unsigned char* dst = F.ws + WS_XB4;
        for (size_t i = t0; i < (size_t)S * DM / 8; i += nth) { const f32x4 x = *(const f32x4*)(src + 8 * i) * 2.0f, y = *(const f32x4*)(src + 8 * i + 4) * 2.0f;
            unsigned d = 0u; d = __builtin_amdgcn_cvt_scalef32_pk_fp4_f32(d, x[0], x[1], 1.0f, 0); d = __builtin_amdgcn_cvt_scalef32_pk_fp4_f32(d, x[2], x[3], 1.0f, 1); d = __builtin_amdgcn_cvt_scalef32_pk_fp4_f32(d, y[0], y[1], 1.0f, 2); d = __builtin_amdgcn_cvt_scalef32_pk_fp4_f32(d, y[2], y[3], 1.0f, 3);
            *(unsigned*)(dst + 4 * i) = d; }
    }
    {
        const size_t nth = (size_t)F.G * 512, t0 = (size_t)F.vcu * 512 + F.tid; const float* src = a.in[0]; unsigned char* dst = F.ws + WS_XB8;
        for (size_t i = t0; i < (size_t)S * DM / 8; i += nth) { const f32x4 x = *(const f32x4*)(src + 8 * i), y = *(const f32x4*)(src + 8 * i + 4);
            int lo = __builtin_amdgcn_cvt_pk_fp8_f32(x[0], x[1], 0, false); lo = __builtin_amdgcn_cvt_pk_fp8_f32(x[2], x[3], lo, true); int hi = __builtin_amdgcn_cvt_pk_fp8_f32(y[0], y[1], 0, false); hi = __builtin_amdgcn_cvt_pk_fp8_f32(y[2], y[3], hi, true);
            *(u32x2*)(dst + 8 * i) = (u32x2){(unsigned)lo, (unsigned)hi}; }
    }
    build_rope_table(F, a);
}

DI float rope64(float x, int lane, const f32x2* cs_row) {
    const float other = xhalf(x);
    const f32x2 cs = cs_row[lane & 31];
    return (lane < 32) ? x * cs.x - other * cs.y : other * cs.y + x * cs.x;
}
DI void phase_prep(const Frame& F, const Args& a, int layer) {
    const bf16_t* H = wsb(F, WS_H); bf16_t* CQN = wsb(F, WS_CQN); bf16_t* CKVN = wsb(F, WS_CKVN); bf16_t* KD = wsb(F, WS_KD);
    const float* gq = a.in[14] + layer * 512; const float* gkv = a.in[15] + layer * 256; const int* pos = (const int*)a.in[1];
    const int gw = F.vcu * NWAVES + F.wave, NGW = F.G * NWAVES, lane = F.lane;
    for (int t = gw; t < S; t += NGW) {
        const bf16_t* hr = H + (size_t)t * HW;
        const u32x4 q = *(const u32x4*)(hr + H_DCQ + 8 * lane);
        float v[8] = {bf_lo(q.x), bf_hi(q.x), bf_lo(q.y), bf_hi(q.y), bf_lo(q.z), bf_hi(q.z), bf_lo(q.w), bf_hi(q.w)};
        float ss = 0.f;
#pragma unroll
        for (int e = 0; e < 8; ++e) ss += v[e] * v[e];
        const float rq = rsqrtf(wave_sum(ss) * (1.0f / 512.0f) + 1e-6f);
        const f32x4 g0 = *(const f32x4*)(gq + 8 * lane), g1 = *(const f32x4*)(gq + 8 * lane + 4);
        u32x4 w; w.x = cvtpk(v[0] * rq * g0[0], v[1] * rq * g0[1]); w.y = cvtpk(v[2] * rq * g0[2], v[3] * rq * g0[3]); w.z = cvtpk(v[4] * rq * g1[0], v[5] * rq * g1[1]); w.w = cvtpk(v[6] * rq * g1[2], v[7] * rq * g1[3]);
        *(u32x4*)(CQN + (size_t)t * 512 + 8 * lane) = w;
        const u32x2 k2 = *(const u32x2*)(hr + H_DCKV + 4 * lane);
        const float u0 = bf_lo(k2.x), u1 = bf_hi(k2.x), u2 = bf_lo(k2.y), u3 = bf_hi(k2.y);
        const float rk = rsqrtf(wave_sum(u0 * u0 + u1 * u1 + u2 * u2 + u3 * u3) * (1.0f / 256.0f) + 1e-6f);
        const f32x4 gk = *(const f32x4*)(gkv + 4 * lane);
        u32x2 w2; w2.x = cvtpk(u0 * rk * gk[0], u1 * rk * gk[1]); w2.y = cvtpk(u2 * rk * gk[2], u3 * rk * gk[3]);
        *(u32x2*)(CKVN + (size_t)t * 256 + 4 * lane) = w2;
        const float kr = bf1(hr[H_DKR + lane]);
        const float ro = rope64(kr, lane, (const f32x2*)(F.ws + WS_CS) + (size_t)t * 32);
        const bf16_t rb = (bf16_t)(cvtpk(ro, 0.f) & 0xffffu);
#pragma unroll
        for (int h = 0; h < 4; ++h) KD[(size_t)t * 768 + h * 192 + 128 + lane] = rb;
    }
    for (int t = gw; t < S / 64; t += NGW) { int pm = pos[t * 64 + lane];
#pragma unroll
        for (int o = 1; o < 64; o <<= 1) { const int other = __shfl_xor(pm, o); pm = other > pm ? other : pm; }
        if (lane == 0) ((int*)(F.ws + WS_TPMAX))[t] = pm; }
    float* KM = (float*)(F.ws + WS_KMEAN);
    for (int it = gw; it < 64 * 8; it += NGW) {
        const int n = it >> 3, cc = it & 7; const bf16_t* p = H + (size_t)(n * 256) * HW + H_AK + cc * 64 + lane;
        float s0 = 0.f, s1 = 0.f, s2 = 0.f, s3 = 0.f;
        for (int r = 0; r < 256; r += 4) { s0 += bf1(p[(size_t)r * HW]); s1 += bf1(p[(size_t)(r + 1) * HW]); s2 += bf1(p[(size_t)(r + 2) * HW]); s3 += bf1(p[(size_t)(r + 3) * HW]); }
        KM[n * 512 + cc * 64 + lane] = ((s0 + s1) + (s2 + s3)) * (1.0f / 256.0f);
    }
}
DI void phase_ropeq(const Frame& F, const Args& a) {
    bf16_t* QD = wsb(F, WS_QD); const int* pos = (const int*)a.in[1];
    const int gw = F.vcu * NWAVES + F.wave, NGW = F.G * NWAVES, lane = F.lane;
    for (int t = gw; t < S; t += NGW) {
        const f32x2* cs = (const f32x2*)(F.ws + WS_CS) + (size_t)t * 32;
#pragma unroll
        for (int h = 0; h < 4; ++h) { bf16_t* p = QD + (size_t)t * 768 + h * 192 + 128 + lane; const float ro = rope64(bf1(*p), lane, cs); *p = (bf16_t)(cvtpk(ro, 0.f) & 0xffffu); }
    }
}
DI void phase_moba_select(const Frame& F, const Args& a, int layer) {
    const bf16_t* H = wsb(F, WS_H); const float* KM = (const float*)(F.ws + WS_KMEAN); const int* pos = (const int*)a.in[1]; const int* TP = (const int*)(F.ws + WS_TPMAX);
    unsigned* cnt = (unsigned*)(F.ws + WS_CTL) + CW_MOBA + layer * 1024; int* lists = (int*)(F.ws + WS_MLIST);
    const int gw = F.vcu * NWAVES + F.wave, NGW = F.G * NWAVES;
    int lane = F.lane; asm volatile("" : "+v"(lane));
    const int r = lane & 31, hi = lane >> 5;
    for (int it = gw; it < (S / 32) * 4; it += NGW) {
        const int h = it & 3, q0 = (it >> 2) * 32, q = q0 + r, own = q0 >> 8;
        if (own == 0) continue;
        const bf16_t* qp = H + (size_t)q * HW + H_AQ + h * 128 + hi * 8;
        const bool two = own > 32;
        f32x16 g0, g1;
#pragma unroll
        for (int i = 0; i < 16; ++i) { g0[i] = 0.f; g1[i] = 0.f; }
#pragma unroll
        for (int kk = 0; kk < 8; ++kk) {
            const bf16x8 qf = *(const bf16x8*)(qp + kk * 16);
#pragma unroll
            for (int rb = 0; rb < 2; ++rb) {
                if (rb == 1 && !two) continue;
                const float* kp = KM + (size_t)(rb * 32 + r) * 512 + h * 128 + kk * 16 + hi * 8;
                const f32x4 x = *(const f32x4*)kp, y = *(const f32x4*)(kp + 4);
                u32x4 wh, wl;
                wh.x = cvtpk(x[0], x[1]); wh.y = cvtpk(x[2], x[3]); wh.z = cvtpk(y[0], y[1]); wh.w = cvtpk(y[2], y[3]);
                wl.x = cvtpk(x[0] - bf_lo(wh.x), x[1] - bf_hi(wh.x)); wl.y = cvtpk(x[2] - bf_lo(wh.y), x[3] - bf_hi(wh.y)); wl.z = cvtpk(y[0] - bf_lo(wh.z), y[1] - bf_hi(wh.z)); wl.w = cvtpk(y[2] - bf_lo(wh.w), y[3] - bf_hi(wh.w));
                if (rb == 0) { g0 = __builtin_amdgcn_mfma_f32_32x32x16_bf16(__builtin_bit_cast(bf16x8, wh), qf, g0, 0, 0, 0); g0 = __builtin_amdgcn_mfma_f32_32x32x16_bf16(__builtin_bit_cast(bf16x8, wl), qf, g0, 0, 0, 0); }
                else { g1 = __builtin_amdgcn_mfma_f32_32x32x16_bf16(__builtin_bit_cast(bf16x8, wh), qf, g1, 0, 0, 0); g1 = __builtin_amdgcn_mfma_f32_32x32x16_bf16(__builtin_bit_cast(bf16x8, wl), qf, g1, 0, 0, 0); }
            }
        }
        float v1 = -INFINITY, v2 = -INFINITY, v3 = -INFINITY; int i1 = -1, i2 = -1, i3 = -1;
#pragma unroll
        for (int rb = 0; rb < 2; ++rb)
#pragma unroll
            for (int i = 0; i < 16; ++i) {
                const int n = rb * 32 + (i & 3) + 8 * (i >> 2) + 4 * hi; const float g = (rb == 0) ? g0[i] : g1[i];
                if (n < own) {
                    if (g > v1) { v3 = v2; i3 = i2; v2 = v1; i2 = i1; v1 = g; i1 = n; }
                    else if (g > v2) { v3 = v2; i3 = i2; v2 = g; i2 = n; }
                    else if (g > v3) { v3 = g; i3 = n; }
                }
            }
        const float p1 = xhalf(v1), p2 = xhalf(v2), p3 = xhalf(v3);
        const int j1 = __shfl_xor(i1, 32), j2 = __shfl_xor(i2, 32), j3 = __shfl_xor(i3, 32);
#pragma unroll
        for (int c = 0; c < 3; ++c) { const float g = c == 0 ? p1 : (c == 1 ? p2 : p3); const int n = c == 0 ? j1 : (c == 1 ? j2 : j3);
            if (n >= 0) {
                if (g > v1 || (g == v1 && n < i1)) { v3 = v2; i3 = i2; v2 = v1; i2 = i1; v1 = g; i1 = n; }
                else if (g > v2 || (g == v2 && n < i2)) { v3 = v2; i3 = i2; v2 = g; i2 = n; }
                else if (g > v3 || (g == v3 && n < i3)) { v3 = g; i3 = n; }
            } }
        if (hi == 0) {
            const int pq = pos[q];
#pragma unroll
            for (int sl = 0; sl < 3; ++sl) { const int n = sl == 0 ? i1 : (sl == 1 ? i2 : i3);
                if (n >= 0) { const int bm = max(max(TP[4 * n], TP[4 * n + 1]), max(TP[4 * n + 2], TP[4 * n + 3])); const int near = (pq - bm < 790) ? 1 : 0;
                    const unsigned p = atomicAdd(cnt + near * 256 + h * 64 + n, 1u);
                    if (p < (unsigned)(near ? MCAP - MCAP_F : MCAP_F)) lists[(size_t)(h * 64 + n) * MCAP + (near ? MCAP_F : 0) + p] = q * 4 + sl; } }
        }
    }
}
DI void phase_mixer_combine(const Frame& F, const Args& a, int layer) {
    const unsigned char* PART = F.ws + WS_PART; bf16_t* OA = wsb(F, WS_O);
    const int gw = F.vcu * NWAVES + F.wave, NGW = F.G * NWAVES, lane = F.lane;
    for (size_t i = (size_t)F.vcu * 512 + F.tid; i < (size_t)2 * S * 64; i += (size_t)F.G * 512) {
        const size_t br = (i >= (size_t)S * 64) ? 3 : 1, e = (i - (br == 3 ? (size_t)S * 64 : 0)) * 8;
        const u32x4 w = *(const u32x4*)(wsb(F, WS_O) + br * S * 512 + e);
        int lo = __builtin_amdgcn_cvt_pk_fp8_f32(bf_lo(w.x) * 8.0f, bf_hi(w.x) * 8.0f, 0, false); lo = __builtin_amdgcn_cvt_pk_fp8_f32(bf_lo(w.y) * 8.0f, bf_hi(w.y) * 8.0f, lo, true);
        int hi = __builtin_amdgcn_cvt_pk_fp8_f32(bf_lo(w.z) * 8.0f, bf_hi(w.z) * 8.0f, 0, false); hi = __builtin_amdgcn_cvt_pk_fp8_f32(bf_lo(w.w) * 8.0f, bf_hi(w.w) * 8.0f, hi, true);
        *(u32x2*)(F.ws + WS_O8 + br * S * 512 + e) = (u32x2){(unsigned)lo, (unsigned)hi};
    }
    for (int it = gw; it < S * 4; it += NGW) {
        const int q = it >> 2, h = it & 3, nsel = (q >> 8) < 3 ? (q >> 8) : 3;
        const unsigned char* pp = PART + ((size_t)q * 16 + h * 4) * 272;
        float mm[4], ll[4]; unsigned ov[4];
#pragma unroll
        for (int s = 0; s < 4; ++s) { const bool use = (s == 3) || (s < nsel); const f32x2 ml = *(const f32x2*)(pp + s * 272 + 256); mm[s] = use ? ml.x : -1e30f; ll[s] = use ? ml.y : 0.f; ov[s] = *(const unsigned*)(pp + s * 272 + lane * 4); }
        const float M = fmaxf(fmaxf(mm[0], mm[1]), fmaxf(mm[2], mm[3]));
        float wsum = 0.f, x0 = 0.f, x1 = 0.f;
#pragma unroll
        for (int s = 0; s < 4; ++s) { const float w = ll[s] * ex2(mm[s] - M); wsum += w; x0 += w * bf_lo(ov[s]); x1 += w * bf_hi(ov[s]); }
        const float inv = 1.0f / wsum;
        *(unsigned*)(OA + (size_t)q * 512 + h * 128 + lane * 2) = cvtpk(x0 * inv, x1 * inv);
        *(unsigned short*)(F.ws + WS_O8 + (size_t)q * 512 + h * 128 + lane * 2) = (unsigned short)__builtin_amdgcn_cvt_pk_fp8_f32(x0 * inv * 8.0f, x1 * inv * 8.0f, 0, false);
    }
    float d1 = 0.f, d2 = 0.f;
    for (int i = 0; i < 64; ++i) { d1 += a.in[9][layer * 64 + i] * a.in[10][layer * 64 + i]; d2 += a.in[11][layer * 64 + i] * a.in[12][layer * 64 + i]; }
    const float lambda_init = 0.8f - 0.6f * expf(-0.3f * (float)layer), lam = expf(d1) - expf(d2) + lambda_init;
    bf16_t* OC = wsb(F, WS_O) + (size_t)2 * S * 512; const bf16_t* OC2 = wsb(F, WS_OC2);
    const f32x2 sg = *(const f32x2*)(a.in[13] + layer * 128 + lane * 2);
    for (int it = gw; it < S * 4; it += NGW) {
        const size_t off = (size_t)(it >> 2) * 512 + (it & 3) * 128 + lane * 2;
        const unsigned w1 = *(const unsigned*)(OC + off), w2 = *(const unsigned*)(OC2 + off);
        const float x0 = bf_lo(w1) - lam * bf_lo(w2), x1 = bf_hi(w1) - lam * bf_hi(w2);
        const float rn = rsqrtf(wave_sum(x0 * x0 + x1 * x1) * (1.0f / 128.0f) + 1e-6f) * (1.0f - lambda_init);
        *(unsigned*)(OC + off) = cvtpk(x0 * rn * sg.x, x1 * rn * sg.y);
        *(unsigned short*)(F.ws + WS_O8 + (size_t)2 * S * 512 + off) = (unsigned short)__builtin_amdgcn_cvt_pk_fp8_f32(x0 * rn * sg.x * 8.0f, x1 * rn * sg.y * 8.0f, 0, false);
    }
}
template <int NJ, int NE> DI void ln_store(float (&v)[NJ][NE], const float* g, const float* b, float* of, bf16_t* ob, int lane, unsigned char* o8 = nullptr, unsigned char* o4 = nullptr) {
    static_assert(NJ * NE == 32 && NE % 8 == 0, "row layout");
    float s = 0.f;
#pragma unroll
    for (int j = 0; j < NJ; ++j)
#pragma unroll
        for (int e = 0; e < NE; ++e) s += v[j][e];
    const float mean = wave_sum(s) * (1.0f / DM);
    float q = 0.f;
#pragma unroll
    for (int j = 0; j < NJ; ++j)
#pragma unroll
        for (int e = 0; e < NE; ++e) { v[j][e] -= mean; q += v[j][e] * v[j][e]; }
    const float rstd = rsqrtf(wave_sum(q) * (1.0f / DM) + 1e-5f);
#pragma unroll
    for (int j = 0; j < NJ; ++j)
#pragma unroll
        for (int e8 = 0; e8 < NE; e8 += 8) {
            const int c = (DM / NJ) * j + NE * lane + e8;
            const f32x4 g0 = *(const f32x4*)(g + c), g1 = *(const f32x4*)(g + c + 4), b0 = *(const f32x4*)(b + c), b1 = *(const f32x4*)(b + c + 4);
            f32x4 o0, o1;
#pragma unroll
            for (int e = 0; e < 4; ++e) { o0[e] = v[j][e8 + e] * rstd * g0[e] + b0[e]; o1[e] = v[j][e8 + 4 + e] * rstd * g1[e] + b1[e]; }
            if (of) { *(f32x4*)(of + c) = o0; *(f32x4*)(of + c + 4) = o1; }
            u32x4 w; w.x = cvtpk(o0[0], o0[1]); w.y = cvtpk(o0[2], o0[3]); w.z = cvtpk(o1[0], o1[1]); w.w = cvtpk(o1[2], o1[3]);
            *(u32x4*)(ob + c) = w;
            if (o8) { int lo = __builtin_amdgcn_cvt_pk_fp8_f32(o0[0], o0[1], 0, false); lo = __builtin_amdgcn_cvt_pk_fp8_f32(o0[2], o0[3], lo, true); int hi = __builtin_amdgcn_cvt_pk_fp8_f32(o1[0], o1[1], 0, false); hi = __builtin_amdgcn_cvt_pk_fp8_f32(o1[2], o1[3], hi, true);
                *(u32x2*)(o8 + c) = (u32x2){(unsigned)lo, (unsigned)hi}; }
            if (o4) { unsigned d = 0u; d = __builtin_amdgcn_cvt_scalef32_pk_fp4_f32(d, o0[0] * 2.0f, o0[1] * 2.0f, 1.0f, 0); d = __builtin_amdgcn_cvt_scalef32_pk_fp4_f32(d, o0[2] * 2.0f, o0[3] * 2.0f, 1.0f, 1);
                d = __builtin_amdgcn_cvt_scalef32_pk_fp4_f32(d, o1[0] * 2.0f, o1[1] * 2.0f, 1.0f, 2); d = __builtin_amdgcn_cvt_scalef32_pk_fp4_f32(d, o1[2] * 2.0f, o1[3] * 2.0f, 1.0f, 3); *(unsigned*)(o4 + (c >> 1)) = d; }
        }
}
DI void phase_ln1(const Frame& F, const Args& a, int layer) {
    const bf16_t* Y = wsb(F, WS_GT); bf16_t* XB = wsb(F, WS_XB);
    const int gw = F.vcu * NWAVES + F.wave, NGW = F.G * NWAVES, lane = F.lane;
    for (int t = gw; t < S; t += NGW) {
        float v[4][8];
#pragma unroll
        for (int j = 0; j < 4; ++j) { const u32x4 w = *(const u32x4*)(Y + (size_t)t * DM + 512 * j + 8 * lane);
            v[j][0] = bf_lo(w.x); v[j][1] = bf_hi(w.x); v[j][2] = bf_lo(w.y); v[j][3] = bf_hi(w.y); v[j][4] = bf_lo(w.z); v[j][5] = bf_hi(w.z); v[j][6] = bf_lo(w.w); v[j][7] = bf_hi(w.w); }
        ln_store<4, 8>(v, a.in[18] + layer * DM, a.in[19] + layer * DM, (float*)nullptr, XB + (size_t)t * DM, lane);
    }
}

namespace att {
constexpr int TBL = RING_BYTES - 4096;
constexpr int TPMO = TBL - 1024;
constexpr int KMO = 0;
constexpr float NEG = -1e30f;
enum { MIX_A = 0, MIX_B = 1, MIX_C = 2, MIX_D = 3 };

struct Ctx { int qi, pq, own; float c, cb; unsigned long long sel; };

DI int t5_bucket(int rel) {
    if (rel < 16) return rel;
    return 15 + (rel >= 16) + (rel >= 21) + (rel >= 27) + (rel >= 35) + (rel >= 46) + (rel >= 59) + (rel >= 77) + (rel >= 99) + (rel >= 128) + (rel >= 166) + (rel >= 216) + (rel >= 280) + (rel >= 363) + (rel >= 470) + (rel >= 609) + (rel >= 790);
}
DI void build_tbl(LAS unsigned char* lds, const float* t5, int col, const int* tpmax) {
    if (threadIdx.x < 256) *(LAS int*)(lds + TPMO + threadIdx.x * 4) = tpmax[threadIdx.x];
    for (int rel = threadIdx.x; rel < 1024; rel += 512) *(LAS float*)(lds + TBL + rel * 4) = t5[t5_bucket(rel) * 16 + col] * LOG2E;
}

#define ATT_SB() __builtin_amdgcn_sched_barrier(0)
#ifndef ATT_CONV_INTERLEAVE
#define ATT_CONV_INTERLEAVE 1
#endif
#ifndef ATT_CP_D
#define ATT_CP_D 0
#endif
#ifndef ATT_CP
#define ATT_CP 0
#endif
#ifndef ATT_X_LDS2
#define ATT_X_LDS2 0
#endif
#ifndef ATT_NOPRIO
#define ATT_NOPRIO 0
#endif
#if ATT_NOPRIO
#define ATT_PRIO(x) do { } while (0)
#else
#define ATT_PRIO(x) __builtin_amdgcn_s_setprio(x)
#endif
#if defined(ATT_X_NOSM)
#define ATT_SM(...) do { l_run = 1.0f; st0.resc = false; st1.resc = false; st0.alpha = 1.f; st1.alpha = 1.f; pf0[0] = qf[0]; pf0[1] = qf[1]; pf1[0] = qf[2]; pf1[1] = qf[3]; } while (0)
#else
#define ATT_SM(...) __VA_ARGS__
#endif
#ifndef ATT_PD
#define ATT_PD 4
#endif
DI float hmax32(float v) { auto rr = __builtin_amdgcn_permlane32_swap(__float_as_uint(v), __float_as_uint(v), false, false); return fmaxf(__uint_as_float(rr[0]), __uint_as_float(rr[1])); }
struct SmState { float mx, cc, dd, rs; bool resc; float alpha; };
template <int MIX, bool FAST, int W>
DI void sm_item(f32x16& s, SmState& st, float& m_run, float& l_run, bf16x8 (&pf)[2], const Ctx& cx, const LAS unsigned char* pkp, const LAS unsigned char* lds, int k0, int kmax, int kmin, int hi, bool lv) {
    constexpr bool BIAS = (MIX != MIX_D);
    if constexpr (W == 0 || W == 1) {
        constexpr int sg = W;
        if constexpr (FAST) {
            float a = fmaxf(fmaxf(s[sg * 8 + 0], s[sg * 8 + 1]), s[sg * 8 + 2]), b = fmaxf(fmaxf(s[sg * 8 + 3], s[sg * 8 + 4]), s[sg * 8 + 5]);
            a = fmaxf(fmaxf(a, s[sg * 8 + 6]), s[sg * 8 + 7]);
            st.mx = (W == 0) ? fmaxf(a, b) : fmaxf(st.mx, fmaxf(a, b));
            asm volatile("" : "+v"(st.mx));
        } else {
            i32x4 pk0 = (i32x4){0, 0, 0, 0}, pk1 = (i32x4){0, 0, 0, 0};
            if (BIAS) { const LAS i32x4* pp = (const LAS i32x4*)(pkp + (sg * 16 + hi * 8) * 4); pk0 = pp[0]; pk1 = pp[1]; }
            float mx = (W == 0) ? NEG : st.mx;
#pragma unroll
            for (int j = 0; j < 8; ++j) {
                const int i = sg * 8 + j, key = k0 + sg * 16 + hi * 8 + j;
                float tv = s[i] * cx.c;
                if (BIAS) { int rel = cx.pq - (j < 4 ? pk0[j & 3] : pk1[j & 3]); rel = rel < 0 ? 0 : (rel > 1023 ? 1023 : rel); tv += *(const LAS float*)(lds + TBL + rel * 4); }
                bool valid = key <= kmax;
                if (MIX == MIX_B) valid = valid && (key >= kmin);
                tv = valid ? tv : NEG;
                s[i] = tv; mx = fmaxf(mx, tv);
            }
            st.mx = mx;
        }
        if constexpr (W == 1) {
            float mx = hmax32(st.mx);
            if constexpr (FAST) mx = lv ? mx * cx.c + cx.cb : NEG;
            const bool need = mx > m_run + 8.0f;
            const float mn = need ? mx : m_run;
            st.alpha = ex2(m_run - mn); m_run = mn; l_run *= st.alpha;
            st.resc = (__ballot(need) != 0ull);
            st.cc = FAST ? (lv ? cx.c : 0.f) : 1.0f; st.dd = FAST ? (lv ? cx.cb - mn : NEG) : -mn; st.rs = 0.f;
            asm volatile("" : "+v"(st.alpha), "+v"(m_run), "+v"(l_run), "+v"(st.dd));
        }
    } else if constexpr (W >= 2 && W <= 5) {
        constexpr int e0 = (W - 2) * 4;
#pragma unroll
        for (int e = e0; e < e0 + 4; ++e) { float p = ex2(s[e] * st.cc + st.dd); asm volatile("" : "+v"(p)); s[e] = p; st.rs += p; }
        asm volatile("" : "+v"(st.rs));
        if constexpr (W == 5) l_run += st.rs;
    } else {
        constexpr int sg = W - 6;
        u32x4 w; w.x = cvtpk(s[sg * 8 + 0], s[sg * 8 + 1]); w.y = cvtpk(s[sg * 8 + 2], s[sg * 8 + 3]); w.z = cvtpk(s[sg * 8 + 4], s[sg * 8 + 5]); w.w = cvtpk(s[sg * 8 + 6], s[sg * 8 + 7]); asm volatile("" : "+v"(w)); pf[sg] = __builtin_bit_cast(bf16x8, w);
    }
}
template <int DQK, int DV, int MIX, bool FAST>
DI void tile_body(const LAS unsigned char* sb, const LAS unsigned char* lds, const bf16x8 (&qf)[DQK / 16], f32x16 (&o)[DV / 32], float& m_run, float& l_run, const Ctx& cx,
                  int k0, int kmax, int kmin, int pr, int xk, int xv, int r, int hi, bool lv) {
    constexpr int KCH = DQK / 8, NQ = DQK / 16, NP = DV / 16, KBUF = 64 * KCH * 16, VBUF = DV * 128;
    const LAS unsigned char* kb0 = sb + pr * (KCH * 16); const LAS unsigned char* kb1 = kb0 + 32 * (KCH * 16);
    const LAS unsigned char* vb = sb + KBUF + r * 128; const LAS unsigned char* pkp = sb + KBUF + VBUF;
    f32x16 s0, s1;
#pragma unroll
    for (int i = 0; i < 16; ++i) { s0[i] = 0.f; s1[i] = 0.f; }
    bf16x8 kf[NQ], kg[NQ], vf[2 * NP], pf0[2], pf1[2];
    SmState st0, st1;
#if defined(ATT_X_NOLDS)
#define ATT_KF(base, kk) (qf[(kk) % NQ])
#else
#define ATT_KF(base, kk) (*(const LAS bf16x8*)((base) + (((2 * (kk) + hi) ^ xk) << 4)))
#endif
#if defined(ATT_X_NOLDS)
#define ATT_VF(f) (qf[(f) % NQ])
#else
#define ATT_VF(f) (*(const LAS bf16x8*)(vb + (((f) % NP) >> 1) * 32 * 128 + (((((f) / NP) * 4 + ((f) & 1) * 2 + hi) ^ xv) << 4)))
#endif
#define ATT_PRE_K(W) do { _Pragma("unroll") for (int kk = ((W) * NQ) / 8; kk < (((W) + 1) * NQ) / 8; ++kk) { kg[kk] = ATT_KF(kb1, kk); if (ATT_X_LDS2) { bf16x8 dm_ = ATT_KF(kb1 + 16, kk); asm volatile("" :: "v"(dm_)); } } } while (0)
#define ATT_PRE_V(W) do { _Pragma("unroll") for (int f = ((W) * NP) / 8; f < (((W) + 1) * NP) / 8; ++f) { vf[f] = ATT_VF(f); if (ATT_X_LDS2) { bf16x8 dm_ = ATT_VF(f ^ 1); asm volatile("" :: "v"(dm_)); } } } while (0)
#pragma unroll
    for (int kk = 0; kk < NQ; ++kk) kf[kk] = ATT_KF(kb0, kk);
    ATT_SB();
#pragma unroll
    for (int kk = 0; kk < NQ; ++kk) s0 = __builtin_amdgcn_mfma_f32_32x32x16_bf16(kf[kk], qf[kk], s0, 0, 0, 0);
    ATT_PRE_K(0); ATT_PRE_K(1); if (ATT_PD > 2) ATT_PRE_K(2); if (ATT_PD > 3) ATT_PRE_K(3);
    ATT_SB();
#define ATT_STEP2(W) do { \
        ATT_PRIO(1); _Pragma("unroll") for (int kk = ((W) * NQ) / 8; kk < (((W) + 1) * NQ) / 8; ++kk) s1 = __builtin_amdgcn_mfma_f32_32x32x16_bf16(kg[kk], qf[kk], s1, 0, 0, 0); ATT_PRIO(0); \
        if ((W) + ATT_PD < 8) ATT_PRE_K((W) + ATT_PD); else ATT_PRE_V((W) + ATT_PD - 8); \
        ATT_SM(sm_item<MIX, FAST, W>(s0, st0, m_run, l_run, pf0, cx, pkp, lds, k0, kmax, kmin, hi, lv)); ATT_SB(); } while (0)
    ATT_STEP2(0); ATT_STEP2(1); ATT_STEP2(2); ATT_STEP2(3); ATT_STEP2(4); ATT_STEP2(5); ATT_STEP2(6); ATT_STEP2(7);
#undef ATT_STEP2
    if (st0.resc) {
#pragma unroll
        for (int d = 0; d < DV / 32; ++d)
#pragma unroll
            for (int i = 0; i < 16; ++i) o[d][i] *= st0.alpha;
    }
    ATT_SB();
#define ATT_STEP3(W) do { \
        ATT_PRIO(1); _Pragma("unroll") for (int f = ((W) * NP) / 8; f < (((W) + 1) * NP) / 8; ++f) o[f >> 1] = __builtin_amdgcn_mfma_f32_32x32x16_bf16(vf[f], pf0[f & 1], o[f >> 1], 0, 0, 0); ATT_PRIO(0); \
        ATT_PRE_V((W) + ATT_PD); \
        ATT_SM(sm_item<MIX, FAST, W>(s1, st1, m_run, l_run, pf1, cx, pkp + 128, lds, k0 + 32, kmax, kmin, hi, lv)); ATT_SB(); } while (0)
    ATT_STEP3(0); ATT_STEP3(1); ATT_STEP3(2); ATT_STEP3(3); ATT_STEP3(4); ATT_STEP3(5); ATT_STEP3(6); ATT_STEP3(7);
#undef ATT_STEP3
    if (st1.resc) {
#pragma unroll
        for (int d = 0; d < DV / 32; ++d)
#pragma unroll
            for (int i = 0; i < 16; ++i) o[d][i] *= st1.alpha;
    }
    ATT_SB();
#define ATT_STEP4(W) do { \
        _Pragma("unroll") for (int f = ((W) * NP) / 8; f < (((W) + 1) * NP) / 8; ++f) o[(f - NP) >> 1] = __builtin_amdgcn_mfma_f32_32x32x16_bf16(vf[f], pf1[f & 1], o[(f - NP) >> 1], 0, 0, 0); \
        if ((W) + ATT_PD < 16) ATT_PRE_V((W) + ATT_PD); ATT_SB(); } while (0)
    ATT_STEP4(8); ATT_STEP4(9); ATT_STEP4(10); ATT_STEP4(11); ATT_STEP4(12); ATT_STEP4(13); ATT_STEP4(14); ATT_STEP4(15);
#undef ATT_STEP4
#undef ATT_KF
#undef ATT_VF
#undef ATT_PRE_K
#undef ATT_PRE_V
}
template <int DQK, int DV, int MIX>
DI void flash_pass(LAS unsigned char* lds, const bf16x8 (&qf)[DQK / 16], const bf16_t* __restrict__ Kg, int ldk, const bf16_t* __restrict__ VTg, int ldvt,
                   const int* __restrict__ pos, int t0, int t1, int q0, int qpmin, const Ctx& cx, f32x16 (&o)[DV / 32], float& m_run, float& l_run, int ts_force = -1) {
    constexpr int KCH = DQK / 8, NKL = KCH / 8, NVL = DV / 64;
    constexpr bool BIAS = (MIX != MIX_D);
    constexpr int KBUF = 64 * KCH * 16, VBUF = DV * 128, PBUF = BIAS ? 2048 : 0, SLOT = KBUF + VBUF + PBUF, NV = NKL + NVL + (BIAS ? 1 : 0);
    static_assert(3 * SLOT <= TPMO, "attention ring");
    static_assert(DQK % 128 == 0 || DQK == 64 || DQK == 192, "QK MFMAs per softmax work item");
    int tid = threadIdx.x; asm volatile("" : "+v"(tid));
    const int lane = tid & 63, r = lane & 31, hi = lane >> 5, wave = __builtin_amdgcn_readfirstlane(tid >> 6);
    const int pr = (r & 0x13) | ((r & 4) << 1) | ((r & 8) >> 1);
    const int xk = (KCH == 16) ? (((pr & 1) << 3) | ((pr >> 1) & 7)) : ((pr >> 1) & 7);
    const int xv = (r >> 1) & 7;
    unsigned koff[NKL], voff[NVL];
#pragma unroll
    for (int i = 0; i < NKL; ++i) { const int p = (i * 8 + wave) * 64 + lane, row = p / KCH, cs = p % KCH; const int x = (KCH == 16) ? (((row & 1) << 3) | ((row >> 1) & 7)) : ((row >> 1) & 7); koff[i] = (unsigned)(row * ldk + (cs ^ x) * 8) * 2u; }
#pragma unroll
    for (int i = 0; i < NVL; ++i) { const int p = (i * 8 + wave) * 64 + lane, row = p >> 3, cs = p & 7; voff[i] = (unsigned)(row * ldvt + (cs ^ ((row >> 1) & 7)) * 8) * 2u; }
#define ATT_ISSUE(t, sl) do { LAS unsigned char* sb_ = lds + (sl) * SLOT; \
    _Pragma("unroll") for (int i_ = 0; i_ < NKL; ++i_) __builtin_amdgcn_global_load_lds((const unsigned*)((const char*)Kg + (size_t)(t) * 64 * ldk * 2 + koff[i_]), (LAS unsigned*)(sb_ + (i_ * 8 + wave) * 1024), 16, 0, 0); \
    _Pragma("unroll") for (int i_ = 0; i_ < NVL; ++i_) __builtin_amdgcn_global_load_lds((const unsigned*)((const char*)VTg + (size_t)(t) * 128 + voff[i_]), (LAS unsigned*)(sb_ + KBUF + (i_ * 8 + wave) * 1024), 16, 0, 0); \
    if (BIAS) __builtin_amdgcn_global_load_lds((const unsigned*)(pos + (t) * 64 + lane), (LAS unsigned*)(sb_ + KBUF + VBUF + wave * 256), 4, 0, 0); } while (0)
#ifndef ATT_X_DMA2
#define ATT_X_DMA2 0
#endif
#if ATT_X_DMA2
#define ATT_ISSUE2(t, sl) do { ATT_ISSUE(t, sl); ATT_ISSUE(t, sl); } while (0)
#else
#define ATT_ISSUE2(t, sl) ATT_ISSUE(t, sl)
#endif
#if defined(ATT_X_NODMA)
#define ATT_ISSUE_LOOP(t, sl) do { (void)(sl); } while (0)
#define ATT_NEXT_SLOT(sl) ((sl) ^ 1)
#else
#define ATT_ISSUE_LOOP(t, sl) ATT_ISSUE2(t, sl)
#define ATT_NEXT_SLOT(sl) (((sl) == 2) ? 0 : (sl) + 1)
#endif
#define ATT_WAITBAR(N) asm volatile("s_waitcnt vmcnt(%0) lgkmcnt(0)\n\ts_barrier" :: "n"(N) : "memory")
    int ts = t0;
    if (ts_force >= 0) ts = ts_force;
    else if (MIX != MIX_B) { const int tlim = (q0 >> 6) < t1 ? (q0 >> 6) : t1;
        if (!BIAS) ts = tlim > t0 ? tlim : t0;
        else {
            ts = tlim > t0 ? tlim : t0;
            for (int base = t0; base < tlim; base += 64) { const int idx = base + lane; const bool stop = (idx >= tlim) || (qpmin - *(const LAS int*)(lds + TPMO + (idx < 256 ? idx : 255) * 4) < 790);
                const unsigned long long mk = __ballot(stop); if (mk != 0ull) { const int f = base + (int)__builtin_ctzll(mk); ts = f < tlim ? f : tlim; break; } } } }
    ATT_ISSUE2(t0, 0);
    if (t0 + 1 < t1) ATT_ISSUE2(t0 + 1, 1);
    int sl = 0;
#define ATT_TILES(TA, TB, FASTV) \
    for (int t = (TA); t < (TB); ++t) { \
        if (t + 1 < t1) ATT_WAITBAR(NV * (ATT_X_DMA2 ? 2 : 1)); else ATT_WAITBAR(0);            \
        if (t + 2 < t1) { const int s2 = (sl >= 1) ? sl - 1 : 2; ATT_ISSUE_LOOP(t + 2, s2); } \
        const LAS unsigned char* sb = lds + sl * SLOT; \
        int kmax, kmin = 0; \
        kmax = cx.qi; \
        if (MIX == MIX_B) kmin = cx.qi - 127; \
        const int k0 = t * 64; \
        const bool lv = (kmax >= k0) && (kmin <= k0 + 63); \
        if (__ballot(lv) != 0ull) tile_body<DQK, DV, MIX, FASTV>(sb, lds, qf, o, m_run, l_run, cx, k0, kmax, kmin, pr, xk, xv, r, hi, lv); \
        sl = ATT_NEXT_SLOT(sl); \
    }
    ATT_TILES(t0, ts, true)
    ATT_TILES(ts, t1, false)
#undef ATT_TILES
    asm volatile("s_waitcnt lgkmcnt(0)\n\ts_barrier" ::: "memory");
#undef ATT_ISSUE
#undef ATT_WAITBAR
}
DI int fast_split(const LAS unsigned char* lds, int t0, int t1, int q0, int qpmin, int lane) {
    const int tlim = (q0 >> 6) < t1 ? (q0 >> 6) : t1;
    int ts = tlim > t0 ? tlim : t0;
    for (int base = t0; base < tlim; base += 64) { const int idx = base + lane; const bool stop = (idx >= tlim) || (qpmin - *(const LAS int*)(lds + TPMO + (idx < 256 ? idx : 255) * 4) < 790);
        const unsigned long long mk = __ballot(stop); if (mk != 0ull) { const int f = base + (int)__builtin_ctzll(mk); ts = f < tlim ? f : tlim; break; } }
    return ts;
}
template <int DQK, int DV, int MIX>
DI void flash_pass_cp(LAS unsigned char* lds, const bf16x8 (&qf)[DQK / 16], const bf16_t* __restrict__ Kg, int ldk, const bf16_t* __restrict__ VTg, int ldvt,
                      int t0, int ts, const Ctx& cx, f32x16 (&o)[DV / 32], float& m_run, float& l_run) {
    constexpr int KCH = DQK / 8, NKL = KCH / 8, NVL = DV / 64, NQ = DQK / 16, NP = DV / 16;
    constexpr int KBUF = 64 * KCH * 16, VBUF = DV * 128;
    static_assert(3 * (KBUF + VBUF) <= TPMO, "attention rings");
    int tid = threadIdx.x; asm volatile("" : "+v"(tid));
    const int lane = tid & 63, r = lane & 31, hi = lane >> 5, wave = __builtin_amdgcn_readfirstlane(tid >> 6);
    const int pr = (r & 0x13) | ((r & 4) << 1) | ((r & 8) >> 1);
    const int xk = (KCH == 16) ? (((pr & 1) << 3) | ((pr >> 1) & 7)) : ((pr >> 1) & 7);
    const int xv = (r >> 1) & 7;
    unsigned koff[NKL], voff[NVL];
#pragma unroll
    for (int i = 0; i < NKL; ++i) { const int p = (i * 8 + wave) * 64 + lane, row = p / KCH, cs = p % KCH; const int x = (KCH == 16) ? (((row & 1) << 3) | ((row >> 1) & 7)) : ((row >> 1) & 7); koff[i] = (unsigned)(row * ldk + (cs ^ x) * 8) * 2u; }
#pragma unroll
    for (int i = 0; i < NVL; ++i) { const int p = (i * 8 + wave) * 64 + lane, row = p >> 3, cs = p & 7; voff[i] = (unsigned)(row * ldvt + (cs ^ ((row >> 1) & 7)) * 8) * 2u; }
#define CP_ISSUE_K(t, sl) do { _Pragma("unroll") for (int i_ = 0; i_ < NKL; ++i_) __builtin_amdgcn_global_load_lds((const unsigned*)((const char*)Kg + (size_t)(t) * 64 * ldk * 2 + koff[i_]), (LAS unsigned*)(lds + (sl) * KBUF + (i_ * 8 + wave) * 1024), 16, 0, 0); } while (0)
#define CP_ISSUE_V(t, sl) do { _Pragma("unroll") for (int i_ = 0; i_ < NVL; ++i_) __builtin_amdgcn_global_load_lds((const unsigned*)((const char*)VTg + (size_t)(t) * 128 + voff[i_]), (LAS unsigned*)(lds + 3 * KBUF + (sl) * VBUF + (i_ * 8 + wave) * 1024), 16, 0, 0); } while (0)
#define CP_KF(base, kk) (*(const LAS bf16x8*)((base) + (((2 * (kk) + hi) ^ xk) << 4)))
#define CP_VF(base, hf, j) (*(const LAS bf16x8*)((base) + ((j) >> 1) * 32 * 128 + (((((hf) * 4 + ((j) & 1) * 2 + hi) ^ xv)) << 4)))
    const int n = ts - t0;
    CP_ISSUE_K(t0, 0); CP_ISSUE_V(t0, 0);
    if (n > 1) CP_ISSUE_K(t0 + 1, 1);
    asm volatile("s_waitcnt vmcnt(0) lgkmcnt(0)\n\ts_barrier" ::: "memory");
    const LAS unsigned char* kl = lds + pr * (KCH * 16);
    const LAS unsigned char* vl = lds + 3 * KBUF + r * 128;
    f32x16 sc, sn;
    bf16x8 kfr[NQ], vfr[NP], pp[2], pc[2];
    SmState st;
#pragma unroll
    for (int i = 0; i < 16; ++i) sc[i] = 0.f;
#pragma unroll
    for (int kk = 0; kk < NQ; ++kk) kfr[kk] = CP_KF(kl, kk);
    ATT_SB();
#pragma unroll
    for (int kk = 0; kk < NQ; ++kk) sc = __builtin_amdgcn_mfma_f32_32x32x16_bf16(kfr[kk], qf[kk], sc, 0, 0, 0);
#define CP_PRE(W, KB, HFK_UNUSED, VB, HFV, DOK, DOV) do { \
        if (DOK) { _Pragma("unroll") for (int kk = ((W) * NQ) / 8; kk < (((W) + 1) * NQ) / 8; ++kk) kfr[kk] = CP_KF(KB, kk); } \
        if (DOV) { _Pragma("unroll") for (int j = ((W) * NP) / 8; j < (((W) + 1) * NP) / 8; ++j) vfr[j] = CP_VF(VB, HFV, j); } } while (0)
#define CP_ITEM(W, DOK, DOV, KB, VB, HFV, KBN, VBN, HFVN) do { \
        ATT_PRIO(1); \
        if (DOK) { _Pragma("unroll") for (int kk = ((W) * NQ) / 8; kk < (((W) + 1) * NQ) / 8; ++kk) sn = __builtin_amdgcn_mfma_f32_32x32x16_bf16(kfr[kk], qf[kk], sn, 0, 0, 0); } \
        if (DOV) { _Pragma("unroll") for (int j = ((W) * NP) / 8; j < (((W) + 1) * NP) / 8; ++j) o[j >> 1] = __builtin_amdgcn_mfma_f32_32x32x16_bf16(vfr[j], pp[j & 1], o[j >> 1], 0, 0, 0); } \
        ATT_PRIO(0); \
        if ((W) + 2 < 8) CP_PRE((W) + 2, KB, 0, VB, HFV, DOK, DOV); else CP_PRE((W) - 6, KBN, 0, VBN, HFVN, true, true); \
        sm_item<MIX, true, W>(sc, st, m_run, l_run, pc, cx, lds, lds, 0, 0, 0, hi, true); ATT_SB(); } while (0)
#define CP_STEP(DOK, DOV, KB, VB, HFV, KBN, VBN, HFVN) do { \
        _Pragma("unroll") for (int i = 0; i < 16; ++i) sn[i] = 0.f; \
        CP_ITEM(0, DOK, DOV, KB, VB, HFV, KBN, VBN, HFVN); CP_ITEM(1, DOK, DOV, KB, VB, HFV, KBN, VBN, HFVN); CP_ITEM(2, DOK, DOV, KB, VB, HFV, KBN, VBN, HFVN); CP_ITEM(3, DOK, DOV, KB, VB, HFV, KBN, VBN, HFVN); \
        CP_ITEM(4, DOK, DOV, KB, VB, HFV, KBN, VBN, HFVN); CP_ITEM(5, DOK, DOV, KB, VB, HFV, KBN, VBN, HFVN); CP_ITEM(6, DOK, DOV, KB, VB, HFV, KBN, VBN, HFVN); CP_ITEM(7, DOK, DOV, KB, VB, HFV, KBN, VBN, HFVN); \
        if (st.resc) { _Pragma("unroll") for (int d = 0; d < DV / 32; ++d) _Pragma("unroll") for (int i = 0; i < 16; ++i) o[d][i] *= st.alpha; } \
        pp[0] = pc[0]; pp[1] = pc[1]; sc = sn; ATT_SB(); } while (0)
    int ks = 0, vs = 0;
    for (int i = 0; i < n; ++i) {
        const int t = t0 + i;
        const int ks1 = (ks == 2) ? 0 : ks + 1, ks2 = (ks == 0) ? 2 : ks - 1, vs1 = (vs == 2) ? 0 : vs + 1, vsp = (vs == 0) ? 2 : vs - 1;
        if (i > 0) asm volatile("s_waitcnt vmcnt(0) lgkmcnt(0)\n\ts_barrier" ::: "memory");
        if (t + 2 < ts) CP_ISSUE_K(t + 2, ks2);
        if (t + 1 < ts) CP_ISSUE_V(t + 1, vs1);
        const LAS unsigned char* kA = kl + ks * KBUF + 32 * (KCH * 16); const LAS unsigned char* kB = kl + ks1 * KBUF; const LAS unsigned char* kAn = kl + ks1 * KBUF + 32 * (KCH * 16);
        const LAS unsigned char* vP = vl + vsp * VBUF; const LAS unsigned char* vC = vl + vs * VBUF;
        if (i == 0) {
            CP_PRE(0, kA, 0, vP, 1, true, false); CP_PRE(1, kA, 0, vP, 1, true, false);
            CP_STEP(true, false, kA, vP, 1, kB, vC, 0);
        } else {
            CP_STEP(true, true, kA, vP, 1, kB, vC, 0);
        }
        CP_STEP(true, true, kB, vC, 0, kAn, vC, 1);
        ks = ks1; vs = vs1;
    }
    {
        const int vsp = (vs == 0) ? 2 : vs - 1; const LAS unsigned char* vP = vl + vsp * VBUF;
#pragma unroll
        for (int j = (2 * NP) / 8; j < NP; ++j) vfr[j] = CP_VF(vP, 1, j);
        ATT_SB();
#pragma unroll
        for (int j = 0; j < NP; ++j) o[j >> 1] = __builtin_amdgcn_mfma_f32_32x32x16_bf16(vfr[j], pp[j & 1], o[j >> 1], 0, 0, 0);
    }
    asm volatile("s_waitcnt lgkmcnt(0)\n\ts_barrier" ::: "memory");
#undef CP_ISSUE_K
#undef CP_ISSUE_V
#undef CP_KF
#undef CP_VF
#undef CP_PRE
#undef CP_ITEM
#undef CP_STEP
}
template <int DV> DI void store_o(const f32x16 (&o)[DV / 32], float scale, bf16_t* orow, int hi) {
#pragma unroll
    for (int d = 0; d < DV / 32; ++d)
#pragma unroll
        for (int a = 0; a < 4; ++a) { u32x2 w; w.x = cvtpk(o[d][4 * a] * scale, o[d][4 * a + 1] * scale); w.y = cvtpk(o[d][4 * a + 2] * scale, o[d][4 * a + 3] * scale); *(u32x2*)(orow + d * 32 + 8 * a + 4 * hi) = w; }
}

DI int wg_min_pos(const Frame& F, int pq) {
#pragma unroll
    for (int o = 1; o < 64; o <<= 1) { const int other = __shfl_xor(pq, o); pq = other < pq ? other : pq; }
    if (F.tid == 0) F.MISC[5] = 0x7fffffffu;
    __syncthreads();
    if (F.lane == 0) atomicMin((int*)&F.MISC[5], pq);
    __syncthreads();
    const int v = (int)F.MISC[5];
    __syncthreads();
    return v;
}
DI void unit_D(const Frame& F, const Args& a, int h, int qt) {
    const int lane = F.lane, r = lane & 31, hi = lane >> 5, qi = qt * 256 + F.wave * 32 + r;
    const bf16_t* QD = wsb(F, WS_QD) + (size_t)qi * 768 + h * 192 + hi * 8;
    bf16x8 qf[12];
#pragma unroll
    for (int kk = 0; kk < 12; ++kk) qf[kk] = *(const bf16x8*)(QD + kk * 16);
    f32x16 o[4];
#pragma unroll
    for (int d = 0; d < 4; ++d)
#pragma unroll
        for (int i = 0; i < 16; ++i) o[d][i] = 0.f;
    float m = NEG, l = 0.f;
    Ctx cx; cx.qi = qi; cx.pq = 0; cx.own = 0; cx.sel = 0ull; cx.cb = 0.f; cx.c = 0.07216878364870322f * LOG2E;
    const int ts = qt * 4;
    if (ATT_CP_D && ts > 0) flash_pass_cp<192, 128, MIX_D>(F.lds, qf, wsb(F, WS_KD) + h * 192, 768, wsb(F, WS_VDT) + (size_t)(h * 128) * S, S, 0, ts, cx, o, m, l);
    flash_pass<192, 128, MIX_D>(F.lds, qf, wsb(F, WS_KD) + h * 192, 768, wsb(F, WS_VDT) + (size_t)(h * 128) * S, S, (const int*)a.in[1], ATT_CP_D ? ts : 0, (qt + 1) * 4, qt * 256, 0, cx, o, m, l, ATT_CP_D ? ts : -1);
    l += xhalf(l);
    store_o<128>(o, 1.0f / l, wsb(F, WS_O) + (size_t)3 * S * 512 + (size_t)qi * 512 + h * 128, hi);
}
DI void unit_C(const Frame& F, const Args& a, int h, int qt, int mp) {
    const int lane = F.lane, r = lane & 31, hi = lane >> 5, qi = qt * 256 + F.wave * 32 + r;
    const int* pos = (const int*)a.in[1];
    build_tbl(F.lds, a.in[2], 12 + h, (const int*)(F.ws + WS_TPMAX));
    Ctx cx; cx.qi = qi; cx.pq = pos[qi]; cx.own = 0; cx.sel = 0ull; cx.c = 0.125f * LOG2E; cx.cb = a.in[2][31 * 16 + 12 + h] * LOG2E;
    const int qpmin = wg_min_pos(F, cx.pq);
    const bf16_t* H = wsb(F, WS_H);
    const bf16_t* Q = H + (size_t)qi * HW + H_CQ + h * 128 + mp * 64 + hi * 8;
    bf16x8 qf[4];
#pragma unroll
    for (int kk = 0; kk < 4; ++kk) qf[kk] = *(const bf16x8*)(Q + kk * 16);
    f32x16 o[4];
#pragma unroll
    for (int d = 0; d < 4; ++d)
#pragma unroll
        for (int i = 0; i < 16; ++i) o[d][i] = 0.f;
    float m = NEG, l = 0.f;
    const int ts = ATT_CP ? fast_split(F.lds, 0, (qt + 1) * 4, qt * 256, qpmin, lane) : 0;
    if (ATT_CP && ts > 0) flash_pass_cp<64, 128, MIX_C>(F.lds, qf, H + H_CK + h * 128 + mp * 64, HW, wsb(F, WS_VT) + (size_t)(VT_C + h * 128) * S, S, 0, ts, cx, o, m, l);
    flash_pass<64, 128, MIX_C>(F.lds, qf, H + H_CK + h * 128 + mp * 64, HW, wsb(F, WS_VT) + (size_t)(VT_C + h * 128) * S, S, pos, ATT_CP ? ts : 0, (qt + 1) * 4, qt * 256, qpmin, cx, o, m, l, ATT_CP ? ts : -1);
    l += xhalf(l);
    bf16_t* orow = (mp == 0 ? wsb(F, WS_O) + (size_t)2 * S * 512 : wsb(F, WS_OC2)) + (size_t)qi * 512 + h * 128;
    store_o<128>(o, 1.0f / l, orow, hi);
}
DI void unit_B(const Frame& F, const Args& a, int layer, int hq, int qt) {
    const int lane = F.lane, r = lane & 31, hi = lane >> 5, qi = qt * 256 + F.wave * 32 + r, g = hq >> 2;
    const int* pos = (const int*)a.in[1];
    build_tbl(F.lds, a.in[2], 4 + hq, (const int*)(F.ws + WS_TPMAX));
    const bf16_t* H = wsb(F, WS_H);
    const bf16_t* Q = H + (size_t)qi * HW + H_BQ + hq * 64 + hi * 8;
    bf16x8 qf[4];
#pragma unroll
    for (int kk = 0; kk < 4; ++kk) qf[kk] = *(const bf16x8*)(Q + kk * 16);
    f32x16 o[2];
#pragma unroll
    for (int d = 0; d < 2; ++d)
#pragma unroll
        for (int i = 0; i < 16; ++i) o[d][i] = 0.f;
    float m = NEG, l = 0.f;
    Ctx cx; cx.qi = qi; cx.pq = pos[qi]; cx.own = 0; cx.sel = 0ull; cx.c = 0.125f * LOG2E; cx.cb = a.in[2][31 * 16 + 4 + hq] * LOG2E;
    const int t0 = (qt * 4 - 2) < 0 ? 0 : (qt * 4 - 2);
    flash_pass<64, 64, MIX_B>(F.lds, qf, H + H_BK + g * 64, HW, wsb(F, WS_VT) + (size_t)(VT_B + g * 64) * S, S, pos, t0, (qt + 1) * 4, qt * 256, 0, cx, o, m, l);
    l += xhalf(l);
    l += ex2(a.in[8][layer * 8 + hq] * LOG2E - m);
    store_o<64>(o, 1.0f / l, wsb(F, WS_O) + (size_t)1 * S * 512 + (size_t)qi * 512 + hq * 64, hi);
}
DI void store_part(const f32x16 (&o)[4], float m, float l, unsigned char* prow, int hi) {
    l += xhalf(l);
    store_o<128>(o, 1.0f / l, (bf16_t*)prow, hi);
    if (hi == 0) *(f32x2*)(prow + 256) = (f32x2){m, l};
}
DI void unit_A_own(const Frame& F, const Args& a, int h, int qt) {
    const int lane = F.lane, r = lane & 31, hi = lane >> 5, qi = qt * 256 + F.wave * 32 + r;
    const int* pos = (const int*)a.in[1];
    build_tbl(F.lds, a.in[2], h, (const int*)(F.ws + WS_TPMAX));
    const bf16_t* H = wsb(F, WS_H);
    const bf16_t* Q = H + (size_t)qi * HW + H_AQ + h * 128 + hi * 8;
    bf16x8 qf[8];
#pragma unroll
    for (int kk = 0; kk < 8; ++kk) qf[kk] = *(const bf16x8*)(Q + kk * 16);
    f32x16 o[4];
#pragma unroll
    for (int d = 0; d < 4; ++d)
#pragma unroll
        for (int i = 0; i < 16; ++i) o[d][i] = 0.f;
    float m = NEG, l = 0.f;
    Ctx cx; cx.qi = qi; cx.pq = pos[qi]; cx.own = qt; cx.sel = 0ull; cx.c = 0.08838834764831845f * LOG2E; cx.cb = a.in[2][31 * 16 + h] * LOG2E;
    flash_pass<128, 128, MIX_C>(F.lds, qf, H + H_AK + h * 128, HW, wsb(F, WS_VT) + (size_t)(VT_A + h * 128) * S, S, pos, qt * 4, (qt + 1) * 4, 0, 0, cx, o, m, l);
    store_part(o, m, l, F.ws + WS_PART + ((size_t)qi * 16 + h * 4 + 3) * 272, hi);
}
DI void unit_A_gather(const Frame& F, const Args& a, int h, int n, int near, int chunk, int count) {
    const int lane = F.lane, r = lane & 31, hi = lane >> 5;
    const int* pos = (const int*)a.in[1];
    if (near) build_tbl(F.lds, a.in[2], h, (const int*)(F.ws + WS_TPMAX));
    const int* list = (const int*)(F.ws + WS_MLIST) + (size_t)(h * 64 + n) * MCAP + (near ? MCAP_F : 0);
    const int idx = chunk * 256 + F.wave * 32 + r; const bool live = idx < count;
    const int e = list[live ? idx : chunk * 256];
    const int qi = e >> 2, slot = e & 3;
    const bf16_t* H = wsb(F, WS_H);
    const bf16_t* Q = H + (size_t)qi * HW + H_AQ + h * 128 + hi * 8;
    bf16x8 qf[8];
#pragma unroll
    for (int kk = 0; kk < 8; ++kk) qf[kk] = *(const bf16x8*)(Q + kk * 16);
    f32x16 o[4];
#pragma unroll
    for (int d = 0; d < 4; ++d)
#pragma unroll
        for (int i = 0; i < 16; ++i) o[d][i] = 0.f;
    float m = NEG, l = 0.f;
    Ctx cx; cx.qi = 0x7fffffff; cx.pq = pos[qi]; cx.own = 0; cx.sel = 0ull; cx.c = 0.08838834764831845f * LOG2E; cx.cb = a.in[2][31 * 16 + h] * LOG2E;
    flash_pass<128, 128, MIX_C>(F.lds, qf, H + H_AK + h * 128, HW, wsb(F, WS_VT) + (size_t)(VT_A + h * 128) * S, S, pos, n * 4, (n + 1) * 4, 0, 0, cx, o, m, l, near ? n * 4 : (n + 1) * 4);
    if (live) store_part(o, m, l, F.ws + WS_PART + ((size_t)qi * 16 + h * 4 + slot) * 272, hi);
    else { l += xhalf(l); }
}
}

DI int next_unit(const Frame& F, unsigned* head) {
    if (F.tid == 0) F.MISC[4] = __hip_atomic_fetch_add(head, 1u, __ATOMIC_RELAXED, __HIP_MEMORY_SCOPE_AGENT);
    __syncthreads();
    const int u = (int)F.MISC[4];
    __syncthreads();
    return u;
}
DI void convert_chunk(const Frame& F, const Args& a, int layer, int c) {
    const bool isv = c >= 256; const int row0 = (c & 255) * 64 + F.wave * 8;
    const float* src = (isv ? a.in[23] : a.in[22]) + (size_t)layer * 16384 * DM + (size_t)row0 * DM;
    unsigned char* dst = F.ws + (isv ? WS_VB : WS_UB) + (size_t)row0 * 1024;
    const float scale = isv ? V_SCALE : U_SCALE;
    int lane = F.lane; asm volatile("" : "+v"(lane));
    for (int j = 0; j < 8; ++j) {
        const float* p = src + (size_t)j * DM + 4 * lane; unsigned char* q = dst + (size_t)j * 1024 + 2 * lane;
        f32x4 x[8];
#pragma unroll
        for (int k = 0; k < 8; ++k) x[k] = *(const f32x4*)(p + 256 * k);
#pragma unroll
        for (int k = 0; k < 8; ++k) { unsigned d = 0u; const f32x4 y = x[k] * scale;
            d = __builtin_amdgcn_cvt_scalef32_pk_fp4_f32(d, y[0], y[1], 1.0f, 0); d = __builtin_amdgcn_cvt_scalef32_pk_fp4_f32(d, y[2], y[3], 1.0f, 1);
            *(unsigned short*)(q + 128 * k) = (unsigned short)d; }
    }
}
template <int PART> DI void phase_attention(const Frame& F, const Args& a, int layer, int rep = 0) {
    unsigned* q = (unsigned*)(F.ws + WS_CTL) + CW_Q + layer * 256 + rep * 512;
    if constexpr (PART == 0) {
#if !defined(NO_D) && !defined(NO_C)
    for (;;) { const int u = next_unit(F, q + 0); if (u >= 768) break;
        const int qt = 63 - u / 12, k = u % 12;
        if (k < 4) att::unit_D(F, a, k, qt);
        else att::unit_C(F, a, (k - 4) >> 1, qt, (k - 4) & 1);
        if (ATT_CONV_INTERLEAVE) { const int c = next_unit(F, q + 32); if (c < 512) convert_chunk(F, a, layer, c); } }
    if (ATT_CONV_INTERLEAVE) for (;;) { const int c = next_unit(F, q + 32); if (c >= 512) break; convert_chunk(F, a, layer, c); }
#endif
    } else {
#ifndef NO_A
    {
        const unsigned* cnt = (const unsigned*)(F.ws + WS_CTL) + CW_MOBA + layer * 1024;
        LAS int* pre = (LAS int*)(F.lds + att::TBL - 4096);
        __syncthreads();
        if (F.tid == 0) { int acc = 0; for (int i = 0; i < 512; ++i) { pre[i] = acc; const unsigned c = cnt[i], cap = (i >= 256) ? (unsigned)(MCAP - MCAP_F) : (unsigned)MCAP_F; acc += (int)(((c < cap ? c : cap) + 255u) >> 8); } pre[512] = acc; }
        __syncthreads();
        const int ntot = 256 + pre[512];
        for (;;) { const int u = next_unit(F, q + 128); if (u >= ntot) break;
            if (u < 256) { att::unit_A_own(F, a, u & 3, 63 - (u >> 2)); continue; }
            const int g = u - 256; int lo_ = 0, hi_ = 511;
            while (lo_ < hi_) { const int mid = (lo_ + hi_ + 1) >> 1; if (pre[mid] <= g) lo_ = mid; else hi_ = mid - 1; }
            const unsigned c = cnt[lo_], cap = (lo_ >= 256) ? (unsigned)(MCAP - MCAP_F) : (unsigned)MCAP_F;
            att::unit_A_gather(F, a, (lo_ >> 6) & 3, lo_ & 63, lo_ >> 8, g - pre[lo_], (int)(c < cap ? c : cap)); }
    }
#endif
#ifndef NO_B
    for (;;) { const int u = next_unit(F, q + 192); if (u >= 512) break; att::unit_B(F, a, layer, u & 7, u >> 3); }
#endif
    }
}

DI void ins16(float (&v)[16], float x) {
#pragma unroll
    for (int k = 0; k < 16; ++k) { const float t = fmaxf(v[k], x); x = fminf(v[k], x); v[k] = t; }
}
DI float pack_idx(float s, int idx, unsigned mask) { return __uint_as_float((__float_as_uint(s) & ~mask) | (unsigned)idx); }
DI void peer_select_group(const Frame& F, const bf16_t* SK, int grp, LAS unsigned char* sel) {
    const bf16_t* QP = wsb(F, WS_H);
    int lane = F.lane; asm volatile("" : "+v"(lane));
    const int r = lane & 31, hi = lane >> 5;
    {
        const int h = F.wave, t = grp * 32 + r;
        float L[2][16];
#pragma unroll
        for (int m = 0; m < 2; ++m) {
            const bf16_t* qrow = QP + (size_t)t * DM + h * 256 + m * 128 + hi * 8;
            bf16x8 qf[8];
#pragma unroll
            for (int kk = 0; kk < 8; ++kk) qf[kk] = *(const bf16x8*)(qrow + kk * 16);
            const bf16_t* kb = SK + ((size_t)(h * 2 + m) * 128 + r) * 128 + hi * 8;
            float v[16];
#pragma unroll
            for (int k = 0; k < 16; ++k) v[k] = -3.0e38f;
#pragma unroll
            for (int rb = 0; rb < 4; ++rb) {
                f32x16 s;
#pragma unroll
                for (int i = 0; i < 16; ++i) s[i] = 0.f;
#pragma unroll
                for (int kk = 0; kk < 8; ++kk) { const bf16x8 kf = *(const bf16x8*)(kb + (size_t)rb * 32 * 128 + kk * 16); s = __builtin_amdgcn_mfma_f32_32x32x16_bf16(kf, qf[kk], s, 0, 0, 0); }
#pragma unroll
                for (int i = 0; i < 16; ++i) ins16(v, pack_idx(s[i], rb * 32 + (i & 3) + 8 * (i >> 2) + 4 * hi, 127u));
                asm volatile("" : "+v"(v[0]), "+v"(v[1]), "+v"(v[2]), "+v"(v[3]), "+v"(v[4]), "+v"(v[5]), "+v"(v[6]), "+v"(v[7]), "+v"(v[8]), "+v"(v[9]), "+v"(v[10]), "+v"(v[11]), "+v"(v[12]), "+v"(v[13]), "+v"(v[14]), "+v"(v[15]));
                asm volatile("" : "+v"(kb));
            }
            float ov[16];
#pragma unroll
            for (int k = 0; k < 16; ++k) ov[k] = xhalf(v[k]);
#pragma unroll
            for (int k = 0; k < 16; ++k) ins16(v, ov[k]);
#pragma unroll
            for (int k = 0; k < 16; ++k) L[m][k] = v[k];
        }
        int i0[16], i1[16];
#pragma unroll
        for (int k = 0; k < 16; ++k) { i0[k] = (int)(__float_as_uint(L[0][k]) & 127u); i1[k] = (int)(__float_as_uint(L[1][k]) & 127u); L[0][k] = __uint_as_float(__float_as_uint(L[0][k]) & ~127u); L[1][k] = __uint_as_float(__float_as_uint(L[1][k]) & ~127u); }
        float b[16];
#pragma unroll
        for (int k = 0; k < 16; ++k) b[k] = -3.0e38f;
#pragma unroll
        for (int i = 0; i < 16; ++i)
#pragma unroll
            for (int j = 0; j < 16; ++j) if ((i + 1) * (j + 1) <= 16) ins16(b, pack_idx(L[0][i] + L[1][j], i * 16 + j, 255u));
        float g[16]; int e[16]; float den = 0.f;
        const float b0 = __uint_as_float(__float_as_uint(b[0]) & ~255u);
#pragma unroll
        for (int k = 0; k < 16; ++k) {
            const unsigned bits = __float_as_uint(b[k]); const int ci = (int)((bits >> 4) & 15u), cj = (int)(bits & 15u);
            int e0 = i0[0], e1 = i1[0];
#pragma unroll
            for (int c = 1; c < 16; ++c) { e0 = (ci == c) ? i0[c] : e0; e1 = (cj == c) ? i1[c] : e1; }
            e[k] = e0 * 128 + e1;
            g[k] = ex2((__uint_as_float(bits & ~255u) - b0) * LOG2E); den += g[k];
        }
        const float inv = 1.0f / den;
        if (hi == 0) {
#pragma unroll
            for (int k = 0; k < 16; k += 4) *(LAS i32x4*)(sel + (r * 128 + h * 16 + k) * 4) = (i32x4){e[k], e[k + 1], e[k + 2], e[k + 3]};
        } else {
#pragma unroll
            for (int k = 0; k < 16; k += 4) *(LAS f32x4*)(sel + 16384 + (r * 128 + h * 16 + k) * 4) = (f32x4){g[k] * inv, g[k + 1] * inv, g[k + 2] * inv, g[k + 3] * inv};
        }
    }
}
DI float gelu_as(float v) {
    const float av = fabsf(v), t = __builtin_amdgcn_rcpf(av * 0.2316418882f + 1.0f);
    float q = t * 0.5307027145f + (-0.7265760135f); q = q * t + 0.7107068705f; q = q * t + (-0.142248368f); q = q * t + 0.127414796f; q = q * t;
    const float e = ex2((v * v) * (-0.72134752044f));
    const float m = v * (q * e);
    return v < 0.f ? m : v - m;
}
template <int CTRL, int RM> DI float dpp_add(float v) { return v + __builtin_bit_cast(float, __builtin_amdgcn_update_dpp(0, __builtin_bit_cast(int, v), CTRL, RM, 0xf, RM == 0xf)); }
DI float wave_total(float v) {
    v = dpp_add<0x111, 0xf>(v); v = dpp_add<0x112, 0xf>(v); v = dpp_add<0x114, 0xf>(v); v = dpp_add<0x118, 0xf>(v);
    v = dpp_add<0x142, 0xa>(v); v = dpp_add<0x143, 0xc>(v);
    return __uint_as_float(__builtin_amdgcn_readlane(__float_as_uint(v), 63));
}
DI void reduce4(float (&d)[4], int lane) {
#pragma unroll
    for (int i = 0; i < 4; ++i) d[i] = wave_total(d[i]);
}
DI void peer_gather_group(const Frame& F, const Args& a, int layer, float* outf, bf16_t* XB, int grp, const LAS unsigned char* sel) {
    typedef int v8i_t __attribute__((ext_vector_type(8)));
    const unsigned char* UB = F.ws + WS_UB; const unsigned char* VB = F.ws + WS_VB;
    int lane = F.lane; asm volatile("" : "+v"(lane));
    const int m16 = lane & 15, g4 = lane >> 4;
    LAS unsigned char* x8 = F.lds + 65536 + F.wave * 2048;
    int sc = 0x7f7f7f7f; asm volatile("" : "+v"(sc));
    for (int ti = 0; ti < 4; ++ti) {
        const int tl = F.wave * 4 + ti, t = grp * 32 + tl;
        const bf16_t* xr = XB + (size_t)t * DM + 32 * lane;
        {
            u32x4 w8[2];
#pragma unroll
            for (int c = 0; c < 4; ++c) { const u32x4 w = *(const u32x4*)(xr + 8 * c);
#if PEER_X_SWAP
                int lo = __builtin_amdgcn_cvt_pk_fp8_f32(bf_hi(w.x), bf_lo(w.x), 0, false); lo = __builtin_amdgcn_cvt_pk_fp8_f32(bf_hi(w.y), bf_lo(w.y), lo, true);
                int hi = __builtin_amdgcn_cvt_pk_fp8_f32(bf_hi(w.z), bf_lo(w.z), 0, false); hi = __builtin_amdgcn_cvt_pk_fp8_f32(bf_hi(w.w), bf_lo(w.w), hi, true);
#else
                int lo = __builtin_amdgcn_cvt_pk_fp8_f32(bf_lo(w.x), bf_hi(w.x), 0, false); lo = __builtin_amdgcn_cvt_pk_fp8_f32(bf_lo(w.y), bf_hi(w.y), lo, true);
                int hi = __builtin_amdgcn_cvt_pk_fp8_f32(bf_lo(w.z), bf_hi(w.z), 0, false); hi = __builtin_amdgcn_cvt_pk_fp8_f32(bf_lo(w.w), bf_hi(w.w), hi, true);
#endif
                w8[c >> 1][(c & 1) * 2] = (unsigned)lo; w8[c >> 1][(c & 1) * 2 + 1] = (unsigned)hi; }
            *(LAS u32x4*)(x8 + 32 * lane) = w8[0]; *(LAS u32x4*)(x8 + 32 * lane + 16) = w8[1];
        }
        f32x2 acc[16];
#pragma unroll
        for (int e = 0; e < 16; ++e) acc[e] = (f32x2){0.f, 0.f};
        for (int half = 0; half < 2; ++half) {
            const int ev = *(const LAS int*)(sel + (tl * 128 + half * 64 + lane) * 4); const float gv = *(const LAS float*)(sel + 16384 + (tl * 128 + half * 64 + lane) * 4);
            for (int bb = 0; bb < 4; ++bb) {
                const int em = __builtin_amdgcn_ds_bpermute((16 * bb + m16) << 2, ev);
                const unsigned char* up = UB + (size_t)em * 1024 + 16 * g4;
                u32x4 ua[16], va[16];
#pragma unroll
                for (int s = 0; s < 16; ++s) ua[s] = *(const u32x4*)(up + 64 * s);
#pragma unroll
                for (int j = 0; j < 16; ++j) { const int e = __builtin_amdgcn_readlane(ev, 16 * bb + j); va[j] = *(const u32x4*)(VB + (size_t)e * 1024 + 16 * lane); }
                f32x4 h = (f32x4){0.f, 0.f, 0.f, 0.f};
#pragma unroll
                for (int s = 0; s < 16; ++s) {
                    const u32x4 x0 = *(const LAS u32x4*)(x8 + 128 * s + 16 * g4), x1 = *(const LAS u32x4*)(x8 + 128 * s + 64 + 16 * g4);
                    const v8i_t xb = (v8i_t){(int)x0.x, (int)x0.y, (int)x0.z, (int)x0.w, (int)x1.x, (int)x1.y, (int)x1.z, (int)x1.w};
                    asm volatile("s_nop 1\n\tv_mfma_scale_f32_16x16x128_f8f6f4 %0, %1, %2, %0, %3, %3 op_sel_hi:[0,0,0] cbsz:4" : "+v"(h) : "v"(ua[s]), "v"(xb), "v"(sc));
                }
                asm volatile("s_nop 15" : "+v"(h));
                float hv[4];
#pragma unroll
                for (int i = 0; i < 4; ++i) { const float gq = __int_as_float(__builtin_amdgcn_ds_bpermute((16 * bb + 4 * g4 + i) << 2, __float_as_int(gv)));
                    hv[i] = gq * gelu_as(h[i] * (1.0f / U_SCALE)) * (1.0f / V_SCALE); }
#pragma unroll
                for (int j = 0; j < 16; ++j) {
                    const float wk = __uint_as_float(__builtin_amdgcn_readlane(__float_as_uint(hv[j & 3]), 16 * (j >> 2)));
                    const f32x2 wk2 = (f32x2){wk, wk}; const u32x4 w_ = va[j];
#define FP4_ACC(b) acc[b] += __builtin_amdgcn_cvt_scalef32_pk_f32_fp4(w_[(b) >> 2], 1.0f, (b) & 3) * wk2;
                    FP4_ACC(0) FP4_ACC(1) FP4_ACC(2) FP4_ACC(3) FP4_ACC(4) FP4_ACC(5) FP4_ACC(6) FP4_ACC(7) FP4_ACC(8) FP4_ACC(9) FP4_ACC(10) FP4_ACC(11) FP4_ACC(12) FP4_ACC(13) FP4_ACC(14) FP4_ACC(15)
#undef FP4_ACC
                }
            }
        }
        float z[1][32];
#pragma unroll
        for (int c = 0; c < 4; ++c) { const u32x4 w = *(const u32x4*)(xr + 8 * c);
            z[0][8 * c + 0] = acc[4 * c].x + DN_ALPHA * bf_lo(w.x); z[0][8 * c + 1] = acc[4 * c].y + DN_ALPHA * bf_hi(w.x); z[0][8 * c + 2] = acc[4 * c + 1].x + DN_ALPHA * bf_lo(w.y); z[0][8 * c + 3] = acc[4 * c + 1].y + DN_ALPHA * bf_hi(w.y);
            z[0][8 * c + 4] = acc[4 * c + 2].x + DN_ALPHA * bf_lo(w.z); z[0][8 * c + 5] = acc[4 * c + 2].y + DN_ALPHA * bf_hi(w.z); z[0][8 * c + 6] = acc[4 * c + 3].x + DN_ALPHA * bf_lo(w.w); z[0][8 * c + 7] = acc[4 * c + 3].y + DN_ALPHA * bf_hi(w.w); }
        ln_store<1, 32>(z, a.in[24] + layer * DM, a.in[25] + layer * DM, outf ? outf + (size_t)t * DM : (float*)nullptr, XB + (size_t)t * DM, lane, outf ? (unsigned char*)nullptr : F.ws + WS_XB8 + (size_t)t * DM, outf ? (unsigned char*)nullptr : F.ws + WS_XB4 + (size_t)t * (DM / 2));
    }
}
DI void phase_peer(const Frame& F, const Args& a, int layer, const bf16_t* SK, float* outf) {
    LAS unsigned char* sel = F.lds;
    bf16_t* XB = wsb(F, WS_XB);
    const int g0 = F.vcu, g1 = F.vcu + F.G, ng = S / 32;
    if (F.vcu & 1) {
        if (g0 < ng) peer_select_group(F, SK, g0, sel);
        if (g1 < ng) peer_select_group(F, SK, g1, sel + 32768);
        __syncthreads();
        if (g0 < ng) peer_gather_group(F, a, layer, outf, XB, g0, sel);
        if (g1 < ng) peer_gather_group(F, a, layer, outf, XB, g1, sel + 32768);
    } else {
        if (g0 < ng) peer_select_group(F, SK, g0, sel);
        __syncthreads();
        if (g0 < ng) peer_gather_group(F, a, layer, outf, XB, g0, sel);
        if (g1 < ng) peer_select_group(F, SK, g1, sel + 32768);
        __syncthreads();
        if (g1 < ng) peer_gather_group(F, a, layer, outf, XB, g1, sel + 32768);
    }
    for (int g = F.vcu + 2 * F.G; g < ng; g += F.G) { __syncthreads(); peer_select_group(F, SK, g, sel); __syncthreads(); peer_gather_group(F, a, layer, outf, XB, g, sel); }
}

#ifndef GEMM_SP2
#define GEMM_SP2 true
#endif
#ifndef GEMM_ALIGN_EPI
#define GEMM_ALIGN_EPI true
#endif
template <int MODE, bool F8 = false, int SC0 = 127, int SC1 = 127, bool F4 = false> DI void run_gemm(const Frame& F, const bf16_t* A, int lda, const bf16_t* Bt, int ldb, int M, int N, int K, long apn, const pg8::Epi<MODE>& E, int rot = 0) {
    pg8::Gemm g{A, Bt, M, N, K, lda, ldb, apn}; pg8::StaticOrder So; So.init(M, N, F.G, (F.G == 256) ? (int)((blockIdx.x + (unsigned)rot) & 255u) : (int)blockIdx.x);
    pg8::gemm_phase<pg8::Epi<MODE>, pg8::StaticOrder, GEMM_ALIGN_EPI, GEMM_SP2, F8, SC0, SC1, F4>(F.lds, g, So, E);
}
#ifndef MK_CHECK
#define MK_CHECK 0
#endif
#ifndef MK_CHECK_WORD
#define MK_CHECK_WORD 0
#endif

#if MK_CHECK
namespace chk {
constexpr int NS = 64;
__device__ const int SAMPLES[NS] = {0, 1, 2, 31, 32, 63, 64, 127, 128, 129, 255, 256, 257, 300, 383, 384, 511, 512, 513, 767, 768, 1000, 1023, 1024, 1025, 1279, 1280, 2047, 2048, 2049, 3071, 3072,
    4095, 4096, 5000, 6143, 6144, 7777, 8191, 8192, 8193, 9999, 10239, 10240, 11111, 12287, 12288, 12289, 13000, 13311, 13312, 14000, 14335, 14336, 15000, 15359, 15360, 15871, 16127, 16128, 16129, 16255, 16256, 16383};
DI float bsum(const Frame& F, float v) {
    v = wave_sum(v);
    __syncthreads();
    if (F.lane == 0) F.MISC[16 + F.wave] = __float_as_uint(v);
    __syncthreads();
    float s = 0.f;
    for (int w = 0; w < 8; ++w) s += __uint_as_float(F.MISC[16 + w]);
    return s;
}
DI float bmax(const Frame& F, float v) {
#pragma unroll
    for (int o = 1; o < 64; o <<= 1) v = fmaxf(v, __shfl_xor(v, o));
    __syncthreads();
    if (F.lane == 0) F.MISC[16 + F.wave] = __float_as_uint(v);
    __syncthreads();
    float s = -INFINITY;
    for (int w = 0; w < 8; ++w) s = fmaxf(s, __uint_as_float(F.MISC[16 + w]));
    return s;
}
DI void verdict(const Frame& F, float err, float nrm, float tol, int code) {
    const float e = bsum(F, err), n = bsum(F, nrm);
    if (F.tid == 0) { const bool bad = !(e <= tol * tol * n + 1e-12f); if (bad) { atomicAdd((unsigned*)(F.ws + WS_CTL) + CW_CHK, 1u); atomicAdd((unsigned*)(F.ws + WS_CTL) + CW_CHK + 64 * (1 + code), 1u); } }
}
DI float sigm(float z) { return 1.0f / (1.0f + expf(-z)); }
DI float rope_inv(int j) { return powf(10000.0f, -(float)j / 32.0f); }
DI float t5_naive(const float* t5, int col, int rel) {
    int n = rel > 0 ? rel : 0; int b;
    if (n < 16) b = n; else { b = 16 + (int)(logf((float)n / 16.0f) / logf(64.0f) * 16.0f); if (b > 31) b = 31; }
    return t5[b * 16 + col];
}
DI void s1(const Frame& F, const Args& a, int layer) {
    const bf16_t* X = wsb(F, WS_XB); const float* W = a.in[3] + (size_t)layer * DM * 4672;
    const bf16_t* H = wsb(F, WS_H); const bf16_t* VT = wsb(F, WS_VT);
    for (int u = F.vcu; u < NS; u += F.G) { const int t = SAMPLES[u]; float err = 0.f, nrm = 0.f;
        for (int c = F.tid; c < 4672; c += 512) { float ref = 0.f; for (int k = 0; k < DM; ++k) ref += bf1(X[(size_t)t * DM + k]) * W[(size_t)k * 4672 + c];
            const int d = win_map(c); const float got = d < HW ? bf1(H[(size_t)t * HW + d]) : bf1(VT[(size_t)(d - HW) * S + t]); err += (ref - got) * (ref - got); nrm += ref * ref; }
        verdict(F, err, nrm, 0.06f, 0); }
}
DI void s2(const Frame& F, const Args& a, int layer) {
    const bf16_t* H = wsb(F, WS_H); const int* pos = (const int*)a.in[1];
    for (int u = F.vcu; u < NS; u += F.G) { const int t = SAMPLES[u]; float err = 0.f, nrm = 0.f;
        float ssq = 0.f; for (int k = 0; k < 512; ++k) { const float v = bf1(H[(size_t)t * HW + H_DCQ + k]); ssq += v * v; }
        const float rq = 1.0f / sqrtf(ssq / 512.0f + 1e-6f);
        float ssk = 0.f; for (int k = 0; k < 256; ++k) { const float v = bf1(H[(size_t)t * HW + H_DCKV + k]); ssk += v * v; }
        const float rk = 1.0f / sqrtf(ssk / 256.0f + 1e-6f);
        for (int c = F.tid; c < 512; c += 512) { const float ref = bf1(H[(size_t)t * HW + H_DCQ + c]) * rq * a.in[14][layer * 512 + c]; const float got = bf1(wsb(F, WS_CQN)[(size_t)t * 512 + c]); err += (ref - got) * (ref - got); nrm += ref * ref; }
        for (int c = F.tid; c < 256; c += 512) { const float ref = bf1(H[(size_t)t * HW + H_DCKV + c]) * rk * a.in[15][layer * 256 + c]; const float got = bf1(wsb(F, WS_CKVN)[(size_t)t * 256 + c]); err += (ref - got) * (ref - got); nrm += ref * ref; }
        for (int c = F.tid; c < 256; c += 512) { const int h = c >> 6, j = c & 63, jj = j & 31; const float x1 = bf1(H[(size_t)t * HW + H_DKR + jj]), x2 = bf1(H[(size_t)t * HW + H_DKR + jj + 32]);
            const float ang = (float)pos[t] * rope_inv(jj); const float ref = j < 32 ? x1 * cosf(ang) - x2 * sinf(ang) : x1 * sinf(ang) + x2 * cosf(ang);
            const float got = bf1(wsb(F, WS_KD)[(size_t)t * 768 + h * 192 + 128 + j]); err += (ref - got) * (ref - got); nrm += ref * ref; }
        verdict(F, err, nrm, 0.02f, 1); }
}
DI void s3(const Frame& F, const Args& a, int layer) {
    const int* pos = (const int*)a.in[1]; const float* Wq = a.in[16] + (size_t)layer * 512 * 768; const float* Wkv = a.in[17] + (size_t)layer * 256 * 1024;
    LAS float* pre = (LAS float*)F.lds;
    for (int u = F.vcu; u < NS; u += F.G) { const int t = SAMPLES[u]; float err = 0.f, nrm = 0.f;
        __syncthreads();
        for (int n = F.tid; n < 768; n += 512) { float r = 0.f; for (int k = 0; k < 512; ++k) r += bf1(wsb(F, WS_CQN)[(size_t)t * 512 + k]) * Wq[(size_t)k * 768 + n]; pre[n] = r; }
        __syncthreads();
        for (int n = F.tid; n < 768; n += 512) { const int h = n / 192, j = n % 192; float ref = pre[n];
            if (j >= 128) { const int jj = (j - 128) & 31; const float x1 = pre[h * 192 + 128 + jj], x2 = pre[h * 192 + 128 + jj + 32]; const float ang = (float)pos[t] * rope_inv(jj);
                ref = (j - 128) < 32 ? x1 * cosf(ang) - x2 * sinf(ang) : x1 * sinf(ang) + x2 * cosf(ang); }
            const float got = bf1(wsb(F, WS_QD)[(size_t)t * 768 + n]); err += (ref - got) * (ref - got); nrm += ref * ref; }
        for (int n = F.tid; n < 1024; n += 512) { float ref = 0.f; for (int k = 0; k < 256; ++k) ref += bf1(wsb(F, WS_CKVN)[(size_t)t * 256 + k]) * Wkv[(size_t)k * 1024 + n];
            const int h = n >> 8, j = n & 255; const float got = j < 128 ? bf1(wsb(F, WS_KD)[(size_t)t * 768 + h * 192 + j]) : bf1(wsb(F, WS_VDT)[(size_t)(h * 128 + j - 128) * S + t]);
            err += (ref - got) * (ref - got); nrm += ref * ref; }
        verdict(F, err, nrm, 0.02f, 2); }
}
DI void s4(const Frame& F, const Args& a, int layer) {
    const int* pos = (const int*)a.in[1]; const float* t5 = a.in[2]; const bf16_t* H = wsb(F, WS_H);
    LAS float* lg = (LAS float*)F.lds;
    LAS float* qv = (LAS float*)(F.lds + 65536);
    LAS float* ga = (LAS float*)(F.lds + 65536 + 1024);
    LAS float* op = (LAS float*)(F.lds + 65536 + 2048);
    LAS float* o1 = (LAS float*)(F.lds + 65536 + 2048 + 2048);
    LAS int* selb = (LAS int*)(F.lds + 65536 + 8192);
    for (int u = F.vcu; u < NS * 20; u += F.G) {
        const int q = SAMPLES[u / 20], mh = u % 20;
        int mix, h; if (mh < 4) { mix = 0; h = mh; } else if (mh < 12) { mix = 1; h = mh - 4; } else if (mh < 16) { mix = 2; h = mh - 12; } else { mix = 3; h = mh - 16; }
        const int DQ = mix == 0 ? 128 : (mix == 3 ? 192 : 64), DVV = mix == 1 ? 64 : 128;
        const int nmaps = mix == 2 ? 2 : 1;
        const float scale = 1.0f / sqrtf((float)DQ);
        const int bcol = mix == 0 ? h : (mix == 1 ? 4 + h : 12 + h);
        float errs = 0.f, nrms = 0.f;
        for (int mp = 0; mp < nmaps; ++mp) {
            const bf16_t* Qp; const bf16_t* Kp; int ldk; const bf16_t* Vp;
            if (mix == 0) { Qp = H + (size_t)q * HW + H_AQ + h * 128; Kp = H + H_AK + h * 128; ldk = HW; Vp = wsb(F, WS_VT) + (size_t)(VT_A + h * 128) * S; }
            else if (mix == 1) { Qp = H + (size_t)q * HW + H_BQ + h * 64; Kp = H + H_BK + (h >> 2) * 64; ldk = HW; Vp = wsb(F, WS_VT) + (size_t)(VT_B + (h >> 2) * 64) * S; }
            else if (mix == 2) { Qp = H + (size_t)q * HW + H_CQ + h * 128 + mp * 64; Kp = H + H_CK + h * 128 + mp * 64; ldk = HW; Vp = wsb(F, WS_VT) + (size_t)(VT_C + h * 128) * S; }
            else { Qp = wsb(F, WS_QD) + (size_t)q * 768 + h * 192; Kp = wsb(F, WS_KD) + h * 192; ldk = 768; Vp = wsb(F, WS_VDT) + (size_t)(h * 128) * S; }
            __syncthreads();
            for (int d = F.tid; d < DQ; d += 512) qv[d] = bf1(Qp[d]);
            if (F.tid < 64) { ga[F.tid] = 0.f; selb[F.tid] = 0; }
            __syncthreads();
            const int own = q >> 8;
            if (mix == 0) {
                for (int idx = F.tid; idx < own * 128; idx += 512) { const int n = idx >> 7, d = idx & 127; float sm = 0.f; for (int i = 0; i < 256; ++i) sm += bf1(Kp[(size_t)(n * 256 + i) * ldk + d]); atomicAdd((float*)&ga[n], qv[d] * (sm / 256.0f)); }
                __syncthreads();
                if (F.tid == 0) { for (int rnk = 0; rnk < 3 && rnk < own; ++rnk) { int best = -1; float bv = -INFINITY; for (int n = 0; n < own; ++n) if (!selb[n] && ga[n] > bv) { bv = ga[n]; best = n; } if (best >= 0) selb[best] = 1; } }
                __syncthreads();
            }
            float mx = -INFINITY;
            for (int k = F.tid; k <= q; k += 512) {
                bool valid = true;
                if (mix == 0) { const int blk = k >> 8; valid = (blk == own) ? true : (selb[blk] != 0); }
                if (mix == 1) valid = (q - k) < 128;
                float l = -INFINITY;
                if (valid) { float dot = 0.f; for (int d = 0; d < DQ; ++d) dot += qv[d] * bf1(Kp[(size_t)k * ldk + d]); l = dot * scale; if (mix != 3) l += t5_naive(t5, bcol, pos[q] - pos[k]); }
                lg[k] = l; mx = fmaxf(mx, l);
            }
            mx = bmax(F, mx);
            const float sink = (mix == 1) ? a.in[8][layer * 8 + h] : -INFINITY;
            if (mix == 1) mx = fmaxf(mx, sink);
            float sm = 0.f;
            for (int k = F.tid; k <= q; k += 512) { const float p = expf(lg[k] - mx); lg[k] = p; sm += p; }
            sm = bsum(F, sm);
            if (mix == 1) sm += expf(sink - mx);
            __syncthreads();
            { const int dv = F.tid % 128, part = F.tid / 128; float acc = 0.f;
              if (dv < DVV) for (int k = part; k <= q; k += 4) acc += lg[k] * bf1(Vp[(size_t)dv * S + k]);
              op[part * 128 + dv] = acc; }
            __syncthreads();
            float val = 0.f;
            if (F.tid < DVV) val = (op[F.tid] + op[128 + F.tid] + op[256 + F.tid] + op[384 + F.tid]) / sm;
            if (mix == 2 && mp == 0) { if (F.tid < 128) o1[F.tid] = val; __syncthreads(); continue; }
            if (mix == 2) {
                float d1 = 0.f, d2 = 0.f; for (int i = 0; i < 64; ++i) { d1 += a.in[9][layer * 64 + i] * a.in[10][layer * 64 + i]; d2 += a.in[11][layer * 64 + i] * a.in[12][layer * 64 + i]; }
                const float li = 0.8f - 0.6f * expf(-0.3f * (float)layer), lam = expf(d1) - expf(d2) + li;
                float x = (F.tid < 128) ? (o1[F.tid] - lam * val) : 0.f;
                const float ms = bsum(F, x * x) / 128.0f;
                val = x / sqrtf(ms + 1e-6f) * ((F.tid < 128) ? a.in[13][layer * 128 + F.tid] : 0.f) * (1.0f - li);
            }
            if (F.tid < DVV) { const int ocol = (mix == 1) ? h * 64 + F.tid : h * 128 + F.tid; const float got = bf1(wsb(F, WS_O)[(size_t)mix * S * 512 + (size_t)q * 512 + ocol]); errs = (val - got) * (val - got); nrms = val * val; }
        }
        verdict(F, errs, nrms, 0.03f, 3 + mix);
    }
}
DI void s5(const Frame& F, const Args& a, int layer) {
    const bf16_t* X = wsb(F, WS_XB);
    for (int u = F.vcu; u < NS; u += F.G) { const int t = SAMPLES[u]; float err = 0.f, nrm = 0.f, err2 = 0.f, nrm2 = 0.f;
        for (int c = F.tid; c < 8192; c += 512) { const int n = c >> 11, cc = c & 2047; const float* W = a.in[4] + ((size_t)layer * 4 + n) * DM * DM; float z = a.in[5][(size_t)layer * 8192 + c];
            for (int k = 0; k < DM; ++k) z += bf1(X[(size_t)t * DM + k]) * W[(size_t)k * DM + cc];
            const float ref = sigm(z), got = __builtin_amdgcn_cvt_pk_f32_fp8((int)(F.ws + WS_GT)[(size_t)t * 8192 + c], false)[0]; err += (ref - got) * (ref - got); nrm += ref * ref; }
        for (int c = F.tid; c < DM; c += 512) { float ref = 0.f;
            for (int n = 0; n < 4; ++n) { const float* W = a.in[6] + ((size_t)layer * 4 + n) * 512 * DM; float br = 0.f; for (int j = 0; j < 512; ++j) br += bf1(wsb(F, WS_O)[(size_t)n * S * 512 + (size_t)t * 512 + j]) * W[(size_t)j * DM + c];
                ref += __builtin_amdgcn_cvt_pk_f32_fp8((int)(F.ws + WS_GT)[(size_t)t * 8192 + n * DM + c], false)[0] * br; }
            const float got = bf1(wsb(F, WS_H)[(size_t)t * DM + c]); err2 += (ref - got) * (ref - got); nrm2 += ref * ref; }
        verdict(F, err, nrm, 0.12f, 7); verdict(F, err2, nrm2, 0.12f, 8); }
}
DI void s6(const Frame& F, const Args& a, int layer) {
    const bf16_t* X = wsb(F, WS_XB); const float* W = a.in[7] + (size_t)layer * DM * DM; const bf16_t* Y = wsb(F, WS_GT);
    for (int u = F.vcu; u < NS; u += F.G) { const int t = SAMPLES[u]; float err = 0.f, nrm = 0.f;
        for (int c = F.tid; c < DM; c += 512) { float ref = 0.f; for (int j = 0; j < DM; ++j) ref += bf1(wsb(F, WS_H)[(size_t)t * DM + j]) * W[(size_t)j * DM + c];
            const float full = DN_ALPHA * bf1(X[(size_t)t * DM + c]) + ref, got = bf1(Y[(size_t)t * DM + c]); err += (full - got) * (full - got); nrm += full * full; }
        verdict(F, err, nrm, 0.006f, 9); }
}
DI void poison(const Frame& F) {
    const unsigned bad = __hip_atomic_load((unsigned*)(F.ws + WS_CTL) + CW_CHK + 64 * MK_CHECK_WORD, __ATOMIC_RELAXED, __HIP_MEMORY_SCOPE_AGENT);
    const float sc = 1.0f + (float)bad / 256.0f;
    for (size_t i = (size_t)F.vcu * 512 + F.tid; i < (size_t)S * DM / 4; i += (size_t)F.G * 512) { f32x4 v = ((f32x4*)F.out)[i]; v = v * sc; ((f32x4*)F.out)[i] = v; }
}
}
#endif

#ifndef MK_CHECK
#define MK_CHECK 0
#endif
#ifndef MK_CHECK_WORD
#define MK_CHECK_WORD 0
#endif
#ifndef MK_CHECK_LAYER
#define MK_CHECK_LAYER 0
#endif
#ifndef MK_PROBE_REL
#define MK_PROBE_REL (-2)
#endif
#ifndef MK_PROBE_REPS
#define MK_PROBE_REPS 1
#endif
#ifndef MK_PER_PHASE
#define MK_PER_PHASE 0
#endif
constexpr int NPL = 11, NPHASES = 1 + NL * NPL;
DI void run_layer(const Frame& F, const Args& args, const XcdBarrier& bar, const int layer, const int lo, const int hi) {
#define PH(k) (lo <= (k) && (k) < hi)
#define SEAM(k) do { if (PH(k) && PH((k) + 1)) xcd_barrier(bar); } while (0)
        const int pb = 1 + layer * NPL;
        unsigned char* wl = F.ws + WS_W + (size_t)layer * WL_STRIDE;
        if (PH(pb + 0)) {
            { pg8::Epi<0> E{}; E.O = wsb(F, WS_H); E.ldc = HW; E.grp = 128; run_gemm<0, true, 121, 127>(F, (const bf16_t*)(F.ws + WS_XB8), DM / 2, (const bf16_t*)(wl + W_IN), DM / 2, S, HW, DM / 2, 0, E); }
            { pg8::Epi<0> E{}; E.O = wsb(F, WS_VT); E.ldc = S; E.grp = 128; run_gemm<0, true, 127, 121>(F, (const bf16_t*)(wl + W_IN + (size_t)HW * DM), DM / 2, (const bf16_t*)(F.ws + WS_XB8), DM / 2, VT_ROWS, S, DM / 2, 0, E, 128); }
            { pg8::Epi<1> E{}; E.O = wsb(F, WS_GT); E.ldc = 8192; E.bias = args.in[5] + (size_t)layer * 8192; run_gemm<1, false, 121, 126, true>(F, (const bf16_t*)(F.ws + WS_XB4), DM / 4, (const bf16_t*)(wl + W_G), DM / 4, S, 8192, DM / 4, 0, E); }
        }
        SEAM(pb + 0);
        if (PH(pb + 1)) phase_prep(F, args, layer);
        SEAM(pb + 1);
        if (PH(pb + 2)) {
            { pg8::Epi<0> E{}; E.O = wsb(F, WS_QD); E.ldc = 768; E.grp = 128; run_gemm<0>(F, wsb(F, WS_CQN), 512, (const bf16_t*)(wl + W_UQ), 512, S, 768, 512, 0, E); }
            { pg8::Epi<0> E{}; E.O = wsb(F, WS_KD); E.ldc = 768; E.grp = 192; run_gemm<0>(F, wsb(F, WS_CKVN), 256, (const bf16_t*)(wl + W_UKV), 256, S, 512, 256, 0, E, 64); }
            { pg8::Epi<0> E{}; E.O = wsb(F, WS_VDT); E.ldc = S; E.grp = 128; run_gemm<0>(F, (const bf16_t*)(wl + W_UKV) + (size_t)512 * 256, 256, wsb(F, WS_CKVN), 256, 512, S, 256, 0, E, 192); }
        }
        SEAM(pb + 2);
        if (PH(pb + 3)) { phase_ropeq(F, args); phase_moba_select(F, args, layer); }
        SEAM(pb + 3);
        if (PH(pb + 4)) {
            phase_attention<0>(F, args, layer);
            if (!ATT_CONV_INTERLEAVE) { convert_fp4(F, args.in[22] + (size_t)layer * 16384 * DM, F.ws + WS_UB, 16384, U_SCALE); convert_fp4(F, args.in[23] + (size_t)layer * 16384 * DM, F.ws + WS_VB, 16384, V_SCALE); }
            if (layer + 1 < NL) convert_weights(F, args, layer + 1, layer + 2);
            __syncthreads();
            phase_attention<1>(F, args, layer);
        }
        SEAM(pb + 4);
        if (PH(pb + 5)) phase_mixer_combine(F, args, layer);
        SEAM(pb + 5);
        if (PH(pb + 6)) {
            for (int n = 0; n < 4; ++n) { pg8::Epi<2> E{}; E.O = wsb(F, WS_H); E.ldc = DM; E.G = (const bf16_t*)(F.ws + WS_GT + n * DM); E.ldg = 8192; E.first = (n == 0); E.O8 = (n == 3) ? F.ws + WS_XB8 : (unsigned char*)nullptr;
                run_gemm<2, true, 121, 124>(F, (const bf16_t*)(F.ws + WS_O8 + (size_t)n * S * 512), 256, (const bf16_t*)(wl + W_BR) + (size_t)n * DM * 512, 256, S, DM, 256, 0, E); }
        }
        SEAM(pb + 6);
        if (PH(pb + 7)) { pg8::Epi<3> E{}; E.O = F.ws + WS_GT; E.ldc = DM; E.X = wsb(F, WS_XB); E.alpha = DN_ALPHA;
            run_gemm<3, true, 121, 124>(F, (const bf16_t*)(F.ws + WS_XB8), DM / 2, (const bf16_t*)(wl + W_O), DM / 2, S, DM, DM / 2, 0, E); }
        SEAM(pb + 7);
        if (PH(pb + 8)) phase_ln1(F, args, layer);
        SEAM(pb + 8);
        if (PH(pb + 9)) { pg8::Epi<0> E{}; E.O = wsb(F, WS_H); E.ldc = DM; E.grp = 128; run_gemm<0>(F, wsb(F, WS_XB), DM, (const bf16_t*)(wl + W_PQ), DM, S, DM, DM, 0, E); }
        SEAM(pb + 9);
        if (PH(pb + 10)) phase_peer(F, args, layer, (const bf16_t*)(wl + W_SK), (layer == NL - 1) ? F.out : (float*)nullptr);
        SEAM(pb + 10);
#undef PH
#undef SEAM
}
__global__ void __launch_bounds__(512, 2) fwd_kernel(Args args) {
    extern __shared__ __attribute__((aligned(16))) unsigned char lds_raw[];
    Frame F;
    F.lds = (LAS unsigned char*)lds_raw; F.MISC = (volatile LAS unsigned*)(F.lds + MISC_OFF);
    F.tid = threadIdx.x; F.lane = F.tid & 63; F.wave = __builtin_amdgcn_readfirstlane(F.tid >> 6);
    F.G = gridDim.x; { const int bx = blockIdx.x; F.vcu = (F.G % 8 == 0) ? (bx % 8) * (F.G / 8) + bx / 8 : bx; }
    F.ws = args.ws; F.out = args.out;
    if (F.tid < 64) F.MISC[F.tid] = 0u;
    __syncthreads();
    const int lo = args.ph_lo, hi = args.ph_hi;
    unsigned* barw = (unsigned*)(F.ws + WS_CTL) + CW_BAR + (lo > 0 ? XCD_BAR_WORDS : 0);
    XcdBarrier bar; bar.bar = barw; bar.x = 0; bar.st = F.MISC;
    if (hi - lo > 1) bar = xcd_barrier_post(barw, F.MISC);
#define PH(k) (lo <= (k) && (k) < hi)
#define SEAM(k) do { if (PH(k) && PH((k) + 1)) xcd_barrier(bar); } while (0)
    if (PH(0)) phase_prologue(F, args);
    SEAM(0);
    run_layer(F, args, bar, 0, lo, hi);
    run_layer(F, args, bar, 1, lo, hi);
#undef PH
#undef SEAM
}


#if MK_CHECK
__global__ void __launch_bounds__(512, 1) chk_kernel(Args args, int stage, int layer) {
    extern __shared__ __attribute__((aligned(16))) unsigned char lds_raw[];
    Frame F;
    F.lds = (LAS unsigned char*)lds_raw; F.MISC = (volatile LAS unsigned*)(F.lds + MISC_OFF);
    F.tid = threadIdx.x; F.lane = F.tid & 63; F.wave = __builtin_amdgcn_readfirstlane(F.tid >> 6);
    F.G = gridDim.x; { const int bx = blockIdx.x; F.vcu = (F.G % 8 == 0) ? (bx % 8) * (F.G / 8) + bx / 8 : bx; }
    F.ws = args.ws; F.out = args.out;
    if (stage == 1) { chk::s1(F, args, layer); chk::s2(F, args, layer); chk::s3(F, args, layer); }
    if (stage == 4) chk::s4(F, args, layer);
    if (stage == 5) chk::s5(F, args, layer);
    if (stage == 6) chk::s6(F, args, layer);
    if (stage == 99) chk::poison(F);
}
#endif
extern "C" void kernel_launch(void* const* d_in, const int* in_sizes, int n_in, void* d_out, int out_size, void* d_ws, size_t ws_size, hipStream_t stream) {
    static int grid = 0;
    if (grid == 0) {
        if (n_in != 26 || out_size != S * DM || ws_size < WS_END) { fprintf(stderr, "kernel_launch: unexpected problem (n_in %d, out %d, ws %zu); nothing launched\n", n_in, out_size, ws_size); grid = -1; return; }
        int dev = 0, cus = 0, per_cu = 0;
        if (hipGetDevice(&dev) != hipSuccess || hipDeviceGetAttribute(&cus, hipDeviceAttributeMultiprocessorCount, dev) != hipSuccess) { grid = -1; return; }
        if (hipFuncSetAttribute((const void*)fwd_kernel, hipFuncAttributeMaxDynamicSharedMemorySize, LDS_BYTES) != hipSuccess) { fprintf(stderr, "kernel_launch: hipFuncSetAttribute failed\n"); grid = -1; return; }
        if (hipOccupancyMaxActiveBlocksPerMultiprocessor(&per_cu, (const void*)fwd_kernel, 512, LDS_BYTES) != hipSuccess || per_cu < 1) { fprintf(stderr, "kernel_launch: occupancy query says %d blocks per CU\n", per_cu); }
        (void)hipGetLastError();
        grid = cus;
    }
    if (grid < 0) return;
    (void)hipMemsetAsync((char*)d_ws + WS_CTL, 0, CTL_ZERO_BYTES, stream);
    Args a{};
    for (int i = 0; i < 26; ++i) a.in[i] = (const float*)d_in[i];
    a.out = (float*)d_out; a.ws = (unsigned char*)d_ws;
#if MK_CHECK
    {
        static bool once = false; if (!once) { once = true; (void)hipFuncSetAttribute((const void*)chk_kernel, hipFuncAttributeMaxDynamicSharedMemorySize, LDS_BYTES); }
        const int pb = 1 + MK_CHECK_LAYER * NPL; const int cuts[6] = {0, pb + 4, pb + 6, pb + 7, pb + 8, NPHASES}; const int stg[5] = {1, 4, 5, 6, 0};
        for (int i = 0; i < 5; ++i) { (void)hipMemsetAsync((unsigned*)((char*)d_ws + WS_CTL) + CW_BAR, 0, 2 * XCD_BAR_WORDS * 4, stream); a.ph_lo = cuts[i]; a.ph_hi = cuts[i + 1]; hipLaunchKernelGGL(fwd_kernel, dim3(grid), dim3(512), LDS_BYTES, stream, a);
            if (stg[i]) hipLaunchKernelGGL(chk_kernel, dim3(grid), dim3(512), LDS_BYTES, stream, a, stg[i], MK_CHECK_LAYER); }
        hipLaunchKernelGGL(chk_kernel, dim3(grid), dim3(512), LDS_BYTES, stream, a, 99, 0);
    }
#elif MK_PROBE_REL > -2
    {
        unsigned* ctl = (unsigned*)((char*)d_ws + WS_CTL);
        auto launch = [&](int lo, int hi) { if (hi <= lo) return; (void)hipMemsetAsync(ctl + CW_BAR, 0, 2 * XCD_BAR_WORDS * 4, stream); a.ph_lo = lo; a.ph_hi = hi; hipLaunchKernelGGL(fwd_kernel, dim3(grid), dim3(512), LDS_BYTES, stream, a); };
        int cur = 0;
        const int nl = (MK_PROBE_REL == -1) ? 1 : NL;
        for (int layer = 0; layer < nl; ++layer) {
            const int p = (MK_PROBE_REL == -1) ? 0 : 1 + layer * NPL + MK_PROBE_REL;
            launch(cur, p);
            for (int r = 0; r <= MK_PROBE_REPS; ++r) {
                (void)hipMemsetAsync(ctl + CW_Q, 0, 4096 * 4, stream);
#ifdef MK_PROBE_MIXER
                if (r > 0) { (void)hipMemsetAsync(ctl + CW_Q, 0x04, 4096 * 4, stream); (void)hipMemsetAsync(ctl + CW_Q + layer * 256 + 64 * MK_PROBE_MIXER, 0, 4, stream); }
#endif
                if (MK_PROBE_REL == 10 && r == 0) (void)hipMemcpyAsync((char*)d_ws + WS_GT, (char*)d_ws + WS_XB, (size_t)S * DM * 2, hipMemcpyDeviceToDevice, stream);
                if (MK_PROBE_REL == 10 && r > 0) (void)hipMemcpyAsync((char*)d_ws + WS_XB, (char*)d_ws + WS_GT, (size_t)S * DM * 2, hipMemcpyDeviceToDevice, stream);
                if (MK_PROBE_REL == 3 && r == 0) (void)hipMemcpyAsync((char*)d_ws + WS_PART, (char*)d_ws + WS_QD, (size_t)S * 768 * 2, hipMemcpyDeviceToDevice, stream);
                if (MK_PROBE_REL == 3 && r > 0) { (void)hipMemcpyAsync((char*)d_ws + WS_QD, (char*)d_ws + WS_PART, (size_t)S * 768 * 2, hipMemcpyDeviceToDevice, stream); (void)hipMemsetAsync(ctl + CW_MOBA, 0, 2048 * 4, stream); }
                launch(p, p + 1);
            }
            cur = p + 1;
        }
        launch(cur, NPHASES);
    }
#elif MK_PER_PHASE
    for (int p = 0; p < NPHASES; ++p) { a.ph_lo = p; a.ph_hi = p + 1; hipLaunchKernelGGL(fwd_kernel, dim3(grid), dim3(512), LDS_BYTES, stream, a); }
#else
    a.ph_lo = 0; a.ph_hi = NPHASES;
    hipLaunchKernelGGL(fwd_kernel, dim3(grid), dim3(512), LDS_BYTES, stream, a);
#endif
}
```

```cpp
#include <hip/hip_runtime.h>
#include <cstdio>
#include <cstdint>
#include <cmath>

#define DI __device__ __forceinline__
#define LAS __attribute__((address_space(3)))
#define GAS __attribute__((address_space(1)))
typedef unsigned short bf16_t;
typedef short bf16x8 __attribute__((ext_vector_type(8)));
typedef float f32x4 __attribute__((ext_vector_type(4)));
typedef float f32x2 __attribute__((ext_vector_type(2)));
typedef float f32x16 __attribute__((ext_vector_type(16)));
typedef unsigned u32x4 __attribute__((ext_vector_type(4)));
typedef unsigned u32x2 __attribute__((ext_vector_type(2)));
typedef int i32x4 __attribute__((ext_vector_type(4)));
typedef __bf16 bf16x2_t __attribute__((ext_vector_type(2)));

DI unsigned cvtpk(float lo, float hi) { f32x2 v = {lo, hi}; bf16x2_t b = __builtin_convertvector(v, bf16x2_t); return __builtin_bit_cast(unsigned, b); }
DI float bf_lo(unsigned u) { return __uint_as_float(u << 16); }
DI float bf_hi(unsigned u) { return __uint_as_float(u & 0xffff0000u); }
DI float bf1(bf16_t u) { return __uint_as_float((unsigned)u << 16); }
DI float ex2(float x) { return __builtin_amdgcn_exp2f(x); }
DI float wave_sum(float v) {
#pragma unroll
    for (int o = 1; o < 64; o <<= 1) v += __shfl_xor(v, o);
    return v;
}
DI float xhalf(float v) { return __shfl_xor(v, 32); }

namespace pg8 {
#define PG8_LAS __attribute__((address_space(3)))
#ifndef PG8_WGM
#define PG8_WGM 8
#endif
constexpr int BM = 256, BK = 64, HALF = 128, HTB = HALF * BK * 2  , STAGE_BYTES = 8 * HTB, NXCD = 8, WGM = PG8_WGM;

__host__ __device__ __forceinline__ int lds_byte(int r, int c) { const int st = (r >> 4) * 2 + (c >> 5), rr = r & 15, cc = c & 31, ob = rr * 64 + cc * 2; return st * 1024 + (ob ^ (((ob >> 9) & 1) << 5)); }
__host__ __device__ __forceinline__ void stage_rc(int b, int& R, int& C) { const int st = b / 1024, sb = b % 1024, swz = sb ^ (((sb >> 9) & 1) << 5); R = (st >> 1) * 16 + swz / 64; C = (st & 1) * 32 + (swz % 64) / 2; }
__host__ __device__ __forceinline__ int perm32(int rho) { const int n = rho >> 4, i = rho & 15; return 8 * (i >> 2) + 4 * n + (i & 3); }

struct Unit { int pm, pn; };
struct Gemm { const bf16_t* A; const bf16_t* Bt; int M, N, K, lda, ldb; long apn; };

struct StaticOrder {
    int nM, nN, nwg, G, c;
    __host__ __device__ void init(int M, int N, int G_, int c_) { nM = M / BM; nN = N / BM; nwg = nM * nN; G = G_; c = c_; }
    __host__ __device__ bool next(int i, Unit& u) const {
        const long L = (long)i * G + c; if (L >= nwg) return false;
        int wgid = (int)L; { const int q = nwg / NXCD, r = nwg % NXCD, xcd = wgid % NXCD, off = wgid / NXCD; wgid = (xcd < r ? xcd * (q + 1) : r * (q + 1) + (xcd - r) * q) + off; }
        const int nig = WGM * nN, gid = wgid / nig, fm = gid * WGM, gsz = (nM - fm) < WGM ? (nM - fm) : WGM;
        u.pm = fm + ((wgid % nig) % gsz); u.pn = (wgid % nig) / gsz; return true;
    }
    __device__ __forceinline__ void a_ready(const Unit&) const {}
    __device__ __forceinline__ void done(const Unit&) const {}
};

template <int MODE> struct Epi {
    static constexpr bool PERM = true, AFTER_DRAIN = false;
    void* O; int ldc; int grp; const float* bias; const bf16_t* G; int ldg; const void* X; float alpha; int first; unsigned char* O8;
    __device__ __forceinline__ void operator()(const f32x4 (&acc)[2][2][4][2], const Unit& u, int wr, int wc, int fr, int fq) const {
        const int row0 = u.pm * BM + wr * 64 + fr, colb = u.pn * BM + wc * 32 + 8 * fq;
#pragma unroll
        for (int ai = 0; ai < 2; ++ai)
#pragma unroll
            for (int m = 0; m < 4; ++m) {
                const size_t r = (size_t)(row0 + ai * HALF + m * 16);
#pragma unroll
                for (int bj = 0; bj < 2; ++bj) {
                    const int c = colb + bj * HALF;
                    f32x4 v0 = acc[ai][bj][m][0], v1 = acc[ai][bj][m][1];
                    if constexpr (MODE == 0) {
                        const int dc = (c >> 7) * grp + (c & 127);
                        u32x4 w; w.x = cvtpk(v0[0], v0[1]); w.y = cvtpk(v0[2], v0[3]); w.z = cvtpk(v1[0], v1[1]); w.w = cvtpk(v1[2], v1[3]);
                        *(u32x4*)((bf16_t*)O + r * ldc + dc) = w;
                    } else if constexpr (MODE == 1) {
                        const f32x4 b0 = *(const f32x4*)(bias + c), b1 = *(const f32x4*)(bias + c + 4);
                        v0 = v0 + b0; v1 = v1 + b1;
#pragma unroll
                        for (int e = 0; e < 4; ++e) { v0[e] = __builtin_amdgcn_rcpf(1.0f + ex2(-1.4426950408889634f * v0[e])); v1[e] = __builtin_amdgcn_rcpf(1.0f + ex2(-1.4426950408889634f * v1[e])); }
                        int lo = __builtin_amdgcn_cvt_pk_fp8_f32(v0[0], v0[1], 0, false); lo = __builtin_amdgcn_cvt_pk_fp8_f32(v0[2], v0[3], lo, true);
                        int hi = __builtin_amdgcn_cvt_pk_fp8_f32(v1[0], v1[1], 0, false); hi = __builtin_amdgcn_cvt_pk_fp8_f32(v1[2], v1[3], hi, true);
                        *(u32x2*)((unsigned char*)O + r * ldc + c) = (u32x2){(unsigned)lo, (unsigned)hi};
                    } else if constexpr (MODE == 2) {
                        const u32x2 gq = *(const u32x2*)((const unsigned char*)G + r * ldg + c);
                        const f32x2 g0 = __builtin_amdgcn_cvt_pk_f32_fp8((int)gq.x, false), g1 = __builtin_amdgcn_cvt_pk_f32_fp8((int)gq.x, true), g2 = __builtin_amdgcn_cvt_pk_f32_fp8((int)gq.y, false), g3 = __builtin_amdgcn_cvt_pk_f32_fp8((int)gq.y, true);
                        bf16_t* op = (bf16_t*)O + r * ldc + c;
                        u32x4 old = (u32x4){0u, 0u, 0u, 0u};
                        if (!first) old = *(const u32x4*)op;
                        const float r0 = bf_lo(old.x) + g0.x * v0[0], r1 = bf_hi(old.x) + g0.y * v0[1], r2 = bf_lo(old.y) + g1.x * v0[2], r3 = bf_hi(old.y) + g1.y * v0[3];
                        const float r4 = bf_lo(old.z) + g2.x * v1[0], r5 = bf_hi(old.z) + g2.y * v1[1], r6 = bf_lo(old.w) + g3.x * v1[2], r7 = bf_hi(old.w) + g3.y * v1[3];
                        u32x4 w; w.x = cvtpk(r0, r1); w.y = cvtpk(r2, r3); w.z = cvtpk(r4, r5); w.w = cvtpk(r6, r7);
                        *(u32x4*)op = w;
                        if (O8) {
                            int lo = __builtin_amdgcn_cvt_pk_fp8_f32(r0 * 8.0f, r1 * 8.0f, 0, false); lo = __builtin_amdgcn_cvt_pk_fp8_f32(r2 * 8.0f, r3 * 8.0f, lo, true);
                            int hi = __builtin_amdgcn_cvt_pk_fp8_f32(r4 * 8.0f, r5 * 8.0f, 0, false); hi = __builtin_amdgcn_cvt_pk_fp8_f32(r6 * 8.0f, r7 * 8.0f, hi, true);
                            *(u32x2*)(O8 + r * ldc + c) = (u32x2){(unsigned)lo, (unsigned)hi}; }
                    } else if constexpr (MODE == 3) {
                        const u32x4 xx = *(const u32x4*)((const bf16_t*)X + r * ldc + c);
                        u32x4 w;
                        w.x = cvtpk(bf_lo(xx.x) * alpha + v0[0], bf_hi(xx.x) * alpha + v0[1]); w.y = cvtpk(bf_lo(xx.y) * alpha + v0[2], bf_hi(xx.y) * alpha + v0[3]);
                        w.z = cvtpk(bf_lo(xx.z) * alpha + v1[0], bf_hi(xx.z) * alpha + v1[1]); w.w = cvtpk(bf_lo(xx.w) * alpha + v1[2], bf_hi(xx.w) * alpha + v1[3]);
                        *(u32x4*)((bf16_t*)O + r * ldc + c) = w;
                    } else {
                        *(f32x4*)((float*)O + r * ldc + c) = v0; *(f32x4*)((float*)O + r * ldc + c + 4) = v1;
                    }
                }
            }
    }
};

template <class Epi, class Sched, bool ALIGN_EPI = false, bool SP2 = false, bool F8 = false, int SC0 = 127, int SC1 = 127, bool F4 = false>
__device__ __forceinline__ void gemm_phase(PG8_LAS unsigned char* lds, const Gemm g, const Sched& S, const Epi& E) {
    int tid_ = threadIdx.x; asm volatile("" : "+v"(tid_));
    const int tid = tid_, wid = __builtin_amdgcn_readfirstlane(tid >> 6), lane = tid & 63, wr = wid >> 2, wc = wid & 3, fr = lane & 15, fq = lane >> 4;
    const int K = g.K, nt = K / BK;
    unsigned voffA[2], voffB[2];
#pragma unroll
    for (int i = 0; i < 2; ++i) { int R, C; stage_rc(tid * 16 + i * 8192, R, C); const int Rb = Epi::PERM ? ((R & ~31) + perm32(R & 31)) : R;
        voffA[i] = (unsigned)(R * g.lda + C) * 2u; voffB[i] = (unsigned)(Rb * g.ldb + C) * 2u; }
    const size_t kstep = (size_t)(BK * 2);
    const size_t hstepA = (size_t)HALF * g.lda * 2, hstepB = (size_t)HALF * g.ldb * 2;
    const size_t tstepA = 2 * hstepA, tstepB = 2 * hstepB;
    const unsigned ldsw = (unsigned)wid * 1024u;
    const int aoff = lds_byte(wr * 64 + fr, fq * 8), boff = lds_byte(wc * 32 + fr, fq * 8);

#define PG8_SA(b, h) (((b) * 2 + (h)) * HTB)
#define PG8_SB(b, h) ((4 + (b) * 2 + (h)) * HTB)
#define PG8_STAGE(bufoff, gbase, voff) do { _Pragma("unroll") for (int _i = 0; _i < 2; ++_i) \
        __builtin_amdgcn_global_load_lds((const unsigned*)((const char*)(gbase) + (voff)[_i]), (PG8_LAS unsigned*)(lds + (bufoff) + ldsw + _i * 8192), 16, 0, 0); } while (0)
#define PG8_LDA(dst, b, h) do { _Pragma("unroll") for (int m = 0; m < 4; ++m) { if constexpr (F8) { const v4i_t lo_ = *(const PG8_LAS v4i_t*)(lds + PG8_SA(b, h) + aoff + m * 2048), hi_ = *(const PG8_LAS v4i_t*)(lds + PG8_SA(b, h) + aoff + m * 2048 + 1024); dst##8[m] = __builtin_shufflevector(lo_, hi_, 0, 1, 2, 3, 4, 5, 6, 7); } else { _Pragma("unroll") for (int k = 0; k < 2; ++k) dst[m][k] = *(const PG8_LAS bf16x8*)(lds + PG8_SA(b, h) + aoff + m * 2048 + k * 1024); } } } while (0)
#define PG8_LDB(dst, b, h) do { _Pragma("unroll") for (int n = 0; n < 2; ++n) { if constexpr (F8) { const v4i_t lo_ = *(const PG8_LAS v4i_t*)(lds + PG8_SB(b, h) + boff + n * 2048), hi_ = *(const PG8_LAS v4i_t*)(lds + PG8_SB(b, h) + boff + n * 2048 + 1024); dst##8[n] = __builtin_shufflevector(lo_, hi_, 0, 1, 2, 3, 4, 5, 6, 7); } else { _Pragma("unroll") for (int k = 0; k < 2; ++k) dst[n][k] = *(const PG8_LAS bf16x8*)(lds + PG8_SB(b, h) + boff + n * 2048 + k * 1024); } } } while (0)
#define PG8_MMA(ai, bj, At, Bt) do { __builtin_amdgcn_s_setprio(1); \
        if constexpr (F8) {   \
            asm volatile("s_nop 1\n\t" \
            "v_mfma_scale_f32_16x16x128_f8f6f4 %0, %12, %8, %0, %14, %15 op_sel_hi:[0,0,0]\n\t"  \
            "v_mfma_scale_f32_16x16x128_f8f6f4 %1, %13, %8, %1, %14, %15 op_sel_hi:[0,0,0]\n\t"  \
            "v_mfma_scale_f32_16x16x128_f8f6f4 %2, %12, %9, %2, %14, %15 op_sel_hi:[0,0,0]\n\t"  \
            "v_mfma_scale_f32_16x16x128_f8f6f4 %3, %13, %9, %3, %14, %15 op_sel_hi:[0,0,0]\n\t"  \
            "v_mfma_scale_f32_16x16x128_f8f6f4 %4, %12, %10, %4, %14, %15 op_sel_hi:[0,0,0]\n\t"  \
            "v_mfma_scale_f32_16x16x128_f8f6f4 %5, %13, %10, %5, %14, %15 op_sel_hi:[0,0,0]\n\t"  \
            "v_mfma_scale_f32_16x16x128_f8f6f4 %6, %12, %11, %6, %14, %15 op_sel_hi:[0,0,0]\n\t"  \
            "v_mfma_scale_f32_16x16x128_f8f6f4 %7, %13, %11, %7, %14, %15 op_sel_hi:[0,0,0]\n\t"  \
                : "+v"(acc[ai][bj][0][0]), "+v"(acc[ai][bj][0][1]), "+v"(acc[ai][bj][1][0]), "+v"(acc[ai][bj][1][1]), "+v"(acc[ai][bj][2][0]), "+v"(acc[ai][bj][2][1]), "+v"(acc[ai][bj][3][0]), "+v"(acc[ai][bj][3][1]) \
                : "v"(At##8[0]), "v"(At##8[1]), "v"(At##8[2]), "v"(At##8[3]), "v"(Bt##8[0]), "v"(Bt##8[1]), "v"(sc0), "v"(sc1)); \
        } else if constexpr (F4) { \
            asm volatile("s_nop 1\n\t" \
            "v_mfma_scale_f32_16x16x128_f8f6f4 %0, %16, %8, %0, %20, %21 op_sel_hi:[0,0,0] cbsz:4 blgp:4\n\t"  \
            "v_mfma_scale_f32_16x16x128_f8f6f4 %0, %17, %9, %0, %20, %21 op_sel_hi:[0,0,0] cbsz:4 blgp:4\n\t"  \
            "v_mfma_scale_f32_16x16x128_f8f6f4 %1, %18, %8, %1, %20, %21 op_sel_hi:[0,0,0] cbsz:4 blgp:4\n\t"  \
            "v_mfma_scale_f32_16x16x128_f8f6f4 %1, %19, %9, %1, %20, %21 op_sel_hi:[0,0,0] cbsz:4 blgp:4\n\t"  \
            "v_mfma_scale_f32_16x16x128_f8f6f4 %2, %16, %10, %2, %20, %21 op_sel_hi:[0,0,0] cbsz:4 blgp:4\n\t"  \
            "v_mfma_scale_f32_16x16x128_f8f6f4 %2, %17, %11, %2, %20, %21 op_sel_hi:[0,0,0] cbsz:4 blgp:4\n\t"  \
            "v_mfma_scale_f32_16x16x128_f8f6f4 %3, %18, %10, %3, %20, %21 op_sel_hi:[0,0,0] cbsz:4 blgp:4\n\t"  \
            "v_mfma_scale_f32_16x16x128_f8f6f4 %3, %19, %11, %3, %20, %21 op_sel_hi:[0,0,0] cbsz:4 blgp:4\n\t"  \
            "v_mfma_scale_f32_16x16x128_f8f6f4 %4, %16, %12, %4, %20, %21 op_sel_hi:[0,0,0] cbsz:4 blgp:4\n\t"  \
            "v_mfma_scale_f32_16x16x128_f8f6f4 %4, %17, %13, %4, %20, %21 op_sel_hi:[0,0,0] cbsz:4 blgp:4\n\t"  \
            "v_mfma_scale_f32_16x16x128_f8f6f4 %5, %18, %12, %5, %20, %21 op_sel_hi:[0,0,0] cbsz:4 blgp:4\n\t"  \
            "v_mfma_scale_f32_16x16x128_f8f6f4 %5, %19, %13, %5, %20, %21 op_sel_hi:[0,0,0] cbsz:4 blgp:4\n\t"  \
            "v_mfma_scale_f32_16x16x128_f8f6f4 %6, %16, %14, %6, %20, %21 op_sel_hi:[0,0,0] cbsz:4 blgp:4\n\t"  \
            "v_mfma_scale_f32_16x16x128_f8f6f4 %6, %17, %15, %6, %20, %21 op_sel_hi:[0,0,0] cbsz:4 blgp:4\n\t"  \
            "v_mfma_scale_f32_16x16x128_f8f6f4 %7, %18, %14, %7, %20, %21 op_sel_hi:[0,0,0] cbsz:4 blgp:4\n\t"  \
            "v_mfma_scale_f32_16x16x128_f8f6f4 %7, %19, %15, %7, %20, %21 op_sel_hi:[0,0,0] cbsz:4 blgp:4\n\t"  \
                : "+v"(acc[ai][bj][0][0]), "+v"(acc[ai][bj][0][1]), "+v"(acc[ai][bj][1][0]), "+v"(acc[ai][bj][1][1]), "+v"(acc[ai][bj][2][0]), "+v"(acc[ai][bj][2][1]), "+v"(acc[ai][bj][3][0]), "+v"(acc[ai][bj][3][1]) \
                : "v"(At[0][0]), "v"(At[0][1]), "v"(At[1][0]), "v"(At[1][1]), "v"(At[2][0]), "v"(At[2][1]), "v"(At[3][0]), "v"(At[3][1]), "v"(Bt[0][0]), "v"(Bt[0][1]), "v"(Bt[1][0]), "v"(Bt[1][1]), "v"(sc0), "v"(sc1)); \
        } else { _Pragma("unroll") for (int m = 0; m < 4; ++m) _Pragma("unroll") for (int n = 0; n < 2; ++n) _Pragma("unroll") for (int k = 0; k < 2; ++k) \
            acc[ai][bj][m][n] = __builtin_amdgcn_mfma_f32_16x16x32_bf16(Bt[n][k], At[m][k], acc[ai][bj][m][n], 0, 0, 0); } \
        __builtin_amdgcn_s_setprio(0); } while (0)
#define PG8_WAIT_V(n) asm volatile("s_waitcnt vmcnt(" #n ")" ::: "memory")
#define PG8_WAIT_L(n) asm volatile("s_waitcnt lgkmcnt(" #n ")" ::: "memory")
#define PG8_BAR __builtin_amdgcn_s_barrier()
#define PG8_SCHED __builtin_amdgcn_sched_barrier(0)
    Unit cur, nxt; int ui = 0;
    if (!S.next(0, cur)) return;
    f32x4 acc[2][2][4][2];
#pragma unroll
    for (int a = 0; a < 2; ++a)
#pragma unroll
        for (int b = 0; b < 2; ++b)
#pragma unroll
            for (int m = 0; m < 4; ++m)
#pragma unroll
                for (int n = 0; n < 2; ++n) acc[a][b][m][n] = (f32x4){0.f, 0.f, 0.f, 0.f};
    bf16x8 At[4][2], B0[2][2], B1[2][2];
    typedef int v8i_t __attribute__((ext_vector_type(8))); typedef int v4i_t __attribute__((ext_vector_type(4)));
    v8i_t At8[4], B08[2], B18[2];
    int sc0 = SC0 * 0x01010101, sc1 = SC1 * 0x01010101; asm volatile("" : "+v"(sc0), "+v"(sc1));
    const char* cA = (const char*)g.A + (size_t)cur.pm * tstepA + (size_t)cur.pn * g.apn; const char* cB = (const char*)g.Bt + (size_t)cur.pn * tstepB;
    S.a_ready(cur);
    if constexpr (SP2) {
        PG8_STAGE(PG8_SB(0, 0), cB, voffB); PG8_STAGE(PG8_SB(0, 1), cB + hstepB, voffB); PG8_STAGE(PG8_SA(0, 0), cA, voffA); PG8_STAGE(PG8_SA(0, 1), cA + hstepA, voffA);
        if (wr == 1) PG8_BAR;
        PG8_WAIT_V(2); PG8_BAR;
        PG8_STAGE(PG8_SB(1, 0), cB + kstep, voffB); PG8_STAGE(PG8_SA(1, 0), cA + kstep, voffA); PG8_STAGE(PG8_SB(1, 1), cB + hstepB + kstep, voffB);
        PG8_WAIT_V(6); PG8_BAR;
    } else {
        PG8_STAGE(PG8_SB(0, 0), cB, voffB); PG8_STAGE(PG8_SA(0, 0), cA, voffA); PG8_STAGE(PG8_SB(0, 1), cB + hstepB, voffB); PG8_STAGE(PG8_SA(0, 1), cA + hstepA, voffA);
        if (wr == 1) PG8_BAR;
        PG8_WAIT_V(4); PG8_BAR;
        PG8_STAGE(PG8_SB(1, 0), cB + kstep, voffB); PG8_STAGE(PG8_SA(1, 0), cA + kstep, voffA); PG8_STAGE(PG8_SB(1, 1), cB + hstepB + kstep, voffB);
        PG8_WAIT_V(6); PG8_BAR;
    }
    for (;;) {
        const bool has_next = S.next(ui + 1, nxt);
        const char* nA = has_next ? (const char*)g.A + (size_t)nxt.pm * tstepA + (size_t)nxt.pn * g.apn : cA; const char* nB = has_next ? (const char*)g.Bt + (size_t)nxt.pn * tstepB : cB;
        for (int t = 0; t < nt; t += 2) {
            const bool last = (t == nt - 2);
            const char* a1 = cA + (size_t)(t + 1) * kstep;
            const char* a2 = last ? nA : cA + (size_t)(t + 2) * kstep; const char* b2 = last ? nB : cB + (size_t)(t + 2) * kstep;
            const char* a3 = a2 + kstep; const char* b3 = b2 + kstep;
            if (last && has_next) S.a_ready(nxt);
            if constexpr (SP2) {
            PG8_LDB(B0, 0, 0); PG8_LDB(B1, 0, 1); PG8_SCHED; PG8_LDA(At, 0, 0); PG8_STAGE(PG8_SA(1, 1), a1 + hstepA, voffA);
            PG8_WAIT_V(8); PG8_WAIT_L(0); PG8_BAR; PG8_MMA(0, 0, At, B0); PG8_MMA(0, 1, At, B1); PG8_BAR; PG8_SCHED;
            PG8_LDA(At, 0, 1); PG8_STAGE(PG8_SB(0, 0), b2, voffB); PG8_STAGE(PG8_SB(0, 1), b2 + hstepB, voffB); PG8_STAGE(PG8_SA(0, 0), a2, voffA);
            PG8_WAIT_V(8); PG8_WAIT_L(0); PG8_BAR; PG8_MMA(1, 0, At, B0); PG8_MMA(1, 1, At, B1); PG8_BAR; PG8_SCHED;
            PG8_LDB(B0, 1, 0); PG8_LDB(B1, 1, 1); PG8_SCHED; PG8_LDA(At, 1, 0); PG8_STAGE(PG8_SA(0, 1), a2 + hstepA, voffA);
            PG8_WAIT_V(8); PG8_WAIT_L(0); PG8_BAR; PG8_MMA(0, 0, At, B0); PG8_MMA(0, 1, At, B1); PG8_BAR; PG8_SCHED;
            PG8_LDA(At, 1, 1); PG8_STAGE(PG8_SB(1, 0), b3, voffB); PG8_STAGE(PG8_SB(1, 1), b3 + hstepB, voffB); PG8_STAGE(PG8_SA(1, 0), a3, voffA);
            PG8_WAIT_V(8); PG8_WAIT_L(0); PG8_BAR; PG8_MMA(1, 0, At, B0); PG8_MMA(1, 1, At, B1); PG8_BAR; PG8_SCHED;
            } else {
            PG8_LDB(B0, 0, 0); PG8_SCHED; PG8_LDA(At, 0, 0); PG8_STAGE(PG8_SA(1, 1), a1 + hstepA, voffA);
            PG8_WAIT_L(8); PG8_BAR; PG8_WAIT_L(0); PG8_MMA(0, 0, At, B0); PG8_BAR; PG8_SCHED;
            PG8_LDB(B1, 0, 1); PG8_STAGE(PG8_SB(0, 0), b2, voffB);
            PG8_BAR; PG8_WAIT_L(0); PG8_MMA(0, 1, At, B1); PG8_BAR;
            PG8_LDA(At, 0, 1); PG8_STAGE(PG8_SA(0, 0), a2, voffA);
            PG8_BAR; PG8_WAIT_L(0); PG8_MMA(1, 0, At, B0); PG8_BAR; PG8_SCHED;
            PG8_STAGE(PG8_SB(0, 1), b2 + hstepB, voffB);
            PG8_WAIT_V(6); PG8_BAR; PG8_MMA(1, 1, At, B1); PG8_BAR;
            PG8_LDB(B0, 1, 0); PG8_SCHED; PG8_LDA(At, 1, 0); PG8_STAGE(PG8_SA(0, 1), a2 + hstepA, voffA);
            PG8_WAIT_L(8); PG8_BAR; PG8_WAIT_L(0); PG8_MMA(0, 0, At, B0); PG8_BAR; PG8_SCHED;
            PG8_LDB(B1, 1, 1); PG8_STAGE(PG8_SB(1, 0), b3, voffB);
            PG8_BAR; PG8_WAIT_L(0); PG8_MMA(0, 1, At, B1); PG8_BAR;
            PG8_LDA(At, 1, 1); PG8_STAGE(PG8_SA(1, 0), a3, voffA);
            PG8_BAR; PG8_WAIT_L(0); PG8_MMA(1, 0, At, B0); PG8_BAR; PG8_SCHED;
            PG8_STAGE(PG8_SB(1, 1), b3 + hstepB, voffB);
            PG8_WAIT_V(6); PG8_BAR; PG8_MMA(1, 1, At, B1); PG8_BAR;
            }
        }
        if constexpr (F8 || F4) {
#pragma unroll
            for (int a_ = 0; a_ < 2; ++a_) asm volatile("s_nop 15\n\ts_nop 7" : "+v"(acc[a_][0][0][0]), "+v"(acc[a_][0][0][1]), "+v"(acc[a_][0][1][0]), "+v"(acc[a_][0][1][1]), "+v"(acc[a_][0][2][0]), "+v"(acc[a_][0][2][1]), "+v"(acc[a_][0][3][0]), "+v"(acc[a_][0][3][1]),
                "+v"(acc[a_][1][0][0]), "+v"(acc[a_][1][0][1]), "+v"(acc[a_][1][1][0]), "+v"(acc[a_][1][1][1]), "+v"(acc[a_][1][2][0]), "+v"(acc[a_][1][2][1]), "+v"(acc[a_][1][3][0]), "+v"(acc[a_][1][3][1]));
        }
        if constexpr (ALIGN_EPI) { if (wr == 0) PG8_BAR; }
        if constexpr (!Epi::AFTER_DRAIN) { E(acc, cur, wr, wc, fr, fq); S.done(cur); }
        if (!has_next) break;
#pragma unroll
        for (int a = 0; a < 2; ++a)
#pragma unroll
            for (int b = 0; b < 2; ++b)
#pragma unroll
                for (int m = 0; m < 4; ++m)
#pragma unroll
                    for (int n = 0; n < 2; ++n) acc[a][b][m][n] = (f32x4){0.f, 0.f, 0.f, 0.f};
        cur = nxt; cA = nA; cB = nB; ++ui;
        if constexpr (ALIGN_EPI) { if (wr == 1) PG8_BAR; }
    }
    PG8_WAIT_V(0);
    if constexpr (!ALIGN_EPI) { if (wr == 0) PG8_BAR; }
    PG8_BAR;
    if constexpr (Epi::AFTER_DRAIN) { E.fused(acc, cur, wr, wc, fr, fq, lds, wid, lane); S.done(cur); }
#undef PG8_SA
#undef PG8_SB
#undef PG8_STAGE
#undef PG8_LDA
#undef PG8_LDB
#undef PG8_MMA
#undef PG8_WAIT_V
#undef PG8_WAIT_L
#undef PG8_BAR
#undef PG8_SCHED
}
}

constexpr int S = 16384, DM = 2048, NL = 2, NWAVES = 8;
constexpr int HW = 3584;
constexpr int H_AQ = 0, H_AK = 512, H_BQ = 1024, H_BK = 1536, H_CQ = 1664, H_CK = 2176, H_DCQ = 2688, H_DCKV = 3200, H_DKR = 3456;
constexpr int VT_A = 0, VT_B = 512, VT_C = 640, VT_ROWS = 1280;
constexpr int WIN_ROWS = HW + VT_ROWS;
constexpr float LOG2E = 1.4426950408889634f;
constexpr float DN_ALPHA = 1.4142135623730951f;
constexpr size_t MiB = 1u << 20;
constexpr size_t WS_CTL = 0, CTL_ZERO_BYTES = 1 * MiB;
constexpr size_t WS_W = 1 * MiB, WL_STRIDE = 78 * MiB;
constexpr size_t W_IN = 0, W_G = 19 * MiB, W_BR = 51 * MiB, W_O = 59 * MiB, W_UQ = 67 * MiB, W_UKV = 68 * MiB, W_PQ = 69 * MiB, W_SK = 77 * MiB;
constexpr size_t WS_UB = 157 * MiB, WS_VB = 221 * MiB;
constexpr size_t WS_MLIST = 189 * MiB;
constexpr int MCAP_F = 16384, MCAP = MCAP_F + 4096;
constexpr size_t WS_PART = 926 * MiB;
constexpr size_t WS_CS = 245 * MiB;
constexpr size_t WS_XB8 = 253 * MiB;
constexpr size_t WS_XB = 285 * MiB;
constexpr size_t WS_H = 349 * MiB;
constexpr size_t WS_VT = 461 * MiB;
constexpr size_t WS_GT = 501 * MiB;
constexpr size_t WS_O8 = 629 * MiB;
constexpr size_t WS_XB4 = 661 * MiB;
constexpr size_t WS_O = 757 * MiB;
constexpr size_t WS_QD = 821 * MiB, WS_KD = 845 * MiB, WS_VDT = 869 * MiB, WS_CQN = 885 * MiB, WS_CKVN = 901 * MiB;
constexpr size_t WS_SELE = 909 * MiB, WS_SELG = 917 * MiB, WS_KMEAN = 925 * MiB, WS_TPMAX = 925 * MiB + 512 * 1024, WS_OC2 = 994 * MiB, WS_END = 1010 * MiB;
constexpr int CW_BAR = 4096, CW_Q = 16384, CW_CHK = 20480, CW_MOBA = 24576;
constexpr int RING_BYTES = 131072;
constexpr int MISC_OFF = RING_BYTES;
constexpr int TR_OFF = 0;
constexpr int LDS_BYTES = 147456;

constexpr float U_SCALE = 90.0f, V_SCALE = 4.0f;
#define XB_TMO      128
#define XB_XCNT(j)  (256  + 64 * (j))
#define XB_XSUB(j)  (1280 + 64 * (j))
#define XB_XGEN(j)  (2304 + 64 * (j))
#define XB_TOP      3328
#define XB_TOPGEN   3392
#define XCD_BAR_WORDS 3456
#define XB_SPIN_CAP (1u << 18)

__device__ __forceinline__ unsigned xb_ld(unsigned* p)              { return __hip_atomic_load(p, __ATOMIC_RELAXED, __HIP_MEMORY_SCOPE_AGENT); }
__device__ __forceinline__ unsigned xb_add(unsigned* p, unsigned v) { return __hip_atomic_fetch_add(p, v, __ATOMIC_RELAXED, __HIP_MEMORY_SCOPE_AGENT); }
__device__ __forceinline__ unsigned xb_xcc_id() { return (unsigned)__builtin_amdgcn_s_getreg((3 << 11) | 20) & 0xFu; }
#define XB_SPIN(cond, bar) do { unsigned _sp = 0; while (cond) { __builtin_amdgcn_s_sleep(1); \
    if ((++_sp & 255u) == 0u) { if (xb_ld(&(bar)[XB_TMO])) break; if (_sp > XB_SPIN_CAP) { atomicAdd(&(bar)[XB_TMO], 1u); break; } } } } while (0)

struct XcdBarrier {
    unsigned* bar; unsigned x;
    volatile LAS unsigned* st;
};

__device__ __forceinline__ XcdBarrier xcd_barrier_post(unsigned* bar, volatile LAS unsigned* st) {
    XcdBarrier b; b.bar = bar; b.x = xb_xcc_id(); b.st = st;
    if (threadIdx.x == 0) (void)xb_add(&bar[XB_XCNT(b.x)], 1u);
    return b;
}
__device__ __forceinline__ void xcd_barrier_complete(unsigned* bar, unsigned x, unsigned& nloc, unsigned& nx) {
    const unsigned G = gridDim.x * gridDim.y * gridDim.z;
    unsigned sum, cnt, mine, sp = 0u;
    for (;;) {
        sum = 0u; cnt = 0u; mine = 0u;
#pragma unroll
        for (unsigned j = 0; j < 16; ++j) { const unsigned c = xb_ld(&bar[XB_XCNT(j)]); sum += c; cnt += (c > 0u) ? 1u : 0u; mine = (j == x) ? c : mine; }
        if (sum == G) break;
        __builtin_amdgcn_s_sleep(1);
        if ((++sp & 255u) == 0u) { if (xb_ld(&bar[XB_TMO])) break; if (sp > XB_SPIN_CAP) { atomicAdd(&bar[XB_TMO], 1u); break; } }
    }
    nloc = mine > 0u ? mine : 1u; nx = cnt > 0u ? cnt : 1u;
}

__device__ __forceinline__ void xcd_barrier(const XcdBarrier& b) {
    asm volatile("s_waitcnt vmcnt(0)" ::: "memory");
    __syncthreads();
    if (threadIdx.x == 0) {
        unsigned* bar = b.bar;
        __builtin_amdgcn_s_waitcnt(0);
        unsigned nloc = b.st[0], nx = b.st[1];
        if (nloc == 0u) { xcd_barrier_complete(bar, b.x, nloc, nx); b.st[0] = nloc; b.st[1] = nx; }
        const unsigned old = xb_add(&bar[XB_XSUB(b.x)], 1u);
        const unsigned gen = old / nloc;
        if (old + 1u == (gen + 1u) * nloc) {
            __builtin_amdgcn_fence(__ATOMIC_RELEASE, "agent");
            asm volatile("s_waitcnt vmcnt(0)" ::: "memory");
            const unsigned og = xb_add(&bar[XB_TOP], 1u);
            const unsigned tg = og / nx;
            if (og + 1u == (tg + 1u) * nx) xb_add(&bar[XB_TOPGEN], 1u);
            else XB_SPIN(xb_ld(&bar[XB_TOPGEN]) == tg, bar);
            __builtin_amdgcn_fence(__ATOMIC_ACQUIRE, "agent");
            xb_add(&bar[XB_XGEN(b.x)], 1u);
            asm volatile("s_waitcnt vmcnt(0)" ::: "memory");
        } else {
            XB_SPIN(xb_ld(&bar[XB_XGEN(b.x)]) == gen, bar);
            __builtin_amdgcn_fence(__ATOMIC_ACQUIRE, "agent");
            asm volatile("s_waitcnt vmcnt(0)" ::: "memory");
        }
    }
    __syncthreads();
}

struct Args { const float* in[26]; float* out; unsigned char* ws; int ph_lo, ph_hi; };
struct Frame {
    LAS unsigned char* lds; volatile LAS unsigned* MISC;
    int tid, lane, wave, vcu, G;
    unsigned char* ws; float* out;
};
DI bf16_t* wsb(const Frame& F, size_t off) { return (bf16_t*)(F.ws + off); }

DI void transpose_item(const float* W, int ldw, bf16_t* WT, int ldt, int k0, int n0, int drow0, LAS float* scr, int lane) {
#pragma unroll 8
    for (int i = 0; i < 32; ++i) { const int kk = 2 * i + (lane >> 5); scr[kk * 33 + (lane & 31)] = W[(size_t)(k0 + kk) * ldw + n0 + (lane & 31)]; }
    asm volatile("s_waitcnt lgkmcnt(0)" ::: "memory");
    const int c = lane & 7;
#pragma unroll
    for (int j = 0; j < 4; ++j) { const int n = (lane >> 3) + 8 * j; const LAS float* s = scr + (8 * c) * 33 + n;
        u32x4 o; o.x = cvtpk(s[0 * 33], s[1 * 33]); o.y = cvtpk(s[2 * 33], s[3 * 33]); o.z = cvtpk(s[4 * 33], s[5 * 33]); o.w = cvtpk(s[6 * 33], s[7 * 33]);
        *(u32x4*)(WT + (size_t)(drow0 + n) * ldt + k0 + 8 * c) = o; }
    asm volatile("s_waitcnt lgkmcnt(0)" ::: "memory");
}
DI void transpose_item8(const float* W, int ldw, unsigned char* WT, int ldt, int k0, int n0, int drow0, LAS float* scr, int lane, float scale) {
#pragma unroll 8
    for (int i = 0; i < 32; ++i) { const int kk = 2 * i + (lane >> 5); scr[kk * 33 + (lane & 31)] = W[(size_t)(k0 + kk) * ldw + n0 + (lane & 31)]; }
    asm volatile("s_waitcnt lgkmcnt(0)" ::: "memory");
    const int c = lane & 7;
#pragma unroll
    for (int j = 0; j < 4; ++j) { const int n = (lane >> 3) + 8 * j; const LAS float* s = scr + (8 * c) * 33 + n;
        int lo = __builtin_amdgcn_cvt_pk_fp8_f32(s[0 * 33] * scale, s[1 * 33] * scale, 0, false); lo = __builtin_amdgcn_cvt_pk_fp8_f32(s[2 * 33] * scale, s[3 * 33] * scale, lo, true);
        int hi = __builtin_amdgcn_cvt_pk_fp8_f32(s[4 * 33] * scale, s[5 * 33] * scale, 0, false); hi = __builtin_amdgcn_cvt_pk_fp8_f32(s[6 * 33] * scale, s[7 * 33] * scale, hi, true);
        *(u32x2*)(WT + (size_t)(drow0 + n) * ldt + k0 + 8 * c) = (u32x2){(unsigned)lo, (unsigned)hi}; }
    asm volatile("s_waitcnt lgkmcnt(0)" ::: "memory");
}
DI void transpose_item4(const float* W, int ldw, unsigned char* WT, int ldt, int k0, int n0, int drow0, LAS float* scr, int lane, float scale) {
#pragma unroll 8
    for (int i = 0; i < 32; ++i) { const int kk = 2 * i + (lane >> 5); scr[kk * 33 + (lane & 31)] = W[(size_t)(k0 + kk) * ldw + n0 + (lane & 31)]; }
    asm volatile("s_waitcnt lgkmcnt(0)" ::: "memory");
    const int c = lane & 7;
#pragma unroll
    for (int j = 0; j < 4; ++j) { const int n = (lane >> 3) + 8 * j; const LAS float* s = scr + (8 * c) * 33 + n;
        unsigned d = 0u;
        d = __builtin_amdgcn_cvt_scalef32_pk_fp4_f32(d, s[0 * 33] * scale, s[1 * 33] * scale, 1.0f, 0); d = __builtin_amdgcn_cvt_scalef32_pk_fp4_f32(d, s[2 * 33] * scale, s[3 * 33] * scale, 1.0f, 1);
        d = __builtin_amdgcn_cvt_scalef32_pk_fp4_f32(d, s[4 * 33] * scale, s[5 * 33] * scale, 1.0f, 2); d = __builtin_amdgcn_cvt_scalef32_pk_fp4_f32(d, s[6 * 33] * scale, s[7 * 33] * scale, 1.0f, 3);
        *(unsigned*)(WT + (size_t)(drow0 + n) * ldt + (k0 >> 1) + 4 * c) = d; }
    asm volatile("s_waitcnt lgkmcnt(0)" ::: "memory");
}
DI int win_map(int c) {
    if (c < 1024) return c;
    if (c < 1536) return HW + VT_A + (c - 1024);
    if (c < 2176) return H_BQ + (c - 1536);
    if (c < 2304) return HW + VT_B + (c - 2176);
    if (c < 3328) return H_CQ + (c - 2304);
    if (c < 3840) return HW + VT_C + (c - 3328);
    return H_DCQ + (c - 3840);
}
template <int MAP, bool F8 = false, bool F4 = false> DI void transpose_matrix(const Frame& F, const float* W, int K, int N, bf16_t* WT, int roff) {
    LAS float* scr = (LAS float*)(F.lds + TR_OFF + F.wave * 8704);
    const int gw = F.vcu * NWAVES + F.wave, NGW = F.G * NWAVES, nblk = N / 32, items = (K / 64) * nblk;
    int lane = F.lane; asm volatile("" : "+v"(lane));
    for (int it = gw; it < items; it += NGW) {
        const int kb = it / nblk, nb = it % nblk, n0 = 32 * nb;
        int drow = roff + n0;
        if (MAP == 1) drow = win_map(n0);
        if (MAP == 2) { const int h = n0 >> 8, j = n0 & 255; drow = (j < 128) ? h * 128 + j : 512 + h * 128 + (j - 128); }
        if (F4) transpose_item4(W, N, (unsigned char*)WT, K / 2, 64 * kb, n0, drow, scr, lane, 64.0f); else if (F8) transpose_item8(W, N, (unsigned char*)WT, K, 64 * kb, n0, drow, scr, lane, 64.0f); else transpose_item(W, N, WT, K, 64 * kb, n0, drow, scr, lane);
    }
}
DI void convert_bf16(const Frame& F, const float* src, bf16_t* dst, size_t n) {
    const size_t nth = (size_t)F.G * 512, t0 = (size_t)F.vcu * 512 + F.tid;
    for (size_t i = t0; i < n / 8; i += nth) { const f32x4 a = *(const f32x4*)(src + 8 * i), b = *(const f32x4*)(src + 8 * i + 4);
        u32x4 w; w.x = cvtpk(a[0], a[1]); w.y = cvtpk(a[2], a[3]); w.z = cvtpk(b[0], b[1]); w.w = cvtpk(b[2], b[3]); *(u32x4*)(dst + 8 * i) = w; }
}

typedef float v16f __attribute__((ext_vector_type(16)));
typedef float v32f __attribute__((ext_vector_type(32)));
typedef unsigned v6u __attribute__((ext_vector_type(6)));
DI void convert_fp6(const Frame& F, const float* src, unsigned char* dst, int rows, float scale) {
    const size_t nth = (size_t)F.G * 512, t0 = (size_t)F.vcu * 512 + F.tid;
    for (size_t i = t0; i < (size_t)rows * 64; i += nth) {
        const size_t row = i >> 6; const int l = (int)(i & 63);
        const float* p = src + row * 2048 + 32 * l;
        v16f a, b;
#pragma unroll
        for (int q = 0; q < 8; ++q) { const f32x4 x = *(const f32x4*)(p + 4 * q) * scale;
            a[2 * q] = x[0]; b[2 * q] = x[1]; a[2 * q + 1] = x[2]; b[2 * q + 1] = x[3]; }
        const v6u w = __builtin_amdgcn_cvt_scalef32_2xpk16_fp6_f32(a, b, 1.0f);
        *(u32x4*)(dst + row * 1536 + 16 * l) = (u32x4){w[0], w[1], w[2], w[3]};
        *(u32x2*)(dst + row * 1536 + 1024 + 8 * l) = (u32x2){w[4], w[5]};
    }
}

DI void convert_fp4(const Frame& F, const float* src, unsigned char* dst, int rows, float scale) {
    const size_t nth = (size_t)F.G * 512, t0 = (size_t)F.vcu * 512 + F.tid;
    for (size_t i = t0; i < (size_t)rows * 64; i += nth) {
        const float* p = src + i * 32;
        u32x4 w = (u32x4){0u, 0u, 0u, 0u};
#define FP4_PK(q) { const f32x4 x = *(const f32x4*)(p + 4 * (q)) * scale; unsigned d = w[(q) >> 1];         \
            d = __builtin_amdgcn_cvt_scalef32_pk_fp4_f32(d, x[0], x[1], 1.0f, (2 * (q)) & 3); d = __builtin_amdgcn_cvt_scalef32_pk_fp4_f32(d, x[2], x[3], 1.0f, (2 * (q) + 1) & 3); w[(q) >> 1] = d; }
        FP4_PK(0) FP4_PK(1) FP4_PK(2) FP4_PK(3) FP4_PK(4) FP4_PK(5) FP4_PK(6) FP4_PK(7)
#undef FP4_PK
        *(u32x4*)(dst + i * 16) = w;
    }
}

DI void convert_weights(const Frame& F, const Args& a, int l_lo, int l_hi) {
    for (int l = l_lo; l < l_hi; ++l) {
        unsigned char* wl = F.ws + WS_W + (size_t)l * WL_STRIDE;
        transpose_matrix<1, true>(F, a.in[3] + (size_t)l * DM * 4672, DM, 4672, (bf16_t*)(wl + W_IN), 0);
        for (int n = 0; n < 4; ++n) transpose_matrix<0, false, true>(F, a.in[4] + ((size_t)l * 4 + n) * DM * DM, DM, DM, (bf16_t*)(wl + W_G), n * DM);
        for (int n = 0; n < 4; ++n) transpose_matrix<0, true>(F, a.in[6] + ((size_t)l * 4 + n) * 512 * DM, 512, DM, (bf16_t*)(wl + W_BR) + (size_t)n * DM * 512, 0);
        transpose_matrix<0, true>(F, a.in[7] + (size_t)l * DM * DM, DM, DM, (bf16_t*)(wl + W_O), 0);
        transpose_matrix<0>(F, a.in[16] + (size_t)l * 512 * 768, 512, 768, (bf16_t*)(wl + W_UQ), 0);
        transpose_matrix<2>(F, a.in[17] + (size_t)l * 256 * 1024, 256, 1024, (bf16_t*)(wl + W_UKV), 0);
        transpose_matrix<0>(F, a.in[20] + (size_t)l * DM * DM, DM, DM, (bf16_t*)(wl + W_PQ), 0);
        convert_bf16(F, a.in[21] + (size_t)l * 8 * 2 * 128 * 128, (bf16_t*)(wl + W_SK), (size_t)8 * 2 * 128 * 128);
    }
}
DI void build_rope_table(const Frame& F, const Args& a) {
    f32x2* CS = (f32x2*)(F.ws + WS_CS); const int* pos = (const int*)a.in[1];
    for (size_t i = (size_t)F.vcu * 512 + F.tid; i < (size_t)S * 32; i += (size_t)F.G * 512) {
        const int j = (int)(i & 31); const float inv = exp2f(-(float)j * (13.287712379549449f / 32.0f));
        const float ang = (float)pos[i >> 5] * inv;
        CS[i] = (f32x2){cosf(ang), sinf(ang)};
    }
}
DI void phase_prologue(const Frame& F, const Args& a) {
    convert_weights(F, a, 0, 1);
    convert_bf16(F, a.in[0], wsb(F, WS_XB), (size_t)S * DM);
    {
        const size_t nth = (size_t)F.G * 512, t0 = (size_t)F.vcu * 512 + F.tid; const float* src = a.in[0]; unsigned char* dst = F.ws + WS_XB4;
        for (size_t i = t0; i < (size_t)S * DM / 8; i += nth) { const f32x4 x = *(const f32x4*)(src + 8 * i) * 2.0f, y = *(const f32x4*)(src + 8 * i + 4) * 2.0f;
            unsigned d = 0u; d = __builtin_amdgcn_cvt_scalef32_pk_fp4_f32(d, x[0], x[1], 1.0f, 0); d = __builtin_amdgcn_cvt_scalef32_pk_fp4_f32(d, x[2], x[3], 1.0f, 1); d = __builtin_amdgcn_cvt_scalef32_pk_fp4_f32(d, y[0], y[1], 1.0f, 2); d = __builtin_amdgcn_cvt_scalef32_pk_fp4_f32(d, y[2], y[3], 1.0f, 3);
            *(unsigned*)(dst + 4 * i) = d; }
    }
    {
        const size_t nth = (size_t)F.G * 512, t0 = (size_t)F.vcu * 512 + F.tid; const float* src = a.in[0]; unsigned char* dst = F.ws + WS_XB8;
        for (size_t i = t0; i < (size_t)S * DM / 8; i += nth) { const f32x4 x = *(const f32x4*)(src + 8 * i), y = *(const f32x4*)(src + 8 * i + 4);
            int lo = __builtin_amdgcn_cvt_pk_fp8_f32(x[0], x[1], 0, false); lo = __builtin_amdgcn_cvt_pk_fp8_f32(x[2], x[3], lo, true); int hi = __builtin_amdgcn_cvt_pk_fp8_f32(y[0], y[1], 0, false); hi = __builtin_amdgcn_cvt_pk_fp8_f32(y[2], y[3], hi, true);
            *(u32x2*)(dst + 8 * i) = (u32x2){(unsigned)lo, (unsigned)hi}; }
    }
    build_rope_table(F, a);
}

DI float rope64(float x, int lane, const f32x2* cs_row) {
    const float other = xhalf(x);
    const f32x2 cs = cs_row[lane & 31];
    return (lane < 32) ? x * cs.x - other * cs.y : other * cs.y + x * cs.x;
}
DI void phase_prep(const Frame& F, const Args& a, int layer) {
    const bf16_t* H = wsb(F, WS_H); bf16_t* CQN = wsb(F, WS_CQN); bf16_t* CKVN = wsb(F, WS_CKVN); bf16_t* KD = wsb(F, WS_KD);
    const float* gq = a.in[14] + layer * 512; const float* gkv = a.in[15] + layer * 256; const int* pos = (const int*)a.in[1];
    const int gw = F.vcu * NWAVES + F.wave, NGW = F.G * NWAVES, lane = F.lane;
    for (int t = gw; t < S; t += NGW) {
        const bf16_t* hr = H + (size_t)t * HW;
        const u32x4 q = *(const u32x4*)(hr + H_DCQ + 8 * lane);
        float v[8] = {bf_lo(q.x), bf_hi(q.x), bf_lo(q.y), bf_hi(q.y), bf_lo(q.z), bf_hi(q.z), bf_lo(q.w), bf_hi(q.w)};
        float ss = 0.f;
#pragma unroll
        for (int e = 0; e < 8; ++e) ss += v[e] * v[e];
        const float rq = rsqrtf(wave_sum(ss) * (1.0f / 512.0f) + 1e-6f);
        const f32x4 g0 = *(const f32x4*)(gq + 8 * lane), g1 = *(const f32x4*)(gq + 8 * lane + 4);
        u32x4 w; w.x = cvtpk(v[0] * rq * g0[0], v[1] * rq * g0[1]); w.y = cvtpk(v[2] * rq * g0[2], v[3] * rq * g0[3]); w.z = cvtpk(v[4] * rq * g1[0], v[5] * rq * g1[1]); w.w = cvtpk(v[6] * rq * g1[2], v[7] * rq * g1[3]);
        *(u32x4*)(CQN + (size_t)t * 512 + 8 * lane) = w;
        const u32x2 k2 = *(const u32x2*)(hr + H_DCKV + 4 * lane);
        const float u0 = bf_lo(k2.x), u1 = bf_hi(k2.x), u2 = bf_lo(k2.y), u3 = bf_hi(k2.y);
        const float rk = rsqrtf(wave_sum(u0 * u0 + u1 * u1 + u2 * u2 + u3 * u3) * (1.0f / 256.0f) + 1e-6f);
        const f32x4 gk = *(const f32x4*)(gkv + 4 * lane);
        u32x2 w2; w2.x = cvtpk(u0 * rk * gk[0], u1 * rk * gk[1]); w2.y = cvtpk(u2 * rk * gk[2], u3 * rk * gk[3]);
        *(u32x2*)(CKVN + (size_t)t * 256 + 4 * lane) = w2;
        const float kr = bf1(hr[H_DKR + lane]);
        const float ro = rope64(kr, lane, (const f32x2*)(F.ws + WS_CS) + (size_t)t * 32);
        const bf16_t rb = (bf16_t)(cvtpk(ro, 0.f) & 0xffffu);
#pragma unroll
        for (int h = 0; h < 4; ++h) KD[(size_t)t * 768 + h * 192 + 128 + lane] = rb;
    }
    for (int t = gw; t < S / 64; t += NGW) { int pm = pos[t * 64 + lane];
#pragma unroll
        for (int o = 1; o < 64; o <<= 1) { const int other = __shfl_xor(pm, o); pm = other > pm ? other : pm; }
        if (lane == 0) ((int*)(F.ws + WS_TPMAX))[t] = pm; }
    float* KM = (float*)(F.ws + WS_KMEAN);
    for (int it = gw; it < 64 * 8; it += NGW) {
        const int n = it >> 3, cc = it & 7; const bf16_t* p = H + (size_t)(n * 256) * HW + H_AK + cc * 64 + lane;
        float s0 = 0.f, s1 = 0.f, s2 = 0.f, s3 = 0.f;
        for (int r = 0; r < 256; r += 4) { s0 += bf1(p[(size_t)r * HW]); s1 += bf1(p[(size_t)(r + 1) * HW]); s2 += bf1(p[(size_t)(r + 2) * HW]); s3 += bf1(p[(size_t)(r + 3) * HW]); }
        KM[n * 512 + cc * 64 + lane] = ((s0 + s1) + (s2 + s3)) * (1.0f / 256.0f);
    }
}
DI void phase_ropeq(const Frame& F, const Args& a) {
    bf16_t* QD = wsb(F, WS_QD); const int* pos = (const int*)a.in[1];
    const int gw = F.vcu * NWAVES + F.wave, NGW = F.G * NWAVES, lane = F.lane;
    for (int t = gw; t < S; t += NGW) {
        const f32x2* cs = (const f32x2*)(F.ws + WS_CS) + (size_t)t * 32;
#pragma unroll
        for (int h = 0; h < 4; ++h) { bf16_t* p = QD + (size_t)t * 768 + h * 192 + 128 + lane; const float ro = rope64(bf1(*p), lane, cs); *p = (bf16_t)(cvtpk(ro, 0.f) & 0xffffu); }
    }
}
DI void phase_moba_select(const Frame& F, const Args& a, int layer) {
    const bf16_t* H = wsb(F, WS_H); const float* KM = (const float*)(F.ws + WS_KMEAN); const int* pos = (const int*)a.in[1]; const int* TP = (const int*)(F.ws + WS_TPMAX);
    unsigned* cnt = (unsigned*)(F.ws + WS_CTL) + CW_MOBA + layer * 1024; int* lists = (int*)(F.ws + WS_MLIST);
    const int gw = F.vcu * NWAVES + F.wave, NGW = F.G * NWAVES;
    int lane = F.lane; asm volatile("" : "+v"(lane));
    const int r = lane & 31, hi = lane >> 5;
    for (int it = gw; it < (S / 32) * 4; it += NGW) {
        const int h = it & 3, q0 = (it >> 2) * 32, q = q0 + r, own = q0 >> 8;
        if (own == 0) continue;
        const bf16_t* qp = H + (size_t)q * HW + H_AQ + h * 128 + hi * 8;
        const bool two = own > 32;
        f32x16 g0, g1;
#pragma unroll
        for (int i = 0; i < 16; ++i) { g0[i] = 0.f; g1[i] = 0.f; }
#pragma unroll
        for (int kk = 0; kk < 8; ++kk) {
            const bf16x8 qf = *(const bf16x8*)(qp + kk * 16);
#pragma unroll
            for (int rb = 0; rb < 2; ++rb) {
                if (rb == 1 && !two) continue;
                const float* kp = KM + (size_t)(rb * 32 + r) * 512 + h * 128 + kk * 16 + hi * 8;
                const f32x4 x = *(const f32x4*)kp, y = *(const f32x4*)(kp + 4);
                u32x4 wh, wl;
                wh.x = cvtpk(x[0], x[1]); wh.y = cvtpk(x[2], x[3]); wh.z = cvtpk(y[0], y[1]); wh.w = cvtpk(y[2], y[3]);
                wl.x = cvtpk(x[0] - bf_lo(wh.x), x[1] - bf_hi(wh.x)); wl.y = cvtpk(x[2] - bf_lo(wh.y), x[3] - bf_hi(wh.y)); wl.z = cvtpk(y[0] - bf_lo(wh.z), y[1] - bf_hi(wh.z)); wl.w = cvtpk(y[2] - bf_lo(wh.w), y[3] - bf_hi(wh.w));
                if (rb == 0) { g0 = __builtin_amdgcn_mfma_f32_32x32x16_bf16(__builtin_bit_cast(bf16x8, wh), qf, g0, 0, 0, 0); g0 = __builtin_amdgcn_mfma_f32_32x32x16_bf16(__builtin_bit_cast(bf16x8, wl), qf, g0, 0, 0, 0); }
                else { g1 = __builtin_amdgcn_mfma_f32_32x32x16_bf16(__builtin_bit_cast(bf16x8, wh), qf, g1, 0, 0, 0); g1 = __builtin_amdgcn_mfma_f32_32x32x16_bf16(__builtin_bit_cast(bf16x8, wl), qf, g1, 0, 0, 0); }
            }
        }
        float v1 = -INFINITY, v2 = -INFINITY, v3 = -INFINITY; int i1 = -1, i2 = -1, i3 = -1;
#pragma unroll
        for (int rb = 0; rb < 2; ++rb)
#pragma unroll
            for (int i = 0; i < 16; ++i) {
                const int n = rb * 32 + (i & 3) + 8 * (i >> 2) + 4 * hi; const float g = (rb == 0) ? g0[i] : g1[i];
                if (n < own) {
                    if (g > v1) { v3 = v2; i3 = i2; v2 = v1; i2 = i1; v1 = g; i1 = n; }
                    else if (g > v2) { v3 = v2; i3 = i2; v2 = g; i2 = n; }
                    else if (g > v3) { v3 = g; i3 = n; }
                }
            }
        const float p1 = xhalf(v1), p2 = xhalf(v2), p3 = xhalf(v3);
        const int j1 = __shfl_xor(i1, 32), j2 = __shfl_xor(i2, 32), j3 = __shfl_xor(i3, 32);
#pragma unroll
        for (int c = 0; c < 3; ++c) { const float g = c == 0 ? p1 : (c == 1 ? p2 : p3); const int n = c == 0 ? j1 : (c == 1 ? j2 : j3);
            if (n >= 0) {
                if (g > v1 || (g == v1 && n < i1)) { v3 = v2; i3 = i2; v2 = v1; i2 = i1; v1 = g; i1 = n; }
                else if (g > v2 || (g == v2 && n < i2)) { v3 = v2; i3 = i2; v2 = g; i2 = n; }
                else if (g > v3 || (g == v3 && n < i3)) { v3 = g; i3 = n; }
            } }
        if (hi == 0) {
            const int pq = pos[q];
#pragma unroll
            for (int sl = 0; sl < 3; ++sl) { const int n = sl == 0 ? i1 : (sl == 1 ? i2 : i3);
                if (n >= 0) { const int bm = max(max(TP[4 * n], TP[4 * n + 1]), max(TP[4 * n + 2], TP[4 * n + 3])); const int near = (pq - bm < 790) ? 1 : 0;
                    const unsigned p = atomicAdd(cnt + near * 256 + h * 64 + n, 1u);
                    if (p < (unsigned)(near ? MCAP - MCAP_F : MCAP_F)) lists[(size_t)(h * 64 + n) * MCAP + (near ? MCAP_F : 0) + p] = q * 4 + sl; } }
        }
    }
}
DI void phase_mixer_combine(const Frame& F, const Args& a, int layer) {
    const unsigned char* PART = F.ws + WS_PART; bf16_t* OA = wsb(F, WS_O);
    const int gw = F.vcu * NWAVES + F.wave, NGW = F.G * NWAVES, lane = F.lane;
    for (size_t i = (size_t)F.vcu * 512 + F.tid; i < (size_t)2 * S * 64; i += (size_t)F.G * 512) {
        const size_t br = (i >= (size_t)S * 64) ? 3 : 1, e = (i - (br == 3 ? (size_t)S * 64 : 0)) * 8;
        const u32x4 w = *(const u32x4*)(wsb(F, WS_O) + br * S * 512 + e);
        int lo = __builtin_amdgcn_cvt_pk_fp8_f32(bf_lo(w.x) * 8.0f, bf_hi(w.x) * 8.0f, 0, false); lo = __builtin_amdgcn_cvt_pk_fp8_f32(bf_lo(w.y) * 8.0f, bf_hi(w.y) * 8.0f, lo, true);
        int hi = __builtin_amdgcn_cvt_pk_fp8_f32(bf_lo(w.z) * 8.0f, bf_hi(w.z) * 8.0f, 0, false); hi = __builtin_amdgcn_cvt_pk_fp8_f32(bf_lo(w.w) * 8.0f, bf_hi(w.w) * 8.0f, hi, true);
        *(u32x2*)(F.ws + WS_O8 + br * S * 512 + e) = (u32x2){(unsigned)lo, (unsigned)hi};
    }
    for (int it = gw; it < S * 4; it += NGW) {
        const int q = it >> 2, h = it & 3, nsel = (q >> 8) < 3 ? (q >> 8) : 3;
        const unsigned char* pp = PART + ((size_t)q * 16 + h * 4) * 272;
        float mm[4], ll[4]; unsigned ov[4];
#pragma unroll
        for (int s = 0; s < 4; ++s) { const bool use = (s == 3) || (s < nsel); const f32x2 ml = *(const f32x2*)(pp + s * 272 + 256); mm[s] = use ? ml.x : -1e30f; ll[s] = use ? ml.y : 0.f; ov[s] = *(const unsigned*)(pp + s * 272 + lane * 4); }
        const float M = fmaxf(fmaxf(mm[0], mm[1]), fmaxf(mm[2], mm[3]));
        float wsum = 0.f, x0 = 0.f, x1 = 0.f;
#pragma unroll
        for (int s = 0; s < 4; ++s) { const float w = ll[s] * ex2(mm[s] - M); wsum += w; x0 += w * bf_lo(ov[s]); x1 += w * bf_hi(ov[s]); }
        const float inv = 1.0f / wsum;
        *(unsigned*)(OA + (size_t)q * 512 + h * 128 + lane * 2) = cvtpk(x0 * inv, x1 * inv);
        *(unsigned short*)(F.ws + WS_O8 + (size_t)q * 512 + h * 128 + lane * 2) = (unsigned short)__builtin_amdgcn_cvt_pk_fp8_f32(x0 * inv * 8.0f, x1 * inv * 8.0f, 0, false);
    }
    float d1 = 0.f, d2 = 0.f;
    for (int i = 0; i < 64; ++i) { d1 += a.in[9][layer * 64 + i] * a.in[10][layer * 64 + i]; d2 += a.in[11][layer * 64 + i] * a.in[12][layer * 64 + i]; }
    const float lambda_init = 0.8f - 0.6f * expf(-0.3f * (float)layer), lam = expf(d1) - expf(d2) + lambda_init;
    bf16_t* OC = wsb(F, WS_O) + (size_t)2 * S * 512; const bf16_t* OC2 = wsb(F, WS_OC2);
    const f32x2 sg = *(const f32x2*)(a.in[13] + layer * 128 + lane * 2);
    for (int it = gw; it < S * 4; it += NGW) {
        const size_t off = (size_t)(it >> 2) * 512 + (it & 3) * 128 + lane * 2;
        const unsigned w1 = *(const unsigned*)(OC + off), w2 = *(const unsigned*)(OC2 + off);
        const float x0 = bf_lo(w1) - lam * bf_lo(w2), x1 = bf_hi(w1) - lam * bf_hi(w2);
        const float rn = rsqrtf(wave_sum(x0 * x0 + x1 * x1) * (1.0f / 128.0f) + 1e-6f) * (1.0f - lambda_init);
        *(unsigned*)(OC + off) = cvtpk(x0 * rn * sg.x, x1 * rn * sg.y);
        *(unsigned short*)(F.ws + WS_O8 + (size_t)2 * S * 512 + off) = (unsigned short)__builtin_amdgcn_cvt_pk_fp8_f32(x0 * rn * sg.x * 8.0f, x1 * rn * sg.y * 8.0f, 0, false);
    }
}
template <int NJ, int NE> DI void ln_store(float (&v)[NJ][NE], const float* g, const float* b, float* of, bf16_t* ob, int lane, unsigned char* o8 = nullptr, unsigned char* o4 = nullptr) {
    static_assert(NJ * NE == 32 && NE % 8 == 0, "row layout");
    float s = 0.f;
#pragma unroll
    for (int j = 0; j < NJ; ++j)
#pragma unroll
        for (int e = 0; e < NE; ++e) s += v[j][e];
    const float mean = wave_sum(s) * (1.0f / DM);
    float q = 0.f;
#pragma unroll
    for (int j = 0; j < NJ; ++j)
#pragma unroll
        for (int e = 0; e < NE; ++e) { v[j][e] -= mean; q += v[j][e] * v[j][e]; }
    const float rstd = rsqrtf(wave_sum(q) * (1.0f / DM) + 1e-5f);
#pragma unroll
    for (int j = 0; j < NJ; ++j)
#pragma unroll
        for (int e8 = 0; e8 < NE; e8 += 8) {
            const int c = (DM / NJ) * j + NE * lane + e8;
            const f32x4 g0 = *(const f32x4*)(g + c), g1 = *(const f32x4*)(g + c + 4), b0 = *(const f32x4*)(b + c), b1 = *(const f32x4*)(b + c + 4);
            f32x4 o0, o1;
#pragma unroll
            for (int e = 0; e < 4; ++e) { o0[e] = v[j][e8 + e] * rstd * g0[e] + b0[e]; o1[e] = v[j][e8 + 4 + e] * rstd * g1[e] + b1[e]; }
            if (of) { *(f32x4*)(of + c) = o0; *(f32x4*)(of + c + 4) = o1; }
            u32x4 w; w.x = cvtpk(o0[0], o0[1]); w.y = cvtpk(o0[2], o0[3]); w.z = cvtpk(o1[0], o1[1]); w.w = cvtpk(o1[2], o1[3]);
            *(u32x4*)(ob + c) = w;
            if (o8) { int lo = __builtin_amdgcn_cvt_pk_fp8_f32(o0[0], o0[1], 0, false); lo = __builtin_amdgcn_cvt_pk_fp8_f32(o0[2], o0[3], lo, true); int hi = __builtin_amdgcn_cvt_pk_fp8_f32(o1[0], o1[1], 0, false); hi = __builtin_amdgcn_cvt_pk_fp8_f32(o1[2], o1[3], hi, true);
                *(u32x2*)(o8 + c) = (u32x2){(unsigned)lo, (unsigned)hi}; }
            if (o4) { unsigned d = 0u; d = __builtin_amdgcn_cvt_scalef32_pk_fp4_f32(d, o0[0] * 2.0f, o0[1] * 2.0f, 1.0f, 0); d = __builtin_amdgcn_cvt_scalef32_pk_fp4_f32(d, o0[2] * 2.0f, o0[3] * 2.0f, 1.0f, 1);
                d = __builtin_amdgcn_cvt_scalef32_pk_fp4_f32(d, o1[0] * 2.0f, o1[1] * 2.0f, 1.0f, 2); d = __builtin_amdgcn_cvt_scalef32_pk_fp4_f32(d, o1[2] * 2.0f, o1[3] * 2.0f, 1.0f, 3); *(unsigned*)(o4 + (c >> 1)) = d; }
        }
}
DI void phase_ln1(const Frame& F, const Args& a, int layer) {
    const bf16_t* Y = wsb(F, WS_GT); bf16_t* XB = wsb(F, WS_XB);
    const int gw = F.vcu * NWAVES + F.wave, NGW = F.G * NWAVES, lane = F.lane;
    for (int t = gw; t < S; t += NGW) {
        float v[4][8];
#pragma unroll
        for (int j = 0; j < 4; ++j) { const u32x4 w = *(const u32x4*)(Y + (size_t)t * DM + 512 * j + 8 * lane);
            v[j][0] = bf_lo(w.x); v[j][1] = bf_hi(w.x); v[j][2] = bf_lo(w.y); v[j][3] = bf_hi(w.y); v[j][4] = bf_lo(w.z); v[j][5] = bf_hi(w.z); v[j][6] = bf_lo(w.w); v[j][7] = bf_hi(w.w); }
        ln_store<4, 8>(v, a.in[18] + layer * DM, a.in[19] + layer * DM, (float*)nullptr, XB + (size_t)t * DM, lane);
    }
}

namespace att {
constexpr int TBL = RING_BYTES - 4096;
constexpr int TPMO = TBL - 1024;
constexpr int KMO = 0;
constexpr float NEG = -1e30f;
enum { MIX_A = 0, MIX_B = 1, MIX_C = 2, MIX_D = 3 };

struct Ctx { int qi, pq, own; float c, cb; unsigned long long sel; };

DI int t5_bucket(int rel) {
    if (rel < 16) return rel;
    return 15 + (rel >= 16) + (rel >= 21) + (rel >= 27) + (rel >= 35) + (rel >= 46) + (rel >= 59) + (rel >= 77) + (rel >= 99) + (rel >= 128) + (rel >= 166) + (rel >= 216) + (rel >= 280) + (rel >= 363) + (rel >= 470) + (rel >= 609) + (rel >= 790);
}
DI void build_tbl(LAS unsigned char* lds, const float* t5, int col, const int* tpmax) {
    if (threadIdx.x < 256) *(LAS int*)(lds + TPMO + threadIdx.x * 4) = tpmax[threadIdx.x];
    for (int rel = threadIdx.x; rel < 1024; rel += 512) *(LAS float*)(lds + TBL + rel * 4) = t5[t5_bucket(rel) * 16 + col] * LOG2E;
}

#define ATT_SB() __builtin_amdgcn_sched_barrier(0)
#ifndef ATT_CONV_INTERLEAVE
#define ATT_CONV_INTERLEAVE 1
#endif
#ifndef ATT_CP_D
#define ATT_CP_D 0
#endif
#ifndef ATT_CP
#define ATT_CP 0
#endif
#ifndef ATT_X_LDS2
#define ATT_X_LDS2 0
#endif
#ifndef ATT_NOPRIO
#define ATT_NOPRIO 0
#endif
#if ATT_NOPRIO
#define ATT_PRIO(x) do { } while (0)
#else
#define ATT_PRIO(x) __builtin_amdgcn_s_setprio(x)
#endif
#if defined(ATT_X_NOSM)
#define ATT_SM(...) do { l_run = 1.0f; st0.resc = false; st1.resc = false; st0.alpha = 1.f; st1.alpha = 1.f; pf0[0] = qf[0]; pf0[1] = qf[1]; pf1[0] = qf[2]; pf1[1] = qf[3]; } while (0)
#else
#define ATT_SM(...) __VA_ARGS__
#endif
#ifndef ATT_PD
#define ATT_PD 4
#endif
DI float hmax32(float v) { auto rr = __builtin_amdgcn_permlane32_swap(__float_as_uint(v), __float_as_uint(v), false, false); return fmaxf(__uint_as_float(rr[0]), __uint_as_float(rr[1])); }
struct SmState { float mx, cc, dd, rs; bool resc; float alpha; };
template <int MIX, bool FAST, int W>
DI void sm_item(f32x16& s, SmState& st, float& m_run, float& l_run, bf16x8 (&pf)[2], const Ctx& cx, const LAS unsigned char* pkp, const LAS unsigned char* lds, int k0, int kmax, int kmin, int hi, bool lv) {
    constexpr bool BIAS = (MIX != MIX_D);
    if constexpr (W == 0 || W == 1) {
        constexpr int sg = W;
        if constexpr (FAST) {
            float a = fmaxf(fmaxf(s[sg * 8 + 0], s[sg * 8 + 1]), s[sg * 8 + 2]), b = fmaxf(fmaxf(s[sg * 8 + 3], s[sg * 8 + 4]), s[sg * 8 + 5]);
            a = fmaxf(fmaxf(a, s[sg * 8 + 6]), s[sg * 8 + 7]);
            st.mx = (W == 0) ? fmaxf(a, b) : fmaxf(st.mx, fmaxf(a, b));
            asm volatile("" : "+v"(st.mx));
        } else {
            i32x4 pk0 = (i32x4){0, 0, 0, 0}, pk1 = (i32x4){0, 0, 0, 0};
            if (BIAS) { const LAS i32x4* pp = (const LAS i32x4*)(pkp + (sg * 16 + hi * 8) * 4); pk0 = pp[0]; pk1 = pp[1]; }
            float mx = (W == 0) ? NEG : st.mx;
#pragma unroll
            for (int j = 0; j < 8; ++j) {
                const int i = sg * 8 + j, key = k0 + sg * 16 + hi * 8 + j;
                float tv = s[i] * cx.c;
                if (BIAS) { int rel = cx.pq - (j < 4 ? pk0[j & 3] : pk1[j & 3]); rel = rel < 0 ? 0 : (rel > 1023 ? 1023 : rel); tv += *(const LAS float*)(lds + TBL + rel * 4); }
                bool valid = key <= kmax;
                if (MIX == MIX_B) valid = valid && (key >= kmin);
                tv = valid ? tv : NEG;
                s[i] = tv; mx = fmaxf(mx, tv);
            }
            st.mx = mx;
        }
        if constexpr (W == 1) {
            float mx = hmax32(st.mx);
            if constexpr (FAST) mx = lv ? mx * cx.c + cx.cb : NEG;
            const bool need = mx > m_run + 8.0f;
            const float mn = need ? mx : m_run;
            st.alpha = ex2(m_run - mn); m_run = mn; l_run *= st.alpha;
            st.resc = (__ballot(need) != 0ull);
            st.cc = FAST ? (lv ? cx.c : 0.f) : 1.0f; st.dd = FAST ? (lv ? cx.cb - mn : NEG) : -mn; st.rs = 0.f;
            asm volatile("" : "+v"(st.alpha), "+v"(m_run), "+v"(l_run), "+v"(st.dd));
        }
    } else if constexpr (W >= 2 && W <= 5) {
        constexpr int e0 = (W - 2) * 4;
#pragma unroll
        for (int e = e0; e < e0 + 4; ++e) { float p = ex2(s[e] * st.cc + st.dd); asm volatile("" : "+v"(p)); s[e] = p; st.rs += p; }
        asm volatile("" : "+v"(st.rs));
        if constexpr (W == 5) l_run += st.rs;
    } else {
        constexpr int sg = W - 6;
        u32x4 w; w.x = cvtpk(s[sg * 8 + 0], s[sg * 8 + 1]); w.y = cvtpk(s[sg * 8 + 2], s[sg * 8 + 3]); w.z = cvtpk(s[sg * 8 + 4], s[sg * 8 + 5]); w.w = cvtpk(s[sg * 8 + 6], s[sg * 8 + 7]); asm volatile("" : "+v"(w)); pf[sg] = __builtin_bit_cast(bf16x8, w);
    }
}
template <int DQK, int DV, int MIX, bool FAST>
DI void tile_body(const LAS unsigned char* sb, const LAS unsigned char* lds, const bf16x8 (&qf)[DQK / 16], f32x16 (&o)[DV / 32], float& m_run, float& l_run, const Ctx& cx,
                  int k0, int kmax, int kmin, int pr, int xk, int xv, int r, int hi, bool lv) {
    constexpr int KCH = DQK / 8, NQ = DQK / 16, NP = DV / 16, KBUF = 64 * KCH * 16, VBUF = DV * 128;
    const LAS unsigned char* kb0 = sb + pr * (KCH * 16); const LAS unsigned char* kb1 = kb0 + 32 * (KCH * 16);
    const LAS unsigned char* vb = sb + KBUF + r * 128; const LAS unsigned char* pkp = sb + KBUF + VBUF;
    f32x16 s0, s1;
#pragma unroll
    for (int i = 0; i < 16; ++i) { s0[i] = 0.f; s1[i] = 0.f; }
    bf16x8 kf[NQ], kg[NQ], vf[2 * NP], pf0[2], pf1[2];
    SmState st0, st1;
#if defined(ATT_X_NOLDS)
#define ATT_KF(base, kk) (qf[(kk) % NQ])
#else
#define ATT_KF(base, kk) (*(const LAS bf16x8*)((base) + (((2 * (kk) + hi) ^ xk) << 4)))
#endif
#if defined(ATT_X_NOLDS)
#define ATT_VF(f) (qf[(f) % NQ])
#else
#define ATT_VF(f) (*(const LAS bf16x8*)(vb + (((f) % NP) >> 1) * 32 * 128 + (((((f) / NP) * 4 + ((f) & 1) * 2 + hi) ^ xv) << 4)))
#endif
#define ATT_PRE_K(W) do { _Pragma("unroll") for (int kk = ((W) * NQ) / 8; kk < (((W) + 1) * NQ) / 8; ++kk) { kg[kk] = ATT_KF(kb1, kk); if (ATT_X_LDS2) { bf16x8 dm_ = ATT_KF(kb1 + 16, kk); asm volatile("" :: "v"(dm_)); } } } while (0)
#define ATT_PRE_V(W) do { _Pragma("unroll") for (int f = ((W) * NP) / 8; f < (((W) + 1) * NP) / 8; ++f) { vf[f] = ATT_VF(f); if (ATT_X_LDS2) { bf16x8 dm_ = ATT_VF(f ^ 1); asm volatile("" :: "v"(dm_)); } } } while (0)
#pragma unroll
    for (int kk = 0; kk < NQ; ++kk) kf[kk] = ATT_KF(kb0, kk);
    ATT_SB();
#pragma unroll
    for (int kk = 0; kk < NQ; ++kk) s0 = __builtin_amdgcn_mfma_f32_32x32x16_bf16(kf[kk], qf[kk], s0, 0, 0, 0);
    ATT_PRE_K(0); ATT_PRE_K(1); if (ATT_PD > 2) ATT_PRE_K(2); if (ATT_PD > 3) ATT_PRE_K(3);
    ATT_SB();
#define ATT_STEP2(W) do { \
        ATT_PRIO(1); _Pragma("unroll") for (int kk = ((W) * NQ) / 8; kk < (((W) + 1) * NQ) / 8; ++kk) s1 = __builtin_amdgcn_mfma_f32_32x32x16_bf16(kg[kk], qf[kk], s1, 0, 0, 0); ATT_PRIO(0); \
        if ((W) + ATT_PD < 8) ATT_PRE_K((W) + ATT_PD); else ATT_PRE_V((W) + ATT_PD - 8); \
        ATT_SM(sm_item<MIX, FAST, W>(s0, st0, m_run, l_run, pf0, cx, pkp, lds, k0, kmax, kmin, hi, lv)); ATT_SB(); } while (0)
    ATT_STEP2(0); ATT_STEP2(1); ATT_STEP2(2); ATT_STEP2(3); ATT_STEP2(4); ATT_STEP2(5); ATT_STEP2(6); ATT_STEP2(7);
#undef ATT_STEP2
    if (st0.resc) {
#pragma unroll
        for (int d = 0; d < DV / 32; ++d)
#pragma unroll
            for (int i = 0; i < 16; ++i) o[d][i] *= st0.alpha;
    }
    ATT_SB();
#define ATT_STEP3(W) do { \
        ATT_PRIO(1); _Pragma("unroll") for (int f = ((W) * NP) / 8; f < (((W) + 1) * NP) / 8; ++f) o[f >> 1] = __builtin_amdgcn_mfma_f32_32x32x16_bf16(vf[f], pf0[f & 1], o[f >> 1], 0, 0, 0); ATT_PRIO(0); \
        ATT_PRE_V((W) + ATT_PD); \
        ATT_SM(sm_item<MIX, FAST, W>(s1, st1, m_run, l_run, pf1, cx, pkp + 128, lds, k0 + 32, kmax, kmin, hi, lv)); ATT_SB(); } while (0)
    ATT_STEP3(0); ATT_STEP3(1); ATT_STEP3(2); ATT_STEP3(3); ATT_STEP3(4); ATT_STEP3(5); ATT_STEP3(6); ATT_STEP3(7);
#undef ATT_STEP3
    if (st1.resc) {
#pragma unroll
        for (int d = 0; d < DV / 32; ++d)
#pragma unroll
            for (int i = 0; i < 16; ++i) o[d][i] *= st1.alpha;
    }
    ATT_SB();
#define ATT_STEP4(W) do { \
        _Pragma("unroll") for (int f = ((W) * NP) / 8; f < (((W) + 1) * NP) / 8; ++f) o[(f - NP) >> 1] = __builtin_amdgcn_mfma_f32_32x32x16_bf16(vf[f], pf1[f & 1], o[(f - NP) >> 1], 0, 0, 0); \
        if ((W) + ATT_PD < 16) ATT_PRE_V((W) + ATT_PD); ATT_SB(); } while (0)
    ATT_STEP4(8); ATT_STEP4(9); ATT_STEP4(10); ATT_STEP4(11); ATT_STEP4(12); ATT_STEP4(13); ATT_STEP4(14); ATT_STEP4(15);
#undef ATT_STEP4
#undef ATT_KF
#undef ATT_VF
#undef ATT_PRE_K
#undef ATT_PRE_V
}
template <int DQK, int DV, int MIX>
DI void flash_pass(LAS unsigned char* lds, const bf16x8 (&qf)[DQK / 16], const bf16_t* __restrict__ Kg, int ldk, const bf16_t* __restrict__ VTg, int ldvt,
                   const int* __restrict__ pos, int t0, int t1, int q0, int qpmin, const Ctx& cx, f32x16 (&o)[DV / 32], float& m_run, float& l_run, int ts_force = -1) {
    constexpr int KCH = DQK / 8, NKL = KCH / 8, NVL = DV / 64;
    constexpr bool BIAS = (MIX != MIX_D);
    constexpr int KBUF = 64 * KCH * 16, VBUF = DV * 128, PBUF = BIAS ? 2048 : 0, SLOT = KBUF + VBUF + PBUF, NV = NKL + NVL + (BIAS ? 1 : 0);
    static_assert(3 * SLOT <= TPMO, "attention ring");
    static_assert(DQK % 128 == 0 || DQK == 64 || DQK == 192, "QK MFMAs per softmax work item");
    int tid = threadIdx.x; asm volatile("" : "+v"(tid));
    const int lane = tid & 63, r = lane & 31, hi = lane >> 5, wave = __builtin_amdgcn_readfirstlane(tid >> 6);
    const int pr = (r & 0x13) | ((r & 4) << 1) | ((r & 8) >> 1);
    const int xk = (KCH == 16) ? (((pr & 1) << 3) | ((pr >> 1) & 7)) : ((pr >> 1) & 7);
    const int xv = (r >> 1) & 7;
    unsigned koff[NKL], voff[NVL];
#pragma unroll
    for (int i = 0; i < NKL; ++i) { const int p = (i * 8 + wave) * 64 + lane, row = p / KCH, cs = p % KCH; const int x = (KCH == 16) ? (((row & 1) << 3) | ((row >> 1) & 7)) : ((row >> 1) & 7); koff[i] = (unsigned)(row * ldk + (cs ^ x) * 8) * 2u; }
#pragma unroll
    for (int i = 0; i < NVL; ++i) { const int p = (i * 8 + wave) * 64 + lane, row = p >> 3, cs = p & 7; voff[i] = (unsigned)(row * ldvt + (cs ^ ((row >> 1) & 7)) * 8) * 2u; }
#define ATT_ISSUE(t, sl) do { LAS unsigned char* sb_ = lds + (sl) * SLOT; \
    _Pragma("unroll") for (int i_ = 0; i_ < NKL; ++i_) __builtin_amdgcn_global_load_lds((const unsigned*)((const char*)Kg + (size_t)(t) * 64 * ldk * 2 + koff[i_]), (LAS unsigned*)(sb_ + (i_ * 8 + wave) * 1024), 16, 0, 0); \
    _Pragma("unroll") for (int i_ = 0; i_ < NVL; ++i_) __builtin_amdgcn_global_load_lds((const unsigned*)((const char*)VTg + (size_t)(t) * 128 + voff[i_]), (LAS unsigned*)(sb_ + KBUF + (i_ * 8 + wave) * 1024), 16, 0, 0); \
    if (BIAS) __builtin_amdgcn_global_load_lds((const unsigned*)(pos + (t) * 64 + lane), (LAS unsigned*)(sb_ + KBUF + VBUF + wave * 256), 4, 0, 0); } while (0)
#ifndef ATT_X_DMA2
#define ATT_X_DMA2 0
#endif
#if ATT_X_DMA2
#define ATT_ISSUE2(t, sl) do { ATT_ISSUE(t, sl); ATT_ISSUE(t, sl); } while (0)
#else
#define ATT_ISSUE2(t, sl) ATT_ISSUE(t, sl)
#endif
#if defined(ATT_X_NODMA)
#define ATT_ISSUE_LOOP(t, sl) do { (void)(sl); } while (0)
#define ATT_NEXT_SLOT(sl) ((sl) ^ 1)
#else
#define ATT_ISSUE_LOOP(t, sl) ATT_ISSUE2(t, sl)
#define ATT_NEXT_SLOT(sl) (((sl) == 2) ? 0 : (sl) + 1)
#endif
#define ATT_WAITBAR(N) asm volatile("s_waitcnt vmcnt(%0) lgkmcnt(0)\n\ts_barrier" :: "n"(N) : "memory")
    int ts = t0;
    if (ts_force >= 0) ts = ts_force;
    else if (MIX != MIX_B) { const int tlim = (q0 >> 6) < t1 ? (q0 >> 6) : t1;
        if (!BIAS) ts = tlim > t0 ? tlim : t0;
        else {
            ts = tlim > t0 ? tlim : t0;
            for (int base = t0; base < tlim; base += 64) { const int idx = base + lane; const bool stop = (idx >= tlim) || (qpmin - *(const LAS int*)(lds + TPMO + (idx < 256 ? idx : 255) * 4) < 790);
                const unsigned long long mk = __ballot(stop); if (mk != 0ull) { const int f = base + (int)__builtin_ctzll(mk); ts = f < tlim ? f : tlim; break; } } } }
    ATT_ISSUE2(t0, 0);
    if (t0 + 1 < t1) ATT_ISSUE2(t0 + 1, 1);
    int sl = 0;
#define ATT_TILES(TA, TB, FASTV) \
    for (int t = (TA); t < (TB); ++t) { \
        if (t + 1 < t1) ATT_WAITBAR(NV * (ATT_X_DMA2 ? 2 : 1)); else ATT_WAITBAR(0);            \
        if (t + 2 < t1) { const int s2 = (sl >= 1) ? sl - 1 : 2; ATT_ISSUE_LOOP(t + 2, s2); } \
        const LAS unsigned char* sb = lds + sl * SLOT; \
        int kmax, kmin = 0; \
        kmax = cx.qi; \
        if (MIX == MIX_B) kmin = cx.qi - 127; \
        const int k0 = t * 64; \
        const bool lv = (kmax >= k0) && (kmin <= k0 + 63); \
        if (__ballot(lv) != 0ull) tile_body<DQK, DV, MIX, FASTV>(sb, lds, qf, o, m_run, l_run, cx, k0, kmax, kmin, pr, xk, xv, r, hi, lv); \
        sl = ATT_NEXT_SLOT(sl); \
    }
    ATT_TILES(t0, ts, true)
    ATT_TILES(ts, t1, false)
#undef ATT_TILES
    asm volatile("s_waitcnt lgkmcnt(0)\n\ts_barrier" ::: "memory");
#undef ATT_ISSUE
#undef ATT_WAITBAR
}
DI int fast_split(const LAS unsigned char* lds, int t0, int t1, int q0, int qpmin, int lane) {
    const int tlim = (q0 >> 6) < t1 ? (q0 >> 6) : t1;
    int ts = tlim > t0 ? tlim : t0;
    for (int base = t0; base < tlim; base += 64) { const int idx = base + lane; const bool stop = (idx >= tlim) || (qpmin - *(const LAS int*)(lds + TPMO + (idx < 256 ? idx : 255) * 4) < 790);
        const unsigned long long mk = __ballot(stop); if (mk != 0ull) { const int f = base + (int)__builtin_ctzll(mk); ts = f < tlim ? f : tlim; break; } }
    return ts;
}
template <int DQK, int DV, int MIX>
DI void flash_pass_cp(LAS unsigned char* lds, const bf16x8 (&qf)[DQK / 16], const bf16_t* __restrict__ Kg, int ldk, const bf16_t* __restrict__ VTg, int ldvt,
                      int t0, int ts, const Ctx& cx, f32x16 (&o)[DV / 32], float& m_run, float& l_run) {
    constexpr int KCH = DQK / 8, NKL = KCH / 8, NVL = DV / 64, NQ = DQK / 16, NP = DV / 16;
    constexpr int KBUF = 64 * KCH * 16, VBUF = DV * 128;
    static_assert(3 * (KBUF + VBUF) <= TPMO, "attention rings");
    int tid = threadIdx.x; asm volatile("" : "+v"(tid));
    const int lane = tid & 63, r = lane & 31, hi = lane >> 5, wave = __builtin_amdgcn_readfirstlane(tid >> 6);
    const int pr = (r & 0x13) | ((r & 4) << 1) | ((r & 8) >> 1);
    const int xk = (KCH == 16) ? (((pr & 1) << 3) | ((pr >> 1) & 7)) : ((pr >> 1) & 7);
    const int xv = (r >> 1) & 7;
    unsigned koff[NKL], voff[NVL];
#pragma unroll
    for (int i = 0; i < NKL; ++i) { const int p = (i * 8 + wave) * 64 + lane, row = p / KCH, cs = p % KCH; const int x = (KCH == 16) ? (((row & 1) << 3) | ((row >> 1) & 7)) : ((row >> 1) & 7); koff[i] = (unsigned)(row * ldk + (cs ^ x) * 8) * 2u; }
#pragma unroll
    for (int i = 0; i < NVL; ++i) { const int p = (i * 8 + wave) * 64 + lane, row = p >> 3, cs = p & 7; voff[i] = (unsigned)(row * ldvt + (cs ^ ((row >> 1) & 7)) * 8) * 2u; }
#define CP_ISSUE_K(t, sl) do { _Pragma("unroll") for (int i_ = 0; i_ < NKL; ++i_) __builtin_amdgcn_global_load_lds((const unsigned*)((const char*)Kg + (size_t)(t) * 64 * ldk * 2 + koff[i_]), (LAS unsigned*)(lds + (sl) * KBUF + (i_ * 8 + wave) * 1024), 16, 0, 0); } while (0)
#define CP_ISSUE_V(t, sl) do { _Pragma("unroll") for (int i_ = 0; i_ < NVL; ++i_) __builtin_amdgcn_global_load_lds((const unsigned*)((const char*)VTg + (size_t)(t) * 128 + voff[i_]), (LAS unsigned*)(lds + 3 * KBUF + (sl) * VBUF + (i_ * 8 + wave) * 1024), 16, 0, 0); } while (0)
#define CP_KF(base, kk) (*(const LAS bf16x8*)((base) + (((2 * (kk) + hi) ^ xk) << 4)))
#define CP_VF(base, hf, j) (*(const LAS bf16x8*)((base) + ((j) >> 1) * 32 * 128 + (((((hf) * 4 + ((j) & 1) * 2 + hi) ^ xv)) << 4)))
    const int n = ts - t0;
    CP_ISSUE_K(t0, 0); CP_ISSUE_V(t0, 0);
    if (n > 1) CP_ISSUE_K(t0 + 1, 1);
    asm volatile("s_waitcnt vmcnt(0) lgkmcnt(0)\n\ts_barrier" ::: "memory");
    const LAS unsigned char* kl = lds + pr * (KCH * 16);
    const LAS unsigned char* vl = lds + 3 * KBUF + r * 128;
    f32x16 sc, sn;
    bf16x8 kfr[NQ], vfr[NP], pp[2], pc[2];
    SmState st;
#pragma unroll
    for (int i = 0; i < 16; ++i) sc[i] = 0.f;
#pragma unroll
    for (int kk = 0; kk < NQ; ++kk) kfr[kk] = CP_KF(kl, kk);
    ATT_SB();
#pragma unroll
    for (int kk = 0; kk < NQ; ++kk) sc = __builtin_amdgcn_mfma_f32_32x32x16_bf16(kfr[kk], qf[kk], sc, 0, 0, 0);
#define CP_PRE(W, KB, HFK_UNUSED, VB, HFV, DOK, DOV) do { \
        if (DOK) { _Pragma("unroll") for (int kk = ((W) * NQ) / 8; kk < (((W) + 1) * NQ) / 8; ++kk) kfr[kk] = CP_KF(KB, kk); } \
        if (DOV) { _Pragma("unroll") for (int j = ((W) * NP) / 8; j < (((W) + 1) * NP) / 8; ++j) vfr[j] = CP_VF(VB, HFV, j); } } while (0)
#define CP_ITEM(W, DOK, DOV, KB, VB, HFV, KBN, VBN, HFVN) do { \
        ATT_PRIO(1); \
        if (DOK) { _Pragma("unroll") for (int kk = ((W) * NQ) / 8; kk < (((W) + 1) * NQ) / 8; ++kk) sn = __builtin_amdgcn_mfma_f32_32x32x16_bf16(kfr[kk], qf[kk], sn, 0, 0, 0); } \
        if (DOV) { _Pragma("unroll") for (int j = ((W) * NP) / 8; j < (((W) + 1) * NP) / 8; ++j) o[j >> 1] = __builtin_amdgcn_mfma_f32_32x32x16_bf16(vfr[j], pp[j & 1], o[j >> 1], 0, 0, 0); } \
        ATT_PRIO(0); \
        if ((W) + 2 < 8) CP_PRE((W) + 2, KB, 0, VB, HFV, DOK, DOV); else CP_PRE((W) - 6, KBN, 0, VBN, HFVN, true, true); \
        sm_item<MIX, true, W>(sc, st, m_run, l_run, pc, cx, lds, lds, 0, 0, 0, hi, true); ATT_SB(); } while (0)
#define CP_STEP(DOK, DOV, KB, VB, HFV, KBN, VBN, HFVN) do { \
        _Pragma("unroll") for (int i = 0; i < 16; ++i) sn[i] = 0.f; \
        CP_ITEM(0, DOK, DOV, KB, VB, HFV, KBN, VBN, HFVN); CP_ITEM(1, DOK, DOV, KB, VB, HFV, KBN, VBN, HFVN); CP_ITEM(2, DOK, DOV, KB, VB, HFV, KBN, VBN, HFVN); CP_ITEM(3, DOK, DOV, KB, VB, HFV, KBN, VBN, HFVN); \
        CP_ITEM(4, DOK, DOV, KB, VB, HFV, KBN, VBN, HFVN); CP_ITEM(5, DOK, DOV, KB, VB, HFV, KBN, VBN, HFVN); CP_ITEM(6, DOK, DOV, KB, VB, HFV, KBN, VBN, HFVN); CP_ITEM(7, DOK, DOV, KB, VB, HFV, KBN, VBN, HFVN); \
        if (st.resc) { _Pragma("unroll") for (int d = 0; d < DV / 32; ++d) _Pragma("unroll") for (int i = 0; i < 16; ++i) o[d][i] *= st.alpha; } \
        pp[0] = pc[0]; pp[1] = pc[1]; sc = sn; ATT_SB(); } while (0)
    int ks = 0, vs = 0;
    for (int i = 0; i < n; ++i) {
        const int t = t0 + i;
        const int ks1 = (ks == 2) ? 0 : ks + 1, ks2 = (ks == 0) ? 2 : ks - 1, vs1 = (vs == 2) ? 0 : vs + 1, vsp = (vs == 0) ? 2 : vs - 1;
        if (i > 0) asm volatile("s_waitcnt vmcnt(0) lgkmcnt(0)\n\ts_barrier" ::: "memory");
        if (t + 2 < ts) CP_ISSUE_K(t + 2, ks2);
        if (t + 1 < ts) CP_ISSUE_V(t + 1, vs1);
        const LAS unsigned char* kA = kl + ks * KBUF + 32 * (KCH * 16); const LAS unsigned char* kB = kl + ks1 * KBUF; const LAS unsigned char* kAn = kl + ks1 * KBUF + 32 * (KCH * 16);
        const LAS unsigned char* vP = vl + vsp * VBUF; const LAS unsigned char* vC = vl + vs * VBUF;
        if (i == 0) {
            CP_PRE(0, kA, 0, vP, 1, true, false); CP_PRE(1, kA, 0, vP, 1, true, false);
            CP_STEP(true, false, kA, vP, 1, kB, vC, 0);
        } else {
            CP_STEP(true, true, kA, vP, 1, kB, vC, 0);
        }
        CP_STEP(true, true, kB, vC, 0, kAn, vC, 1);
        ks = ks1; vs = vs1;
    }
    {
        const int vsp = (vs == 0) ? 2 : vs - 1; const LAS unsigned char* vP = vl + vsp * VBUF;
#pragma unroll
        for (int j = (2 * NP) / 8; j < NP; ++j) vfr[j] = CP_VF(vP, 1, j);
        ATT_SB();
#pragma unroll
        for (int j = 0; j < NP; ++j) o[j >> 1] = __builtin_amdgcn_mfma_f32_32x32x16_bf16(vfr[j], pp[j & 1], o[j >> 1], 0, 0, 0);
    }
    asm volatile("s_waitcnt lgkmcnt(0)\n\ts_barrier" ::: "memory");
#undef CP_ISSUE_K
#undef CP_ISSUE_V
#undef CP_KF
#undef CP_VF
#undef CP_PRE
#undef CP_ITEM
#undef CP_STEP
}
template <int DV> DI void store_o(const f32x16 (&o)[DV / 32], float scale, bf16_t* orow, int hi) {
#pragma unroll
    for (int d = 0; d < DV / 32; ++d)
#pragma unroll
        for (int a = 0; a < 4; ++a) { u32x2 w; w.x = cvtpk(o[d][4 * a] * scale, o[d][4 * a + 1] * scale); w.y = cvtpk(o[d][4 * a + 2] * scale, o[d][4 * a + 3] * scale); *(u32x2*)(orow + d * 32 + 8 * a + 4 * hi) = w; }
}

DI int wg_min_pos(const Frame& F, int pq) {
#pragma unroll
    for (int o = 1; o < 64; o <<= 1) { const int other = __shfl_xor(pq, o); pq = other < pq ? other : pq; }
    if (F.tid == 0) F.MISC[5] = 0x7fffffffu;
    __syncthreads();
    if (F.lane == 0) atomicMin((int*)&F.MISC[5], pq);
    __syncthreads();
    const int v = (int)F.MISC[5];
    __syncthreads();
    return v;
}
DI void unit_D(const Frame& F, const Args& a, int h, int qt) {
    const int lane = F.lane, r = lane & 31, hi = lane >> 5, qi = qt * 256 + F.wave * 32 + r;
    const bf16_t* QD = wsb(F, WS_QD) + (size_t)qi * 768 + h * 192 + hi * 8;
    bf16x8 qf[12];
#pragma unroll
    for (int kk = 0; kk < 12; ++kk) qf[kk] = *(const bf16x8*)(QD + kk * 16);
    f32x16 o[4];
#pragma unroll
    for (int d = 0; d < 4; ++d)
#pragma unroll
        for (int i = 0; i < 16; ++i) o[d][i] = 0.f;
    float m = NEG, l = 0.f;
    Ctx cx; cx.qi = qi; cx.pq = 0; cx.own = 0; cx.sel = 0ull; cx.cb = 0.f; cx.c = 0.07216878364870322f * LOG2E;
    const int ts = qt * 4;
    if (ATT_CP_D && ts > 0) flash_pass_cp<192, 128, MIX_D>(F.lds, qf, wsb(F, WS_KD) + h * 192, 768, wsb(F, WS_VDT) + (size_t)(h * 128) * S, S, 0, ts, cx, o, m, l);
    flash_pass<192, 128, MIX_D>(F.lds, qf, wsb(F, WS_KD) + h * 192, 768, wsb(F, WS_VDT) + (size_t)(h * 128) * S, S, (const int*)a.in[1], ATT_CP_D ? ts : 0, (qt + 1) * 4, qt * 256, 0, cx, o, m, l, ATT_CP_D ? ts : -1);
    l += xhalf(l);
    store_o<128>(o, 1.0f / l, wsb(F, WS_O) + (size_t)3 * S * 512 + (size_t)qi * 512 + h * 128, hi);
}
DI void unit_C(const Frame& F, const Args& a, int h, int qt, int mp) {
    const int lane = F.lane, r = lane & 31, hi = lane >> 5, qi = qt * 256 + F.wave * 32 + r;
    const int* pos = (const int*)a.in[1];
    build_tbl(F.lds, a.in[2], 12 + h, (const int*)(F.ws + WS_TPMAX));
    Ctx cx; cx.qi = qi; cx.pq = pos[qi]; cx.own = 0; cx.sel = 0ull; cx.c = 0.125f * LOG2E; cx.cb = a.in[2][31 * 16 + 12 + h] * LOG2E;
    const int qpmin = wg_min_pos(F, cx.pq);
    const bf16_t* H = wsb(F, WS_H);
    const bf16_t* Q = H + (size_t)qi * HW + H_CQ + h * 128 + mp * 64 + hi * 8;
    bf16x8 qf[4];
#pragma unroll
    for (int kk = 0; kk < 4; ++kk) qf[kk] = *(const bf16x8*)(Q + kk * 16);
    f32x16 o[4];
#pragma unroll
    for (int d = 0; d < 4; ++d)
#pragma unroll
        for (int i = 0; i < 16; ++i) o[d][i] = 0.f;
    float m = NEG, l = 0.f;
    const int ts = ATT_CP ? fast_split(F.lds, 0, (qt + 1) * 4, qt * 256, qpmin, lane) : 0;
    if (ATT_CP && ts > 0) flash_pass_cp<64, 128, MIX_C>(F.lds, qf, H + H_CK + h * 128 + mp * 64, HW, wsb(F, WS_VT) + (size_t)(VT_C + h * 128) * S, S, 0, ts, cx, o, m, l);
    flash_pass<64, 128, MIX_C>(F.lds, qf, H + H_CK + h * 128 + mp * 64, HW, wsb(F, WS_VT) + (size_t)(VT_C + h * 128) * S, S, pos, ATT_CP ? ts : 0, (qt + 1) * 4, qt * 256, qpmin, cx, o, m, l, ATT_CP ? ts : -1);
    l += xhalf(l);
    bf16_t* orow = (mp == 0 ? wsb(F, WS_O) + (size_t)2 * S * 512 : wsb(F, WS_OC2)) + (size_t)qi * 512 + h * 128;
    store_o<128>(o, 1.0f / l, orow, hi);
}
DI void unit_B(const Frame& F, const Args& a, int layer, int hq, int qt) {
    const int lane = F.lane, r = lane & 31, hi = lane >> 5, qi = qt * 256 + F.wave * 32 + r, g = hq >> 2;
    const int* pos = (const int*)a.in[1];
    build_tbl(F.lds, a.in[2], 4 + hq, (const int*)(F.ws + WS_TPMAX));
    const bf16_t* H = wsb(F, WS_H);
    const bf16_t* Q = H + (size_t)qi * HW + H_BQ + hq * 64 + hi * 8;
    bf16x8 qf[4];
#pragma unroll
    for (int kk = 0; kk < 4; ++kk) qf[kk] = *(const bf16x8*)(Q + kk * 16);
    f32x16 o[2];
#pragma unroll
    for (int d = 0; d < 2; ++d)
#pragma unroll
        for (int i = 0; i < 16; ++i) o[d][i] = 0.f;
    float m = NEG, l = 0.f;
    Ctx cx; cx.qi = qi; cx.pq = pos[qi]; cx.own = 0; cx.sel = 0ull; cx.c = 0.125f * LOG2E; cx.cb = a.in[2][31 * 16 + 4 + hq] * LOG2E;
    const int t0 = (qt * 4 - 2) < 0 ? 0 : (qt * 4 - 2);
    flash_pass<64, 64, MIX_B>(F.lds, qf, H + H_BK + g * 64, HW, wsb(F, WS_VT) + (size_t)(VT_B + g * 64) * S, S, pos, t0, (qt + 1) * 4, qt * 256, 0, cx, o, m, l);
    l += xhalf(l);
    l += ex2(a.in[8][layer * 8 + hq] * LOG2E - m);
    store_o<64>(o, 1.0f / l, wsb(F, WS_O) + (size_t)1 * S * 512 + (size_t)qi * 512 + hq * 64, hi);
}
DI void store_part(const f32x16 (&o)[4], float m, float l, unsigned char* prow, int hi) {
    l += xhalf(l);
    store_o<128>(o, 1.0f / l, (bf16_t*)prow, hi);
    if (hi == 0) *(f32x2*)(prow + 256) = (f32x2){m, l};
}
DI void unit_A_own(const Frame& F, const Args& a, int h, int qt) {
    const int lane = F.lane, r = lane & 31, hi = lane >> 5, qi = qt * 256 + F.wave * 32 + r;
    const int* pos = (const int*)a.in[1];
    build_tbl(F.lds, a.in[2], h, (const int*)(F.ws + WS_TPMAX));
    const bf16_t* H = wsb(F, WS_H);
    const bf16_t* Q = H + (size_t)qi * HW + H_AQ + h * 128 + hi * 8;
    bf16x8 qf[8];
#pragma unroll
    for (int kk = 0; kk < 8; ++kk) qf[kk] = *(const bf16x8*)(Q + kk * 16);
    f32x16 o[4];
#pragma unroll
    for (int d = 0; d < 4; ++d)
#pragma unroll
        for (int i = 0; i < 16; ++i) o[d][i] = 0.f;
    float m = NEG, l = 0.f;
    Ctx cx; cx.qi = qi; cx.pq = pos[qi]; cx.own = qt; cx.sel = 0ull; cx.c = 0.08838834764831845f * LOG2E; cx.cb = a.in[2][31 * 16 + h] * LOG2E;
    flash_pass<128, 128, MIX_C>(F.lds, qf, H + H_AK + h * 128, HW, wsb(F, WS_VT) + (size_t)(VT_A + h * 128) * S, S, pos, qt * 4, (qt + 1) * 4, 0, 0, cx, o, m, l);
    store_part(o, m, l, F.ws + WS_PART + ((size_t)qi * 16 + h * 4 + 3) * 272, hi);
}
DI void unit_A_gather(const Frame& F, const Args& a, int h, int n, int near, int chunk, int count) {
    const int lane = F.lane, r = lane & 31, hi = lane >> 5;
    const int* pos = (const int*)a.in[1];
    if (near) build_tbl(F.lds, a.in[2], h, (const int*)(F.ws + WS_TPMAX));
    const int* list = (const int*)(F.ws + WS_MLIST) + (size_t)(h * 64 + n) * MCAP + (near ? MCAP_F : 0);
    const int idx = chunk * 256 + F.wave * 32 + r; const bool live = idx < count;
    const int e = list[live ? idx : chunk * 256];
    const int qi = e >> 2, slot = e & 3;
    const bf16_t* H = wsb(F, WS_H);
    const bf16_t* Q = H + (size_t)qi * HW + H_AQ + h * 128 + hi * 8;
    bf16x8 qf[8];
#pragma unroll
    for (int kk = 0; kk < 8; ++kk) qf[kk] = *(const bf16x8*)(Q + kk * 16);
    f32x16 o[4];
#pragma unroll
    for (int d = 0; d < 4; ++d)
#pragma unroll
        for (int i = 0; i < 16; ++i) o[d][i] = 0.f;
    float m = NEG, l = 0.f;
    Ctx cx; cx.qi = 0x7fffffff; cx.pq = pos[qi]; cx.own = 0; cx.sel = 0ull; cx.c = 0.08838834764831845f * LOG2E; cx.cb = a.in[2][31 * 16 + h] * LOG2E;
    flash_pass<128, 128, MIX_C>(F.lds, qf, H + H_AK + h * 128, HW, wsb(F, WS_VT) + (size_t)(VT_A + h * 128) * S, S, pos, n * 4, (n + 1) * 4, 0, 0, cx, o, m, l, near ? n * 4 : (n + 1) * 4);
    if (live) store_part(o, m, l, F.ws + WS_PART + ((size_t)qi * 16 + h * 4 + slot) * 272, hi);
    else { l += xhalf(l); }
}
}

DI int next_unit(const Frame& F, unsigned* head) {
    if (F.tid == 0) F.MISC[4] = __hip_atomic_fetch_add(head, 1u, __ATOMIC_RELAXED, __HIP_MEMORY_SCOPE_AGENT);
    __syncthreads();
    const int u = (int)F.MISC[4];
    __syncthreads();
    return u;
}
DI void convert_chunk(const Frame& F, const Args& a, int layer, int c) {
    const bool isv = c >= 256; const int row0 = (c & 255) * 64 + F.wave * 8;
    const float* src = (isv ? a.in[23] : a.in[22]) + (size_t)layer * 16384 * DM + (size_t)row0 * DM;
    unsigned char* dst = F.ws + WS_UB + (size_t)row0 * 2048 + (isv ? 1024 : 0);
    const float scale = isv ? V_SCALE : U_SCALE;
    int lane = F.lane; asm volatile("" : "+v"(lane));
    for (int j = 0; j < 8; ++j) {
        const float* p = src + (size_t)j * DM + 4 * lane; unsigned char* q = dst + (size_t)j * 2048 + 2 * lane;
        f32x4 x[8];
#pragma unroll
        for (int k = 0; k < 8; ++k) x[k] = *(const f32x4*)(p + 256 * k);
#pragma unroll
        for (int k = 0; k < 8; ++k) { unsigned d = 0u; const f32x4 y = x[k] * scale;
            d = __builtin_amdgcn_cvt_scalef32_pk_fp4_f32(d, y[0], y[1], 1.0f, 0); d = __builtin_amdgcn_cvt_scalef32_pk_fp4_f32(d, y[2], y[3], 1.0f, 1);
            *(unsigned short*)(q + 128 * k) = (unsigned short)d; }
    }
}
template <int PART> DI void phase_attention(const Frame& F, const Args& a, int layer, int rep = 0) {
    unsigned* q = (unsigned*)(F.ws + WS_CTL) + CW_Q + layer * 256 + rep * 512;
    if constexpr (PART == 0) {
#if !defined(NO_D) && !defined(NO_C)
    for (;;) { const int u = next_unit(F, q + 0); if (u >= 768) break;
        const int qt = 63 - u / 12, k = u % 12;
        if (k < 4) att::unit_D(F, a, k, qt);
        else att::unit_C(F, a, (k - 4) >> 1, qt, (k - 4) & 1);
        if (ATT_CONV_INTERLEAVE) { const int c = next_unit(F, q + 32); if (c < 512) convert_chunk(F, a, layer, c); } }
    if (ATT_CONV_INTERLEAVE) for (;;) { const int c = next_unit(F, q + 32); if (c >= 512) break; convert_chunk(F, a, layer, c); }
#endif
    } else {
#ifndef NO_A
    {
        const unsigned* cnt = (const unsigned*)(F.ws + WS_CTL) + CW_MOBA + layer * 1024;
        LAS int* pre = (LAS int*)(F.lds + att::TBL - 4096);
        __syncthreads();
        if (F.tid == 0) { int acc = 0; for (int i = 0; i < 512; ++i) { pre[i] = acc; const unsigned c = cnt[i], cap = (i >= 256) ? (unsigned)(MCAP - MCAP_F) : (unsigned)MCAP_F; acc += (int)(((c < cap ? c : cap) + 255u) >> 8); } pre[512] = acc; }
        __syncthreads();
        const int ntot = 256 + pre[512];
        for (;;) { const int u = next_unit(F, q + 128); if (u >= ntot) break;
            if (u < 256) { att::unit_A_own(F, a, u & 3, 63 - (u >> 2)); continue; }
            const int g = u - 256; int lo_ = 0, hi_ = 511;
            while (lo_ < hi_) { const int mid = (lo_ + hi_ + 1) >> 1; if (pre[mid] <= g) lo_ = mid; else hi_ = mid - 1; }
            const unsigned c = cnt[lo_], cap = (lo_ >= 256) ? (unsigned)(MCAP - MCAP_F) : (unsigned)MCAP_F;
            att::unit_A_gather(F, a, (lo_ >> 6) & 3, lo_ & 63, lo_ >> 8, g - pre[lo_], (int)(c < cap ? c : cap)); }
    }
#endif
#ifndef NO_B
    for (;;) { const int u = next_unit(F, q + 192); if (u >= 512) break; att::unit_B(F, a, layer, u & 7, u >> 3); }
#endif
    }
}

DI void ins16(float (&v)[16], float x) {
#pragma unroll
    for (int k = 0; k < 16; ++k) { const float t = fmaxf(v[k], x); x = fminf(v[k], x); v[k] = t; }
}
DI float pack_idx(float s, int idx, unsigned mask) { return __uint_as_float((__float_as_uint(s) & ~mask) | (unsigned)idx); }
DI void peer_select_group(const Frame& F, const bf16_t* SK, int grp, LAS unsigned char* sel) {
    const bf16_t* QP = wsb(F, WS_H);
    int lane = F.lane; asm volatile("" : "+v"(lane));
    const int r = lane & 31, hi = lane >> 5;
    {
        const int h = F.wave, t = grp * 32 + r;
        float L[2][16];
#pragma unroll
        for (int m = 0; m < 2; ++m) {
            const bf16_t* qrow = QP + (size_t)t * DM + h * 256 + m * 128 + hi * 8;
            bf16x8 qf[8];
#pragma unroll
            for (int kk = 0; kk < 8; ++kk) qf[kk] = *(const bf16x8*)(qrow + kk * 16);
            const bf16_t* kb = SK + ((size_t)(h * 2 + m) * 128 + r) * 128 + hi * 8;
            float v[16];
#pragma unroll
            for (int k = 0; k < 16; ++k) v[k] = -3.0e38f;
#pragma unroll
            for (int rb = 0; rb < 4; ++rb) {
                f32x16 s;
#pragma unroll
                for (int i = 0; i < 16; ++i) s[i] = 0.f;
#pragma unroll
                for (int kk = 0; kk < 8; ++kk) { const bf16x8 kf = *(const bf16x8*)(kb + (size_t)rb * 32 * 128 + kk * 16); s = __builtin_amdgcn_mfma_f32_32x32x16_bf16(kf, qf[kk], s, 0, 0, 0); }
#pragma unroll
                for (int i = 0; i < 16; ++i) ins16(v, pack_idx(s[i], rb * 32 + (i & 3) + 8 * (i >> 2) + 4 * hi, 127u));
                asm volatile("" : "+v"(v[0]), "+v"(v[1]), "+v"(v[2]), "+v"(v[3]), "+v"(v[4]), "+v"(v[5]), "+v"(v[6]), "+v"(v[7]), "+v"(v[8]), "+v"(v[9]), "+v"(v[10]), "+v"(v[11]), "+v"(v[12]), "+v"(v[13]), "+v"(v[14]), "+v"(v[15]));
                asm volatile("" : "+v"(kb));
            }
            float ov[16];
#pragma unroll
            for (int k = 0; k < 16; ++k) ov[k] = xhalf(v[k]);
#pragma unroll
            for (int k = 0; k < 16; ++k) ins16(v, ov[k]);
#pragma unroll
            for (int k = 0; k < 16; ++k) L[m][k] = v[k];
        }
        int i0[16], i1[16];
#pragma unroll
        for (int k = 0; k < 16; ++k) { i0[k] = (int)(__float_as_uint(L[0][k]) & 127u); i1[k] = (int)(__float_as_uint(L[1][k]) & 127u); L[0][k] = __uint_as_float(__float_as_uint(L[0][k]) & ~127u); L[1][k] = __uint_as_float(__float_as_uint(L[1][k]) & ~127u); }
        float b[16];
#pragma unroll
        for (int k = 0; k < 16; ++k) b[k] = -3.0e38f;
#pragma unroll
        for (int i = 0; i < 16; ++i)
#pragma unroll
            for (int j = 0; j < 16; ++j) if ((i + 1) * (j + 1) <= 16) ins16(b, pack_idx(L[0][i] + L[1][j], i * 16 + j, 255u));
        float g[16]; int e[16]; float den = 0.f;
        const float b0 = __uint_as_float(__float_as_uint(b[0]) & ~255u);
#pragma unroll
        for (int k = 0; k < 16; ++k) {
            const unsigned bits = __float_as_uint(b[k]); const int ci = (int)((bits >> 4) & 15u), cj = (int)(bits & 15u);
            int e0 = i0[0], e1 = i1[0];
#pragma unroll
            for (int c = 1; c < 16; ++c) { e0 = (ci == c) ? i0[c] : e0; e1 = (cj == c) ? i1[c] : e1; }
            e[k] = e0 * 128 + e1;
            g[k] = ex2((__uint_as_float(bits & ~255u) - b0) * LOG2E); den += g[k];
        }
        const float inv = 1.0f / den;
        if (hi == 0) {
#pragma unroll
            for (int k = 0; k < 16; k += 4) *(LAS i32x4*)(sel + (r * 128 + h * 16 + k) * 4) = (i32x4){e[k], e[k + 1], e[k + 2], e[k + 3]};
        } else {
#pragma unroll
            for (int k = 0; k < 16; k += 4) *(LAS f32x4*)(sel + 16384 + (r * 128 + h * 16 + k) * 4) = (f32x4){g[k] * inv, g[k + 1] * inv, g[k + 2] * inv, g[k + 3] * inv};
        }
    }
}
DI float gelu_as(float v) {
    const float av = fabsf(v), t = __builtin_amdgcn_rcpf(av * 0.2316418882f + 1.0f);
    float q = t * 0.5307027145f + (-0.7265760135f); q = q * t + 0.7107068705f; q = q * t + (-0.142248368f); q = q * t + 0.127414796f; q = q * t;
    const float e = ex2((v * v) * (-0.72134752044f));
    const float m = v * (q * e);
    return v < 0.f ? m : v - m;
}
template <int CTRL, int RM> DI float dpp_add(float v) { return v + __builtin_bit_cast(float, __builtin_amdgcn_update_dpp(0, __builtin_bit_cast(int, v), CTRL, RM, 0xf, RM == 0xf)); }
DI float wave_total(float v) {
    v = dpp_add<0x111, 0xf>(v); v = dpp_add<0x112, 0xf>(v); v = dpp_add<0x114, 0xf>(v); v = dpp_add<0x118, 0xf>(v);
    v = dpp_add<0x142, 0xa>(v); v = dpp_add<0x143, 0xc>(v);
    return __uint_as_float(__builtin_amdgcn_readlane(__float_as_uint(v), 63));
}
DI void reduce4(float (&d)[4], int lane) {
#pragma unroll
    for (int i = 0; i < 4; ++i) d[i] = wave_total(d[i]);
}
DI void peer_gather_group(const Frame& F, const Args& a, int layer, float* outf, bf16_t* XB, int grp, const LAS unsigned char* sel) {
    typedef int v8i_t __attribute__((ext_vector_type(8)));
    const unsigned char* UB = F.ws + WS_UB;
    int lane = F.lane; asm volatile("" : "+v"(lane));
    const int m16 = lane & 15, g4 = lane >> 4;
    LAS unsigned char* x8 = F.lds + 65536 + F.wave * 2048;
    int sc = 0x7f7f7f7f; asm volatile("" : "+v"(sc));
    for (int ti = 0; ti < 4; ++ti) {
        const int tl = F.wave * 4 + ti, t = grp * 32 + tl;
        const bf16_t* xr = XB + (size_t)t * DM + 32 * lane;
        {
            u32x4 w8[2];
#pragma unroll
            for (int c = 0; c < 4; ++c) { const u32x4 w = *(const u32x4*)(xr + 8 * c);
#if PEER_X_SWAP
                int lo = __builtin_amdgcn_cvt_pk_fp8_f32(bf_hi(w.x), bf_lo(w.x), 0, false); lo = __builtin_amdgcn_cvt_pk_fp8_f32(bf_hi(w.y), bf_lo(w.y), lo, true);
                int hi = __builtin_amdgcn_cvt_pk_fp8_f32(bf_hi(w.z), bf_lo(w.z), 0, false); hi = __builtin_amdgcn_cvt_pk_fp8_f32(bf_hi(w.w), bf_lo(w.w), hi, true);
#else
                int lo = __builtin_amdgcn_cvt_pk_fp8_f32(bf_lo(w.x), bf_hi(w.x), 0, false); lo = __builtin_amdgcn_cvt_pk_fp8_f32(bf_lo(w.y), bf_hi(w.y), lo, true);
                int hi = __builtin_amdgcn_cvt_pk_fp8_f32(bf_lo(w.z), bf_hi(w.z), 0, false); hi = __builtin_amdgcn_cvt_pk_fp8_f32(bf_lo(w.w), bf_hi(w.w), hi, true);
#endif
                w8[c >> 1][(c & 1) * 2] = (unsigned)lo; w8[c >> 1][(c & 1) * 2 + 1] = (unsigned)hi; }
            *(LAS u32x4*)(x8 + 32 * lane) = w8[0]; *(LAS u32x4*)(x8 + 32 * lane + 16) = w8[1];
        }
        f32x2 acc[16];
#pragma unroll
        for (int e = 0; e < 16; ++e) acc[e] = (f32x2){0.f, 0.f};
        for (int half = 0; half < 2; ++half) {
            const int ev = *(const LAS int*)(sel + (tl * 128 + half * 64 + lane) * 4); const float gv = *(const LAS float*)(sel + 16384 + (tl * 128 + half * 64 + lane) * 4);
            for (int bb = 0; bb < 4; ++bb) {
                const int em = __builtin_amdgcn_ds_bpermute((16 * bb + m16) << 2, ev);
                const unsigned char* up = UB + (size_t)em * 2048 + 16 * g4;
                u32x4 ua[16], va[16];
#pragma unroll
                for (int s = 0; s < 16; ++s) ua[s] = *(const u32x4*)(up + 64 * s);
#pragma unroll
                for (int j = 0; j < 16; ++j) { const int e = __builtin_amdgcn_readlane(ev, 16 * bb + j); va[j] = *(const u32x4*)(UB + (size_t)e * 2048 + 1024 + 16 * lane); }
                f32x4 h = (f32x4){0.f, 0.f, 0.f, 0.f};
#pragma unroll
                for (int s = 0; s < 16; ++s) {
                    const u32x4 x0 = *(const LAS u32x4*)(x8 + 128 * s + 16 * g4), x1 = *(const LAS u32x4*)(x8 + 128 * s + 64 + 16 * g4);
                    const v8i_t xb = (v8i_t){(int)x0.x, (int)x0.y, (int)x0.z, (int)x0.w, (int)x1.x, (int)x1.y, (int)x1.z, (int)x1.w};
                    asm volatile("s_nop 1\n\tv_mfma_scale_f32_16x16x128_f8f6f4 %0, %1, %2, %0, %3, %3 op_sel_hi:[0,0,0] cbsz:4" : "+v"(h) : "v"(ua[s]), "v"(xb), "v"(sc));
                }
                asm volatile("s_nop 15" : "+v"(h));
                float hv[4];
#pragma unroll
                for (int i = 0; i < 4; ++i) { const float gq = __int_as_float(__builtin_amdgcn_ds_bpermute((16 * bb + 4 * g4 + i) << 2, __float_as_int(gv)));
                    hv[i] = gq * gelu_as(h[i] * (1.0f / U_SCALE)) * (1.0f / V_SCALE); }
#pragma unroll
                for (int j = 0; j < 16; ++j) {
                    const float wk = __uint_as_float(__builtin_amdgcn_readlane(__float_as_uint(hv[j & 3]), 16 * (j >> 2)));
                    const f32x2 wk2 = (f32x2){wk, wk}; const u32x4 w_ = va[j];
#define FP4_ACC(b) acc[b] += __builtin_amdgcn_cvt_scalef32_pk_f32_fp4(w_[(b) >> 2], 1.0f, (b) & 3) * wk2;
                    FP4_ACC(0) FP4_ACC(1) FP4_ACC(2) FP4_ACC(3) FP4_ACC(4) FP4_ACC(5) FP4_ACC(6) FP4_ACC(7) FP4_ACC(8) FP4_ACC(9) FP4_ACC(10) FP4_ACC(11) FP4_ACC(12) FP4_ACC(13) FP4_ACC(14) FP4_ACC(15)
#undef FP4_ACC
                }
            }
        }
        float z[1][32];
#pragma unroll
        for (int c = 0; c < 4; ++c) { const u32x4 w = *(const u32x4*)(xr + 8 * c);
            z[0][8 * c + 0] = acc[4 * c].x + DN_ALPHA * bf_lo(w.x); z[0][8 * c + 1] = acc[4 * c].y + DN_ALPHA * bf_hi(w.x); z[0][8 * c + 2] = acc[4 * c + 1].x + DN_ALPHA * bf_lo(w.y); z[0][8 * c + 3] = acc[4 * c + 1].y + DN_ALPHA * bf_hi(w.y);
            z[0][8 * c + 4] = acc[4 * c + 2].x + DN_ALPHA * bf_lo(w.z); z[0][8 * c + 5] = acc[4 * c + 2].y + DN_ALPHA * bf_hi(w.z); z[0][8 * c + 6] = acc[4 * c + 3].x + DN_ALPHA * bf_lo(w.w); z[0][8 * c + 7] = acc[4 * c + 3].y + DN_ALPHA * bf_hi(w.w); }
        ln_store<1, 32>(z, a.in[24] + layer * DM, a.in[25] + layer * DM, outf ? outf + (size_t)t * DM : (float*)nullptr, XB + (size_t)t * DM, lane, outf ? (unsigned char*)nullptr : F.ws + WS_XB8 + (size_t)t * DM, outf ? (unsigned char*)nullptr : F.ws + WS_XB4 + (size_t)t * (DM / 2));
    }
}
DI void phase_peer(const Frame& F, const Args& a, int layer, const bf16_t* SK, float* outf) {
    LAS unsigned char* sel = F.lds;
    bf16_t* XB = wsb(F, WS_XB);
    const int g0 = F.vcu, g1 = F.vcu + F.G, ng = S / 32;
    if (F.vcu & 1) {
        if (g0 < ng) peer_select_group(F, SK, g0, sel);
        if (g1 < ng) peer_select_group(F, SK, g1, sel + 32768);
        __syncthreads();
        if (g0 < ng) peer_gather_group(F, a, layer, outf, XB, g0, sel);
        if (g1 < ng) peer_gather_group(F, a, layer, outf, XB, g1, sel + 32768);
    } else {
        if (g0 < ng) peer_select_group(F, SK, g0, sel);
        __syncthreads();
        if (g0 < ng) peer_gather_group(F, a, layer, outf, XB, g0, sel);
        if (g1 < ng) peer_select_group(F, SK, g1, sel + 32768);
        __syncthreads();
        if (g1 < ng) peer_gather_group(F, a, layer, outf, XB, g1, sel + 32768);
    }
    for (int g = F.vcu + 2 * F.G; g < ng; g += F.G) { __syncthreads(); peer_select_group(F, SK, g, sel); __syncthreads(); peer_gather_group(F, a, layer, outf, XB, g, sel); }
}

#ifndef GEMM_SP2
#define GEMM_SP2 true
#endif
#ifndef GEMM_ALIGN_EPI
#define GEMM_ALIGN_EPI true
#endif
template <int MODE, bool F8 = false, int SC0 = 127, int SC1 = 127, bool F4 = false> DI void run_gemm(const Frame& F, const bf16_t* A, int lda, const bf16_t* Bt, int ldb, int M, int N, int K, long apn, const pg8::Epi<MODE>& E, int rot = 0) {
    pg8::Gemm g{A, Bt, M, N, K, lda, ldb, apn}; pg8::StaticOrder So; So.init(M, N, F.G, (F.G == 256) ? (int)((blockIdx.x + (unsigned)rot) & 255u) : (int)blockIdx.x);
    pg8::gemm_phase<pg8::Epi<MODE>, pg8::StaticOrder, GEMM_ALIGN_EPI, GEMM_SP2, F8, SC0, SC1, F4>(F.lds, g, So, E);
}
#ifndef MK_CHECK
#define MK_CHECK 0
#endif
#ifndef MK_CHECK_WORD
#define MK_CHECK_WORD 0
#endif

#if MK_CHECK
namespace chk {
constexpr int NS = 64;
__device__ const int SAMPLES[NS] = {0, 1, 2, 31, 32, 63, 64, 127, 128, 129, 255, 256, 257, 300, 383, 384, 511, 512, 513, 767, 768, 1000, 1023, 1024, 1025, 1279, 1280, 2047, 2048, 2049, 3071, 3072,
    4095, 4096, 5000, 6143, 6144, 7777, 8191, 8192, 8193, 9999, 10239, 10240, 11111, 12287, 12288, 12289, 13000, 13311, 13312, 14000, 14335, 14336, 15000, 15359, 15360, 15871, 16127, 16128, 16129, 16255, 16256, 16383};
DI float bsum(const Frame& F, float v) {
    v = wave_sum(v);
    __syncthreads();
    if (F.lane == 0) F.MISC[16 + F.wave] = __float_as_uint(v);
    __syncthreads();
    float s = 0.f;
    for (int w = 0; w < 8; ++w) s += __uint_as_float(F.MISC[16 + w]);
    return s;
}
DI float bmax(const Frame& F, float v) {
#pragma unroll
    for (int o = 1; o < 64; o <<= 1) v = fmaxf(v, __shfl_xor(v, o));
    __syncthreads();
    if (F.lane == 0) F.MISC[16 + F.wave] = __float_as_uint(v);
    __syncthreads();
    float s = -INFINITY;
    for (int w = 0; w < 8; ++w) s = fmaxf(s, __uint_as_float(F.MISC[16 + w]));
    return s;
}
DI void verdict(const Frame& F, float err, float nrm, float tol, int code) {
    const float e = bsum(F, err), n = bsum(F, nrm);
    if (F.tid == 0) { const bool bad = !(e <= tol * tol * n + 1e-12f); if (bad) { atomicAdd((unsigned*)(F.ws + WS_CTL) + CW_CHK, 1u); atomicAdd((unsigned*)(F.ws + WS_CTL) + CW_CHK + 64 * (1 + code), 1u); } }
}
DI float sigm(float z) { return 1.0f / (1.0f + expf(-z)); }
DI float rope_inv(int j) { return powf(10000.0f, -(float)j / 32.0f); }
DI float t5_naive(const float* t5, int col, int rel) {
    int n = rel > 0 ? rel : 0; int b;
    if (n < 16) b = n; else { b = 16 + (int)(logf((float)n / 16.0f) / logf(64.0f) * 16.0f); if (b > 31) b = 31; }
    return t5[b * 16 + col];
}
DI void s1(const Frame& F, const Args& a, int layer) {
    const bf16_t* X = wsb(F, WS_XB); const float* W = a.in[3] + (size_t)layer * DM * 4672;
    const bf16_t* H = wsb(F, WS_H); const bf16_t* VT = wsb(F, WS_VT);
    for (int u = F.vcu; u < NS; u += F.G) { const int t = SAMPLES[u]; float err = 0.f, nrm = 0.f;
        for (int c = F.tid; c < 4672; c += 512) { float ref = 0.f; for (int k = 0; k < DM; ++k) ref += bf1(X[(size_t)t * DM + k]) * W[(size_t)k * 4672 + c];
            const int d = win_map(c); const float got = d < HW ? bf1(H[(size_t)t * HW + d]) : bf1(VT[(size_t)(d - HW) * S + t]); err += (ref - got) * (ref - got); nrm += ref * ref; }
        verdict(F, err, nrm, 0.06f, 0); }
}
DI void s2(const Frame& F, const Args& a, int layer) {
    const bf16_t* H = wsb(F, WS_H); const int* pos = (const int*)a.in[1];
    for (int u = F.vcu; u < NS; u += F.G) { const int t = SAMPLES[u]; float err = 0.f, nrm = 0.f;
        float ssq = 0.f; for (int k = 0; k < 512; ++k) { const float v = bf1(H[(size_t)t * HW + H_DCQ + k]); ssq += v * v; }
        const float rq = 1.0f / sqrtf(ssq / 512.0f + 1e-6f);
        float ssk = 0.f; for (int k = 0; k < 256; ++k) { const float v = bf1(H[(size_t)t * HW + H_DCKV + k]); ssk += v * v; }
        const float rk = 1.0f / sqrtf(ssk / 256.0f + 1e-6f);
        for (int c = F.tid; c < 512; c += 512) { const float ref = bf1(H[(size_t)t * HW + H_DCQ + c]) * rq * a.in[14][layer * 512 + c]; const float got = bf1(wsb(F, WS_CQN)[(size_t)t * 512 + c]); err += (ref - got) * (ref - got); nrm += ref * ref; }
        for (int c = F.tid; c < 256; c += 512) { const float ref = bf1(H[(size_t)t * HW + H_DCKV + c]) * rk * a.in[15][layer * 256 + c]; const float got = bf1(wsb(F, WS_CKVN)[(size_t)t * 256 + c]); err += (ref - got) * (ref - got); nrm += ref * ref; }
        for (int c = F.tid; c < 256; c += 512) { const int h = c >> 6, j = c & 63, jj = j & 31; const float x1 = bf1(H[(size_t)t * HW + H_DKR + jj]), x2 = bf1(H[(size_t)t * HW + H_DKR + jj + 32]);
            const float ang = (float)pos[t] * rope_inv(jj); const float ref = j < 32 ? x1 * cosf(ang) - x2 * sinf(ang) : x1 * sinf(ang) + x2 * cosf(ang);
            const float got = bf1(wsb(F, WS_KD)[(size_t)t * 768 + h * 192 + 128 + j]); err += (ref - got) * (ref - got); nrm += ref * ref; }
        verdict(F, err, nrm, 0.02f, 1); }
}
DI void s3(const Frame& F, const Args& a, int layer) {
    const int* pos = (const int*)a.in[1]; const float* Wq = a.in[16] + (size_t)layer * 512 * 768; const float* Wkv = a.in[17] + (size_t)layer * 256 * 1024;
    LAS float* pre = (LAS float*)F.lds;
    for (int u = F.vcu; u < NS; u += F.G) { const int t = SAMPLES[u]; float err = 0.f, nrm = 0.f;
        __syncthreads();
        for (int n = F.tid; n < 768; n += 512) { float r = 0.f; for (int k = 0; k < 512; ++k) r += bf1(wsb(F, WS_CQN)[(size_t)t * 512 + k]) * Wq[(size_t)k * 768 + n]; pre[n] = r; }
        __syncthreads();
        for (int n = F.tid; n < 768; n += 512) { const int h = n / 192, j = n % 192; float ref = pre[n];
            if (j >= 128) { const int jj = (j - 128) & 31; const float x1 = pre[h * 192 + 128 + jj], x2 = pre[h * 192 + 128 + jj + 32]; const float ang = (float)pos[t] * rope_inv(jj);
                ref = (j - 128) < 32 ? x1 * cosf(ang) - x2 * sinf(ang) : x1 * sinf(ang) + x2 * cosf(ang); }
            const float got = bf1(wsb(F, WS_QD)[(size_t)t * 768 + n]); err += (ref - got) * (ref - got); nrm += ref * ref; }
        for (int n = F.tid; n < 1024; n += 512) { float ref = 0.f; for (int k = 0; k < 256; ++k) ref += bf1(wsb(F, WS_CKVN)[(size_t)t * 256 + k]) * Wkv[(size_t)k * 1024 + n];
            const int h = n >> 8, j = n & 255; const float got = j < 128 ? bf1(wsb(F, WS_KD)[(size_t)t * 768 + h * 192 + j]) : bf1(wsb(F, WS_VDT)[(size_t)(h * 128 + j - 128) * S + t]);
            err += (ref - got) * (ref - got); nrm += ref * ref; }
        verdict(F, err, nrm, 0.02f, 2); }
}
DI void s4(const Frame& F, const Args& a, int layer) {
    const int* pos = (const int*)a.in[1]; const float* t5 = a.in[2]; const bf16_t* H = wsb(F, WS_H);
    LAS float* lg = (LAS float*)F.lds;
    LAS float* qv = (LAS float*)(F.lds + 65536);
    LAS float* ga = (LAS float*)(F.lds + 65536 + 1024);
    LAS float* op = (LAS float*)(F.lds + 65536 + 2048);
    LAS float* o1 = (LAS float*)(F.lds + 65536 + 2048 + 2048);
    LAS int* selb = (LAS int*)(F.lds + 65536 + 8192);
    for (int u = F.vcu; u < NS * 20; u += F.G) {
        const int q = SAMPLES[u / 20], mh = u % 20;
        int mix, h; if (mh < 4) { mix = 0; h = mh; } else if (mh < 12) { mix = 1; h = mh - 4; } else if (mh < 16) { mix = 2; h = mh - 12; } else { mix = 3; h = mh - 16; }
        const int DQ = mix == 0 ? 128 : (mix == 3 ? 192 : 64), DVV = mix == 1 ? 64 : 128;
        const int nmaps = mix == 2 ? 2 : 1;
        const float scale = 1.0f / sqrtf((float)DQ);
        const int bcol = mix == 0 ? h : (mix == 1 ? 4 + h : 12 + h);
        float errs = 0.f, nrms = 0.f;
        for (int mp = 0; mp < nmaps; ++mp) {
            const bf16_t* Qp; const bf16_t* Kp; int ldk; const bf16_t* Vp;
            if (mix == 0) { Qp = H + (size_t)q * HW + H_AQ + h * 128; Kp = H + H_AK + h * 128; ldk = HW; Vp = wsb(F, WS_VT) + (size_t)(VT_A + h * 128) * S; }
            else if (mix == 1) { Qp = H + (size_t)q * HW + H_BQ + h * 64; Kp = H + H_BK + (h >> 2) * 64; ldk = HW; Vp = wsb(F, WS_VT) + (size_t)(VT_B + (h >> 2) * 64) * S; }
            else if (mix == 2) { Qp = H + (size_t)q * HW + H_CQ + h * 128 + mp * 64; Kp = H + H_CK + h * 128 + mp * 64; ldk = HW; Vp = wsb(F, WS_VT) + (size_t)(VT_C + h * 128) * S; }
            else { Qp = wsb(F, WS_QD) + (size_t)q * 768 + h * 192; Kp = wsb(F, WS_KD) + h * 192; ldk = 768; Vp = wsb(F, WS_VDT) + (size_t)(h * 128) * S; }
            __syncthreads();
            for (int d = F.tid; d < DQ; d += 512) qv[d] = bf1(Qp[d]);
            if (F.tid < 64) { ga[F.tid] = 0.f; selb[F.tid] = 0; }
            __syncthreads();
            const int own = q >> 8;
            if (mix == 0) {
                for (int idx = F.tid; idx < own * 128; idx += 512) { const int n = idx >> 7, d = idx & 127; float sm = 0.f; for (int i = 0; i < 256; ++i) sm += bf1(Kp[(size_t)(n * 256 + i) * ldk + d]); atomicAdd((float*)&ga[n], qv[d] * (sm / 256.0f)); }
                __syncthreads();
                if (F.tid == 0) { for (int rnk = 0; rnk < 3 && rnk < own; ++rnk) { int best = -1; float bv = -INFINITY; for (int n = 0; n < own; ++n) if (!selb[n] && ga[n] > bv) { bv = ga[n]; best = n; } if (best >= 0) selb[best] = 1; } }
                __syncthreads();
            }
            float mx = -INFINITY;
            for (int k = F.tid; k <= q; k += 512) {
                bool valid = true;
                if (mix == 0) { const int blk = k >> 8; valid = (blk == own) ? true : (selb[blk] != 0); }
                if (mix == 1) valid = (q - k) < 128;
                float l = -INFINITY;
                if (valid) { float dot = 0.f; for (int d = 0; d < DQ; ++d) dot += qv[d] * bf1(Kp[(size_t)k * ldk + d]); l = dot * scale; if (mix != 3) l += t5_naive(t5, bcol, pos[q] - pos[k]); }
                lg[k] = l; mx = fmaxf(mx, l);
            }
            mx = bmax(F, mx);
            const float sink = (mix == 1) ? a.in[8][layer * 8 + h] : -INFINITY;
            if (mix == 1) mx = fmaxf(mx, sink);
            float sm = 0.f;
            for (int k = F.tid; k <= q; k += 512) { const float p = expf(lg[k] - mx); lg[k] = p; sm += p; }
            sm = bsum(F, sm);
            if (mix == 1) sm += expf(sink - mx);
            __syncthreads();
            { const int dv = F.tid % 128, part = F.tid / 128; float acc = 0.f;
              if (dv < DVV) for (int k = part; k <= q; k += 4) acc += lg[k] * bf1(Vp[(size_t)dv * S + k]);
              op[part * 128 + dv] = acc; }
            __syncthreads();
            float val = 0.f;
            if (F.tid < DVV) val = (op[F.tid] + op[128 + F.tid] + op[256 + F.tid] + op[384 + F.tid]) / sm;
            if (mix == 2 && mp == 0) { if (F.tid < 128) o1[F.tid] = val; __syncthreads(); continue; }
            if (mix == 2) {
                float d1 = 0.f, d2 = 0.f; for (int i = 0; i < 64; ++i) { d1 += a.in[9][layer * 64 + i] * a.in[10][layer * 64 + i]; d2 += a.in[11][layer * 64 + i] * a.in[12][layer * 64 + i]; }
                const float li = 0.8f - 0.6f * expf(-0.3f * (float)layer), lam = expf(d1) - expf(d2) + li;
                float x = (F.tid < 128) ? (o1[F.tid] - lam * val) : 0.f;
                const float ms = bsum(F, x * x) / 128.0f;
                val = x / sqrtf(ms + 1e-6f) * ((F.tid < 128) ? a.in[13][layer * 128 + F.tid] : 0.f) * (1.0f - li);
            }
            if (F.tid < DVV) { const int ocol = (mix == 1) ? h * 64 + F.tid : h * 128 + F.tid; const float got = bf1(wsb(F, WS_O)[(size_t)mix * S * 512 + (size_t)q * 512 + ocol]); errs = (val - got) * (val - got); nrms = val * val; }
        }
        verdict(F, errs, nrms, 0.03f, 3 + mix);
    }
}
DI void s5(const Frame& F, const Args& a, int layer) {
    const bf16_t* X = wsb(F, WS_XB);
    for (int u = F.vcu; u < NS; u += F.G) { const int t = SAMPLES[u]; float err = 0.f, nrm = 0.f, err2 = 0.f, nrm2 = 0.f;
        for (int c = F.tid; c < 8192; c += 512) { const int n = c >> 11, cc = c & 2047; const float* W = a.in[4] + ((size_t)layer * 4 + n) * DM * DM; float z = a.in[5][(size_t)layer * 8192 + c];
            for (int k = 0; k < DM; ++k) z += bf1(X[(size_t)t * DM + k]) * W[(size_t)k * DM + cc];
            const float ref = sigm(z), got = __builtin_amdgcn_cvt_pk_f32_fp8((int)(F.ws + WS_GT)[(size_t)t * 8192 + c], false)[0]; err += (ref - got) * (ref - got); nrm += ref * ref; }
        for (int c = F.tid; c < DM; c += 512) { float ref = 0.f;
            for (int n = 0; n < 4; ++n) { const float* W = a.in[6] + ((size_t)layer * 4 + n) * 512 * DM; float br = 0.f; for (int j = 0; j < 512; ++j) br += bf1(wsb(F, WS_O)[(size_t)n * S * 512 + (size_t)t * 512 + j]) * W[(size_t)j * DM + c];
                ref += __builtin_amdgcn_cvt_pk_f32_fp8((int)(F.ws + WS_GT)[(size_t)t * 8192 + n * DM + c], false)[0] * br; }
            const float got = bf1(wsb(F, WS_H)[(size_t)t * DM + c]); err2 += (ref - got) * (ref - got); nrm2 += ref * ref; }
        verdict(F, err, nrm, 0.12f, 7); verdict(F, err2, nrm2, 0.12f, 8); }
}
DI void s6(const Frame& F, const Args& a, int layer) {
    const bf16_t* X = wsb(F, WS_XB); const float* W = a.in[7] + (size_t)layer * DM * DM; const bf16_t* Y = wsb(F, WS_GT);
    for (int u = F.vcu; u < NS; u += F.G) { const int t = SAMPLES[u]; float err = 0.f, nrm = 0.f;
        for (int c = F.tid; c < DM; c += 512) { float ref = 0.f; for (int j = 0; j < DM; ++j) ref += bf1(wsb(F, WS_H)[(size_t)t * DM + j]) * W[(size_t)j * DM + c];
            const float full = DN_ALPHA * bf1(X[(size_t)t * DM + c]) + ref, got = bf1(Y[(size_t)t * DM + c]); err += (full - got) * (full - got); nrm += full * full; }
        verdict(F, err, nrm, 0.006f, 9); }
}
DI void poison(const Frame& F) {
    const unsigned bad = __hip_atomic_load((unsigned*)(F.ws + WS_CTL) + CW_CHK + 64 * MK_CHECK_WORD, __ATOMIC_RELAXED, __HIP_MEMORY_SCOPE_AGENT);
    const float sc = 1.0f + (float)bad / 256.0f;
    for (size_t i = (size_t)F.vcu * 512 + F.tid; i < (size_t)S * DM / 4; i += (size_t)F.G * 512) { f32x4 v = ((f32x4*)F.out)[i]; v = v * sc; ((f32x4*)F.out)[i] = v; }
}
}
#endif

#ifndef MK_CHECK
#define MK_CHECK 0
#endif
#ifndef MK_CHECK_WORD
#define MK_CHECK_WORD 0
#endif
#ifndef MK_CHECK_LAYER
#define MK_CHECK_LAYER 0
#endif
#ifndef MK_PROBE_REL
#define MK_PROBE_REL (-2)
#endif
#ifndef MK_PROBE_REPS
#define MK_PROBE_REPS 1
#endif
#ifndef MK_PER_PHASE
#define MK_PER_PHASE 0
#endif
constexpr int NPL = 11, NPHASES = 1 + NL * NPL;
DI void run_layer(const Frame& F, const Args& args, const XcdBarrier& bar, const int layer, const int lo, const int hi) {
#define PH(k) (lo <= (k) && (k) < hi)
#define SEAM(k) do { if (PH(k) && PH((k) + 1)) xcd_barrier(bar); } while (0)
        const int pb = 1 + layer * NPL;
        unsigned char* wl = F.ws + WS_W + (size_t)layer * WL_STRIDE;
        if (PH(pb + 0)) {
            { pg8::Epi<0> E{}; E.O = wsb(F, WS_H); E.ldc = HW; E.grp = 128; run_gemm<0, true, 121, 127>(F, (const bf16_t*)(F.ws + WS_XB8), DM / 2, (const bf16_t*)(wl + W_IN), DM / 2, S, HW, DM / 2, 0, E); }
            { pg8::Epi<0> E{}; E.O = wsb(F, WS_VT); E.ldc = S; E.grp = 128; run_gemm<0, true, 127, 121>(F, (const bf16_t*)(wl + W_IN + (size_t)HW * DM), DM / 2, (const bf16_t*)(F.ws + WS_XB8), DM / 2, VT_ROWS, S, DM / 2, 0, E, 128); }
            { pg8::Epi<1> E{}; E.O = wsb(F, WS_GT); E.ldc = 8192; E.bias = args.in[5] + (size_t)layer * 8192; run_gemm<1, false, 121, 126, true>(F, (const bf16_t*)(F.ws + WS_XB4), DM / 4, (const bf16_t*)(wl + W_G), DM / 4, S, 8192, DM / 4, 0, E); }
        }
        SEAM(pb + 0);
        if (PH(pb + 1)) phase_prep(F, args, layer);
        SEAM(pb + 1);
        if (PH(pb + 2)) {
            { pg8::Epi<0> E{}; E.O = wsb(F, WS_QD); E.ldc = 768; E.grp = 128; run_gemm<0>(F, wsb(F, WS_CQN), 512, (const bf16_t*)(wl + W_UQ), 512, S, 768, 512, 0, E); }
            { pg8::Epi<0> E{}; E.O = wsb(F, WS_KD); E.ldc = 768; E.grp = 192; run_gemm<0>(F, wsb(F, WS_CKVN), 256, (const bf16_t*)(wl + W_UKV), 256, S, 512, 256, 0, E, 64); }
            { pg8::Epi<0> E{}; E.O = wsb(F, WS_VDT); E.ldc = S; E.grp = 128; run_gemm<0>(F, (const bf16_t*)(wl + W_UKV) + (size_t)512 * 256, 256, wsb(F, WS_CKVN), 256, 512, S, 256, 0, E, 192); }
        }
        SEAM(pb + 2);
        if (PH(pb + 3)) { phase_ropeq(F, args); phase_moba_select(F, args, layer); }
        SEAM(pb + 3);
        if (PH(pb + 4)) {
            phase_attention<0>(F, args, layer);
            if (layer + 1 < NL) convert_weights(F, args, layer + 1, layer + 2);
            __syncthreads();
            phase_attention<1>(F, args, layer);
        }
        SEAM(pb + 4);
        if (PH(pb + 5)) phase_mixer_combine(F, args, layer);
        SEAM(pb + 5);
        if (PH(pb + 6)) {
            for (int n = 0; n < 4; ++n) { pg8::Epi<2> E{}; E.O = wsb(F, WS_H); E.ldc = DM; E.G = (const bf16_t*)(F.ws + WS_GT + n * DM); E.ldg = 8192; E.first = (n == 0); E.O8 = (n == 3) ? F.ws + WS_XB8 : (unsigned char*)nullptr;
                run_gemm<2, true, 121, 124>(F, (const bf16_t*)(F.ws + WS_O8 + (size_t)n * S * 512), 256, (const bf16_t*)(wl + W_BR) + (size_t)n * DM * 512, 256, S, DM, 256, 0, E); }
        }
        SEAM(pb + 6);
        if (PH(pb + 7)) { pg8::Epi<3> E{}; E.O = F.ws + WS_GT; E.ldc = DM; E.X = wsb(F, WS_XB); E.alpha = DN_ALPHA;
            run_gemm<3, true, 121, 124>(F, (const bf16_t*)(F.ws + WS_XB8), DM / 2, (const bf16_t*)(wl + W_O), DM / 2, S, DM, DM / 2, 0, E); }
        SEAM(pb + 7);
        if (PH(pb + 8)) phase_ln1(F, args, layer);
        SEAM(pb + 8);
        if (PH(pb + 9)) { pg8::Epi<0> E{}; E.O = wsb(F, WS_H); E.ldc = DM; E.grp = 128; run_gemm<0>(F, wsb(F, WS_XB), DM, (const bf16_t*)(wl + W_PQ), DM, S, DM, DM, 0, E); }
        SEAM(pb + 9);
        if (PH(pb + 10)) phase_peer(F, args, layer, (const bf16_t*)(wl + W_SK), (layer == NL - 1) ? F.out : (float*)nullptr);
        SEAM(pb + 10);
#undef PH
#undef SEAM
}
__global__ void __launch_bounds__(512, 2) fwd_kernel(Args args) {
    extern __shared__ __attribute__((aligned(16))) unsigned char lds_raw[];
    Frame F;
    F.lds = (LAS unsigned char*)lds_raw; F.MISC = (volatile LAS unsigned*)(F.lds + MISC_OFF);
    F.tid = threadIdx.x; F.lane = F.tid & 63; F.wave = __builtin_amdgcn_readfirstlane(F.tid >> 6);
    F.G = gridDim.x; { const int bx = blockIdx.x; F.vcu = (F.G % 8 == 0) ? (bx % 8) * (F.G / 8) + bx / 8 : bx; }
    F.ws = args.ws; F.out = args.out;
    if (F.tid < 64) F.MISC[F.tid] = 0u;
    __syncthreads();
    const int lo = args.ph_lo, hi = args.ph_hi;
    unsigned* barw = (unsigned*)(F.ws + WS_CTL) + CW_BAR + (lo > 0 ? XCD_BAR_WORDS : 0);
    XcdBarrier bar; bar.bar = barw; bar.x = 0; bar.st = F.MISC;
    if (hi - lo > 1) bar = xcd_barrier_post(barw, F.MISC);
#define PH(k) (lo <= (k) && (k) < hi)
#define SEAM(k) do { if (PH(k) && PH((k) + 1)) xcd_barrier(bar); } while (0)
    if (PH(0)) phase_prologue(F, args);
    SEAM(0);
    run_layer(F, args, bar, 0, lo, hi);
    run_layer(F, args, bar, 1, lo, hi);
#undef PH
#undef SEAM
}


#if MK_CHECK
__global__ void __launch_bounds__(512, 1) chk_kernel(Args args, int stage, int layer) {
    extern __shared__ __attribute__((aligned(16))) unsigned char lds_raw[];
    Frame F;
    F.lds = (LAS unsigned char*)lds_raw; F.MISC = (volatile LAS unsigned*)(F.lds + MISC_OFF);
    F.tid = threadIdx.x; F.lane = F.tid & 63; F.wave = __builtin_amdgcn_readfirstlane(F.tid >> 6);
    F.G = gridDim.x; { const int bx = blockIdx.x; F.vcu = (F.G % 8 == 0) ? (bx % 8) * (F.G / 8) + bx / 8 : bx; }
    F.ws = args.ws; F.out = args.out;
    if (stage == 1) { chk::s1(F, args, layer); chk::s2(F, args, layer); chk::s3(F, args, layer); }
    if (stage == 4) chk::s4(F, args, layer);
    if (stage == 5) chk::s5(F, args, layer);
    if (stage == 6) chk::s6(F, args, layer);
    if (stage == 99) chk::poison(F);
}
#endif
extern "C" void kernel_launch(void* const* d_in, const int* in_sizes, int n_in, void* d_out, int out_size, void* d_ws, size_t ws_size, hipStream_t stream) {
    static int grid = 0;
    if (grid == 0) {
        if (n_in != 26 || out_size != S * DM || ws_size < WS_END) { fprintf(stderr, "kernel_launch: unexpected problem (n_in %d, out %d, ws %zu); nothing launched\n", n_in, out_size, ws_size); grid = -1; return; }
        int dev = 0, cus = 0, per_cu = 0;
        if (hipGetDevice(&dev) != hipSuccess || hipDeviceGetAttribute(&cus, hipDeviceAttributeMultiprocessorCount, dev) != hipSuccess) { grid = -1; return; }
        if (hipFuncSetAttribute((const void*)fwd_kernel, hipFuncAttributeMaxDynamicSharedMemorySize, LDS_BYTES) != hipSuccess) { fprintf(stderr, "kernel_launch: hipFuncSetAttribute failed\n"); grid = -1; return; }
        if (hipOccupancyMaxActiveBlocksPerMultiprocessor(&per_cu, (const void*)fwd_kernel, 512, LDS_BYTES) != hipSuccess || per_cu < 1) { fprintf(stderr, "kernel_launch: occupancy query says %d blocks per CU\n", per_cu); }
        (void)hipGetLastError();
        grid = cus;
    }
    if (grid < 0) return;
    (void)hipMemsetAsync((char*)d_ws + WS_CTL, 0, CTL_ZERO_BYTES, stream);
    Args a{};
    for (int i = 0; i < 26; ++i) a.in[i] = (const float*)d_in[i];
    a.out = (float*)d_out; a.ws = (unsigned char*)d_ws;
#if MK_CHECK
    {
        static bool once = false; if (!once) { once = true; (void)hipFuncSetAttribute((const void*)chk_kernel, hipFuncAttributeMaxDynamicSharedMemorySize, LDS_BYTES); }
        const int pb = 1 + MK_CHECK_LAYER * NPL; const int cuts[6] = {0, pb + 4, pb + 6, pb + 7, pb + 8, NPHASES}; const int stg[5] = {1, 4, 5, 6, 0};
        for (int i = 0; i < 5; ++i) { (void)hipMemsetAsync((unsigned*)((char*)d_ws + WS_CTL) + CW_BAR, 0, 2 * XCD_BAR_WORDS * 4, stream); a.ph_lo = cuts[i]; a.ph_hi = cuts[i + 1]; hipLaunchKernelGGL(fwd_kernel, dim3(grid), dim3(512), LDS_BYTES, stream, a);
            if (stg[i]) hipLaunchKernelGGL(chk_kernel, dim3(grid), dim3(512), LDS_BYTES, stream, a, stg[i], MK_CHECK_LAYER); }
        hipLaunchKernelGGL(chk_kernel, dim3(grid), dim3(512), LDS_BYTES, stream, a, 99, 0);
    }
#elif MK_PROBE_REL > -2
    {
        unsigned* ctl = (unsigned*)((char*)d_ws + WS_CTL);
        auto launch = [&](int lo, int hi) { if (hi <= lo) return; (void)hipMemsetAsync(ctl + CW_BAR, 0, 2 * XCD_BAR_WORDS * 4, stream); a.ph_lo = lo; a.ph_hi = hi; hipLaunchKernelGGL(fwd_kernel, dim3(grid), dim3(512), LDS_BYTES, stream, a); };
        int cur = 0;
        const int nl = (MK_PROBE_REL == -1) ? 1 : NL;
        for (int layer = 0; layer < nl; ++layer) {
            const int p = (MK_PROBE_REL == -1) ? 0 : 1 + layer * NPL + MK_PROBE_REL;
            launch(cur, p);
            for (int r = 0; r <= MK_PROBE_REPS; ++r) {
                (void)hipMemsetAsync(ctl + CW_Q, 0, 4096 * 4, stream);
#ifdef MK_PROBE_MIXER
                if (r > 0) { (void)hipMemsetAsync(ctl + CW_Q, 0x04, 4096 * 4, stream); (void)hipMemsetAsync(ctl + CW_Q + layer * 256 + 64 * MK_PROBE_MIXER, 0, 4, stream); }
#endif
                if (MK_PROBE_REL == 10 && r == 0) (void)hipMemcpyAsync((char*)d_ws + WS_GT, (char*)d_ws + WS_XB, (size_t)S * DM * 2, hipMemcpyDeviceToDevice, stream);
                if (MK_PROBE_REL == 10 && r > 0) (void)hipMemcpyAsync((char*)d_ws + WS_XB, (char*)d_ws + WS_GT, (size_t)S * DM * 2, hipMemcpyDeviceToDevice, stream);
                if (MK_PROBE_REL == 3 && r == 0) (void)hipMemcpyAsync((char*)d_ws + WS_PART, (char*)d_ws + WS_QD, (size_t)S * 768 * 2, hipMemcpyDeviceToDevice, stream);
                if (MK_PROBE_REL == 3 && r > 0) { (void)hipMemcpyAsync((char*)d_ws + WS_QD, (char*)d_ws + WS_PART, (size_t)S * 768 * 2, hipMemcpyDeviceToDevice, stream); (void)hipMemsetAsync(ctl + CW_MOBA, 0, 2048 * 4, stream); }
                launch(p, p + 1);
            }
            cur = p + 1;
        }
        launch(cur, NPHASES);
    }
#elif MK_PER_PHASE
    for (int p = 0; p < NPHASES; ++p) { a.ph_lo = p; a.ph_hi = p + 1; hipLaunchKernelGGL(fwd_kernel, dim3(grid), dim3(512), LDS_BYTES, stream, a); }
#else
    a.ph_lo = 0; a.ph_hi = NPHASES;
    hipLaunchKernelGGL(fwd_kernel, dim3(grid), dim3(512), LDS_BYTES, stream, a);
#endif
}
```

```cpp
#include <hip/hip_runtime.h>
#include <cstdio>
#include <cstdint>
#include <cmath>

#define DI __device__ __forceinline__
#define LAS __attribute__((address_space(3)))
#define GAS __attribute__((address_space(1)))
typedef unsigned short bf16_t;
typedef short bf16x8 __attribute__((ext_vector_type(8)));
typedef float f32x4 __attribute__((ext_vector_type(4)));
typedef float f32x2 __attribute__((ext_vector_type(2)));
typedef float f32x16 __attribute__((ext_vector_type(16)));
typedef unsigned u32x4 __attribute__((ext_vector_type(4)));
typedef unsigned u32x2 __attribute__((ext_vector_type(2)));
typedef int i32x4 __attribute__((ext_vector_type(4)));
typedef __bf16 bf16x2_t __attribute__((ext_vector_type(2)));

DI unsigned cvtpk(float lo, float hi) { f32x2 v = {lo, hi}; bf16x2_t b = __builtin_convertvector(v, bf16x2_t); return __builtin_bit_cast(unsigned, b); }
DI float bf_lo(unsigned u) { return __uint_as_float(u << 16); }
DI float bf_hi(unsigned u) { return __uint_as_float(u & 0xffff0000u); }
DI float bf1(bf16_t u) { return __uint_as_float((unsigned)u << 16); }
DI float ex2(float x) { return __builtin_amdgcn_exp2f(x); }
DI float wave_sum(float v) {
#pragma unroll
    for (int o = 1; o < 64; o <<= 1) v += __shfl_xor(v, o);
    return v;
}
DI float xhalf(float v) { return __shfl_xor(v, 32); }

namespace pg8 {
#define PG8_LAS __attribute__((address_space(3)))
#ifndef PG8_WGM
#define PG8_WGM 8
#endif
constexpr int BM = 256, BK = 64, HALF = 128, HTB = HALF * BK * 2  , STAGE_BYTES = 8 * HTB, NXCD = 8, WGM = PG8_WGM;

__host__ __device__ __forceinline__ int lds_byte(int r, int c) { const int st = (r >> 4) * 2 + (c >> 5), rr = r & 15, cc = c & 31, ob = rr * 64 + cc * 2; return st * 1024 + (ob ^ (((ob >> 9) & 1) << 5)); }
__host__ __device__ __forceinline__ void stage_rc(int b, int& R, int& C) { const int st = b / 1024, sb = b % 1024, swz = sb ^ (((sb >> 9) & 1) << 5); R = (st >> 1) * 16 + swz / 64; C = (st & 1) * 32 + (swz % 64) / 2; }
__host__ __device__ __forceinline__ int perm32(int rho) { const int n = rho >> 4, i = rho & 15; return 8 * (i >> 2) + 4 * n + (i & 3); }

struct Unit { int pm, pn, br; };
struct Gemm { const bf16_t* A; const bf16_t* Bt; int M, N, K, lda, ldb; long apn; long abr, bbr; };

struct StaticOrder {
    int nM, nN, nwg, G, c;
    __host__ __device__ void init(int M, int N, int G_, int c_) { nM = M / BM; nN = N / BM; nwg = nM * nN; G = G_; c = c_; }
    __host__ __device__ bool next(int i, Unit& u) const {
        const long L = (long)i * G + c; if (L >= nwg) return false;
        int wgid = (int)L; { const int q = nwg / NXCD, r = nwg % NXCD, xcd = wgid % NXCD, off = wgid / NXCD; wgid = (xcd < r ? xcd * (q + 1) : r * (q + 1) + (xcd - r) * q) + off; }
        const int nig = WGM * nN, gid = wgid / nig, fm = gid * WGM, gsz = (nM - fm) < WGM ? (nM - fm) : WGM;
        u.pm = fm + ((wgid % nig) % gsz); u.pn = (wgid % nig) / gsz; u.br = 0; return true;
    }
    __device__ __forceinline__ void a_ready(const Unit&) const {}
    __device__ __forceinline__ void done(const Unit&) const {}
};
template <int NBR> struct ChainOrder {
    StaticOrder so;
    __host__ __device__ void init(int M, int N, int G_, int c_) { so.init(M, N, G_, c_); }
    __host__ __device__ bool next(int i, Unit& u) const { const bool ok = so.next(i / NBR, u); u.br = i % NBR; return ok; }
    __device__ __forceinline__ void a_ready(const Unit&) const {}
    __device__ __forceinline__ void done(const Unit&) const {}
};

template <int MODE> struct Epi {
    static constexpr bool PERM = true, AFTER_DRAIN = false, CHAIN = (MODE == 5); static constexpr int NBR = 4;
    void* O; int ldc; int grp; const float* bias; const bf16_t* G; int ldg; const void* X; float alpha; int first; unsigned char* O8;
    static __device__ __forceinline__ f32x2 gclamp(f32x2 g) { return (f32x2){fmaxf(g.x, 0.001953125f), fmaxf(g.y, 0.001953125f)}; }
    __device__ __forceinline__ void rescale(f32x4 (&acc)[2][2][4][2], const Unit& u, int wr, int wc, int fr, int fq) const {
        const int row0 = u.pm * BM + wr * 64 + fr, colb = u.pn * BM + wc * 32 + 8 * fq;
        const float z = (u.br + 1 < NBR) ? 1.0f : 0.0f;
        const size_t gcol = (size_t)(u.br + 1 < NBR ? u.br : 0) * ldc;
#pragma unroll
        for (int ai = 0; ai < 2; ++ai)
#pragma unroll
            for (int m = 0; m < 4; ++m) {
                const size_t r = (size_t)(row0 + ai * HALF + m * 16);
#pragma unroll
                for (int bj = 0; bj < 2; ++bj) {
                    const int c = colb + bj * HALF;
                    const unsigned char* gp = (const unsigned char*)G + r * ldg + gcol + c;
                    asm volatile("" : "+v"(gp));
                    const u32x2 ga = *(const u32x2*)gp, gb = *(const u32x2*)(gp + ldc);
                    const f32x2 a0 = gclamp(__builtin_amdgcn_cvt_pk_f32_fp8((int)ga.x, false)), a1 = gclamp(__builtin_amdgcn_cvt_pk_f32_fp8((int)ga.x, true)), a2 = gclamp(__builtin_amdgcn_cvt_pk_f32_fp8((int)ga.y, false)), a3 = gclamp(__builtin_amdgcn_cvt_pk_f32_fp8((int)ga.y, true));
                    const f32x2 b0 = gclamp(__builtin_amdgcn_cvt_pk_f32_fp8((int)gb.x, false)), b1 = gclamp(__builtin_amdgcn_cvt_pk_f32_fp8((int)gb.x, true)), b2 = gclamp(__builtin_amdgcn_cvt_pk_f32_fp8((int)gb.y, false)), b3 = gclamp(__builtin_amdgcn_cvt_pk_f32_fp8((int)gb.y, true));
                    f32x4& v0 = acc[ai][bj][m][0]; f32x4& v1 = acc[ai][bj][m][1];
                    v0[0] *= z * a0.x * __builtin_amdgcn_rcpf(b0.x); v0[1] *= z * a0.y * __builtin_amdgcn_rcpf(b0.y); v0[2] *= z * a1.x * __builtin_amdgcn_rcpf(b1.x); v0[3] *= z * a1.y * __builtin_amdgcn_rcpf(b1.y);
                    v1[0] *= z * a2.x * __builtin_amdgcn_rcpf(b2.x); v1[1] *= z * a2.y * __builtin_amdgcn_rcpf(b2.y); v1[2] *= z * a3.x * __builtin_amdgcn_rcpf(b3.x); v1[3] *= z * a3.y * __builtin_amdgcn_rcpf(b3.y);
                    asm volatile("" : "+v"(v0), "+v"(v1));
                }
            }
    }
    __device__ __forceinline__ void operator()(const f32x4 (&acc)[2][2][4][2], const Unit& u, int wr, int wc, int fr, int fq) const {
        const int row0 = u.pm * BM + wr * 64 + fr, colb = u.pn * BM + wc * 32 + 8 * fq;
#pragma unroll
        for (int ai = 0; ai < 2; ++ai)
#pragma unroll
            for (int m = 0; m < 4; ++m) {
                const size_t r = (size_t)(row0 + ai * HALF + m * 16);
#pragma unroll
                for (int bj = 0; bj < 2; ++bj) {
                    const int c = colb + bj * HALF;
                    f32x4 v0 = acc[ai][bj][m][0], v1 = acc[ai][bj][m][1];
                    if constexpr (MODE == 0) {
                        const int dc = (c >> 7) * grp + (c & 127);
                        u32x4 w; w.x = cvtpk(v0[0], v0[1]); w.y = cvtpk(v0[2], v0[3]); w.z = cvtpk(v1[0], v1[1]); w.w = cvtpk(v1[2], v1[3]);
                        *(u32x4*)((bf16_t*)O + r * ldc + dc) = w;
                    } else if constexpr (MODE == 1) {
                        const f32x4 b0 = *(const f32x4*)(bias + c), b1 = *(const f32x4*)(bias + c + 4);
                        v0 = v0 + b0; v1 = v1 + b1;
#pragma unroll
                        for (int e = 0; e < 4; ++e) { v0[e] = __builtin_amdgcn_rcpf(1.0f + ex2(-1.4426950408889634f * v0[e])); v1[e] = __builtin_amdgcn_rcpf(1.0f + ex2(-1.4426950408889634f * v1[e])); }
                        int lo = __builtin_amdgcn_cvt_pk_fp8_f32(v0[0], v0[1], 0, false); lo = __builtin_amdgcn_cvt_pk_fp8_f32(v0[2], v0[3], lo, true);
                        int hi = __builtin_amdgcn_cvt_pk_fp8_f32(v1[0], v1[1], 0, false); hi = __builtin_amdgcn_cvt_pk_fp8_f32(v1[2], v1[3], hi, true);
                        *(u32x2*)((unsigned char*)O + r * ldc + c) = (u32x2){(unsigned)lo, (unsigned)hi};
                    } else if constexpr (MODE == 2) {
                        const u32x2 gq = *(const u32x2*)((const unsigned char*)G + r * ldg + c);
                        const f32x2 g0 = __builtin_amdgcn_cvt_pk_f32_fp8((int)gq.x, false), g1 = __builtin_amdgcn_cvt_pk_f32_fp8((int)gq.x, true), g2 = __builtin_amdgcn_cvt_pk_f32_fp8((int)gq.y, false), g3 = __builtin_amdgcn_cvt_pk_f32_fp8((int)gq.y, true);
                        bf16_t* op = (bf16_t*)O + r * ldc + c;
                        u32x4 old = (u32x4){0u, 0u, 0u, 0u};
                        if (!first) old = *(const u32x4*)op;
                        const float r0 = bf_lo(old.x) + g0.x * v0[0], r1 = bf_hi(old.x) + g0.y * v0[1], r2 = bf_lo(old.y) + g1.x * v0[2], r3 = bf_hi(old.y) + g1.y * v0[3];
                        const float r4 = bf_lo(old.z) + g2.x * v1[0], r5 = bf_hi(old.z) + g2.y * v1[1], r6 = bf_lo(old.w) + g3.x * v1[2], r7 = bf_hi(old.w) + g3.y * v1[3];
                        u32x4 w; w.x = cvtpk(r0, r1); w.y = cvtpk(r2, r3); w.z = cvtpk(r4, r5); w.w = cvtpk(r6, r7);
                        *(u32x4*)op = w;
                        if (O8) {
                            int lo = __builtin_amdgcn_cvt_pk_fp8_f32(r0 * 8.0f, r1 * 8.0f, 0, false); lo = __builtin_amdgcn_cvt_pk_fp8_f32(r2 * 8.0f, r3 * 8.0f, lo, true);
                            int hi = __builtin_amdgcn_cvt_pk_fp8_f32(r4 * 8.0f, r5 * 8.0f, 0, false); hi = __builtin_amdgcn_cvt_pk_fp8_f32(r6 * 8.0f, r7 * 8.0f, hi, true);
                            *(u32x2*)(O8 + r * ldc + c) = (u32x2){(unsigned)lo, (unsigned)hi}; }
                    } else if constexpr (MODE == 5) {
                        const u32x2 gq = *(const u32x2*)((const unsigned char*)G + r * ldg + 3 * ldc + c);
                        const f32x2 g0 = gclamp(__builtin_amdgcn_cvt_pk_f32_fp8((int)gq.x, false)), g1 = gclamp(__builtin_amdgcn_cvt_pk_f32_fp8((int)gq.x, true)), g2 = gclamp(__builtin_amdgcn_cvt_pk_f32_fp8((int)gq.y, false)), g3 = gclamp(__builtin_amdgcn_cvt_pk_f32_fp8((int)gq.y, true));
                        const float r0 = g0.x * v0[0], r1 = g0.y * v0[1], r2 = g1.x * v0[2], r3 = g1.y * v0[3], r4 = g2.x * v1[0], r5 = g2.y * v1[1], r6 = g3.x * v1[2], r7 = g3.y * v1[3];
                        u32x4 w; w.x = cvtpk(r0, r1); w.y = cvtpk(r2, r3); w.z = cvtpk(r4, r5); w.w = cvtpk(r6, r7);
                        *(u32x4*)((bf16_t*)O + r * ldc + c) = w;
                        int lo = __builtin_amdgcn_cvt_pk_fp8_f32(r0 * 8.0f, r1 * 8.0f, 0, false); lo = __builtin_amdgcn_cvt_pk_fp8_f32(r2 * 8.0f, r3 * 8.0f, lo, true);
                        int hi = __builtin_amdgcn_cvt_pk_fp8_f32(r4 * 8.0f, r5 * 8.0f, 0, false); hi = __builtin_amdgcn_cvt_pk_fp8_f32(r6 * 8.0f, r7 * 8.0f, hi, true);
                        *(u32x2*)(O8 + r * ldc + c) = (u32x2){(unsigned)lo, (unsigned)hi};
                    } else if constexpr (MODE == 3) {
                        const u32x4 xx = *(const u32x4*)((const bf16_t*)X + r * ldc + c);
                        u32x4 w;
                        w.x = cvtpk(bf_lo(xx.x) * alpha + v0[0], bf_hi(xx.x) * alpha + v0[1]); w.y = cvtpk(bf_lo(xx.y) * alpha + v0[2], bf_hi(xx.y) * alpha + v0[3]);
                        w.z = cvtpk(bf_lo(xx.z) * alpha + v1[0], bf_hi(xx.z) * alpha + v1[1]); w.w = cvtpk(bf_lo(xx.w) * alpha + v1[2], bf_hi(xx.w) * alpha + v1[3]);
                        *(u32x4*)((bf16_t*)O + r * ldc + c) = w;
                    } else {
                        *(f32x4*)((float*)O + r * ldc + c) = v0; *(f32x4*)((float*)O + r * ldc + c + 4) = v1;
                    }
                }
            }
    }
};

template <class Epi, class Sched, bool ALIGN_EPI = false, bool SP2 = false, bool F8 = false, int SC0 = 127, int SC1 = 127, bool F4 = false>
__device__ __forceinline__ void gemm_phase(PG8_LAS unsigned char* lds, const Gemm g, const Sched& S, const Epi& E) {
    int tid_ = threadIdx.x; asm volatile("" : "+v"(tid_));
    const int tid = tid_, wid = __builtin_amdgcn_readfirstlane(tid >> 6), lane = tid & 63, wr = wid >> 2, wc = wid & 3, fr = lane & 15, fq = lane >> 4;
    const int K = g.K, nt = K / BK;
    unsigned voffA[2], voffB[2];
#pragma unroll
    for (int i = 0; i < 2; ++i) { int R, C; stage_rc(tid * 16 + i * 8192, R, C); const int Rb = Epi::PERM ? ((R & ~31) + perm32(R & 31)) : R;
        voffA[i] = (unsigned)(R * g.lda + C) * 2u; voffB[i] = (unsigned)(Rb * g.ldb + C) * 2u; }
    const size_t kstep = (size_t)(BK * 2);
    const size_t hstepA = (size_t)HALF * g.lda * 2, hstepB = (size_t)HALF * g.ldb * 2;
    const size_t tstepA = 2 * hstepA, tstepB = 2 * hstepB;
    const unsigned ldsw = (unsigned)wid * 1024u;
    const int aoff = lds_byte(wr * 64 + fr, fq * 8), boff = lds_byte(wc * 32 + fr, fq * 8);

#define PG8_SA(b, h) (((b) * 2 + (h)) * HTB)
#define PG8_SB(b, h) ((4 + (b) * 2 + (h)) * HTB)
#define PG8_STAGE(bufoff, gbase, voff) do { _Pragma("unroll") for (int _i = 0; _i < 2; ++_i) \
        __builtin_amdgcn_global_load_lds((const unsigned*)((const char*)(gbase) + (voff)[_i]), (PG8_LAS unsigned*)(lds + (bufoff) + ldsw + _i * 8192), 16, 0, 0); } while (0)
#define PG8_LDA(dst, b, h) do { _Pragma("unroll") for (int m = 0; m < 4; ++m) { if constexpr (F8) { const v4i_t lo_ = *(const PG8_LAS v4i_t*)(lds + PG8_SA(b, h) + aoff + m * 2048), hi_ = *(const PG8_LAS v4i_t*)(lds + PG8_SA(b, h) + aoff + m * 2048 + 1024); dst##8[m] = __builtin_shufflevector(lo_, hi_, 0, 1, 2, 3, 4, 5, 6, 7); } else { _Pragma("unroll") for (int k = 0; k < 2; ++k) dst[m][k] = *(const PG8_LAS bf16x8*)(lds + PG8_SA(b, h) + aoff + m * 2048 + k * 1024); } } } while (0)
#define PG8_LDB(dst, b, h) do { _Pragma("unroll") for (int n = 0; n < 2; ++n) { if constexpr (F8) { const v4i_t lo_ = *(const PG8_LAS v4i_t*)(lds + PG8_SB(b, h) + boff + n * 2048), hi_ = *(const PG8_LAS v4i_t*)(lds + PG8_SB(b, h) + boff + n * 2048 + 1024); dst##8[n] = __builtin_shufflevector(lo_, hi_, 0, 1, 2, 3, 4, 5, 6, 7); } else { _Pragma("unroll") for (int k = 0; k < 2; ++k) dst[n][k] = *(const PG8_LAS bf16x8*)(lds + PG8_SB(b, h) + boff + n * 2048 + k * 1024); } } } while (0)
#define PG8_MMA(ai, bj, At, Bt) do { __builtin_amdgcn_s_setprio(1); \
        if constexpr (F8) {   \
            asm volatile("s_nop 1\n\t" \
            "v_mfma_scale_f32_16x16x128_f8f6f4 %0, %12, %8, %0, %14, %15 op_sel_hi:[0,0,0]\n\t"  \
            "v_mfma_scale_f32_16x16x128_f8f6f4 %1, %13, %8, %1, %14, %15 op_sel_hi:[0,0,0]\n\t"  \
            "v_mfma_scale_f32_16x16x128_f8f6f4 %2, %12, %9, %2, %14, %15 op_sel_hi:[0,0,0]\n\t"  \
            "v_mfma_scale_f32_16x16x128_f8f6f4 %3, %13, %9, %3, %14, %15 op_sel_hi:[0,0,0]\n\t"  \
            "v_mfma_scale_f32_16x16x128_f8f6f4 %4, %12, %10, %4, %14, %15 op_sel_hi:[0,0,0]\n\t"  \
            "v_mfma_scale_f32_16x16x128_f8f6f4 %5, %13, %10, %5, %14, %15 op_sel_hi:[0,0,0]\n\t"  \
            "v_mfma_scale_f32_16x16x128_f8f6f4 %6, %12, %11, %6, %14, %15 op_sel_hi:[0,0,0]\n\t"  \
            "v_mfma_scale_f32_16x16x128_f8f6f4 %7, %13, %11, %7, %14, %15 op_sel_hi:[0,0,0]\n\t"  \
                : "+v"(acc[ai][bj][0][0]), "+v"(acc[ai][bj][0][1]), "+v"(acc[ai][bj][1][0]), "+v"(acc[ai][bj][1][1]), "+v"(acc[ai][bj][2][0]), "+v"(acc[ai][bj][2][1]), "+v"(acc[ai][bj][3][0]), "+v"(acc[ai][bj][3][1]) \
                : "v"(At##8[0]), "v"(At##8[1]), "v"(At##8[2]), "v"(At##8[3]), "v"(Bt##8[0]), "v"(Bt##8[1]), "v"(sc0), "v"(sc1)); \
        } else if constexpr (F4) { \
            asm volatile("s_nop 1\n\t" \
            "v_mfma_scale_f32_16x16x128_f8f6f4 %0, %16, %8, %0, %20, %21 op_sel_hi:[0,0,0] cbsz:4 blgp:4\n\t"  \
            "v_mfma_scale_f32_16x16x128_f8f6f4 %0, %17, %9, %0, %20, %21 op_sel_hi:[0,0,0] cbsz:4 blgp:4\n\t"  \
            "v_mfma_scale_f32_16x16x128_f8f6f4 %1, %18, %8, %1, %20, %21 op_sel_hi:[0,0,0] cbsz:4 blgp:4\n\t"  \
            "v_mfma_scale_f32_16x16x128_f8f6f4 %1, %19, %9, %1, %20, %21 op_sel_hi:[0,0,0] cbsz:4 blgp:4\n\t"  \
            "v_mfma_scale_f32_16x16x128_f8f6f4 %2, %16, %10, %2, %20, %21 op_sel_hi:[0,0,0] cbsz:4 blgp:4\n\t"  \
            "v_mfma_scale_f32_16x16x128_f8f6f4 %2, %17, %11, %2, %20, %21 op_sel_hi:[0,0,0] cbsz:4 blgp:4\n\t"  \
            "v_mfma_scale_f32_16x16x128_f8f6f4 %3, %18, %10, %3, %20, %21 op_sel_hi:[0,0,0] cbsz:4 blgp:4\n\t"  \
            "v_mfma_scale_f32_16x16x128_f8f6f4 %3, %19, %11, %3, %20, %21 op_sel_hi:[0,0,0] cbsz:4 blgp:4\n\t"  \
            "v_mfma_scale_f32_16x16x128_f8f6f4 %4, %16, %12, %4, %20, %21 op_sel_hi:[0,0,0] cbsz:4 blgp:4\n\t"  \
            "v_mfma_scale_f32_16x16x128_f8f6f4 %4, %17, %13, %4, %20, %21 op_sel_hi:[0,0,0] cbsz:4 blgp:4\n\t"  \
            "v_mfma_scale_f32_16x16x128_f8f6f4 %5, %18, %12, %5, %20, %21 op_sel_hi:[0,0,0] cbsz:4 blgp:4\n\t"  \
            "v_mfma_scale_f32_16x16x128_f8f6f4 %5, %19, %13, %5, %20, %21 op_sel_hi:[0,0,0] cbsz:4 blgp:4\n\t"  \
            "v_mfma_scale_f32_16x16x128_f8f6f4 %6, %16, %14, %6, %20, %21 op_sel_hi:[0,0,0] cbsz:4 blgp:4\n\t"  \
            "v_mfma_scale_f32_16x16x128_f8f6f4 %6, %17, %15, %6, %20, %21 op_sel_hi:[0,0,0] cbsz:4 blgp:4\n\t"  \
            "v_mfma_scale_f32_16x16x128_f8f6f4 %7, %18, %14, %7, %20, %21 op_sel_hi:[0,0,0] cbsz:4 blgp:4\n\t"  \
            "v_mfma_scale_f32_16x16x128_f8f6f4 %7, %19, %15, %7, %20, %21 op_sel_hi:[0,0,0] cbsz:4 blgp:4\n\t"  \
                : "+v"(acc[ai][bj][0][0]), "+v"(acc[ai][bj][0][1]), "+v"(acc[ai][bj][1][0]), "+v"(acc[ai][bj][1][1]), "+v"(acc[ai][bj][2][0]), "+v"(acc[ai][bj][2][1]), "+v"(acc[ai][bj][3][0]), "+v"(acc[ai][bj][3][1]) \
                : "v"(At[0][0]), "v"(At[0][1]), "v"(At[1][0]), "v"(At[1][1]), "v"(At[2][0]), "v"(At[2][1]), "v"(At[3][0]), "v"(At[3][1]), "v"(Bt[0][0]), "v"(Bt[0][1]), "v"(Bt[1][0]), "v"(Bt[1][1]), "v"(sc0), "v"(sc1)); \
        } else { _Pragma("unroll") for (int m = 0; m < 4; ++m) _Pragma("unroll") for (int n = 0; n < 2; ++n) _Pragma("unroll") for (int k = 0; k < 2; ++k) \
            acc[ai][bj][m][n] = __builtin_amdgcn_mfma_f32_16x16x32_bf16(Bt[n][k], At[m][k], acc[ai][bj][m][n], 0, 0, 0); } \
        __builtin_amdgcn_s_setprio(0); } while (0)
#define PG8_WAIT_V(n) asm volatile("s_waitcnt vmcnt(" #n ")" ::: "memory")
#define PG8_WAIT_L(n) asm volatile("s_waitcnt lgkmcnt(" #n ")" ::: "memory")
#define PG8_BAR __builtin_amdgcn_s_barrier()
#define PG8_SCHED __builtin_amdgcn_sched_barrier(0)
    Unit cur, nxt; int ui = 0;
    if (!S.next(0, cur)) return;
    f32x4 acc[2][2][4][2];
#pragma unroll
    for (int a = 0; a < 2; ++a)
#pragma unroll
        for (int b = 0; b < 2; ++b)
#pragma unroll
            for (int m = 0; m < 4; ++m)
#pragma unroll
                for (int n = 0; n < 2; ++n) acc[a][b][m][n] = (f32x4){0.f, 0.f, 0.f, 0.f};
    bf16x8 At[4][2], B0[2][2], B1[2][2];
    typedef int v8i_t __attribute__((ext_vector_type(8))); typedef int v4i_t __attribute__((ext_vector_type(4)));
    v8i_t At8[4], B08[2], B18[2];
    int sc0 = SC0 * 0x01010101, sc1 = SC1 * 0x01010101; asm volatile("" : "+v"(sc0), "+v"(sc1));
    const char* cA = (const char*)g.A + (size_t)cur.pm * tstepA + (size_t)cur.pn * g.apn + (size_t)cur.br * g.abr; const char* cB = (const char*)g.Bt + (size_t)cur.pn * tstepB + (size_t)cur.br * g.bbr;
    S.a_ready(cur);
    if constexpr (SP2) {
        PG8_STAGE(PG8_SB(0, 0), cB, voffB); PG8_STAGE(PG8_SB(0, 1), cB + hstepB, voffB); PG8_STAGE(PG8_SA(0, 0), cA, voffA); PG8_STAGE(PG8_SA(0, 1), cA + hstepA, voffA);
        if (wr == 1) PG8_BAR;
        PG8_WAIT_V(2); PG8_BAR;
        PG8_STAGE(PG8_SB(1, 0), cB + kstep, voffB); PG8_STAGE(PG8_SA(1, 0), cA + kstep, voffA); PG8_STAGE(PG8_SB(1, 1), cB + hstepB + kstep, voffB);
        PG8_WAIT_V(6); PG8_BAR;
    } else {
        PG8_STAGE(PG8_SB(0, 0), cB, voffB); PG8_STAGE(PG8_SA(0, 0), cA, voffA); PG8_STAGE(PG8_SB(0, 1), cB + hstepB, voffB); PG8_STAGE(PG8_SA(0, 1), cA + hstepA, voffA);
        if (wr == 1) PG8_BAR;
        PG8_WAIT_V(4); PG8_BAR;
        PG8_STAGE(PG8_SB(1, 0), cB + kstep, voffB); PG8_STAGE(PG8_SA(1, 0), cA + kstep, voffA); PG8_STAGE(PG8_SB(1, 1), cB + hstepB + kstep, voffB);
        PG8_WAIT_V(6); PG8_BAR;
    }
    for (;;) {
        const bool has_next = S.next(ui + 1, nxt);
        const char* nA = has_next ? (const char*)g.A + (size_t)nxt.pm * tstepA + (size_t)nxt.pn * g.apn + (size_t)nxt.br * g.abr : cA; const char* nB = has_next ? (const char*)g.Bt + (size_t)nxt.pn * tstepB + (size_t)nxt.br * g.bbr : cB;
        for (int t = 0; t < nt; t += 2) {
            const bool last = (t == nt - 2);
            const char* a1 = cA + (size_t)(t + 1) * kstep;
            const char* a2 = last ? nA : cA + (size_t)(t + 2) * kstep; const char* b2 = last ? nB : cB + (size_t)(t + 2) * kstep;
            const char* a3 = a2 + kstep; const char* b3 = b2 + kstep;
            if (last && has_next) S.a_ready(nxt);
            if constexpr (SP2) {
            PG8_LDB(B0, 0, 0); PG8_LDB(B1, 0, 1); PG8_SCHED; PG8_LDA(At, 0, 0); PG8_STAGE(PG8_SA(1, 1), a1 + hstepA, voffA);
            PG8_WAIT_V(8); PG8_WAIT_L(0); PG8_BAR; PG8_MMA(0, 0, At, B0); PG8_MMA(0, 1, At, B1); PG8_BAR; PG8_SCHED;
            PG8_LDA(At, 0, 1); PG8_STAGE(PG8_SB(0, 0), b2, voffB); PG8_STAGE(PG8_SB(0, 1), b2 + hstepB, voffB); PG8_STAGE(PG8_SA(0, 0), a2, voffA);
            PG8_WAIT_V(8); PG8_WAIT_L(0); PG8_BAR; PG8_MMA(1, 0, At, B0); PG8_MMA(1, 1, At, B1); PG8_BAR; PG8_SCHED;
            PG8_LDB(B0, 1, 0); PG8_LDB(B1, 1, 1); PG8_SCHED; PG8_LDA(At, 1, 0); PG8_STAGE(PG8_SA(0, 1), a2 + hstepA, voffA);
            PG8_WAIT_V(8); PG8_WAIT_L(0); PG8_BAR; PG8_MMA(0, 0, At, B0); PG8_MMA(0, 1, At, B1); PG8_BAR; PG8_SCHED;
            PG8_LDA(At, 1, 1); PG8_STAGE(PG8_SB(1, 0), b3, voffB); PG8_STAGE(PG8_SB(1, 1), b3 + hstepB, voffB); PG8_STAGE(PG8_SA(1, 0), a3, voffA);
            PG8_WAIT_V(8); PG8_WAIT_L(0); PG8_BAR; PG8_MMA(1, 0, At, B0); PG8_MMA(1, 1, At, B1); PG8_BAR; PG8_SCHED;
            } else {
            PG8_LDB(B0, 0, 0); PG8_SCHED; PG8_LDA(At, 0, 0); PG8_STAGE(PG8_SA(1, 1), a1 + hstepA, voffA);
            PG8_WAIT_L(8); PG8_BAR; PG8_WAIT_L(0); PG8_MMA(0, 0, At, B0); PG8_BAR; PG8_SCHED;
            PG8_LDB(B1, 0, 1); PG8_STAGE(PG8_SB(0, 0), b2, voffB);
            PG8_BAR; PG8_WAIT_L(0); PG8_MMA(0, 1, At, B1); PG8_BAR;
            PG8_LDA(At, 0, 1); PG8_STAGE(PG8_SA(0, 0), a2, voffA);
            PG8_BAR; PG8_WAIT_L(0); PG8_MMA(1, 0, At, B0); PG8_BAR; PG8_SCHED;
            PG8_STAGE(PG8_SB(0, 1), b2 + hstepB, voffB);
            PG8_WAIT_V(6); PG8_BAR; PG8_MMA(1, 1, At, B1); PG8_BAR;
            PG8_LDB(B0, 1, 0); PG8_SCHED; PG8_LDA(At, 1, 0); PG8_STAGE(PG8_SA(0, 1), a2 + hstepA, voffA);
            PG8_WAIT_L(8); PG8_BAR; PG8_WAIT_L(0); PG8_MMA(0, 0, At, B0); PG8_BAR; PG8_SCHED;
            PG8_LDB(B1, 1, 1); PG8_STAGE(PG8_SB(1, 0), b3, voffB);
            PG8_BAR; PG8_WAIT_L(0); PG8_MMA(0, 1, At, B1); PG8_BAR;
            PG8_LDA(At, 1, 1); PG8_STAGE(PG8_SA(1, 0), a3, voffA);
            PG8_BAR; PG8_WAIT_L(0); PG8_MMA(1, 0, At, B0); PG8_BAR; PG8_SCHED;
            PG8_STAGE(PG8_SB(1, 1), b3 + hstepB, voffB);
            PG8_WAIT_V(6); PG8_BAR; PG8_MMA(1, 1, At, B1); PG8_BAR;
            }
        }
        if constexpr (F8 || F4) {
#pragma unroll
            for (int a_ = 0; a_ < 2; ++a_) asm volatile("s_nop 15\n\ts_nop 7" : "+v"(acc[a_][0][0][0]), "+v"(acc[a_][0][0][1]), "+v"(acc[a_][0][1][0]), "+v"(acc[a_][0][1][1]), "+v"(acc[a_][0][2][0]), "+v"(acc[a_][0][2][1]), "+v"(acc[a_][0][3][0]), "+v"(acc[a_][0][3][1]),
                "+v"(acc[a_][1][0][0]), "+v"(acc[a_][1][0][1]), "+v"(acc[a_][1][1][0]), "+v"(acc[a_][1][1][1]), "+v"(acc[a_][1][2][0]), "+v"(acc[a_][1][2][1]), "+v"(acc[a_][1][3][0]), "+v"(acc[a_][1][3][1]));
        }
        if constexpr (ALIGN_EPI) { if (wr == 0) PG8_BAR; }
        bool chain_keep = false;
        if constexpr (Epi::CHAIN) { if (cur.br + 1 == Epi::NBR) E(acc, cur, wr, wc, fr, fq); E.rescale(acc, cur, wr, wc, fr, fq); chain_keep = true; }
        if constexpr (!Epi::AFTER_DRAIN && !Epi::CHAIN) { E(acc, cur, wr, wc, fr, fq); S.done(cur); }
        if (!has_next) break;
        if (!chain_keep) {
#pragma unroll
        for (int a = 0; a < 2; ++a)
#pragma unroll
            for (int b = 0; b < 2; ++b)
#pragma unroll
                for (int m = 0; m < 4; ++m)
#pragma unroll
                    for (int n = 0; n < 2; ++n) acc[a][b][m][n] = (f32x4){0.f, 0.f, 0.f, 0.f};
        }
        cur = nxt; cA = nA; cB = nB; ++ui;
        if constexpr (ALIGN_EPI) { if (wr == 1) PG8_BAR; }
    }
    PG8_WAIT_V(0);
    if constexpr (!ALIGN_EPI) { if (wr == 0) PG8_BAR; }
    PG8_BAR;
    if constexpr (Epi::AFTER_DRAIN) { E.fused(acc, cur, wr, wc, fr, fq, lds, wid, lane); S.done(cur); }
#undef PG8_SA
#undef PG8_SB
#undef PG8_STAGE
#undef PG8_LDA
#undef PG8_LDB
#undef PG8_MMA
#undef PG8_WAIT_V
#undef PG8_WAIT_L
#undef PG8_BAR
#undef PG8_SCHED
}
}

constexpr int S = 16384, DM = 2048, NL = 2, NWAVES = 8;
constexpr int HW = 3584;
constexpr int H_AQ = 0, H_AK = 512, H_BQ = 1024, H_BK = 1536, H_CQ = 1664, H_CK = 2176, H_DCQ = 2688, H_DCKV = 3200, H_DKR = 3456;
constexpr int VT_A = 0, VT_B = 512, VT_C = 640, VT_ROWS = 1280;
constexpr int WIN_ROWS = HW + VT_ROWS;
constexpr float LOG2E = 1.4426950408889634f;
constexpr float DN_ALPHA = 1.4142135623730951f;
constexpr size_t MiB = 1u << 20;
constexpr size_t WS_CTL = 0, CTL_ZERO_BYTES = 1 * MiB;
constexpr size_t WS_W = 1 * MiB, WL_STRIDE = 78 * MiB;
constexpr size_t W_IN = 0, W_G = 19 * MiB, W_BR = 51 * MiB, W_O = 59 * MiB, W_UQ = 67 * MiB, W_UKV = 68 * MiB, W_PQ = 69 * MiB, W_SK = 77 * MiB;
constexpr size_t WS_UB = 157 * MiB, WS_VB = 221 * MiB;
constexpr size_t WS_MLIST = 189 * MiB;
constexpr int MCAP_F = 16384, MCAP = MCAP_F + 4096;
constexpr size_t WS_PART = 926 * MiB;
constexpr size_t WS_CS = 245 * MiB;
constexpr size_t WS_XB8 = 253 * MiB;
constexpr size_t WS_XB = 285 * MiB;
constexpr size_t WS_H = 349 * MiB;
constexpr size_t WS_VT = 461 * MiB;
constexpr size_t WS_GT = 501 * MiB;
constexpr size_t WS_O8 = 629 * MiB;
constexpr size_t WS_XB4 = 661 * MiB;
constexpr size_t WS_O = 757 * MiB;
constexpr size_t WS_QD = 821 * MiB, WS_KD = 845 * MiB, WS_VDT = 869 * MiB, WS_CQN = 885 * MiB, WS_CKVN = 901 * MiB;
constexpr size_t WS_SELE = 909 * MiB, WS_SELG = 917 * MiB, WS_KMEAN = 925 * MiB, WS_TPMAX = 925 * MiB + 512 * 1024, WS_OC2 = 994 * MiB, WS_END = 1010 * MiB;
constexpr int CW_BAR = 4096, CW_Q = 16384, CW_CHK = 20480, CW_MOBA = 24576;
constexpr int RING_BYTES = 131072;
constexpr int MISC_OFF = RING_BYTES;
constexpr int TR_OFF = 0;
constexpr int LDS_BYTES = 147456;

constexpr float U_SCALE = 90.0f, V_SCALE = 4.0f;
#define XB_TMO      128
#define XB_XCNT(j)  (256  + 64 * (j))
#define XB_XSUB(j)  (1280 + 64 * (j))
#define XB_XGEN(j)  (2304 + 64 * (j))
#define XB_TOP      3328
#define XB_TOPGEN   3392
#define XCD_BAR_WORDS 3456
#define XB_SPIN_CAP (1u << 18)

__device__ __forceinline__ unsigned xb_ld(unsigned* p)              { return __hip_atomic_load(p, __ATOMIC_RELAXED, __HIP_MEMORY_SCOPE_AGENT); }
__device__ __forceinline__ unsigned xb_add(unsigned* p, unsigned v) { return __hip_atomic_fetch_add(p, v, __ATOMIC_RELAXED, __HIP_MEMORY_SCOPE_AGENT); }
__device__ __forceinline__ unsigned xb_xcc_id() { return (unsigned)__builtin_amdgcn_s_getreg((3 << 11) | 20) & 0xFu; }
#define XB_SPIN(cond, bar) do { unsigned _sp = 0; while (cond) { __builtin_amdgcn_s_sleep(1); \
    if ((++_sp & 255u) == 0u) { if (xb_ld(&(bar)[XB_TMO])) break; if (_sp > XB_SPIN_CAP) { atomicAdd(&(bar)[XB_TMO], 1u); break; } } } } while (0)

struct XcdBarrier {
    unsigned* bar; unsigned x;
    volatile LAS unsigned* st;
};

__device__ __forceinline__ XcdBarrier xcd_barrier_post(unsigned* bar, volatile LAS unsigned* st) {
    XcdBarrier b; b.bar = bar; b.x = xb_xcc_id(); b.st = st;
    if (threadIdx.x == 0) (void)xb_add(&bar[XB_XCNT(b.x)], 1u);
    return b;
}
__device__ __forceinline__ void xcd_barrier_complete(unsigned* bar, unsigned x, unsigned& nloc, unsigned& nx) {
    const unsigned G = gridDim.x * gridDim.y * gridDim.z;
    unsigned sum, cnt, mine, sp = 0u;
    for (;;) {
        sum = 0u; cnt = 0u; mine = 0u;
#pragma unroll
        for (unsigned j = 0; j < 16; ++j) { const unsigned c = xb_ld(&bar[XB_XCNT(j)]); sum += c; cnt += (c > 0u) ? 1u : 0u; mine = (j == x) ? c : mine; }
        if (sum == G) break;
        __builtin_amdgcn_s_sleep(1);
        if ((++sp & 255u) == 0u) { if (xb_ld(&bar[XB_TMO])) break; if (sp > XB_SPIN_CAP) { atomicAdd(&bar[XB_TMO], 1u); break; } }
    }
    nloc = mine > 0u ? mine : 1u; nx = cnt > 0u ? cnt : 1u;
}

__device__ __forceinline__ void xcd_barrier(const XcdBarrier& b) {
    asm volatile("s_waitcnt vmcnt(0)" ::: "memory");
    __syncthreads();
    if (threadIdx.x == 0) {
        unsigned* bar = b.bar;
        __builtin_amdgcn_s_waitcnt(0);
        unsigned nloc = b.st[0], nx = b.st[1];
        if (nloc == 0u) { xcd_barrier_complete(bar, b.x, nloc, nx); b.st[0] = nloc; b.st[1] = nx; }
        const unsigned old = xb_add(&bar[XB_XSUB(b.x)], 1u);
        const unsigned gen = old / nloc;
        if (old + 1u == (gen + 1u) * nloc) {
            __builtin_amdgcn_fence(__ATOMIC_RELEASE, "agent");
            asm volatile("s_waitcnt vmcnt(0)" ::: "memory");
            const unsigned og = xb_add(&bar[XB_TOP], 1u);
            const unsigned tg = og / nx;
            if (og + 1u == (tg + 1u) * nx) xb_add(&bar[XB_TOPGEN], 1u);
            else XB_SPIN(xb_ld(&bar[XB_TOPGEN]) == tg, bar);
            __builtin_amdgcn_fence(__ATOMIC_ACQUIRE, "agent");
            xb_add(&bar[XB_XGEN(b.x)], 1u);
            asm volatile("s_waitcnt vmcnt(0)" ::: "memory");
        } else {
            XB_SPIN(xb_ld(&bar[XB_XGEN(b.x)]) == gen, bar);
            __builtin_amdgcn_fence(__ATOMIC_ACQUIRE, "agent");
            asm volatile("s_waitcnt vmcnt(0)" ::: "memory");
        }
    }
    __syncthreads();
}

struct Args { const float* in[26]; float* out; unsigned char* ws; int ph_lo, ph_hi; };
struct Frame {
    LAS unsigned char* lds; volatile LAS unsigned* MISC;
    int tid, lane, wave, vcu, G;
    unsigned char* ws; float* out;
};
DI bf16_t* wsb(const Frame& F, size_t off) { return (bf16_t*)(F.ws + off); }

DI void transpose_item(const float* W, int ldw, bf16_t* WT, int ldt, int k0, int n0, int drow0, LAS float* scr, int lane) {
#pragma unroll 8
    for (int i = 0; i < 32; ++i) { const int kk = 2 * i + (lane >> 5); scr[kk * 33 + (lane & 31)] = W[(size_t)(k0 + kk) * ldw + n0 + (lane & 31)]; }
    asm volatile("s_waitcnt lgkmcnt(0)" ::: "memory");
    const int c = lane & 7;
#pragma unroll
    for (int j = 0; j < 4; ++j) { const int n = (lane >> 3) + 8 * j; const LAS float* s = scr + (8 * c) * 33 + n;
        u32x4 o; o.x = cvtpk(s[0 * 33], s[1 * 33]); o.y = cvtpk(s[2 * 33], s[3 * 33]); o.z = cvtpk(s[4 * 33], s[5 * 33]); o.w = cvtpk(s[6 * 33], s[7 * 33]);
        *(u32x4*)(WT + (size_t)(drow0 + n) * ldt + k0 + 8 * c) = o; }
    asm volatile("s_waitcnt lgkmcnt(0)" ::: "memory");
}
DI void transpose_item8(const float* W, int ldw, unsigned char* WT, int ldt, int k0, int n0, int drow0, LAS float* scr, int lane, float scale) {
#pragma unroll 8
    for (int i = 0; i < 32; ++i) { const int kk = 2 * i + (lane >> 5); scr[kk * 33 + (lane & 31)] = W[(size_t)(k0 + kk) * ldw + n0 + (lane & 31)]; }
    asm volatile("s_waitcnt lgkmcnt(0)" ::: "memory");
    const int c = lane & 7;
#pragma unroll
    for (int j = 0; j < 4; ++j) { const int n = (lane >> 3) + 8 * j; const LAS float* s = scr + (8 * c) * 33 + n;
        int lo = __builtin_amdgcn_cvt_pk_fp8_f32(s[0 * 33] * scale, s[1 * 33] * scale, 0, false); lo = __builtin_amdgcn_cvt_pk_fp8_f32(s[2 * 33] * scale, s[3 * 33] * scale, lo, true);
        int hi = __builtin_amdgcn_cvt_pk_fp8_f32(s[4 * 33] * scale, s[5 * 33] * scale, 0, false); hi = __builtin_amdgcn_cvt_pk_fp8_f32(s[6 * 33] * scale, s[7 * 33] * scale, hi, true);
        *(u32x2*)(WT + (size_t)(drow0 + n) * ldt + k0 + 8 * c) = (u32x2){(unsigned)lo, (unsigned)hi}; }
    asm volatile("s_waitcnt lgkmcnt(0)" ::: "memory");
}
DI void transpose_item4(const float* W, int ldw, unsigned char* WT, int ldt, int k0, int n0, int drow0, LAS float* scr, int lane, float scale) {
#pragma unroll 8
    for (int i = 0; i < 32; ++i) { const int kk = 2 * i + (lane >> 5); scr[kk * 33 + (lane & 31)] = W[(size_t)(k0 + kk) * ldw + n0 + (lane & 31)]; }
    asm volatile("s_waitcnt lgkmcnt(0)" ::: "memory");
    const int c = lane & 7;
#pragma unroll
    for (int j = 0; j < 4; ++j) { const int n = (lane >> 3) + 8 * j; const LAS float* s = scr + (8 * c) * 33 + n;
        unsigned d = 0u;
        d = __builtin_amdgcn_cvt_scalef32_pk_fp4_f32(d, s[0 * 33] * scale, s[1 * 33] * scale, 1.0f, 0); d = __builtin_amdgcn_cvt_scalef32_pk_fp4_f32(d, s[2 * 33] * scale, s[3 * 33] * scale, 1.0f, 1);
        d = __builtin_amdgcn_cvt_scalef32_pk_fp4_f32(d, s[4 * 33] * scale, s[5 * 33] * scale, 1.0f, 2); d = __builtin_amdgcn_cvt_scalef32_pk_fp4_f32(d, s[6 * 33] * scale, s[7 * 33] * scale, 1.0f, 3);
        *(unsigned*)(WT + (size_t)(drow0 + n) * ldt + (k0 >> 1) + 4 * c) = d; }
    asm volatile("s_waitcnt lgkmcnt(0)" ::: "memory");
}
DI int win_map(int c) {
    if (c < 1024) return c;
    if (c < 1536) return HW + VT_A + (c - 1024);
    if (c < 2176) return H_BQ + (c - 1536);
    if (c < 2304) return HW + VT_B + (c - 2176);
    if (c < 3328) return H_CQ + (c - 2304);
    if (c < 3840) return HW + VT_C + (c - 3328);
    return H_DCQ + (c - 3840);
}
template <int MAP, bool F8 = false, bool F4 = false> DI void transpose_matrix(const Frame& F, const float* W, int K, int N, bf16_t* WT, int roff) {
    LAS float* scr = (LAS float*)(F.lds + TR_OFF + F.wave * 8704);
    const int gw = F.vcu * NWAVES + F.wave, NGW = F.G * NWAVES, nblk = N / 32, items = (K / 64) * nblk;
    int lane = F.lane; asm volatile("" : "+v"(lane));
    for (int it = gw; it < items; it += NGW) {
        const int kb = it / nblk, nb = it % nblk, n0 = 32 * nb;
        int drow = roff + n0;
        if (MAP == 1) drow = win_map(n0);
        if (MAP == 2) { const int h = n0 >> 8, j = n0 & 255; drow = (j < 128) ? h * 128 + j : 512 + h * 128 + (j - 128); }
        if (F4) transpose_item4(W, N, (unsigned char*)WT, K / 2, 64 * kb, n0, drow, scr, lane, 64.0f); else if (F8) transpose_item8(W, N, (unsigned char*)WT, K, 64 * kb, n0, drow, scr, lane, 64.0f); else transpose_item(W, N, WT, K, 64 * kb, n0, drow, scr, lane);
    }
}
DI void convert_bf16(const Frame& F, const float* src, bf16_t* dst, size_t n) {
    const size_t nth = (size_t)F.G * 512, t0 = (size_t)F.vcu * 512 + F.tid;
    for (size_t i = t0; i < n / 8; i += nth) { const f32x4 a = *(const f32x4*)(src + 8 * i), b = *(const f32x4*)(src + 8 * i + 4);
        u32x4 w; w.x = cvtpk(a[0], a[1]); w.y = cvtpk(a[2], a[3]); w.z = cvtpk(b[0], b[1]); w.w = cvtpk(b[2], b[3]); *(u32x4*)(dst + 8 * i) = w; }
}

typedef float v16f __attribute__((ext_vector_type(16)));
typedef float v32f __attribute__((ext_vector_type(32)));
typedef unsigned v6u __attribute__((ext_vector_type(6)));
DI void convert_fp6(const Frame& F, const float* src, unsigned char* dst, int rows, float scale) {
    const size_t nth = (size_t)F.G * 512, t0 = (size_t)F.vcu * 512 + F.tid;
    for (size_t i = t0; i < (size_t)rows * 64; i += nth) {
        const size_t row = i >> 6; const int l = (int)(i & 63);
        const float* p = src + row * 2048 + 32 * l;
        v16f a, b;
#pragma unroll
        for (int q = 0; q < 8; ++q) { const f32x4 x = *(const f32x4*)(p + 4 * q) * scale;
            a[2 * q] = x[0]; b[2 * q] = x[1]; a[2 * q + 1] = x[2]; b[2 * q + 1] = x[3]; }
        const v6u w = __builtin_amdgcn_cvt_scalef32_2xpk16_fp6_f32(a, b, 1.0f);
        *(u32x4*)(dst + row * 1536 + 16 * l) = (u32x4){w[0], w[1], w[2], w[3]};
        *(u32x2*)(dst + row * 1536 + 1024 + 8 * l) = (u32x2){w[4], w[5]};
    }
}

DI void convert_fp4(const Frame& F, const float* src, unsigned char* dst, int rows, float scale) {
    const size_t nth = (size_t)F.G * 512, t0 = (size_t)F.vcu * 512 + F.tid;
    for (size_t i = t0; i < (size_t)rows * 64; i += nth) {
        const float* p = src + i * 32;
        u32x4 w = (u32x4){0u, 0u, 0u, 0u};
#define FP4_PK(q) { const f32x4 x = *(const f32x4*)(p + 4 * (q)) * scale; unsigned d = w[(q) >> 1];         \
            d = __builtin_amdgcn_cvt_scalef32_pk_fp4_f32(d, x[0], x[1], 1.0f, (2 * (q)) & 3); d = __builtin_amdgcn_cvt_scalef32_pk_fp4_f32(d, x[2], x[3], 1.0f, (2 * (q) + 1) & 3); w[(q) >> 1] = d; }
        FP4_PK(0) FP4_PK(1) FP4_PK(2) FP4_PK(3) FP4_PK(4) FP4_PK(5) FP4_PK(6) FP4_PK(7)
#undef FP4_PK
        *(u32x4*)(dst + i * 16) = w;
    }
}

DI void convert_weights(const Frame& F, const Args& a, int l_lo, int l_hi) {
    for (int l = l_lo; l < l_hi; ++l) {
        unsigned char* wl = F.ws + WS_W + (size_t)l * WL_STRIDE;
        transpose_matrix<1, true>(F, a.in[3] + (size_t)l * DM * 4672, DM, 4672, (bf16_t*)(wl + W_IN), 0);
        for (int n = 0; n < 4; ++n) transpose_matrix<0, false, true>(F, a.in[4] + ((size_t)l * 4 + n) * DM * DM, DM, DM, (bf16_t*)(wl + W_G), n * DM);
        for (int n = 0; n < 4; ++n) transpose_matrix<0, true>(F, a.in[6] + ((size_t)l * 4 + n) * 512 * DM, 512, DM, (bf16_t*)(wl + W_BR) + (size_t)n * DM * 512, 0);
        transpose_matrix<0, true>(F, a.in[7] + (size_t)l * DM * DM, DM, DM, (bf16_t*)(wl + W_O), 0);
        transpose_matrix<0>(F, a.in[16] + (size_t)l * 512 * 768, 512, 768, (bf16_t*)(wl + W_UQ), 0);
        transpose_matrix<2>(F, a.in[17] + (size_t)l * 256 * 1024, 256, 1024, (bf16_t*)(wl + W_UKV), 0);
        transpose_matrix<0>(F, a.in[20] + (size_t)l * DM * DM, DM, DM, (bf16_t*)(wl + W_PQ), 0);
        convert_bf16(F, a.in[21] + (size_t)l * 8 * 2 * 128 * 128, (bf16_t*)(wl + W_SK), (size_t)8 * 2 * 128 * 128);
    }
}
DI void build_rope_table(const Frame& F, const Args& a) {
    f32x2* CS = (f32x2*)(F.ws + WS_CS); const int* pos = (const int*)a.in[1];
    for (size_t i = (size_t)F.vcu * 512 + F.tid; i < (size_t)S * 32; i += (size_t)F.G * 512) {
        const int j = (int)(i & 31); const float inv = exp2f(-(float)j * (13.287712379549449f / 32.0f));
        const float ang = (float)pos[i >> 5] * inv;
        CS[i] = (f32x2){cosf(ang), sinf(ang)};
    }
}
DI void phase_prologue(const Frame& F, const Args& a) {
    convert_weights(F, a, 0, 1);
    convert_bf16(F, a.in[0], wsb(F, WS_XB), (size_t)S * DM);
    {
        const size_t nth = (size_t)F.G * 512, t0 = (size_t)F.vcu * 512 + F.tid; const float* src = a.in[0]; unsigned char* dst = F.ws + WS_XB4;
        for (size_t i = t0; i < (size_t)S * DM / 8; i += nth) { const f32x4 x = *(const f32x4*)(src + 8 * i) * 2.0f, y = *(const f32x4*)(src + 8 * i + 4) * 2.0f;
            unsigned d = 0u; d = __builtin_amdgcn_cvt_scalef32_pk_fp4_f32(d, x[0], x[1], 1.0f, 0); d = __builtin_amdgcn_cvt_scalef32_pk_fp4_f32(d, x[2], x[3], 1.0f, 1); d = __builtin_amdgcn_cvt_scalef32_pk_fp4_f32(d, y[0], y[1], 1.0f, 2); d = __builtin_amdgcn_cvt_scalef32_pk_fp4_f32(d, y[2], y[3], 1.0f, 3);
            *(unsigned*)(dst + 4 * i) = d; }
    }
    {
        const size_t nth = (size_t)F.G * 512, t0 = (size_t)F.vcu * 512 + F.tid; const float* src = a.in[0]; unsigned char* dst = F.ws + WS_XB8;
        for (size_t i = t0; i < (size_t)S * DM / 8; i += nth) { const f32x4 x = *(const f32x4*)(src + 8 * i), y = *(const f32x4*)(src + 8 * i + 4);
            int lo = __builtin_amdgcn_cvt_pk_fp8_f32(x[0], x[1], 0, false); lo = __builtin_amdgcn_cvt_pk_fp8_f32(x[2], x[3], lo, true); int hi = __builtin_amdgcn_cvt_pk_fp8_f32(y[0], y[1], 0, false); hi = __builtin_amdgcn_cvt_pk_fp8_f32(y[2], y[3], hi, true);
            *(u32x2*)(dst + 8 * i) = (u32x2){(unsigned)lo, (unsigned)hi}; }
    }
    build_rope_table(F, a);
}

DI float rope64(float x, int lane, const f32x2* cs_row) {
    const float other = xhalf(x);
    const f32x2 cs = cs_row[lane & 31];
    return (lane < 32) ? x * cs.x - other * cs.y : other * cs.y + x * cs.x;
}
DI void phase_prep(const Frame& F, const Args& a, int layer) {
    const bf16_t* H = wsb(F, WS_H); bf16_t* CQN = wsb(F, WS_CQN); bf16_t* CKVN = wsb(F, WS_CKVN); bf16_t* KD = wsb(F, WS_KD);
    const float* gq = a.in[14] + layer * 512; const float* gkv = a.in[15] + layer * 256; const int* pos = (const int*)a.in[1];
    const int gw = F.vcu * NWAVES + F.wave, NGW = F.G * NWAVES, lane = F.lane;
    for (int t = gw; t < S; t += NGW) {
        const bf16_t* hr = H + (size_t)t * HW;
        const u32x4 q = *(const u32x4*)(hr + H_DCQ + 8 * lane);
        float v[8] = {bf_lo(q.x), bf_hi(q.x), bf_lo(q.y), bf_hi(q.y), bf_lo(q.z), bf_hi(q.z), bf_lo(q.w), bf_hi(q.w)};
        float ss = 0.f;
#pragma unroll
        for (int e = 0; e < 8; ++e) ss += v[e] * v[e];
        const float rq = rsqrtf(wave_sum(ss) * (1.0f / 512.0f) + 1e-6f);
        const f32x4 g0 = *(const f32x4*)(gq + 8 * lane), g1 = *(const f32x4*)(gq + 8 * lane + 4);
        u32x4 w; w.x = cvtpk(v[0] * rq * g0[0], v[1] * rq * g0[1]); w.y = cvtpk(v[2] * rq * g0[2], v[3] * rq * g0[3]); w.z = cvtpk(v[4] * rq * g1[0], v[5] * rq * g1[1]); w.w = cvtpk(v[6] * rq * g1[2], v[7] * rq * g1[3]);
        *(u32x4*)(CQN + (size_t)t * 512 + 8 * lane) = w;
        const u32x2 k2 = *(const u32x2*)(hr + H_DCKV + 4 * lane);
        const float u0 = bf_lo(k2.x), u1 = bf_hi(k2.x), u2 = bf_lo(k2.y), u3 = bf_hi(k2.y);
        const float rk = rsqrtf(wave_sum(u0 * u0 + u1 * u1 + u2 * u2 + u3 * u3) * (1.0f / 256.0f) + 1e-6f);
        const f32x4 gk = *(const f32x4*)(gkv + 4 * lane);
        u32x2 w2; w2.x = cvtpk(u0 * rk * gk[0], u1 * rk * gk[1]); w2.y = cvtpk(u2 * rk * gk[2], u3 * rk * gk[3]);
        *(u32x2*)(CKVN + (size_t)t * 256 + 4 * lane) = w2;
        const float kr = bf1(hr[H_DKR + lane]);
        const float ro = rope64(kr, lane, (const f32x2*)(F.ws + WS_CS) + (size_t)t * 32);
        const bf16_t rb = (bf16_t)(cvtpk(ro, 0.f) & 0xffffu);
#pragma unroll
        for (int h = 0; h < 4; ++h) KD[(size_t)t * 768 + h * 192 + 128 + lane] = rb;
    }
    for (int t = gw; t < S / 64; t += NGW) { int pm = pos[t * 64 + lane];
#pragma unroll
        for (int o = 1; o < 64; o <<= 1) { const int other = __shfl_xor(pm, o); pm = other > pm ? other : pm; }
        if (lane == 0) ((int*)(F.ws + WS_TPMAX))[t] = pm; }
    float* KM = (float*)(F.ws + WS_KMEAN);
    for (int it = gw; it < 64 * 8; it += NGW) {
        const int n = it >> 3, cc = it & 7; const bf16_t* p = H + (size_t)(n * 256) * HW + H_AK + cc * 64 + lane;
        float s0 = 0.f, s1 = 0.f, s2 = 0.f, s3 = 0.f;
        for (int r = 0; r < 256; r += 4) { s0 += bf1(p[(size_t)r * HW]); s1 += bf1(p[(size_t)(r + 1) * HW]); s2 += bf1(p[(size_t)(r + 2) * HW]); s3 += bf1(p[(size_t)(r + 3) * HW]); }
        KM[n * 512 + cc * 64 + lane] = ((s0 + s1) + (s2 + s3)) * (1.0f / 256.0f);
    }
}
DI void phase_ropeq(const Frame& F, const Args& a) {
    bf16_t* QD = wsb(F, WS_QD); const int* pos = (const int*)a.in[1];
    const int gw = F.vcu * NWAVES + F.wave, NGW = F.G * NWAVES, lane = F.lane;
    for (int t = gw; t < S; t += NGW) {
        const f32x2* cs = (const f32x2*)(F.ws + WS_CS) + (size_t)t * 32;
#pragma unroll
        for (int h = 0; h < 4; ++h) { bf16_t* p = QD + (size_t)t * 768 + h * 192 + 128 + lane; const float ro = rope64(bf1(*p), lane, cs); *p = (bf16_t)(cvtpk(ro, 0.f) & 0xffffu); }
    }
}
DI void phase_moba_select(const Frame& F, const Args& a, int layer) {
    const bf16_t* H = wsb(F, WS_H); const float* KM = (const float*)(F.ws + WS_KMEAN); const int* pos = (const int*)a.in[1]; const int* TP = (const int*)(F.ws + WS_TPMAX);
    unsigned* cnt = (unsigned*)(F.ws + WS_CTL) + CW_MOBA + layer * 1024; int* lists = (int*)(F.ws + WS_MLIST);
    const int gw = F.vcu * NWAVES + F.wave, NGW = F.G * NWAVES;
    int lane = F.lane; asm volatile("" : "+v"(lane));
    const int r = lane & 31, hi = lane >> 5;
    for (int it = gw; it < (S / 32) * 4; it += NGW) {
        const int h = it & 3, q0 = (it >> 2) * 32, q = q0 + r, own = q0 >> 8;
        if (own == 0) continue;
        const bf16_t* qp = H + (size_t)q * HW + H_AQ + h * 128 + hi * 8;
        const bool two = own > 32;
        f32x16 g0, g1;
#pragma unroll
        for (int i = 0; i < 16; ++i) { g0[i] = 0.f; g1[i] = 0.f; }
#pragma unroll
        for (int kk = 0; kk < 8; ++kk) {
            const bf16x8 qf = *(const bf16x8*)(qp + kk * 16);
#pragma unroll
            for (int rb = 0; rb < 2; ++rb) {
                if (rb == 1 && !two) continue;
                const float* kp = KM + (size_t)(rb * 32 + r) * 512 + h * 128 + kk * 16 + hi * 8;
                const f32x4 x = *(const f32x4*)kp, y = *(const f32x4*)(kp + 4);
                u32x4 wh, wl;
                wh.x = cvtpk(x[0], x[1]); wh.y = cvtpk(x[2], x[3]); wh.z = cvtpk(y[0], y[1]); wh.w = cvtpk(y[2], y[3]);
                wl.x = cvtpk(x[0] - bf_lo(wh.x), x[1] - bf_hi(wh.x)); wl.y = cvtpk(x[2] - bf_lo(wh.y), x[3] - bf_hi(wh.y)); wl.z = cvtpk(y[0] - bf_lo(wh.z), y[1] - bf_hi(wh.z)); wl.w = cvtpk(y[2] - bf_lo(wh.w), y[3] - bf_hi(wh.w));
                if (rb == 0) { g0 = __builtin_amdgcn_mfma_f32_32x32x16_bf16(__builtin_bit_cast(bf16x8, wh), qf, g0, 0, 0, 0); g0 = __builtin_amdgcn_mfma_f32_32x32x16_bf16(__builtin_bit_cast(bf16x8, wl), qf, g0, 0, 0, 0); }
                else { g1 = __builtin_amdgcn_mfma_f32_32x32x16_bf16(__builtin_bit_cast(bf16x8, wh), qf, g1, 0, 0, 0); g1 = __builtin_amdgcn_mfma_f32_32x32x16_bf16(__builtin_bit_cast(bf16x8, wl), qf, g1, 0, 0, 0); }
            }
        }
        float v1 = -INFINITY, v2 = -INFINITY, v3 = -INFINITY; int i1 = -1, i2 = -1, i3 = -1;
#pragma unroll
        for (int rb = 0; rb < 2; ++rb)
#pragma unroll
            for (int i = 0; i < 16; ++i) {
                const int n = rb * 32 + (i & 3) + 8 * (i >> 2) + 4 * hi; const float g = (rb == 0) ? g0[i] : g1[i];
                if (n < own) {
                    if (g > v1) { v3 = v2; i3 = i2; v2 = v1; i2 = i1; v1 = g; i1 = n; }
                    else if (g > v2) { v3 = v2; i3 = i2; v2 = g; i2 = n; }
                    else if (g > v3) { v3 = g; i3 = n; }
                }
            }
        const float p1 = xhalf(v1), p2 = xhalf(v2), p3 = xhalf(v3);
        const int j1 = __shfl_xor(i1, 32), j2 = __shfl_xor(i2, 32), j3 = __shfl_xor(i3, 32);
#pragma unroll
        for (int c = 0; c < 3; ++c) { const float g = c == 0 ? p1 : (c == 1 ? p2 : p3); const int n = c == 0 ? j1 : (c == 1 ? j2 : j3);
            if (n >= 0) {
                if (g > v1 || (g == v1 && n < i1)) { v3 = v2; i3 = i2; v2 = v1; i2 = i1; v1 = g; i1 = n; }
                else if (g > v2 || (g == v2 && n < i2)) { v3 = v2; i3 = i2; v2 = g; i2 = n; }
                else if (g > v3 || (g == v3 && n < i3)) { v3 = g; i3 = n; }
            } }
        if (hi == 0) {
            const int pq = pos[q];
#pragma unroll
            for (int sl = 0; sl < 3; ++sl) { const int n = sl == 0 ? i1 : (sl == 1 ? i2 : i3);
                if (n >= 0) { const int bm = max(max(TP[4 * n], TP[4 * n + 1]), max(TP[4 * n + 2], TP[4 * n + 3])); const int near = (pq - bm < 790) ? 1 : 0;
                    const unsigned p = atomicAdd(cnt + near * 256 + h * 64 + n, 1u);
                    if (p < (unsigned)(near ? MCAP - MCAP_F : MCAP_F)) lists[(size_t)(h * 64 + n) * MCAP + (near ? MCAP_F : 0) + p] = q * 4 + sl; } }
        }
    }
}
DI void phase_mixer_combine(const Frame& F, const Args& a, int layer) {
    const unsigned char* PART = F.ws + WS_PART; bf16_t* OA = wsb(F, WS_O);
    const int gw = F.vcu * NWAVES + F.wave, NGW = F.G * NWAVES, lane = F.lane;
    for (size_t i = (size_t)F.vcu * 512 + F.tid; i < (size_t)2 * S * 64; i += (size_t)F.G * 512) {
        const size_t br = (i >= (size_t)S * 64) ? 3 : 1, e = (i - (br == 3 ? (size_t)S * 64 : 0)) * 8;
        const u32x4 w = *(const u32x4*)(wsb(F, WS_O) + br * S * 512 + e);
        int lo = __builtin_amdgcn_cvt_pk_fp8_f32(bf_lo(w.x) * 8.0f, bf_hi(w.x) * 8.0f, 0, false); lo = __builtin_amdgcn_cvt_pk_fp8_f32(bf_lo(w.y) * 8.0f, bf_hi(w.y) * 8.0f, lo, true);
        int hi = __builtin_amdgcn_cvt_pk_fp8_f32(bf_lo(w.z) * 8.0f, bf_hi(w.z) * 8.0f, 0, false); hi = __builtin_amdgcn_cvt_pk_fp8_f32(bf_lo(w.w) * 8.0f, bf_hi(w.w) * 8.0f, hi, true);
        *(u32x2*)(F.ws + WS_O8 + br * S * 512 + e) = (u32x2){(unsigned)lo, (unsigned)hi};
    }
    for (int it = gw; it < S * 4; it += NGW) {
        const int q = it >> 2, h = it & 3, nsel = (q >> 8) < 3 ? (q >> 8) : 3;
        const unsigned char* pp = PART + ((size_t)q * 16 + h * 4) * 272;
        float mm[4], ll[4]; unsigned ov[4];
#pragma unroll
        for (int s = 0; s < 4; ++s) { const bool use = (s == 3) || (s < nsel); const f32x2 ml = *(const f32x2*)(pp + s * 272 + 256); mm[s] = use ? ml.x : -1e30f; ll[s] = use ? ml.y : 0.f; ov[s] = *(const unsigned*)(pp + s * 272 + lane * 4); }
        const float M = fmaxf(fmaxf(mm[0], mm[1]), fmaxf(mm[2], mm[3]));
        float wsum = 0.f, x0 = 0.f, x1 = 0.f;
#pragma unroll
        for (int s = 0; s < 4; ++s) { const float w = ll[s] * ex2(mm[s] - M); wsum += w; x0 += w * bf_lo(ov[s]); x1 += w * bf_hi(ov[s]); }
        const float inv = 1.0f / wsum;
        *(unsigned*)(OA + (size_t)q * 512 + h * 128 + lane * 2) = cvtpk(x0 * inv, x1 * inv);
        *(unsigned short*)(F.ws + WS_O8 + (size_t)q * 512 + h * 128 + lane * 2) = (unsigned short)__builtin_amdgcn_cvt_pk_fp8_f32(x0 * inv * 8.0f, x1 * inv * 8.0f, 0, false);
    }
    float d1 = 0.f, d2 = 0.f;
    for (int i = 0; i < 64; ++i) { d1 += a.in[9][layer * 64 + i] * a.in[10][layer * 64 + i]; d2 += a.in[11][layer * 64 + i] * a.in[12][layer * 64 + i]; }
    const float lambda_init = 0.8f - 0.6f * expf(-0.3f * (float)layer), lam = expf(d1) - expf(d2) + lambda_init;
    bf16_t* OC = wsb(F, WS_O) + (size_t)2 * S * 512; const bf16_t* OC2 = wsb(F, WS_OC2);
    const f32x2 sg = *(const f32x2*)(a.in[13] + layer * 128 + lane * 2);
    for (int it = gw; it < S * 4; it += NGW) {
        const size_t off = (size_t)(it >> 2) * 512 + (it & 3) * 128 + lane * 2;
        const unsigned w1 = *(const unsigned*)(OC + off), w2 = *(const unsigned*)(OC2 + off);
        const float x0 = bf_lo(w1) - lam * bf_lo(w2), x1 = bf_hi(w1) - lam * bf_hi(w2);
        const float rn = rsqrtf(wave_sum(x0 * x0 + x1 * x1) * (1.0f / 128.0f) + 1e-6f) * (1.0f - lambda_init);
        *(unsigned*)(OC + off) = cvtpk(x0 * rn * sg.x, x1 * rn * sg.y);
        *(unsigned short*)(F.ws + WS_O8 + (size_t)2 * S * 512 + off) = (unsigned short)__builtin_amdgcn_cvt_pk_fp8_f32(x0 * rn * sg.x * 8.0f, x1 * rn * sg.y * 8.0f, 0, false);
    }
}
template <int NJ, int NE> DI void ln_store(float (&v)[NJ][NE], const float* g, const float* b, float* of, bf16_t* ob, int lane, unsigned char* o8 = nullptr, unsigned char* o4 = nullptr) {
    static_assert(NJ * NE == 32 && NE % 8 == 0, "row layout");
    float s = 0.f;
#pragma unroll
    for (int j = 0; j < NJ; ++j)
#pragma unroll
        for (int e = 0; e < NE; ++e) s += v[j][e];
    const float mean = wave_sum(s) * (1.0f / DM);
    float q = 0.f;
#pragma unroll
    for (int j = 0; j < NJ; ++j)
#pragma unroll
        for (int e = 0; e < NE; ++e) { v[j][e] -= mean; q += v[j][e] * v[j][e]; }
    const float rstd = rsqrtf(wave_sum(q) * (1.0f / DM) + 1e-5f);
#pragma unroll
    for (int j = 0; j < NJ; ++j)
#pragma unroll
        for (int e8 = 0; e8 < NE; e8 += 8) {
            const int c = (DM / NJ) * j + NE * lane + e8;
            const f32x4 g0 = *(const f32x4*)(g + c), g1 = *(const f32x4*)(g + c + 4), b0 = *(const f32x4*)(b + c), b1 = *(const f32x4*)(b + c + 4);
            f32x4 o0, o1;
#pragma unroll
            for (int e = 0; e < 4; ++e) { o0[e] = v[j][e8 + e] * rstd * g0[e] + b0[e]; o1[e] = v[j][e8 + 4 + e] * rstd * g1[e] + b1[e]; }
            if (of) { *(f32x4*)(of + c) = o0; *(f32x4*)(of + c + 4) = o1; }
            u32x4 w; w.x = cvtpk(o0[0], o0[1]); w.y = cvtpk(o0[2], o0[3]); w.z = cvtpk(o1[0], o1[1]); w.w = cvtpk(o1[2], o1[3]);
            *(u32x4*)(ob + c) = w;
            if (o8) { int lo = __builtin_amdgcn_cvt_pk_fp8_f32(o0[0], o0[1], 0, false); lo = __builtin_amdgcn_cvt_pk_fp8_f32(o0[2], o0[3], lo, true); int hi = __builtin_amdgcn_cvt_pk_fp8_f32(o1[0], o1[1], 0, false); hi = __builtin_amdgcn_cvt_pk_fp8_f32(o1[2], o1[3], hi, true);
                *(u32x2*)(o8 + c) = (u32x2){(unsigned)lo, (unsigned)hi}; }
            if (o4) { unsigned d = 0u; d = __builtin_amdgcn_cvt_scalef32_pk_fp4_f32(d, o0[0] * 2.0f, o0[1] * 2.0f, 1.0f, 0); d = __builtin_amdgcn_cvt_scalef32_pk_fp4_f32(d, o0[2] * 2.0f, o0[3] * 2.0f, 1.0f, 1);
                d = __builtin_amdgcn_cvt_scalef32_pk_fp4_f32(d, o1[0] * 2.0f, o1[1] * 2.0f, 1.0f, 2); d = __builtin_amdgcn_cvt_scalef32_pk_fp4_f32(d, o1[2] * 2.0f, o1[3] * 2.0f, 1.0f, 3); *(unsigned*)(o4 + (c >> 1)) = d; }
        }
}
DI void phase_ln1(const Frame& F, const Args& a, int layer) {
    const bf16_t* Y = wsb(F, WS_GT); bf16_t* XB = wsb(F, WS_XB);
    const int gw = F.vcu * NWAVES + F.wave, NGW = F.G * NWAVES, lane = F.lane;
    for (int t = gw; t < S; t += NGW) {
        float v[4][8];
#pragma unroll
        for (int j = 0; j < 4; ++j) { const u32x4 w = *(const u32x4*)(Y + (size_t)t * DM + 512 * j + 8 * lane);
            v[j][0] = bf_lo(w.x); v[j][1] = bf_hi(w.x); v[j][2] = bf_lo(w.y); v[j][3] = bf_hi(w.y); v[j][4] = bf_lo(w.z); v[j][5] = bf_hi(w.z); v[j][6] = bf_lo(w.w); v[j][7] = bf_hi(w.w); }
        ln_store<4, 8>(v, a.in[18] + layer * DM, a.in[19] + layer * DM, (float*)nullptr, XB + (size_t)t * DM, lane);
    }
}

namespace att {
constexpr int TBL = RING_BYTES - 4096;
constexpr int TPMO = TBL - 1024;
constexpr int KMO = 0;
constexpr float NEG = -1e30f;
enum { MIX_A = 0, MIX_B = 1, MIX_C = 2, MIX_D = 3 };

struct Ctx { int qi, pq, own; float c, cb; unsigned long long sel; };

DI int t5_bucket(int rel) {
    if (rel < 16) return rel;
    return 15 + (rel >= 16) + (rel >= 21) + (rel >= 27) + (rel >= 35) + (rel >= 46) + (rel >= 59) + (rel >= 77) + (rel >= 99) + (rel >= 128) + (rel >= 166) + (rel >= 216) + (rel >= 280) + (rel >= 363) + (rel >= 470) + (rel >= 609) + (rel >= 790);
}
DI void build_tbl(LAS unsigned char* lds, const float* t5, int col, const int* tpmax) {
    if (threadIdx.x < 256) *(LAS int*)(lds + TPMO + threadIdx.x * 4) = tpmax[threadIdx.x];
    for (int rel = threadIdx.x; rel < 1024; rel += 512) *(LAS float*)(lds + TBL + rel * 4) = t5[t5_bucket(rel) * 16 + col] * LOG2E;
}

#define ATT_SB() __builtin_amdgcn_sched_barrier(0)
#ifndef ATT_CONV_INTERLEAVE
#define ATT_CONV_INTERLEAVE 1
#endif
#ifndef ATT_CP_D
#define ATT_CP_D 0
#endif
#ifndef ATT_CP
#define ATT_CP 0
#endif
#ifndef ATT_X_LDS2
#define ATT_X_LDS2 0
#endif
#ifndef ATT_NOPRIO
#define ATT_NOPRIO 0
#endif
#if ATT_NOPRIO
#define ATT_PRIO(x) do { } while (0)
#else
#define ATT_PRIO(x) __builtin_amdgcn_s_setprio(x)
#endif
#if defined(ATT_X_NOSM)
#define ATT_SM(...) do { l_run = 1.0f; st0.resc = false; st1.resc = false; st0.alpha = 1.f; st1.alpha = 1.f; pf0[0] = qf[0]; pf0[1] = qf[1]; pf1[0] = qf[2]; pf1[1] = qf[3]; } while (0)
#else
#define ATT_SM(...) __VA_ARGS__
#endif
#ifndef ATT_PD
#define ATT_PD 4
#endif
DI float hmax32(float v) { auto rr = __builtin_amdgcn_permlane32_swap(__float_as_uint(v), __float_as_uint(v), false, false); return fmaxf(__uint_as_float(rr[0]), __uint_as_float(rr[1])); }
struct SmState { float mx, cc, dd, rs; bool resc; float alpha; };
template <int MIX, bool FAST, int W>
DI void sm_item(f32x16& s, SmState& st, float& m_run, float& l_run, bf16x8 (&pf)[2], const Ctx& cx, const LAS unsigned char* pkp, const LAS unsigned char* lds, int k0, int kmax, int kmin, int hi, bool lv) {
    constexpr bool BIAS = (MIX != MIX_D);
    if constexpr (W == 0 || W == 1) {
        constexpr int sg = W;
        if constexpr (FAST) {
            float a = fmaxf(fmaxf(s[sg * 8 + 0], s[sg * 8 + 1]), s[sg * 8 + 2]), b = fmaxf(fmaxf(s[sg * 8 + 3], s[sg * 8 + 4]), s[sg * 8 + 5]);
            a = fmaxf(fmaxf(a, s[sg * 8 + 6]), s[sg * 8 + 7]);
            st.mx = (W == 0) ? fmaxf(a, b) : fmaxf(st.mx, fmaxf(a, b));
            asm volatile("" : "+v"(st.mx));
        } else {
            i32x4 pk0 = (i32x4){0, 0, 0, 0}, pk1 = (i32x4){0, 0, 0, 0};
            if (BIAS) { const LAS i32x4* pp = (const LAS i32x4*)(pkp + (sg * 16 + hi * 8) * 4); pk0 = pp[0]; pk1 = pp[1]; }
            float mx = (W == 0) ? NEG : st.mx;
#pragma unroll
            for (int j = 0; j < 8; ++j) {
                const int i = sg * 8 + j, key = k0 + sg * 16 + hi * 8 + j;
                float tv = s[i] * cx.c;
                if (BIAS) { int rel = cx.pq - (j < 4 ? pk0[j & 3] : pk1[j & 3]); rel = rel < 0 ? 0 : (rel > 1023 ? 1023 : rel); tv += *(const LAS float*)(lds + TBL + rel * 4); }
                bool valid = key <= kmax;
                if (MIX == MIX_B) valid = valid && (key >= kmin);
                tv = valid ? tv : NEG;
                s[i] = tv; mx = fmaxf(mx, tv);
            }
            st.mx = mx;
        }
        if constexpr (W == 1) {
            float mx = hmax32(st.mx);
            if constexpr (FAST) mx = lv ? mx * cx.c + cx.cb : NEG;
            const bool need = mx > m_run + 8.0f;
            const float mn = need ? mx : m_run;
            st.alpha = ex2(m_run - mn); m_run = mn; l_run *= st.alpha;
            st.resc = (__ballot(need) != 0ull);
            st.cc = FAST ? (lv ? cx.c : 0.f) : 1.0f; st.dd = FAST ? (lv ? cx.cb - mn : NEG) : -mn; st.rs = 0.f;
            asm volatile("" : "+v"(st.alpha), "+v"(m_run), "+v"(l_run), "+v"(st.dd));
        }
    } else if constexpr (W >= 2 && W <= 5) {
        constexpr int e0 = (W - 2) * 4;
#pragma unroll
        for (int e = e0; e < e0 + 4; ++e) { float p = ex2(s[e] * st.cc + st.dd); asm volatile("" : "+v"(p)); s[e] = p; st.rs += p; }
        asm volatile("" : "+v"(st.rs));
        if constexpr (W == 5) l_run += st.rs;
    } else {
        constexpr int sg = W - 6;
        u32x4 w; w.x = cvtpk(s[sg * 8 + 0], s[sg * 8 + 1]); w.y = cvtpk(s[sg * 8 + 2], s[sg * 8 + 3]); w.z = cvtpk(s[sg * 8 + 4], s[sg * 8 + 5]); w.w = cvtpk(s[sg * 8 + 6], s[sg * 8 + 7]); asm volatile("" : "+v"(w)); pf[sg] = __builtin_bit_cast(bf16x8, w);
    }
}
template <int DQK, int DV, int MIX, bool FAST>
DI void tile_body(const LAS unsigned char* sb, const LAS unsigned char* lds, const bf16x8 (&qf)[DQK / 16], f32x16 (&o)[DV / 32], float& m_run, float& l_run, const Ctx& cx,
                  int k0, int kmax, int kmin, int pr, int xk, int xv, int r, int hi, bool lv) {
    constexpr int KCH = DQK / 8, NQ = DQK / 16, NP = DV / 16, KBUF = 64 * KCH * 16, VBUF = DV * 128;
    const LAS unsigned char* kb0 = sb + pr * (KCH * 16); const LAS unsigned char* kb1 = kb0 + 32 * (KCH * 16);
    const LAS unsigned char* vb = sb + KBUF + r * 128; const LAS unsigned char* pkp = sb + KBUF + VBUF;
    f32x16 s0, s1;
#pragma unroll
    for (int i = 0; i < 16; ++i) { s0[i] = 0.f; s1[i] = 0.f; }
    bf16x8 kf[NQ], kg[NQ], vf[2 * NP], pf0[2], pf1[2];
    SmState st0, st1;
#if defined(ATT_X_NOLDS)
#define ATT_KF(base, kk) (qf[(kk) % NQ])
#else
#define ATT_KF(base, kk) (*(const LAS bf16x8*)((base) + (((2 * (kk) + hi) ^ xk) << 4)))
#endif
#if defined(ATT_X_NOLDS)
#define ATT_VF(f) (qf[(f) % NQ])
#else
#define ATT_VF(f) (*(const LAS bf16x8*)(vb + (((f) % NP) >> 1) * 32 * 128 + (((((f) / NP) * 4 + ((f) & 1) * 2 + hi) ^ xv) << 4)))
#endif
#define ATT_PRE_K(W) do { _Pragma("unroll") for (int kk = ((W) * NQ) / 8; kk < (((W) + 1) * NQ) / 8; ++kk) { kg[kk] = ATT_KF(kb1, kk); if (ATT_X_LDS2) { bf16x8 dm_ = ATT_KF(kb1 + 16, kk); asm volatile("" :: "v"(dm_)); } } } while (0)
#define ATT_PRE_V(W) do { _Pragma("unroll") for (int f = ((W) * NP) / 8; f < (((W) + 1) * NP) / 8; ++f) { vf[f] = ATT_VF(f); if (ATT_X_LDS2) { bf16x8 dm_ = ATT_VF(f ^ 1); asm volatile("" :: "v"(dm_)); } } } while (0)
#pragma unroll
    for (int kk = 0; kk < NQ; ++kk) kf[kk] = ATT_KF(kb0, kk);
    ATT_SB();
#pragma unroll
    for (int kk = 0; kk < NQ; ++kk) s0 = __builtin_amdgcn_mfma_f32_32x32x16_bf16(kf[kk], qf[kk], s0, 0, 0, 0);
    ATT_PRE_K(0); ATT_PRE_K(1); if (ATT_PD > 2) ATT_PRE_K(2); if (ATT_PD > 3) ATT_PRE_K(3);
    ATT_SB();
#define ATT_STEP2(W) do { \
        ATT_PRIO(1); _Pragma("unroll") for (int kk = ((W) * NQ) / 8; kk < (((W) + 1) * NQ) / 8; ++kk) s1 = __builtin_amdgcn_mfma_f32_32x32x16_bf16(kg[kk], qf[kk], s1, 0, 0, 0); ATT_PRIO(0); \
        if ((W) + ATT_PD < 8) ATT_PRE_K((W) + ATT_PD); else ATT_PRE_V((W) + ATT_PD - 8); \
        ATT_SM(sm_item<MIX, FAST, W>(s0, st0, m_run, l_run, pf0, cx, pkp, lds, k0, kmax, kmin, hi, lv)); ATT_SB(); } while (0)
    ATT_STEP2(0); ATT_STEP2(1); ATT_STEP2(2); ATT_STEP2(3); ATT_STEP2(4); ATT_STEP2(5); ATT_STEP2(6); ATT_STEP2(7);
#undef ATT_STEP2
    if (st0.resc) {
#pragma unroll
        for (int d = 0; d < DV / 32; ++d)
#pragma unroll
            for (int i = 0; i < 16; ++i) o[d][i] *= st0.alpha;
    }
    ATT_SB();
#define ATT_STEP3(W) do { \
        ATT_PRIO(1); _Pragma("unroll") for (int f = ((W) * NP) / 8; f < (((W) + 1) * NP) / 8; ++f) o[f >> 1] = __builtin_amdgcn_mfma_f32_32x32x16_bf16(vf[f], pf0[f & 1], o[f >> 1], 0, 0, 0); ATT_PRIO(0); \
        ATT_PRE_V((W) + ATT_PD); \
        ATT_SM(sm_item<MIX, FAST, W>(s1, st1, m_run, l_run, pf1, cx, pkp + 128, lds, k0 + 32, kmax, kmin, hi, lv)); ATT_SB(); } while (0)
    ATT_STEP3(0); ATT_STEP3(1); ATT_STEP3(2); ATT_STEP3(3); ATT_STEP3(4); ATT_STEP3(5); ATT_STEP3(6); ATT_STEP3(7);
#undef ATT_STEP3
    if (st1.resc) {
#pragma unroll
        for (int d = 0; d < DV / 32; ++d)
#pragma unroll
            for (int i = 0; i < 16; ++i) o[d][i] *= st1.alpha;
    }
    ATT_SB();
#define ATT_STEP4(W) do { \
        _Pragma("unroll") for (int f = ((W) * NP) / 8; f < (((W) + 1) * NP) / 8; ++f) o[(f - NP) >> 1] = __builtin_amdgcn_mfma_f32_32x32x16_bf16(vf[f], pf1[f & 1], o[(f - NP) >> 1], 0, 0, 0); \
        if ((W) + ATT_PD < 16) ATT_PRE_V((W) + ATT_PD); ATT_SB(); } while (0)
    ATT_STEP4(8); ATT_STEP4(9); ATT_STEP4(10); ATT_STEP4(11); ATT_STEP4(12); ATT_STEP4(13); ATT_STEP4(14); ATT_STEP4(15);
#undef ATT_STEP4
#undef ATT_KF
#undef ATT_VF
#undef ATT_PRE_K
#undef ATT_PRE_V
}
template <int DQK, int DV, int MIX>
DI void flash_pass(LAS unsigned char* lds, const bf16x8 (&qf)[DQK / 16], const bf16_t* __restrict__ Kg, int ldk, const bf16_t* __restrict__ VTg, int ldvt,
                   const int* __restrict__ pos, int t0, int t1, int q0, int qpmin, const Ctx& cx, f32x16 (&o)[DV / 32], float& m_run, float& l_run, int ts_force = -1) {
    constexpr int KCH = DQK / 8, NKL = KCH / 8, NVL = DV / 64;
    constexpr bool BIAS = (MIX != MIX_D);
    constexpr int KBUF = 64 * KCH * 16, VBUF = DV * 128, PBUF = BIAS ? 2048 : 0, SLOT = KBUF + VBUF + PBUF, NV = NKL + NVL + (BIAS ? 1 : 0);
    static_assert(3 * SLOT <= TPMO, "attention ring");
    static_assert(DQK % 128 == 0 || DQK == 64 || DQK == 192, "QK MFMAs per softmax work item");
    int tid = threadIdx.x; asm volatile("" : "+v"(tid));
    const int lane = tid & 63, r = lane & 31, hi = lane >> 5, wave = __builtin_amdgcn_readfirstlane(tid >> 6);
    const int pr = (r & 0x13) | ((r & 4) << 1) | ((r & 8) >> 1);
    const int xk = (KCH == 16) ? (((pr & 1) << 3) | ((pr >> 1) & 7)) : ((pr >> 1) & 7);
    const int xv = (r >> 1) & 7;
    unsigned koff[NKL], voff[NVL];
#pragma unroll
    for (int i = 0; i < NKL; ++i) { const int p = (i * 8 + wave) * 64 + lane, row = p / KCH, cs = p % KCH; const int x = (KCH == 16) ? (((row & 1) << 3) | ((row >> 1) & 7)) : ((row >> 1) & 7); koff[i] = (unsigned)(row * ldk + (cs ^ x) * 8) * 2u; }
#pragma unroll
    for (int i = 0; i < NVL; ++i) { const int p = (i * 8 + wave) * 64 + lane, row = p >> 3, cs = p & 7; voff[i] = (unsigned)(row * ldvt + (cs ^ ((row >> 1) & 7)) * 8) * 2u; }
#define ATT_ISSUE(t, sl) do { LAS unsigned char* sb_ = lds + (sl) * SLOT; \
    _Pragma("unroll") for (int i_ = 0; i_ < NKL; ++i_) __builtin_amdgcn_global_load_lds((const unsigned*)((const char*)Kg + (size_t)(t) * 64 * ldk * 2 + koff[i_]), (LAS unsigned*)(sb_ + (i_ * 8 + wave) * 1024), 16, 0, 0); \
    _Pragma("unroll") for (int i_ = 0; i_ < NVL; ++i_) __builtin_amdgcn_global_load_lds((const unsigned*)((const char*)VTg + (size_t)(t) * 128 + voff[i_]), (LAS unsigned*)(sb_ + KBUF + (i_ * 8 + wave) * 1024), 16, 0, 0); \
    if (BIAS) __builtin_amdgcn_global_load_lds((const unsigned*)(pos + (t) * 64 + lane), (LAS unsigned*)(sb_ + KBUF + VBUF + wave * 256), 4, 0, 0); } while (0)
#ifndef ATT_X_DMA2
#define ATT_X_DMA2 0
#endif
#if ATT_X_DMA2
#define ATT_ISSUE2(t, sl) do { ATT_ISSUE(t, sl); ATT_ISSUE(t, sl); } while (0)
#else
#define ATT_ISSUE2(t, sl) ATT_ISSUE(t, sl)
#endif
#if defined(ATT_X_NODMA)
#define ATT_ISSUE_LOOP(t, sl) do { (void)(sl); } while (0)
#define ATT_NEXT_SLOT(sl) ((sl) ^ 1)
#else
#define ATT_ISSUE_LOOP(t, sl) ATT_ISSUE2(t, sl)
#define ATT_NEXT_SLOT(sl) (((sl) == 2) ? 0 : (sl) + 1)
#endif
#define ATT_WAITBAR(N) asm volatile("s_waitcnt vmcnt(%0) lgkmcnt(0)\n\ts_barrier" :: "n"(N) : "memory")
    int ts = t0;
    if (ts_force >= 0) ts = ts_force;
    else if (MIX != MIX_B) { const int tlim = (q0 >> 6) < t1 ? (q0 >> 6) : t1;
        if (!BIAS) ts = tlim > t0 ? tlim : t0;
        else {
            ts = tlim > t0 ? tlim : t0;
            for (int base = t0; base < tlim; base += 64) { const int idx = base + lane; const bool stop = (idx >= tlim) || (qpmin - *(const LAS int*)(lds + TPMO + (idx < 256 ? idx : 255) * 4) < 790);
                const unsigned long long mk = __ballot(stop); if (mk != 0ull) { const int f = base + (int)__builtin_ctzll(mk); ts = f < tlim ? f : tlim; break; } } } }
    ATT_ISSUE2(t0, 0);
    if (t0 + 1 < t1) ATT_ISSUE2(t0 + 1, 1);
    int sl = 0;
#define ATT_TILES(TA, TB, FASTV) \
    for (int t = (TA); t < (TB); ++t) { \
        if (t + 1 < t1) ATT_WAITBAR(NV * (ATT_X_DMA2 ? 2 : 1)); else ATT_WAITBAR(0);            \
        if (t + 2 < t1) { const int s2 = (sl >= 1) ? sl - 1 : 2; ATT_ISSUE_LOOP(t + 2, s2); } \
        const LAS unsigned char* sb = lds + sl * SLOT; \
        int kmax, kmin = 0; \
        kmax = cx.qi; \
        if (MIX == MIX_B) kmin = cx.qi - 127; \
        const int k0 = t * 64; \
        const bool lv = (kmax >= k0) && (kmin <= k0 + 63); \
        if (__ballot(lv) != 0ull) tile_body<DQK, DV, MIX, FASTV>(sb, lds, qf, o, m_run, l_run, cx, k0, kmax, kmin, pr, xk, xv, r, hi, lv); \
        sl = ATT_NEXT_SLOT(sl); \
    }
    ATT_TILES(t0, ts, true)
    ATT_TILES(ts, t1, false)
#undef ATT_TILES
    asm volatile("s_waitcnt lgkmcnt(0)\n\ts_barrier" ::: "memory");
#undef ATT_ISSUE
#undef ATT_WAITBAR
}
DI int fast_split(const LAS unsigned char* lds, int t0, int t1, int q0, int qpmin, int lane) {
    const int tlim = (q0 >> 6) < t1 ? (q0 >> 6) : t1;
    int ts = tlim > t0 ? tlim : t0;
    for (int base = t0; base < tlim; base += 64) { const int idx = base + lane; const bool stop = (idx >= tlim) || (qpmin - *(const LAS int*)(lds + TPMO + (idx < 256 ? idx : 255) * 4) < 790);
        const unsigned long long mk = __ballot(stop); if (mk != 0ull) { const int f = base + (int)__builtin_ctzll(mk); ts = f < tlim ? f : tlim; break; } }
    return ts;
}
template <int DQK, int DV, int MIX>
DI void flash_pass_cp(LAS unsigned char* lds, const bf16x8 (&qf)[DQK / 16], const bf16_t* __restrict__ Kg, int ldk, const bf16_t* __restrict__ VTg, int ldvt,
                      int t0, int ts, const Ctx& cx, f32x16 (&o)[DV / 32], float& m_run, float& l_run) {
    constexpr int KCH = DQK / 8, NKL = KCH / 8, NVL = DV / 64, NQ = DQK / 16, NP = DV / 16;
    constexpr int KBUF = 64 * KCH * 16, VBUF = DV * 128;
    static_assert(3 * (KBUF + VBUF) <= TPMO, "attention rings");
    int tid = threadIdx.x; asm volatile("" : "+v"(tid));
    const int lane = tid & 63, r = lane & 31, hi = lane >> 5, wave = __builtin_amdgcn_readfirstlane(tid >> 6);
    const int pr = (r & 0x13) | ((r & 4) << 1) | ((r & 8) >> 1);
    const int xk = (KCH == 16) ? (((pr & 1) << 3) | ((pr >> 1) & 7)) : ((pr >> 1) & 7);
    const int xv = (r >> 1) & 7;
    unsigned koff[NKL], voff[NVL];
#pragma unroll
    for (int i = 0; i < NKL; ++i) { const int p = (i * 8 + wave) * 64 + lane, row = p / KCH, cs = p % KCH; const int x = (KCH == 16) ? (((row & 1) << 3) | ((row >> 1) & 7)) : ((row >> 1) & 7); koff[i] = (unsigned)(row * ldk + (cs ^ x) * 8) * 2u; }
#pragma unroll
    for (int i = 0; i < NVL; ++i) { const int p = (i * 8 + wave) * 64 + lane, row = p >> 3, cs = p & 7; voff[i] = (unsigned)(row * ldvt + (cs ^ ((row >> 1) & 7)) * 8) * 2u; }
#define CP_ISSUE_K(t, sl) do { _Pragma("unroll") for (int i_ = 0; i_ < NKL; ++i_) __builtin_amdgcn_global_load_lds((const unsigned*)((const char*)Kg + (size_t)(t) * 64 * ldk * 2 + koff[i_]), (LAS unsigned*)(lds + (sl) * KBUF + (i_ * 8 + wave) * 1024), 16, 0, 0); } while (0)
#define CP_ISSUE_V(t, sl) do { _Pragma("unroll") for (int i_ = 0; i_ < NVL; ++i_) __builtin_amdgcn_global_load_lds((const unsigned*)((const char*)VTg + (size_t)(t) * 128 + voff[i_]), (LAS unsigned*)(lds + 3 * KBUF + (sl) * VBUF + (i_ * 8 + wave) * 1024), 16, 0, 0); } while (0)
#define CP_KF(base, kk) (*(const LAS bf16x8*)((base) + (((2 * (kk) + hi) ^ xk) << 4)))
#define CP_VF(base, hf, j) (*(const LAS bf16x8*)((base) + ((j) >> 1) * 32 * 128 + (((((hf) * 4 + ((j) & 1) * 2 + hi) ^ xv)) << 4)))
    const int n = ts - t0;
    CP_ISSUE_K(t0, 0); CP_ISSUE_V(t0, 0);
    if (n > 1) CP_ISSUE_K(t0 + 1, 1);
    asm volatile("s_waitcnt vmcnt(0) lgkmcnt(0)\n\ts_barrier" ::: "memory");
    const LAS unsigned char* kl = lds + pr * (KCH * 16);
    const LAS unsigned char* vl = lds + 3 * KBUF + r * 128;
    f32x16 sc, sn;
    bf16x8 kfr[NQ], vfr[NP], pp[2], pc[2];
    SmState st;
#pragma unroll
    for (int i = 0; i < 16; ++i) sc[i] = 0.f;
#pragma unroll
    for (int kk = 0; kk < NQ; ++kk) kfr[kk] = CP_KF(kl, kk);
    ATT_SB();
#pragma unroll
    for (int kk = 0; kk < NQ; ++kk) sc = __builtin_amdgcn_mfma_f32_32x32x16_bf16(kfr[kk], qf[kk], sc, 0, 0, 0);
#define CP_PRE(W, KB, HFK_UNUSED, VB, HFV, DOK, DOV) do { \
        if (DOK) { _Pragma("unroll") for (int kk = ((W) * NQ) / 8; kk < (((W) + 1) * NQ) / 8; ++kk) kfr[kk] = CP_KF(KB, kk); } \
        if (DOV) { _Pragma("unroll") for (int j = ((W) * NP) / 8; j < (((W) + 1) * NP) / 8; ++j) vfr[j] = CP_VF(VB, HFV, j); } } while (0)
#define CP_ITEM(W, DOK, DOV, KB, VB, HFV, KBN, VBN, HFVN) do { \
        ATT_PRIO(1); \
        if (DOK) { _Pragma("unroll") for (int kk = ((W) * NQ) / 8; kk < (((W) + 1) * NQ) / 8; ++kk) sn = __builtin_amdgcn_mfma_f32_32x32x16_bf16(kfr[kk], qf[kk], sn, 0, 0, 0); } \
        if (DOV) { _Pragma("unroll") for (int j = ((W) * NP) / 8; j < (((W) + 1) * NP) / 8; ++j) o[j >> 1] = __builtin_amdgcn_mfma_f32_32x32x16_bf16(vfr[j], pp[j & 1], o[j >> 1], 0, 0, 0); } \
        ATT_PRIO(0); \
        if ((W) + 2 < 8) CP_PRE((W) + 2, KB, 0, VB, HFV, DOK, DOV); else CP_PRE((W) - 6, KBN, 0, VBN, HFVN, true, true); \
        sm_item<MIX, true, W>(sc, st, m_run, l_run, pc, cx, lds, lds, 0, 0, 0, hi, true); ATT_SB(); } while (0)
#define CP_STEP(DOK, DOV, KB, VB, HFV, KBN, VBN, HFVN) do { \
        _Pragma("unroll") for (int i = 0; i < 16; ++i) sn[i] = 0.f; \
        CP_ITEM(0, DOK, DOV, KB, VB, HFV, KBN, VBN, HFVN); CP_ITEM(1, DOK, DOV, KB, VB, HFV, KBN, VBN, HFVN); CP_ITEM(2, DOK, DOV, KB, VB, HFV, KBN, VBN, HFVN); CP_ITEM(3, DOK, DOV, KB, VB, HFV, KBN, VBN, HFVN); \
        CP_ITEM(4, DOK, DOV, KB, VB, HFV, KBN, VBN, HFVN); CP_ITEM(5, DOK, DOV, KB, VB, HFV, KBN, VBN, HFVN); CP_ITEM(6, DOK, DOV, KB, VB, HFV, KBN, VBN, HFVN); CP_ITEM(7, DOK, DOV, KB, VB, HFV, KBN, VBN, HFVN); \
        if (st.resc) { _Pragma("unroll") for (int d = 0; d < DV / 32; ++d) _Pragma("unroll") for (int i = 0; i < 16; ++i) o[d][i] *= st.alpha; } \
        pp[0] = pc[0]; pp[1] = pc[1]; sc = sn; ATT_SB(); } while (0)
    int ks = 0, vs = 0;
    for (int i = 0; i < n; ++i) {
        const int t = t0 + i;
        const int ks1 = (ks == 2) ? 0 : ks + 1, ks2 = (ks == 0) ? 2 : ks - 1, vs1 = (vs == 2) ? 0 : vs + 1, vsp = (vs == 0) ? 2 : vs - 1;
        if (i > 0) asm volatile("s_waitcnt vmcnt(0) lgkmcnt(0)\n\ts_barrier" ::: "memory");
        if (t + 2 < ts) CP_ISSUE_K(t + 2, ks2);
        if (t + 1 < ts) CP_ISSUE_V(t + 1, vs1);
        const LAS unsigned char* kA = kl + ks * KBUF + 32 * (KCH * 16); const LAS unsigned char* kB = kl + ks1 * KBUF; const LAS unsigned char* kAn = kl + ks1 * KBUF + 32 * (KCH * 16);
        const LAS unsigned char* vP = vl + vsp * VBUF; const LAS unsigned char* vC = vl + vs * VBUF;
        if (i == 0) {
            CP_PRE(0, kA, 0, vP, 1, true, false); CP_PRE(1, kA, 0, vP, 1, true, false);
            CP_STEP(true, false, kA, vP, 1, kB, vC, 0);
        } else {
            CP_STEP(true, true, kA, vP, 1, kB, vC, 0);
        }
        CP_STEP(true, true, kB, vC, 0, kAn, vC, 1);
        ks = ks1; vs = vs1;
    }
    {
        const int vsp = (vs == 0) ? 2 : vs - 1; const LAS unsigned char* vP = vl + vsp * VBUF;
#pragma unroll
        for (int j = (2 * NP) / 8; j < NP; ++j) vfr[j] = CP_VF(vP, 1, j);
        ATT_SB();
#pragma unroll
        for (int j = 0; j < NP; ++j) o[j >> 1] = __builtin_amdgcn_mfma_f32_32x32x16_bf16(vfr[j], pp[j & 1], o[j >> 1], 0, 0, 0);
    }
    asm volatile("s_waitcnt lgkmcnt(0)\n\ts_barrier" ::: "memory");
#undef CP_ISSUE_K
#undef CP_ISSUE_V
#undef CP_KF
#undef CP_VF
#undef CP_PRE
#undef CP_ITEM
#undef CP_STEP
}
template <int DV> DI void store_o(const f32x16 (&o)[DV / 32], float scale, bf16_t* orow, int hi) {
#pragma unroll
    for (int d = 0; d < DV / 32; ++d)
#pragma unroll
        for (int a = 0; a < 4; ++a) { u32x2 w; w.x = cvtpk(o[d][4 * a] * scale, o[d][4 * a + 1] * scale); w.y = cvtpk(o[d][4 * a + 2] * scale, o[d][4 * a + 3] * scale); *(u32x2*)(orow + d * 32 + 8 * a + 4 * hi) = w; }
}

DI int wg_min_pos(const Frame& F, int pq) {
#pragma unroll
    for (int o = 1; o < 64; o <<= 1) { const int other = __shfl_xor(pq, o); pq = other < pq ? other : pq; }
    if (F.tid == 0) F.MISC[5] = 0x7fffffffu;
    __syncthreads();
    if (F.lane == 0) atomicMin((int*)&F.MISC[5], pq);
    __syncthreads();
    const int v = (int)F.MISC[5];
    __syncthreads();
    return v;
}
DI void unit_D(const Frame& F, const Args& a, int h, int qt) {
    int lane = F.lane; asm volatile("" : "+v"(lane));
    const int r = lane & 31, hi = lane >> 5, qi = qt * 256 + F.wave * 32 + r;
    const bf16_t* QD = wsb(F, WS_QD) + (size_t)qi * 768 + h * 192 + hi * 8;
    bf16x8 qf[12];
#pragma unroll
    for (int kk = 0; kk < 12; ++kk) qf[kk] = *(const bf16x8*)(QD + kk * 16);
    f32x16 o[4];
#pragma unroll
    for (int d = 0; d < 4; ++d)
#pragma unroll
        for (int i = 0; i < 16; ++i) o[d][i] = 0.f;
    float m = NEG, l = 0.f;
    Ctx cx; cx.qi = qi; cx.pq = 0; cx.own = 0; cx.sel = 0ull; cx.cb = 0.f; cx.c = 0.07216878364870322f * LOG2E;
    const int ts = qt * 4;
    if (ATT_CP_D && ts > 0) flash_pass_cp<192, 128, MIX_D>(F.lds, qf, wsb(F, WS_KD) + h * 192, 768, wsb(F, WS_VDT) + (size_t)(h * 128) * S, S, 0, ts, cx, o, m, l);
    flash_pass<192, 128, MIX_D>(F.lds, qf, wsb(F, WS_KD) + h * 192, 768, wsb(F, WS_VDT) + (size_t)(h * 128) * S, S, (const int*)a.in[1], ATT_CP_D ? ts : 0, (qt + 1) * 4, qt * 256, 0, cx, o, m, l, ATT_CP_D ? ts : -1);
    l += xhalf(l);
    int lane2 = F.lane; asm volatile("" : "+v"(lane2));
    const int hi2 = lane2 >> 5, qi2 = qt * 256 + F.wave * 32 + (lane2 & 31);
    store_o<128>(o, 1.0f / l, wsb(F, WS_O) + (size_t)3 * S * 512 + (size_t)qi2 * 512 + h * 128, hi2);
}
DI void unit_C(const Frame& F, const Args& a, int h, int qt, int mp) {
    int lane = F.lane; asm volatile("" : "+v"(lane));
    const int r = lane & 31, hi = lane >> 5, qi = qt * 256 + F.wave * 32 + r;
    const int* pos = (const int*)a.in[1];
    build_tbl(F.lds, a.in[2], 12 + h, (const int*)(F.ws + WS_TPMAX));
    Ctx cx; cx.qi = qi; cx.pq = pos[qi]; cx.own = 0; cx.sel = 0ull; cx.c = 0.125f * LOG2E; cx.cb = a.in[2][31 * 16 + 12 + h] * LOG2E;
    const int qpmin = wg_min_pos(F, cx.pq);
    const bf16_t* H = wsb(F, WS_H);
    const bf16_t* Q = H + (size_t)qi * HW + H_CQ + h * 128 + mp * 64 + hi * 8;
    bf16x8 qf[4];
#pragma unroll
    for (int kk = 0; kk < 4; ++kk) qf[kk] = *(const bf16x8*)(Q + kk * 16);
    f32x16 o[4];
#pragma unroll
    for (int d = 0; d < 4; ++d)
#pragma unroll
        for (int i = 0; i < 16; ++i) o[d][i] = 0.f;
    float m = NEG, l = 0.f;
    const int ts = ATT_CP ? fast_split(F.lds, 0, (qt + 1) * 4, qt * 256, qpmin, lane) : 0;
    if (ATT_CP && ts > 0) flash_pass_cp<64, 128, MIX_C>(F.lds, qf, H + H_CK + h * 128 + mp * 64, HW, wsb(F, WS_VT) + (size_t)(VT_C + h * 128) * S, S, 0, ts, cx, o, m, l);
    flash_pass<64, 128, MIX_C>(F.lds, qf, H + H_CK + h * 128 + mp * 64, HW, wsb(F, WS_VT) + (size_t)(VT_C + h * 128) * S, S, pos, ATT_CP ? ts : 0, (qt + 1) * 4, qt * 256, qpmin, cx, o, m, l, ATT_CP ? ts : -1);
    l += xhalf(l);
    int lane2 = F.lane; asm volatile("" : "+v"(lane2));
    const int hi2 = lane2 >> 5, qi2 = qt * 256 + F.wave * 32 + (lane2 & 31);
    bf16_t* orow = (mp == 0 ? wsb(F, WS_O) + (size_t)2 * S * 512 : wsb(F, WS_OC2)) + (size_t)qi2 * 512 + h * 128;
    store_o<128>(o, 1.0f / l, orow, hi2);
}
DI void unit_B(const Frame& F, const Args& a, int layer, int hq, int qt) {
    const int lane = F.lane, r = lane & 31, hi = lane >> 5, qi = qt * 256 + F.wave * 32 + r, g = hq >> 2;
    const int* pos = (const int*)a.in[1];
    build_tbl(F.lds, a.in[2], 4 + hq, (const int*)(F.ws + WS_TPMAX));
    const bf16_t* H = wsb(F, WS_H);
    const bf16_t* Q = H + (size_t)qi * HW + H_BQ + hq * 64 + hi * 8;
    bf16x8 qf[4];
#pragma unroll
    for (int kk = 0; kk < 4; ++kk) qf[kk] = *(const bf16x8*)(Q + kk * 16);
    f32x16 o[2];
#pragma unroll
    for (int d = 0; d < 2; ++d)
#pragma unroll
        for (int i = 0; i < 16; ++i) o[d][i] = 0.f;
    float m = NEG, l = 0.f;
    Ctx cx; cx.qi = qi; cx.pq = pos[qi]; cx.own = 0; cx.sel = 0ull; cx.c = 0.125f * LOG2E; cx.cb = a.in[2][31 * 16 + 4 + hq] * LOG2E;
    const int t0 = (qt * 4 - 2) < 0 ? 0 : (qt * 4 - 2);
    flash_pass<64, 64, MIX_B>(F.lds, qf, H + H_BK + g * 64, HW, wsb(F, WS_VT) + (size_t)(VT_B + g * 64) * S, S, pos, t0, (qt + 1) * 4, qt * 256, 0, cx, o, m, l);
    l += xhalf(l);
    l += ex2(a.in[8][layer * 8 + hq] * LOG2E - m);
    store_o<64>(o, 1.0f / l, wsb(F, WS_O) + (size_t)1 * S * 512 + (size_t)qi * 512 + hq * 64, hi);
}
DI void store_part(const f32x16 (&o)[4], float m, float l, unsigned char* prow, int hi) {
    l += xhalf(l);
    store_o<128>(o, 1.0f / l, (bf16_t*)prow, hi);
    if (hi == 0) *(f32x2*)(prow + 256) = (f32x2){m, l};
}
DI void unit_A_own(const Frame& F, const Args& a, int h, int qt) {
    const int lane = F.lane, r = lane & 31, hi = lane >> 5, qi = qt * 256 + F.wave * 32 + r;
    const int* pos = (const int*)a.in[1];
    build_tbl(F.lds, a.in[2], h, (const int*)(F.ws + WS_TPMAX));
    const bf16_t* H = wsb(F, WS_H);
    const bf16_t* Q = H + (size_t)qi * HW + H_AQ + h * 128 + hi * 8;
    bf16x8 qf[8];
#pragma unroll
    for (int kk = 0; kk < 8; ++kk) qf[kk] = *(const bf16x8*)(Q + kk * 16);
    f32x16 o[4];
#pragma unroll
    for (int d = 0; d < 4; ++d)
#pragma unroll
        for (int i = 0; i < 16; ++i) o[d][i] = 0.f;
    float m = NEG, l = 0.f;
    Ctx cx; cx.qi = qi; cx.pq = pos[qi]; cx.own = qt; cx.sel = 0ull; cx.c = 0.08838834764831845f * LOG2E; cx.cb = a.in[2][31 * 16 + h] * LOG2E;
    flash_pass<128, 128, MIX_C>(F.lds, qf, H + H_AK + h * 128, HW, wsb(F, WS_VT) + (size_t)(VT_A + h * 128) * S, S, pos, qt * 4, (qt + 1) * 4, 0, 0, cx, o, m, l);
    store_part(o, m, l, F.ws + WS_PART + ((size_t)qi * 16 + h * 4 + 3) * 272, hi);
}
DI void unit_A_gather(const Frame& F, const Args& a, int h, int n, int near, int chunk, int count) {
    const int lane = F.lane, r = lane & 31, hi = lane >> 5;
    const int* pos = (const int*)a.in[1];
    if (near) build_tbl(F.lds, a.in[2], h, (const int*)(F.ws + WS_TPMAX));
    const int* list = (const int*)(F.ws + WS_MLIST) + (size_t)(h * 64 + n) * MCAP + (near ? MCAP_F : 0);
    const int idx = chunk * 256 + F.wave * 32 + r; const bool live = idx < count;
    const int e = list[live ? idx : chunk * 256];
    const int qi = e >> 2, slot = e & 3;
    const bf16_t* H = wsb(F, WS_H);
    const bf16_t* Q = H + (size_t)qi * HW + H_AQ + h * 128 + hi * 8;
    bf16x8 qf[8];
#pragma unroll
    for (int kk = 0; kk < 8; ++kk) qf[kk] = *(const bf16x8*)(Q + kk * 16);
    f32x16 o[4];
#pragma unroll
    for (int d = 0; d < 4; ++d)
#pragma unroll
        for (int i = 0; i < 16; ++i) o[d][i] = 0.f;
    float m = NEG, l = 0.f;
    Ctx cx; cx.qi = 0x7fffffff; cx.pq = pos[qi]; cx.own = 0; cx.sel = 0ull; cx.c = 0.08838834764831845f * LOG2E; cx.cb = a.in[2][31 * 16 + h] * LOG2E;
    flash_pass<128, 128, MIX_C>(F.lds, qf, H + H_AK + h * 128, HW, wsb(F, WS_VT) + (size_t)(VT_A + h * 128) * S, S, pos, n * 4, (n + 1) * 4, 0, 0, cx, o, m, l, near ? n * 4 : (n + 1) * 4);
    if (live) store_part(o, m, l, F.ws + WS_PART + ((size_t)qi * 16 + h * 4 + slot) * 272, hi);
    else { l += xhalf(l); }
}
}

DI int next_unit(const Frame& F, unsigned* head) {
    if (F.tid == 0) F.MISC[4] = __hip_atomic_fetch_add(head, 1u, __ATOMIC_RELAXED, __HIP_MEMORY_SCOPE_AGENT);
    __syncthreads();
    const int u = (int)F.MISC[4];
    __syncthreads();
    return u;
}
DI void convert_chunk(const Frame& F, const Args& a, int layer, int c) {
    const bool isv = c >= 256; const int row0 = (c & 255) * 64 + F.wave * 8;
    const float* src = (isv ? a.in[23] : a.in[22]) + (size_t)layer * 16384 * DM + (size_t)row0 * DM;
    unsigned char* dst = F.ws + WS_UB + (size_t)row0 * 2048 + (isv ? 1024 : 0);
    const float scale = isv ? V_SCALE : U_SCALE;
    int lane = F.lane; asm volatile("" : "+v"(lane));
    for (int j = 0; j < 8; ++j) {
        const float* p = src + (size_t)j * DM + 4 * lane; unsigned char* q = dst + (size_t)j * 2048 + 2 * lane;
        f32x4 x[8];
#pragma unroll
        for (int k = 0; k < 8; ++k) x[k] = *(const f32x4*)(p + 256 * k);
#pragma unroll
        for (int k = 0; k < 8; ++k) { unsigned d = 0u; const f32x4 y = x[k] * scale;
            d = __builtin_amdgcn_cvt_scalef32_pk_fp4_f32(d, y[0], y[1], 1.0f, 0); d = __builtin_amdgcn_cvt_scalef32_pk_fp4_f32(d, y[2], y[3], 1.0f, 1);
            *(unsigned short*)(q + 128 * k) = (unsigned short)d; }
    }
}
template <int PART> DI void phase_attention(const Frame& F, const Args& a, int layer, int rep = 0) {
    unsigned* q = (unsigned*)(F.ws + WS_CTL) + CW_Q + layer * 256 + rep * 512;
    if constexpr (PART == 0) {
#if !defined(NO_D) && !defined(NO_C)
    for (;;) { const int u = next_unit(F, q + 0); if (u >= 768) break;
        const int qt = 63 - u / 12, k = u % 12;
        if (k < 4) att::unit_D(F, a, k, qt);
        else att::unit_C(F, a, (k - 4) >> 1, qt, (k - 4) & 1);
        if (ATT_CONV_INTERLEAVE) { const int c = next_unit(F, q + 32); if (c < 512) convert_chunk(F, a, layer, c); } }
    if (ATT_CONV_INTERLEAVE) for (;;) { const int c = next_unit(F, q + 32); if (c >= 512) break; convert_chunk(F, a, layer, c); }
#endif
    } else {
#ifndef NO_A
    {
        const unsigned* cnt = (const unsigned*)(F.ws + WS_CTL) + CW_MOBA + layer * 1024;
        LAS int* pre = (LAS int*)(F.lds + att::TBL - 4096);
        __syncthreads();
        if (F.tid == 0) { int acc = 0; for (int i = 0; i < 512; ++i) { pre[i] = acc; const unsigned c = cnt[i], cap = (i >= 256) ? (unsigned)(MCAP - MCAP_F) : (unsigned)MCAP_F; acc += (int)(((c < cap ? c : cap) + 255u) >> 8); } pre[512] = acc; }
        __syncthreads();
        const int ntot = 256 + pre[512];
        for (;;) { const int u = next_unit(F, q + 128); if (u >= ntot) break;
            if (u < 256) { att::unit_A_own(F, a, u & 3, 63 - (u >> 2)); continue; }
            const int g = u - 256; int lo_ = 0, hi_ = 511;
            while (lo_ < hi_) { const int mid = (lo_ + hi_ + 1) >> 1; if (pre[mid] <= g) lo_ = mid; else hi_ = mid - 1; }
            const unsigned c = cnt[lo_], cap = (lo_ >= 256) ? (unsigned)(MCAP - MCAP_F) : (unsigned)MCAP_F;
            att::unit_A_gather(F, a, (lo_ >> 6) & 3, lo_ & 63, lo_ >> 8, g - pre[lo_], (int)(c < cap ? c : cap)); }
    }
#endif
#ifndef NO_B
    for (;;) { const int u = next_unit(F, q + 192); if (u >= 512) break; att::unit_B(F, a, layer, u & 7, u >> 3); }
#endif
    }
}

DI void ins16(float (&v)[16], float x) {
#pragma unroll
    for (int k = 0; k < 16; ++k) { const float t = fmaxf(v[k], x); x = fminf(v[k], x); v[k] = t; }
}
DI float pack_idx(float s, int idx, unsigned mask) { return __uint_as_float((__float_as_uint(s) & ~mask) | (unsigned)idx); }
DI void peer_select_group(const Frame& F, const bf16_t* SK, int grp, LAS unsigned char* sel) {
    const bf16_t* QP = wsb(F, WS_H);
    int lane = F.lane; asm volatile("" : "+v"(lane));
    const int r = lane & 31, hi = lane >> 5;
    {
        const int h = F.wave, t = grp * 32 + r;
        float L[2][16];
#pragma unroll
        for (int m = 0; m < 2; ++m) {
            const bf16_t* qrow = QP + (size_t)t * DM + h * 256 + m * 128 + hi * 8;
            bf16x8 qf[8];
#pragma unroll
            for (int kk = 0; kk < 8; ++kk) qf[kk] = *(const bf16x8*)(qrow + kk * 16);
            const bf16_t* kb = SK + ((size_t)(h * 2 + m) * 128 + r) * 128 + hi * 8;
            float v[16];
#pragma unroll
            for (int k = 0; k < 16; ++k) v[k] = -3.0e38f;
#pragma unroll
            for (int rb = 0; rb < 4; ++rb) {
                f32x16 s;
#pragma unroll
                for (int i = 0; i < 16; ++i) s[i] = 0.f;
#pragma unroll
                for (int kk = 0; kk < 8; ++kk) { const bf16x8 kf = *(const bf16x8*)(kb + (size_t)rb * 32 * 128 + kk * 16); s = __builtin_amdgcn_mfma_f32_32x32x16_bf16(kf, qf[kk], s, 0, 0, 0); }
#pragma unroll
                for (int i = 0; i < 16; ++i) ins16(v, pack_idx(s[i], rb * 32 + (i & 3) + 8 * (i >> 2) + 4 * hi, 127u));
                asm volatile("" : "+v"(v[0]), "+v"(v[1]), "+v"(v[2]), "+v"(v[3]), "+v"(v[4]), "+v"(v[5]), "+v"(v[6]), "+v"(v[7]), "+v"(v[8]), "+v"(v[9]), "+v"(v[10]), "+v"(v[11]), "+v"(v[12]), "+v"(v[13]), "+v"(v[14]), "+v"(v[15]));
                asm volatile("" : "+v"(kb));
            }
            float ov[16];
#pragma unroll
            for (int k = 0; k < 16; ++k) ov[k] = xhalf(v[k]);
#pragma unroll
            for (int k = 0; k < 16; ++k) ins16(v, ov[k]);
#pragma unroll
            for (int k = 0; k < 16; ++k) L[m][k] = v[k];
        }
        int i0[16], i1[16];
#pragma unroll
        for (int k = 0; k < 16; ++k) { i0[k] = (int)(__float_as_uint(L[0][k]) & 127u); i1[k] = (int)(__float_as_uint(L[1][k]) & 127u); L[0][k] = __uint_as_float(__float_as_uint(L[0][k]) & ~127u); L[1][k] = __uint_as_float(__float_as_uint(L[1][k]) & ~127u); }
        float b[16];
#pragma unroll
        for (int k = 0; k < 16; ++k) b[k] = -3.0e38f;
#pragma unroll
        for (int i = 0; i < 16; ++i)
#pragma unroll
            for (int j = 0; j < 16; ++j) if ((i + 1) * (j + 1) <= 16) ins16(b, pack_idx(L[0][i] + L[1][j], i * 16 + j, 255u));
        float g[16]; int e[16]; float den = 0.f;
        const float b0 = __uint_as_float(__float_as_uint(b[0]) & ~255u);
#pragma unroll
        for (int k = 0; k < 16; ++k) {
            const unsigned bits = __float_as_uint(b[k]); const int ci = (int)((bits >> 4) & 15u), cj = (int)(bits & 15u);
            int e0 = i0[0], e1 = i1[0];
#pragma unroll
            for (int c = 1; c < 16; ++c) { e0 = (ci == c) ? i0[c] : e0; e1 = (cj == c) ? i1[c] : e1; }
            e[k] = e0 * 128 + e1;
            g[k] = ex2((__uint_as_float(bits & ~255u) - b0) * LOG2E); den += g[k];
        }
        const float inv = 1.0f / den;
        if (hi == 0) {
#pragma unroll
            for (int k = 0; k < 16; k += 4) *(LAS i32x4*)(sel + (r * 128 + h * 16 + k) * 4) = (i32x4){e[k], e[k + 1], e[k + 2], e[k + 3]};
        } else {
#pragma unroll
            for (int k = 0; k < 16; k += 4) *(LAS f32x4*)(sel + 16384 + (r * 128 + h * 16 + k) * 4) = (f32x4){g[k] * inv, g[k + 1] * inv, g[k + 2] * inv, g[k + 3] * inv};
        }
    }
}
DI float gelu_as(float v) {
    const float av = fabsf(v), t = __builtin_amdgcn_rcpf(av * 0.2316418882f + 1.0f);
    float q = t * 0.5307027145f + (-0.7265760135f); q = q * t + 0.7107068705f; q = q * t + (-0.142248368f); q = q * t + 0.127414796f; q = q * t;
    const float e = ex2((v * v) * (-0.72134752044f));
    const float m = v * (q * e);
    return v < 0.f ? m : v - m;
}
template <int CTRL, int RM> DI float dpp_add(float v) { return v + __builtin_bit_cast(float, __builtin_amdgcn_update_dpp(0, __builtin_bit_cast(int, v), CTRL, RM, 0xf, RM == 0xf)); }
DI float wave_total(float v) {
    v = dpp_add<0x111, 0xf>(v); v = dpp_add<0x112, 0xf>(v); v = dpp_add<0x114, 0xf>(v); v = dpp_add<0x118, 0xf>(v);
    v = dpp_add<0x142, 0xa>(v); v = dpp_add<0x143, 0xc>(v);
    return __uint_as_float(__builtin_amdgcn_readlane(__float_as_uint(v), 63));
}
DI void reduce4(float (&d)[4], int lane) {
#pragma unroll
    for (int i = 0; i < 4; ++i) d[i] = wave_total(d[i]);
}
DI void peer_gather_group(const Frame& F, const Args& a, int layer, float* outf, bf16_t* XB, int grp, const LAS unsigned char* sel) {
    typedef int v8i_t __attribute__((ext_vector_type(8)));
    const unsigned char* UB = F.ws + WS_UB;
    int lane = F.lane; asm volatile("" : "+v"(lane));
    const int m16 = lane & 15, g4 = lane >> 4;
    LAS unsigned char* x8 = F.lds + 65536 + F.wave * 2048;
    int sc = 0x7f7f7f7f; asm volatile("" : "+v"(sc));
    for (int ti = 0; ti < 4; ++ti) {
        const int tl = F.wave * 4 + ti, t = grp * 32 + tl;
        const bf16_t* xr = XB + (size_t)t * DM + 32 * lane;
        {
            u32x4 w8[2];
#pragma unroll
            for (int c = 0; c < 4; ++c) { const u32x4 w = *(const u32x4*)(xr + 8 * c);
#if PEER_X_SWAP
                int lo = __builtin_amdgcn_cvt_pk_fp8_f32(bf_hi(w.x), bf_lo(w.x), 0, false); lo = __builtin_amdgcn_cvt_pk_fp8_f32(bf_hi(w.y), bf_lo(w.y), lo, true);
                int hi = __builtin_amdgcn_cvt_pk_fp8_f32(bf_hi(w.z), bf_lo(w.z), 0, false); hi = __builtin_amdgcn_cvt_pk_fp8_f32(bf_hi(w.w), bf_lo(w.w), hi, true);
#else
                int lo = __builtin_amdgcn_cvt_pk_fp8_f32(bf_lo(w.x), bf_hi(w.x), 0, false); lo = __builtin_amdgcn_cvt_pk_fp8_f32(bf_lo(w.y), bf_hi(w.y), lo, true);
                int hi = __builtin_amdgcn_cvt_pk_fp8_f32(bf_lo(w.z), bf_hi(w.z), 0, false); hi = __builtin_amdgcn_cvt_pk_fp8_f32(bf_lo(w.w), bf_hi(w.w), hi, true);
#endif
                w8[c >> 1][(c & 1) * 2] = (unsigned)lo; w8[c >> 1][(c & 1) * 2 + 1] = (unsigned)hi; }
            *(LAS u32x4*)(x8 + 32 * lane) = w8[0]; *(LAS u32x4*)(x8 + 32 * lane + 16) = w8[1];
        }
        f32x2 acc[16];
#pragma unroll
        for (int e = 0; e < 16; ++e) acc[e] = (f32x2){0.f, 0.f};
        for (int half = 0; half < 2; ++half) {
            const int ev = *(const LAS int*)(sel + (tl * 128 + half * 64 + lane) * 4); const float gv = *(const LAS float*)(sel + 16384 + (tl * 128 + half * 64 + lane) * 4);
            for (int bb = 0; bb < 4; ++bb) {
                const int em = __builtin_amdgcn_ds_bpermute((16 * bb + m16) << 2, ev);
                const unsigned char* up = UB + (size_t)em * 2048 + 16 * g4;
                u32x4 ua[16], va[16];
#pragma unroll
                for (int s = 0; s < 16; ++s) ua[s] = *(const u32x4*)(up + 64 * s);
#pragma unroll
                for (int j = 0; j < 16; ++j) { const int e = __builtin_amdgcn_readlane(ev, 16 * bb + j); va[j] = *(const u32x4*)(UB + (size_t)e * 2048 + 1024 + 16 * lane); }
                f32x4 h = (f32x4){0.f, 0.f, 0.f, 0.f};
#pragma unroll
                for (int s = 0; s < 16; ++s) {
                    const u32x4 x0 = *(const LAS u32x4*)(x8 + 128 * s + 16 * g4), x1 = *(const LAS u32x4*)(x8 + 128 * s + 64 + 16 * g4);
                    const v8i_t xb = (v8i_t){(int)x0.x, (int)x0.y, (int)x0.z, (int)x0.w, (int)x1.x, (int)x1.y, (int)x1.z, (int)x1.w};
                    asm volatile("s_nop 1\n\tv_mfma_scale_f32_16x16x128_f8f6f4 %0, %1, %2, %0, %3, %3 op_sel_hi:[0,0,0] cbsz:4" : "+v"(h) : "v"(ua[s]), "v"(xb), "v"(sc));
                }
                asm volatile("s_nop 15" : "+v"(h));
                float hv[4];
#pragma unroll
                for (int i = 0; i < 4; ++i) { const float gq = __int_as_float(__builtin_amdgcn_ds_bpermute((16 * bb + 4 * g4 + i) << 2, __float_as_int(gv)));
                    hv[i] = gq * gelu_as(h[i] * (1.0f / U_SCALE)) * (1.0f / V_SCALE); }
#pragma unroll
                for (int j = 0; j < 16; ++j) {
                    const float wk = __uint_as_float(__builtin_amdgcn_readlane(__float_as_uint(hv[j & 3]), 16 * (j >> 2)));
                    const f32x2 wk2 = (f32x2){wk, wk}; const u32x4 w_ = va[j];
#define FP4_ACC(b) acc[b] += __builtin_amdgcn_cvt_scalef32_pk_f32_fp4(w_[(b) >> 2], 1.0f, (b) & 3) * wk2;
                    FP4_ACC(0) FP4_ACC(1) FP4_ACC(2) FP4_ACC(3) FP4_ACC(4) FP4_ACC(5) FP4_ACC(6) FP4_ACC(7) FP4_ACC(8) FP4_ACC(9) FP4_ACC(10) FP4_ACC(11) FP4_ACC(12) FP4_ACC(13) FP4_ACC(14) FP4_ACC(15)
#undef FP4_ACC
                }
            }
        }
        float z[1][32];
#pragma unroll
        for (int c = 0; c < 4; ++c) { const u32x4 w = *(const u32x4*)(xr + 8 * c);
            z[0][8 * c + 0] = acc[4 * c].x + DN_ALPHA * bf_lo(w.x); z[0][8 * c + 1] = acc[4 * c].y + DN_ALPHA * bf_hi(w.x); z[0][8 * c + 2] = acc[4 * c + 1].x + DN_ALPHA * bf_lo(w.y); z[0][8 * c + 3] = acc[4 * c + 1].y + DN_ALPHA * bf_hi(w.y);
            z[0][8 * c + 4] = acc[4 * c + 2].x + DN_ALPHA * bf_lo(w.z); z[0][8 * c + 5] = acc[4 * c + 2].y + DN_ALPHA * bf_hi(w.z); z[0][8 * c + 6] = acc[4 * c + 3].x + DN_ALPHA * bf_lo(w.w); z[0][8 * c + 7] = acc[4 * c + 3].y + DN_ALPHA * bf_hi(w.w); }
        ln_store<1, 32>(z, a.in[24] + layer * DM, a.in[25] + layer * DM, outf ? outf + (size_t)t * DM : (float*)nullptr, XB + (size_t)t * DM, lane, outf ? (unsigned char*)nullptr : F.ws + WS_XB8 + (size_t)t * DM, outf ? (unsigned char*)nullptr : F.ws + WS_XB4 + (size_t)t * (DM / 2));
    }
}
DI void phase_peer(const Frame& F, const Args& a, int layer, const bf16_t* SK, float* outf) {
    LAS unsigned char* sel = F.lds;
    bf16_t* XB = wsb(F, WS_XB);
    const int g0 = F.vcu, g1 = F.vcu + F.G, ng = S / 32;
    if (F.vcu & 1) {
        if (g0 < ng) peer_select_group(F, SK, g0, sel);
        if (g1 < ng) peer_select_group(F, SK, g1, sel + 32768);
        __syncthreads();
        if (g0 < ng) peer_gather_group(F, a, layer, outf, XB, g0, sel);
        if (g1 < ng) peer_gather_group(F, a, layer, outf, XB, g1, sel + 32768);
    } else {
        if (g0 < ng) peer_select_group(F, SK, g0, sel);
        __syncthreads();
        if (g0 < ng) peer_gather_group(F, a, layer, outf, XB, g0, sel);
        if (g1 < ng) peer_select_group(F, SK, g1, sel + 32768);
        __syncthreads();
        if (g1 < ng) peer_gather_group(F, a, layer, outf, XB, g1, sel + 32768);
    }
    for (int g = F.vcu + 2 * F.G; g < ng; g += F.G) { __syncthreads(); peer_select_group(F, SK, g, sel); __syncthreads(); peer_gather_group(F, a, layer, outf, XB, g, sel); }
}

#ifndef GEMM_SP2
#define GEMM_SP2 true
#endif
#ifndef GEMM_ALIGN_EPI
#define GEMM_ALIGN_EPI true
#endif
DI void run_merge_chain(const Frame& F, const unsigned char* O8a, const unsigned char* Wbr, const pg8::Epi<5>& E) {
    pg8::Gemm g{(const bf16_t*)O8a, (const bf16_t*)Wbr, S, DM, 256, 256, 256, 0, (long)S * 512, (long)DM * 512 * 2}; pg8::ChainOrder<4> So; So.init(S, DM, F.G, (int)blockIdx.x);
    pg8::gemm_phase<pg8::Epi<5>, pg8::ChainOrder<4>, GEMM_ALIGN_EPI, GEMM_SP2, true, 121, 124, false>(F.lds, g, So, E);
}
template <int MODE, bool F8 = false, int SC0 = 127, int SC1 = 127, bool F4 = false> DI void run_gemm(const Frame& F, const bf16_t* A, int lda, const bf16_t* Bt, int ldb, int M, int N, int K, long apn, const pg8::Epi<MODE>& E, int rot = 0) {
    pg8::Gemm g{A, Bt, M, N, K, lda, ldb, apn}; pg8::StaticOrder So; So.init(M, N, F.G, (F.G == 256) ? (int)((blockIdx.x + (unsigned)rot) & 255u) : (int)blockIdx.x);
    pg8::gemm_phase<pg8::Epi<MODE>, pg8::StaticOrder, GEMM_ALIGN_EPI, GEMM_SP2, F8, SC0, SC1, F4>(F.lds, g, So, E);
}
#ifndef MK_CHECK
#define MK_CHECK 0
#endif
#ifndef MK_CHECK_WORD
#define MK_CHECK_WORD 0
#endif

#if MK_CHECK
namespace chk {
constexpr int NS = 64;
__device__ const int SAMPLES[NS] = {0, 1, 2, 31, 32, 63, 64, 127, 128, 129, 255, 256, 257, 300, 383, 384, 511, 512, 513, 767, 768, 1000, 1023, 1024, 1025, 1279, 1280, 2047, 2048, 2049, 3071, 3072,
    4095, 4096, 5000, 6143, 6144, 7777, 8191, 8192, 8193, 9999, 10239, 10240, 11111, 12287, 12288, 12289, 13000, 13311, 13312, 14000, 14335, 14336, 15000, 15359, 15360, 15871, 16127, 16128, 16129, 16255, 16256, 16383};
DI float bsum(const Frame& F, float v) {
    v = wave_sum(v);
    __syncthreads();
    if (F.lane == 0) F.MISC[16 + F.wave] = __float_as_uint(v);
    __syncthreads();
    float s = 0.f;
    for (int w = 0; w < 8; ++w) s += __uint_as_float(F.MISC[16 + w]);
    return s;
}
DI float bmax(const Frame& F, float v) {
#pragma unroll
    for (int o = 1; o < 64; o <<= 1) v = fmaxf(v, __shfl_xor(v, o));
    __syncthreads();
    if (F.lane == 0) F.MISC[16 + F.wave] = __float_as_uint(v);
    __syncthreads();
    float s = -INFINITY;
    for (int w = 0; w < 8; ++w) s = fmaxf(s, __uint_as_float(F.MISC[16 + w]));
    return s;
}
DI void verdict(const Frame& F, float err, float nrm, float tol, int code) {
    const float e = bsum(F, err), n = bsum(F, nrm);
    if (F.tid == 0) { const bool bad = !(e <= tol * tol * n + 1e-12f); if (bad) { atomicAdd((unsigned*)(F.ws + WS_CTL) + CW_CHK, 1u); atomicAdd((unsigned*)(F.ws + WS_CTL) + CW_CHK + 64 * (1 + code), 1u); } }
}
DI float sigm(float z) { return 1.0f / (1.0f + expf(-z)); }
DI float rope_inv(int j) { return powf(10000.0f, -(float)j / 32.0f); }
DI float t5_naive(const float* t5, int col, int rel) {
    int n = rel > 0 ? rel : 0; int b;
    if (n < 16) b = n; else { b = 16 + (int)(logf((float)n / 16.0f) / logf(64.0f) * 16.0f); if (b > 31) b = 31; }
    return t5[b * 16 + col];
}
DI void s1(const Frame& F, const Args& a, int layer) {
    const bf16_t* X = wsb(F, WS_XB); const float* W = a.in[3] + (size_t)layer * DM * 4672;
    const bf16_t* H = wsb(F, WS_H); const bf16_t* VT = wsb(F, WS_VT);
    for (int u = F.vcu; u < NS; u += F.G) { const int t = SAMPLES[u]; float err = 0.f, nrm = 0.f;
        for (int c = F.tid; c < 4672; c += 512) { float ref = 0.f; for (int k = 0; k < DM; ++k) ref += bf1(X[(size_t)t * DM + k]) * W[(size_t)k * 4672 + c];
            const int d = win_map(c); const float got = d < HW ? bf1(H[(size_t)t * HW + d]) : bf1(VT[(size_t)(d - HW) * S + t]); err += (ref - got) * (ref - got); nrm += ref * ref; }
        verdict(F, err, nrm, 0.06f, 0); }
}
DI void s2(const Frame& F, const Args& a, int layer) {
    const bf16_t* H = wsb(F, WS_H); const int* pos = (const int*)a.in[1];
    for (int u = F.vcu; u < NS; u += F.G) { const int t = SAMPLES[u]; float err = 0.f, nrm = 0.f;
        float ssq = 0.f; for (int k = 0; k < 512; ++k) { const float v = bf1(H[(size_t)t * HW + H_DCQ + k]); ssq += v * v; }
        const float rq = 1.0f / sqrtf(ssq / 512.0f + 1e-6f);
        float ssk = 0.f; for (int k = 0; k < 256; ++k) { const float v = bf1(H[(size_t)t * HW + H_DCKV + k]); ssk += v * v; }
        const float rk = 1.0f / sqrtf(ssk / 256.0f + 1e-6f);
        for (int c = F.tid; c < 512; c += 512) { const float ref = bf1(H[(size_t)t * HW + H_DCQ + c]) * rq * a.in[14][layer * 512 + c]; const float got = bf1(wsb(F, WS_CQN)[(size_t)t * 512 + c]); err += (ref - got) * (ref - got); nrm += ref * ref; }
        for (int c = F.tid; c < 256; c += 512) { const float ref = bf1(H[(size_t)t * HW + H_DCKV + c]) * rk * a.in[15][layer * 256 + c]; const float got = bf1(wsb(F, WS_CKVN)[(size_t)t * 256 + c]); err += (ref - got) * (ref - got); nrm += ref * ref; }
        for (int c = F.tid; c < 256; c += 512) { const int h = c >> 6, j = c & 63, jj = j & 31; const float x1 = bf1(H[(size_t)t * HW + H_DKR + jj]), x2 = bf1(H[(size_t)t * HW + H_DKR + jj + 32]);
            const float ang = (float)pos[t] * rope_inv(jj); const float ref = j < 32 ? x1 * cosf(ang) - x2 * sinf(ang) : x1 * sinf(ang) + x2 * cosf(ang);
            const float got = bf1(wsb(F, WS_KD)[(size_t)t * 768 + h * 192 + 128 + j]); err += (ref - got) * (ref - got); nrm += ref * ref; }
        verdict(F, err, nrm, 0.02f, 1); }
}
DI void s3(const Frame& F, const Args& a, int layer) {
    const int* pos = (const int*)a.in[1]; const float* Wq = a.in[16] + (size_t)layer * 512 * 768; const float* Wkv = a.in[17] + (size_t)layer * 256 * 1024;
    LAS float* pre = (LAS float*)F.lds;
    for (int u = F.vcu; u < NS; u += F.G) { const int t = SAMPLES[u]; float err = 0.f, nrm = 0.f;
        __syncthreads();
        for (int n = F.tid; n < 768; n += 512) { float r = 0.f; for (int k = 0; k < 512; ++k) r += bf1(wsb(F, WS_CQN)[(size_t)t * 512 + k]) * Wq[(size_t)k * 768 + n]; pre[n] = r; }
        __syncthreads();
        for (int n = F.tid; n < 768; n += 512) { const int h = n / 192, j = n % 192; float ref = pre[n];
            if (j >= 128) { const int jj = (j - 128) & 31; const float x1 = pre[h * 192 + 128 + jj], x2 = pre[h * 192 + 128 + jj + 32]; const float ang = (float)pos[t] * rope_inv(jj);
                ref = (j - 128) < 32 ? x1 * cosf(ang) - x2 * sinf(ang) : x1 * sinf(ang) + x2 * cosf(ang); }
            const float got = bf1(wsb(F, WS_QD)[(size_t)t * 768 + n]); err += (ref - got) * (ref - got); nrm += ref * ref; }
        for (int n = F.tid; n < 1024; n += 512) { float ref = 0.f; for (int k = 0; k < 256; ++k) ref += bf1(wsb(F, WS_CKVN)[(size_t)t * 256 + k]) * Wkv[(size_t)k * 1024 + n];
            const int h = n >> 8, j = n & 255; const float got = j < 128 ? bf1(wsb(F, WS_KD)[(size_t)t * 768 + h * 192 + j]) : bf1(wsb(F, WS_VDT)[(size_t)(h * 128 + j - 128) * S + t]);
            err += (ref - got) * (ref - got); nrm += ref * ref; }
        verdict(F, err, nrm, 0.02f, 2); }
}
DI void s4(const Frame& F, const Args& a, int layer) {
    const int* pos = (const int*)a.in[1]; const float* t5 = a.in[2]; const bf16_t* H = wsb(F, WS_H);
    LAS float* lg = (LAS float*)F.lds;
    LAS float* qv = (LAS float*)(F.lds + 65536);
    LAS float* ga = (LAS float*)(F.lds + 65536 + 1024);
    LAS float* op = (LAS float*)(F.lds + 65536 + 2048);
    LAS float* o1 = (LAS float*)(F.lds + 65536 + 2048 + 2048);
    LAS int* selb = (LAS int*)(F.lds + 65536 + 8192);
    for (int u = F.vcu; u < NS * 20; u += F.G) {
        const int q = SAMPLES[u / 20], mh = u % 20;
        int mix, h; if (mh < 4) { mix = 0; h = mh; } else if (mh < 12) { mix = 1; h = mh - 4; } else if (mh < 16) { mix = 2; h = mh - 12; } else { mix = 3; h = mh - 16; }
        const int DQ = mix == 0 ? 128 : (mix == 3 ? 192 : 64), DVV = mix == 1 ? 64 : 128;
        const int nmaps = mix == 2 ? 2 : 1;
        const float scale = 1.0f / sqrtf((float)DQ);
        const int bcol = mix == 0 ? h : (mix == 1 ? 4 + h : 12 + h);
        float errs = 0.f, nrms = 0.f;
        for (int mp = 0; mp < nmaps; ++mp) {
            const bf16_t* Qp; const bf16_t* Kp; int ldk; const bf16_t* Vp;
            if (mix == 0) { Qp = H + (size_t)q * HW + H_AQ + h * 128; Kp = H + H_AK + h * 128; ldk = HW; Vp = wsb(F, WS_VT) + (size_t)(VT_A + h * 128) * S; }
            else if (mix == 1) { Qp = H + (size_t)q * HW + H_BQ + h * 64; Kp = H + H_BK + (h >> 2) * 64; ldk = HW; Vp = wsb(F, WS_VT) + (size_t)(VT_B + (h >> 2) * 64) * S; }
            else if (mix == 2) { Qp = H + (size_t)q * HW + H_CQ + h * 128 + mp * 64; Kp = H + H_CK + h * 128 + mp * 64; ldk = HW; Vp = wsb(F, WS_VT) + (size_t)(VT_C + h * 128) * S; }
            else { Qp = wsb(F, WS_QD) + (size_t)q * 768 + h * 192; Kp = wsb(F, WS_KD) + h * 192; ldk = 768; Vp = wsb(F, WS_VDT) + (size_t)(h * 128) * S; }
            __syncthreads();
            for (int d = F.tid; d < DQ; d += 512) qv[d] = bf1(Qp[d]);
            if (F.tid < 64) { ga[F.tid] = 0.f; selb[F.tid] = 0; }
            __syncthreads();
            const int own = q >> 8;
            if (mix == 0) {
                for (int idx = F.tid; idx < own * 128; idx += 512) { const int n = idx >> 7, d = idx & 127; float sm = 0.f; for (int i = 0; i < 256; ++i) sm += bf1(Kp[(size_t)(n * 256 + i) * ldk + d]); atomicAdd((float*)&ga[n], qv[d] * (sm / 256.0f)); }
                __syncthreads();
                if (F.tid == 0) { for (int rnk = 0; rnk < 3 && rnk < own; ++rnk) { int best = -1; float bv = -INFINITY; for (int n = 0; n < own; ++n) if (!selb[n] && ga[n] > bv) { bv = ga[n]; best = n; } if (best >= 0) selb[best] = 1; } }
                __syncthreads();
            }
            float mx = -INFINITY;
            for (int k = F.tid; k <= q; k += 512) {
                bool valid = true;
                if (mix == 0) { const int blk = k >> 8; valid = (blk == own) ? true : (selb[blk] != 0); }
                if (mix == 1) valid = (q - k) < 128;
                float l = -INFINITY;
                if (valid) { float dot = 0.f; for (int d = 0; d < DQ; ++d) dot += qv[d] * bf1(Kp[(size_t)k * ldk + d]); l = dot * scale; if (mix != 3) l += t5_naive(t5, bcol, pos[q] - pos[k]); }
                lg[k] = l; mx = fmaxf(mx, l);
            }
            mx = bmax(F, mx);
            const float sink = (mix == 1) ? a.in[8][layer * 8 + h] : -INFINITY;
            if (mix == 1) mx = fmaxf(mx, sink);
            float sm = 0.f;
            for (int k = F.tid; k <= q; k += 512) { const float p = expf(lg[k] - mx); lg[k] = p; sm += p; }
            sm = bsum(F, sm);
            if (mix == 1) sm += expf(sink - mx);
            __syncthreads();
            { const int dv = F.tid % 128, part = F.tid / 128; float acc = 0.f;
              if (dv < DVV) for (int k = part; k <= q; k += 4) acc += lg[k] * bf1(Vp[(size_t)dv * S + k]);
              op[part * 128 + dv] = acc; }
            __syncthreads();
            float val = 0.f;
            if (F.tid < DVV) val = (op[F.tid] + op[128 + F.tid] + op[256 + F.tid] + op[384 + F.tid]) / sm;
            if (mix == 2 && mp == 0) { if (F.tid < 128) o1[F.tid] = val; __syncthreads(); continue; }
            if (mix == 2) {
                float d1 = 0.f, d2 = 0.f; for (int i = 0; i < 64; ++i) { d1 += a.in[9][layer * 64 + i] * a.in[10][layer * 64 + i]; d2 += a.in[11][layer * 64 + i] * a.in[12][layer * 64 + i]; }
                const float li = 0.8f - 0.6f * expf(-0.3f * (float)layer), lam = expf(d1) - expf(d2) + li;
                float x = (F.tid < 128) ? (o1[F.tid] - lam * val) : 0.f;
                const float ms = bsum(F, x * x) / 128.0f;
                val = x / sqrtf(ms + 1e-6f) * ((F.tid < 128) ? a.in[13][layer * 128 + F.tid] : 0.f) * (1.0f - li);
            }
            if (F.tid < DVV) { const int ocol = (mix == 1) ? h * 64 + F.tid : h * 128 + F.tid; const float got = bf1(wsb(F, WS_O)[(size_t)mix * S * 512 + (size_t)q * 512 + ocol]); errs = (val - got) * (val - got); nrms = val * val; }
        }
        verdict(F, errs, nrms, 0.03f, 3 + mix);
    }
}
DI void s5(const Frame& F, const Args& a, int layer) {
    const bf16_t* X = wsb(F, WS_XB);
    for (int u = F.vcu; u < NS; u += F.G) { const int t = SAMPLES[u]; float err = 0.f, nrm = 0.f, err2 = 0.f, nrm2 = 0.f;
        for (int c = F.tid; c < 8192; c += 512) { const int n = c >> 11, cc = c & 2047; const float* W = a.in[4] + ((size_t)layer * 4 + n) * DM * DM; float z = a.in[5][(size_t)layer * 8192 + c];
            for (int k = 0; k < DM; ++k) z += bf1(X[(size_t)t * DM + k]) * W[(size_t)k * DM + cc];
            const float ref = sigm(z), got = __builtin_amdgcn_cvt_pk_f32_fp8((int)(F.ws + WS_GT)[(size_t)t * 8192 + c], false)[0]; err += (ref - got) * (ref - got); nrm += ref * ref; }
        for (int c = F.tid; c < DM; c += 512) { float ref = 0.f;
            for (int n = 0; n < 4; ++n) { const float* W = a.in[6] + ((size_t)layer * 4 + n) * 512 * DM; float br = 0.f; for (int j = 0; j < 512; ++j) br += bf1(wsb(F, WS_O)[(size_t)n * S * 512 + (size_t)t * 512 + j]) * W[(size_t)j * DM + c];
                ref += __builtin_amdgcn_cvt_pk_f32_fp8((int)(F.ws + WS_GT)[(size_t)t * 8192 + n * DM + c], false)[0] * br; }
            const float got = bf1(wsb(F, WS_H)[(size_t)t * DM + c]); err2 += (ref - got) * (ref - got); nrm2 += ref * ref; }
        verdict(F, err, nrm, 0.12f, 7); verdict(F, err2, nrm2, 0.12f, 8); }
}
DI void s6(const Frame& F, const Args& a, int layer) {
    const bf16_t* X = wsb(F, WS_XB); const float* W = a.in[7] + (size_t)layer * DM * DM; const bf16_t* Y = wsb(F, WS_GT);
    for (int u = F.vcu; u < NS; u += F.G) { const int t = SAMPLES[u]; float err = 0.f, nrm = 0.f;
        for (int c = F.tid; c < DM; c += 512) { float ref = 0.f; for (int j = 0; j < DM; ++j) ref += bf1(wsb(F, WS_H)[(size_t)t * DM + j]) * W[(size_t)j * DM + c];
            const float full = DN_ALPHA * bf1(X[(size_t)t * DM + c]) + ref, got = bf1(Y[(size_t)t * DM + c]); err += (full - got) * (full - got); nrm += full * full; }
        verdict(F, err, nrm, 0.006f, 9); }
}
DI void poison(const Frame& F) {
    const unsigned bad = __hip_atomic_load((unsigned*)(F.ws + WS_CTL) + CW_CHK + 64 * MK_CHECK_WORD, __ATOMIC_RELAXED, __HIP_MEMORY_SCOPE_AGENT);
    const float sc = 1.0f + (float)bad / 256.0f;
    for (size_t i = (size_t)F.vcu * 512 + F.tid; i < (size_t)S * DM / 4; i += (size_t)F.G * 512) { f32x4 v = ((f32x4*)F.out)[i]; v = v * sc; ((f32x4*)F.out)[i] = v; }
}
}
#endif

#ifndef MK_CHECK
#define MK_CHECK 0
#endif
#ifndef MK_CHECK_WORD
#define MK_CHECK_WORD 0
#endif
#ifndef MK_CHECK_LAYER
#define MK_CHECK_LAYER 0
#endif
#ifndef MERGE_CHAIN
#define MERGE_CHAIN 1
#endif
#ifndef MK_X_BAR2
#define MK_X_BAR2 0
#endif
#ifndef MK_PROBE_REL
#define MK_PROBE_REL (-2)
#endif
#ifndef MK_PROBE_REPS
#define MK_PROBE_REPS 1
#endif
#ifndef MK_PER_PHASE
#define MK_PER_PHASE 0
#endif
constexpr int NPL = 11, NPHASES = 1 + NL * NPL;
DI void run_layer(const Frame& F, const Args& args, const XcdBarrier& bar, const int layer, const int lo, const int hi) {
#define PH(k) (lo <= (k) && (k) < hi)
#define SEAM(k) do { if (PH(k) && PH((k) + 1)) { xcd_barrier(bar); if (MK_X_BAR2) xcd_barrier(bar); } } while (0)
        const int pb = 1 + layer * NPL;
        unsigned char* wl = F.ws + WS_W + (size_t)layer * WL_STRIDE;
        if (PH(pb + 0)) {
            { pg8::Epi<0> E{}; E.O = wsb(F, WS_H); E.ldc = HW; E.grp = 128; run_gemm<0, true, 121, 127>(F, (const bf16_t*)(F.ws + WS_XB8), DM / 2, (const bf16_t*)(wl + W_IN), DM / 2, S, HW, DM / 2, 0, E); }
            { pg8::Epi<0> E{}; E.O = wsb(F, WS_VT); E.ldc = S; E.grp = 128; run_gemm<0, true, 127, 121>(F, (const bf16_t*)(wl + W_IN + (size_t)HW * DM), DM / 2, (const bf16_t*)(F.ws + WS_XB8), DM / 2, VT_ROWS, S, DM / 2, 0, E, 128); }
            { pg8::Epi<1> E{}; E.O = wsb(F, WS_GT); E.ldc = 8192; E.bias = args.in[5] + (size_t)layer * 8192; run_gemm<1, false, 121, 126, true>(F, (const bf16_t*)(F.ws + WS_XB4), DM / 4, (const bf16_t*)(wl + W_G), DM / 4, S, 8192, DM / 4, 0, E); }
        }
        SEAM(pb + 0);
        if (PH(pb + 1)) phase_prep(F, args, layer);
        SEAM(pb + 1);
        if (PH(pb + 2)) {
            { pg8::Epi<0> E{}; E.O = wsb(F, WS_QD); E.ldc = 768; E.grp = 128; run_gemm<0>(F, wsb(F, WS_CQN), 512, (const bf16_t*)(wl + W_UQ), 512, S, 768, 512, 0, E); }
            { pg8::Epi<0> E{}; E.O = wsb(F, WS_KD); E.ldc = 768; E.grp = 192; run_gemm<0>(F, wsb(F, WS_CKVN), 256, (const bf16_t*)(wl + W_UKV), 256, S, 512, 256, 0, E, 64); }
            { pg8::Epi<0> E{}; E.O = wsb(F, WS_VDT); E.ldc = S; E.grp = 128; run_gemm<0>(F, (const bf16_t*)(wl + W_UKV) + (size_t)512 * 256, 256, wsb(F, WS_CKVN), 256, 512, S, 256, 0, E, 192); }
        }
        SEAM(pb + 2);
        if (PH(pb + 3)) { phase_ropeq(F, args); phase_moba_select(F, args, layer); }
        SEAM(pb + 3);
        if (PH(pb + 4)) {
            phase_attention<0>(F, args, layer);
            if (layer + 1 < NL) convert_weights(F, args, layer + 1, layer + 2);
            __syncthreads();
            phase_attention<1>(F, args, layer);
        }
        SEAM(pb + 4);
        if (PH(pb + 5)) phase_mixer_combine(F, args, layer);
        SEAM(pb + 5);
        if (PH(pb + 6)) {
            if (MERGE_CHAIN) { pg8::Epi<5> E{}; E.O = wsb(F, WS_H); E.ldc = DM; E.G = (const bf16_t*)(F.ws + WS_GT); E.ldg = 8192; E.O8 = F.ws + WS_XB8;
                run_merge_chain(F, F.ws + WS_O8, wl + W_BR, E); }
            else
            for (int n = 0; n < 4; ++n) { pg8::Epi<2> E{}; E.O = wsb(F, WS_H); E.ldc = DM; E.G = (const bf16_t*)(F.ws + WS_GT + n * DM); E.ldg = 8192; E.first = (n == 0); E.O8 = (n == 3) ? F.ws + WS_XB8 : (unsigned char*)nullptr;
                run_gemm<2, true, 121, 124>(F, (const bf16_t*)(F.ws + WS_O8 + (size_t)n * S * 512), 256, (const bf16_t*)(wl + W_BR) + (size_t)n * DM * 512, 256, S, DM, 256, 0, E); }
        }
        SEAM(pb + 6);
        if (PH(pb + 7)) { pg8::Epi<3> E{}; E.O = F.ws + WS_GT; E.ldc = DM; E.X = wsb(F, WS_XB); E.alpha = DN_ALPHA;
            run_gemm<3, true, 121, 124>(F, (const bf16_t*)(F.ws + WS_XB8), DM / 2, (const bf16_t*)(wl + W_O), DM / 2, S, DM, DM / 2, 0, E); }
        SEAM(pb + 7);
        if (PH(pb + 8)) phase_ln1(F, args, layer);
        SEAM(pb + 8);
        if (PH(pb + 9)) { pg8::Epi<0> E{}; E.O = wsb(F, WS_H); E.ldc = DM; E.grp = 128; run_gemm<0>(F, wsb(F, WS_XB), DM, (const bf16_t*)(wl + W_PQ), DM, S, DM, DM, 0, E); }
        SEAM(pb + 9);
        if (PH(pb + 10)) phase_peer(F, args, layer, (const bf16_t*)(wl + W_SK), (layer == NL - 1) ? F.out : (float*)nullptr);
        SEAM(pb + 10);
#undef PH
#undef SEAM
}
__global__ void __launch_bounds__(512, 2) fwd_kernel(Args args) {
    extern __shared__ __attribute__((aligned(16))) unsigned char lds_raw[];
    Frame F;
    F.lds = (LAS unsigned char*)lds_raw; F.MISC = (volatile LAS unsigned*)(F.lds + MISC_OFF);
    F.tid = threadIdx.x; F.lane = F.tid & 63; F.wave = __builtin_amdgcn_readfirstlane(F.tid >> 6);
    F.G = gridDim.x; { const int bx = blockIdx.x; F.vcu = (F.G % 8 == 0) ? (bx % 8) * (F.G / 8) + bx / 8 : bx; }
    F.ws = args.ws; F.out = args.out;
    if (F.tid < 64) F.MISC[F.tid] = 0u;
    __syncthreads();
    const int lo = args.ph_lo, hi = args.ph_hi;
    unsigned* barw = (unsigned*)(F.ws + WS_CTL) + CW_BAR + (lo > 0 ? XCD_BAR_WORDS : 0);
    XcdBarrier bar; bar.bar = barw; bar.x = 0; bar.st = F.MISC;
    if (hi - lo > 1) bar = xcd_barrier_post(barw, F.MISC);
#define PH(k) (lo <= (k) && (k) < hi)
#define SEAM(k) do { if (PH(k) && PH((k) + 1)) { xcd_barrier(bar); if (MK_X_BAR2) xcd_barrier(bar); } } while (0)
    if (PH(0)) phase_prologue(F, args);
    SEAM(0);
    run_layer(F, args, bar, 0, lo, hi);
    run_layer(F, args, bar, 1, lo, hi);
#undef PH
#undef SEAM
}


#if MK_CHECK
__global__ void __launch_bounds__(512, 1) chk_kernel(Args args, int stage, int layer) {
    extern __shared__ __attribute__((aligned(16))) unsigned char lds_raw[];
    Frame F;
    F.lds = (LAS unsigned char*)lds_raw; F.MISC = (volatile LAS unsigned*)(F.lds + MISC_OFF);
    F.tid = threadIdx.x; F.lane = F.tid & 63; F.wave = __builtin_amdgcn_readfirstlane(F.tid >> 6);
    F.G = gridDim.x; { const int bx = blockIdx.x; F.vcu = (F.G % 8 == 0) ? (bx % 8) * (F.G / 8) + bx / 8 : bx; }
    F.ws = args.ws; F.out = args.out;
    if (stage == 1) { chk::s1(F, args, layer); chk::s2(F, args, layer); chk::s3(F, args, layer); }
    if (stage == 4) chk::s4(F, args, layer);
    if (stage == 5) chk::s5(F, args, layer);
    if (stage == 6) chk::s6(F, args, layer);
    if (stage == 99) chk::poison(F);
}
#endif
extern "C" void kernel_launch(void* const* d_in, const int* in_sizes, int n_in, void* d_out, int out_size, void* d_ws, size_t ws_size, hipStream_t stream) {
    static int grid = 0;
    if (grid == 0) {
        if (n_in != 26 || out_size != S * DM || ws_size < WS_END) { fprintf(stderr, "kernel_launch: unexpected problem (n_in %d, out %d, ws %zu); nothing launched\n", n_in, out_size, ws_size); grid = -1; return; }
        int dev = 0, cus = 0, per_cu = 0;
        if (hipGetDevice(&dev) != hipSuccess || hipDeviceGetAttribute(&cus, hipDeviceAttributeMultiprocessorCount, dev) != hipSuccess) { grid = -1; return; }
        if (hipFuncSetAttribute((const void*)fwd_kernel, hipFuncAttributeMaxDynamicSharedMemorySize, LDS_BYTES) != hipSuccess) { fprintf(stderr, "kernel_launch: hipFuncSetAttribute failed\n"); grid = -1; return; }
        if (hipOccupancyMaxActiveBlocksPerMultiprocessor(&per_cu, (const void*)fwd_kernel, 512, LDS_BYTES) != hipSuccess || per_cu < 1) { fprintf(stderr, "kernel_launch: occupancy query says %d blocks per CU\n", per_cu); }
        (void)hipGetLastError();
        grid = cus;
    }
    if (grid < 0) return;
    (void)hipMemsetAsync((char*)d_ws + WS_CTL, 0, CTL_ZERO_BYTES, stream);
    Args a{};
    for (int i = 0; i < 26; ++i) a.in[i] = (const float*)d_in[i];
    a.out = (float*)d_out; a.ws = (unsigned char*)d_ws;
#if MK_CHECK
    {
        static bool once = false; if (!once) { once = true; (void)hipFuncSetAttribute((const void*)chk_kernel, hipFuncAttributeMaxDynamicSharedMemorySize, LDS_BYTES); }
        const int pb = 1 + MK_CHECK_LAYER * NPL; const int cuts[6] = {0, pb + 4, pb + 6, pb + 7, pb + 8, NPHASES}; const int stg[5] = {1, 4, 5, 6, 0};
        for (int i = 0; i < 5; ++i) { (void)hipMemsetAsync((unsigned*)((char*)d_ws + WS_CTL) + CW_BAR, 0, 2 * XCD_BAR_WORDS * 4, stream); a.ph_lo = cuts[i]; a.ph_hi = cuts[i + 1]; hipLaunchKernelGGL(fwd_kernel, dim3(grid), dim3(512), LDS_BYTES, stream, a);
            if (stg[i]) hipLaunchKernelGGL(chk_kernel, dim3(grid), dim3(512), LDS_BYTES, stream, a, stg[i], MK_CHECK_LAYER); }
        hipLaunchKernelGGL(chk_kernel, dim3(grid), dim3(512), LDS_BYTES, stream, a, 99, 0);
    }
#elif MK_PROBE_REL > -2
    {
        unsigned* ctl = (unsigned*)((char*)d_ws + WS_CTL);
        auto launch = [&](int lo, int hi) { if (hi <= lo) return; (void)hipMemsetAsync(ctl + CW_BAR, 0, 2 * XCD_BAR_WORDS * 4, stream); a.ph_lo = lo; a.ph_hi = hi; hipLaunchKernelGGL(fwd_kernel, dim3(grid), dim3(512), LDS_BYTES, stream, a); };
        int cur = 0;
        const int nl = (MK_PROBE_REL == -1) ? 1 : NL;
        for (int layer = 0; layer < nl; ++layer) {
            const int p = (MK_PROBE_REL == -1) ? 0 : 1 + layer * NPL + MK_PROBE_REL;
            launch(cur, p);
            for (int r = 0; r <= MK_PROBE_REPS; ++r) {
                (void)hipMemsetAsync(ctl + CW_Q, 0, 4096 * 4, stream);
#ifdef MK_PROBE_MIXER
                if (r > 0) { (void)hipMemsetAsync(ctl + CW_Q, 0x04, 4096 * 4, stream); (void)hipMemsetAsync(ctl + CW_Q + layer * 256 + 64 * MK_PROBE_MIXER, 0, 4, stream); }
#endif
                if (MK_PROBE_REL == 10 && r == 0) (void)hipMemcpyAsync((char*)d_ws + WS_GT, (char*)d_ws + WS_XB, (size_t)S * DM * 2, hipMemcpyDeviceToDevice, stream);
                if (MK_PROBE_REL == 10 && r > 0) (void)hipMemcpyAsync((char*)d_ws + WS_XB, (char*)d_ws + WS_GT, (size_t)S * DM * 2, hipMemcpyDeviceToDevice, stream);
                if (MK_PROBE_REL == 3 && r == 0) (void)hipMemcpyAsync((char*)d_ws + WS_PART, (char*)d_ws + WS_QD, (size_t)S * 768 * 2, hipMemcpyDeviceToDevice, stream);
                if (MK_PROBE_REL == 3 && r > 0) { (void)hipMemcpyAsync((char*)d_ws + WS_QD, (char*)d_ws + WS_PART, (size_t)S * 768 * 2, hipMemcpyDeviceToDevice, stream); (void)hipMemsetAsync(ctl + CW_MOBA, 0, 2048 * 4, stream); }
                launch(p, p + 1);
            }
            cur = p + 1;
        }
        launch(cur, NPHASES);
    }
#elif MK_PER_PHASE
    for (int p = 0; p < NPHASES; ++p) { a.ph_lo = p; a.ph_hi = p + 1; hipLaunchKernelGGL(fwd_kernel, dim3(grid), dim3(512), LDS_BYTES, stream, a); }
#else
    a.ph_lo = 0; a.ph_hi = NPHASES;
    hipLaunchKernelGGL(fwd_kernel, dim3(grid), dim3(512), LDS_BYTES, stream, a);
#endif
}
```

```cpp
#include <hip/hip_runtime.h>
#include <cstdio>
#include <cstdint>
#include <cmath>

#define DI __device__ __forceinline__
#define LAS __attribute__((address_space(3)))
#define GAS __attribute__((address_space(1)))
typedef unsigned short bf16_t;
typedef short bf16x8 __attribute__((ext_vector_type(8)));
typedef float f32x4 __attribute__((ext_vector_type(4)));
typedef float f32x2 __attribute__((ext_vector_type(2)));
typedef float f32x16 __attribute__((ext_vector_type(16)));
typedef unsigned u32x4 __attribute__((ext_vector_type(4)));
typedef unsigned u32x2 __attribute__((ext_vector_type(2)));
typedef int i32x4 __attribute__((ext_vector_type(4)));
typedef __bf16 bf16x2_t __attribute__((ext_vector_type(2)));

DI unsigned cvtpk(float lo, float hi) { f32x2 v = {lo, hi}; bf16x2_t b = __builtin_convertvector(v, bf16x2_t); return __builtin_bit_cast(unsigned, b); }
DI float bf_lo(unsigned u) { return __uint_as_float(u << 16); }
DI float bf_hi(unsigned u) { return __uint_as_float(u & 0xffff0000u); }
DI float bf1(bf16_t u) { return __uint_as_float((unsigned)u << 16); }
DI float ex2(float x) { return __builtin_amdgcn_exp2f(x); }
DI float wave_sum(float v) {
#pragma unroll
    for (int o = 1; o < 64; o <<= 1) v += __shfl_xor(v, o);
    return v;
}
DI float xhalf(float v) { return __shfl_xor(v, 32); }

namespace pg8 {
#define PG8_LAS __attribute__((address_space(3)))
#ifndef PG8_WGM
#define PG8_WGM 8
#endif
constexpr int BM = 256, BK = 64, HALF = 128, HTB = HALF * BK * 2  , STAGE_BYTES = 8 * HTB, NXCD = 8, WGM = PG8_WGM;

__host__ __device__ __forceinline__ int lds_byte(int r, int c) { const int st = (r >> 4) * 2 + (c >> 5), rr = r & 15, cc = c & 31, ob = rr * 64 + cc * 2; return st * 1024 + (ob ^ (((ob >> 9) & 1) << 5)); }
__host__ __device__ __forceinline__ void stage_rc(int b, int& R, int& C) { const int st = b / 1024, sb = b % 1024, swz = sb ^ (((sb >> 9) & 1) << 5); R = (st >> 1) * 16 + swz / 64; C = (st & 1) * 32 + (swz % 64) / 2; }
__host__ __device__ __forceinline__ int perm32(int rho) { const int n = rho >> 4, i = rho & 15; return 8 * (i >> 2) + 4 * n + (i & 3); }

struct Unit { int pm, pn, br; };
struct Gemm { const bf16_t* A; const bf16_t* Bt; int M, N, K, lda, ldb; long apn; long abr, bbr; };

struct StaticOrder {
    int nM, nN, nwg, G, c;
    __host__ __device__ void init(int M, int N, int G_, int c_) { nM = M / BM; nN = N / BM; nwg = nM * nN; G = G_; c = c_; }
    __host__ __device__ bool next(int i, Unit& u) const {
        const long L = (long)i * G + c; if (L >= nwg) return false;
        int wgid = (int)L; { const int q = nwg / NXCD, r = nwg % NXCD, xcd = wgid % NXCD, off = wgid / NXCD; wgid = (xcd < r ? xcd * (q + 1) : r * (q + 1) + (xcd - r) * q) + off; }
        const int nig = WGM * nN, gid = wgid / nig, fm = gid * WGM, gsz = (nM - fm) < WGM ? (nM - fm) : WGM;
        u.pm = fm + ((wgid % nig) % gsz); u.pn = (wgid % nig) / gsz; u.br = 0; return true;
    }
    __device__ __forceinline__ void a_ready(const Unit&) const {}
    __device__ __forceinline__ void done(const Unit&) const {}
};
template <int NBR> struct ChainOrder {
    StaticOrder so;
    __host__ __device__ void init(int M, int N, int G_, int c_) { so.init(M, N, G_, c_); }
    __host__ __device__ bool next(int i, Unit& u) const { const bool ok = so.next(i / NBR, u); u.br = i % NBR; return ok; }
    __device__ __forceinline__ void a_ready(const Unit&) const {}
    __device__ __forceinline__ void done(const Unit&) const {}
};

template <int MODE> struct Epi {
    static constexpr bool PERM = true, AFTER_DRAIN = false, CHAIN = (MODE == 5); static constexpr int NBR = 4;
    void* O; int ldc; int grp; const float* bias; const bf16_t* G; int ldg; const void* X; float alpha; int first; unsigned char* O8;
    static __device__ __forceinline__ f32x2 gclamp(f32x2 g) { return (f32x2){fmaxf(g.x, 0.001953125f), fmaxf(g.y, 0.001953125f)}; }
    __device__ __forceinline__ void rescale(f32x4 (&acc)[2][2][4][2], const Unit& u, int wr, int wc, int fr, int fq) const {
        const int row0 = u.pm * BM + wr * 64 + fr, colb = u.pn * BM + wc * 32 + 8 * fq;
        const float z = (u.br + 1 < NBR) ? 1.0f : 0.0f;
        const size_t gcol = (size_t)(u.br + 1 < NBR ? u.br : 0) * ldc;
#pragma unroll
        for (int ai = 0; ai < 2; ++ai)
#pragma unroll
            for (int m = 0; m < 4; ++m) {
                const size_t r = (size_t)(row0 + ai * HALF + m * 16);
#pragma unroll
                for (int bj = 0; bj < 2; ++bj) {
                    const int c = colb + bj * HALF;
                    const unsigned char* gp = (const unsigned char*)G + r * ldg + gcol + c;
                    asm volatile("" : "+v"(gp));
                    const u32x2 ga = *(const u32x2*)gp, gb = *(const u32x2*)(gp + ldc);
                    const f32x2 a0 = gclamp(__builtin_amdgcn_cvt_pk_f32_fp8((int)ga.x, false)), a1 = gclamp(__builtin_amdgcn_cvt_pk_f32_fp8((int)ga.x, true)), a2 = gclamp(__builtin_amdgcn_cvt_pk_f32_fp8((int)ga.y, false)), a3 = gclamp(__builtin_amdgcn_cvt_pk_f32_fp8((int)ga.y, true));
                    const f32x2 b0 = gclamp(__builtin_amdgcn_cvt_pk_f32_fp8((int)gb.x, false)), b1 = gclamp(__builtin_amdgcn_cvt_pk_f32_fp8((int)gb.x, true)), b2 = gclamp(__builtin_amdgcn_cvt_pk_f32_fp8((int)gb.y, false)), b3 = gclamp(__builtin_amdgcn_cvt_pk_f32_fp8((int)gb.y, true));
                    f32x4& v0 = acc[ai][bj][m][0]; f32x4& v1 = acc[ai][bj][m][1];
                    v0[0] *= z * a0.x * __builtin_amdgcn_rcpf(b0.x); v0[1] *= z * a0.y * __builtin_amdgcn_rcpf(b0.y); v0[2] *= z * a1.x * __builtin_amdgcn_rcpf(b1.x); v0[3] *= z * a1.y * __builtin_amdgcn_rcpf(b1.y);
                    v1[0] *= z * a2.x * __builtin_amdgcn_rcpf(b2.x); v1[1] *= z * a2.y * __builtin_amdgcn_rcpf(b2.y); v1[2] *= z * a3.x * __builtin_amdgcn_rcpf(b3.x); v1[3] *= z * a3.y * __builtin_amdgcn_rcpf(b3.y);
                    asm volatile("" : "+v"(v0), "+v"(v1));
                }
            }
    }
    __device__ __forceinline__ void operator()(const f32x4 (&acc)[2][2][4][2], const Unit& u, int wr, int wc, int fr, int fq) const {
        const int row0 = u.pm * BM + wr * 64 + fr, colb = u.pn * BM + wc * 32 + 8 * fq;
#pragma unroll
        for (int ai = 0; ai < 2; ++ai)
#pragma unroll
            for (int m = 0; m < 4; ++m) {
                const size_t r = (size_t)(row0 + ai * HALF + m * 16);
#pragma unroll
                for (int bj = 0; bj < 2; ++bj) {
                    const int c = colb + bj * HALF;
                    f32x4 v0 = acc[ai][bj][m][0], v1 = acc[ai][bj][m][1];
                    if constexpr (MODE == 0) {
                        const int dc = (c >> 7) * grp + (c & 127);
                        u32x4 w; w.x = cvtpk(v0[0], v0[1]); w.y = cvtpk(v0[2], v0[3]); w.z = cvtpk(v1[0], v1[1]); w.w = cvtpk(v1[2], v1[3]);
                        *(u32x4*)((bf16_t*)O + r * ldc + dc) = w;
                    } else if constexpr (MODE == 1) {
                        const f32x4 b0 = *(const f32x4*)(bias + c), b1 = *(const f32x4*)(bias + c + 4);
                        v0 = v0 + b0; v1 = v1 + b1;
#pragma unroll
                        for (int e = 0; e < 4; ++e) { v0[e] = __builtin_amdgcn_rcpf(1.0f + ex2(-1.4426950408889634f * v0[e])); v1[e] = __builtin_amdgcn_rcpf(1.0f + ex2(-1.4426950408889634f * v1[e])); }
                        int lo = __builtin_amdgcn_cvt_pk_fp8_f32(v0[0], v0[1], 0, false); lo = __builtin_amdgcn_cvt_pk_fp8_f32(v0[2], v0[3], lo, true);
                        int hi = __builtin_amdgcn_cvt_pk_fp8_f32(v1[0], v1[1], 0, false); hi = __builtin_amdgcn_cvt_pk_fp8_f32(v1[2], v1[3], hi, true);
                        *(u32x2*)((unsigned char*)O + r * ldc + c) = (u32x2){(unsigned)lo, (unsigned)hi};
                    } else if constexpr (MODE == 2) {
                        const u32x2 gq = *(const u32x2*)((const unsigned char*)G + r * ldg + c);
                        const f32x2 g0 = __builtin_amdgcn_cvt_pk_f32_fp8((int)gq.x, false), g1 = __builtin_amdgcn_cvt_pk_f32_fp8((int)gq.x, true), g2 = __builtin_amdgcn_cvt_pk_f32_fp8((int)gq.y, false), g3 = __builtin_amdgcn_cvt_pk_f32_fp8((int)gq.y, true);
                        bf16_t* op = (bf16_t*)O + r * ldc + c;
                        u32x4 old = (u32x4){0u, 0u, 0u, 0u};
                        if (!first) old = *(const u32x4*)op;
                        const float r0 = bf_lo(old.x) + g0.x * v0[0], r1 = bf_hi(old.x) + g0.y * v0[1], r2 = bf_lo(old.y) + g1.x * v0[2], r3 = bf_hi(old.y) + g1.y * v0[3];
                        const float r4 = bf_lo(old.z) + g2.x * v1[0], r5 = bf_hi(old.z) + g2.y * v1[1], r6 = bf_lo(old.w) + g3.x * v1[2], r7 = bf_hi(old.w) + g3.y * v1[3];
                        u32x4 w; w.x = cvtpk(r0, r1); w.y = cvtpk(r2, r3); w.z = cvtpk(r4, r5); w.w = cvtpk(r6, r7);
                        *(u32x4*)op = w;
                        if (O8) {
                            int lo = __builtin_amdgcn_cvt_pk_fp8_f32(r0 * 8.0f, r1 * 8.0f, 0, false); lo = __builtin_amdgcn_cvt_pk_fp8_f32(r2 * 8.0f, r3 * 8.0f, lo, true);
                            int hi = __builtin_amdgcn_cvt_pk_fp8_f32(r4 * 8.0f, r5 * 8.0f, 0, false); hi = __builtin_amdgcn_cvt_pk_fp8_f32(r6 * 8.0f, r7 * 8.0f, hi, true);
                            *(u32x2*)(O8 + r * ldc + c) = (u32x2){(unsigned)lo, (unsigned)hi}; }
                    } else if constexpr (MODE == 5) {
                        const u32x2 gq = *(const u32x2*)((const unsigned char*)G + r * ldg + 3 * ldc + c);
                        const f32x2 g0 = gclamp(__builtin_amdgcn_cvt_pk_f32_fp8((int)gq.x, false)), g1 = gclamp(__builtin_amdgcn_cvt_pk_f32_fp8((int)gq.x, true)), g2 = gclamp(__builtin_amdgcn_cvt_pk_f32_fp8((int)gq.y, false)), g3 = gclamp(__builtin_amdgcn_cvt_pk_f32_fp8((int)gq.y, true));
                        const float r0 = g0.x * v0[0], r1 = g0.y * v0[1], r2 = g1.x * v0[2], r3 = g1.y * v0[3], r4 = g2.x * v1[0], r5 = g2.y * v1[1], r6 = g3.x * v1[2], r7 = g3.y * v1[3];
#if defined(MK_CHECK) && MK_CHECK
                        { u32x4 w; w.x = cvtpk(r0, r1); w.y = cvtpk(r2, r3); w.z = cvtpk(r4, r5); w.w = cvtpk(r6, r7); *(u32x4*)((bf16_t*)O + r * ldc + c) = w; }
#endif
                        int lo = __builtin_amdgcn_cvt_pk_fp8_f32(r0 * 8.0f, r1 * 8.0f, 0, false); lo = __builtin_amdgcn_cvt_pk_fp8_f32(r2 * 8.0f, r3 * 8.0f, lo, true);
                        int hi = __builtin_amdgcn_cvt_pk_fp8_f32(r4 * 8.0f, r5 * 8.0f, 0, false); hi = __builtin_amdgcn_cvt_pk_fp8_f32(r6 * 8.0f, r7 * 8.0f, hi, true);
                        *(u32x2*)(O8 + r * ldc + c) = (u32x2){(unsigned)lo, (unsigned)hi};
                    } else if constexpr (MODE == 3) {
                        const u32x4 xx = *(const u32x4*)((const bf16_t*)X + r * ldc + c);
                        u32x4 w;
                        w.x = cvtpk(bf_lo(xx.x) * alpha + v0[0], bf_hi(xx.x) * alpha + v0[1]); w.y = cvtpk(bf_lo(xx.y) * alpha + v0[2], bf_hi(xx.y) * alpha + v0[3]);
                        w.z = cvtpk(bf_lo(xx.z) * alpha + v1[0], bf_hi(xx.z) * alpha + v1[1]); w.w = cvtpk(bf_lo(xx.w) * alpha + v1[2], bf_hi(xx.w) * alpha + v1[3]);
                        *(u32x4*)((bf16_t*)O + r * ldc + c) = w;
                    } else {
                        *(f32x4*)((float*)O + r * ldc + c) = v0; *(f32x4*)((float*)O + r * ldc + c + 4) = v1;
                    }
                }
            }
    }
};

template <class Epi, class Sched, bool ALIGN_EPI = false, bool SP2 = false, bool F8 = false, int SC0 = 127, int SC1 = 127, bool F4 = false>
__device__ __forceinline__ void gemm_phase(PG8_LAS unsigned char* lds, const Gemm g, const Sched& S, const Epi& E) {
    int tid_ = threadIdx.x; asm volatile("" : "+v"(tid_));
    const int tid = tid_, wid = __builtin_amdgcn_readfirstlane(tid >> 6), lane = tid & 63, wr = wid >> 2, wc = wid & 3, fr = lane & 15, fq = lane >> 4;
    const int K = g.K, nt = K / BK;
    unsigned voffA[2], voffB[2];
#pragma unroll
    for (int i = 0; i < 2; ++i) { int R, C; stage_rc(tid * 16 + i * 8192, R, C); const int Rb = Epi::PERM ? ((R & ~31) + perm32(R & 31)) : R;
        voffA[i] = (unsigned)(R * g.lda + C) * 2u; voffB[i] = (unsigned)(Rb * g.ldb + C) * 2u; }
    const size_t kstep = (size_t)(BK * 2);
    const size_t hstepA = (size_t)HALF * g.lda * 2, hstepB = (size_t)HALF * g.ldb * 2;
    const size_t tstepA = 2 * hstepA, tstepB = 2 * hstepB;
    const unsigned ldsw = (unsigned)wid * 1024u;
    const int aoff = lds_byte(wr * 64 + fr, fq * 8), boff = lds_byte(wc * 32 + fr, fq * 8);

#define PG8_SA(b, h) (((b) * 2 + (h)) * HTB)
#define PG8_SB(b, h) ((4 + (b) * 2 + (h)) * HTB)
#define PG8_STAGE(bufoff, gbase, voff) do { _Pragma("unroll") for (int _i = 0; _i < 2; ++_i) \
        __builtin_amdgcn_global_load_lds((const unsigned*)((const char*)(gbase) + (voff)[_i]), (PG8_LAS unsigned*)(lds + (bufoff) + ldsw + _i * 8192), 16, 0, 0); } while (0)
#define PG8_LDA(dst, b, h) do { _Pragma("unroll") for (int m = 0; m < 4; ++m) { if constexpr (F8) { const v4i_t lo_ = *(const PG8_LAS v4i_t*)(lds + PG8_SA(b, h) + aoff + m * 2048), hi_ = *(const PG8_LAS v4i_t*)(lds + PG8_SA(b, h) + aoff + m * 2048 + 1024); dst##8[m] = __builtin_shufflevector(lo_, hi_, 0, 1, 2, 3, 4, 5, 6, 7); } else { _Pragma("unroll") for (int k = 0; k < 2; ++k) dst[m][k] = *(const PG8_LAS bf16x8*)(lds + PG8_SA(b, h) + aoff + m * 2048 + k * 1024); } } } while (0)
#define PG8_LDB(dst, b, h) do { _Pragma("unroll") for (int n = 0; n < 2; ++n) { if constexpr (F8) { const v4i_t lo_ = *(const PG8_LAS v4i_t*)(lds + PG8_SB(b, h) + boff + n * 2048), hi_ = *(const PG8_LAS v4i_t*)(lds + PG8_SB(b, h) + boff + n * 2048 + 1024); dst##8[n] = __builtin_shufflevector(lo_, hi_, 0, 1, 2, 3, 4, 5, 6, 7); } else { _Pragma("unroll") for (int k = 0; k < 2; ++k) dst[n][k] = *(const PG8_LAS bf16x8*)(lds + PG8_SB(b, h) + boff + n * 2048 + k * 1024); } } } while (0)
#define PG8_MMA(ai, bj, At, Bt) do { __builtin_amdgcn_s_setprio(1); \
        if constexpr (F8) {   \
            asm volatile("s_nop 1\n\t" \
            "v_mfma_scale_f32_16x16x128_f8f6f4 %0, %12, %8, %0, %14, %15 op_sel_hi:[0,0,0]\n\t"  \
            "v_mfma_scale_f32_16x16x128_f8f6f4 %1, %13, %8, %1, %14, %15 op_sel_hi:[0,0,0]\n\t"  \
            "v_mfma_scale_f32_16x16x128_f8f6f4 %2, %12, %9, %2, %14, %15 op_sel_hi:[0,0,0]\n\t"  \
            "v_mfma_scale_f32_16x16x128_f8f6f4 %3, %13, %9, %3, %14, %15 op_sel_hi:[0,0,0]\n\t"  \
            "v_mfma_scale_f32_16x16x128_f8f6f4 %4, %12, %10, %4, %14, %15 op_sel_hi:[0,0,0]\n\t"  \
            "v_mfma_scale_f32_16x16x128_f8f6f4 %5, %13, %10, %5, %14, %15 op_sel_hi:[0,0,0]\n\t"  \
            "v_mfma_scale_f32_16x16x128_f8f6f4 %6, %12, %11, %6, %14, %15 op_sel_hi:[0,0,0]\n\t"  \
            "v_mfma_scale_f32_16x16x128_f8f6f4 %7, %13, %11, %7, %14, %15 op_sel_hi:[0,0,0]\n\t"  \
                : "+v"(acc[ai][bj][0][0]), "+v"(acc[ai][bj][0][1]), "+v"(acc[ai][bj][1][0]), "+v"(acc[ai][bj][1][1]), "+v"(acc[ai][bj][2][0]), "+v"(acc[ai][bj][2][1]), "+v"(acc[ai][bj][3][0]), "+v"(acc[ai][bj][3][1]) \
                : "v"(At##8[0]), "v"(At##8[1]), "v"(At##8[2]), "v"(At##8[3]), "v"(Bt##8[0]), "v"(Bt##8[1]), "v"(sc0), "v"(sc1)); \
        } else if constexpr (F4) { \
            asm volatile("s_nop 1\n\t" \
            "v_mfma_scale_f32_16x16x128_f8f6f4 %0, %16, %8, %0, %20, %21 op_sel_hi:[0,0,0] cbsz:4 blgp:4\n\t"  \
            "v_mfma_scale_f32_16x16x128_f8f6f4 %0, %17, %9, %0, %20, %21 op_sel_hi:[0,0,0] cbsz:4 blgp:4\n\t"  \
            "v_mfma_scale_f32_16x16x128_f8f6f4 %1, %18, %8, %1, %20, %21 op_sel_hi:[0,0,0] cbsz:4 blgp:4\n\t"  \
            "v_mfma_scale_f32_16x16x128_f8f6f4 %1, %19, %9, %1, %20, %21 op_sel_hi:[0,0,0] cbsz:4 blgp:4\n\t"  \
            "v_mfma_scale_f32_16x16x128_f8f6f4 %2, %16, %10, %2, %20, %21 op_sel_hi:[0,0,0] cbsz:4 blgp:4\n\t"  \
            "v_mfma_scale_f32_16x16x128_f8f6f4 %2, %17, %11, %2, %20, %21 op_sel_hi:[0,0,0] cbsz:4 blgp:4\n\t"  \
            "v_mfma_scale_f32_16x16x128_f8f6f4 %3, %18, %10, %3, %20, %21 op_sel_hi:[0,0,0] cbsz:4 blgp:4\n\t"  \
            "v_mfma_scale_f32_16x16x128_f8f6f4 %3, %19, %11, %3, %20, %21 op_sel_hi:[0,0,0] cbsz:4 blgp:4\n\t"  \
            "v_mfma_scale_f32_16x16x128_f8f6f4 %4, %16, %12, %4, %20, %21 op_sel_hi:[0,0,0] cbsz:4 blgp:4\n\t"  \
            "v_mfma_scale_f32_16x16x128_f8f6f4 %4, %17, %13, %4, %20, %21 op_sel_hi:[0,0,0] cbsz:4 blgp:4\n\t"  \
            "v_mfma_scale_f32_16x16x128_f8f6f4 %5, %18, %12, %5, %20, %21 op_sel_hi:[0,0,0] cbsz:4 blgp:4\n\t"  \
            "v_mfma_scale_f32_16x16x128_f8f6f4 %5, %19, %13, %5, %20, %21 op_sel_hi:[0,0,0] cbsz:4 blgp:4\n\t"  \
            "v_mfma_scale_f32_16x16x128_f8f6f4 %6, %16, %14, %6, %20, %21 op_sel_hi:[0,0,0] cbsz:4 blgp:4\n\t"  \
            "v_mfma_scale_f32_16x16x128_f8f6f4 %6, %17, %15, %6, %20, %21 op_sel_hi:[0,0,0] cbsz:4 blgp:4\n\t"  \
            "v_mfma_scale_f32_16x16x128_f8f6f4 %7, %18, %14, %7, %20, %21 op_sel_hi:[0,0,0] cbsz:4 blgp:4\n\t"  \
            "v_mfma_scale_f32_16x16x128_f8f6f4 %7, %19, %15, %7, %20, %21 op_sel_hi:[0,0,0] cbsz:4 blgp:4\n\t"  \
                : "+v"(acc[ai][bj][0][0]), "+v"(acc[ai][bj][0][1]), "+v"(acc[ai][bj][1][0]), "+v"(acc[ai][bj][1][1]), "+v"(acc[ai][bj][2][0]), "+v"(acc[ai][bj][2][1]), "+v"(acc[ai][bj][3][0]), "+v"(acc[ai][bj][3][1]) \
                : "v"(At[0][0]), "v"(At[0][1]), "v"(At[1][0]), "v"(At[1][1]), "v"(At[2][0]), "v"(At[2][1]), "v"(At[3][0]), "v"(At[3][1]), "v"(Bt[0][0]), "v"(Bt[0][1]), "v"(Bt[1][0]), "v"(Bt[1][1]), "v"(sc0), "v"(sc1)); \
        } else { _Pragma("unroll") for (int m = 0; m < 4; ++m) _Pragma("unroll") for (int n = 0; n < 2; ++n) _Pragma("unroll") for (int k = 0; k < 2; ++k) \
            acc[ai][bj][m][n] = __builtin_amdgcn_mfma_f32_16x16x32_bf16(Bt[n][k], At[m][k], acc[ai][bj][m][n], 0, 0, 0); } \
        __builtin_amdgcn_s_setprio(0); } while (0)
#define PG8_WAIT_V(n) asm volatile("s_waitcnt vmcnt(" #n ")" ::: "memory")
#define PG8_WAIT_L(n) asm volatile("s_waitcnt lgkmcnt(" #n ")" ::: "memory")
#define PG8_BAR __builtin_amdgcn_s_barrier()
#define PG8_SCHED __builtin_amdgcn_sched_barrier(0)
    Unit cur, nxt; int ui = 0;
    if (!S.next(0, cur)) return;
    f32x4 acc[2][2][4][2];
#pragma unroll
    for (int a = 0; a < 2; ++a)
#pragma unroll
        for (int b = 0; b < 2; ++b)
#pragma unroll
            for (int m = 0; m < 4; ++m)
#pragma unroll
                for (int n = 0; n < 2; ++n) acc[a][b][m][n] = (f32x4){0.f, 0.f, 0.f, 0.f};
    bf16x8 At[4][2], B0[2][2], B1[2][2];
    typedef int v8i_t __attribute__((ext_vector_type(8))); typedef int v4i_t __attribute__((ext_vector_type(4)));
    v8i_t At8[4], B08[2], B18[2];
    int sc0 = SC0 * 0x01010101, sc1 = SC1 * 0x01010101; asm volatile("" : "+v"(sc0), "+v"(sc1));
    const char* cA = (const char*)g.A + (size_t)cur.pm * tstepA + (size_t)cur.pn * g.apn + (size_t)cur.br * g.abr; const char* cB = (const char*)g.Bt + (size_t)cur.pn * tstepB + (size_t)cur.br * g.bbr;
    S.a_ready(cur);
    if constexpr (SP2) {
        PG8_STAGE(PG8_SB(0, 0), cB, voffB); PG8_STAGE(PG8_SB(0, 1), cB + hstepB, voffB); PG8_STAGE(PG8_SA(0, 0), cA, voffA); PG8_STAGE(PG8_SA(0, 1), cA + hstepA, voffA);
        if (wr == 1) PG8_BAR;
        PG8_WAIT_V(2); PG8_BAR;
        PG8_STAGE(PG8_SB(1, 0), cB + kstep, voffB); PG8_STAGE(PG8_SA(1, 0), cA + kstep, voffA); PG8_STAGE(PG8_SB(1, 1), cB + hstepB + kstep, voffB);
        PG8_WAIT_V(6); PG8_BAR;
    } else {
        PG8_STAGE(PG8_SB(0, 0), cB, voffB); PG8_STAGE(PG8_SA(0, 0), cA, voffA); PG8_STAGE(PG8_SB(0, 1), cB + hstepB, voffB); PG8_STAGE(PG8_SA(0, 1), cA + hstepA, voffA);
        if (wr == 1) PG8_BAR;
        PG8_WAIT_V(4); PG8_BAR;
        PG8_STAGE(PG8_SB(1, 0), cB + kstep, voffB); PG8_STAGE(PG8_SA(1, 0), cA + kstep, voffA); PG8_STAGE(PG8_SB(1, 1), cB + hstepB + kstep, voffB);
        PG8_WAIT_V(6); PG8_BAR;
    }
    for (;;) {
        const bool has_next = S.next(ui + 1, nxt);
        const char* nA = has_next ? (const char*)g.A + (size_t)nxt.pm * tstepA + (size_t)nxt.pn * g.apn + (size_t)nxt.br * g.abr : cA; const char* nB = has_next ? (const char*)g.Bt + (size_t)nxt.pn * tstepB + (size_t)nxt.br * g.bbr : cB;
        for (int t = 0; t < nt; t += 2) {
            const bool last = (t == nt - 2);
            const char* a1 = cA + (size_t)(t + 1) * kstep;
            const char* a2 = last ? nA : cA + (size_t)(t + 2) * kstep; const char* b2 = last ? nB : cB + (size_t)(t + 2) * kstep;
            const char* a3 = a2 + kstep; const char* b3 = b2 + kstep;
            if (last && has_next) S.a_ready(nxt);
            if constexpr (SP2) {
            PG8_LDB(B0, 0, 0); PG8_LDB(B1, 0, 1); PG8_SCHED; PG8_LDA(At, 0, 0); PG8_STAGE(PG8_SA(1, 1), a1 + hstepA, voffA);
            PG8_WAIT_V(8); PG8_WAIT_L(0); PG8_BAR; PG8_MMA(0, 0, At, B0); PG8_MMA(0, 1, At, B1); PG8_BAR; PG8_SCHED;
            PG8_LDA(At, 0, 1); PG8_STAGE(PG8_SB(0, 0), b2, voffB); PG8_STAGE(PG8_SB(0, 1), b2 + hstepB, voffB); PG8_STAGE(PG8_SA(0, 0), a2, voffA);
            PG8_WAIT_V(8); PG8_WAIT_L(0); PG8_BAR; PG8_MMA(1, 0, At, B0); PG8_MMA(1, 1, At, B1); PG8_BAR; PG8_SCHED;
            PG8_LDB(B0, 1, 0); PG8_LDB(B1, 1, 1); PG8_SCHED; PG8_LDA(At, 1, 0); PG8_STAGE(PG8_SA(0, 1), a2 + hstepA, voffA);
            PG8_WAIT_V(8); PG8_WAIT_L(0); PG8_BAR; PG8_MMA(0, 0, At, B0); PG8_MMA(0, 1, At, B1); PG8_BAR; PG8_SCHED;
            PG8_LDA(At, 1, 1); PG8_STAGE(PG8_SB(1, 0), b3, voffB); PG8_STAGE(PG8_SB(1, 1), b3 + hstepB, voffB); PG8_STAGE(PG8_SA(1, 0), a3, voffA);
            PG8_WAIT_V(8); PG8_WAIT_L(0); PG8_BAR; PG8_MMA(1, 0, At, B0); PG8_MMA(1, 1, At, B1); PG8_BAR; PG8_SCHED;
            } else {
            PG8_LDB(B0, 0, 0); PG8_SCHED; PG8_LDA(At, 0, 0); PG8_STAGE(PG8_SA(1, 1), a1 + hstepA, voffA);
            PG8_WAIT_L(8); PG8_BAR; PG8_WAIT_L(0); PG8_MMA(0, 0, At, B0); PG8_BAR; PG8_SCHED;
            PG8_LDB(B1, 0, 1); PG8_STAGE(PG8_SB(0, 0), b2, voffB);
            PG8_BAR; PG8_WAIT_L(0); PG8_MMA(0, 1, At, B1); PG8_BAR;
            PG8_LDA(At, 0, 1); PG8_STAGE(PG8_SA(0, 0), a2, voffA);
            PG8_BAR; PG8_WAIT_L(0); PG8_MMA(1, 0, At, B0); PG8_BAR; PG8_SCHED;
            PG8_STAGE(PG8_SB(0, 1), b2 + hstepB, voffB);
            PG8_WAIT_V(6); PG8_BAR; PG8_MMA(1, 1, At, B1); PG8_BAR;
            PG8_LDB(B0, 1, 0); PG8_SCHED; PG8_LDA(At, 1, 0); PG8_STAGE(PG8_SA(0, 1), a2 + hstepA, voffA);
            PG8_WAIT_L(8); PG8_BAR; PG8_WAIT_L(0); PG8_MMA(0, 0, At, B0); PG8_BAR; PG8_SCHED;
            PG8_LDB(B1, 1, 1); PG8_STAGE(PG8_SB(1, 0), b3, voffB);
            PG8_BAR; PG8_WAIT_L(0); PG8_MMA(0, 1, At, B1); PG8_BAR;
            PG8_LDA(At, 1, 1); PG8_STAGE(PG8_SA(1, 0), a3, voffA);
            PG8_BAR; PG8_WAIT_L(0); PG8_MMA(1, 0, At, B0); PG8_BAR; PG8_SCHED;
            PG8_STAGE(PG8_SB(1, 1), b3 + hstepB, voffB);
            PG8_WAIT_V(6); PG8_BAR; PG8_MMA(1, 1, At, B1); PG8_BAR;
            }
        }
        if constexpr (F8 || F4) {
#pragma unroll
            for (int a_ = 0; a_ < 2; ++a_) asm volatile("s_nop 15\n\ts_nop 7" : "+v"(acc[a_][0][0][0]), "+v"(acc[a_][0][0][1]), "+v"(acc[a_][0][1][0]), "+v"(acc[a_][0][1][1]), "+v"(acc[a_][0][2][0]), "+v"(acc[a_][0][2][1]), "+v"(acc[a_][0][3][0]), "+v"(acc[a_][0][3][1]),
                "+v"(acc[a_][1][0][0]), "+v"(acc[a_][1][0][1]), "+v"(acc[a_][1][1][0]), "+v"(acc[a_][1][1][1]), "+v"(acc[a_][1][2][0]), "+v"(acc[a_][1][2][1]), "+v"(acc[a_][1][3][0]), "+v"(acc[a_][1][3][1]));
        }
        if constexpr (ALIGN_EPI) { if (wr == 0) PG8_BAR; }
        bool chain_keep = false;
        if constexpr (Epi::CHAIN) { if (cur.br + 1 == Epi::NBR) E(acc, cur, wr, wc, fr, fq); E.rescale(acc, cur, wr, wc, fr, fq); chain_keep = true; }
        if constexpr (!Epi::AFTER_DRAIN && !Epi::CHAIN) { E(acc, cur, wr, wc, fr, fq); S.done(cur); }
        if (!has_next) break;
        if (!chain_keep) {
#pragma unroll
        for (int a = 0; a < 2; ++a)
#pragma unroll
            for (int b = 0; b < 2; ++b)
#pragma unroll
                for (int m = 0; m < 4; ++m)
#pragma unroll
                    for (int n = 0; n < 2; ++n) acc[a][b][m][n] = (f32x4){0.f, 0.f, 0.f, 0.f};
        }
        cur = nxt; cA = nA; cB = nB; ++ui;
        if constexpr (ALIGN_EPI) { if (wr == 1) PG8_BAR; }
    }
    PG8_WAIT_V(0);
    if constexpr (!ALIGN_EPI) { if (wr == 0) PG8_BAR; }
    PG8_BAR;
    if constexpr (Epi::AFTER_DRAIN) { E.fused(acc, cur, wr, wc, fr, fq, lds, wid, lane); S.done(cur); }
#undef PG8_SA
#undef PG8_SB
#undef PG8_STAGE
#undef PG8_LDA
#undef PG8_LDB
#undef PG8_MMA
#undef PG8_WAIT_V
#undef PG8_WAIT_L
#undef PG8_BAR
#undef PG8_SCHED
}
}

constexpr int S = 16384, DM = 2048, NL = 2, NWAVES = 8;
constexpr int HW = 3584;
constexpr int H_AQ = 0, H_AK = 512, H_BQ = 1024, H_BK = 1536, H_CQ = 1664, H_CK = 2176, H_DCQ = 2688, H_DCKV = 3200, H_DKR = 3456;
constexpr int VT_A = 0, VT_B = 512, VT_C = 640, VT_ROWS = 1280;
constexpr int WIN_ROWS = HW + VT_ROWS;
constexpr float LOG2E = 1.4426950408889634f;
constexpr float DN_ALPHA = 1.4142135623730951f;
constexpr size_t MiB = 1u << 20;
constexpr size_t WS_CTL = 0, CTL_ZERO_BYTES = 1 * MiB;
constexpr size_t WS_W = 1 * MiB, WL_STRIDE = 78 * MiB;
constexpr size_t W_IN = 0, W_G = 19 * MiB, W_BR = 51 * MiB, W_O = 59 * MiB, W_UQ = 67 * MiB, W_UKV = 68 * MiB, W_PQ = 69 * MiB, W_SK = 77 * MiB;
constexpr size_t WS_UB = 157 * MiB, WS_VB = 221 * MiB;
constexpr size_t WS_MLIST = 189 * MiB;
constexpr int MCAP_F = 16384, MCAP = MCAP_F + 4096;
constexpr size_t WS_PART = 926 * MiB;
constexpr size_t WS_CS = 245 * MiB;
constexpr size_t WS_XB8 = 253 * MiB;
constexpr size_t WS_XB = 285 * MiB;
constexpr size_t WS_H = 349 * MiB;
constexpr size_t WS_VT = 461 * MiB;
constexpr size_t WS_GT = 501 * MiB;
constexpr size_t WS_O8 = 629 * MiB;
constexpr size_t WS_XB4 = 661 * MiB;
constexpr size_t WS_O = 757 * MiB;
constexpr size_t WS_QD = 821 * MiB, WS_KD = 845 * MiB, WS_VDT = 869 * MiB, WS_CQN = 885 * MiB, WS_CKVN = 901 * MiB;
constexpr size_t WS_SELE = 909 * MiB, WS_SELG = 917 * MiB, WS_KMEAN = 925 * MiB, WS_TPMAX = 925 * MiB + 512 * 1024, WS_OC2 = 994 * MiB, WS_END = 1010 * MiB;
constexpr int CW_BAR = 4096, CW_Q = 16384, CW_CHK = 20480, CW_MOBA = 24576;
constexpr int RING_BYTES = 131072;
constexpr int MISC_OFF = RING_BYTES;
constexpr int TR_OFF = 0;
constexpr int LDS_BYTES = 147456;

constexpr float U_SCALE = 90.0f, V_SCALE = 4.0f;
#define XB_TMO      128
#define XB_XCNT(j)  (256  + 64 * (j))
#define XB_XSUB(j)  (1280 + 64 * (j))
#define XB_XGEN(j)  (2304 + 64 * (j))
#define XB_TOP      3328
#define XB_TOPGEN   3392
#define XCD_BAR_WORDS 3456
#define XB_SPIN_CAP (1u << 18)

__device__ __forceinline__ unsigned xb_ld(unsigned* p)              { return __hip_atomic_load(p, __ATOMIC_RELAXED, __HIP_MEMORY_SCOPE_AGENT); }
__device__ __forceinline__ unsigned xb_add(unsigned* p, unsigned v) { return __hip_atomic_fetch_add(p, v, __ATOMIC_RELAXED, __HIP_MEMORY_SCOPE_AGENT); }
__device__ __forceinline__ unsigned xb_xcc_id() { return (unsigned)__builtin_amdgcn_s_getreg((3 << 11) | 20) & 0xFu; }
#define XB_SPIN(cond, bar) do { unsigned _sp = 0; while (cond) { __builtin_amdgcn_s_sleep(1); \
    if ((++_sp & 255u) == 0u) { if (xb_ld(&(bar)[XB_TMO])) break; if (_sp > XB_SPIN_CAP) { atomicAdd(&(bar)[XB_TMO], 1u); break; } } } } while (0)

struct XcdBarrier {
    unsigned* bar; unsigned x;
    volatile LAS unsigned* st;
};

__device__ __forceinline__ XcdBarrier xcd_barrier_post(unsigned* bar, volatile LAS unsigned* st) {
    XcdBarrier b; b.bar = bar; b.x = xb_xcc_id(); b.st = st;
    if (threadIdx.x == 0) (void)xb_add(&bar[XB_XCNT(b.x)], 1u);
    return b;
}
__device__ __forceinline__ void xcd_barrier_complete(unsigned* bar, unsigned x, unsigned& nloc, unsigned& nx) {
    const unsigned G = gridDim.x * gridDim.y * gridDim.z;
    unsigned sum, cnt, mine, sp = 0u;
    for (;;) {
        sum = 0u; cnt = 0u; mine = 0u;
#pragma unroll
        for (unsigned j = 0; j < 16; ++j) { const unsigned c = xb_ld(&bar[XB_XCNT(j)]); sum += c; cnt += (c > 0u) ? 1u : 0u; mine = (j == x) ? c : mine; }
        if (sum == G) break;
        __builtin_amdgcn_s_sleep(1);
        if ((++sp & 255u) == 0u) { if (xb_ld(&bar[XB_TMO])) break; if (sp > XB_SPIN_CAP) { atomicAdd(&bar[XB_TMO], 1u); break; } }
    }
    nloc = mine > 0u ? mine : 1u; nx = cnt > 0u ? cnt : 1u;
}

__device__ __forceinline__ void xcd_barrier(const XcdBarrier& b) {
    asm volatile("s_waitcnt vmcnt(0)" ::: "memory");
    __syncthreads();
    if (threadIdx.x == 0) {
        unsigned* bar = b.bar;
        __builtin_amdgcn_s_waitcnt(0);
        unsigned nloc = b.st[0], nx = b.st[1];
        if (nloc == 0u) { xcd_barrier_complete(bar, b.x, nloc, nx); b.st[0] = nloc; b.st[1] = nx; }
        const unsigned old = xb_add(&bar[XB_XSUB(b.x)], 1u);
        const unsigned gen = old / nloc;
        if (old + 1u == (gen + 1u) * nloc) {
            __builtin_amdgcn_fence(__ATOMIC_RELEASE, "agent");
            asm volatile("s_waitcnt vmcnt(0)" ::: "memory");
            const unsigned og = xb_add(&bar[XB_TOP], 1u);
            const unsigned tg = og / nx;
            if (og + 1u == (tg + 1u) * nx) xb_add(&bar[XB_TOPGEN], 1u);
            else XB_SPIN(xb_ld(&bar[XB_TOPGEN]) == tg, bar);
            __builtin_amdgcn_fence(__ATOMIC_ACQUIRE, "agent");
            xb_add(&bar[XB_XGEN(b.x)], 1u);
            asm volatile("s_waitcnt vmcnt(0)" ::: "memory");
        } else {
            XB_SPIN(xb_ld(&bar[XB_XGEN(b.x)]) == gen, bar);
            __builtin_amdgcn_fence(__ATOMIC_ACQUIRE, "agent");
            asm volatile("s_waitcnt vmcnt(0)" ::: "memory");
        }
    }
    __syncthreads();
}

struct Args { const float* in[26]; float* out; unsigned char* ws; int ph_lo, ph_hi; };
struct Frame {
    LAS unsigned char* lds; volatile LAS unsigned* MISC;
    int tid, lane, wave, vcu, G;
    unsigned char* ws; float* out;
};
DI bf16_t* wsb(const Frame& F, size_t off) { return (bf16_t*)(F.ws + off); }

DI void transpose_item(const float* W, int ldw, bf16_t* WT, int ldt, int k0, int n0, int drow0, LAS float* scr, int lane) {
#pragma unroll 8
    for (int i = 0; i < 32; ++i) { const int kk = 2 * i + (lane >> 5); scr[kk * 33 + (lane & 31)] = W[(size_t)(k0 + kk) * ldw + n0 + (lane & 31)]; }
    asm volatile("s_waitcnt lgkmcnt(0)" ::: "memory");
    const int c = lane & 7;
#pragma unroll
    for (int j = 0; j < 4; ++j) { const int n = (lane >> 3) + 8 * j; const LAS float* s = scr + (8 * c) * 33 + n;
        u32x4 o; o.x = cvtpk(s[0 * 33], s[1 * 33]); o.y = cvtpk(s[2 * 33], s[3 * 33]); o.z = cvtpk(s[4 * 33], s[5 * 33]); o.w = cvtpk(s[6 * 33], s[7 * 33]);
        *(u32x4*)(WT + (size_t)(drow0 + n) * ldt + k0 + 8 * c) = o; }
    asm volatile("s_waitcnt lgkmcnt(0)" ::: "memory");
}
DI void transpose_item8(const float* W, int ldw, unsigned char* WT, int ldt, int k0, int n0, int drow0, LAS float* scr, int lane, float scale) {
#pragma unroll 8
    for (int i = 0; i < 32; ++i) { const int kk = 2 * i + (lane >> 5); scr[kk * 33 + (lane & 31)] = W[(size_t)(k0 + kk) * ldw + n0 + (lane & 31)]; }
    asm volatile("s_waitcnt lgkmcnt(0)" ::: "memory");
    const int c = lane & 7;
#pragma unroll
    for (int j = 0; j < 4; ++j) { const int n = (lane >> 3) + 8 * j; const LAS float* s = scr + (8 * c) * 33 + n;
        int lo = __builtin_amdgcn_cvt_pk_fp8_f32(s[0 * 33] * scale, s[1 * 33] * scale, 0, false); lo = __builtin_amdgcn_cvt_pk_fp8_f32(s[2 * 33] * scale, s[3 * 33] * scale, lo, true);
        int hi = __builtin_amdgcn_cvt_pk_fp8_f32(s[4 * 33] * scale, s[5 * 33] * scale, 0, false); hi = __builtin_amdgcn_cvt_pk_fp8_f32(s[6 * 33] * scale, s[7 * 33] * scale, hi, true);
        *(u32x2*)(WT + (size_t)(drow0 + n) * ldt + k0 + 8 * c) = (u32x2){(unsigned)lo, (unsigned)hi}; }
    asm volatile("s_waitcnt lgkmcnt(0)" ::: "memory");
}
DI void transpose_item4(const float* W, int ldw, unsigned char* WT, int ldt, int k0, int n0, int drow0, LAS float* scr, int lane, float scale) {
#pragma unroll 8
    for (int i = 0; i < 32; ++i) { const int kk = 2 * i + (lane >> 5); scr[kk * 33 + (lane & 31)] = W[(size_t)(k0 + kk) * ldw + n0 + (lane & 31)]; }
    asm volatile("s_waitcnt lgkmcnt(0)" ::: "memory");
    const int c = lane & 7;
#pragma unroll
    for (int j = 0; j < 4; ++j) { const int n = (lane >> 3) + 8 * j; const LAS float* s = scr + (8 * c) * 33 + n;
        unsigned d = 0u;
        d = __builtin_amdgcn_cvt_scalef32_pk_fp4_f32(d, s[0 * 33] * scale, s[1 * 33] * scale, 1.0f, 0); d = __builtin_amdgcn_cvt_scalef32_pk_fp4_f32(d, s[2 * 33] * scale, s[3 * 33] * scale, 1.0f, 1);
        d = __builtin_amdgcn_cvt_scalef32_pk_fp4_f32(d, s[4 * 33] * scale, s[5 * 33] * scale, 1.0f, 2); d = __builtin_amdgcn_cvt_scalef32_pk_fp4_f32(d, s[6 * 33] * scale, s[7 * 33] * scale, 1.0f, 3);
        *(unsigned*)(WT + (size_t)(drow0 + n) * ldt + (k0 >> 1) + 4 * c) = d; }
    asm volatile("s_waitcnt lgkmcnt(0)" ::: "memory");
}
DI int win_map(int c) {
    if (c < 1024) return c;
    if (c < 1536) return HW + VT_A + (c - 1024);
    if (c < 2176) return H_BQ + (c - 1536);
    if (c < 2304) return HW + VT_B + (c - 2176);
    if (c < 3328) return H_CQ + (c - 2304);
    if (c < 3840) return HW + VT_C + (c - 3328);
    return H_DCQ + (c - 3840);
}
template <int MAP, bool F8 = false, bool F4 = false> DI void transpose_matrix(const Frame& F, const float* W, int K, int N, bf16_t* WT, int roff) {
    LAS float* scr = (LAS float*)(F.lds + TR_OFF + F.wave * 8704);
    const int gw = F.vcu * NWAVES + F.wave, NGW = F.G * NWAVES, nblk = N / 32, items = (K / 64) * nblk;
    int lane = F.lane; asm volatile("" : "+v"(lane));
    for (int it = gw; it < items; it += NGW) {
        const int kb = it / nblk, nb = it % nblk, n0 = 32 * nb;
        int drow = roff + n0;
        if (MAP == 1) drow = win_map(n0);
        if (MAP == 2) { const int h = n0 >> 8, j = n0 & 255; drow = (j < 128) ? h * 128 + j : 512 + h * 128 + (j - 128); }
        if (F4) transpose_item4(W, N, (unsigned char*)WT, K / 2, 64 * kb, n0, drow, scr, lane, 64.0f); else if (F8) transpose_item8(W, N, (unsigned char*)WT, K, 64 * kb, n0, drow, scr, lane, 64.0f); else transpose_item(W, N, WT, K, 64 * kb, n0, drow, scr, lane);
    }
}
DI void convert_bf16(const Frame& F, const float* src, bf16_t* dst, size_t n) {
    const size_t nth = (size_t)F.G * 512, t0 = (size_t)F.vcu * 512 + F.tid;
    for (size_t i = t0; i < n / 8; i += nth) { const f32x4 a = *(const f32x4*)(src + 8 * i), b = *(const f32x4*)(src + 8 * i + 4);
        u32x4 w; w.x = cvtpk(a[0], a[1]); w.y = cvtpk(a[2], a[3]); w.z = cvtpk(b[0], b[1]); w.w = cvtpk(b[2], b[3]); *(u32x4*)(dst + 8 * i) = w; }
}

typedef float v16f __attribute__((ext_vector_type(16)));
typedef float v32f __attribute__((ext_vector_type(32)));
typedef unsigned v6u __attribute__((ext_vector_type(6)));
DI void convert_fp6(const Frame& F, const float* src, unsigned char* dst, int rows, float scale) {
    const size_t nth = (size_t)F.G * 512, t0 = (size_t)F.vcu * 512 + F.tid;
    for (size_t i = t0; i < (size_t)rows * 64; i += nth) {
        const size_t row = i >> 6; const int l = (int)(i & 63);
        const float* p = src + row * 2048 + 32 * l;
        v16f a, b;
#pragma unroll
        for (int q = 0; q < 8; ++q) { const f32x4 x = *(const f32x4*)(p + 4 * q) * scale;
            a[2 * q] = x[0]; b[2 * q] = x[1]; a[2 * q + 1] = x[2]; b[2 * q + 1] = x[3]; }
        const v6u w = __builtin_amdgcn_cvt_scalef32_2xpk16_fp6_f32(a, b, 1.0f);
        *(u32x4*)(dst + row * 1536 + 16 * l) = (u32x4){w[0], w[1], w[2], w[3]};
        *(u32x2*)(dst + row * 1536 + 1024 + 8 * l) = (u32x2){w[4], w[5]};
    }
}

DI void convert_fp4(const Frame& F, const float* src, unsigned char* dst, int rows, float scale) {
    const size_t nth = (size_t)F.G * 512, t0 = (size_t)F.vcu * 512 + F.tid;
    for (size_t i = t0; i < (size_t)rows * 64; i += nth) {
        const float* p = src + i * 32;
        u32x4 w = (u32x4){0u, 0u, 0u, 0u};
#define FP4_PK(q) { const f32x4 x = *(const f32x4*)(p + 4 * (q)) * scale; unsigned d = w[(q) >> 1];         \
            d = __builtin_amdgcn_cvt_scalef32_pk_fp4_f32(d, x[0], x[1], 1.0f, (2 * (q)) & 3); d = __builtin_amdgcn_cvt_scalef32_pk_fp4_f32(d, x[2], x[3], 1.0f, (2 * (q) + 1) & 3); w[(q) >> 1] = d; }
        FP4_PK(0) FP4_PK(1) FP4_PK(2) FP4_PK(3) FP4_PK(4) FP4_PK(5) FP4_PK(6) FP4_PK(7)
#undef FP4_PK
        *(u32x4*)(dst + i * 16) = w;
    }
}

DI void convert_weights(const Frame& F, const Args& a, int l_lo, int l_hi) {
    for (int l = l_lo; l < l_hi; ++l) {
        unsigned char* wl = F.ws + WS_W + (size_t)l * WL_STRIDE;
        transpose_matrix<1, true>(F, a.in[3] + (size_t)l * DM * 4672, DM, 4672, (bf16_t*)(wl + W_IN), 0);
        for (int n = 0; n < 4; ++n) transpose_matrix<0, false, true>(F, a.in[4] + ((size_t)l * 4 + n) * DM * DM, DM, DM, (bf16_t*)(wl + W_G), n * DM);
        for (int n = 0; n < 4; ++n) transpose_matrix<0, true>(F, a.in[6] + ((size_t)l * 4 + n) * 512 * DM, 512, DM, (bf16_t*)(wl + W_BR) + (size_t)n * DM * 512, 0);
        transpose_matrix<0, true>(F, a.in[7] + (size_t)l * DM * DM, DM, DM, (bf16_t*)(wl + W_O), 0);
        transpose_matrix<0>(F, a.in[16] + (size_t)l * 512 * 768, 512, 768, (bf16_t*)(wl + W_UQ), 0);
        transpose_matrix<2>(F, a.in[17] + (size_t)l * 256 * 1024, 256, 1024, (bf16_t*)(wl + W_UKV), 0);
        transpose_matrix<0>(F, a.in[20] + (size_t)l * DM * DM, DM, DM, (bf16_t*)(wl + W_PQ), 0);
        convert_bf16(F, a.in[21] + (size_t)l * 8 * 2 * 128 * 128, (bf16_t*)(wl + W_SK), (size_t)8 * 2 * 128 * 128);
    }
}
DI void build_rope_table(const Frame& F, const Args& a) {
    f32x2* CS = (f32x2*)(F.ws + WS_CS); const int* pos = (const int*)a.in[1];
    for (size_t i = (size_t)F.vcu * 512 + F.tid; i < (size_t)S * 32; i += (size_t)F.G * 512) {
        const int j = (int)(i & 31); const float inv = exp2f(-(float)j * (13.287712379549449f / 32.0f));
        const float ang = (float)pos[i >> 5] * inv;
        CS[i] = (f32x2){cosf(ang), sinf(ang)};
    }
}
DI void phase_prologue(const Frame& F, const Args& a) {
    convert_weights(F, a, 0, 1);
    convert_bf16(F, a.in[0], wsb(F, WS_XB), (size_t)S * DM);
    {
        const size_t nth = (size_t)F.G * 512, t0 = (size_t)F.vcu * 512 + F.tid; const float* src = a.in[0]; unsigned char* dst = F.ws + WS_XB4;
        for (size_t i = t0; i < (size_t)S * DM / 8; i += nth) { const f32x4 x = *(const f32x4*)(src + 8 * i) * 2.0f, y = *(const f32x4*)(src + 8 * i + 4) * 2.0f;
            unsigned d = 0u; d = __builtin_amdgcn_cvt_scalef32_pk_fp4_f32(d, x[0], x[1], 1.0f, 0); d = __builtin_amdgcn_cvt_scalef32_pk_fp4_f32(d, x[2], x[3], 1.0f, 1); d = __builtin_amdgcn_cvt_scalef32_pk_fp4_f32(d, y[0], y[1], 1.0f, 2); d = __builtin_amdgcn_cvt_scalef32_pk_fp4_f32(d, y[2], y[3], 1.0f, 3);
            *(unsigned*)(dst + 4 * i) = d; }
    }
    {
        const size_t nth = (size_t)F.G * 512, t0 = (size_t)F.vcu * 512 + F.tid; const float* src = a.in[0]; unsigned char* dst = F.ws + WS_XB8;
        for (size_t i = t0; i < (size_t)S * DM / 8; i += nth) { const f32x4 x = *(const f32x4*)(src + 8 * i), y = *(const f32x4*)(src + 8 * i + 4);
            int lo = __builtin_amdgcn_cvt_pk_fp8_f32(x[0], x[1], 0, false); lo = __builtin_amdgcn_cvt_pk_fp8_f32(x[2], x[3], lo, true); int hi = __builtin_amdgcn_cvt_pk_fp8_f32(y[0], y[1], 0, false); hi = __builtin_amdgcn_cvt_pk_fp8_f32(y[2], y[3], hi, true);
            *(u32x2*)(dst + 8 * i) = (u32x2){(unsigned)lo, (unsigned)hi}; }
    }
    build_rope_table(F, a);
}

DI float rope64(float x, int lane, const f32x2* cs_row) {
    const float other = xhalf(x);
    const f32x2 cs = cs_row[lane & 31];
    return (lane < 32) ? x * cs.x - other * cs.y : other * cs.y + x * cs.x;
}
DI void phase_prep(const Frame& F, const Args& a, int layer) {
    const bf16_t* H = wsb(F, WS_H); bf16_t* CQN = wsb(F, WS_CQN); bf16_t* CKVN = wsb(F, WS_CKVN); bf16_t* KD = wsb(F, WS_KD);
    const float* gq = a.in[14] + layer * 512; const float* gkv = a.in[15] + layer * 256; const int* pos = (const int*)a.in[1];
    const int gw = F.vcu * NWAVES + F.wave, NGW = F.G * NWAVES, lane = F.lane;
    for (int t = gw; t < S; t += NGW) {
        const bf16_t* hr = H + (size_t)t * HW;
        const u32x4 q = *(const u32x4*)(hr + H_DCQ + 8 * lane);
        float v[8] = {bf_lo(q.x), bf_hi(q.x), bf_lo(q.y), bf_hi(q.y), bf_lo(q.z), bf_hi(q.z), bf_lo(q.w), bf_hi(q.w)};
        float ss = 0.f;
#pragma unroll
        for (int e = 0; e < 8; ++e) ss += v[e] * v[e];
        const float rq = rsqrtf(wave_sum(ss) * (1.0f / 512.0f) + 1e-6f);
        const f32x4 g0 = *(const f32x4*)(gq + 8 * lane), g1 = *(const f32x4*)(gq + 8 * lane + 4);
        u32x4 w; w.x = cvtpk(v[0] * rq * g0[0], v[1] * rq * g0[1]); w.y = cvtpk(v[2] * rq * g0[2], v[3] * rq * g0[3]); w.z = cvtpk(v[4] * rq * g1[0], v[5] * rq * g1[1]); w.w = cvtpk(v[6] * rq * g1[2], v[7] * rq * g1[3]);
        *(u32x4*)(CQN + (size_t)t * 512 + 8 * lane) = w;
        const u32x2 k2 = *(const u32x2*)(hr + H_DCKV + 4 * lane);
        const float u0 = bf_lo(k2.x), u1 = bf_hi(k2.x), u2 = bf_lo(k2.y), u3 = bf_hi(k2.y);
        const float rk = rsqrtf(wave_sum(u0 * u0 + u1 * u1 + u2 * u2 + u3 * u3) * (1.0f / 256.0f) + 1e-6f);
        const f32x4 gk = *(const f32x4*)(gkv + 4 * lane);
        u32x2 w2; w2.x = cvtpk(u0 * rk * gk[0], u1 * rk * gk[1]); w2.y = cvtpk(u2 * rk * gk[2], u3 * rk * gk[3]);
        *(u32x2*)(CKVN + (size_t)t * 256 + 4 * lane) = w2;
        const float kr = bf1(hr[H_DKR + lane]);
        const float ro = rope64(kr, lane, (const f32x2*)(F.ws + WS_CS) + (size_t)t * 32);
        const bf16_t rb = (bf16_t)(cvtpk(ro, 0.f) & 0xffffu);
#pragma unroll
        for (int h = 0; h < 4; ++h) KD[(size_t)t * 768 + h * 192 + 128 + lane] = rb;
    }
    for (int t = gw; t < S / 64; t += NGW) { int pm = pos[t * 64 + lane];
#pragma unroll
        for (int o = 1; o < 64; o <<= 1) { const int other = __shfl_xor(pm, o); pm = other > pm ? other : pm; }
        if (lane == 0) ((int*)(F.ws + WS_TPMAX))[t] = pm; }
    float* KM = (float*)(F.ws + WS_KMEAN);
    for (int it = gw; it < 64 * 8; it += NGW) {
        const int n = it >> 3, cc = it & 7; const bf16_t* p = H + (size_t)(n * 256) * HW + H_AK + cc * 64 + lane;
        float s0 = 0.f, s1 = 0.f, s2 = 0.f, s3 = 0.f;
        for (int r = 0; r < 256; r += 4) { s0 += bf1(p[(size_t)r * HW]); s1 += bf1(p[(size_t)(r + 1) * HW]); s2 += bf1(p[(size_t)(r + 2) * HW]); s3 += bf1(p[(size_t)(r + 3) * HW]); }
        KM[n * 512 + cc * 64 + lane] = ((s0 + s1) + (s2 + s3)) * (1.0f / 256.0f);
    }
}
DI void phase_ropeq(const Frame& F, const Args& a) {
    bf16_t* QD = wsb(F, WS_QD); const int* pos = (const int*)a.in[1];
    const int gw = F.vcu * NWAVES + F.wave, NGW = F.G * NWAVES, lane = F.lane;
    for (int t = gw; t < S; t += NGW) {
        const f32x2* cs = (const f32x2*)(F.ws + WS_CS) + (size_t)t * 32;
#pragma unroll
        for (int h = 0; h < 4; ++h) { bf16_t* p = QD + (size_t)t * 768 + h * 192 + 128 + lane; const float ro = rope64(bf1(*p), lane, cs); *p = (bf16_t)(cvtpk(ro, 0.f) & 0xffffu); }
    }
}
DI void phase_moba_select(const Frame& F, const Args& a, int layer) {
    const bf16_t* H = wsb(F, WS_H); const float* KM = (const float*)(F.ws + WS_KMEAN); const int* pos = (const int*)a.in[1]; const int* TP = (const int*)(F.ws + WS_TPMAX);
    unsigned* cnt = (unsigned*)(F.ws + WS_CTL) + CW_MOBA + layer * 1024; int* lists = (int*)(F.ws + WS_MLIST);
    const int gw = F.vcu * NWAVES + F.wave, NGW = F.G * NWAVES;
    int lane = F.lane; asm volatile("" : "+v"(lane));
    const int r = lane & 31, hi = lane >> 5;
    for (int it = gw; it < (S / 32) * 4; it += NGW) {
        const int h = it & 3, q0 = (it >> 2) * 32, q = q0 + r, own = q0 >> 8;
        if (own == 0) continue;
        const bf16_t* qp = H + (size_t)q * HW + H_AQ + h * 128 + hi * 8;
        const bool two = own > 32;
        f32x16 g0, g1;
#pragma unroll
        for (int i = 0; i < 16; ++i) { g0[i] = 0.f; g1[i] = 0.f; }
#pragma unroll
        for (int kk = 0; kk < 8; ++kk) {
            const bf16x8 qf = *(const bf16x8*)(qp + kk * 16);
#pragma unroll
            for (int rb = 0; rb < 2; ++rb) {
                if (rb == 1 && !two) continue;
                const float* kp = KM + (size_t)(rb * 32 + r) * 512 + h * 128 + kk * 16 + hi * 8;
                const f32x4 x = *(const f32x4*)kp, y = *(const f32x4*)(kp + 4);
                u32x4 wh, wl;
                wh.x = cvtpk(x[0], x[1]); wh.y = cvtpk(x[2], x[3]); wh.z = cvtpk(y[0], y[1]); wh.w = cvtpk(y[2], y[3]);
                wl.x = cvtpk(x[0] - bf_lo(wh.x), x[1] - bf_hi(wh.x)); wl.y = cvtpk(x[2] - bf_lo(wh.y), x[3] - bf_hi(wh.y)); wl.z = cvtpk(y[0] - bf_lo(wh.z), y[1] - bf_hi(wh.z)); wl.w = cvtpk(y[2] - bf_lo(wh.w), y[3] - bf_hi(wh.w));
                if (rb == 0) { g0 = __builtin_amdgcn_mfma_f32_32x32x16_bf16(__builtin_bit_cast(bf16x8, wh), qf, g0, 0, 0, 0); g0 = __builtin_amdgcn_mfma_f32_32x32x16_bf16(__builtin_bit_cast(bf16x8, wl), qf, g0, 0, 0, 0); }
                else { g1 = __builtin_amdgcn_mfma_f32_32x32x16_bf16(__builtin_bit_cast(bf16x8, wh), qf, g1, 0, 0, 0); g1 = __builtin_amdgcn_mfma_f32_32x32x16_bf16(__builtin_bit_cast(bf16x8, wl), qf, g1, 0, 0, 0); }
            }
        }
        float v1 = -INFINITY, v2 = -INFINITY, v3 = -INFINITY; int i1 = -1, i2 = -1, i3 = -1;
#pragma unroll
        for (int rb = 0; rb < 2; ++rb)
#pragma unroll
            for (int i = 0; i < 16; ++i) {
                const int n = rb * 32 + (i & 3) + 8 * (i >> 2) + 4 * hi; const float g = (rb == 0) ? g0[i] : g1[i];
                if (n < own) {
                    if (g > v1) { v3 = v2; i3 = i2; v2 = v1; i2 = i1; v1 = g; i1 = n; }
                    else if (g > v2) { v3 = v2; i3 = i2; v2 = g; i2 = n; }
                    else if (g > v3) { v3 = g; i3 = n; }
                }
            }
        const float p1 = xhalf(v1), p2 = xhalf(v2), p3 = xhalf(v3);
        const int j1 = __shfl_xor(i1, 32), j2 = __shfl_xor(i2, 32), j3 = __shfl_xor(i3, 32);
#pragma unroll
        for (int c = 0; c < 3; ++c) { const float g = c == 0 ? p1 : (c == 1 ? p2 : p3); const int n = c == 0 ? j1 : (c == 1 ? j2 : j3);
            if (n >= 0) {
                if (g > v1 || (g == v1 && n < i1)) { v3 = v2; i3 = i2; v2 = v1; i2 = i1; v1 = g; i1 = n; }
                else if (g > v2 || (g == v2 && n < i2)) { v3 = v2; i3 = i2; v2 = g; i2 = n; }
                else if (g > v3 || (g == v3 && n < i3)) { v3 = g; i3 = n; }
            } }
        if (hi == 0) {
            const int pq = pos[q];
#pragma unroll
            for (int sl = 0; sl < 3; ++sl) { const int n = sl == 0 ? i1 : (sl == 1 ? i2 : i3);
                if (n >= 0) { const int bm = max(max(TP[4 * n], TP[4 * n + 1]), max(TP[4 * n + 2], TP[4 * n + 3])); const int near = (pq - bm < 790) ? 1 : 0;
                    const unsigned p = atomicAdd(cnt + near * 256 + h * 64 + n, 1u);
                    if (p < (unsigned)(near ? MCAP - MCAP_F : MCAP_F)) lists[(size_t)(h * 64 + n) * MCAP + (near ? MCAP_F : 0) + p] = q * 4 + sl; } }
        }
    }
}
DI void phase_mixer_combine(const Frame& F, const Args& a, int layer) {
    const unsigned char* PART = F.ws + WS_PART; bf16_t* OA = wsb(F, WS_O);
    const int gw = F.vcu * NWAVES + F.wave, NGW = F.G * NWAVES, lane = F.lane;
    for (size_t i = (size_t)F.vcu * 512 + F.tid; i < (size_t)2 * S * 64; i += (size_t)F.G * 512) {
        const size_t br = (i >= (size_t)S * 64) ? 3 : 1, e = (i - (br == 3 ? (size_t)S * 64 : 0)) * 8;
        const u32x4 w = *(const u32x4*)(wsb(F, WS_O) + br * S * 512 + e);
        int lo = __builtin_amdgcn_cvt_pk_fp8_f32(bf_lo(w.x) * 8.0f, bf_hi(w.x) * 8.0f, 0, false); lo = __builtin_amdgcn_cvt_pk_fp8_f32(bf_lo(w.y) * 8.0f, bf_hi(w.y) * 8.0f, lo, true);
        int hi = __builtin_amdgcn_cvt_pk_fp8_f32(bf_lo(w.z) * 8.0f, bf_hi(w.z) * 8.0f, 0, false); hi = __builtin_amdgcn_cvt_pk_fp8_f32(bf_lo(w.w) * 8.0f, bf_hi(w.w) * 8.0f, hi, true);
        *(u32x2*)(F.ws + WS_O8 + br * S * 512 + e) = (u32x2){(unsigned)lo, (unsigned)hi};
    }
    for (int it = gw; it < S * 4; it += NGW) {
        const int q = it >> 2, h = it & 3, nsel = (q >> 8) < 3 ? (q >> 8) : 3;
        const unsigned char* pp = PART + ((size_t)q * 16 + h * 4) * 272;
        float mm[4], ll[4]; unsigned ov[4];
#pragma unroll
        for (int s = 0; s < 4; ++s) { const bool use = (s == 3) || (s < nsel); const f32x2 ml = *(const f32x2*)(pp + s * 272 + 256); mm[s] = use ? ml.x : -1e30f; ll[s] = use ? ml.y : 0.f; ov[s] = *(const unsigned*)(pp + s * 272 + lane * 4); }
        const float M = fmaxf(fmaxf(mm[0], mm[1]), fmaxf(mm[2], mm[3]));
        float wsum = 0.f, x0 = 0.f, x1 = 0.f;
#pragma unroll
        for (int s = 0; s < 4; ++s) { const float w = ll[s] * ex2(mm[s] - M); wsum += w; x0 += w * bf_lo(ov[s]); x1 += w * bf_hi(ov[s]); }
        const float inv = 1.0f / wsum;
        *(unsigned*)(OA + (size_t)q * 512 + h * 128 + lane * 2) = cvtpk(x0 * inv, x1 * inv);
        *(unsigned short*)(F.ws + WS_O8 + (size_t)q * 512 + h * 128 + lane * 2) = (unsigned short)__builtin_amdgcn_cvt_pk_fp8_f32(x0 * inv * 8.0f, x1 * inv * 8.0f, 0, false);
    }
    float d1 = 0.f, d2 = 0.f;
    for (int i = 0; i < 64; ++i) { d1 += a.in[9][layer * 64 + i] * a.in[10][layer * 64 + i]; d2 += a.in[11][layer * 64 + i] * a.in[12][layer * 64 + i]; }
    const float lambda_init = 0.8f - 0.6f * expf(-0.3f * (float)layer), lam = expf(d1) - expf(d2) + lambda_init;
    bf16_t* OC = wsb(F, WS_O) + (size_t)2 * S * 512; const bf16_t* OC2 = wsb(F, WS_OC2);
    const f32x2 sg = *(const f32x2*)(a.in[13] + layer * 128 + lane * 2);
    for (int it = gw; it < S * 4; it += NGW) {
        const size_t off = (size_t)(it >> 2) * 512 + (it & 3) * 128 + lane * 2;
        const unsigned w1 = *(const unsigned*)(OC + off), w2 = *(const unsigned*)(OC2 + off);
        const float x0 = bf_lo(w1) - lam * bf_lo(w2), x1 = bf_hi(w1) - lam * bf_hi(w2);
        const float rn = rsqrtf(wave_sum(x0 * x0 + x1 * x1) * (1.0f / 128.0f) + 1e-6f) * (1.0f - lambda_init);
        *(unsigned*)(OC + off) = cvtpk(x0 * rn * sg.x, x1 * rn * sg.y);
        *(unsigned short*)(F.ws + WS_O8 + (size_t)2 * S * 512 + off) = (unsigned short)__builtin_amdgcn_cvt_pk_fp8_f32(x0 * rn * sg.x * 8.0f, x1 * rn * sg.y * 8.0f, 0, false);
    }
}
template <int NJ, int NE> DI void ln_store(float (&v)[NJ][NE], const float* g, const float* b, float* of, bf16_t* ob, int lane, unsigned char* o8 = nullptr, unsigned char* o4 = nullptr) {
    static_assert(NJ * NE == 32 && NE % 8 == 0, "row layout");
    float s = 0.f;
#pragma unroll
    for (int j = 0; j < NJ; ++j)
#pragma unroll
        for (int e = 0; e < NE; ++e) s += v[j][e];
    const float mean = wave_sum(s) * (1.0f / DM);
    float q = 0.f;
#pragma unroll
    for (int j = 0; j < NJ; ++j)
#pragma unroll
        for (int e = 0; e < NE; ++e) { v[j][e] -= mean; q += v[j][e] * v[j][e]; }
    const float rstd = rsqrtf(wave_sum(q) * (1.0f / DM) + 1e-5f);
#pragma unroll
    for (int j = 0; j < NJ; ++j)
#pragma unroll
        for (int e8 = 0; e8 < NE; e8 += 8) {
            const int c = (DM / NJ) * j + NE * lane + e8;
            const f32x4 g0 = *(const f32x4*)(g + c), g1 = *(const f32x4*)(g + c + 4), b0 = *(const f32x4*)(b + c), b1 = *(const f32x4*)(b + c + 4);
            f32x4 o0, o1;
#pragma unroll
            for (int e = 0; e < 4; ++e) { o0[e] = v[j][e8 + e] * rstd * g0[e] + b0[e]; o1[e] = v[j][e8 + 4 + e] * rstd * g1[e] + b1[e]; }
            if (of) { *(f32x4*)(of + c) = o0; *(f32x4*)(of + c + 4) = o1; }
            u32x4 w; w.x = cvtpk(o0[0], o0[1]); w.y = cvtpk(o0[2], o0[3]); w.z = cvtpk(o1[0], o1[1]); w.w = cvtpk(o1[2], o1[3]);
            *(u32x4*)(ob + c) = w;
            if (o8) { int lo = __builtin_amdgcn_cvt_pk_fp8_f32(o0[0], o0[1], 0, false); lo = __builtin_amdgcn_cvt_pk_fp8_f32(o0[2], o0[3], lo, true); int hi = __builtin_amdgcn_cvt_pk_fp8_f32(o1[0], o1[1], 0, false); hi = __builtin_amdgcn_cvt_pk_fp8_f32(o1[2], o1[3], hi, true);
                *(u32x2*)(o8 + c) = (u32x2){(unsigned)lo, (unsigned)hi}; }
            if (o4) { unsigned d = 0u; d = __builtin_amdgcn_cvt_scalef32_pk_fp4_f32(d, o0[0] * 2.0f, o0[1] * 2.0f, 1.0f, 0); d = __builtin_amdgcn_cvt_scalef32_pk_fp4_f32(d, o0[2] * 2.0f, o0[3] * 2.0f, 1.0f, 1);
                d = __builtin_amdgcn_cvt_scalef32_pk_fp4_f32(d, o1[0] * 2.0f, o1[1] * 2.0f, 1.0f, 2); d = __builtin_amdgcn_cvt_scalef32_pk_fp4_f32(d, o1[2] * 2.0f, o1[3] * 2.0f, 1.0f, 3); *(unsigned*)(o4 + (c >> 1)) = d; }
        }
}
DI void phase_ln1(const Frame& F, const Args& a, int layer) {
    const bf16_t* Y = wsb(F, WS_GT); bf16_t* XB = wsb(F, WS_XB);
    const int gw = F.vcu * NWAVES + F.wave, NGW = F.G * NWAVES, lane = F.lane;
    for (int t = gw; t < S; t += NGW) {
        float v[4][8];
#pragma unroll
        for (int j = 0; j < 4; ++j) { const u32x4 w = *(const u32x4*)(Y + (size_t)t * DM + 512 * j + 8 * lane);
            v[j][0] = bf_lo(w.x); v[j][1] = bf_hi(w.x); v[j][2] = bf_lo(w.y); v[j][3] = bf_hi(w.y); v[j][4] = bf_lo(w.z); v[j][5] = bf_hi(w.z); v[j][6] = bf_lo(w.w); v[j][7] = bf_hi(w.w); }
        ln_store<4, 8>(v, a.in[18] + layer * DM, a.in[19] + layer * DM, (float*)nullptr, XB + (size_t)t * DM, lane);
    }
}

namespace att {
constexpr int TBL = RING_BYTES - 4096;
constexpr int TPMO = TBL - 1024;
constexpr int KMO = 0;
constexpr float NEG = -1e30f;
enum { MIX_A = 0, MIX_B = 1, MIX_C = 2, MIX_D = 3 };

struct Ctx { int qi, pq, own; float c, cb; unsigned long long sel; };

DI int t5_bucket(int rel) {
    if (rel < 16) return rel;
    return 15 + (rel >= 16) + (rel >= 21) + (rel >= 27) + (rel >= 35) + (rel >= 46) + (rel >= 59) + (rel >= 77) + (rel >= 99) + (rel >= 128) + (rel >= 166) + (rel >= 216) + (rel >= 280) + (rel >= 363) + (rel >= 470) + (rel >= 609) + (rel >= 790);
}
DI void build_tbl(LAS unsigned char* lds, const float* t5, int col, const int* tpmax) {
    if (threadIdx.x < 256) *(LAS int*)(lds + TPMO + threadIdx.x * 4) = tpmax[threadIdx.x];
    for (int rel = threadIdx.x; rel < 1024; rel += 512) *(LAS float*)(lds + TBL + rel * 4) = t5[t5_bucket(rel) * 16 + col] * LOG2E;
}

#define ATT_SB() __builtin_amdgcn_sched_barrier(0)
#ifndef ATT_CONV_INTERLEAVE
#define ATT_CONV_INTERLEAVE 1
#endif
#ifndef ATT_CP_D
#define ATT_CP_D 0
#endif
#ifndef ATT_CP
#define ATT_CP 0
#endif
#ifndef ATT_X_LDS2
#define ATT_X_LDS2 0
#endif
#ifndef ATT_NOPRIO
#define ATT_NOPRIO 0
#endif
#if ATT_NOPRIO
#define ATT_PRIO(x) do { } while (0)
#else
#define ATT_PRIO(x) __builtin_amdgcn_s_setprio(x)
#endif
#if defined(ATT_X_NOSM)
#define ATT_SM(...) do { l_run = 1.0f; st0.resc = false; st1.resc = false; st0.alpha = 1.f; st1.alpha = 1.f; pf0[0] = qf[0]; pf0[1] = qf[1]; pf1[0] = qf[2]; pf1[1] = qf[3]; } while (0)
#else
#define ATT_SM(...) __VA_ARGS__
#endif
#ifndef ATT_PD
#define ATT_PD 4
#endif
DI float hmax32(float v) { auto rr = __builtin_amdgcn_permlane32_swap(__float_as_uint(v), __float_as_uint(v), false, false); return fmaxf(__uint_as_float(rr[0]), __uint_as_float(rr[1])); }
struct SmState { float mx, cc, dd, rs; bool resc; float alpha; };
template <int MIX, bool FAST, int W>
DI void sm_item(f32x16& s, SmState& st, float& m_run, float& l_run, bf16x8 (&pf)[2], const Ctx& cx, const LAS unsigned char* pkp, const LAS unsigned char* lds, int k0, int kmax, int kmin, int hi, bool lv) {
    constexpr bool BIAS = (MIX != MIX_D);
    if constexpr (W == 0 || W == 1) {
        constexpr int sg = W;
        if constexpr (FAST) {
            float a = fmaxf(fmaxf(s[sg * 8 + 0], s[sg * 8 + 1]), s[sg * 8 + 2]), b = fmaxf(fmaxf(s[sg * 8 + 3], s[sg * 8 + 4]), s[sg * 8 + 5]);
            a = fmaxf(fmaxf(a, s[sg * 8 + 6]), s[sg * 8 + 7]);
            st.mx = (W == 0) ? fmaxf(a, b) : fmaxf(st.mx, fmaxf(a, b));
            asm volatile("" : "+v"(st.mx));
        } else {
            i32x4 pk0 = (i32x4){0, 0, 0, 0}, pk1 = (i32x4){0, 0, 0, 0};
            if (BIAS) { const LAS i32x4* pp = (const LAS i32x4*)(pkp + (sg * 16 + hi * 8) * 4); pk0 = pp[0]; pk1 = pp[1]; }
            float mx = (W == 0) ? NEG : st.mx;
#pragma unroll
            for (int j = 0; j < 8; ++j) {
                const int i = sg * 8 + j, key = k0 + sg * 16 + hi * 8 + j;
                float tv = s[i] * cx.c;
                if (BIAS) { int rel = cx.pq - (j < 4 ? pk0[j & 3] : pk1[j & 3]); rel = rel < 0 ? 0 : (rel > 1023 ? 1023 : rel); tv += *(const LAS float*)(lds + TBL + rel * 4); }
                bool valid = key <= kmax;
                if (MIX == MIX_B) valid = valid && (key >= kmin);
                tv = valid ? tv : NEG;
                s[i] = tv; mx = fmaxf(mx, tv);
            }
            st.mx = mx;
        }
        if constexpr (W == 1) {
            float mx = hmax32(st.mx);
            if constexpr (FAST) mx = lv ? mx * cx.c + cx.cb : NEG;
            const bool need = mx > m_run + 8.0f;
            const float mn = need ? mx : m_run;
            st.alpha = ex2(m_run - mn); m_run = mn; l_run *= st.alpha;
            st.resc = (__ballot(need) != 0ull);
            st.cc = FAST ? (lv ? cx.c : 0.f) : 1.0f; st.dd = FAST ? (lv ? cx.cb - mn : NEG) : -mn; st.rs = 0.f;
            asm volatile("" : "+v"(st.alpha), "+v"(m_run), "+v"(l_run), "+v"(st.dd));
        }
    } else if constexpr (W >= 2 && W <= 5) {
        constexpr int e0 = (W - 2) * 4;
#pragma unroll
        for (int e = e0; e < e0 + 4; ++e) { float p = ex2(s[e] * st.cc + st.dd); asm volatile("" : "+v"(p)); s[e] = p; st.rs += p; }
        asm volatile("" : "+v"(st.rs));
        if constexpr (W == 5) l_run += st.rs;
    } else {
        constexpr int sg = W - 6;
        u32x4 w; w.x = cvtpk(s[sg * 8 + 0], s[sg * 8 + 1]); w.y = cvtpk(s[sg * 8 + 2], s[sg * 8 + 3]); w.z = cvtpk(s[sg * 8 + 4], s[sg * 8 + 5]); w.w = cvtpk(s[sg * 8 + 6], s[sg * 8 + 7]); asm volatile("" : "+v"(w)); pf[sg] = __builtin_bit_cast(bf16x8, w);
    }
}
template <int DQK, int DV, int MIX, bool FAST>
DI void tile_body(const LAS unsigned char* sb, const LAS unsigned char* lds, const bf16x8 (&qf)[DQK / 16], f32x16 (&o)[DV / 32], float& m_run, float& l_run, const Ctx& cx,
                  int k0, int kmax, int kmin, int pr, int xk, int xv, int r, int hi, bool lv) {
    constexpr int KCH = DQK / 8, NQ = DQK / 16, NP = DV / 16, KBUF = 64 * KCH * 16, VBUF = DV * 128;
    const LAS unsigned char* kb0 = sb + pr * (KCH * 16); const LAS unsigned char* kb1 = kb0 + 32 * (KCH * 16);
    const LAS unsigned char* vb = sb + KBUF + r * 128; const LAS unsigned char* pkp = sb + KBUF + VBUF;
    f32x16 s0, s1;
#pragma unroll
    for (int i = 0; i < 16; ++i) { s0[i] = 0.f; s1[i] = 0.f; }
    bf16x8 kf[NQ], kg[NQ], vf[2 * NP], pf0[2], pf1[2];
    SmState st0, st1;
#if defined(ATT_X_NOLDS)
#define ATT_KF(base, kk) (qf[(kk) % NQ])
#else
#define ATT_KF(base, kk) (*(const LAS bf16x8*)((base) + (((2 * (kk) + hi) ^ xk) << 4)))
#endif
#if defined(ATT_X_NOLDS)
#define ATT_VF(f) (qf[(f) % NQ])
#else
#define ATT_VF(f) (*(const LAS bf16x8*)(vb + (((f) % NP) >> 1) * 32 * 128 + (((((f) / NP) * 4 + ((f) & 1) * 2 + hi) ^ xv) << 4)))
#endif
#define ATT_PRE_K(W) do { _Pragma("unroll") for (int kk = ((W) * NQ) / 8; kk < (((W) + 1) * NQ) / 8; ++kk) { kg[kk] = ATT_KF(kb1, kk); if (ATT_X_LDS2) { bf16x8 dm_ = ATT_KF(kb1 + 16, kk); asm volatile("" :: "v"(dm_)); } } } while (0)
#define ATT_PRE_V(W) do { _Pragma("unroll") for (int f = ((W) * NP) / 8; f < (((W) + 1) * NP) / 8; ++f) { vf[f] = ATT_VF(f); if (ATT_X_LDS2) { bf16x8 dm_ = ATT_VF(f ^ 1); asm volatile("" :: "v"(dm_)); } } } while (0)
#pragma unroll
    for (int kk = 0; kk < NQ; ++kk) kf[kk] = ATT_KF(kb0, kk);
    ATT_SB();
#pragma unroll
    for (int kk = 0; kk < NQ; ++kk) s0 = __builtin_amdgcn_mfma_f32_32x32x16_bf16(kf[kk], qf[kk], s0, 0, 0, 0);
    ATT_PRE_K(0); ATT_PRE_K(1); if (ATT_PD > 2) ATT_PRE_K(2); if (ATT_PD > 3) ATT_PRE_K(3);
    ATT_SB();
#define ATT_STEP2(W) do { \
        ATT_PRIO(1); _Pragma("unroll") for (int kk = ((W) * NQ) / 8; kk < (((W) + 1) * NQ) / 8; ++kk) s1 = __builtin_amdgcn_mfma_f32_32x32x16_bf16(kg[kk], qf[kk], s1, 0, 0, 0); ATT_PRIO(0); \
        if ((W) + ATT_PD < 8) ATT_PRE_K((W) + ATT_PD); else ATT_PRE_V((W) + ATT_PD - 8); \
        ATT_SM(sm_item<MIX, FAST, W>(s0, st0, m_run, l_run, pf0, cx, pkp, lds, k0, kmax, kmin, hi, lv)); ATT_SB(); } while (0)
    ATT_STEP2(0); ATT_STEP2(1); ATT_STEP2(2); ATT_STEP2(3); ATT_STEP2(4); ATT_STEP2(5); ATT_STEP2(6); ATT_STEP2(7);
#undef ATT_STEP2
    if (st0.resc) {
#pragma unroll
        for (int d = 0; d < DV / 32; ++d)
#pragma unroll
            for (int i = 0; i < 16; ++i) o[d][i] *= st0.alpha;
    }
    ATT_SB();
#define ATT_STEP3(W) do { \
        ATT_PRIO(1); _Pragma("unroll") for (int f = ((W) * NP) / 8; f < (((W) + 1) * NP) / 8; ++f) o[f >> 1] = __builtin_amdgcn_mfma_f32_32x32x16_bf16(vf[f], pf0[f & 1], o[f >> 1], 0, 0, 0); ATT_PRIO(0); \
        ATT_PRE_V((W) + ATT_PD); \
        ATT_SM(sm_item<MIX, FAST, W>(s1, st1, m_run, l_run, pf1, cx, pkp + 128, lds, k0 + 32, kmax, kmin, hi, lv)); ATT_SB(); } while (0)
    ATT_STEP3(0); ATT_STEP3(1); ATT_STEP3(2); ATT_STEP3(3); ATT_STEP3(4); ATT_STEP3(5); ATT_STEP3(6); ATT_STEP3(7);
#undef ATT_STEP3
    if (st1.resc) {
#pragma unroll
        for (int d = 0; d < DV / 32; ++d)
#pragma unroll
            for (int i = 0; i < 16; ++i) o[d][i] *= st1.alpha;
    }
    ATT_SB();
#define ATT_STEP4(W) do { \
        _Pragma("unroll") for (int f = ((W) * NP) / 8; f < (((W) + 1) * NP) / 8; ++f) o[(f - NP) >> 1] = __builtin_amdgcn_mfma_f32_32x32x16_bf16(vf[f], pf1[f & 1], o[(f - NP) >> 1], 0, 0, 0); \
        if ((W) + ATT_PD < 16) ATT_PRE_V((W) + ATT_PD); ATT_SB(); } while (0)
    ATT_STEP4(8); ATT_STEP4(9); ATT_STEP4(10); ATT_STEP4(11); ATT_STEP4(12); ATT_STEP4(13); ATT_STEP4(14); ATT_STEP4(15);
#undef ATT_STEP4
#undef ATT_KF
#undef ATT_VF
#undef ATT_PRE_K
#undef ATT_PRE_V
}
template <int DQK, int DV, int MIX>
DI void flash_pass(LAS unsigned char* lds, const bf16x8 (&qf)[DQK / 16], const bf16_t* __restrict__ Kg, int ldk, const bf16_t* __restrict__ VTg, int ldvt,
                   const int* __restrict__ pos, int t0, int t1, int q0, int qpmin, const Ctx& cx, f32x16 (&o)[DV / 32], float& m_run, float& l_run, int ts_force = -1) {
    constexpr int KCH = DQK / 8, NKL = KCH / 8, NVL = DV / 64;
    constexpr bool BIAS = (MIX != MIX_D);
    constexpr int KBUF = 64 * KCH * 16, VBUF = DV * 128, PBUF = BIAS ? 2048 : 0, SLOT = KBUF + VBUF + PBUF, NV = NKL + NVL + (BIAS ? 1 : 0);
    static_assert(3 * SLOT <= TPMO, "attention ring");
    static_assert(DQK % 128 == 0 || DQK == 64 || DQK == 192, "QK MFMAs per softmax work item");
    int tid = threadIdx.x; asm volatile("" : "+v"(tid));
    const int lane = tid & 63, r = lane & 31, hi = lane >> 5, wave = __builtin_amdgcn_readfirstlane(tid >> 6);
    const int pr = (r & 0x13) | ((r & 4) << 1) | ((r & 8) >> 1);
    const int xk = (KCH == 16) ? (((pr & 1) << 3) | ((pr >> 1) & 7)) : ((pr >> 1) & 7);
    const int xv = (r >> 1) & 7;
    unsigned koff[NKL], voff[NVL];
#pragma unroll
    for (int i = 0; i < NKL; ++i) { const int p = (i * 8 + wave) * 64 + lane, row = p / KCH, cs = p % KCH; const int x = (KCH == 16) ? (((row & 1) << 3) | ((row >> 1) & 7)) : ((row >> 1) & 7); koff[i] = (unsigned)(row * ldk + (cs ^ x) * 8) * 2u; }
#pragma unroll
    for (int i = 0; i < NVL; ++i) { const int p = (i * 8 + wave) * 64 + lane, row = p >> 3, cs = p & 7; voff[i] = (unsigned)(row * ldvt + (cs ^ ((row >> 1) & 7)) * 8) * 2u; }
#define ATT_ISSUE(t, sl) do { LAS unsigned char* sb_ = lds + (sl) * SLOT; \
    _Pragma("unroll") for (int i_ = 0; i_ < NKL; ++i_) __builtin_amdgcn_global_load_lds((const unsigned*)((const char*)Kg + (size_t)(t) * 64 * ldk * 2 + koff[i_]), (LAS unsigned*)(sb_ + (i_ * 8 + wave) * 1024), 16, 0, 0); \
    _Pragma("unroll") for (int i_ = 0; i_ < NVL; ++i_) __builtin_amdgcn_global_load_lds((const unsigned*)((const char*)VTg + (size_t)(t) * 128 + voff[i_]), (LAS unsigned*)(sb_ + KBUF + (i_ * 8 + wave) * 1024), 16, 0, 0); \
    if (BIAS) __builtin_amdgcn_global_load_lds((const unsigned*)(pos + (t) * 64 + lane), (LAS unsigned*)(sb_ + KBUF + VBUF + wave * 256), 4, 0, 0); } while (0)
#ifndef ATT_X_DMA2
#define ATT_X_DMA2 0
#endif
#if ATT_X_DMA2
#define ATT_ISSUE2(t, sl) do { ATT_ISSUE(t, sl); ATT_ISSUE(t, sl); } while (0)
#else
#define ATT_ISSUE2(t, sl) ATT_ISSUE(t, sl)
#endif
#if defined(ATT_X_NODMA)
#define ATT_ISSUE_LOOP(t, sl) do { (void)(sl); } while (0)
#define ATT_NEXT_SLOT(sl) ((sl) ^ 1)
#else
#define ATT_ISSUE_LOOP(t, sl) ATT_ISSUE2(t, sl)
#define ATT_NEXT_SLOT(sl) (((sl) == 2) ? 0 : (sl) + 1)
#endif
#define ATT_WAITBAR(N) asm volatile("s_waitcnt vmcnt(%0) lgkmcnt(0)\n\ts_barrier" :: "n"(N) : "memory")
    int ts = t0;
    if (ts_force >= 0) ts = ts_force;
    else if (MIX != MIX_B) { const int tlim = (q0 >> 6) < t1 ? (q0 >> 6) : t1;
        if (!BIAS) ts = tlim > t0 ? tlim : t0;
        else {
            ts = tlim > t0 ? tlim : t0;
            for (int base = t0; base < tlim; base += 64) { const int idx = base + lane; const bool stop = (idx >= tlim) || (qpmin - *(const LAS int*)(lds + TPMO + (idx < 256 ? idx : 255) * 4) < 790);
                const unsigned long long mk = __ballot(stop); if (mk != 0ull) { const int f = base + (int)__builtin_ctzll(mk); ts = f < tlim ? f : tlim; break; } } } }
    ATT_ISSUE2(t0, 0);
    if (t0 + 1 < t1) ATT_ISSUE2(t0 + 1, 1);
    int sl = 0;
#define ATT_TILES(TA, TB, FASTV) \
    for (int t = (TA); t < (TB); ++t) { \
        if (t + 1 < t1) ATT_WAITBAR(NV * (ATT_X_DMA2 ? 2 : 1)); else ATT_WAITBAR(0);            \
        if (t + 2 < t1) { const int s2 = (sl >= 1) ? sl - 1 : 2; ATT_ISSUE_LOOP(t + 2, s2); } \
        const LAS unsigned char* sb = lds + sl * SLOT; \
        int kmax, kmin = 0; \
        kmax = cx.qi; \
        if (MIX == MIX_B) kmin = cx.qi - 127; \
        const int k0 = t * 64; \
        const bool lv = (kmax >= k0) && (kmin <= k0 + 63); \
        if (__ballot(lv) != 0ull) tile_body<DQK, DV, MIX, FASTV>(sb, lds, qf, o, m_run, l_run, cx, k0, kmax, kmin, pr, xk, xv, r, hi, lv); \
        sl = ATT_NEXT_SLOT(sl); \
    }
    ATT_TILES(t0, ts, true)
    ATT_TILES(ts, t1, false)
#undef ATT_TILES
    asm volatile("s_waitcnt lgkmcnt(0)\n\ts_barrier" ::: "memory");
#undef ATT_ISSUE
#undef ATT_WAITBAR
}
DI int fast_split(const LAS unsigned char* lds, int t0, int t1, int q0, int qpmin, int lane) {
    const int tlim = (q0 >> 6) < t1 ? (q0 >> 6) : t1;
    int ts = tlim > t0 ? tlim : t0;
    for (int base = t0; base < tlim; base += 64) { const int idx = base + lane; const bool stop = (idx >= tlim) || (qpmin - *(const LAS int*)(lds + TPMO + (idx < 256 ? idx : 255) * 4) < 790);
        const unsigned long long mk = __ballot(stop); if (mk != 0ull) { const int f = base + (int)__builtin_ctzll(mk); ts = f < tlim ? f : tlim; break; } }
    return ts;
}
template <int DQK, int DV, int MIX>
DI void flash_pass_cp(LAS unsigned char* lds, const bf16x8 (&qf)[DQK / 16], const bf16_t* __restrict__ Kg, int ldk, const bf16_t* __restrict__ VTg, int ldvt,
                      int t0, int ts, const Ctx& cx, f32x16 (&o)[DV / 32], float& m_run, float& l_run) {
    constexpr int KCH = DQK / 8, NKL = KCH / 8, NVL = DV / 64, NQ = DQK / 16, NP = DV / 16;
    constexpr int KBUF = 64 * KCH * 16, VBUF = DV * 128;
    static_assert(3 * (KBUF + VBUF) <= TPMO, "attention rings");
    int tid = threadIdx.x; asm volatile("" : "+v"(tid));
    const int lane = tid & 63, r = lane & 31, hi = lane >> 5, wave = __builtin_amdgcn_readfirstlane(tid >> 6);
    const int pr = (r & 0x13) | ((r & 4) << 1) | ((r & 8) >> 1);
    const int xk = (KCH == 16) ? (((pr & 1) << 3) | ((pr >> 1) & 7)) : ((pr >> 1) & 7);
    const int xv = (r >> 1) & 7;
    unsigned koff[NKL], voff[NVL];
#pragma unroll
    for (int i = 0; i < NKL; ++i) { const int p = (i * 8 + wave) * 64 + lane, row = p / KCH, cs = p % KCH; const int x = (KCH == 16) ? (((row & 1) << 3) | ((row >> 1) & 7)) : ((row >> 1) & 7); koff[i] = (unsigned)(row * ldk + (cs ^ x) * 8) * 2u; }
#pragma unroll
    for (int i = 0; i < NVL; ++i) { const int p = (i * 8 + wave) * 64 + lane, row = p >> 3, cs = p & 7; voff[i] = (unsigned)(row * ldvt + (cs ^ ((row >> 1) & 7)) * 8) * 2u; }
#define CP_ISSUE_K(t, sl) do { _Pragma("unroll") for (int i_ = 0; i_ < NKL; ++i_) __builtin_amdgcn_global_load_lds((const unsigned*)((const char*)Kg + (size_t)(t) * 64 * ldk * 2 + koff[i_]), (LAS unsigned*)(lds + (sl) * KBUF + (i_ * 8 + wave) * 1024), 16, 0, 0); } while (0)
#define CP_ISSUE_V(t, sl) do { _Pragma("unroll") for (int i_ = 0; i_ < NVL; ++i_) __builtin_amdgcn_global_load_lds((const unsigned*)((const char*)VTg + (size_t)(t) * 128 + voff[i_]), (LAS unsigned*)(lds + 3 * KBUF + (sl) * VBUF + (i_ * 8 + wave) * 1024), 16, 0, 0); } while (0)
#define CP_KF(base, kk) (*(const LAS bf16x8*)((base) + (((2 * (kk) + hi) ^ xk) << 4)))
#define CP_VF(base, hf, j) (*(const LAS bf16x8*)((base) + ((j) >> 1) * 32 * 128 + (((((hf) * 4 + ((j) & 1) * 2 + hi) ^ xv)) << 4)))
    const int n = ts - t0;
    CP_ISSUE_K(t0, 0); CP_ISSUE_V(t0, 0);
    if (n > 1) CP_ISSUE_K(t0 + 1, 1);
    asm volatile("s_waitcnt vmcnt(0) lgkmcnt(0)\n\ts_barrier" ::: "memory");
    const LAS unsigned char* kl = lds + pr * (KCH * 16);
    const LAS unsigned char* vl = lds + 3 * KBUF + r * 128;
    f32x16 sc, sn;
    bf16x8 kfr[NQ], vfr[NP], pp[2], pc[2];
    SmState st;
#pragma unroll
    for (int i = 0; i < 16; ++i) sc[i] = 0.f;
#pragma unroll
    for (int kk = 0; kk < NQ; ++kk) kfr[kk] = CP_KF(kl, kk);
    ATT_SB();
#pragma unroll
    for (int kk = 0; kk < NQ; ++kk) sc = __builtin_amdgcn_mfma_f32_32x32x16_bf16(kfr[kk], qf[kk], sc, 0, 0, 0);
#define CP_PRE(W, KB, HFK_UNUSED, VB, HFV, DOK, DOV) do { \
        if (DOK) { _Pragma("unroll") for (int kk = ((W) * NQ) / 8; kk < (((W) + 1) * NQ) / 8; ++kk) kfr[kk] = CP_KF(KB, kk); } \
        if (DOV) { _Pragma("unroll") for (int j = ((W) * NP) / 8; j < (((W) + 1) * NP) / 8; ++j) vfr[j] = CP_VF(VB, HFV, j); } } while (0)
#define CP_ITEM(W, DOK, DOV, KB, VB, HFV, KBN, VBN, HFVN) do { \
        ATT_PRIO(1); \
        if (DOK) { _Pragma("unroll") for (int kk = ((W) * NQ) / 8; kk < (((W) + 1) * NQ) / 8; ++kk) sn = __builtin_amdgcn_mfma_f32_32x32x16_bf16(kfr[kk], qf[kk], sn, 0, 0, 0); } \
        if (DOV) { _Pragma("unroll") for (int j = ((W) * NP) / 8; j < (((W) + 1) * NP) / 8; ++j) o[j >> 1] = __builtin_amdgcn_mfma_f32_32x32x16_bf16(vfr[j], pp[j & 1], o[j >> 1], 0, 0, 0); } \
        ATT_PRIO(0); \
        if ((W) + 2 < 8) CP_PRE((W) + 2, KB, 0, VB, HFV, DOK, DOV); else CP_PRE((W) - 6, KBN, 0, VBN, HFVN, true, true); \
        sm_item<MIX, true, W>(sc, st, m_run, l_run, pc, cx, lds, lds, 0, 0, 0, hi, true); ATT_SB(); } while (0)
#define CP_STEP(DOK, DOV, KB, VB, HFV, KBN, VBN, HFVN) do { \
        _Pragma("unroll") for (int i = 0; i < 16; ++i) sn[i] = 0.f; \
        CP_ITEM(0, DOK, DOV, KB, VB, HFV, KBN, VBN, HFVN); CP_ITEM(1, DOK, DOV, KB, VB, HFV, KBN, VBN, HFVN); CP_ITEM(2, DOK, DOV, KB, VB, HFV, KBN, VBN, HFVN); CP_ITEM(3, DOK, DOV, KB, VB, HFV, KBN, VBN, HFVN); \
        CP_ITEM(4, DOK, DOV, KB, VB, HFV, KBN, VBN, HFVN); CP_ITEM(5, DOK, DOV, KB, VB, HFV, KBN, VBN, HFVN); CP_ITEM(6, DOK, DOV, KB, VB, HFV, KBN, VBN, HFVN); CP_ITEM(7, DOK, DOV, KB, VB, HFV, KBN, VBN, HFVN); \
        if (st.resc) { _Pragma("unroll") for (int d = 0; d < DV / 32; ++d) _Pragma("unroll") for (int i = 0; i < 16; ++i) o[d][i] *= st.alpha; } \
        pp[0] = pc[0]; pp[1] = pc[1]; sc = sn; ATT_SB(); } while (0)
    int ks = 0, vs = 0;
    for (int i = 0; i < n; ++i) {
        const int t = t0 + i;
        const int ks1 = (ks == 2) ? 0 : ks + 1, ks2 = (ks == 0) ? 2 : ks - 1, vs1 = (vs == 2) ? 0 : vs + 1, vsp = (vs == 0) ? 2 : vs - 1;
        if (i > 0) asm volatile("s_waitcnt vmcnt(0) lgkmcnt(0)\n\ts_barrier" ::: "memory");
        if (t + 2 < ts) CP_ISSUE_K(t + 2, ks2);
        if (t + 1 < ts) CP_ISSUE_V(t + 1, vs1);
        const LAS unsigned char* kA = kl + ks * KBUF + 32 * (KCH * 16); const LAS unsigned char* kB = kl + ks1 * KBUF; const LAS unsigned char* kAn = kl + ks1 * KBUF + 32 * (KCH * 16);
        const LAS unsigned char* vP = vl + vsp * VBUF; const LAS unsigned char* vC = vl + vs * VBUF;
        if (i == 0) {
            CP_PRE(0, kA, 0, vP, 1, true, false); CP_PRE(1, kA, 0, vP, 1, true, false);
            CP_STEP(true, false, kA, vP, 1, kB, vC, 0);
        } else {
            CP_STEP(true, true, kA, vP, 1, kB, vC, 0);
        }
        CP_STEP(true, true, kB, vC, 0, kAn, vC, 1);
        ks = ks1; vs = vs1;
    }
    {
        const int vsp = (vs == 0) ? 2 : vs - 1; const LAS unsigned char* vP = vl + vsp * VBUF;
#pragma unroll
        for (int j = (2 * NP) / 8; j < NP; ++j) vfr[j] = CP_VF(vP, 1, j);
        ATT_SB();
#pragma unroll
        for (int j = 0; j < NP; ++j) o[j >> 1] = __builtin_amdgcn_mfma_f32_32x32x16_bf16(vfr[j], pp[j & 1], o[j >> 1], 0, 0, 0);
    }
    asm volatile("s_waitcnt lgkmcnt(0)\n\ts_barrier" ::: "memory");
#undef CP_ISSUE_K
#undef CP_ISSUE_V
#undef CP_KF
#undef CP_VF
#undef CP_PRE
#undef CP_ITEM
#undef CP_STEP
}
template <int DV> DI void store_o(const f32x16 (&o)[DV / 32], float scale, bf16_t* orow, int hi) {
#pragma unroll
    for (int d = 0; d < DV / 32; ++d)
#pragma unroll
        for (int a = 0; a < 4; ++a) { u32x2 w; w.x = cvtpk(o[d][4 * a] * scale, o[d][4 * a + 1] * scale); w.y = cvtpk(o[d][4 * a + 2] * scale, o[d][4 * a + 3] * scale); *(u32x2*)(orow + d * 32 + 8 * a + 4 * hi) = w; }
}

DI int wg_min_pos(const Frame& F, int pq) {
#pragma unroll
    for (int o = 1; o < 64; o <<= 1) { const int other = __shfl_xor(pq, o); pq = other < pq ? other : pq; }
    if (F.tid == 0) F.MISC[5] = 0x7fffffffu;
    __syncthreads();
    if (F.lane == 0) atomicMin((int*)&F.MISC[5], pq);
    __syncthreads();
    const int v = (int)F.MISC[5];
    __syncthreads();
    return v;
}
DI void unit_D(const Frame& F, const Args& a, int h, int qt) {
    int lane = F.lane; asm volatile("" : "+v"(lane));
    const int r = lane & 31, hi = lane >> 5, qi = qt * 256 + F.wave * 32 + r;
    const bf16_t* QD = wsb(F, WS_QD) + (size_t)qi * 768 + h * 192 + hi * 8;
    bf16x8 qf[12];
#pragma unroll
    for (int kk = 0; kk < 12; ++kk) qf[kk] = *(const bf16x8*)(QD + kk * 16);
    f32x16 o[4];
#pragma unroll
    for (int d = 0; d < 4; ++d)
#pragma unroll
        for (int i = 0; i < 16; ++i) o[d][i] = 0.f;
    float m = NEG, l = 0.f;
    Ctx cx; cx.qi = qi; cx.pq = 0; cx.own = 0; cx.sel = 0ull; cx.cb = 0.f; cx.c = 0.07216878364870322f * LOG2E;
    const int ts = qt * 4;
    if (ATT_CP_D && ts > 0) flash_pass_cp<192, 128, MIX_D>(F.lds, qf, wsb(F, WS_KD) + h * 192, 768, wsb(F, WS_VDT) + (size_t)(h * 128) * S, S, 0, ts, cx, o, m, l);
    flash_pass<192, 128, MIX_D>(F.lds, qf, wsb(F, WS_KD) + h * 192, 768, wsb(F, WS_VDT) + (size_t)(h * 128) * S, S, (const int*)a.in[1], ATT_CP_D ? ts : 0, (qt + 1) * 4, qt * 256, 0, cx, o, m, l, ATT_CP_D ? ts : -1);
    l += xhalf(l);
    int lane2 = F.lane; asm volatile("" : "+v"(lane2));
    const int hi2 = lane2 >> 5, qi2 = qt * 256 + F.wave * 32 + (lane2 & 31);
    store_o<128>(o, 1.0f / l, wsb(F, WS_O) + (size_t)3 * S * 512 + (size_t)qi2 * 512 + h * 128, hi2);
}
DI void unit_C(const Frame& F, const Args& a, int h, int qt, int mp) {
    int lane = F.lane; asm volatile("" : "+v"(lane));
    const int r = lane & 31, hi = lane >> 5, qi = qt * 256 + F.wave * 32 + r;
    const int* pos = (const int*)a.in[1];
    build_tbl(F.lds, a.in[2], 12 + h, (const int*)(F.ws + WS_TPMAX));
    Ctx cx; cx.qi = qi; cx.pq = pos[qi]; cx.own = 0; cx.sel = 0ull; cx.c = 0.125f * LOG2E; cx.cb = a.in[2][31 * 16 + 12 + h] * LOG2E;
    const int qpmin = wg_min_pos(F, cx.pq);
    const bf16_t* H = wsb(F, WS_H);
    const bf16_t* Q = H + (size_t)qi * HW + H_CQ + h * 128 + mp * 64 + hi * 8;
    bf16x8 qf[4];
#pragma unroll
    for (int kk = 0; kk < 4; ++kk) qf[kk] = *(const bf16x8*)(Q + kk * 16);
    f32x16 o[4];
#pragma unroll
    for (int d = 0; d < 4; ++d)
#pragma unroll
        for (int i = 0; i < 16; ++i) o[d][i] = 0.f;
    float m = NEG, l = 0.f;
    const int ts = ATT_CP ? fast_split(F.lds, 0, (qt + 1) * 4, qt * 256, qpmin, lane) : 0;
    if (ATT_CP && ts > 0) flash_pass_cp<64, 128, MIX_C>(F.lds, qf, H + H_CK + h * 128 + mp * 64, HW, wsb(F, WS_VT) + (size_t)(VT_C + h * 128) * S, S, 0, ts, cx, o, m, l);
    flash_pass<64, 128, MIX_C>(F.lds, qf, H + H_CK + h * 128 + mp * 64, HW, wsb(F, WS_VT) + (size_t)(VT_C + h * 128) * S, S, pos, ATT_CP ? ts : 0, (qt + 1) * 4, qt * 256, qpmin, cx, o, m, l, ATT_CP ? ts : -1);
    l += xhalf(l);
    int lane2 = F.lane; asm volatile("" : "+v"(lane2));
    const int hi2 = lane2 >> 5, qi2 = qt * 256 + F.wave * 32 + (lane2 & 31);
    bf16_t* orow = (mp == 0 ? wsb(F, WS_O) + (size_t)2 * S * 512 : wsb(F, WS_OC2)) + (size_t)qi2 * 512 + h * 128;
    store_o<128>(o, 1.0f / l, orow, hi2);
}
DI void unit_B(const Frame& F, const Args& a, int layer, int hq, int qt) {
    const int lane = F.lane, r = lane & 31, hi = lane >> 5, qi = qt * 256 + F.wave * 32 + r, g = hq >> 2;
    const int* pos = (const int*)a.in[1];
    build_tbl(F.lds, a.in[2], 4 + hq, (const int*)(F.ws + WS_TPMAX));
    const bf16_t* H = wsb(F, WS_H);
    const bf16_t* Q = H + (size_t)qi * HW + H_BQ + hq * 64 + hi * 8;
    bf16x8 qf[4];
#pragma unroll
    for (int kk = 0; kk < 4; ++kk) qf[kk] = *(const bf16x8*)(Q + kk * 16);
    f32x16 o[2];
#pragma unroll
    for (int d = 0; d < 2; ++d)
#pragma unroll
        for (int i = 0; i < 16; ++i) o[d][i] = 0.f;
    float m = NEG, l = 0.f;
    Ctx cx; cx.qi = qi; cx.pq = pos[qi]; cx.own = 0; cx.sel = 0ull; cx.c = 0.125f * LOG2E; cx.cb = a.in[2][31 * 16 + 4 + hq] * LOG2E;
    const int t0 = (qt * 4 - 2) < 0 ? 0 : (qt * 4 - 2);
    flash_pass<64, 64, MIX_B>(F.lds, qf, H + H_BK + g * 64, HW, wsb(F, WS_VT) + (size_t)(VT_B + g * 64) * S, S, pos, t0, (qt + 1) * 4, qt * 256, 0, cx, o, m, l);
    l += xhalf(l);
    l += ex2(a.in[8][layer * 8 + hq] * LOG2E - m);
    store_o<64>(o, 1.0f / l, wsb(F, WS_O) + (size_t)1 * S * 512 + (size_t)qi * 512 + hq * 64, hi);
}
DI void store_part(const f32x16 (&o)[4], float m, float l, unsigned char* prow, int hi) {
    l += xhalf(l);
    store_o<128>(o, 1.0f / l, (bf16_t*)prow, hi);
    if (hi == 0) *(f32x2*)(prow + 256) = (f32x2){m, l};
}
DI void unit_A_own(const Frame& F, const Args& a, int h, int qt) {
    const int lane = F.lane, r = lane & 31, hi = lane >> 5, qi = qt * 256 + F.wave * 32 + r;
    const int* pos = (const int*)a.in[1];
    build_tbl(F.lds, a.in[2], h, (const int*)(F.ws + WS_TPMAX));
    const bf16_t* H = wsb(F, WS_H);
    const bf16_t* Q = H + (size_t)qi * HW + H_AQ + h * 128 + hi * 8;
    bf16x8 qf[8];
#pragma unroll
    for (int kk = 0; kk < 8; ++kk) qf[kk] = *(const bf16x8*)(Q + kk * 16);
    f32x16 o[4];
#pragma unroll
    for (int d = 0; d < 4; ++d)
#pragma unroll
        for (int i = 0; i < 16; ++i) o[d][i] = 0.f;
    float m = NEG, l = 0.f;
    Ctx cx; cx.qi = qi; cx.pq = pos[qi]; cx.own = qt; cx.sel = 0ull; cx.c = 0.08838834764831845f * LOG2E; cx.cb = a.in[2][31 * 16 + h] * LOG2E;
    flash_pass<128, 128, MIX_C>(F.lds, qf, H + H_AK + h * 128, HW, wsb(F, WS_VT) + (size_t)(VT_A + h * 128) * S, S, pos, qt * 4, (qt + 1) * 4, 0, 0, cx, o, m, l);
    store_part(o, m, l, F.ws + WS_PART + ((size_t)qi * 16 + h * 4 + 3) * 272, hi);
}
DI void unit_A_gather(const Frame& F, const Args& a, int h, int n, int near, int chunk, int count) {
    const int lane = F.lane, r = lane & 31, hi = lane >> 5;
    const int* pos = (const int*)a.in[1];
    if (near) build_tbl(F.lds, a.in[2], h, (const int*)(F.ws + WS_TPMAX));
    const int* list = (const int*)(F.ws + WS_MLIST) + (size_t)(h * 64 + n) * MCAP + (near ? MCAP_F : 0);
    const int idx = chunk * 256 + F.wave * 32 + r; const bool live = idx < count;
    const int e = list[live ? idx : chunk * 256];
    const int qi = e >> 2, slot = e & 3;
    const bf16_t* H = wsb(F, WS_H);
    const bf16_t* Q = H + (size_t)qi * HW + H_AQ + h * 128 + hi * 8;
    bf16x8 qf[8];
#pragma unroll
    for (int kk = 0; kk < 8; ++kk) qf[kk] = *(const bf16x8*)(Q + kk * 16);
    f32x16 o[4];
#pragma unroll
    for (int d = 0; d < 4; ++d)
#pragma unroll
        for (int i = 0; i < 16; ++i) o[d][i] = 0.f;
    float m = NEG, l = 0.f;
    Ctx cx; cx.qi = 0x7fffffff; cx.pq = pos[qi]; cx.own = 0; cx.sel = 0ull; cx.c = 0.08838834764831845f * LOG2E; cx.cb = a.in[2][31 * 16 + h] * LOG2E;
    flash_pass<128, 128, MIX_C>(F.lds, qf, H + H_AK + h * 128, HW, wsb(F, WS_VT) + (size_t)(VT_A + h * 128) * S, S, pos, n * 4, (n + 1) * 4, 0, 0, cx, o, m, l, near ? n * 4 : (n + 1) * 4);
    if (live) store_part(o, m, l, F.ws + WS_PART + ((size_t)qi * 16 + h * 4 + slot) * 272, hi);
    else { l += xhalf(l); }
}
}

DI int next_unit(const Frame& F, unsigned* head) {
    if (F.tid == 0) F.MISC[4] = __hip_atomic_fetch_add(head, 1u, __ATOMIC_RELAXED, __HIP_MEMORY_SCOPE_AGENT);
    __syncthreads();
    const int u = (int)F.MISC[4];
    __syncthreads();
    return u;
}
DI void convert_chunk(const Frame& F, const Args& a, int layer, int c) {
    const bool isv = c >= 256; const int row0 = (c & 255) * 64 + F.wave * 8;
    const float* src = (isv ? a.in[23] : a.in[22]) + (size_t)layer * 16384 * DM + (size_t)row0 * DM;
    unsigned char* dst = F.ws + WS_UB + (size_t)row0 * 2048 + (isv ? 1024 : 0);
    const float scale = isv ? V_SCALE : U_SCALE;
    int lane = F.lane; asm volatile("" : "+v"(lane));
    for (int j = 0; j < 8; ++j) {
        const float* p = src + (size_t)j * DM + 4 * lane; unsigned char* q = dst + (size_t)j * 2048 + 2 * lane;
        f32x4 x[8];
#pragma unroll
        for (int k = 0; k < 8; ++k) x[k] = *(const f32x4*)(p + 256 * k);
#pragma unroll
        for (int k = 0; k < 8; ++k) { unsigned d = 0u; const f32x4 y = x[k] * scale;
            d = __builtin_amdgcn_cvt_scalef32_pk_fp4_f32(d, y[0], y[1], 1.0f, 0); d = __builtin_amdgcn_cvt_scalef32_pk_fp4_f32(d, y[2], y[3], 1.0f, 1);
            *(unsigned short*)(q + 128 * k) = (unsigned short)d; }
    }
}
template <int PART> DI void phase_attention(const Frame& F, const Args& a, int layer, int rep = 0) {
    unsigned* q = (unsigned*)(F.ws + WS_CTL) + CW_Q + layer * 256 + rep * 512;
    if constexpr (PART == 0) {
#if !defined(NO_D) && !defined(NO_C)
    for (;;) { const int u = next_unit(F, q + 0); if (u >= 768) break;
        const int qt = 63 - u / 12, k = u % 12;
        if (k < 4) att::unit_D(F, a, k, qt);
        else att::unit_C(F, a, (k - 4) >> 1, qt, (k - 4) & 1);
        if (ATT_CONV_INTERLEAVE) { const int c = next_unit(F, q + 32); if (c < 512) convert_chunk(F, a, layer, c); } }
    if (ATT_CONV_INTERLEAVE) for (;;) { const int c = next_unit(F, q + 32); if (c >= 512) break; convert_chunk(F, a, layer, c); }
#endif
    } else {
#ifndef NO_A
    {
        const unsigned* cnt = (const unsigned*)(F.ws + WS_CTL) + CW_MOBA + layer * 1024;
        LAS int* pre = (LAS int*)(F.lds + att::TBL - 4096);
        __syncthreads();
        if (F.tid == 0) { int acc = 0; for (int i = 0; i < 512; ++i) { pre[i] = acc; const unsigned c = cnt[i], cap = (i >= 256) ? (unsigned)(MCAP - MCAP_F) : (unsigned)MCAP_F; acc += (int)(((c < cap ? c : cap) + 255u) >> 8); } pre[512] = acc; }
        __syncthreads();
        const int ntot = 256 + pre[512];
        for (;;) { const int u = next_unit(F, q + 128); if (u >= ntot) break;
            if (u < 256) { att::unit_A_own(F, a, u & 3, 63 - (u >> 2)); continue; }
            const int g = u - 256; int lo_ = 0, hi_ = 511;
            while (lo_ < hi_) { const int mid = (lo_ + hi_ + 1) >> 1; if (pre[mid] <= g) lo_ = mid; else hi_ = mid - 1; }
            const unsigned c = cnt[lo_], cap = (lo_ >= 256) ? (unsigned)(MCAP - MCAP_F) : (unsigned)MCAP_F;
            att::unit_A_gather(F, a, (lo_ >> 6) & 3, lo_ & 63, lo_ >> 8, g - pre[lo_], (int)(c < cap ? c : cap)); }
    }
#endif
#ifndef NO_B
    for (;;) { const int u = next_unit(F, q + 192); if (u >= 512) break; att::unit_B(F, a, layer, u & 7, u >> 3); }
#endif
    }
}

DI void ins16(float (&v)[16], float x) {
#pragma unroll
    for (int k = 0; k < 16; ++k) { const float t = fmaxf(v[k], x); x = fminf(v[k], x); v[k] = t; }
}
DI float pack_idx(float s, int idx, unsigned mask) { return __uint_as_float((__float_as_uint(s) & ~mask) | (unsigned)idx); }
DI void peer_select_group(const Frame& F, const bf16_t* SK, int grp, LAS unsigned char* sel) {
    const bf16_t* QP = wsb(F, WS_H);
    int lane = F.lane; asm volatile("" : "+v"(lane));
    const int r = lane & 31, hi = lane >> 5;
    {
        const int h = F.wave, t = grp * 32 + r;
        float L[2][16];
#pragma unroll
        for (int m = 0; m < 2; ++m) {
            const bf16_t* qrow = QP + (size_t)t * DM + h * 256 + m * 128 + hi * 8;
            bf16x8 qf[8];
#pragma unroll
            for (int kk = 0; kk < 8; ++kk) qf[kk] = *(const bf16x8*)(qrow + kk * 16);
            const bf16_t* kb = SK + ((size_t)(h * 2 + m) * 128 + r) * 128 + hi * 8;
            float v[16];
#pragma unroll
            for (int k = 0; k < 16; ++k) v[k] = -3.0e38f;
#pragma unroll
            for (int rb = 0; rb < 4; ++rb) {
                f32x16 s;
#pragma unroll
                for (int i = 0; i < 16; ++i) s[i] = 0.f;
#pragma unroll
                for (int kk = 0; kk < 8; ++kk) { const bf16x8 kf = *(const bf16x8*)(kb + (size_t)rb * 32 * 128 + kk * 16); s = __builtin_amdgcn_mfma_f32_32x32x16_bf16(kf, qf[kk], s, 0, 0, 0); }
#pragma unroll
                for (int i = 0; i < 16; ++i) ins16(v, pack_idx(s[i], rb * 32 + (i & 3) + 8 * (i >> 2) + 4 * hi, 127u));
                asm volatile("" : "+v"(v[0]), "+v"(v[1]), "+v"(v[2]), "+v"(v[3]), "+v"(v[4]), "+v"(v[5]), "+v"(v[6]), "+v"(v[7]), "+v"(v[8]), "+v"(v[9]), "+v"(v[10]), "+v"(v[11]), "+v"(v[12]), "+v"(v[13]), "+v"(v[14]), "+v"(v[15]));
                asm volatile("" : "+v"(kb));
            }
            float ov[16];
#pragma unroll
            for (int k = 0; k < 16; ++k) ov[k] = xhalf(v[k]);
#pragma unroll
            for (int k = 0; k < 16; ++k) ins16(v, ov[k]);
#pragma unroll
            for (int k = 0; k < 16; ++k) L[m][k] = v[k];
        }
        int i0[16], i1[16];
#pragma unroll
        for (int k = 0; k < 16; ++k) { i0[k] = (int)(__float_as_uint(L[0][k]) & 127u); i1[k] = (int)(__float_as_uint(L[1][k]) & 127u); L[0][k] = __uint_as_float(__float_as_uint(L[0][k]) & ~127u); L[1][k] = __uint_as_float(__float_as_uint(L[1][k]) & ~127u); }
        float b[16];
#pragma unroll
        for (int k = 0; k < 16; ++k) b[k] = -3.0e38f;
#pragma unroll
        for (int i = 0; i < 16; ++i)
#pragma unroll
            for (int j = 0; j < 16; ++j) if ((i + 1) * (j + 1) <= 16) ins16(b, pack_idx(L[0][i] + L[1][j], i * 16 + j, 255u));
        float g[16]; int e[16]; float den = 0.f;
        const float b0 = __uint_as_float(__float_as_uint(b[0]) & ~255u);
#pragma unroll
        for (int k = 0; k < 16; ++k) {
            const unsigned bits = __float_as_uint(b[k]); const int ci = (int)((bits >> 4) & 15u), cj = (int)(bits & 15u);
            int e0 = i0[0], e1 = i1[0];
#pragma unroll
            for (int c = 1; c < 16; ++c) { e0 = (ci == c) ? i0[c] : e0; e1 = (cj == c) ? i1[c] : e1; }
            e[k] = e0 * 128 + e1;
            g[k] = ex2((__uint_as_float(bits & ~255u) - b0) * LOG2E); den += g[k];
        }
        const float inv = 1.0f / den;
        if (hi == 0) {
#pragma unroll
            for (int k = 0; k < 16; k += 4) *(LAS i32x4*)(sel + (r * 128 + h * 16 + k) * 4) = (i32x4){e[k], e[k + 1], e[k + 2], e[k + 3]};
        } else {
#pragma unroll
            for (int k = 0; k < 16; k += 4) *(LAS f32x4*)(sel + 16384 + (r * 128 + h * 16 + k) * 4) = (f32x4){g[k] * inv, g[k + 1] * inv, g[k + 2] * inv, g[k + 3] * inv};
        }
    }
}
DI float gelu_as(float v) {
    const float av = fabsf(v), t = __builtin_amdgcn_rcpf(av * 0.2316418882f + 1.0f);
    float q = t * 0.5307027145f + (-0.7265760135f); q = q * t + 0.7107068705f; q = q * t + (-0.142248368f); q = q * t + 0.127414796f; q = q * t;
    const float e = ex2((v * v) * (-0.72134752044f));
    const float m = v * (q * e);
    return v < 0.f ? m : v - m;
}
template <int CTRL, int RM> DI float dpp_add(float v) { return v + __builtin_bit_cast(float, __builtin_amdgcn_update_dpp(0, __builtin_bit_cast(int, v), CTRL, RM, 0xf, RM == 0xf)); }
DI float wave_total(float v) {
    v = dpp_add<0x111, 0xf>(v); v = dpp_add<0x112, 0xf>(v); v = dpp_add<0x114, 0xf>(v); v = dpp_add<0x118, 0xf>(v);
    v = dpp_add<0x142, 0xa>(v); v = dpp_add<0x143, 0xc>(v);
    return __uint_as_float(__builtin_amdgcn_readlane(__float_as_uint(v), 63));
}
DI void reduce4(float (&d)[4], int lane) {
#pragma unroll
    for (int i = 0; i < 4; ++i) d[i] = wave_total(d[i]);
}
DI void peer_gather_group(const Frame& F, const Args& a, int layer, float* outf, bf16_t* XB, int grp, const LAS unsigned char* sel) {
    typedef int v8i_t __attribute__((ext_vector_type(8)));
    const unsigned char* UB = F.ws + WS_UB;
    int lane = F.lane; asm volatile("" : "+v"(lane));
    const int m16 = lane & 15, g4 = lane >> 4;
    LAS unsigned char* x8 = F.lds + 65536 + F.wave * 2048;
    int sc = 0x7f7f7f7f; asm volatile("" : "+v"(sc));
    for (int ti = 0; ti < 4; ++ti) {
        const int tl = F.wave * 4 + ti, t = grp * 32 + tl;
        const bf16_t* xr = XB + (size_t)t * DM + 32 * lane;
        {
            u32x4 w8[2];
#pragma unroll
            for (int c = 0; c < 4; ++c) { const u32x4 w = *(const u32x4*)(xr + 8 * c);
#if PEER_X_SWAP
                int lo = __builtin_amdgcn_cvt_pk_fp8_f32(bf_hi(w.x), bf_lo(w.x), 0, false); lo = __builtin_amdgcn_cvt_pk_fp8_f32(bf_hi(w.y), bf_lo(w.y), lo, true);
                int hi = __builtin_amdgcn_cvt_pk_fp8_f32(bf_hi(w.z), bf_lo(w.z), 0, false); hi = __builtin_amdgcn_cvt_pk_fp8_f32(bf_hi(w.w), bf_lo(w.w), hi, true);
#else
                int lo = __builtin_amdgcn_cvt_pk_fp8_f32(bf_lo(w.x), bf_hi(w.x), 0, false); lo = __builtin_amdgcn_cvt_pk_fp8_f32(bf_lo(w.y), bf_hi(w.y), lo, true);
                int hi = __builtin_amdgcn_cvt_pk_fp8_f32(bf_lo(w.z), bf_hi(w.z), 0, false); hi = __builtin_amdgcn_cvt_pk_fp8_f32(bf_lo(w.w), bf_hi(w.w), hi, true);
#endif
                w8[c >> 1][(c & 1) * 2] = (unsigned)lo; w8[c >> 1][(c & 1) * 2 + 1] = (unsigned)hi; }
            *(LAS u32x4*)(x8 + 32 * lane) = w8[0]; *(LAS u32x4*)(x8 + 32 * lane + 16) = w8[1];
        }
        f32x2 acc[16];
#pragma unroll
        for (int e = 0; e < 16; ++e) acc[e] = (f32x2){0.f, 0.f};
        for (int half = 0; half < 2; ++half) {
            const int ev = *(const LAS int*)(sel + (tl * 128 + half * 64 + lane) * 4); const float gv = *(const LAS float*)(sel + 16384 + (tl * 128 + half * 64 + lane) * 4);
            for (int bb = 0; bb < 4; ++bb) {
                const int em = __builtin_amdgcn_ds_bpermute((16 * bb + m16) << 2, ev);
                const unsigned char* up = UB + (size_t)em * 2048 + 16 * g4;
                u32x4 ua[16], va[16];
#pragma unroll
                for (int s = 0; s < 16; ++s) ua[s] = *(const u32x4*)(up + 64 * s);
#pragma unroll
                for (int j = 0; j < 16; ++j) { const int e = __builtin_amdgcn_readlane(ev, 16 * bb + j); va[j] = *(const u32x4*)(UB + (size_t)e * 2048 + 1024 + 16 * lane); }
                f32x4 h = (f32x4){0.f, 0.f, 0.f, 0.f};
#pragma unroll
                for (int s = 0; s < 16; ++s) {
                    const u32x4 x0 = *(const LAS u32x4*)(x8 + 128 * s + 16 * g4), x1 = *(const LAS u32x4*)(x8 + 128 * s + 64 + 16 * g4);
                    const v8i_t xb = (v8i_t){(int)x0.x, (int)x0.y, (int)x0.z, (int)x0.w, (int)x1.x, (int)x1.y, (int)x1.z, (int)x1.w};
                    asm volatile("s_nop 1\n\tv_mfma_scale_f32_16x16x128_f8f6f4 %0, %1, %2, %0, %3, %3 op_sel_hi:[0,0,0] cbsz:4" : "+v"(h) : "v"(ua[s]), "v"(xb), "v"(sc));
                }
                asm volatile("s_nop 15" : "+v"(h));
                float hv[4];
#pragma unroll
                for (int i = 0; i < 4; ++i) { const float gq = __int_as_float(__builtin_amdgcn_ds_bpermute((16 * bb + 4 * g4 + i) << 2, __float_as_int(gv)));
                    hv[i] = gq * gelu_as(h[i] * (1.0f / U_SCALE)) * (1.0f / V_SCALE); }
#pragma unroll
                for (int j = 0; j < 16; ++j) {
                    const float wk = __uint_as_float(__builtin_amdgcn_readlane(__float_as_uint(hv[j & 3]), 16 * (j >> 2)));
                    const f32x2 wk2 = (f32x2){wk, wk}; const u32x4 w_ = va[j];
#define FP4_ACC(b) acc[b] += __builtin_amdgcn_cvt_scalef32_pk_f32_fp4(w_[(b) >> 2], 1.0f, (b) & 3) * wk2;
                    FP4_ACC(0) FP4_ACC(1) FP4_ACC(2) FP4_ACC(3) FP4_ACC(4) FP4_ACC(5) FP4_ACC(6) FP4_ACC(7) FP4_ACC(8) FP4_ACC(9) FP4_ACC(10) FP4_ACC(11) FP4_ACC(12) FP4_ACC(13) FP4_ACC(14) FP4_ACC(15)
#undef FP4_ACC
                }
            }
        }
        float z[1][32];
#pragma unroll
        for (int c = 0; c < 4; ++c) { const u32x4 w = *(const u32x4*)(xr + 8 * c);
            z[0][8 * c + 0] = acc[4 * c].x + DN_ALPHA * bf_lo(w.x); z[0][8 * c + 1] = acc[4 * c].y + DN_ALPHA * bf_hi(w.x); z[0][8 * c + 2] = acc[4 * c + 1].x + DN_ALPHA * bf_lo(w.y); z[0][8 * c + 3] = acc[4 * c + 1].y + DN_ALPHA * bf_hi(w.y);
            z[0][8 * c + 4] = acc[4 * c + 2].x + DN_ALPHA * bf_lo(w.z); z[0][8 * c + 5] = acc[4 * c + 2].y + DN_ALPHA * bf_hi(w.z); z[0][8 * c + 6] = acc[4 * c + 3].x + DN_ALPHA * bf_lo(w.w); z[0][8 * c + 7] = acc[4 * c + 3].y + DN_ALPHA * bf_hi(w.w); }
        ln_store<1, 32>(z, a.in[24] + layer * DM, a.in[25] + layer * DM, outf ? outf + (size_t)t * DM : (float*)nullptr, XB + (size_t)t * DM, lane, outf ? (unsigned char*)nullptr : F.ws + WS_XB8 + (size_t)t * DM, outf ? (unsigned char*)nullptr : F.ws + WS_XB4 + (size_t)t * (DM / 2));
    }
}
DI void phase_peer(const Frame& F, const Args& a, int layer, const bf16_t* SK, float* outf) {
    LAS unsigned char* sel = F.lds;
    bf16_t* XB = wsb(F, WS_XB);
    const int g0 = F.vcu, g1 = F.vcu + F.G, ng = S / 32;
    if (F.vcu & 1) {
        if (g0 < ng) peer_select_group(F, SK, g0, sel);
        if (g1 < ng) peer_select_group(F, SK, g1, sel + 32768);
        __syncthreads();
        if (g0 < ng) peer_gather_group(F, a, layer, outf, XB, g0, sel);
        if (g1 < ng) peer_gather_group(F, a, layer, outf, XB, g1, sel + 32768);
    } else {
        if (g0 < ng) peer_select_group(F, SK, g0, sel);
        __syncthreads();
        if (g0 < ng) peer_gather_group(F, a, layer, outf, XB, g0, sel);
        if (g1 < ng) peer_select_group(F, SK, g1, sel + 32768);
        __syncthreads();
        if (g1 < ng) peer_gather_group(F, a, layer, outf, XB, g1, sel + 32768);
    }
    for (int g = F.vcu + 2 * F.G; g < ng; g += F.G) { __syncthreads(); peer_select_group(F, SK, g, sel); __syncthreads(); peer_gather_group(F, a, layer, outf, XB, g, sel); }
}

#ifndef GEMM_SP2
#define GEMM_SP2 true
#endif
#ifndef GEMM_ALIGN_EPI
#define GEMM_ALIGN_EPI true
#endif
DI void run_merge_chain(const Frame& F, const unsigned char* O8a, const unsigned char* Wbr, const pg8::Epi<5>& E) {
    pg8::Gemm g{(const bf16_t*)O8a, (const bf16_t*)Wbr, S, DM, 256, 256, 256, 0, (long)S * 512, (long)DM * 512 * 2}; pg8::ChainOrder<4> So; So.init(S, DM, F.G, (int)blockIdx.x);
    pg8::gemm_phase<pg8::Epi<5>, pg8::ChainOrder<4>, GEMM_ALIGN_EPI, GEMM_SP2, true, 121, 124, false>(F.lds, g, So, E);
}
template <int MODE, bool F8 = false, int SC0 = 127, int SC1 = 127, bool F4 = false> DI void run_gemm(const Frame& F, const bf16_t* A, int lda, const bf16_t* Bt, int ldb, int M, int N, int K, long apn, const pg8::Epi<MODE>& E, int rot = 0) {
    pg8::Gemm g{A, Bt, M, N, K, lda, ldb, apn}; pg8::StaticOrder So; So.init(M, N, F.G, (F.G == 256) ? (int)((blockIdx.x + (unsigned)rot) & 255u) : (int)blockIdx.x);
    pg8::gemm_phase<pg8::Epi<MODE>, pg8::StaticOrder, GEMM_ALIGN_EPI, GEMM_SP2, F8, SC0, SC1, F4>(F.lds, g, So, E);
}
#ifndef MK_CHECK
#define MK_CHECK 0
#endif
#ifndef MK_CHECK_WORD
#define MK_CHECK_WORD 0
#endif

#if MK_CHECK
namespace chk {
constexpr int NS = 64;
__device__ const int SAMPLES[NS] = {0, 1, 2, 31, 32, 63, 64, 127, 128, 129, 255, 256, 257, 300, 383, 384, 511, 512, 513, 767, 768, 1000, 1023, 1024, 1025, 1279, 1280, 2047, 2048, 2049, 3071, 3072,
    4095, 4096, 5000, 6143, 6144, 7777, 8191, 8192, 8193, 9999, 10239, 10240, 11111, 12287, 12288, 12289, 13000, 13311, 13312, 14000, 14335, 14336, 15000, 15359, 15360, 15871, 16127, 16128, 16129, 16255, 16256, 16383};
DI float bsum(const Frame& F, float v) {
    v = wave_sum(v);
    __syncthreads();
    if (F.lane == 0) F.MISC[16 + F.wave] = __float_as_uint(v);
    __syncthreads();
    float s = 0.f;
    for (int w = 0; w < 8; ++w) s += __uint_as_float(F.MISC[16 + w]);
    return s;
}
DI float bmax(const Frame& F, float v) {
#pragma unroll
    for (int o = 1; o < 64; o <<= 1) v = fmaxf(v, __shfl_xor(v, o));
    __syncthreads();
    if (F.lane == 0) F.MISC[16 + F.wave] = __float_as_uint(v);
    __syncthreads();
    float s = -INFINITY;
    for (int w = 0; w < 8; ++w) s = fmaxf(s, __uint_as_float(F.MISC[16 + w]));
    return s;
}
DI void verdict(const Frame& F, float err, float nrm, float tol, int code) {
    const float e = bsum(F, err), n = bsum(F, nrm);
    if (F.tid == 0) { const bool bad = !(e <= tol * tol * n + 1e-12f); if (bad) { atomicAdd((unsigned*)(F.ws + WS_CTL) + CW_CHK, 1u); atomicAdd((unsigned*)(F.ws + WS_CTL) + CW_CHK + 64 * (1 + code), 1u); } }
}
DI float sigm(float z) { return 1.0f / (1.0f + expf(-z)); }
DI float rope_inv(int j) { return powf(10000.0f, -(float)j / 32.0f); }
DI float t5_naive(const float* t5, int col, int rel) {
    int n = rel > 0 ? rel : 0; int b;
    if (n < 16) b = n; else { b = 16 + (int)(logf((float)n / 16.0f) / logf(64.0f) * 16.0f); if (b > 31) b = 31; }
    return t5[b * 16 + col];
}
DI void s1(const Frame& F, const Args& a, int layer) {
    const bf16_t* X = wsb(F, WS_XB); const float* W = a.in[3] + (size_t)layer * DM * 4672;
    const bf16_t* H = wsb(F, WS_H); const bf16_t* VT = wsb(F, WS_VT);
    for (int u = F.vcu; u < NS; u += F.G) { const int t = SAMPLES[u]; float err = 0.f, nrm = 0.f;
        for (int c = F.tid; c < 4672; c += 512) { float ref = 0.f; for (int k = 0; k < DM; ++k) ref += bf1(X[(size_t)t * DM + k]) * W[(size_t)k * 4672 + c];
            const int d = win_map(c); const float got = d < HW ? bf1(H[(size_t)t * HW + d]) : bf1(VT[(size_t)(d - HW) * S + t]); err += (ref - got) * (ref - got); nrm += ref * ref; }
        verdict(F, err, nrm, 0.06f, 0); }
}
DI void s2(const Frame& F, const Args& a, int layer) {
    const bf16_t* H = wsb(F, WS_H); const int* pos = (const int*)a.in[1];
    for (int u = F.vcu; u < NS; u += F.G) { const int t = SAMPLES[u]; float err = 0.f, nrm = 0.f;
        float ssq = 0.f; for (int k = 0; k < 512; ++k) { const float v = bf1(H[(size_t)t * HW + H_DCQ + k]); ssq += v * v; }
        const float rq = 1.0f / sqrtf(ssq / 512.0f + 1e-6f);
        float ssk = 0.f; for (int k = 0; k < 256; ++k) { const float v = bf1(H[(size_t)t * HW + H_DCKV + k]); ssk += v * v; }
        const float rk = 1.0f / sqrtf(ssk / 256.0f + 1e-6f);
        for (int c = F.tid; c < 512; c += 512) { const float ref = bf1(H[(size_t)t * HW + H_DCQ + c]) * rq * a.in[14][layer * 512 + c]; const float got = bf1(wsb(F, WS_CQN)[(size_t)t * 512 + c]); err += (ref - got) * (ref - got); nrm += ref * ref; }
        for (int c = F.tid; c < 256; c += 512) { const float ref = bf1(H[(size_t)t * HW + H_DCKV + c]) * rk * a.in[15][layer * 256 + c]; const float got = bf1(wsb(F, WS_CKVN)[(size_t)t * 256 + c]); err += (ref - got) * (ref - got); nrm += ref * ref; }
        for (int c = F.tid; c < 256; c += 512) { const int h = c >> 6, j = c & 63, jj = j & 31; const float x1 = bf1(H[(size_t)t * HW + H_DKR + jj]), x2 = bf1(H[(size_t)t * HW + H_DKR + jj + 32]);
            const float ang = (float)pos[t] * rope_inv(jj); const float ref = j < 32 ? x1 * cosf(ang) - x2 * sinf(ang) : x1 * sinf(ang) + x2 * cosf(ang);
            const float got = bf1(wsb(F, WS_KD)[(size_t)t * 768 + h * 192 + 128 + j]); err += (ref - got) * (ref - got); nrm += ref * ref; }
        verdict(F, err, nrm, 0.02f, 1); }
}
DI void s3(const Frame& F, const Args& a, int layer) {
    const int* pos = (const int*)a.in[1]; const float* Wq = a.in[16] + (size_t)layer * 512 * 768; const float* Wkv = a.in[17] + (size_t)layer * 256 * 1024;
    LAS float* pre = (LAS float*)F.lds;
    for (int u = F.vcu; u < NS; u += F.G) { const int t = SAMPLES[u]; float err = 0.f, nrm = 0.f;
        __syncthreads();
        for (int n = F.tid; n < 768; n += 512) { float r = 0.f; for (int k = 0; k < 512; ++k) r += bf1(wsb(F, WS_CQN)[(size_t)t * 512 + k]) * Wq[(size_t)k * 768 + n]; pre[n] = r; }
        __syncthreads();
        for (int n = F.tid; n < 768; n += 512) { const int h = n / 192, j = n % 192; float ref = pre[n];
            if (j >= 128) { const int jj = (j - 128) & 31; const float x1 = pre[h * 192 + 128 + jj], x2 = pre[h * 192 + 128 + jj + 32]; const float ang = (float)pos[t] * rope_inv(jj);
                ref = (j - 128) < 32 ? x1 * cosf(ang) - x2 * sinf(ang) : x1 * sinf(ang) + x2 * cosf(ang); }
            const float got = bf1(wsb(F, WS_QD)[(size_t)t * 768 + n]); err += (ref - got) * (ref - got); nrm += ref * ref; }
        for (int n = F.tid; n < 1024; n += 512) { float ref = 0.f; for (int k = 0; k < 256; ++k) ref += bf1(wsb(F, WS_CKVN)[(size_t)t * 256 + k]) * Wkv[(size_t)k * 1024 + n];
            const int h = n >> 8, j = n & 255; const float got = j < 128 ? bf1(wsb(F, WS_KD)[(size_t)t * 768 + h * 192 + j]) : bf1(wsb(F, WS_VDT)[(size_t)(h * 128 + j - 128) * S + t]);
            err += (ref - got) * (ref - got); nrm += ref * ref; }
        verdict(F, err, nrm, 0.02f, 2); }
}
DI void s4(const Frame& F, const Args& a, int layer) {
    const int* pos = (const int*)a.in[1]; const float* t5 = a.in[2]; const bf16_t* H = wsb(F, WS_H);
    LAS float* lg = (LAS float*)F.lds;
    LAS float* qv = (LAS float*)(F.lds + 65536);
    LAS float* ga = (LAS float*)(F.lds + 65536 + 1024);
    LAS float* op = (LAS float*)(F.lds + 65536 + 2048);
    LAS float* o1 = (LAS float*)(F.lds + 65536 + 2048 + 2048);
    LAS int* selb = (LAS int*)(F.lds + 65536 + 8192);
    for (int u = F.vcu; u < NS * 20; u += F.G) {
        const int q = SAMPLES[u / 20], mh = u % 20;
        int mix, h; if (mh < 4) { mix = 0; h = mh; } else if (mh < 12) { mix = 1; h = mh - 4; } else if (mh < 16) { mix = 2; h = mh - 12; } else { mix = 3; h = mh - 16; }
        const int DQ = mix == 0 ? 128 : (mix == 3 ? 192 : 64), DVV = mix == 1 ? 64 : 128;
        const int nmaps = mix == 2 ? 2 : 1;
        const float scale = 1.0f / sqrtf((float)DQ);
        const int bcol = mix == 0 ? h : (mix == 1 ? 4 + h : 12 + h);
        float errs = 0.f, nrms = 0.f;
        for (int mp = 0; mp < nmaps; ++mp) {
            const bf16_t* Qp; const bf16_t* Kp; int ldk; const bf16_t* Vp;
            if (mix == 0) { Qp = H + (size_t)q * HW + H_AQ + h * 128; Kp = H + H_AK + h * 128; ldk = HW; Vp = wsb(F, WS_VT) + (size_t)(VT_A + h * 128) * S; }
            else if (mix == 1) { Qp = H + (size_t)q * HW + H_BQ + h * 64; Kp = H + H_BK + (h >> 2) * 64; ldk = HW; Vp = wsb(F, WS_VT) + (size_t)(VT_B + (h >> 2) * 64) * S; }
            else if (mix == 2) { Qp = H + (size_t)q * HW + H_CQ + h * 128 + mp * 64; Kp = H + H_CK + h * 128 + mp * 64; ldk = HW; Vp = wsb(F, WS_VT) + (size_t)(VT_C + h * 128) * S; }
            else { Qp = wsb(F, WS_QD) + (size_t)q * 768 + h * 192; Kp = wsb(F, WS_KD) + h * 192; ldk = 768; Vp = wsb(F, WS_VDT) + (size_t)(h * 128) * S; }
            __syncthreads();
            for (int d = F.tid; d < DQ; d += 512) qv[d] = bf1(Qp[d]);
            if (F.tid < 64) { ga[F.tid] = 0.f; selb[F.tid] = 0; }
            __syncthreads();
            const int own = q >> 8;
            if (mix == 0) {
                for (int idx = F.tid; idx < own * 128; idx += 512) { const int n = idx >> 7, d = idx & 127; float sm = 0.f; for (int i = 0; i < 256; ++i) sm += bf1(Kp[(size_t)(n * 256 + i) * ldk + d]); atomicAdd((float*)&ga[n], qv[d] * (sm / 256.0f)); }
                __syncthreads();
                if (F.tid == 0) { for (int rnk = 0; rnk < 3 && rnk < own; ++rnk) { int best = -1; float bv = -INFINITY; for (int n = 0; n < own; ++n) if (!selb[n] && ga[n] > bv) { bv = ga[n]; best = n; } if (best >= 0) selb[best] = 1; } }
                __syncthreads();
            }
            float mx = -INFINITY;
            for (int k = F.tid; k <= q; k += 512) {
                bool valid = true;
                if (mix == 0) { const int blk = k >> 8; valid = (blk == own) ? true : (selb[blk] != 0); }
                if (mix == 1) valid = (q - k) < 128;
                float l = -INFINITY;
                if (valid) { float dot = 0.f; for (int d = 0; d < DQ; ++d) dot += qv[d] * bf1(Kp[(size_t)k * ldk + d]); l = dot * scale; if (mix != 3) l += t5_naive(t5, bcol, pos[q] - pos[k]); }
                lg[k] = l; mx = fmaxf(mx, l);
            }
            mx = bmax(F, mx);
            const float sink = (mix == 1) ? a.in[8][layer * 8 + h] : -INFINITY;
            if (mix == 1) mx = fmaxf(mx, sink);
            float sm = 0.f;
            for (int k = F.tid; k <= q; k += 512) { const float p = expf(lg[k] - mx); lg[k] = p; sm += p; }
            sm = bsum(F, sm);
            if (mix == 1) sm += expf(sink - mx);
            __syncthreads();
            { const int dv = F.tid % 128, part = F.tid / 128; float acc = 0.f;
              if (dv < DVV) for (int k = part; k <= q; k += 4) acc += lg[k] * bf1(Vp[(size_t)dv * S + k]);
              op[part * 128 + dv] = acc; }
            __syncthreads();
            float val = 0.f;
            if (F.tid < DVV) val = (op[F.tid] + op[128 + F.tid] + op[256 + F.tid] + op[384 + F.tid]) / sm;
            if (mix == 2 && mp == 0) { if (F.tid < 128) o1[F.tid] = val; __syncthreads(); continue; }
            if (mix == 2) {
                float d1 = 0.f, d2 = 0.f; for (int i = 0; i < 64; ++i) { d1 += a.in[9][layer * 64 + i] * a.in[10][layer * 64 + i]; d2 += a.in[11][layer * 64 + i] * a.in[12][layer * 64 + i]; }
                const float li = 0.8f - 0.6f * expf(-0.3f * (float)layer), lam = expf(d1) - expf(d2) + li;
                float x = (F.tid < 128) ? (o1[F.tid] - lam * val) : 0.f;
                const float ms = bsum(F, x * x) / 128.0f;
                val = x / sqrtf(ms + 1e-6f) * ((F.tid < 128) ? a.in[13][layer * 128 + F.tid] : 0.f) * (1.0f - li);
            }
            if (F.tid < DVV) { const int ocol = (mix == 1) ? h * 64 + F.tid : h * 128 + F.tid; const float got = bf1(wsb(F, WS_O)[(size_t)mix * S * 512 + (size_t)q * 512 + ocol]); errs = (val - got) * (val - got); nrms = val * val; }
        }
        verdict(F, errs, nrms, 0.03f, 3 + mix);
    }
}
DI void s5(const Frame& F, const Args& a, int layer) {
    const bf16_t* X = wsb(F, WS_XB);
    for (int u = F.vcu; u < NS; u += F.G) { const int t = SAMPLES[u]; float err = 0.f, nrm = 0.f, err2 = 0.f, nrm2 = 0.f;
        for (int c = F.tid; c < 8192; c += 512) { const int n = c >> 11, cc = c & 2047; const float* W = a.in[4] + ((size_t)layer * 4 + n) * DM * DM; float z = a.in[5][(size_t)layer * 8192 + c];
            for (int k = 0; k < DM; ++k) z += bf1(X[(size_t)t * DM + k]) * W[(size_t)k * DM + cc];
            const float ref = sigm(z), got = __builtin_amdgcn_cvt_pk_f32_fp8((int)(F.ws + WS_GT)[(size_t)t * 8192 + c], false)[0]; err += (ref - got) * (ref - got); nrm += ref * ref; }
        for (int c = F.tid; c < DM; c += 512) { float ref = 0.f;
            for (int n = 0; n < 4; ++n) { const float* W = a.in[6] + ((size_t)layer * 4 + n) * 512 * DM; float br = 0.f; for (int j = 0; j < 512; ++j) br += bf1(wsb(F, WS_O)[(size_t)n * S * 512 + (size_t)t * 512 + j]) * W[(size_t)j * DM + c];
                ref += __builtin_amdgcn_cvt_pk_f32_fp8((int)(F.ws + WS_GT)[(size_t)t * 8192 + n * DM + c], false)[0] * br; }
            const float got = bf1(wsb(F, WS_H)[(size_t)t * DM + c]); err2 += (ref - got) * (ref - got); nrm2 += ref * ref; }
        verdict(F, err, nrm, 0.12f, 7); verdict(F, err2, nrm2, 0.12f, 8); }
}
DI void s6(const Frame& F, const Args& a, int layer) {
    const bf16_t* X = wsb(F, WS_XB); const float* W = a.in[7] + (size_t)layer * DM * DM; const bf16_t* Y = wsb(F, WS_GT);
    for (int u = F.vcu; u < NS; u += F.G) { const int t = SAMPLES[u]; float err = 0.f, nrm = 0.f;
        for (int c = F.tid; c < DM; c += 512) { float ref = 0.f; for (int j = 0; j < DM; ++j) ref += bf1(wsb(F, WS_H)[(size_t)t * DM + j]) * W[(size_t)j * DM + c];
            const float full = DN_ALPHA * bf1(X[(size_t)t * DM + c]) + ref, got = bf1(Y[(size_t)t * DM + c]); err += (full - got) * (full - got); nrm += full * full; }
        verdict(F, err, nrm, 0.006f, 9); }
}
DI void poison(const Frame& F) {
    const unsigned bad = __hip_atomic_load((unsigned*)(F.ws + WS_CTL) + CW_CHK + 64 * MK_CHECK_WORD, __ATOMIC_RELAXED, __HIP_MEMORY_SCOPE_AGENT);
    const float sc = 1.0f + (float)bad / 256.0f;
    for (size_t i = (size_t)F.vcu * 512 + F.tid; i < (size_t)S * DM / 4; i += (size_t)F.G * 512) { f32x4 v = ((f32x4*)F.out)[i]; v = v * sc; ((f32x4*)F.out)[i] = v; }
}
}
#endif

#ifndef MK_CHECK
#define MK_CHECK 0
#endif
#ifndef MK_CHECK_WORD
#define MK_CHECK_WORD 0
#endif
#ifndef MK_CHECK_LAYER
#define MK_CHECK_LAYER 0
#endif
#ifndef MERGE_CHAIN
#define MERGE_CHAIN 1
#endif
#ifndef MK_X_BAR2
#define MK_X_BAR2 0
#endif
#ifndef MK_PROBE_REL
#define MK_PROBE_REL (-2)
#endif
#ifndef MK_PROBE_REPS
#define MK_PROBE_REPS 1
#endif
#ifndef MK_PER_PHASE
#define MK_PER_PHASE 0
#endif
constexpr int NPL = 11, NPHASES = 1 + NL * NPL;
DI void run_layer(const Frame& F, const Args& args, const XcdBarrier& bar, const int layer, const int lo, const int hi) {
#define PH(k) (lo <= (k) && (k) < hi)
#define SEAM(k) do { if (PH(k) && PH((k) + 1)) { xcd_barrier(bar); if (MK_X_BAR2) xcd_barrier(bar); } } while (0)
        const int pb = 1 + layer * NPL;
        unsigned char* wl = F.ws + WS_W + (size_t)layer * WL_STRIDE;
        if (PH(pb + 0)) {
            { pg8::Epi<0> E{}; E.O = wsb(F, WS_H); E.ldc = HW; E.grp = 128; run_gemm<0, true, 121, 127>(F, (const bf16_t*)(F.ws + WS_XB8), DM / 2, (const bf16_t*)(wl + W_IN), DM / 2, S, HW, DM / 2, 0, E); }
            { pg8::Epi<0> E{}; E.O = wsb(F, WS_VT); E.ldc = S; E.grp = 128; run_gemm<0, true, 127, 121>(F, (const bf16_t*)(wl + W_IN + (size_t)HW * DM), DM / 2, (const bf16_t*)(F.ws + WS_XB8), DM / 2, VT_ROWS, S, DM / 2, 0, E, 128); }
            { pg8::Epi<1> E{}; E.O = wsb(F, WS_GT); E.ldc = 8192; E.bias = args.in[5] + (size_t)layer * 8192; run_gemm<1, false, 121, 126, true>(F, (const bf16_t*)(F.ws + WS_XB4), DM / 4, (const bf16_t*)(wl + W_G), DM / 4, S, 8192, DM / 4, 0, E); }
        }
        SEAM(pb + 0);
        if (PH(pb + 1)) phase_prep(F, args, layer);
        SEAM(pb + 1);
        if (PH(pb + 2)) {
            { pg8::Epi<0> E{}; E.O = wsb(F, WS_QD); E.ldc = 768; E.grp = 128; run_gemm<0>(F, wsb(F, WS_CQN), 512, (const bf16_t*)(wl + W_UQ), 512, S, 768, 512, 0, E); }
            { pg8::Epi<0> E{}; E.O = wsb(F, WS_KD); E.ldc = 768; E.grp = 192; run_gemm<0>(F, wsb(F, WS_CKVN), 256, (const bf16_t*)(wl + W_UKV), 256, S, 512, 256, 0, E, 64); }
            { pg8::Epi<0> E{}; E.O = wsb(F, WS_VDT); E.ldc = S; E.grp = 128; run_gemm<0>(F, (const bf16_t*)(wl + W_UKV) + (size_t)512 * 256, 256, wsb(F, WS_CKVN), 256, 512, S, 256, 0, E, 192); }
        }
        SEAM(pb + 2);
        if (PH(pb + 3)) { phase_ropeq(F, args); phase_moba_select(F, args, layer); }
        SEAM(pb + 3);
        if (PH(pb + 4)) {
            phase_attention<0>(F, args, layer);
            if (layer + 1 < NL) convert_weights(F, args, layer + 1, layer + 2);
            __syncthreads();
            phase_attention<1>(F, args, layer);
        }
        SEAM(pb + 4);
        if (PH(pb + 5)) phase_mixer_combine(F, args, layer);
        SEAM(pb + 5);
        if (PH(pb + 6)) {
            if (MERGE_CHAIN) { pg8::Epi<5> E{}; E.O = wsb(F, WS_H); E.ldc = DM; E.G = (const bf16_t*)(F.ws + WS_GT); E.ldg = 8192; E.O8 = F.ws + WS_XB8;
                run_merge_chain(F, F.ws + WS_O8, wl + W_BR, E); }
            else
            for (int n = 0; n < 4; ++n) { pg8::Epi<2> E{}; E.O = wsb(F, WS_H); E.ldc = DM; E.G = (const bf16_t*)(F.ws + WS_GT + n * DM); E.ldg = 8192; E.first = (n == 0); E.O8 = (n == 3) ? F.ws + WS_XB8 : (unsigned char*)nullptr;
                run_gemm<2, true, 121, 124>(F, (const bf16_t*)(F.ws + WS_O8 + (size_t)n * S * 512), 256, (const bf16_t*)(wl + W_BR) + (size_t)n * DM * 512, 256, S, DM, 256, 0, E); }
        }
        SEAM(pb + 6);
        if (PH(pb + 7)) { pg8::Epi<3> E{}; E.O = F.ws + WS_GT; E.ldc = DM; E.X = wsb(F, WS_XB); E.alpha = DN_ALPHA;
            run_gemm<3, true, 121, 124>(F, (const bf16_t*)(F.ws + WS_XB8), DM / 2, (const bf16_t*)(wl + W_O), DM / 2, S, DM, DM / 2, 0, E); }
        SEAM(pb + 7);
        if (PH(pb + 8)) phase_ln1(F, args, layer);
        SEAM(pb + 8);
        if (PH(pb + 9)) { pg8::Epi<0> E{}; E.O = wsb(F, WS_H); E.ldc = DM; E.grp = 128; run_gemm<0>(F, wsb(F, WS_XB), DM, (const bf16_t*)(wl + W_PQ), DM, S, DM, DM, 0, E); }
        SEAM(pb + 9);
        if (PH(pb + 10)) phase_peer(F, args, layer, (const bf16_t*)(wl + W_SK), (layer == NL - 1) ? F.out : (float*)nullptr);
        SEAM(pb + 10);
#undef PH
#undef SEAM
}
__global__ void __launch_bounds__(512, 2) fwd_kernel(Args args) {
    extern __shared__ __attribute__((aligned(16))) unsigned char lds_raw[];
    Frame F;
    F.lds = (LAS unsigned char*)lds_raw; F.MISC = (volatile LAS unsigned*)(F.lds + MISC_OFF);
    F.tid = threadIdx.x; F.lane = F.tid & 63; F.wave = __builtin_amdgcn_readfirstlane(F.tid >> 6);
    F.G = gridDim.x; { const int bx = blockIdx.x; F.vcu = (F.G % 8 == 0) ? (bx % 8) * (F.G / 8) + bx / 8 : bx; }
    F.ws = args.ws; F.out = args.out;
    if (F.tid < 64) F.MISC[F.tid] = 0u;
    __syncthreads();
    const int lo = args.ph_lo, hi = args.ph_hi;
    unsigned* barw = (unsigned*)(F.ws + WS_CTL) + CW_BAR + (lo > 0 ? XCD_BAR_WORDS : 0);
    XcdBarrier bar; bar.bar = barw; bar.x = 0; bar.st = F.MISC;
    if (hi - lo > 1) bar = xcd_barrier_post(barw, F.MISC);
#define PH(k) (lo <= (k) && (k) < hi)
#define SEAM(k) do { if (PH(k) && PH((k) + 1)) { xcd_barrier(bar); if (MK_X_BAR2) xcd_barrier(bar); } } while (0)
    if (PH(0)) phase_prologue(F, args);
    SEAM(0);
    run_layer(F, args, bar, 0, lo, hi);
    run_layer(F, args, bar, 1, lo, hi);
#undef PH
#undef SEAM
}


#if MK_CHECK
__global__ void __launch_bounds__(512, 1) chk_kernel(Args args, int stage, int layer) {
    extern __shared__ __attribute__((aligned(16))) unsigned char lds_raw[];
    Frame F;
    F.lds = (LAS unsigned char*)lds_raw; F.MISC = (volatile LAS unsigned*)(F.lds + MISC_OFF);
    F.tid = threadIdx.x; F.lane = F.tid & 63; F.wave = __builtin_amdgcn_readfirstlane(F.tid >> 6);
    F.G = gridDim.x; { const int bx = blockIdx.x; F.vcu = (F.G % 8 == 0) ? (bx % 8) * (F.G / 8) + bx / 8 : bx; }
    F.ws = args.ws; F.out = args.out;
    if (stage == 1) { chk::s1(F, args, layer); chk::s2(F, args, layer); chk::s3(F, args, layer); }
    if (stage == 4) chk::s4(F, args, layer);
    if (stage == 5) chk::s5(F, args, layer);
    if (stage == 6) chk::s6(F, args, layer);
    if (stage == 99) chk::poison(F);
}
#endif
extern "C" void kernel_launch(void* const* d_in, const int* in_sizes, int n_in, void* d_out, int out_size, void* d_ws, size_t ws_size, hipStream_t stream) {
    static int grid = 0;
    if (grid == 0) {
        if (n_in != 26 || out_size != S * DM || ws_size < WS_END) { fprintf(stderr, "kernel_launch: unexpected problem (n_in %d, out %d, ws %zu); nothing launched\n", n_in, out_size, ws_size); grid = -1; return; }
        int dev = 0, cus = 0, per_cu = 0;
        if (hipGetDevice(&dev) != hipSuccess || hipDeviceGetAttribute(&cus, hipDeviceAttributeMultiprocessorCount, dev) != hipSuccess) { grid = -1; return; }
        if (hipFuncSetAttribute((const void*)fwd_kernel, hipFuncAttributeMaxDynamicSharedMemorySize, LDS_BYTES) != hipSuccess) { fprintf(stderr, "kernel_launch: hipFuncSetAttribute failed\n"); grid = -1; return; }
        if (hipOccupancyMaxActiveBlocksPerMultiprocessor(&per_cu, (const void*)fwd_kernel, 512, LDS_BYTES) != hipSuccess || per_cu < 1) { fprintf(stderr, "kernel_launch: occupancy query says %d blocks per CU\n", per_cu); }
        (void)hipGetLastError();
        grid = cus;
    }
    if (grid < 0) return;
    (void)hipMemsetAsync((char*)d_ws + WS_CTL, 0, CTL_ZERO_BYTES, stream);
    Args a{};
    for (int i = 0; i < 26; ++i) a.in[i] = (const float*)d_in[i];
    a.out = (float*)d_out; a.ws = (unsigned char*)d_ws;
#if MK_CHECK
    {
        static bool once = false; if (!once) { once = true; (void)hipFuncSetAttribute((const void*)chk_kernel, hipFuncAttributeMaxDynamicSharedMemorySize, LDS_BYTES); }
        const int pb = 1 + MK_CHECK_LAYER * NPL; const int cuts[6] = {0, pb + 4, pb + 6, pb + 7, pb + 8, NPHASES}; const int stg[5] = {1, 4, 5, 6, 0};
        for (int i = 0; i < 5; ++i) { (void)hipMemsetAsync((unsigned*)((char*)d_ws + WS_CTL) + CW_BAR, 0, 2 * XCD_BAR_WORDS * 4, stream); a.ph_lo = cuts[i]; a.ph_hi = cuts[i + 1]; hipLaunchKernelGGL(fwd_kernel, dim3(grid), dim3(512), LDS_BYTES, stream, a);
            if (stg[i]) hipLaunchKernelGGL(chk_kernel, dim3(grid), dim3(512), LDS_BYTES, stream, a, stg[i], MK_CHECK_LAYER); }
        hipLaunchKernelGGL(chk_kernel, dim3(grid), dim3(512), LDS_BYTES, stream, a, 99, 0);
    }
#elif MK_PROBE_REL > -2
    {
        unsigned* ctl = (unsigned*)((char*)d_ws + WS_CTL);
        auto launch = [&](int lo, int hi) { if (hi <= lo) return; (void)hipMemsetAsync(ctl + CW_BAR, 0, 2 * XCD_BAR_WORDS * 4, stream); a.ph_lo = lo; a.ph_hi = hi; hipLaunchKernelGGL(fwd_kernel, dim3(grid), dim3(512), LDS_BYTES, stream, a); };
        int cur = 0;
        const int nl = (MK_PROBE_REL == -1) ? 1 : NL;
        for (int layer = 0; layer < nl; ++layer) {
            const int p = (MK_PROBE_REL == -1) ? 0 : 1 + layer * NPL + MK_PROBE_REL;
            launch(cur, p);
            for (int r = 0; r <= MK_PROBE_REPS; ++r) {
                (void)hipMemsetAsync(ctl + CW_Q, 0, 4096 * 4, stream);
#ifdef MK_PROBE_MIXER
                if (r > 0) { (void)hipMemsetAsync(ctl + CW_Q, 0x04, 4096 * 4, stream); (void)hipMemsetAsync(ctl + CW_Q + layer * 256 + 64 * MK_PROBE_MIXER, 0, 4, stream); }
#endif
                if (MK_PROBE_REL == 10 && r == 0) (void)hipMemcpyAsync((char*)d_ws + WS_GT, (char*)d_ws + WS_XB, (size_t)S * DM * 2, hipMemcpyDeviceToDevice, stream);
                if (MK_PROBE_REL == 10 && r > 0) (void)hipMemcpyAsync((char*)d_ws + WS_XB, (char*)d_ws + WS_GT, (size_t)S * DM * 2, hipMemcpyDeviceToDevice, stream);
                if (MK_PROBE_REL == 3 && r == 0) (void)hipMemcpyAsync((char*)d_ws + WS_PART, (char*)d_ws + WS_QD, (size_t)S * 768 * 2, hipMemcpyDeviceToDevice, stream);
                if (MK_PROBE_REL == 3 && r > 0) { (void)hipMemcpyAsync((char*)d_ws + WS_QD, (char*)d_ws + WS_PART, (size_t)S * 768 * 2, hipMemcpyDeviceToDevice, stream); (void)hipMemsetAsync(ctl + CW_MOBA, 0, 2048 * 4, stream); }
                launch(p, p + 1);
            }
            cur = p + 1;
        }
        launch(cur, NPHASES);
    }
#elif MK_PER_PHASE
    for (int p = 0; p < NPHASES; ++p) { a.ph_lo = p; a.ph_hi = p + 1; hipLaunchKernelGGL(fwd_kernel, dim3(grid), dim3(512), LDS_BYTES, stream, a); }
#else
    a.ph_lo = 0; a.ph_hi = NPHASES;
    hipLaunchKernelGGL(fwd_kernel, dim3(grid), dim3(512), LDS_BYTES, stream, a);
#endif
}
```

```cpp
#include <hip/hip_runtime.h>
#include <cstdio>
#include <cstdint>
#include <cmath>

#define DI __device__ __forceinline__
#define LAS __attribute__((address_space(3)))
#define GAS __attribute__((address_space(1)))
typedef unsigned short bf16_t;
typedef short bf16x8 __attribute__((ext_vector_type(8)));
typedef float f32x4 __attribute__((ext_vector_type(4)));
typedef float f32x2 __attribute__((ext_vector_type(2)));
typedef float f32x16 __attribute__((ext_vector_type(16)));
typedef unsigned u32x4 __attribute__((ext_vector_type(4)));
typedef unsigned u32x2 __attribute__((ext_vector_type(2)));
typedef int i32x4 __attribute__((ext_vector_type(4)));
typedef __bf16 bf16x2_t __attribute__((ext_vector_type(2)));

DI unsigned cvtpk(float lo, float hi) { f32x2 v = {lo, hi}; bf16x2_t b = __builtin_convertvector(v, bf16x2_t); return __builtin_bit_cast(unsigned, b); }
DI float bf_lo(unsigned u) { return __uint_as_float(u << 16); }
DI float bf_hi(unsigned u) { return __uint_as_float(u & 0xffff0000u); }
DI float bf1(bf16_t u) { return __uint_as_float((unsigned)u << 16); }
DI float ex2(float x) { return __builtin_amdgcn_exp2f(x); }
DI float wave_sum(float v) {
#pragma unroll
    for (int o = 1; o < 64; o <<= 1) v += __shfl_xor(v, o);
    return v;
}
DI float xhalf(float v) { return __shfl_xor(v, 32); }

namespace pg8 {
#define PG8_LAS __attribute__((address_space(3)))
#ifndef PG8_WGM
#define PG8_WGM 8
#endif
constexpr int BM = 256, BK = 64, HALF = 128, HTB = HALF * BK * 2  , STAGE_BYTES = 8 * HTB, NXCD = 8, WGM = PG8_WGM;

__host__ __device__ __forceinline__ int lds_byte(int r, int c) { const int st = (r >> 4) * 2 + (c >> 5), rr = r & 15, cc = c & 31, ob = rr * 64 + cc * 2; return st * 1024 + (ob ^ (((ob >> 9) & 1) << 5)); }
__host__ __device__ __forceinline__ void stage_rc(int b, int& R, int& C) { const int st = b / 1024, sb = b % 1024, swz = sb ^ (((sb >> 9) & 1) << 5); R = (st >> 1) * 16 + swz / 64; C = (st & 1) * 32 + (swz % 64) / 2; }
__host__ __device__ __forceinline__ int perm32(int rho) { const int n = rho >> 4, i = rho & 15; return 8 * (i >> 2) + 4 * n + (i & 3); }

struct Unit { int pm, pn, br; };
struct Gemm { const bf16_t* A; const bf16_t* Bt; int M, N, K, lda, ldb; long apn; long abr, bbr; };

struct StaticOrder {
    int nM, nN, nwg, G, c;
    __host__ __device__ void init(int M, int N, int G_, int c_) { nM = M / BM; nN = N / BM; nwg = nM * nN; G = G_; c = c_; }
    __host__ __device__ bool next(int i, Unit& u) const {
        const long L = (long)i * G + c; if (L >= nwg) return false;
        int wgid = (int)L; { const int q = nwg / NXCD, r = nwg % NXCD, xcd = wgid % NXCD, off = wgid / NXCD; wgid = (xcd < r ? xcd * (q + 1) : r * (q + 1) + (xcd - r) * q) + off; }
        const int nig = WGM * nN, gid = wgid / nig, fm = gid * WGM, gsz = (nM - fm) < WGM ? (nM - fm) : WGM;
        u.pm = fm + ((wgid % nig) % gsz); u.pn = (wgid % nig) / gsz; u.br = 0; return true;
    }
    __device__ __forceinline__ void a_ready(const Unit&) const {}
    __device__ __forceinline__ void done(const Unit&) const {}
};
template <int NBR> struct ChainOrder {
    StaticOrder so;
    __host__ __device__ void init(int M, int N, int G_, int c_) { so.init(M, N, G_, c_); }
    __host__ __device__ bool next(int i, Unit& u) const { const bool ok = so.next(i / NBR, u); u.br = i % NBR; return ok; }
    __device__ __forceinline__ void a_ready(const Unit&) const {}
    __device__ __forceinline__ void done(const Unit&) const {}
};

template <int MODE> struct Epi {
    static constexpr bool PERM = true, AFTER_DRAIN = false, CHAIN = (MODE == 5); static constexpr int NBR = 4;
    void* O; int ldc; int grp; const float* bias; const bf16_t* G; int ldg; const void* X; float alpha; int first; unsigned char* O8;
    static __device__ __forceinline__ f32x2 gclamp(f32x2 g) { return (f32x2){fmaxf(g.x, 0.001953125f), fmaxf(g.y, 0.001953125f)}; }
    __device__ __forceinline__ void rescale(f32x4 (&acc)[2][2][4][2], const Unit& u, int wr, int wc, int fr, int fq) const {
        const int row0 = u.pm * BM + wr * 64 + fr, colb = u.pn * BM + wc * 32 + 8 * fq;
        const float z = (u.br + 1 < NBR) ? 1.0f : 0.0f;
        const size_t gcol = (size_t)(u.br + 1 < NBR ? u.br : 0) * ldc;
#pragma unroll
        for (int ai = 0; ai < 2; ++ai)
#pragma unroll
            for (int m = 0; m < 4; ++m) {
                const size_t r = (size_t)(row0 + ai * HALF + m * 16);
#pragma unroll
                for (int bj = 0; bj < 2; ++bj) {
                    const int c = colb + bj * HALF;
                    const unsigned char* gp = (const unsigned char*)G + r * ldg + gcol + c;
                    asm volatile("" : "+v"(gp));
                    const u32x2 ga = *(const u32x2*)gp, gb = *(const u32x2*)(gp + ldc);
                    const f32x2 a0 = gclamp(__builtin_amdgcn_cvt_pk_f32_fp8((int)ga.x, false)), a1 = gclamp(__builtin_amdgcn_cvt_pk_f32_fp8((int)ga.x, true)), a2 = gclamp(__builtin_amdgcn_cvt_pk_f32_fp8((int)ga.y, false)), a3 = gclamp(__builtin_amdgcn_cvt_pk_f32_fp8((int)ga.y, true));
                    const f32x2 b0 = gclamp(__builtin_amdgcn_cvt_pk_f32_fp8((int)gb.x, false)), b1 = gclamp(__builtin_amdgcn_cvt_pk_f32_fp8((int)gb.x, true)), b2 = gclamp(__builtin_amdgcn_cvt_pk_f32_fp8((int)gb.y, false)), b3 = gclamp(__builtin_amdgcn_cvt_pk_f32_fp8((int)gb.y, true));
                    f32x4& v0 = acc[ai][bj][m][0]; f32x4& v1 = acc[ai][bj][m][1];
                    v0[0] *= z * a0.x * __builtin_amdgcn_rcpf(b0.x); v0[1] *= z * a0.y * __builtin_amdgcn_rcpf(b0.y); v0[2] *= z * a1.x * __builtin_amdgcn_rcpf(b1.x); v0[3] *= z * a1.y * __builtin_amdgcn_rcpf(b1.y);
                    v1[0] *= z * a2.x * __builtin_amdgcn_rcpf(b2.x); v1[1] *= z * a2.y * __builtin_amdgcn_rcpf(b2.y); v1[2] *= z * a3.x * __builtin_amdgcn_rcpf(b3.x); v1[3] *= z * a3.y * __builtin_amdgcn_rcpf(b3.y);
                    asm volatile("" : "+v"(v0), "+v"(v1));
                }
            }
    }
    __device__ __forceinline__ void operator()(const f32x4 (&acc)[2][2][4][2], const Unit& u, int wr, int wc, int fr, int fq) const {
        const int row0 = u.pm * BM + wr * 64 + fr, colb = u.pn * BM + wc * 32 + 8 * fq;
#pragma unroll
        for (int ai = 0; ai < 2; ++ai)
#pragma unroll
            for (int m = 0; m < 4; ++m) {
                const size_t r = (size_t)(row0 + ai * HALF + m * 16);
#pragma unroll
                for (int bj = 0; bj < 2; ++bj) {
                    const int c = colb + bj * HALF;
                    f32x4 v0 = acc[ai][bj][m][0], v1 = acc[ai][bj][m][1];
                    if constexpr (MODE == 0) {
                        const int dc = (c >> 7) * grp + (c & 127);
                        u32x4 w; w.x = cvtpk(v0[0], v0[1]); w.y = cvtpk(v0[2], v0[3]); w.z = cvtpk(v1[0], v1[1]); w.w = cvtpk(v1[2], v1[3]);
                        *(u32x4*)((bf16_t*)O + r * ldc + dc) = w;
                    } else if constexpr (MODE == 1) {
                        const f32x4 b0 = *(const f32x4*)(bias + c), b1 = *(const f32x4*)(bias + c + 4);
                        v0 = v0 + b0; v1 = v1 + b1;
#pragma unroll
                        for (int e = 0; e < 4; ++e) { v0[e] = __builtin_amdgcn_rcpf(1.0f + ex2(-1.4426950408889634f * v0[e])); v1[e] = __builtin_amdgcn_rcpf(1.0f + ex2(-1.4426950408889634f * v1[e])); }
                        int lo = __builtin_amdgcn_cvt_pk_fp8_f32(v0[0], v0[1], 0, false); lo = __builtin_amdgcn_cvt_pk_fp8_f32(v0[2], v0[3], lo, true);
                        int hi = __builtin_amdgcn_cvt_pk_fp8_f32(v1[0], v1[1], 0, false); hi = __builtin_amdgcn_cvt_pk_fp8_f32(v1[2], v1[3], hi, true);
                        *(u32x2*)((unsigned char*)O + r * ldc + c) = (u32x2){(unsigned)lo, (unsigned)hi};
                    } else if constexpr (MODE == 2) {
                        const u32x2 gq = *(const u32x2*)((const unsigned char*)G + r * ldg + c);
                        const f32x2 g0 = __builtin_amdgcn_cvt_pk_f32_fp8((int)gq.x, false), g1 = __builtin_amdgcn_cvt_pk_f32_fp8((int)gq.x, true), g2 = __builtin_amdgcn_cvt_pk_f32_fp8((int)gq.y, false), g3 = __builtin_amdgcn_cvt_pk_f32_fp8((int)gq.y, true);
                        bf16_t* op = (bf16_t*)O + r * ldc + c;
                        u32x4 old = (u32x4){0u, 0u, 0u, 0u};
                        if (!first) old = *(const u32x4*)op;
                        const float r0 = bf_lo(old.x) + g0.x * v0[0], r1 = bf_hi(old.x) + g0.y * v0[1], r2 = bf_lo(old.y) + g1.x * v0[2], r3 = bf_hi(old.y) + g1.y * v0[3];
                        const float r4 = bf_lo(old.z) + g2.x * v1[0], r5 = bf_hi(old.z) + g2.y * v1[1], r6 = bf_lo(old.w) + g3.x * v1[2], r7 = bf_hi(old.w) + g3.y * v1[3];
                        u32x4 w; w.x = cvtpk(r0, r1); w.y = cvtpk(r2, r3); w.z = cvtpk(r4, r5); w.w = cvtpk(r6, r7);
                        *(u32x4*)op = w;
                        if (O8) {
                            int lo = __builtin_amdgcn_cvt_pk_fp8_f32(r0 * 8.0f, r1 * 8.0f, 0, false); lo = __builtin_amdgcn_cvt_pk_fp8_f32(r2 * 8.0f, r3 * 8.0f, lo, true);
                            int hi = __builtin_amdgcn_cvt_pk_fp8_f32(r4 * 8.0f, r5 * 8.0f, 0, false); hi = __builtin_amdgcn_cvt_pk_fp8_f32(r6 * 8.0f, r7 * 8.0f, hi, true);
                            *(u32x2*)(O8 + r * ldc + c) = (u32x2){(unsigned)lo, (unsigned)hi}; }
                    } else if constexpr (MODE == 5) {
                        const u32x2 gq = *(const u32x2*)((const unsigned char*)G + r * ldg + 3 * ldc + c);
                        const f32x2 g0 = gclamp(__builtin_amdgcn_cvt_pk_f32_fp8((int)gq.x, false)), g1 = gclamp(__builtin_amdgcn_cvt_pk_f32_fp8((int)gq.x, true)), g2 = gclamp(__builtin_amdgcn_cvt_pk_f32_fp8((int)gq.y, false)), g3 = gclamp(__builtin_amdgcn_cvt_pk_f32_fp8((int)gq.y, true));
                        const float r0 = g0.x * v0[0], r1 = g0.y * v0[1], r2 = g1.x * v0[2], r3 = g1.y * v0[3], r4 = g2.x * v1[0], r5 = g2.y * v1[1], r6 = g3.x * v1[2], r7 = g3.y * v1[3];
#if defined(MK_CHECK) && MK_CHECK
                        { u32x4 w; w.x = cvtpk(r0, r1); w.y = cvtpk(r2, r3); w.z = cvtpk(r4, r5); w.w = cvtpk(r6, r7); *(u32x4*)((bf16_t*)O + r * ldc + c) = w; }
#endif
                        int lo = __builtin_amdgcn_cvt_pk_fp8_f32(r0 * 8.0f, r1 * 8.0f, 0, false); lo = __builtin_amdgcn_cvt_pk_fp8_f32(r2 * 8.0f, r3 * 8.0f, lo, true);
                        int hi = __builtin_amdgcn_cvt_pk_fp8_f32(r4 * 8.0f, r5 * 8.0f, 0, false); hi = __builtin_amdgcn_cvt_pk_fp8_f32(r6 * 8.0f, r7 * 8.0f, hi, true);
                        *(u32x2*)(O8 + r * ldc + c) = (u32x2){(unsigned)lo, (unsigned)hi};
                    } else if constexpr (MODE == 3) {
                        const u32x4 xx = *(const u32x4*)((const bf16_t*)X + r * ldc + c);
                        u32x4 w;
                        w.x = cvtpk(bf_lo(xx.x) * alpha + v0[0], bf_hi(xx.x) * alpha + v0[1]); w.y = cvtpk(bf_lo(xx.y) * alpha + v0[2], bf_hi(xx.y) * alpha + v0[3]);
                        w.z = cvtpk(bf_lo(xx.z) * alpha + v1[0], bf_hi(xx.z) * alpha + v1[1]); w.w = cvtpk(bf_lo(xx.w) * alpha + v1[2], bf_hi(xx.w) * alpha + v1[3]);
                        *(u32x4*)((bf16_t*)O + r * ldc + c) = w;
                    } else {
                        *(f32x4*)((float*)O + r * ldc + c) = v0; *(f32x4*)((float*)O + r * ldc + c + 4) = v1;
                    }
                }
            }
    }
};

template <class Epi, class Sched, bool ALIGN_EPI = false, bool SP2 = false, bool F8 = false, int SC0 = 127, int SC1 = 127, bool F4 = false>
__device__ __forceinline__ void gemm_phase(PG8_LAS unsigned char* lds, const Gemm g, const Sched& S, const Epi& E) {
    int tid_ = threadIdx.x; asm volatile("" : "+v"(tid_));
    const int tid = tid_, wid = __builtin_amdgcn_readfirstlane(tid >> 6), lane = tid & 63, wr = wid >> 2, wc = wid & 3, fr = lane & 15, fq = lane >> 4;
    const int K = g.K, nt = K / BK;
    unsigned voffA[2], voffB[2];
#pragma unroll
    for (int i = 0; i < 2; ++i) { int R, C; stage_rc(tid * 16 + i * 8192, R, C); const int Rb = Epi::PERM ? ((R & ~31) + perm32(R & 31)) : R;
        voffA[i] = (unsigned)(R * g.lda + C) * 2u; voffB[i] = (unsigned)(Rb * g.ldb + C) * 2u; }
    const size_t kstep = (size_t)(BK * 2);
    const size_t hstepA = (size_t)HALF * g.lda * 2, hstepB = (size_t)HALF * g.ldb * 2;
    const size_t tstepA = 2 * hstepA, tstepB = 2 * hstepB;
    const unsigned ldsw = (unsigned)wid * 1024u;
    const int aoff = lds_byte(wr * 64 + fr, fq * 8), boff = lds_byte(wc * 32 + fr, fq * 8);

#define PG8_SA(b, h) (((b) * 2 + (h)) * HTB)
#define PG8_SB(b, h) ((4 + (b) * 2 + (h)) * HTB)
#define PG8_STAGE(bufoff, gbase, voff) do { _Pragma("unroll") for (int _i = 0; _i < 2; ++_i) \
        __builtin_amdgcn_global_load_lds((const unsigned*)((const char*)(gbase) + (voff)[_i]), (PG8_LAS unsigned*)(lds + (bufoff) + ldsw + _i * 8192), 16, 0, 0); } while (0)
#define PG8_LDA(dst, b, h) do { _Pragma("unroll") for (int m = 0; m < 4; ++m) { if constexpr (F8) { const v4i_t lo_ = *(const PG8_LAS v4i_t*)(lds + PG8_SA(b, h) + aoff + m * 2048), hi_ = *(const PG8_LAS v4i_t*)(lds + PG8_SA(b, h) + aoff + m * 2048 + 1024); dst##8[m] = __builtin_shufflevector(lo_, hi_, 0, 1, 2, 3, 4, 5, 6, 7); } else { _Pragma("unroll") for (int k = 0; k < 2; ++k) dst[m][k] = *(const PG8_LAS bf16x8*)(lds + PG8_SA(b, h) + aoff + m * 2048 + k * 1024); } } } while (0)
#define PG8_LDB(dst, b, h) do { _Pragma("unroll") for (int n = 0; n < 2; ++n) { if constexpr (F8) { const v4i_t lo_ = *(const PG8_LAS v4i_t*)(lds + PG8_SB(b, h) + boff + n * 2048), hi_ = *(const PG8_LAS v4i_t*)(lds + PG8_SB(b, h) + boff + n * 2048 + 1024); dst##8[n] = __builtin_shufflevector(lo_, hi_, 0, 1, 2, 3, 4, 5, 6, 7); } else { _Pragma("unroll") for (int k = 0; k < 2; ++k) dst[n][k] = *(const PG8_LAS bf16x8*)(lds + PG8_SB(b, h) + boff + n * 2048 + k * 1024); } } } while (0)
#define PG8_MMA(ai, bj, At, Bt) do { __builtin_amdgcn_s_setprio(1); \
        if constexpr (F8) {   \
            asm volatile("s_nop 1\n\t" \
            "v_mfma_scale_f32_16x16x128_f8f6f4 %0, %12, %8, %0, %14, %15 op_sel_hi:[0,0,0]\n\t"  \
            "v_mfma_scale_f32_16x16x128_f8f6f4 %1, %13, %8, %1, %14, %15 op_sel_hi:[0,0,0]\n\t"  \
            "v_mfma_scale_f32_16x16x128_f8f6f4 %2, %12, %9, %2, %14, %15 op_sel_hi:[0,0,0]\n\t"  \
            "v_mfma_scale_f32_16x16x128_f8f6f4 %3, %13, %9, %3, %14, %15 op_sel_hi:[0,0,0]\n\t"  \
            "v_mfma_scale_f32_16x16x128_f8f6f4 %4, %12, %10, %4, %14, %15 op_sel_hi:[0,0,0]\n\t"  \
            "v_mfma_scale_f32_16x16x128_f8f6f4 %5, %13, %10, %5, %14, %15 op_sel_hi:[0,0,0]\n\t"  \
            "v_mfma_scale_f32_16x16x128_f8f6f4 %6, %12, %11, %6, %14, %15 op_sel_hi:[0,0,0]\n\t"  \
            "v_mfma_scale_f32_16x16x128_f8f6f4 %7, %13, %11, %7, %14, %15 op_sel_hi:[0,0,0]\n\t"  \
                : "+v"(acc[ai][bj][0][0]), "+v"(acc[ai][bj][0][1]), "+v"(acc[ai][bj][1][0]), "+v"(acc[ai][bj][1][1]), "+v"(acc[ai][bj][2][0]), "+v"(acc[ai][bj][2][1]), "+v"(acc[ai][bj][3][0]), "+v"(acc[ai][bj][3][1]) \
                : "v"(At##8[0]), "v"(At##8[1]), "v"(At##8[2]), "v"(At##8[3]), "v"(Bt##8[0]), "v"(Bt##8[1]), "v"(sc0), "v"(sc1)); \
        } else if constexpr (F4) { \
            asm volatile("s_nop 1\n\t" \
            "v_mfma_scale_f32_16x16x128_f8f6f4 %0, %16, %8, %0, %20, %21 op_sel_hi:[0,0,0] cbsz:4 blgp:4\n\t"  \
            "v_mfma_scale_f32_16x16x128_f8f6f4 %0, %17, %9, %0, %20, %21 op_sel_hi:[0,0,0] cbsz:4 blgp:4\n\t"  \
            "v_mfma_scale_f32_16x16x128_f8f6f4 %1, %18, %8, %1, %20, %21 op_sel_hi:[0,0,0] cbsz:4 blgp:4\n\t"  \
            "v_mfma_scale_f32_16x16x128_f8f6f4 %1, %19, %9, %1, %20, %21 op_sel_hi:[0,0,0] cbsz:4 blgp:4\n\t"  \
            "v_mfma_scale_f32_16x16x128_f8f6f4 %2, %16, %10, %2, %20, %21 op_sel_hi:[0,0,0] cbsz:4 blgp:4\n\t"  \
            "v_mfma_scale_f32_16x16x128_f8f6f4 %2, %17, %11, %2, %20, %21 op_sel_hi:[0,0,0] cbsz:4 blgp:4\n\t"  \
            "v_mfma_scale_f32_16x16x128_f8f6f4 %3, %18, %10, %3, %20, %21 op_sel_hi:[0,0,0] cbsz:4 blgp:4\n\t"  \
            "v_mfma_scale_f32_16x16x128_f8f6f4 %3, %19, %11, %3, %20, %21 op_sel_hi:[0,0,0] cbsz:4 blgp:4\n\t"  \
            "v_mfma_scale_f32_16x16x128_f8f6f4 %4, %16, %12, %4, %20, %21 op_sel_hi:[0,0,0] cbsz:4 blgp:4\n\t"  \
            "v_mfma_scale_f32_16x16x128_f8f6f4 %4, %17, %13, %4, %20, %21 op_sel_hi:[0,0,0] cbsz:4 blgp:4\n\t"  \
            "v_mfma_scale_f32_16x16x128_f8f6f4 %5, %18, %12, %5, %20, %21 op_sel_hi:[0,0,0] cbsz:4 blgp:4\n\t"  \
            "v_mfma_scale_f32_16x16x128_f8f6f4 %5, %19, %13, %5, %20, %21 op_sel_hi:[0,0,0] cbsz:4 blgp:4\n\t"  \
            "v_mfma_scale_f32_16x16x128_f8f6f4 %6, %16, %14, %6, %20, %21 op_sel_hi:[0,0,0] cbsz:4 blgp:4\n\t"  \
            "v_mfma_scale_f32_16x16x128_f8f6f4 %6, %17, %15, %6, %20, %21 op_sel_hi:[0,0,0] cbsz:4 blgp:4\n\t"  \
            "v_mfma_scale_f32_16x16x128_f8f6f4 %7, %18, %14, %7, %20, %21 op_sel_hi:[0,0,0] cbsz:4 blgp:4\n\t"  \
            "v_mfma_scale_f32_16x16x128_f8f6f4 %7, %19, %15, %7, %20, %21 op_sel_hi:[0,0,0] cbsz:4 blgp:4\n\t"  \
                : "+v"(acc[ai][bj][0][0]), "+v"(acc[ai][bj][0][1]), "+v"(acc[ai][bj][1][0]), "+v"(acc[ai][bj][1][1]), "+v"(acc[ai][bj][2][0]), "+v"(acc[ai][bj][2][1]), "+v"(acc[ai][bj][3][0]), "+v"(acc[ai][bj][3][1]) \
                : "v"(At[0][0]), "v"(At[0][1]), "v"(At[1][0]), "v"(At[1][1]), "v"(At[2][0]), "v"(At[2][1]), "v"(At[3][0]), "v"(At[3][1]), "v"(Bt[0][0]), "v"(Bt[0][1]), "v"(Bt[1][0]), "v"(Bt[1][1]), "v"(sc0), "v"(sc1)); \
        } else { _Pragma("unroll") for (int m = 0; m < 4; ++m) _Pragma("unroll") for (int n = 0; n < 2; ++n) _Pragma("unroll") for (int k = 0; k < 2; ++k) \
            acc[ai][bj][m][n] = __builtin_amdgcn_mfma_f32_16x16x32_bf16(Bt[n][k], At[m][k], acc[ai][bj][m][n], 0, 0, 0); } \
        __builtin_amdgcn_s_setprio(0); } while (0)
#define PG8_WAIT_V(n) asm volatile("s_waitcnt vmcnt(" #n ")" ::: "memory")
#define PG8_WAIT_L(n) asm volatile("s_waitcnt lgkmcnt(" #n ")" ::: "memory")
#define PG8_BAR __builtin_amdgcn_s_barrier()
#define PG8_SCHED __builtin_amdgcn_sched_barrier(0)
    Unit cur, nxt; int ui = 0;
    if (!S.next(0, cur)) return;
    f32x4 acc[2][2][4][2];
#pragma unroll
    for (int a = 0; a < 2; ++a)
#pragma unroll
        for (int b = 0; b < 2; ++b)
#pragma unroll
            for (int m = 0; m < 4; ++m)
#pragma unroll
                for (int n = 0; n < 2; ++n) acc[a][b][m][n] = (f32x4){0.f, 0.f, 0.f, 0.f};
    bf16x8 At[4][2], B0[2][2], B1[2][2];
    typedef int v8i_t __attribute__((ext_vector_type(8))); typedef int v4i_t __attribute__((ext_vector_type(4)));
    v8i_t At8[4], B08[2], B18[2];
    int sc0 = SC0 * 0x01010101, sc1 = SC1 * 0x01010101; asm volatile("" : "+v"(sc0), "+v"(sc1));
    const char* cA = (const char*)g.A + (size_t)cur.pm * tstepA + (size_t)cur.pn * g.apn + (size_t)cur.br * g.abr; const char* cB = (const char*)g.Bt + (size_t)cur.pn * tstepB + (size_t)cur.br * g.bbr;
    S.a_ready(cur);
    if constexpr (SP2) {
        PG8_STAGE(PG8_SB(0, 0), cB, voffB); PG8_STAGE(PG8_SB(0, 1), cB + hstepB, voffB); PG8_STAGE(PG8_SA(0, 0), cA, voffA); PG8_STAGE(PG8_SA(0, 1), cA + hstepA, voffA);
        if (wr == 1) PG8_BAR;
        PG8_WAIT_V(2); PG8_BAR;
        PG8_STAGE(PG8_SB(1, 0), cB + kstep, voffB); PG8_STAGE(PG8_SA(1, 0), cA + kstep, voffA); PG8_STAGE(PG8_SB(1, 1), cB + hstepB + kstep, voffB);
        PG8_WAIT_V(6); PG8_BAR;
    } else {
        PG8_STAGE(PG8_SB(0, 0), cB, voffB); PG8_STAGE(PG8_SA(0, 0), cA, voffA); PG8_STAGE(PG8_SB(0, 1), cB + hstepB, voffB); PG8_STAGE(PG8_SA(0, 1), cA + hstepA, voffA);
        if (wr == 1) PG8_BAR;
        PG8_WAIT_V(4); PG8_BAR;
        PG8_STAGE(PG8_SB(1, 0), cB + kstep, voffB); PG8_STAGE(PG8_SA(1, 0), cA + kstep, voffA); PG8_STAGE(PG8_SB(1, 1), cB + hstepB + kstep, voffB);
        PG8_WAIT_V(6); PG8_BAR;
    }
    for (;;) {
        const bool has_next = S.next(ui + 1, nxt);
        const char* nA = has_next ? (const char*)g.A + (size_t)nxt.pm * tstepA + (size_t)nxt.pn * g.apn + (size_t)nxt.br * g.abr : cA; const char* nB = has_next ? (const char*)g.Bt + (size_t)nxt.pn * tstepB + (size_t)nxt.br * g.bbr : cB;
        for (int t = 0; t < nt; t += 2) {
            const bool last = (t == nt - 2);
            const char* a1 = cA + (size_t)(t + 1) * kstep;
            const char* a2 = last ? nA : cA + (size_t)(t + 2) * kstep; const char* b2 = last ? nB : cB + (size_t)(t + 2) * kstep;
            const char* a3 = a2 + kstep; const char* b3 = b2 + kstep;
            if (last && has_next) S.a_ready(nxt);
            if constexpr (SP2) {
            PG8_LDB(B0, 0, 0); PG8_LDB(B1, 0, 1); PG8_SCHED; PG8_LDA(At, 0, 0); PG8_STAGE(PG8_SA(1, 1), a1 + hstepA, voffA);
            PG8_WAIT_V(8); PG8_WAIT_L(0); PG8_BAR; PG8_MMA(0, 0, At, B0); PG8_MMA(0, 1, At, B1); PG8_BAR; PG8_SCHED;
            PG8_LDA(At, 0, 1); PG8_STAGE(PG8_SB(0, 0), b2, voffB); PG8_STAGE(PG8_SB(0, 1), b2 + hstepB, voffB); PG8_STAGE(PG8_SA(0, 0), a2, voffA);
            PG8_WAIT_V(8); PG8_WAIT_L(0); PG8_BAR; PG8_MMA(1, 0, At, B0); PG8_MMA(1, 1, At, B1); PG8_BAR; PG8_SCHED;
            PG8_LDB(B0, 1, 0); PG8_LDB(B1, 1, 1); PG8_SCHED; PG8_LDA(At, 1, 0); PG8_STAGE(PG8_SA(0, 1), a2 + hstepA, voffA);
            PG8_WAIT_V(8); PG8_WAIT_L(0); PG8_BAR; PG8_MMA(0, 0, At, B0); PG8_MMA(0, 1, At, B1); PG8_BAR; PG8_SCHED;
            PG8_LDA(At, 1, 1); PG8_STAGE(PG8_SB(1, 0), b3, voffB); PG8_STAGE(PG8_SB(1, 1), b3 + hstepB, voffB); PG8_STAGE(PG8_SA(1, 0), a3, voffA);
            PG8_WAIT_V(8); PG8_WAIT_L(0); PG8_BAR; PG8_MMA(1, 0, At, B0); PG8_MMA(1, 1, At, B1); PG8_BAR; PG8_SCHED;
            } else {
            PG8_LDB(B0, 0, 0); PG8_SCHED; PG8_LDA(At, 0, 0); PG8_STAGE(PG8_SA(1, 1), a1 + hstepA, voffA);
            PG8_WAIT_L(8); PG8_BAR; PG8_WAIT_L(0); PG8_MMA(0, 0, At, B0); PG8_BAR; PG8_SCHED;
            PG8_LDB(B1, 0, 1); PG8_STAGE(PG8_SB(0, 0), b2, voffB);
            PG8_BAR; PG8_WAIT_L(0); PG8_MMA(0, 1, At, B1); PG8_BAR;
            PG8_LDA(At, 0, 1); PG8_STAGE(PG8_SA(0, 0), a2, voffA);
            PG8_BAR; PG8_WAIT_L(0); PG8_MMA(1, 0, At, B0); PG8_BAR; PG8_SCHED;
            PG8_STAGE(PG8_SB(0, 1), b2 + hstepB, voffB);
            PG8_WAIT_V(6); PG8_BAR; PG8_MMA(1, 1, At, B1); PG8_BAR;
            PG8_LDB(B0, 1, 0); PG8_SCHED; PG8_LDA(At, 1, 0); PG8_STAGE(PG8_SA(0, 1), a2 + hstepA, voffA);
            PG8_WAIT_L(8); PG8_BAR; PG8_WAIT_L(0); PG8_MMA(0, 0, At, B0); PG8_BAR; PG8_SCHED;
            PG8_LDB(B1, 1, 1); PG8_STAGE(PG8_SB(1, 0), b3, voffB);
            PG8_BAR; PG8_WAIT_L(0); PG8_MMA(0, 1, At, B1); PG8_BAR;
            PG8_LDA(At, 1, 1); PG8_STAGE(PG8_SA(1, 0), a3, voffA);
            PG8_BAR; PG8_WAIT_L(0); PG8_MMA(1, 0, At, B0); PG8_BAR; PG8_SCHED;
            PG8_STAGE(PG8_SB(1, 1), b3 + hstepB, voffB);
            PG8_WAIT_V(6); PG8_BAR; PG8_MMA(1, 1, At, B1); PG8_BAR;
            }
        }
        if constexpr (F8 || F4) {
#pragma unroll
            for (int a_ = 0; a_ < 2; ++a_) asm volatile("s_nop 15\n\ts_nop 7" : "+v"(acc[a_][0][0][0]), "+v"(acc[a_][0][0][1]), "+v"(acc[a_][0][1][0]), "+v"(acc[a_][0][1][1]), "+v"(acc[a_][0][2][0]), "+v"(acc[a_][0][2][1]), "+v"(acc[a_][0][3][0]), "+v"(acc[a_][0][3][1]),
                "+v"(acc[a_][1][0][0]), "+v"(acc[a_][1][0][1]), "+v"(acc[a_][1][1][0]), "+v"(acc[a_][1][1][1]), "+v"(acc[a_][1][2][0]), "+v"(acc[a_][1][2][1]), "+v"(acc[a_][1][3][0]), "+v"(acc[a_][1][3][1]));
        }
        if constexpr (ALIGN_EPI) { if (wr == 0) PG8_BAR; }
        bool chain_keep = false;
        if constexpr (Epi::CHAIN) { if (cur.br + 1 == Epi::NBR) E(acc, cur, wr, wc, fr, fq); E.rescale(acc, cur, wr, wc, fr, fq); chain_keep = true; }
        if constexpr (!Epi::AFTER_DRAIN && !Epi::CHAIN) { E(acc, cur, wr, wc, fr, fq); S.done(cur); }
        if (!has_next) break;
        if (!chain_keep) {
#pragma unroll
        for (int a = 0; a < 2; ++a)
#pragma unroll
            for (int b = 0; b < 2; ++b)
#pragma unroll
                for (int m = 0; m < 4; ++m)
#pragma unroll
                    for (int n = 0; n < 2; ++n) acc[a][b][m][n] = (f32x4){0.f, 0.f, 0.f, 0.f};
        }
        cur = nxt; cA = nA; cB = nB; ++ui;
        if constexpr (ALIGN_EPI) { if (wr == 1) PG8_BAR; }
    }
    PG8_WAIT_V(0);
    if constexpr (!ALIGN_EPI) { if (wr == 0) PG8_BAR; }
    PG8_BAR;
    if constexpr (Epi::AFTER_DRAIN) { E.fused(acc, cur, wr, wc, fr, fq, lds, wid, lane); S.done(cur); }
#undef PG8_SA
#undef PG8_SB
#undef PG8_STAGE
#undef PG8_LDA
#undef PG8_LDB
#undef PG8_MMA
#undef PG8_WAIT_V
#undef PG8_WAIT_L
#undef PG8_BAR
#undef PG8_SCHED
}
}

constexpr int S = 16384, DM = 2048, NL = 2, NWAVES = 8;
constexpr int HW = 3584;
constexpr int H_AQ = 0, H_AK = 512, H_BQ = 1024, H_BK = 1536, H_CQ = 1664, H_CK = 2176, H_DCQ = 2688, H_DCKV = 3200, H_DKR = 3456;
constexpr int VT_A = 0, VT_B = 512, VT_C = 640, VT_ROWS = 1280;
constexpr int WIN_ROWS = HW + VT_ROWS;
constexpr float LOG2E = 1.4426950408889634f;
constexpr float DN_ALPHA = 1.4142135623730951f;
constexpr size_t MiB = 1u << 20;
constexpr size_t WS_CTL = 0, CTL_ZERO_BYTES = 1 * MiB;
constexpr size_t WS_W = 1 * MiB, WL_STRIDE = 78 * MiB;
constexpr size_t W_IN = 0, W_G = 19 * MiB, W_BR = 51 * MiB, W_O = 59 * MiB, W_UQ = 67 * MiB, W_UKV = 68 * MiB, W_PQ = 69 * MiB, W_SK = 77 * MiB;
constexpr size_t WS_UB = 157 * MiB, WS_VB = 221 * MiB;
constexpr size_t WS_MLIST = 189 * MiB;
constexpr int MCAP_F = 16384, MCAP = MCAP_F + 4096;
constexpr size_t WS_PART = 926 * MiB;
constexpr size_t WS_CS = 245 * MiB;
constexpr size_t WS_XB8 = 253 * MiB;
constexpr size_t WS_XB = 285 * MiB;
constexpr size_t WS_H = 349 * MiB;
constexpr size_t WS_VT = 461 * MiB;
constexpr size_t WS_GT = 501 * MiB;
constexpr size_t WS_O8 = 629 * MiB;
constexpr size_t WS_XB4 = 661 * MiB;
constexpr size_t WS_O = 757 * MiB;
constexpr size_t WS_QD = 821 * MiB, WS_KD = 845 * MiB, WS_VDT = 869 * MiB, WS_CQN = 885 * MiB, WS_CKVN = 901 * MiB;
constexpr size_t WS_SELE = 909 * MiB, WS_SELG = 917 * MiB, WS_KMEAN = 925 * MiB, WS_TPMAX = 925 * MiB + 512 * 1024, WS_OC2 = 994 * MiB, WS_END = 1010 * MiB;
constexpr int CW_BAR = 4096, CW_Q = 16384, CW_CHK = 20480, CW_MOBA = 24576;
constexpr int RING_BYTES = 131072;
constexpr int MISC_OFF = RING_BYTES;
constexpr int TR_OFF = 0;
constexpr int LDS_BYTES = 147456;

constexpr float U_SCALE = 90.0f, V_SCALE = 4.0f;
#define XB_TMO      128
#define XB_XCNT(j)  (256  + 64 * (j))
#define XB_XSUB(j)  (1280 + 64 * (j))
#define XB_XGEN(j)  (2304 + 64 * (j))
#define XB_TOP      3328
#define XB_TOPGEN   3392
#define XCD_BAR_WORDS 3456
#define XB_SPIN_CAP (1u << 18)

__device__ __forceinline__ unsigned xb_ld(unsigned* p)              { return __hip_atomic_load(p, __ATOMIC_RELAXED, __HIP_MEMORY_SCOPE_AGENT); }
__device__ __forceinline__ unsigned xb_add(unsigned* p, unsigned v) { return __hip_atomic_fetch_add(p, v, __ATOMIC_RELAXED, __HIP_MEMORY_SCOPE_AGENT); }
__device__ __forceinline__ unsigned xb_xcc_id() { return (unsigned)__builtin_amdgcn_s_getreg((3 << 11) | 20) & 0xFu; }
#define XB_SPIN(cond, bar) do { unsigned _sp = 0; while (cond) { __builtin_amdgcn_s_sleep(1); \
    if ((++_sp & 255u) == 0u) { if (xb_ld(&(bar)[XB_TMO])) break; if (_sp > XB_SPIN_CAP) { atomicAdd(&(bar)[XB_TMO], 1u); break; } } } } while (0)

struct XcdBarrier {
    unsigned* bar; unsigned x;
    volatile LAS unsigned* st;
};

__device__ __forceinline__ XcdBarrier xcd_barrier_post(unsigned* bar, volatile LAS unsigned* st) {
    XcdBarrier b; b.bar = bar; b.x = xb_xcc_id(); b.st = st;
    if (threadIdx.x == 0) (void)xb_add(&bar[XB_XCNT(b.x)], 1u);
    return b;
}
__device__ __forceinline__ void xcd_barrier_complete(unsigned* bar, unsigned x, unsigned& nloc, unsigned& nx) {
    const unsigned G = gridDim.x * gridDim.y * gridDim.z;
    unsigned sum, cnt, mine, sp = 0u;
    for (;;) {
        sum = 0u; cnt = 0u; mine = 0u;
#pragma unroll
        for (unsigned j = 0; j < 16; ++j) { const unsigned c = xb_ld(&bar[XB_XCNT(j)]); sum += c; cnt += (c > 0u) ? 1u : 0u; mine = (j == x) ? c : mine; }
        if (sum == G) break;
        __builtin_amdgcn_s_sleep(1);
        if ((++sp & 255u) == 0u) { if (xb_ld(&bar[XB_TMO])) break; if (sp > XB_SPIN_CAP) { atomicAdd(&bar[XB_TMO], 1u); break; } }
    }
    nloc = mine > 0u ? mine : 1u; nx = cnt > 0u ? cnt : 1u;
}

__device__ __forceinline__ void xcd_barrier(const XcdBarrier& b) {
    asm volatile("s_waitcnt vmcnt(0)" ::: "memory");
    __syncthreads();
    if (threadIdx.x == 0) {
        unsigned* bar = b.bar;
        __builtin_amdgcn_s_waitcnt(0);
        unsigned nloc = b.st[0], nx = b.st[1];
        if (nloc == 0u) { xcd_barrier_complete(bar, b.x, nloc, nx); b.st[0] = nloc; b.st[1] = nx; }
        const unsigned old = xb_add(&bar[XB_XSUB(b.x)], 1u);
        const unsigned gen = old / nloc;
        if (old + 1u == (gen + 1u) * nloc) {
            __builtin_amdgcn_fence(__ATOMIC_RELEASE, "agent");
            asm volatile("s_waitcnt vmcnt(0)" ::: "memory");
            const unsigned og = xb_add(&bar[XB_TOP], 1u);
            const unsigned tg = og / nx;
            if (og + 1u == (tg + 1u) * nx) xb_add(&bar[XB_TOPGEN], 1u);
            else XB_SPIN(xb_ld(&bar[XB_TOPGEN]) == tg, bar);
            __builtin_amdgcn_fence(__ATOMIC_ACQUIRE, "agent");
            xb_add(&bar[XB_XGEN(b.x)], 1u);
            asm volatile("s_waitcnt vmcnt(0)" ::: "memory");
        } else {
            XB_SPIN(xb_ld(&bar[XB_XGEN(b.x)]) == gen, bar);
            __builtin_amdgcn_fence(__ATOMIC_ACQUIRE, "agent");
            asm volatile("s_waitcnt vmcnt(0)" ::: "memory");
        }
    }
    __syncthreads();
}

struct Args { const float* in[26]; float* out; unsigned char* ws; int ph_lo, ph_hi; };
struct Frame {
    LAS unsigned char* lds; volatile LAS unsigned* MISC;
    int tid, lane, wave, vcu, G;
    unsigned char* ws; float* out;
};
DI bf16_t* wsb(const Frame& F, size_t off) { return (bf16_t*)(F.ws + off); }

DI void transpose_item(const float* W, int ldw, bf16_t* WT, int ldt, int k0, int n0, int drow0, LAS float* scr, int lane) {
#pragma unroll 8
    for (int i = 0; i < 32; ++i) { const int kk = 2 * i + (lane >> 5); scr[kk * 33 + (lane & 31)] = W[(size_t)(k0 + kk) * ldw + n0 + (lane & 31)]; }
    asm volatile("s_waitcnt lgkmcnt(0)" ::: "memory");
    const int c = lane & 7;
#pragma unroll
    for (int j = 0; j < 4; ++j) { const int n = (lane >> 3) + 8 * j; const LAS float* s = scr + (8 * c) * 33 + n;
        u32x4 o; o.x = cvtpk(s[0 * 33], s[1 * 33]); o.y = cvtpk(s[2 * 33], s[3 * 33]); o.z = cvtpk(s[4 * 33], s[5 * 33]); o.w = cvtpk(s[6 * 33], s[7 * 33]);
        *(u32x4*)(WT + (size_t)(drow0 + n) * ldt + k0 + 8 * c) = o; }
    asm volatile("s_waitcnt lgkmcnt(0)" ::: "memory");
}
DI void transpose_item8(const float* W, int ldw, unsigned char* WT, int ldt, int k0, int n0, int drow0, LAS float* scr, int lane, float scale) {
#pragma unroll 8
    for (int i = 0; i < 32; ++i) { const int kk = 2 * i + (lane >> 5); scr[kk * 33 + (lane & 31)] = W[(size_t)(k0 + kk) * ldw + n0 + (lane & 31)]; }
    asm volatile("s_waitcnt lgkmcnt(0)" ::: "memory");
    const int c = lane & 7;
#pragma unroll
    for (int j = 0; j < 4; ++j) { const int n = (lane >> 3) + 8 * j; const LAS float* s = scr + (8 * c) * 33 + n;
        int lo = __builtin_amdgcn_cvt_pk_fp8_f32(s[0 * 33] * scale, s[1 * 33] * scale, 0, false); lo = __builtin_amdgcn_cvt_pk_fp8_f32(s[2 * 33] * scale, s[3 * 33] * scale, lo, true);
        int hi = __builtin_amdgcn_cvt_pk_fp8_f32(s[4 * 33] * scale, s[5 * 33] * scale, 0, false); hi = __builtin_amdgcn_cvt_pk_fp8_f32(s[6 * 33] * scale, s[7 * 33] * scale, hi, true);
        *(u32x2*)(WT + (size_t)(drow0 + n) * ldt + k0 + 8 * c) = (u32x2){(unsigned)lo, (unsigned)hi}; }
    asm volatile("s_waitcnt lgkmcnt(0)" ::: "memory");
}
DI void transpose_item4(const float* W, int ldw, unsigned char* WT, int ldt, int k0, int n0, int drow0, LAS float* scr, int lane, float scale) {
#pragma unroll 8
    for (int i = 0; i < 32; ++i) { const int kk = 2 * i + (lane >> 5); scr[kk * 33 + (lane & 31)] = W[(size_t)(k0 + kk) * ldw + n0 + (lane & 31)]; }
    asm volatile("s_waitcnt lgkmcnt(0)" ::: "memory");
    const int c = lane & 7;
#pragma unroll
    for (int j = 0; j < 4; ++j) { const int n = (lane >> 3) + 8 * j; const LAS float* s = scr + (8 * c) * 33 + n;
        unsigned d = 0u;
        d = __builtin_amdgcn_cvt_scalef32_pk_fp4_f32(d, s[0 * 33] * scale, s[1 * 33] * scale, 1.0f, 0); d = __builtin_amdgcn_cvt_scalef32_pk_fp4_f32(d, s[2 * 33] * scale, s[3 * 33] * scale, 1.0f, 1);
        d = __builtin_amdgcn_cvt_scalef32_pk_fp4_f32(d, s[4 * 33] * scale, s[5 * 33] * scale, 1.0f, 2); d = __builtin_amdgcn_cvt_scalef32_pk_fp4_f32(d, s[6 * 33] * scale, s[7 * 33] * scale, 1.0f, 3);
        *(unsigned*)(WT + (size_t)(drow0 + n) * ldt + (k0 >> 1) + 4 * c) = d; }
    asm volatile("s_waitcnt lgkmcnt(0)" ::: "memory");
}
DI int win_map(int c) {
    if (c < 1024) return c;
    if (c < 1536) return HW + VT_A + (c - 1024);
    if (c < 2176) return H_BQ + (c - 1536);
    if (c < 2304) return HW + VT_B + (c - 2176);
    if (c < 3328) return H_CQ + (c - 2304);
    if (c < 3840) return HW + VT_C + (c - 3328);
    return H_DCQ + (c - 3840);
}
template <int MAP, bool F8 = false, bool F4 = false> DI void transpose_matrix(const Frame& F, const float* W, int K, int N, bf16_t* WT, int roff) {
    LAS float* scr = (LAS float*)(F.lds + TR_OFF + F.wave * 8704);
    const int gw = F.vcu * NWAVES + F.wave, NGW = F.G * NWAVES, nblk = N / 32, items = (K / 64) * nblk;
    int lane = F.lane; asm volatile("" : "+v"(lane));
    for (int it = gw; it < items; it += NGW) {
        const int kb = it / nblk, nb = it % nblk, n0 = 32 * nb;
        int drow = roff + n0;
        if (MAP == 1) drow = win_map(n0);
        if (MAP == 2) { const int h = n0 >> 8, j = n0 & 255; drow = (j < 128) ? h * 128 + j : 512 + h * 128 + (j - 128); }
        if (F4) transpose_item4(W, N, (unsigned char*)WT, K / 2, 64 * kb, n0, drow, scr, lane, 64.0f); else if (F8) transpose_item8(W, N, (unsigned char*)WT, K, 64 * kb, n0, drow, scr, lane, 64.0f); else transpose_item(W, N, WT, K, 64 * kb, n0, drow, scr, lane);
    }
}
DI void convert_bf16(const Frame& F, const float* src, bf16_t* dst, size_t n) {
    const size_t nth = (size_t)F.G * 512, t0 = (size_t)F.vcu * 512 + F.tid;
    for (size_t i = t0; i < n / 8; i += nth) { const f32x4 a = *(const f32x4*)(src + 8 * i), b = *(const f32x4*)(src + 8 * i + 4);
        u32x4 w; w.x = cvtpk(a[0], a[1]); w.y = cvtpk(a[2], a[3]); w.z = cvtpk(b[0], b[1]); w.w = cvtpk(b[2], b[3]); *(u32x4*)(dst + 8 * i) = w; }
}

typedef float v16f __attribute__((ext_vector_type(16)));
typedef float v32f __attribute__((ext_vector_type(32)));
typedef unsigned v6u __attribute__((ext_vector_type(6)));
DI void convert_fp6(const Frame& F, const float* src, unsigned char* dst, int rows, float scale) {
    const size_t nth = (size_t)F.G * 512, t0 = (size_t)F.vcu * 512 + F.tid;
    for (size_t i = t0; i < (size_t)rows * 64; i += nth) {
        const size_t row = i >> 6; const int l = (int)(i & 63);
        const float* p = src + row * 2048 + 32 * l;
        v16f a, b;
#pragma unroll
        for (int q = 0; q < 8; ++q) { const f32x4 x = *(const f32x4*)(p + 4 * q) * scale;
            a[2 * q] = x[0]; b[2 * q] = x[1]; a[2 * q + 1] = x[2]; b[2 * q + 1] = x[3]; }
        const v6u w = __builtin_amdgcn_cvt_scalef32_2xpk16_fp6_f32(a, b, 1.0f);
        *(u32x4*)(dst + row * 1536 + 16 * l) = (u32x4){w[0], w[1], w[2], w[3]};
        *(u32x2*)(dst + row * 1536 + 1024 + 8 * l) = (u32x2){w[4], w[5]};
    }
}

DI void convert_fp4(const Frame& F, const float* src, unsigned char* dst, int rows, float scale) {
    const size_t nth = (size_t)F.G * 512, t0 = (size_t)F.vcu * 512 + F.tid;
    for (size_t i = t0; i < (size_t)rows * 64; i += nth) {
        const float* p = src + i * 32;
        u32x4 w = (u32x4){0u, 0u, 0u, 0u};
#define FP4_PK(q) { const f32x4 x = *(const f32x4*)(p + 4 * (q)) * scale; unsigned d = w[(q) >> 1];         \
            d = __builtin_amdgcn_cvt_scalef32_pk_fp4_f32(d, x[0], x[1], 1.0f, (2 * (q)) & 3); d = __builtin_amdgcn_cvt_scalef32_pk_fp4_f32(d, x[2], x[3], 1.0f, (2 * (q) + 1) & 3); w[(q) >> 1] = d; }
        FP4_PK(0) FP4_PK(1) FP4_PK(2) FP4_PK(3) FP4_PK(4) FP4_PK(5) FP4_PK(6) FP4_PK(7)
#undef FP4_PK
        *(u32x4*)(dst + i * 16) = w;
    }
}

DI void convert_weights(const Frame& F, const Args& a, int l_lo, int l_hi) {
    for (int l = l_lo; l < l_hi; ++l) {
        unsigned char* wl = F.ws + WS_W + (size_t)l * WL_STRIDE;
        transpose_matrix<1, true>(F, a.in[3] + (size_t)l * DM * 4672, DM, 4672, (bf16_t*)(wl + W_IN), 0);
        for (int n = 0; n < 4; ++n) transpose_matrix<0, false, true>(F, a.in[4] + ((size_t)l * 4 + n) * DM * DM, DM, DM, (bf16_t*)(wl + W_G), n * DM);
        for (int n = 0; n < 4; ++n) transpose_matrix<0, true>(F, a.in[6] + ((size_t)l * 4 + n) * 512 * DM, 512, DM, (bf16_t*)(wl + W_BR) + (size_t)n * DM * 512, 0);
        transpose_matrix<0, true>(F, a.in[7] + (size_t)l * DM * DM, DM, DM, (bf16_t*)(wl + W_O), 0);
        transpose_matrix<0>(F, a.in[16] + (size_t)l * 512 * 768, 512, 768, (bf16_t*)(wl + W_UQ), 0);
        transpose_matrix<2>(F, a.in[17] + (size_t)l * 256 * 1024, 256, 1024, (bf16_t*)(wl + W_UKV), 0);
        transpose_matrix<0>(F, a.in[20] + (size_t)l * DM * DM, DM, DM, (bf16_t*)(wl + W_PQ), 0);
        convert_bf16(F, a.in[21] + (size_t)l * 8 * 2 * 128 * 128, (bf16_t*)(wl + W_SK), (size_t)8 * 2 * 128 * 128);
    }
}
DI void build_rope_table(const Frame& F, const Args& a) {
    f32x2* CS = (f32x2*)(F.ws + WS_CS); const int* pos = (const int*)a.in[1];
    for (size_t i = (size_t)F.vcu * 512 + F.tid; i < (size_t)S * 32; i += (size_t)F.G * 512) {
        const int j = (int)(i & 31); const float inv = exp2f(-(float)j * (13.287712379549449f / 32.0f));
        const float ang = (float)pos[i >> 5] * inv;
        CS[i] = (f32x2){cosf(ang), sinf(ang)};
    }
}
DI void phase_prologue(const Frame& F, const Args& a) {
    convert_weights(F, a, 0, 1);
    convert_bf16(F, a.in[0], wsb(F, WS_XB), (size_t)S * DM);
    {
        const size_t nth = (size_t)F.G * 512, t0 = (size_t)F.vcu * 512 + F.tid; const float* src = a.in[0]; unsigned char* dst = F.ws + WS_XB4;
        for (size_t i = t0; i < (size_t)S * DM / 8; i += nth) { const f32x4 x = *(const f32x4*)(src + 8 * i) * 2.0f, y = *(const f32x4*)(src + 8 * i + 4) * 2.0f;
            unsigned d = 0u; d = __builtin_amdgcn_cvt_scalef32_pk_fp4_f32(d, x[0], x[1], 1.0f, 0); d = __builtin_amdgcn_cvt_scalef32_pk_fp4_f32(d, x[2], x[3], 1.0f, 1); d = __builtin_amdgcn_cvt_scalef32_pk_fp4_f32(d, y[0], y[1], 1.0f, 2); d = __builtin_amdgcn_cvt_scalef32_pk_fp4_f32(d, y[2], y[3], 1.0f, 3);
            *(unsigned*)(dst + 4 * i) = d; }
    }
    {
        const size_t nth = (size_t)F.G * 512, t0 = (size_t)F.vcu * 512 + F.tid; const float* src = a.in[0]; unsigned char* dst = F.ws + WS_XB8;
        for (size_t i = t0; i < (size_t)S * DM / 8; i += nth) { const f32x4 x = *(const f32x4*)(src + 8 * i), y = *(const f32x4*)(src + 8 * i + 4);
            int lo = __builtin_amdgcn_cvt_pk_fp8_f32(x[0], x[1], 0, false); lo = __builtin_amdgcn_cvt_pk_fp8_f32(x[2], x[3], lo, true); int hi = __builtin_amdgcn_cvt_pk_fp8_f32(y[0], y[1], 0, false); hi = __builtin_amdgcn_cvt_pk_fp8_f32(y[2], y[3], hi, true);
            *(u32x2*)(dst + 8 * i) = (u32x2){(unsigned)lo, (unsigned)hi}; }
    }
    build_rope_table(F, a);
}

DI float rope64(float x, int lane, const f32x2* cs_row) {
    const float other = xhalf(x);
    const f32x2 cs = cs_row[lane & 31];
    return (lane < 32) ? x * cs.x - other * cs.y : other * cs.y + x * cs.x;
}
DI void phase_prep(const Frame& F, const Args& a, int layer) {
    const bf16_t* H = wsb(F, WS_H); bf16_t* CQN = wsb(F, WS_CQN); bf16_t* CKVN = wsb(F, WS_CKVN); bf16_t* KD = wsb(F, WS_KD);
    const float* gq = a.in[14] + layer * 512; const float* gkv = a.in[15] + layer * 256; const int* pos = (const int*)a.in[1];
    const int gw = F.vcu * NWAVES + F.wave, NGW = F.G * NWAVES, lane = F.lane;
    for (int t = gw; t < S; t += NGW) {
        const bf16_t* hr = H + (size_t)t * HW;
        const u32x4 q = *(const u32x4*)(hr + H_DCQ + 8 * lane);
        float v[8] = {bf_lo(q.x), bf_hi(q.x), bf_lo(q.y), bf_hi(q.y), bf_lo(q.z), bf_hi(q.z), bf_lo(q.w), bf_hi(q.w)};
        float ss = 0.f;
#pragma unroll
        for (int e = 0; e < 8; ++e) ss += v[e] * v[e];
        const float rq = rsqrtf(wave_sum(ss) * (1.0f / 512.0f) + 1e-6f);
        const f32x4 g0 = *(const f32x4*)(gq + 8 * lane), g1 = *(const f32x4*)(gq + 8 * lane + 4);
        u32x4 w; w.x = cvtpk(v[0] * rq * g0[0], v[1] * rq * g0[1]); w.y = cvtpk(v[2] * rq * g0[2], v[3] * rq * g0[3]); w.z = cvtpk(v[4] * rq * g1[0], v[5] * rq * g1[1]); w.w = cvtpk(v[6] * rq * g1[2], v[7] * rq * g1[3]);
        *(u32x4*)(CQN + (size_t)t * 512 + 8 * lane) = w;
        const u32x2 k2 = *(const u32x2*)(hr + H_DCKV + 4 * lane);
        const float u0 = bf_lo(k2.x), u1 = bf_hi(k2.x), u2 = bf_lo(k2.y), u3 = bf_hi(k2.y);
        const float rk = rsqrtf(wave_sum(u0 * u0 + u1 * u1 + u2 * u2 + u3 * u3) * (1.0f / 256.0f) + 1e-6f);
        const f32x4 gk = *(const f32x4*)(gkv + 4 * lane);
        u32x2 w2; w2.x = cvtpk(u0 * rk * gk[0], u1 * rk * gk[1]); w2.y = cvtpk(u2 * rk * gk[2], u3 * rk * gk[3]);
        *(u32x2*)(CKVN + (size_t)t * 256 + 4 * lane) = w2;
        const float kr = bf1(hr[H_DKR + lane]);
        const float ro = rope64(kr, lane, (const f32x2*)(F.ws + WS_CS) + (size_t)t * 32);
        const bf16_t rb = (bf16_t)(cvtpk(ro, 0.f) & 0xffffu);
#pragma unroll
        for (int h = 0; h < 4; ++h) KD[(size_t)t * 768 + h * 192 + 128 + lane] = rb;
    }
    for (int t = gw; t < S / 64; t += NGW) { int pm = pos[t * 64 + lane];
#pragma unroll
        for (int o = 1; o < 64; o <<= 1) { const int other = __shfl_xor(pm, o); pm = other > pm ? other : pm; }
        if (lane == 0) ((int*)(F.ws + WS_TPMAX))[t] = pm; }
    float* KM = (float*)(F.ws + WS_KMEAN);
    for (int it = gw; it < 64 * 8; it += NGW) {
        const int n = it >> 3, cc = it & 7; const bf16_t* p = H + (size_t)(n * 256) * HW + H_AK + cc * 64 + lane;
        float s0 = 0.f, s1 = 0.f, s2 = 0.f, s3 = 0.f;
        for (int r = 0; r < 256; r += 4) { s0 += bf1(p[(size_t)r * HW]); s1 += bf1(p[(size_t)(r + 1) * HW]); s2 += bf1(p[(size_t)(r + 2) * HW]); s3 += bf1(p[(size_t)(r + 3) * HW]); }
        KM[n * 512 + cc * 64 + lane] = ((s0 + s1) + (s2 + s3)) * (1.0f / 256.0f);
    }
}
DI void phase_ropeq(const Frame& F, const Args& a) {
    bf16_t* QD = wsb(F, WS_QD); const int* pos = (const int*)a.in[1];
    const int gw = F.vcu * NWAVES + F.wave, NGW = F.G * NWAVES, lane = F.lane;
    for (int t = gw; t < S; t += NGW) {
        const f32x2* cs = (const f32x2*)(F.ws + WS_CS) + (size_t)t * 32;
#pragma unroll
        for (int h = 0; h < 4; ++h) { bf16_t* p = QD + (size_t)t * 768 + h * 192 + 128 + lane; const float ro = rope64(bf1(*p), lane, cs); *p = (bf16_t)(cvtpk(ro, 0.f) & 0xffffu); }
    }
}
DI void phase_moba_select(const Frame& F, const Args& a, int layer) {
    const bf16_t* H = wsb(F, WS_H); const float* KM = (const float*)(F.ws + WS_KMEAN); const int* pos = (const int*)a.in[1]; const int* TP = (const int*)(F.ws + WS_TPMAX);
    unsigned* cnt = (unsigned*)(F.ws + WS_CTL) + CW_MOBA + layer * 1024; int* lists = (int*)(F.ws + WS_MLIST);
    const int gw = F.vcu * NWAVES + F.wave, NGW = F.G * NWAVES;
    int lane = F.lane; asm volatile("" : "+v"(lane));
    const int r = lane & 31, hi = lane >> 5;
    for (int it = gw; it < (S / 32) * 4; it += NGW) {
        const int h = it & 3, q0 = (it >> 2) * 32, q = q0 + r, own = q0 >> 8;
        if (own == 0) continue;
        const bf16_t* qp = H + (size_t)q * HW + H_AQ + h * 128 + hi * 8;
        const bool two = own > 32;
        f32x16 g0, g1;
#pragma unroll
        for (int i = 0; i < 16; ++i) { g0[i] = 0.f; g1[i] = 0.f; }
#pragma unroll
        for (int kk = 0; kk < 8; ++kk) {
            const bf16x8 qf = *(const bf16x8*)(qp + kk * 16);
#pragma unroll
            for (int rb = 0; rb < 2; ++rb) {
                if (rb == 1 && !two) continue;
                const float* kp = KM + (size_t)(rb * 32 + r) * 512 + h * 128 + kk * 16 + hi * 8;
                const f32x4 x = *(const f32x4*)kp, y = *(const f32x4*)(kp + 4);
                u32x4 wh, wl;
                wh.x = cvtpk(x[0], x[1]); wh.y = cvtpk(x[2], x[3]); wh.z = cvtpk(y[0], y[1]); wh.w = cvtpk(y[2], y[3]);
                wl.x = cvtpk(x[0] - bf_lo(wh.x), x[1] - bf_hi(wh.x)); wl.y = cvtpk(x[2] - bf_lo(wh.y), x[3] - bf_hi(wh.y)); wl.z = cvtpk(y[0] - bf_lo(wh.z), y[1] - bf_hi(wh.z)); wl.w = cvtpk(y[2] - bf_lo(wh.w), y[3] - bf_hi(wh.w));
                if (rb == 0) { g0 = __builtin_amdgcn_mfma_f32_32x32x16_bf16(__builtin_bit_cast(bf16x8, wh), qf, g0, 0, 0, 0); g0 = __builtin_amdgcn_mfma_f32_32x32x16_bf16(__builtin_bit_cast(bf16x8, wl), qf, g0, 0, 0, 0); }
                else { g1 = __builtin_amdgcn_mfma_f32_32x32x16_bf16(__builtin_bit_cast(bf16x8, wh), qf, g1, 0, 0, 0); g1 = __builtin_amdgcn_mfma_f32_32x32x16_bf16(__builtin_bit_cast(bf16x8, wl), qf, g1, 0, 0, 0); }
            }
        }
        float v1 = -INFINITY, v2 = -INFINITY, v3 = -INFINITY; int i1 = -1, i2 = -1, i3 = -1;
#pragma unroll
        for (int rb = 0; rb < 2; ++rb)
#pragma unroll
            for (int i = 0; i < 16; ++i) {
                const int n = rb * 32 + (i & 3) + 8 * (i >> 2) + 4 * hi; const float g = (rb == 0) ? g0[i] : g1[i];
                if (n < own) {
                    if (g > v1) { v3 = v2; i3 = i2; v2 = v1; i2 = i1; v1 = g; i1 = n; }
                    else if (g > v2) { v3 = v2; i3 = i2; v2 = g; i2 = n; }
                    else if (g > v3) { v3 = g; i3 = n; }
                }
            }
        const float p1 = xhalf(v1), p2 = xhalf(v2), p3 = xhalf(v3);
        const int j1 = __shfl_xor(i1, 32), j2 = __shfl_xor(i2, 32), j3 = __shfl_xor(i3, 32);
#pragma unroll
        for (int c = 0; c < 3; ++c) { const float g = c == 0 ? p1 : (c == 1 ? p2 : p3); const int n = c == 0 ? j1 : (c == 1 ? j2 : j3);
            if (n >= 0) {
                if (g > v1 || (g == v1 && n < i1)) { v3 = v2; i3 = i2; v2 = v1; i2 = i1; v1 = g; i1 = n; }
                else if (g > v2 || (g == v2 && n < i2)) { v3 = v2; i3 = i2; v2 = g; i2 = n; }
                else if (g > v3 || (g == v3 && n < i3)) { v3 = g; i3 = n; }
            } }
        if (hi == 0) {
            const int pq = pos[q];
#pragma unroll
            for (int sl = 0; sl < 3; ++sl) { const int n = sl == 0 ? i1 : (sl == 1 ? i2 : i3);
                if (n >= 0) { const int bm = max(max(TP[4 * n], TP[4 * n + 1]), max(TP[4 * n + 2], TP[4 * n + 3])); const int near = (pq - bm < 790) ? 1 : 0;
                    const unsigned p = atomicAdd(cnt + near * 256 + h * 64 + n, 1u);
                    if (p < (unsigned)(near ? MCAP - MCAP_F : MCAP_F)) lists[(size_t)(h * 64 + n) * MCAP + (near ? MCAP_F : 0) + p] = q * 4 + sl; } }
        }
    }
}
DI void phase_mixer_combine(const Frame& F, const Args& a, int layer) {
    const unsigned char* PART = F.ws + WS_PART; bf16_t* OA = wsb(F, WS_O);
    const int gw = F.vcu * NWAVES + F.wave, NGW = F.G * NWAVES, lane = F.lane;
    for (int it = gw; it < S * 4; it += NGW) {
        const int q = it >> 2, h = it & 3, nsel = (q >> 8) < 3 ? (q >> 8) : 3;
        const unsigned char* pp = PART + ((size_t)q * 16 + h * 4) * 272;
        float mm[4], ll[4]; unsigned ov[4];
#pragma unroll
        for (int s = 0; s < 4; ++s) { const bool use = (s == 3) || (s < nsel); const f32x2 ml = *(const f32x2*)(pp + s * 272 + 256); mm[s] = use ? ml.x : -1e30f; ll[s] = use ? ml.y : 0.f; ov[s] = *(const unsigned*)(pp + s * 272 + lane * 4); }
        const float M = fmaxf(fmaxf(mm[0], mm[1]), fmaxf(mm[2], mm[3]));
        float wsum = 0.f, x0 = 0.f, x1 = 0.f;
#pragma unroll
        for (int s = 0; s < 4; ++s) { const float w = ll[s] * ex2(mm[s] - M); wsum += w; x0 += w * bf_lo(ov[s]); x1 += w * bf_hi(ov[s]); }
        const float inv = 1.0f / wsum;
        *(unsigned*)(OA + (size_t)q * 512 + h * 128 + lane * 2) = cvtpk(x0 * inv, x1 * inv);
        *(unsigned short*)(F.ws + WS_O8 + (size_t)q * 512 + h * 128 + lane * 2) = (unsigned short)__builtin_amdgcn_cvt_pk_fp8_f32(x0 * inv * 8.0f, x1 * inv * 8.0f, 0, false);
    }
    float d1 = 0.f, d2 = 0.f;
    for (int i = 0; i < 64; ++i) { d1 += a.in[9][layer * 64 + i] * a.in[10][layer * 64 + i]; d2 += a.in[11][layer * 64 + i] * a.in[12][layer * 64 + i]; }
    const float lambda_init = 0.8f - 0.6f * expf(-0.3f * (float)layer), lam = expf(d1) - expf(d2) + lambda_init;
    bf16_t* OC = wsb(F, WS_O) + (size_t)2 * S * 512; const bf16_t* OC2 = wsb(F, WS_OC2);
    const f32x2 sg = *(const f32x2*)(a.in[13] + layer * 128 + lane * 2);
    for (int it = gw; it < S * 4; it += NGW) {
        const size_t off = (size_t)(it >> 2) * 512 + (it & 3) * 128 + lane * 2;
        const unsigned w1 = *(const unsigned*)(OC + off), w2 = *(const unsigned*)(OC2 + off);
        const float x0 = bf_lo(w1) - lam * bf_lo(w2), x1 = bf_hi(w1) - lam * bf_hi(w2);
        const float rn = rsqrtf(wave_sum(x0 * x0 + x1 * x1) * (1.0f / 128.0f) + 1e-6f) * (1.0f - lambda_init);
        *(unsigned*)(OC + off) = cvtpk(x0 * rn * sg.x, x1 * rn * sg.y);
        *(unsigned short*)(F.ws + WS_O8 + (size_t)2 * S * 512 + off) = (unsigned short)__builtin_amdgcn_cvt_pk_fp8_f32(x0 * rn * sg.x * 8.0f, x1 * rn * sg.y * 8.0f, 0, false);
    }
}
template <int NJ, int NE> DI void ln_store(float (&v)[NJ][NE], const float* g, const float* b, float* of, bf16_t* ob, int lane, unsigned char* o8 = nullptr, unsigned char* o4 = nullptr) {
    static_assert(NJ * NE == 32 && NE % 8 == 0, "row layout");
    float s = 0.f;
#pragma unroll
    for (int j = 0; j < NJ; ++j)
#pragma unroll
        for (int e = 0; e < NE; ++e) s += v[j][e];
    const float mean = wave_sum(s) * (1.0f / DM);
    float q = 0.f;
#pragma unroll
    for (int j = 0; j < NJ; ++j)
#pragma unroll
        for (int e = 0; e < NE; ++e) { v[j][e] -= mean; q += v[j][e] * v[j][e]; }
    const float rstd = rsqrtf(wave_sum(q) * (1.0f / DM) + 1e-5f);
#pragma unroll
    for (int j = 0; j < NJ; ++j)
#pragma unroll
        for (int e8 = 0; e8 < NE; e8 += 8) {
            const int c = (DM / NJ) * j + NE * lane + e8;
            const f32x4 g0 = *(const f32x4*)(g + c), g1 = *(const f32x4*)(g + c + 4), b0 = *(const f32x4*)(b + c), b1 = *(const f32x4*)(b + c + 4);
            f32x4 o0, o1;
#pragma unroll
            for (int e = 0; e < 4; ++e) { o0[e] = v[j][e8 + e] * rstd * g0[e] + b0[e]; o1[e] = v[j][e8 + 4 + e] * rstd * g1[e] + b1[e]; }
            if (of) { *(f32x4*)(of + c) = o0; *(f32x4*)(of + c + 4) = o1; }
            u32x4 w; w.x = cvtpk(o0[0], o0[1]); w.y = cvtpk(o0[2], o0[3]); w.z = cvtpk(o1[0], o1[1]); w.w = cvtpk(o1[2], o1[3]);
            if (ob) *(u32x4*)(ob + c) = w;
            if (o8) { int lo = __builtin_amdgcn_cvt_pk_fp8_f32(o0[0], o0[1], 0, false); lo = __builtin_amdgcn_cvt_pk_fp8_f32(o0[2], o0[3], lo, true); int hi = __builtin_amdgcn_cvt_pk_fp8_f32(o1[0], o1[1], 0, false); hi = __builtin_amdgcn_cvt_pk_fp8_f32(o1[2], o1[3], hi, true);
                *(u32x2*)(o8 + c) = (u32x2){(unsigned)lo, (unsigned)hi}; }
            if (o4) { unsigned d = 0u; d = __builtin_amdgcn_cvt_scalef32_pk_fp4_f32(d, o0[0] * 2.0f, o0[1] * 2.0f, 1.0f, 0); d = __builtin_amdgcn_cvt_scalef32_pk_fp4_f32(d, o0[2] * 2.0f, o0[3] * 2.0f, 1.0f, 1);
                d = __builtin_amdgcn_cvt_scalef32_pk_fp4_f32(d, o1[0] * 2.0f, o1[1] * 2.0f, 1.0f, 2); d = __builtin_amdgcn_cvt_scalef32_pk_fp4_f32(d, o1[2] * 2.0f, o1[3] * 2.0f, 1.0f, 3); *(unsigned*)(o4 + (c >> 1)) = d; }
        }
}
DI void phase_ln1(const Frame& F, const Args& a, int layer) {
    const bf16_t* Y = wsb(F, WS_GT); bf16_t* XB = wsb(F, WS_XB);
    const int gw = F.vcu * NWAVES + F.wave, NGW = F.G * NWAVES, lane = F.lane;
    for (int t = gw; t < S; t += NGW) {
        float v[4][8];
#pragma unroll
        for (int j = 0; j < 4; ++j) { const u32x4 w = *(const u32x4*)(Y + (size_t)t * DM + 512 * j + 8 * lane);
            v[j][0] = bf_lo(w.x); v[j][1] = bf_hi(w.x); v[j][2] = bf_lo(w.y); v[j][3] = bf_hi(w.y); v[j][4] = bf_lo(w.z); v[j][5] = bf_hi(w.z); v[j][6] = bf_lo(w.w); v[j][7] = bf_hi(w.w); }
        ln_store<4, 8>(v, a.in[18] + layer * DM, a.in[19] + layer * DM, (float*)nullptr, XB + (size_t)t * DM, lane);
    }
}

namespace att {
constexpr int TBL = RING_BYTES - 4096;
constexpr int TPMO = TBL - 1024;
constexpr int KMO = 0;
constexpr float NEG = -1e30f;
enum { MIX_A = 0, MIX_B = 1, MIX_C = 2, MIX_D = 3 };

struct Ctx { int qi, pq, own; float c, cb; unsigned long long sel; };

DI int t5_bucket(int rel) {
    if (rel < 16) return rel;
    return 15 + (rel >= 16) + (rel >= 21) + (rel >= 27) + (rel >= 35) + (rel >= 46) + (rel >= 59) + (rel >= 77) + (rel >= 99) + (rel >= 128) + (rel >= 166) + (rel >= 216) + (rel >= 280) + (rel >= 363) + (rel >= 470) + (rel >= 609) + (rel >= 790);
}
DI void build_tbl(LAS unsigned char* lds, const float* t5, int col, const int* tpmax) {
    if (threadIdx.x < 256) *(LAS int*)(lds + TPMO + threadIdx.x * 4) = tpmax[threadIdx.x];
    for (int rel = threadIdx.x; rel < 1024; rel += 512) *(LAS float*)(lds + TBL + rel * 4) = t5[t5_bucket(rel) * 16 + col] * LOG2E;
}

#define ATT_SB() __builtin_amdgcn_sched_barrier(0)
#ifndef ATT_CONV_INTERLEAVE
#define ATT_CONV_INTERLEAVE 1
#endif
#ifndef ATT_CP_D
#define ATT_CP_D 0
#endif
#ifndef ATT_CP
#define ATT_CP 0
#endif
#ifndef ATT_X_LDS2
#define ATT_X_LDS2 0
#endif
#ifndef ATT_NOPRIO
#define ATT_NOPRIO 0
#endif
#if ATT_NOPRIO
#define ATT_PRIO(x) do { } while (0)
#else
#define ATT_PRIO(x) __builtin_amdgcn_s_setprio(x)
#endif
#if defined(ATT_X_NOSM)
#define ATT_SM(...) do { l_run = 1.0f; st0.resc = false; st1.resc = false; st0.alpha = 1.f; st1.alpha = 1.f; pf0[0] = qf[0]; pf0[1] = qf[1]; pf1[0] = qf[2]; pf1[1] = qf[3]; } while (0)
#else
#define ATT_SM(...) __VA_ARGS__
#endif
#ifndef ATT_PD
#define ATT_PD 4
#endif
DI float hmax32(float v) { auto rr = __builtin_amdgcn_permlane32_swap(__float_as_uint(v), __float_as_uint(v), false, false); return fmaxf(__uint_as_float(rr[0]), __uint_as_float(rr[1])); }
struct SmState { float mx, cc, dd, rs; bool resc; float alpha; };
template <int MIX, bool FAST, int W>
DI void sm_item(f32x16& s, SmState& st, float& m_run, float& l_run, bf16x8 (&pf)[2], const Ctx& cx, const LAS unsigned char* pkp, const LAS unsigned char* lds, int k0, int kmax, int kmin, int hi, bool lv) {
    constexpr bool BIAS = (MIX != MIX_D);
    if constexpr (W == 0 || W == 1) {
        constexpr int sg = W;
        if constexpr (FAST) {
            float a = fmaxf(fmaxf(s[sg * 8 + 0], s[sg * 8 + 1]), s[sg * 8 + 2]), b = fmaxf(fmaxf(s[sg * 8 + 3], s[sg * 8 + 4]), s[sg * 8 + 5]);
            a = fmaxf(fmaxf(a, s[sg * 8 + 6]), s[sg * 8 + 7]);
            st.mx = (W == 0) ? fmaxf(a, b) : fmaxf(st.mx, fmaxf(a, b));
            asm volatile("" : "+v"(st.mx));
        } else {
            i32x4 pk0 = (i32x4){0, 0, 0, 0}, pk1 = (i32x4){0, 0, 0, 0};
            if (BIAS) { const LAS i32x4* pp = (const LAS i32x4*)(pkp + (sg * 16 + hi * 8) * 4); pk0 = pp[0]; pk1 = pp[1]; }
            float mx = (W == 0) ? NEG : st.mx;
#pragma unroll
            for (int j = 0; j < 8; ++j) {
                const int i = sg * 8 + j, key = k0 + sg * 16 + hi * 8 + j;
                float tv = s[i] * cx.c;
                if (BIAS) { int rel = cx.pq - (j < 4 ? pk0[j & 3] : pk1[j & 3]); rel = rel < 0 ? 0 : (rel > 1023 ? 1023 : rel); tv += *(const LAS float*)(lds + TBL + rel * 4); }
                bool valid = key <= kmax;
                if (MIX == MIX_B) valid = valid && (key >= kmin);
                tv = valid ? tv : NEG;
                s[i] = tv; mx = fmaxf(mx, tv);
            }
            st.mx = mx;
        }
        if constexpr (W == 1) {
            float mx = hmax32(st.mx);
            if constexpr (FAST) mx = lv ? mx * cx.c + cx.cb : NEG;
            const bool need = mx > m_run + 8.0f;
            const float mn = need ? mx : m_run;
            st.alpha = ex2(m_run - mn); m_run = mn; l_run *= st.alpha;
            st.resc = (__ballot(need) != 0ull);
            st.cc = FAST ? (lv ? cx.c : 0.f) : 1.0f; st.dd = FAST ? (lv ? cx.cb - mn : NEG) : -mn; st.rs = 0.f;
            asm volatile("" : "+v"(st.alpha), "+v"(m_run), "+v"(l_run), "+v"(st.dd));
        }
    } else if constexpr (W >= 2 && W <= 5) {
        constexpr int e0 = (W - 2) * 4;
#pragma unroll
        for (int e = e0; e < e0 + 4; ++e) { float p = ex2(s[e] * st.cc + st.dd); asm volatile("" : "+v"(p)); s[e] = p; st.rs += p; }
        asm volatile("" : "+v"(st.rs));
        if constexpr (W == 5) l_run += st.rs;
    } else {
        constexpr int sg = W - 6;
        u32x4 w; w.x = cvtpk(s[sg * 8 + 0], s[sg * 8 + 1]); w.y = cvtpk(s[sg * 8 + 2], s[sg * 8 + 3]); w.z = cvtpk(s[sg * 8 + 4], s[sg * 8 + 5]); w.w = cvtpk(s[sg * 8 + 6], s[sg * 8 + 7]); asm volatile("" : "+v"(w)); pf[sg] = __builtin_bit_cast(bf16x8, w);
    }
}
template <int DQK, int DV, int MIX, bool FAST>
DI void tile_body(const LAS unsigned char* sb, const LAS unsigned char* lds, const bf16x8 (&qf)[DQK / 16], f32x16 (&o)[DV / 32], float& m_run, float& l_run, const Ctx& cx,
                  int k0, int kmax, int kmin, int pr, int xk, int xv, int r, int hi, bool lv) {
    constexpr int KCH = DQK / 8, NQ = DQK / 16, NP = DV / 16, KBUF = 64 * KCH * 16, VBUF = DV * 128;
    const LAS unsigned char* kb0 = sb + pr * (KCH * 16); const LAS unsigned char* kb1 = kb0 + 32 * (KCH * 16);
    const LAS unsigned char* vb = sb + KBUF + r * 128; const LAS unsigned char* pkp = sb + KBUF + VBUF;
    f32x16 s0, s1;
#pragma unroll
    for (int i = 0; i < 16; ++i) { s0[i] = 0.f; s1[i] = 0.f; }
    bf16x8 kf[NQ], kg[NQ], vf[2 * NP], pf0[2], pf1[2];
    SmState st0, st1;
#if defined(ATT_X_NOLDS)
#define ATT_KF(base, kk) (qf[(kk) % NQ])
#else
#define ATT_KF(base, kk) (*(const LAS bf16x8*)((base) + (((2 * (kk) + hi) ^ xk) << 4)))
#endif
#if defined(ATT_X_NOLDS)
#define ATT_VF(f) (qf[(f) % NQ])
#else
#define ATT_VF(f) (*(const LAS bf16x8*)(vb + (((f) % NP) >> 1) * 32 * 128 + (((((f) / NP) * 4 + ((f) & 1) * 2 + hi) ^ xv) << 4)))
#endif
#define ATT_PRE_K(W) do { _Pragma("unroll") for (int kk = ((W) * NQ) / 8; kk < (((W) + 1) * NQ) / 8; ++kk) { kg[kk] = ATT_KF(kb1, kk); if (ATT_X_LDS2) { bf16x8 dm_ = ATT_KF(kb1 + 16, kk); asm volatile("" :: "v"(dm_)); } } } while (0)
#define ATT_PRE_V(W) do { _Pragma("unroll") for (int f = ((W) * NP) / 8; f < (((W) + 1) * NP) / 8; ++f) { vf[f] = ATT_VF(f); if (ATT_X_LDS2) { bf16x8 dm_ = ATT_VF(f ^ 1); asm volatile("" :: "v"(dm_)); } } } while (0)
#pragma unroll
    for (int kk = 0; kk < NQ; ++kk) kf[kk] = ATT_KF(kb0, kk);
    ATT_SB();
#pragma unroll
    for (int kk = 0; kk < NQ; ++kk) s0 = __builtin_amdgcn_mfma_f32_32x32x16_bf16(kf[kk], qf[kk], s0, 0, 0, 0);
    ATT_PRE_K(0); ATT_PRE_K(1); if (ATT_PD > 2) ATT_PRE_K(2); if (ATT_PD > 3) ATT_PRE_K(3);
    ATT_SB();
#define ATT_STEP2(W) do { \
        ATT_PRIO(1); _Pragma("unroll") for (int kk = ((W) * NQ) / 8; kk < (((W) + 1) * NQ) / 8; ++kk) s1 = __builtin_amdgcn_mfma_f32_32x32x16_bf16(kg[kk], qf[kk], s1, 0, 0, 0); ATT_PRIO(0); \
        if ((W) + ATT_PD < 8) ATT_PRE_K((W) + ATT_PD); else ATT_PRE_V((W) + ATT_PD - 8); \
        ATT_SM(sm_item<MIX, FAST, W>(s0, st0, m_run, l_run, pf0, cx, pkp, lds, k0, kmax, kmin, hi, lv)); ATT_SB(); } while (0)
    ATT_STEP2(0); ATT_STEP2(1); ATT_STEP2(2); ATT_STEP2(3); ATT_STEP2(4); ATT_STEP2(5); ATT_STEP2(6); ATT_STEP2(7);
#undef ATT_STEP2
    if (st0.resc) {
#pragma unroll
        for (int d = 0; d < DV / 32; ++d)
#pragma unroll
            for (int i = 0; i < 16; ++i) o[d][i] *= st0.alpha;
    }
    ATT_SB();
#define ATT_STEP3(W) do { \
        ATT_PRIO(1); _Pragma("unroll") for (int f = ((W) * NP) / 8; f < (((W) + 1) * NP) / 8; ++f) o[f >> 1] = __builtin_amdgcn_mfma_f32_32x32x16_bf16(vf[f], pf0[f & 1], o[f >> 1], 0, 0, 0); ATT_PRIO(0); \
        ATT_PRE_V((W) + ATT_PD); \
        ATT_SM(sm_item<MIX, FAST, W>(s1, st1, m_run, l_run, pf1, cx, pkp + 128, lds, k0 + 32, kmax, kmin, hi, lv)); ATT_SB(); } while (0)
    ATT_STEP3(0); ATT_STEP3(1); ATT_STEP3(2); ATT_STEP3(3); ATT_STEP3(4); ATT_STEP3(5); ATT_STEP3(6); ATT_STEP3(7);
#undef ATT_STEP3
    if (st1.resc) {
#pragma unroll
        for (int d = 0; d < DV / 32; ++d)
#pragma unroll
            for (int i = 0; i < 16; ++i) o[d][i] *= st1.alpha;
    }
    ATT_SB();
#define ATT_STEP4(W) do { \
        _Pragma("unroll") for (int f = ((W) * NP) / 8; f < (((W) + 1) * NP) / 8; ++f) o[(f - NP) >> 1] = __builtin_amdgcn_mfma_f32_32x32x16_bf16(vf[f], pf1[f & 1], o[(f - NP) >> 1], 0, 0, 0); \
        if ((W) + ATT_PD < 16) ATT_PRE_V((W) + ATT_PD); ATT_SB(); } while (0)
    ATT_STEP4(8); ATT_STEP4(9); ATT_STEP4(10); ATT_STEP4(11); ATT_STEP4(12); ATT_STEP4(13); ATT_STEP4(14); ATT_STEP4(15);
#undef ATT_STEP4
#undef ATT_KF
#undef ATT_VF
#undef ATT_PRE_K
#undef ATT_PRE_V
}
template <int DQK, int DV, int MIX>
DI void flash_pass(LAS unsigned char* lds, const bf16x8 (&qf)[DQK / 16], const bf16_t* __restrict__ Kg, int ldk, const bf16_t* __restrict__ VTg, int ldvt,
                   const int* __restrict__ pos, int t0, int t1, int q0, int qpmin, const Ctx& cx, f32x16 (&o)[DV / 32], float& m_run, float& l_run, int ts_force = -1) {
    constexpr int KCH = DQK / 8, NKL = KCH / 8, NVL = DV / 64;
    constexpr bool BIAS = (MIX != MIX_D);
    constexpr int KBUF = 64 * KCH * 16, VBUF = DV * 128, PBUF = BIAS ? 2048 : 0, SLOT = KBUF + VBUF + PBUF, NV = NKL + NVL + (BIAS ? 1 : 0);
    static_assert(3 * SLOT <= TPMO, "attention ring");
    static_assert(DQK % 128 == 0 || DQK == 64 || DQK == 192, "QK MFMAs per softmax work item");
    int tid = threadIdx.x; asm volatile("" : "+v"(tid));
    const int lane = tid & 63, r = lane & 31, hi = lane >> 5, wave = __builtin_amdgcn_readfirstlane(tid >> 6);
    const int pr = (r & 0x13) | ((r & 4) << 1) | ((r & 8) >> 1);
    const int xk = (KCH == 16) ? (((pr & 1) << 3) | ((pr >> 1) & 7)) : ((pr >> 1) & 7);
    const int xv = (r >> 1) & 7;
    unsigned koff[NKL], voff[NVL];
#pragma unroll
    for (int i = 0; i < NKL; ++i) { const int p = (i * 8 + wave) * 64 + lane, row = p / KCH, cs = p % KCH; const int x = (KCH == 16) ? (((row & 1) << 3) | ((row >> 1) & 7)) : ((row >> 1) & 7); koff[i] = (unsigned)(row * ldk + (cs ^ x) * 8) * 2u; }
#pragma unroll
    for (int i = 0; i < NVL; ++i) { const int p = (i * 8 + wave) * 64 + lane, row = p >> 3, cs = p & 7; voff[i] = (unsigned)(row * ldvt + (cs ^ ((row >> 1) & 7)) * 8) * 2u; }
#define ATT_ISSUE(t, sl) do { LAS unsigned char* sb_ = lds + (sl) * SLOT; \
    _Pragma("unroll") for (int i_ = 0; i_ < NKL; ++i_) __builtin_amdgcn_global_load_lds((const unsigned*)((const char*)Kg + (size_t)(t) * 64 * ldk * 2 + koff[i_]), (LAS unsigned*)(sb_ + (i_ * 8 + wave) * 1024), 16, 0, 0); \
    _Pragma("unroll") for (int i_ = 0; i_ < NVL; ++i_) __builtin_amdgcn_global_load_lds((const unsigned*)((const char*)VTg + (size_t)(t) * 128 + voff[i_]), (LAS unsigned*)(sb_ + KBUF + (i_ * 8 + wave) * 1024), 16, 0, 0); \
    if (BIAS) __builtin_amdgcn_global_load_lds((const unsigned*)(pos + (t) * 64 + lane), (LAS unsigned*)(sb_ + KBUF + VBUF + wave * 256), 4, 0, 0); } while (0)
#ifndef ATT_X_DMA2
#define ATT_X_DMA2 0
#endif
#if ATT_X_DMA2
#define ATT_ISSUE2(t, sl) do { ATT_ISSUE(t, sl); ATT_ISSUE(t, sl); } while (0)
#else
#define ATT_ISSUE2(t, sl) ATT_ISSUE(t, sl)
#endif
#if defined(ATT_X_NODMA)
#define ATT_ISSUE_LOOP(t, sl) do { (void)(sl); } while (0)
#define ATT_NEXT_SLOT(sl) ((sl) ^ 1)
#else
#define ATT_ISSUE_LOOP(t, sl) ATT_ISSUE2(t, sl)
#define ATT_NEXT_SLOT(sl) (((sl) == 2) ? 0 : (sl) + 1)
#endif
#define ATT_WAITBAR(N) asm volatile("s_waitcnt vmcnt(%0) lgkmcnt(0)\n\ts_barrier" :: "n"(N) : "memory")
    int ts = t0;
    if (ts_force >= 0) ts = ts_force;
    else if (MIX != MIX_B) { const int tlim = (q0 >> 6) < t1 ? (q0 >> 6) : t1;
        if (!BIAS) ts = tlim > t0 ? tlim : t0;
        else {
            ts = tlim > t0 ? tlim : t0;
            for (int base = t0; base < tlim; base += 64) { const int idx = base + lane; const bool stop = (idx >= tlim) || (qpmin - *(const LAS int*)(lds + TPMO + (idx < 256 ? idx : 255) * 4) < 790);
                const unsigned long long mk = __ballot(stop); if (mk != 0ull) { const int f = base + (int)__builtin_ctzll(mk); ts = f < tlim ? f : tlim; break; } } } }
    ATT_ISSUE2(t0, 0);
    if (t0 + 1 < t1) ATT_ISSUE2(t0 + 1, 1);
    int sl = 0;
#define ATT_TILES(TA, TB, FASTV) \
    for (int t = (TA); t < (TB); ++t) { \
        if (t + 1 < t1) ATT_WAITBAR(NV * (ATT_X_DMA2 ? 2 : 1)); else ATT_WAITBAR(0);            \
        if (t + 2 < t1) { const int s2 = (sl >= 1) ? sl - 1 : 2; ATT_ISSUE_LOOP(t + 2, s2); } \
        const LAS unsigned char* sb = lds + sl * SLOT; \
        int kmax, kmin = 0; \
        kmax = cx.qi; \
        if (MIX == MIX_B) kmin = cx.qi - 127; \
        const int k0 = t * 64; \
        const bool lv = (kmax >= k0) && (kmin <= k0 + 63); \
        if (__ballot(lv) != 0ull) tile_body<DQK, DV, MIX, FASTV>(sb, lds, qf, o, m_run, l_run, cx, k0, kmax, kmin, pr, xk, xv, r, hi, lv); \
        sl = ATT_NEXT_SLOT(sl); \
    }
    ATT_TILES(t0, ts, true)
    ATT_TILES(ts, t1, false)
#undef ATT_TILES
    asm volatile("s_waitcnt lgkmcnt(0)\n\ts_barrier" ::: "memory");
#undef ATT_ISSUE
#undef ATT_WAITBAR
}
DI int fast_split(const LAS unsigned char* lds, int t0, int t1, int q0, int qpmin, int lane) {
    const int tlim = (q0 >> 6) < t1 ? (q0 >> 6) : t1;
    int ts = tlim > t0 ? tlim : t0;
    for (int base = t0; base < tlim; base += 64) { const int idx = base + lane; const bool stop = (idx >= tlim) || (qpmin - *(const LAS int*)(lds + TPMO + (idx < 256 ? idx : 255) * 4) < 790);
        const unsigned long long mk = __ballot(stop); if (mk != 0ull) { const int f = base + (int)__builtin_ctzll(mk); ts = f < tlim ? f : tlim; break; } }
    return ts;
}
template <int DQK, int DV, int MIX>
DI void flash_pass_cp(LAS unsigned char* lds, const bf16x8 (&qf)[DQK / 16], const bf16_t* __restrict__ Kg, int ldk, const bf16_t* __restrict__ VTg, int ldvt,
                      int t0, int ts, const Ctx& cx, f32x16 (&o)[DV / 32], float& m_run, float& l_run) {
    constexpr int KCH = DQK / 8, NKL = KCH / 8, NVL = DV / 64, NQ = DQK / 16, NP = DV / 16;
    constexpr int KBUF = 64 * KCH * 16, VBUF = DV * 128;
    static_assert(3 * (KBUF + VBUF) <= TPMO, "attention rings");
    int tid = threadIdx.x; asm volatile("" : "+v"(tid));
    const int lane = tid & 63, r = lane & 31, hi = lane >> 5, wave = __builtin_amdgcn_readfirstlane(tid >> 6);
    const int pr = (r & 0x13) | ((r & 4) << 1) | ((r & 8) >> 1);
    const int xk = (KCH == 16) ? (((pr & 1) << 3) | ((pr >> 1) & 7)) : ((pr >> 1) & 7);
    const int xv = (r >> 1) & 7;
    unsigned koff[NKL], voff[NVL];
#pragma unroll
    for (int i = 0; i < NKL; ++i) { const int p = (i * 8 + wave) * 64 + lane, row = p / KCH, cs = p % KCH; const int x = (KCH == 16) ? (((row & 1) << 3) | ((row >> 1) & 7)) : ((row >> 1) & 7); koff[i] = (unsigned)(row * ldk + (cs ^ x) * 8) * 2u; }
#pragma unroll
    for (int i = 0; i < NVL; ++i) { const int p = (i * 8 + wave) * 64 + lane, row = p >> 3, cs = p & 7; voff[i] = (unsigned)(row * ldvt + (cs ^ ((row >> 1) & 7)) * 8) * 2u; }
#define CP_ISSUE_K(t, sl) do { _Pragma("unroll") for (int i_ = 0; i_ < NKL; ++i_) __builtin_amdgcn_global_load_lds((const unsigned*)((const char*)Kg + (size_t)(t) * 64 * ldk * 2 + koff[i_]), (LAS unsigned*)(lds + (sl) * KBUF + (i_ * 8 + wave) * 1024), 16, 0, 0); } while (0)
#define CP_ISSUE_V(t, sl) do { _Pragma("unroll") for (int i_ = 0; i_ < NVL; ++i_) __builtin_amdgcn_global_load_lds((const unsigned*)((const char*)VTg + (size_t)(t) * 128 + voff[i_]), (LAS unsigned*)(lds + 3 * KBUF + (sl) * VBUF + (i_ * 8 + wave) * 1024), 16, 0, 0); } while (0)
#define CP_KF(base, kk) (*(const LAS bf16x8*)((base) + (((2 * (kk) + hi) ^ xk) << 4)))
#define CP_VF(base, hf, j) (*(const LAS bf16x8*)((base) + ((j) >> 1) * 32 * 128 + (((((hf) * 4 + ((j) & 1) * 2 + hi) ^ xv)) << 4)))
    const int n = ts - t0;
    CP_ISSUE_K(t0, 0); CP_ISSUE_V(t0, 0);
    if (n > 1) CP_ISSUE_K(t0 + 1, 1);
    asm volatile("s_waitcnt vmcnt(0) lgkmcnt(0)\n\ts_barrier" ::: "memory");
    const LAS unsigned char* kl = lds + pr * (KCH * 16);
    const LAS unsigned char* vl = lds + 3 * KBUF + r * 128;
    f32x16 sc, sn;
    bf16x8 kfr[NQ], vfr[NP], pp[2], pc[2];
    SmState st;
#pragma unroll
    for (int i = 0; i < 16; ++i) sc[i] = 0.f;
#pragma unroll
    for (int kk = 0; kk < NQ; ++kk) kfr[kk] = CP_KF(kl, kk);
    ATT_SB();
#pragma unroll
    for (int kk = 0; kk < NQ; ++kk) sc = __builtin_amdgcn_mfma_f32_32x32x16_bf16(kfr[kk], qf[kk], sc, 0, 0, 0);
#define CP_PRE(W, KB, HFK_UNUSED, VB, HFV, DOK, DOV) do { \
        if (DOK) { _Pragma("unroll") for (int kk = ((W) * NQ) / 8; kk < (((W) + 1) * NQ) / 8; ++kk) kfr[kk] = CP_KF(KB, kk); } \
        if (DOV) { _Pragma("unroll") for (int j = ((W) * NP) / 8; j < (((W) + 1) * NP) / 8; ++j) vfr[j] = CP_VF(VB, HFV, j); } } while (0)
#define CP_ITEM(W, DOK, DOV, KB, VB, HFV, KBN, VBN, HFVN) do { \
        ATT_PRIO(1); \
        if (DOK) { _Pragma("unroll") for (int kk = ((W) * NQ) / 8; kk < (((W) + 1) * NQ) / 8; ++kk) sn = __builtin_amdgcn_mfma_f32_32x32x16_bf16(kfr[kk], qf[kk], sn, 0, 0, 0); } \
        if (DOV) { _Pragma("unroll") for (int j = ((W) * NP) / 8; j < (((W) + 1) * NP) / 8; ++j) o[j >> 1] = __builtin_amdgcn_mfma_f32_32x32x16_bf16(vfr[j], pp[j & 1], o[j >> 1], 0, 0, 0); } \
        ATT_PRIO(0); \
        if ((W) + 2 < 8) CP_PRE((W) + 2, KB, 0, VB, HFV, DOK, DOV); else CP_PRE((W) - 6, KBN, 0, VBN, HFVN, true, true); \
        sm_item<MIX, true, W>(sc, st, m_run, l_run, pc, cx, lds, lds, 0, 0, 0, hi, true); ATT_SB(); } while (0)
#define CP_STEP(DOK, DOV, KB, VB, HFV, KBN, VBN, HFVN) do { \
        _Pragma("unroll") for (int i = 0; i < 16; ++i) sn[i] = 0.f; \
        CP_ITEM(0, DOK, DOV, KB, VB, HFV, KBN, VBN, HFVN); CP_ITEM(1, DOK, DOV, KB, VB, HFV, KBN, VBN, HFVN); CP_ITEM(2, DOK, DOV, KB, VB, HFV, KBN, VBN, HFVN); CP_ITEM(3, DOK, DOV, KB, VB, HFV, KBN, VBN, HFVN); \
        CP_ITEM(4, DOK, DOV, KB, VB, HFV, KBN, VBN, HFVN); CP_ITEM(5, DOK, DOV, KB, VB, HFV, KBN, VBN, HFVN); CP_ITEM(6, DOK, DOV, KB, VB, HFV, KBN, VBN, HFVN); CP_ITEM(7, DOK, DOV, KB, VB, HFV, KBN, VBN, HFVN); \
        if (st.resc) { _Pragma("unroll") for (int d = 0; d < DV / 32; ++d) _Pragma("unroll") for (int i = 0; i < 16; ++i) o[d][i] *= st.alpha; } \
        pp[0] = pc[0]; pp[1] = pc[1]; sc = sn; ATT_SB(); } while (0)
    int ks = 0, vs = 0;
    for (int i = 0; i < n; ++i) {
        const int t = t0 + i;
        const int ks1 = (ks == 2) ? 0 : ks + 1, ks2 = (ks == 0) ? 2 : ks - 1, vs1 = (vs == 2) ? 0 : vs + 1, vsp = (vs == 0) ? 2 : vs - 1;
        if (i > 0) asm volatile("s_waitcnt vmcnt(0) lgkmcnt(0)\n\ts_barrier" ::: "memory");
        if (t + 2 < ts) CP_ISSUE_K(t + 2, ks2);
        if (t + 1 < ts) CP_ISSUE_V(t + 1, vs1);
        const LAS unsigned char* kA = kl + ks * KBUF + 32 * (KCH * 16); const LAS unsigned char* kB = kl + ks1 * KBUF; const LAS unsigned char* kAn = kl + ks1 * KBUF + 32 * (KCH * 16);
        const LAS unsigned char* vP = vl + vsp * VBUF; const LAS unsigned char* vC = vl + vs * VBUF;
        if (i == 0) {
            CP_PRE(0, kA, 0, vP, 1, true, false); CP_PRE(1, kA, 0, vP, 1, true, false);
            CP_STEP(true, false, kA, vP, 1, kB, vC, 0);
        } else {
            CP_STEP(true, true, kA, vP, 1, kB, vC, 0);
        }
        CP_STEP(true, true, kB, vC, 0, kAn, vC, 1);
        ks = ks1; vs = vs1;
    }
    {
        const int vsp = (vs == 0) ? 2 : vs - 1; const LAS unsigned char* vP = vl + vsp * VBUF;
#pragma unroll
        for (int j = (2 * NP) / 8; j < NP; ++j) vfr[j] = CP_VF(vP, 1, j);
        ATT_SB();
#pragma unroll
        for (int j = 0; j < NP; ++j) o[j >> 1] = __builtin_amdgcn_mfma_f32_32x32x16_bf16(vfr[j], pp[j & 1], o[j >> 1], 0, 0, 0);
    }
    asm volatile("s_waitcnt lgkmcnt(0)\n\ts_barrier" ::: "memory");
#undef CP_ISSUE_K
#undef CP_ISSUE_V
#undef CP_KF
#undef CP_VF
#undef CP_PRE
#undef CP_ITEM
#undef CP_STEP
}
template <int DV> DI void store_o(const f32x16 (&o)[DV / 32], float scale, bf16_t* orow, int hi) {
#pragma unroll
    for (int d = 0; d < DV / 32; ++d)
#pragma unroll
        for (int a = 0; a < 4; ++a) { u32x2 w; w.x = cvtpk(o[d][4 * a] * scale, o[d][4 * a + 1] * scale); w.y = cvtpk(o[d][4 * a + 2] * scale, o[d][4 * a + 3] * scale); *(u32x2*)(orow + d * 32 + 8 * a + 4 * hi) = w; }
}

template <int DV> DI void store_o8(const f32x16 (&o)[DV / 32], float scale, unsigned char* orow, int hi) {
#pragma unroll
    for (int d = 0; d < DV / 32; ++d)
#pragma unroll
        for (int a = 0; a < 4; ++a) { int w = __builtin_amdgcn_cvt_pk_fp8_f32(o[d][4 * a] * scale, o[d][4 * a + 1] * scale, 0, false); w = __builtin_amdgcn_cvt_pk_fp8_f32(o[d][4 * a + 2] * scale, o[d][4 * a + 3] * scale, w, true); *(unsigned*)(orow + d * 32 + 8 * a + 4 * hi) = (unsigned)w; }
}
DI int wg_min_pos(const Frame& F, int pq) {
#pragma unroll
    for (int o = 1; o < 64; o <<= 1) { const int other = __shfl_xor(pq, o); pq = other < pq ? other : pq; }
    if (F.tid == 0) F.MISC[5] = 0x7fffffffu;
    __syncthreads();
    if (F.lane == 0) atomicMin((int*)&F.MISC[5], pq);
    __syncthreads();
    const int v = (int)F.MISC[5];
    __syncthreads();
    return v;
}
DI void unit_D(const Frame& F, const Args& a, int h, int qt) {
    int lane = F.lane; asm volatile("" : "+v"(lane));
    const int r = lane & 31, hi = lane >> 5, qi = qt * 256 + F.wave * 32 + r;
    const bf16_t* QD = wsb(F, WS_QD) + (size_t)qi * 768 + h * 192 + hi * 8;
    bf16x8 qf[12];
#pragma unroll
    for (int kk = 0; kk < 12; ++kk) qf[kk] = *(const bf16x8*)(QD + kk * 16);
    f32x16 o[4];
#pragma unroll
    for (int d = 0; d < 4; ++d)
#pragma unroll
        for (int i = 0; i < 16; ++i) o[d][i] = 0.f;
    float m = NEG, l = 0.f;
    Ctx cx; cx.qi = qi; cx.pq = 0; cx.own = 0; cx.sel = 0ull; cx.cb = 0.f; cx.c = 0.07216878364870322f * LOG2E;
    const int ts = qt * 4;
    if (ATT_CP_D && ts > 0) flash_pass_cp<192, 128, MIX_D>(F.lds, qf, wsb(F, WS_KD) + h * 192, 768, wsb(F, WS_VDT) + (size_t)(h * 128) * S, S, 0, ts, cx, o, m, l);
    flash_pass<192, 128, MIX_D>(F.lds, qf, wsb(F, WS_KD) + h * 192, 768, wsb(F, WS_VDT) + (size_t)(h * 128) * S, S, (const int*)a.in[1], ATT_CP_D ? ts : 0, (qt + 1) * 4, qt * 256, 0, cx, o, m, l, ATT_CP_D ? ts : -1);
    l += xhalf(l);
    int lane2 = F.lane; asm volatile("" : "+v"(lane2));
    const int hi2 = lane2 >> 5, qi2 = qt * 256 + F.wave * 32 + (lane2 & 31);
#if defined(MK_CHECK) && MK_CHECK
    store_o<128>(o, 1.0f / l, wsb(F, WS_O) + (size_t)3 * S * 512 + (size_t)qi2 * 512 + h * 128, hi2);
#endif
    store_o8<128>(o, 8.0f / l, F.ws + WS_O8 + (size_t)3 * S * 512 + (size_t)qi2 * 512 + h * 128, hi2);
}
DI void unit_C(const Frame& F, const Args& a, int h, int qt, int mp) {
    int lane = F.lane; asm volatile("" : "+v"(lane));
    const int r = lane & 31, hi = lane >> 5, qi = qt * 256 + F.wave * 32 + r;
    const int* pos = (const int*)a.in[1];
    build_tbl(F.lds, a.in[2], 12 + h, (const int*)(F.ws + WS_TPMAX));
    Ctx cx; cx.qi = qi; cx.pq = pos[qi]; cx.own = 0; cx.sel = 0ull; cx.c = 0.125f * LOG2E; cx.cb = a.in[2][31 * 16 + 12 + h] * LOG2E;
    const int qpmin = wg_min_pos(F, cx.pq);
    const bf16_t* H = wsb(F, WS_H);
    const bf16_t* Q = H + (size_t)qi * HW + H_CQ + h * 128 + mp * 64 + hi * 8;
    bf16x8 qf[4];
#pragma unroll
    for (int kk = 0; kk < 4; ++kk) qf[kk] = *(const bf16x8*)(Q + kk * 16);
    f32x16 o[4];
#pragma unroll
    for (int d = 0; d < 4; ++d)
#pragma unroll
        for (int i = 0; i < 16; ++i) o[d][i] = 0.f;
    float m = NEG, l = 0.f;
    const int ts = ATT_CP ? fast_split(F.lds, 0, (qt + 1) * 4, qt * 256, qpmin, lane) : 0;
    if (ATT_CP && ts > 0) flash_pass_cp<64, 128, MIX_C>(F.lds, qf, H + H_CK + h * 128 + mp * 64, HW, wsb(F, WS_VT) + (size_t)(VT_C + h * 128) * S, S, 0, ts, cx, o, m, l);
    flash_pass<64, 128, MIX_C>(F.lds, qf, H + H_CK + h * 128 + mp * 64, HW, wsb(F, WS_VT) + (size_t)(VT_C + h * 128) * S, S, pos, ATT_CP ? ts : 0, (qt + 1) * 4, qt * 256, qpmin, cx, o, m, l, ATT_CP ? ts : -1);
    l += xhalf(l);
    int lane2 = F.lane; asm volatile("" : "+v"(lane2));
    const int hi2 = lane2 >> 5, qi2 = qt * 256 + F.wave * 32 + (lane2 & 31);
    bf16_t* orow = (mp == 0 ? wsb(F, WS_O) + (size_t)2 * S * 512 : wsb(F, WS_OC2)) + (size_t)qi2 * 512 + h * 128;
    store_o<128>(o, 1.0f / l, orow, hi2);
}
DI void unit_B(const Frame& F, const Args& a, int layer, int hq, int qt) {
    const int lane = F.lane, r = lane & 31, hi = lane >> 5, qi = qt * 256 + F.wave * 32 + r, g = hq >> 2;
    const int* pos = (const int*)a.in[1];
    build_tbl(F.lds, a.in[2], 4 + hq, (const int*)(F.ws + WS_TPMAX));
    const bf16_t* H = wsb(F, WS_H);
    const bf16_t* Q = H + (size_t)qi * HW + H_BQ + hq * 64 + hi * 8;
    bf16x8 qf[4];
#pragma unroll
    for (int kk = 0; kk < 4; ++kk) qf[kk] = *(const bf16x8*)(Q + kk * 16);
    f32x16 o[2];
#pragma unroll
    for (int d = 0; d < 2; ++d)
#pragma unroll
        for (int i = 0; i < 16; ++i) o[d][i] = 0.f;
    float m = NEG, l = 0.f;
    Ctx cx; cx.qi = qi; cx.pq = pos[qi]; cx.own = 0; cx.sel = 0ull; cx.c = 0.125f * LOG2E; cx.cb = a.in[2][31 * 16 + 4 + hq] * LOG2E;
    const int t0 = (qt * 4 - 2) < 0 ? 0 : (qt * 4 - 2);
    flash_pass<64, 64, MIX_B>(F.lds, qf, H + H_BK + g * 64, HW, wsb(F, WS_VT) + (size_t)(VT_B + g * 64) * S, S, pos, t0, (qt + 1) * 4, qt * 256, 0, cx, o, m, l);
    l += xhalf(l);
    l += ex2(a.in[8][layer * 8 + hq] * LOG2E - m);
#if defined(MK_CHECK) && MK_CHECK
    store_o<64>(o, 1.0f / l, wsb(F, WS_O) + (size_t)1 * S * 512 + (size_t)qi * 512 + hq * 64, hi);
#endif
    store_o8<64>(o, 8.0f / l, F.ws + WS_O8 + (size_t)1 * S * 512 + (size_t)qi * 512 + hq * 64, hi);
}
DI void store_part(const f32x16 (&o)[4], float m, float l, unsigned char* prow, int hi) {
    l += xhalf(l);
    store_o<128>(o, 1.0f / l, (bf16_t*)prow, hi);
    if (hi == 0) *(f32x2*)(prow + 256) = (f32x2){m, l};
}
DI void unit_A_own(const Frame& F, const Args& a, int h, int qt) {
    const int lane = F.lane, r = lane & 31, hi = lane >> 5, qi = qt * 256 + F.wave * 32 + r;
    const int* pos = (const int*)a.in[1];
    build_tbl(F.lds, a.in[2], h, (const int*)(F.ws + WS_TPMAX));
    const bf16_t* H = wsb(F, WS_H);
    const bf16_t* Q = H + (size_t)qi * HW + H_AQ + h * 128 + hi * 8;
    bf16x8 qf[8];
#pragma unroll
    for (int kk = 0; kk < 8; ++kk) qf[kk] = *(const bf16x8*)(Q + kk * 16);
    f32x16 o[4];
#pragma unroll
    for (int d = 0; d < 4; ++d)
#pragma unroll
        for (int i = 0; i < 16; ++i) o[d][i] = 0.f;
    float m = NEG, l = 0.f;
    Ctx cx; cx.qi = qi; cx.pq = pos[qi]; cx.own = qt; cx.sel = 0ull; cx.c = 0.08838834764831845f * LOG2E; cx.cb = a.in[2][31 * 16 + h] * LOG2E;
    flash_pass<128, 128, MIX_C>(F.lds, qf, H + H_AK + h * 128, HW, wsb(F, WS_VT) + (size_t)(VT_A + h * 128) * S, S, pos, qt * 4, (qt + 1) * 4, 0, 0, cx, o, m, l);
    store_part(o, m, l, F.ws + WS_PART + ((size_t)qi * 16 + h * 4 + 3) * 272, hi);
}
DI void unit_A_gather(const Frame& F, const Args& a, int h, int n, int near, int chunk, int count) {
    const int lane = F.lane, r = lane & 31, hi = lane >> 5;
    const int* pos = (const int*)a.in[1];
    if (near) build_tbl(F.lds, a.in[2], h, (const int*)(F.ws + WS_TPMAX));
    const int* list = (const int*)(F.ws + WS_MLIST) + (size_t)(h * 64 + n) * MCAP + (near ? MCAP_F : 0);
    const int idx = chunk * 256 + F.wave * 32 + r; const bool live = idx < count;
    const int e = list[live ? idx : chunk * 256];
    const int qi = e >> 2, slot = e & 3;
    const bf16_t* H = wsb(F, WS_H);
    const bf16_t* Q = H + (size_t)qi * HW + H_AQ + h * 128 + hi * 8;
    bf16x8 qf[8];
#pragma unroll
    for (int kk = 0; kk < 8; ++kk) qf[kk] = *(const bf16x8*)(Q + kk * 16);
    f32x16 o[4];
#pragma unroll
    for (int d = 0; d < 4; ++d)
#pragma unroll
        for (int i = 0; i < 16; ++i) o[d][i] = 0.f;
    float m = NEG, l = 0.f;
    Ctx cx; cx.qi = 0x7fffffff; cx.pq = pos[qi]; cx.own = 0; cx.sel = 0ull; cx.c = 0.08838834764831845f * LOG2E; cx.cb = a.in[2][31 * 16 + h] * LOG2E;
    flash_pass<128, 128, MIX_C>(F.lds, qf, H + H_AK + h * 128, HW, wsb(F, WS_VT) + (size_t)(VT_A + h * 128) * S, S, pos, n * 4, (n + 1) * 4, 0, 0, cx, o, m, l, near ? n * 4 : (n + 1) * 4);
    if (live) store_part(o, m, l, F.ws + WS_PART + ((size_t)qi * 16 + h * 4 + slot) * 272, hi);
    else { l += xhalf(l); }
}
}

DI int next_unit(const Frame& F, unsigned* head) {
    if (F.tid == 0) F.MISC[4] = __hip_atomic_fetch_add(head, 1u, __ATOMIC_RELAXED, __HIP_MEMORY_SCOPE_AGENT);
    __syncthreads();
    const int u = (int)F.MISC[4];
    __syncthreads();
    return u;
}
DI void convert_chunk(const Frame& F, const Args& a, int layer, int c) {
    const bool isv = c >= 256; const int row0 = (c & 255) * 64 + F.wave * 8;
    const float* src = (isv ? a.in[23] : a.in[22]) + (size_t)layer * 16384 * DM + (size_t)row0 * DM;
    unsigned char* dst = F.ws + WS_UB + (size_t)row0 * 2048 + (isv ? 1024 : 0);
    const float scale = isv ? V_SCALE : U_SCALE;
    int lane = F.lane; asm volatile("" : "+v"(lane));
    for (int j = 0; j < 8; ++j) {
        const float* p = src + (size_t)j * DM + 4 * lane; unsigned char* q = dst + (size_t)j * 2048 + 2 * lane;
        f32x4 x[8];
#pragma unroll
        for (int k = 0; k < 8; ++k) x[k] = *(const f32x4*)(p + 256 * k);
#pragma unroll
        for (int k = 0; k < 8; ++k) { unsigned d = 0u; const f32x4 y = x[k] * scale;
            d = __builtin_amdgcn_cvt_scalef32_pk_fp4_f32(d, y[0], y[1], 1.0f, 0); d = __builtin_amdgcn_cvt_scalef32_pk_fp4_f32(d, y[2], y[3], 1.0f, 1);
            *(unsigned short*)(q + 128 * k) = (unsigned short)d; }
    }
}
template <int PART> DI void phase_attention(const Frame& F, const Args& a, int layer, int rep = 0) {
    unsigned* q = (unsigned*)(F.ws + WS_CTL) + CW_Q + layer * 256 + rep * 512;
    if constexpr (PART == 0) {
#if !defined(NO_D) && !defined(NO_C)
    for (;;) { const int u = next_unit(F, q + 0); if (u >= 768) break;
        const int qt = 63 - u / 12, k = u % 12;
        if (k < 4) att::unit_D(F, a, k, qt);
        else att::unit_C(F, a, (k - 4) >> 1, qt, (k - 4) & 1);
        if (ATT_CONV_INTERLEAVE) { const int c = next_unit(F, q + 32); if (c < 512) convert_chunk(F, a, layer, c); } }
    if (ATT_CONV_INTERLEAVE) for (;;) { const int c = next_unit(F, q + 32); if (c >= 512) break; convert_chunk(F, a, layer, c); }
#endif
    } else {
#ifndef NO_A
    {
        const unsigned* cnt = (const unsigned*)(F.ws + WS_CTL) + CW_MOBA + layer * 1024;
        LAS int* pre = (LAS int*)(F.lds + att::TBL - 4096);
        __syncthreads();
        if (F.tid == 0) { int acc = 0; for (int i = 0; i < 512; ++i) { pre[i] = acc; const unsigned c = cnt[i], cap = (i >= 256) ? (unsigned)(MCAP - MCAP_F) : (unsigned)MCAP_F; acc += (int)(((c < cap ? c : cap) + 255u) >> 8); } pre[512] = acc; }
        __syncthreads();
        const int ntot = 256 + pre[512];
        for (;;) { const int u = next_unit(F, q + 128); if (u >= ntot) break;
            if (u < 256) { att::unit_A_own(F, a, u & 3, 63 - (u >> 2)); continue; }
            const int g = u - 256; int lo_ = 0, hi_ = 511;
            while (lo_ < hi_) { const int mid = (lo_ + hi_ + 1) >> 1; if (pre[mid] <= g) lo_ = mid; else hi_ = mid - 1; }
            const unsigned c = cnt[lo_], cap = (lo_ >= 256) ? (unsigned)(MCAP - MCAP_F) : (unsigned)MCAP_F;
            att::unit_A_gather(F, a, (lo_ >> 6) & 3, lo_ & 63, lo_ >> 8, g - pre[lo_], (int)(c < cap ? c : cap)); }
    }
#endif
#ifndef NO_B
    for (;;) { const int u = next_unit(F, q + 192); if (u >= 512) break; att::unit_B(F, a, layer, u & 7, u >> 3); }
#endif
    }
}

DI void ins16(float (&v)[16], float x) {
#pragma unroll
    for (int k = 0; k < 16; ++k) { const float t = fmaxf(v[k], x); x = fminf(v[k], x); v[k] = t; }
}
DI float pack_idx(float s, int idx, unsigned mask) { return __uint_as_float((__float_as_uint(s) & ~mask) | (unsigned)idx); }
DI void peer_select_group(const Frame& F, const bf16_t* SK, int grp, LAS unsigned char* sel) {
    const bf16_t* QP = wsb(F, WS_H);
    int lane = F.lane; asm volatile("" : "+v"(lane));
    const int r = lane & 31, hi = lane >> 5;
    {
        const int h = F.wave, t = grp * 32 + r;
        float L[2][16];
#pragma unroll
        for (int m = 0; m < 2; ++m) {
            const bf16_t* qrow = QP + (size_t)t * DM + h * 256 + m * 128 + hi * 8;
            bf16x8 qf[8];
#pragma unroll
            for (int kk = 0; kk < 8; ++kk) qf[kk] = *(const bf16x8*)(qrow + kk * 16);
            const bf16_t* kb = SK + ((size_t)(h * 2 + m) * 128 + r) * 128 + hi * 8;
            float v[16];
#pragma unroll
            for (int k = 0; k < 16; ++k) v[k] = -3.0e38f;
#pragma unroll
            for (int rb = 0; rb < 4; ++rb) {
                f32x16 s;
#pragma unroll
                for (int i = 0; i < 16; ++i) s[i] = 0.f;
#pragma unroll
                for (int kk = 0; kk < 8; ++kk) { const bf16x8 kf = *(const bf16x8*)(kb + (size_t)rb * 32 * 128 + kk * 16); s = __builtin_amdgcn_mfma_f32_32x32x16_bf16(kf, qf[kk], s, 0, 0, 0); }
#pragma unroll
                for (int i = 0; i < 16; ++i) ins16(v, pack_idx(s[i], rb * 32 + (i & 3) + 8 * (i >> 2) + 4 * hi, 127u));
                asm volatile("" : "+v"(v[0]), "+v"(v[1]), "+v"(v[2]), "+v"(v[3]), "+v"(v[4]), "+v"(v[5]), "+v"(v[6]), "+v"(v[7]), "+v"(v[8]), "+v"(v[9]), "+v"(v[10]), "+v"(v[11]), "+v"(v[12]), "+v"(v[13]), "+v"(v[14]), "+v"(v[15]));
                asm volatile("" : "+v"(kb));
            }
            float ov[16];
#pragma unroll
            for (int k = 0; k < 16; ++k) ov[k] = xhalf(v[k]);
#pragma unroll
            for (int k = 0; k < 16; ++k) ins16(v, ov[k]);
#pragma unroll
            for (int k = 0; k < 16; ++k) L[m][k] = v[k];
        }
        int i0[16], i1[16];
#pragma unroll
        for (int k = 0; k < 16; ++k) { i0[k] = (int)(__float_as_uint(L[0][k]) & 127u); i1[k] = (int)(__float_as_uint(L[1][k]) & 127u); L[0][k] = __uint_as_float(__float_as_uint(L[0][k]) & ~127u); L[1][k] = __uint_as_float(__float_as_uint(L[1][k]) & ~127u); }
        float b[16];
#pragma unroll
        for (int k = 0; k < 16; ++k) b[k] = -3.0e38f;
#pragma unroll
        for (int i = 0; i < 16; ++i)
#pragma unroll
            for (int j = 0; j < 16; ++j) if ((i + 1) * (j + 1) <= 16) ins16(b, pack_idx(L[0][i] + L[1][j], i * 16 + j, 255u));
        float g[16]; int e[16]; float den = 0.f;
        const float b0 = __uint_as_float(__float_as_uint(b[0]) & ~255u);
#pragma unroll
        for (int k = 0; k < 16; ++k) {
            const unsigned bits = __float_as_uint(b[k]); const int ci = (int)((bits >> 4) & 15u), cj = (int)(bits & 15u);
            int e0 = i0[0], e1 = i1[0];
#pragma unroll
            for (int c = 1; c < 16; ++c) { e0 = (ci == c) ? i0[c] : e0; e1 = (cj == c) ? i1[c] : e1; }
            e[k] = e0 * 128 + e1;
            g[k] = ex2((__uint_as_float(bits & ~255u) - b0) * LOG2E); den += g[k];
        }
        const float inv = 1.0f / den;
        if (hi == 0) {
#pragma unroll
            for (int k = 0; k < 16; k += 4) *(LAS i32x4*)(sel + (r * 128 + h * 16 + k) * 4) = (i32x4){e[k], e[k + 1], e[k + 2], e[k + 3]};
        } else {
#pragma unroll
            for (int k = 0; k < 16; k += 4) *(LAS f32x4*)(sel + 16384 + (r * 128 + h * 16 + k) * 4) = (f32x4){g[k] * inv, g[k + 1] * inv, g[k + 2] * inv, g[k + 3] * inv};
        }
    }
}
DI float gelu_as(float v) {
    const float av = fabsf(v), t = __builtin_amdgcn_rcpf(av * 0.2316418882f + 1.0f);
    float q = t * 0.5307027145f + (-0.7265760135f); q = q * t + 0.7107068705f; q = q * t + (-0.142248368f); q = q * t + 0.127414796f; q = q * t;
    const float e = ex2((v * v) * (-0.72134752044f));
    const float m = v * (q * e);
    return v < 0.f ? m : v - m;
}
template <int CTRL, int RM> DI float dpp_add(float v) { return v + __builtin_bit_cast(float, __builtin_amdgcn_update_dpp(0, __builtin_bit_cast(int, v), CTRL, RM, 0xf, RM == 0xf)); }
DI float wave_total(float v) {
    v = dpp_add<0x111, 0xf>(v); v = dpp_add<0x112, 0xf>(v); v = dpp_add<0x114, 0xf>(v); v = dpp_add<0x118, 0xf>(v);
    v = dpp_add<0x142, 0xa>(v); v = dpp_add<0x143, 0xc>(v);
    return __uint_as_float(__builtin_amdgcn_readlane(__float_as_uint(v), 63));
}
DI void reduce4(float (&d)[4], int lane) {
#pragma unroll
    for (int i = 0; i < 4; ++i) d[i] = wave_total(d[i]);
}
DI void peer_gather_group(const Frame& F, const Args& a, int layer, float* outf, bf16_t* XB, int grp, const LAS unsigned char* sel) {
    typedef int v8i_t __attribute__((ext_vector_type(8)));
    const unsigned char* UB = F.ws + WS_UB;
    int lane = F.lane; asm volatile("" : "+v"(lane));
    const int m16 = lane & 15, g4 = lane >> 4;
    LAS unsigned char* x8 = F.lds + 65536 + F.wave * 2048;
    int sc = 0x7f7f7f7f; asm volatile("" : "+v"(sc));
    for (int ti = 0; ti < 4; ++ti) {
        const int tl = F.wave * 4 + ti, t = grp * 32 + tl;
        const bf16_t* xr = XB + (size_t)t * DM + 32 * lane;
        {
            u32x4 w8[2];
#pragma unroll
            for (int c = 0; c < 4; ++c) { const u32x4 w = *(const u32x4*)(xr + 8 * c);
#if PEER_X_SWAP
                int lo = __builtin_amdgcn_cvt_pk_fp8_f32(bf_hi(w.x), bf_lo(w.x), 0, false); lo = __builtin_amdgcn_cvt_pk_fp8_f32(bf_hi(w.y), bf_lo(w.y), lo, true);
                int hi = __builtin_amdgcn_cvt_pk_fp8_f32(bf_hi(w.z), bf_lo(w.z), 0, false); hi = __builtin_amdgcn_cvt_pk_fp8_f32(bf_hi(w.w), bf_lo(w.w), hi, true);
#else
                int lo = __builtin_amdgcn_cvt_pk_fp8_f32(bf_lo(w.x), bf_hi(w.x), 0, false); lo = __builtin_amdgcn_cvt_pk_fp8_f32(bf_lo(w.y), bf_hi(w.y), lo, true);
                int hi = __builtin_amdgcn_cvt_pk_fp8_f32(bf_lo(w.z), bf_hi(w.z), 0, false); hi = __builtin_amdgcn_cvt_pk_fp8_f32(bf_lo(w.w), bf_hi(w.w), hi, true);
#endif
                w8[c >> 1][(c & 1) * 2] = (unsigned)lo; w8[c >> 1][(c & 1) * 2 + 1] = (unsigned)hi; }
            *(LAS u32x4*)(x8 + 32 * lane) = w8[0]; *(LAS u32x4*)(x8 + 32 * lane + 16) = w8[1];
        }
        f32x2 acc[16];
#pragma unroll
        for (int e = 0; e < 16; ++e) acc[e] = (f32x2){0.f, 0.f};
        for (int half = 0; half < 2; ++half) {
            const int ev = *(const LAS int*)(sel + (tl * 128 + half * 64 + lane) * 4); const float gv = *(const LAS float*)(sel + 16384 + (tl * 128 + half * 64 + lane) * 4);
            for (int bb = 0; bb < 4; ++bb) {
                const int em = __builtin_amdgcn_ds_bpermute((16 * bb + m16) << 2, ev);
                const unsigned char* up = UB + (size_t)em * 2048 + 16 * g4;
                u32x4 ua[16], va[16];
#pragma unroll
                for (int s = 0; s < 16; ++s) ua[s] = *(const u32x4*)(up + 64 * s);
#pragma unroll
                for (int j = 0; j < 16; ++j) { const int e = __builtin_amdgcn_readlane(ev, 16 * bb + j); va[j] = *(const u32x4*)(UB + (size_t)e * 2048 + 1024 + 16 * lane); }
                f32x4 h = (f32x4){0.f, 0.f, 0.f, 0.f};
#pragma unroll
                for (int s = 0; s < 16; ++s) {
                    const u32x4 x0 = *(const LAS u32x4*)(x8 + 128 * s + 16 * g4), x1 = *(const LAS u32x4*)(x8 + 128 * s + 64 + 16 * g4);
                    const v8i_t xb = (v8i_t){(int)x0.x, (int)x0.y, (int)x0.z, (int)x0.w, (int)x1.x, (int)x1.y, (int)x1.z, (int)x1.w};
                    asm volatile("s_nop 1\n\tv_mfma_scale_f32_16x16x128_f8f6f4 %0, %1, %2, %0, %3, %3 op_sel_hi:[0,0,0] cbsz:4" : "+v"(h) : "v"(ua[s]), "v"(xb), "v"(sc));
                }
                asm volatile("s_nop 15" : "+v"(h));
                float hv[4];
#pragma unroll
                for (int i = 0; i < 4; ++i) { const float gq = __int_as_float(__builtin_amdgcn_ds_bpermute((16 * bb + 4 * g4 + i) << 2, __float_as_int(gv)));
                    hv[i] = gq * gelu_as(h[i] * (1.0f / U_SCALE)) * (1.0f / V_SCALE); }
#pragma unroll
                for (int j = 0; j < 16; ++j) {
                    const float wk = __uint_as_float(__builtin_amdgcn_readlane(__float_as_uint(hv[j & 3]), 16 * (j >> 2)));
                    const f32x2 wk2 = (f32x2){wk, wk}; const u32x4 w_ = va[j];
#define FP4_ACC(b) acc[b] += __builtin_amdgcn_cvt_scalef32_pk_f32_fp4(w_[(b) >> 2], 1.0f, (b) & 3) * wk2;
                    FP4_ACC(0) FP4_ACC(1) FP4_ACC(2) FP4_ACC(3) FP4_ACC(4) FP4_ACC(5) FP4_ACC(6) FP4_ACC(7) FP4_ACC(8) FP4_ACC(9) FP4_ACC(10) FP4_ACC(11) FP4_ACC(12) FP4_ACC(13) FP4_ACC(14) FP4_ACC(15)
#undef FP4_ACC
                }
            }
        }
        float z[1][32];
#pragma unroll
        for (int c = 0; c < 4; ++c) { const u32x4 w = *(const u32x4*)(xr + 8 * c);
            z[0][8 * c + 0] = acc[4 * c].x + DN_ALPHA * bf_lo(w.x); z[0][8 * c + 1] = acc[4 * c].y + DN_ALPHA * bf_hi(w.x); z[0][8 * c + 2] = acc[4 * c + 1].x + DN_ALPHA * bf_lo(w.y); z[0][8 * c + 3] = acc[4 * c + 1].y + DN_ALPHA * bf_hi(w.y);
            z[0][8 * c + 4] = acc[4 * c + 2].x + DN_ALPHA * bf_lo(w.z); z[0][8 * c + 5] = acc[4 * c + 2].y + DN_ALPHA * bf_hi(w.z); z[0][8 * c + 6] = acc[4 * c + 3].x + DN_ALPHA * bf_lo(w.w); z[0][8 * c + 7] = acc[4 * c + 3].y + DN_ALPHA * bf_hi(w.w); }
        ln_store<1, 32>(z, a.in[24] + layer * DM, a.in[25] + layer * DM, outf ? outf + (size_t)t * DM : (float*)nullptr, outf ? (bf16_t*)nullptr : XB + (size_t)t * DM, lane, outf ? (unsigned char*)nullptr : F.ws + WS_XB8 + (size_t)t * DM, outf ? (unsigned char*)nullptr : F.ws + WS_XB4 + (size_t)t * (DM / 2));
    }
}
DI void phase_peer(const Frame& F, const Args& a, int layer, const bf16_t* SK, float* outf) {
    LAS unsigned char* sel = F.lds;
    bf16_t* XB = wsb(F, WS_XB);
    const int g0 = F.vcu, g1 = F.vcu + F.G, ng = S / 32;
    if (F.vcu & 1) {
        if (g0 < ng) peer_select_group(F, SK, g0, sel);
        if (g1 < ng) peer_select_group(F, SK, g1, sel + 32768);
        __syncthreads();
        if (g0 < ng) peer_gather_group(F, a, layer, outf, XB, g0, sel);
        if (g1 < ng) peer_gather_group(F, a, layer, outf, XB, g1, sel + 32768);
    } else {
        if (g0 < ng) peer_select_group(F, SK, g0, sel);
        __syncthreads();
        if (g0 < ng) peer_gather_group(F, a, layer, outf, XB, g0, sel);
        if (g1 < ng) peer_select_group(F, SK, g1, sel + 32768);
        __syncthreads();
        if (g1 < ng) peer_gather_group(F, a, layer, outf, XB, g1, sel + 32768);
    }
    for (int g = F.vcu + 2 * F.G; g < ng; g += F.G) { __syncthreads(); peer_select_group(F, SK, g, sel); __syncthreads(); peer_gather_group(F, a, layer, outf, XB, g, sel); }
}

#ifndef GEMM_SP2
#define GEMM_SP2 true
#endif
#ifndef GEMM_ALIGN_EPI
#define GEMM_ALIGN_EPI true
#endif
DI void run_merge_chain(const Frame& F, const unsigned char* O8a, const unsigned char* Wbr, const pg8::Epi<5>& E) {
    pg8::Gemm g{(const bf16_t*)O8a, (const bf16_t*)Wbr, S, DM, 256, 256, 256, 0, (long)S * 512, (long)DM * 512 * 2}; pg8::ChainOrder<4> So; So.init(S, DM, F.G, (int)blockIdx.x);
    pg8::gemm_phase<pg8::Epi<5>, pg8::ChainOrder<4>, GEMM_ALIGN_EPI, GEMM_SP2, true, 121, 124, false>(F.lds, g, So, E);
}
template <int MODE, bool F8 = false, int SC0 = 127, int SC1 = 127, bool F4 = false> DI void run_gemm(const Frame& F, const bf16_t* A, int lda, const bf16_t* Bt, int ldb, int M, int N, int K, long apn, const pg8::Epi<MODE>& E, int rot = 0) {
    pg8::Gemm g{A, Bt, M, N, K, lda, ldb, apn}; pg8::StaticOrder So; So.init(M, N, F.G, (F.G == 256) ? (int)((blockIdx.x + (unsigned)rot) & 255u) : (int)blockIdx.x);
    pg8::gemm_phase<pg8::Epi<MODE>, pg8::StaticOrder, GEMM_ALIGN_EPI, GEMM_SP2, F8, SC0, SC1, F4>(F.lds, g, So, E);
}
#ifndef MK_CHECK
#define MK_CHECK 0
#endif
#ifndef MK_CHECK_WORD
#define MK_CHECK_WORD 0
#endif

#if MK_CHECK
namespace chk {
constexpr int NS = 64;
__device__ const int SAMPLES[NS] = {0, 1, 2, 31, 32, 63, 64, 127, 128, 129, 255, 256, 257, 300, 383, 384, 511, 512, 513, 767, 768, 1000, 1023, 1024, 1025, 1279, 1280, 2047, 2048, 2049, 3071, 3072,
    4095, 4096, 5000, 6143, 6144, 7777, 8191, 8192, 8193, 9999, 10239, 10240, 11111, 12287, 12288, 12289, 13000, 13311, 13312, 14000, 14335, 14336, 15000, 15359, 15360, 15871, 16127, 16128, 16129, 16255, 16256, 16383};
DI float bsum(const Frame& F, float v) {
    v = wave_sum(v);
    __syncthreads();
    if (F.lane == 0) F.MISC[16 + F.wave] = __float_as_uint(v);
    __syncthreads();
    float s = 0.f;
    for (int w = 0; w < 8; ++w) s += __uint_as_float(F.MISC[16 + w]);
    return s;
}
DI float bmax(const Frame& F, float v) {
#pragma unroll
    for (int o = 1; o < 64; o <<= 1) v = fmaxf(v, __shfl_xor(v, o));
    __syncthreads();
    if (F.lane == 0) F.MISC[16 + F.wave] = __float_as_uint(v);
    __syncthreads();
    float s = -INFINITY;
    for (int w = 0; w < 8; ++w) s = fmaxf(s, __uint_as_float(F.MISC[16 + w]));
    return s;
}
DI void verdict(const Frame& F, float err, float nrm, float tol, int code) {
    const float e = bsum(F, err), n = bsum(F, nrm);
    if (F.tid == 0) { const bool bad = !(e <= tol * tol * n + 1e-12f); if (bad) { atomicAdd((unsigned*)(F.ws + WS_CTL) + CW_CHK, 1u); atomicAdd((unsigned*)(F.ws + WS_CTL) + CW_CHK + 64 * (1 + code), 1u); } }
}
DI float sigm(float z) { return 1.0f / (1.0f + expf(-z)); }
DI float rope_inv(int j) { return powf(10000.0f, -(float)j / 32.0f); }
DI float t5_naive(const float* t5, int col, int rel) {
    int n = rel > 0 ? rel : 0; int b;
    if (n < 16) b = n; else { b = 16 + (int)(logf((float)n / 16.0f) / logf(64.0f) * 16.0f); if (b > 31) b = 31; }
    return t5[b * 16 + col];
}
DI void s1(const Frame& F, const Args& a, int layer) {
    const bf16_t* X = wsb(F, WS_XB); const float* W = a.in[3] + (size_t)layer * DM * 4672;
    const bf16_t* H = wsb(F, WS_H); const bf16_t* VT = wsb(F, WS_VT);
    for (int u = F.vcu; u < NS; u += F.G) { const int t = SAMPLES[u]; float err = 0.f, nrm = 0.f;
        for (int c = F.tid; c < 4672; c += 512) { float ref = 0.f; for (int k = 0; k < DM; ++k) ref += bf1(X[(size_t)t * DM + k]) * W[(size_t)k * 4672 + c];
            const int d = win_map(c); const float got = d < HW ? bf1(H[(size_t)t * HW + d]) : bf1(VT[(size_t)(d - HW) * S + t]); err += (ref - got) * (ref - got); nrm += ref * ref; }
        verdict(F, err, nrm, 0.06f, 0); }
}
DI void s2(const Frame& F, const Args& a, int layer) {
    const bf16_t* H = wsb(F, WS_H); const int* pos = (const int*)a.in[1];
    for (int u = F.vcu; u < NS; u += F.G) { const int t = SAMPLES[u]; float err = 0.f, nrm = 0.f;
        float ssq = 0.f; for (int k = 0; k < 512; ++k) { const float v = bf1(H[(size_t)t * HW + H_DCQ + k]); ssq += v * v; }
        const float rq = 1.0f / sqrtf(ssq / 512.0f + 1e-6f);
        float ssk = 0.f; for (int k = 0; k < 256; ++k) { const float v = bf1(H[(size_t)t * HW + H_DCKV + k]); ssk += v * v; }
        const float rk = 1.0f / sqrtf(ssk / 256.0f + 1e-6f);
        for (int c = F.tid; c < 512; c += 512) { const float ref = bf1(H[(size_t)t * HW + H_DCQ + c]) * rq * a.in[14][layer * 512 + c]; const float got = bf1(wsb(F, WS_CQN)[(size_t)t * 512 + c]); err += (ref - got) * (ref - got); nrm += ref * ref; }
        for (int c = F.tid; c < 256; c += 512) { const float ref = bf1(H[(size_t)t * HW + H_DCKV + c]) * rk * a.in[15][layer * 256 + c]; const float got = bf1(wsb(F, WS_CKVN)[(size_t)t * 256 + c]); err += (ref - got) * (ref - got); nrm += ref * ref; }
        for (int c = F.tid; c < 256; c += 512) { const int h = c >> 6, j = c & 63, jj = j & 31; const float x1 = bf1(H[(size_t)t * HW + H_DKR + jj]), x2 = bf1(H[(size_t)t * HW + H_DKR + jj + 32]);
            const float ang = (float)pos[t] * rope_inv(jj); const float ref = j < 32 ? x1 * cosf(ang) - x2 * sinf(ang) : x1 * sinf(ang) + x2 * cosf(ang);
            const float got = bf1(wsb(F, WS_KD)[(size_t)t * 768 + h * 192 + 128 + j]); err += (ref - got) * (ref - got); nrm += ref * ref; }
        verdict(F, err, nrm, 0.02f, 1); }
}
DI void s3(const Frame& F, const Args& a, int layer) {
    const int* pos = (const int*)a.in[1]; const float* Wq = a.in[16] + (size_t)layer * 512 * 768; const float* Wkv = a.in[17] + (size_t)layer * 256 * 1024;
    LAS float* pre = (LAS float*)F.lds;
    for (int u = F.vcu; u < NS; u += F.G) { const int t = SAMPLES[u]; float err = 0.f, nrm = 0.f;
        __syncthreads();
        for (int n = F.tid; n < 768; n += 512) { float r = 0.f; for (int k = 0; k < 512; ++k) r += bf1(wsb(F, WS_CQN)[(size_t)t * 512 + k]) * Wq[(size_t)k * 768 + n]; pre[n] = r; }
        __syncthreads();
        for (int n = F.tid; n < 768; n += 512) { const int h = n / 192, j = n % 192; float ref = pre[n];
            if (j >= 128) { const int jj = (j - 128) & 31; const float x1 = pre[h * 192 + 128 + jj], x2 = pre[h * 192 + 128 + jj + 32]; const float ang = (float)pos[t] * rope_inv(jj);
                ref = (j - 128) < 32 ? x1 * cosf(ang) - x2 * sinf(ang) : x1 * sinf(ang) + x2 * cosf(ang); }
            const float got = bf1(wsb(F, WS_QD)[(size_t)t * 768 + n]); err += (ref - got) * (ref - got); nrm += ref * ref; }
        for (int n = F.tid; n < 1024; n += 512) { float ref = 0.f; for (int k = 0; k < 256; ++k) ref += bf1(wsb(F, WS_CKVN)[(size_t)t * 256 + k]) * Wkv[(size_t)k * 1024 + n];
            const int h = n >> 8, j = n & 255; const float got = j < 128 ? bf1(wsb(F, WS_KD)[(size_t)t * 768 + h * 192 + j]) : bf1(wsb(F, WS_VDT)[(size_t)(h * 128 + j - 128) * S + t]);
            err += (ref - got) * (ref - got); nrm += ref * ref; }
        verdict(F, err, nrm, 0.02f, 2); }
}
DI void s4(const Frame& F, const Args& a, int layer) {
    const int* pos = (const int*)a.in[1]; const float* t5 = a.in[2]; const bf16_t* H = wsb(F, WS_H);
    LAS float* lg = (LAS float*)F.lds;
    LAS float* qv = (LAS float*)(F.lds + 65536);
    LAS float* ga = (LAS float*)(F.lds + 65536 + 1024);
    LAS float* op = (LAS float*)(F.lds + 65536 + 2048);
    LAS float* o1 = (LAS float*)(F.lds + 65536 + 2048 + 2048);
    LAS int* selb = (LAS int*)(F.lds + 65536 + 8192);
    for (int u = F.vcu; u < NS * 20; u += F.G) {
        const int q = SAMPLES[u / 20], mh = u % 20;
        int mix, h; if (mh < 4) { mix = 0; h = mh; } else if (mh < 12) { mix = 1; h = mh - 4; } else if (mh < 16) { mix = 2; h = mh - 12; } else { mix = 3; h = mh - 16; }
        const int DQ = mix == 0 ? 128 : (mix == 3 ? 192 : 64), DVV = mix == 1 ? 64 : 128;
        const int nmaps = mix == 2 ? 2 : 1;
        const float scale = 1.0f / sqrtf((float)DQ);
        const int bcol = mix == 0 ? h : (mix == 1 ? 4 + h : 12 + h);
        float errs = 0.f, nrms = 0.f;
        for (int mp = 0; mp < nmaps; ++mp) {
            const bf16_t* Qp; const bf16_t* Kp; int ldk; const bf16_t* Vp;
            if (mix == 0) { Qp = H + (size_t)q * HW + H_AQ + h * 128; Kp = H + H_AK + h * 128; ldk = HW; Vp = wsb(F, WS_VT) + (size_t)(VT_A + h * 128) * S; }
            else if (mix == 1) { Qp = H + (size_t)q * HW + H_BQ + h * 64; Kp = H + H_BK + (h >> 2) * 64; ldk = HW; Vp = wsb(F, WS_VT) + (size_t)(VT_B + (h >> 2) * 64) * S; }
            else if (mix == 2) { Qp = H + (size_t)q * HW + H_CQ + h * 128 + mp * 64; Kp = H + H_CK + h * 128 + mp * 64; ldk = HW; Vp = wsb(F, WS_VT) + (size_t)(VT_C + h * 128) * S; }
            else { Qp = wsb(F, WS_QD) + (size_t)q * 768 + h * 192; Kp = wsb(F, WS_KD) + h * 192; ldk = 768; Vp = wsb(F, WS_VDT) + (size_t)(h * 128) * S; }
            __syncthreads();
            for (int d = F.tid; d < DQ; d += 512) qv[d] = bf1(Qp[d]);
            if (F.tid < 64) { ga[F.tid] = 0.f; selb[F.tid] = 0; }
            __syncthreads();
            const int own = q >> 8;
            if (mix == 0) {
                for (int idx = F.tid; idx < own * 128; idx += 512) { const int n = idx >> 7, d = idx & 127; float sm = 0.f; for (int i = 0; i < 256; ++i) sm += bf1(Kp[(size_t)(n * 256 + i) * ldk + d]); atomicAdd((float*)&ga[n], qv[d] * (sm / 256.0f)); }
                __syncthreads();
                if (F.tid == 0) { for (int rnk = 0; rnk < 3 && rnk < own; ++rnk) { int best = -1; float bv = -INFINITY; for (int n = 0; n < own; ++n) if (!selb[n] && ga[n] > bv) { bv = ga[n]; best = n; } if (best >= 0) selb[best] = 1; } }
                __syncthreads();
            }
            float mx = -INFINITY;
            for (int k = F.tid; k <= q; k += 512) {
                bool valid = true;
                if (mix == 0) { const int blk = k >> 8; valid = (blk == own) ? true : (selb[blk] != 0); }
                if (mix == 1) valid = (q - k) < 128;
                float l = -INFINITY;
                if (valid) { float dot = 0.f; for (int d = 0; d < DQ; ++d) dot += qv[d] * bf1(Kp[(size_t)k * ldk + d]); l = dot * scale; if (mix != 3) l += t5_naive(t5, bcol, pos[q] - pos[k]); }
                lg[k] = l; mx = fmaxf(mx, l);
            }
            mx = bmax(F, mx);
            const float sink = (mix == 1) ? a.in[8][layer * 8 + h] : -INFINITY;
            if (mix == 1) mx = fmaxf(mx, sink);
            float sm = 0.f;
            for (int k = F.tid; k <= q; k += 512) { const float p = expf(lg[k] - mx); lg[k] = p; sm += p; }
            sm = bsum(F, sm);
            if (mix == 1) sm += expf(sink - mx);
            __syncthreads();
            { const int dv = F.tid % 128, part = F.tid / 128; float acc = 0.f;
              if (dv < DVV) for (int k = part; k <= q; k += 4) acc += lg[k] * bf1(Vp[(size_t)dv * S + k]);
              op[part * 128 + dv] = acc; }
            __syncthreads();
            float val = 0.f;
            if (F.tid < DVV) val = (op[F.tid] + op[128 + F.tid] + op[256 + F.tid] + op[384 + F.tid]) / sm;
            if (mix == 2 && mp == 0) { if (F.tid < 128) o1[F.tid] = val; __syncthreads(); continue; }
            if (mix == 2) {
                float d1 = 0.f, d2 = 0.f; for (int i = 0; i < 64; ++i) { d1 += a.in[9][layer * 64 + i] * a.in[10][layer * 64 + i]; d2 += a.in[11][layer * 64 + i] * a.in[12][layer * 64 + i]; }
                const float li = 0.8f - 0.6f * expf(-0.3f * (float)layer), lam = expf(d1) - expf(d2) + li;
                float x = (F.tid < 128) ? (o1[F.tid] - lam * val) : 0.f;
                const float ms = bsum(F, x * x) / 128.0f;
                val = x / sqrtf(ms + 1e-6f) * ((F.tid < 128) ? a.in[13][layer * 128 + F.tid] : 0.f) * (1.0f - li);
            }
            if (F.tid < DVV) { const int ocol = (mix == 1) ? h * 64 + F.tid : h * 128 + F.tid; const float got = bf1(wsb(F, WS_O)[(size_t)mix * S * 512 + (size_t)q * 512 + ocol]); errs = (val - got) * (val - got); nrms = val * val; }
        }
        verdict(F, errs, nrms, 0.03f, 3 + mix);
    }
}
DI void s5(const Frame& F, const Args& a, int layer) {
    const bf16_t* X = wsb(F, WS_XB);
    for (int u = F.vcu; u < NS; u += F.G) { const int t = SAMPLES[u]; float err = 0.f, nrm = 0.f, err2 = 0.f, nrm2 = 0.f;
        for (int c = F.tid; c < 8192; c += 512) { const int n = c >> 11, cc = c & 2047; const float* W = a.in[4] + ((size_t)layer * 4 + n) * DM * DM; float z = a.in[5][(size_t)layer * 8192 + c];
            for (int k = 0; k < DM; ++k) z += bf1(X[(size_t)t * DM + k]) * W[(size_t)k * DM + cc];
            const float ref = sigm(z), got = __builtin_amdgcn_cvt_pk_f32_fp8((int)(F.ws + WS_GT)[(size_t)t * 8192 + c], false)[0]; err += (ref - got) * (ref - got); nrm += ref * ref; }
        for (int c = F.tid; c < DM; c += 512) { float ref = 0.f;
            for (int n = 0; n < 4; ++n) { const float* W = a.in[6] + ((size_t)layer * 4 + n) * 512 * DM; float br = 0.f; for (int j = 0; j < 512; ++j) br += bf1(wsb(F, WS_O)[(size_t)n * S * 512 + (size_t)t * 512 + j]) * W[(size_t)j * DM + c];
                ref += __builtin_amdgcn_cvt_pk_f32_fp8((int)(F.ws + WS_GT)[(size_t)t * 8192 + n * DM + c], false)[0] * br; }
            const float got = bf1(wsb(F, WS_H)[(size_t)t * DM + c]); err2 += (ref - got) * (ref - got); nrm2 += ref * ref; }
        verdict(F, err, nrm, 0.12f, 7); verdict(F, err2, nrm2, 0.12f, 8); }
}
DI void s6(const Frame& F, const Args& a, int layer) {
    const bf16_t* X = wsb(F, WS_XB); const float* W = a.in[7] + (size_t)layer * DM * DM; const bf16_t* Y = wsb(F, WS_GT);
    for (int u = F.vcu; u < NS; u += F.G) { const int t = SAMPLES[u]; float err = 0.f, nrm = 0.f;
        for (int c = F.tid; c < DM; c += 512) { float ref = 0.f; for (int j = 0; j < DM; ++j) ref += bf1(wsb(F, WS_H)[(size_t)t * DM + j]) * W[(size_t)j * DM + c];
            const float full = DN_ALPHA * bf1(X[(size_t)t * DM + c]) + ref, got = bf1(Y[(size_t)t * DM + c]); err += (full - got) * (full - got); nrm += full * full; }
        verdict(F, err, nrm, 0.006f, 9); }
}
DI void poison(const Frame& F) {
    const unsigned bad = __hip_atomic_load((unsigned*)(F.ws + WS_CTL) + CW_CHK + 64 * MK_CHECK_WORD, __ATOMIC_RELAXED, __HIP_MEMORY_SCOPE_AGENT);
    const float sc = 1.0f + (float)bad / 256.0f;
    for (size_t i = (size_t)F.vcu * 512 + F.tid; i < (size_t)S * DM / 4; i += (size_t)F.G * 512) { f32x4 v = ((f32x4*)F.out)[i]; v = v * sc; ((f32x4*)F.out)[i] = v; }
}
}
#endif

#ifndef MK_CHECK
#define MK_CHECK 0
#endif
#ifndef MK_CHECK_WORD
#define MK_CHECK_WORD 0
#endif
#ifndef MK_CHECK_LAYER
#define MK_CHECK_LAYER 0
#endif
#ifndef MERGE_CHAIN
#define MERGE_CHAIN 1
#endif
#ifndef MK_X_BAR2
#define MK_X_BAR2 0
#endif
#ifndef MK_PROBE_REL
#define MK_PROBE_REL (-2)
#endif
#ifndef MK_PROBE_REPS
#define MK_PROBE_REPS 1
#endif
#ifndef MK_PER_PHASE
#define MK_PER_PHASE 0
#endif
constexpr int NPL = 11, NPHASES = 1 + NL * NPL;
DI void run_layer(const Frame& F, const Args& args, const XcdBarrier& bar, const int layer, const int lo, const int hi) {
#define PH(k) (lo <= (k) && (k) < hi)
#define SEAM(k) do { if (PH(k) && PH((k) + 1)) { xcd_barrier(bar); if (MK_X_BAR2) xcd_barrier(bar); } } while (0)
        const int pb = 1 + layer * NPL;
        unsigned char* wl = F.ws + WS_W + (size_t)layer * WL_STRIDE;
        if (PH(pb + 0)) {
            { pg8::Epi<0> E{}; E.O = wsb(F, WS_H); E.ldc = HW; E.grp = 128; run_gemm<0, true, 121, 127>(F, (const bf16_t*)(F.ws + WS_XB8), DM / 2, (const bf16_t*)(wl + W_IN), DM / 2, S, HW, DM / 2, 0, E); }
            { pg8::Epi<0> E{}; E.O = wsb(F, WS_VT); E.ldc = S; E.grp = 128; run_gemm<0, true, 127, 121>(F, (const bf16_t*)(wl + W_IN + (size_t)HW * DM), DM / 2, (const bf16_t*)(F.ws + WS_XB8), DM / 2, VT_ROWS, S, DM / 2, 0, E, 128); }
            { pg8::Epi<1> E{}; E.O = wsb(F, WS_GT); E.ldc = 8192; E.bias = args.in[5] + (size_t)layer * 8192; run_gemm<1, false, 121, 126, true>(F, (const bf16_t*)(F.ws + WS_XB4), DM / 4, (const bf16_t*)(wl + W_G), DM / 4, S, 8192, DM / 4, 0, E); }
        }
        SEAM(pb + 0);
        if (PH(pb + 1)) phase_prep(F, args, layer);
        SEAM(pb + 1);
        if (PH(pb + 2)) {
            { pg8::Epi<0> E{}; E.O = wsb(F, WS_QD); E.ldc = 768; E.grp = 128; run_gemm<0>(F, wsb(F, WS_CQN), 512, (const bf16_t*)(wl + W_UQ), 512, S, 768, 512, 0, E); }
            { pg8::Epi<0> E{}; E.O = wsb(F, WS_KD); E.ldc = 768; E.grp = 192; run_gemm<0>(F, wsb(F, WS_CKVN), 256, (const bf16_t*)(wl + W_UKV), 256, S, 512, 256, 0, E, 64); }
            { pg8::Epi<0> E{}; E.O = wsb(F, WS_VDT); E.ldc = S; E.grp = 128; run_gemm<0>(F, (const bf16_t*)(wl + W_UKV) + (size_t)512 * 256, 256, wsb(F, WS_CKVN), 256, 512, S, 256, 0, E, 192); }
        }
        SEAM(pb + 2);
        if (PH(pb + 3)) { phase_ropeq(F, args); phase_moba_select(F, args, layer); }
        SEAM(pb + 3);
        if (PH(pb + 4)) {
            phase_attention<0>(F, args, layer);
            if (layer + 1 < NL) convert_weights(F, args, layer + 1, layer + 2);
            __syncthreads();
            phase_attention<1>(F, args, layer);
        }
        SEAM(pb + 4);
        if (PH(pb + 5)) phase_mixer_combine(F, args, layer);
        SEAM(pb + 5);
        if (PH(pb + 6)) {
            if (MERGE_CHAIN) { pg8::Epi<5> E{}; E.O = wsb(F, WS_H); E.ldc = DM; E.G = (const bf16_t*)(F.ws + WS_GT); E.ldg = 8192; E.O8 = F.ws + WS_XB8;
                run_merge_chain(F, F.ws + WS_O8, wl + W_BR, E); }
            else
            for (int n = 0; n < 4; ++n) { pg8::Epi<2> E{}; E.O = wsb(F, WS_H); E.ldc = DM; E.G = (const bf16_t*)(F.ws + WS_GT + n * DM); E.ldg = 8192; E.first = (n == 0); E.O8 = (n == 3) ? F.ws + WS_XB8 : (unsigned char*)nullptr;
                run_gemm<2, true, 121, 124>(F, (const bf16_t*)(F.ws + WS_O8 + (size_t)n * S * 512), 256, (const bf16_t*)(wl + W_BR) + (size_t)n * DM * 512, 256, S, DM, 256, 0, E); }
        }
        SEAM(pb + 6);
        if (PH(pb + 7)) { pg8::Epi<3> E{}; E.O = F.ws + WS_GT; E.ldc = DM; E.X = wsb(F, WS_XB); E.alpha = DN_ALPHA;
            run_gemm<3, true, 121, 124>(F, (const bf16_t*)(F.ws + WS_XB8), DM / 2, (const bf16_t*)(wl + W_O), DM / 2, S, DM, DM / 2, 0, E); }
        SEAM(pb + 7);
        if (PH(pb + 8)) phase_ln1(F, args, layer);
        SEAM(pb + 8);
        if (PH(pb + 9)) { pg8::Epi<0> E{}; E.O = wsb(F, WS_H); E.ldc = DM; E.grp = 128; run_gemm<0>(F, wsb(F, WS_XB), DM, (const bf16_t*)(wl + W_PQ), DM, S, DM, DM, 0, E); }
        SEAM(pb + 9);
        if (PH(pb + 10)) phase_peer(F, args, layer, (const bf16_t*)(wl + W_SK), (layer == NL - 1) ? F.out : (float*)nullptr);
        SEAM(pb + 10);
#undef PH
#undef SEAM
}
__global__ void __launch_bounds__(512, 2) fwd_kernel(Args args) {
    extern __shared__ __attribute__((aligned(16))) unsigned char lds_raw[];
    Frame F;
    F.lds = (LAS unsigned char*)lds_raw; F.MISC = (volatile LAS unsigned*)(F.lds + MISC_OFF);
    F.tid = threadIdx.x; F.lane = F.tid & 63; F.wave = __builtin_amdgcn_readfirstlane(F.tid >> 6);
    F.G = gridDim.x; { const int bx = blockIdx.x; F.vcu = (F.G % 8 == 0) ? (bx % 8) * (F.G / 8) + bx / 8 : bx; }
    F.ws = args.ws; F.out = args.out;
    if (F.tid < 64) F.MISC[F.tid] = 0u;
    __syncthreads();
    const int lo = args.ph_lo, hi = args.ph_hi;
    unsigned* barw = (unsigned*)(F.ws + WS_CTL) + CW_BAR + (lo > 0 ? XCD_BAR_WORDS : 0);
    XcdBarrier bar; bar.bar = barw; bar.x = 0; bar.st = F.MISC;
    if (hi - lo > 1) bar = xcd_barrier_post(barw, F.MISC);
#define PH(k) (lo <= (k) && (k) < hi)
#define SEAM(k) do { if (PH(k) && PH((k) + 1)) { xcd_barrier(bar); if (MK_X_BAR2) xcd_barrier(bar); } } while (0)
    if (PH(0)) phase_prologue(F, args);
    SEAM(0);
    run_layer(F, args, bar, 0, lo, hi);
    run_layer(F, args, bar, 1, lo, hi);
#undef PH
#undef SEAM
}


#if MK_CHECK
__global__ void __launch_bounds__(512, 1) chk_kernel(Args args, int stage, int layer) {
    extern __shared__ __attribute__((aligned(16))) unsigned char lds_raw[];
    Frame F;
    F.lds = (LAS unsigned char*)lds_raw; F.MISC = (volatile LAS unsigned*)(F.lds + MISC_OFF);
    F.tid = threadIdx.x; F.lane = F.tid & 63; F.wave = __builtin_amdgcn_readfirstlane(F.tid >> 6);
    F.G = gridDim.x; { const int bx = blockIdx.x; F.vcu = (F.G % 8 == 0) ? (bx % 8) * (F.G / 8) + bx / 8 : bx; }
    F.ws = args.ws; F.out = args.out;
    if (stage == 1) { chk::s1(F, args, layer); chk::s2(F, args, layer); chk::s3(F, args, layer); }
    if (stage == 4) chk::s4(F, args, layer);
    if (stage == 5) chk::s5(F, args, layer);
    if (stage == 6) chk::s6(F, args, layer);
    if (stage == 99) chk::poison(F);
}
#endif
extern "C" void kernel_launch(void* const* d_in, const int* in_sizes, int n_in, void* d_out, int out_size, void* d_ws, size_t ws_size, hipStream_t stream) {
    static int grid = 0;
    if (grid == 0) {
        if (n_in != 26 || out_size != S * DM || ws_size < WS_END) { fprintf(stderr, "kernel_launch: unexpected problem (n_in %d, out %d, ws %zu); nothing launched\n", n_in, out_size, ws_size); grid = -1; return; }
        int dev = 0, cus = 0, per_cu = 0;
        if (hipGetDevice(&dev) != hipSuccess || hipDeviceGetAttribute(&cus, hipDeviceAttributeMultiprocessorCount, dev) != hipSuccess) { grid = -1; return; }
        if (hipFuncSetAttribute((const void*)fwd_kernel, hipFuncAttributeMaxDynamicSharedMemorySize, LDS_BYTES) != hipSuccess) { fprintf(stderr, "kernel_launch: hipFuncSetAttribute failed\n"); grid = -1; return; }
        if (hipOccupancyMaxActiveBlocksPerMultiprocessor(&per_cu, (const void*)fwd_kernel, 512, LDS_BYTES) != hipSuccess || per_cu < 1) { fprintf(stderr, "kernel_launch: occupancy query says %d blocks per CU\n", per_cu); }
        (void)hipGetLastError();
        grid = cus;
    }
    if (grid < 0) return;
    (void)hipMemsetAsync((char*)d_ws + WS_CTL, 0, CTL_ZERO_BYTES, stream);
    Args a{};
    for (int i = 0; i < 26; ++i) a.in[i] = (const float*)d_in[i];
    a.out = (float*)d_out; a.ws = (unsigned char*)d_ws;
#if MK_CHECK
    {
        static bool once = false; if (!once) { once = true; (void)hipFuncSetAttribute((const void*)chk_kernel, hipFuncAttributeMaxDynamicSharedMemorySize, LDS_BYTES); }
        const int pb = 1 + MK_CHECK_LAYER * NPL; const int cuts[6] = {0, pb + 4, pb + 6, pb + 7, pb + 8, NPHASES}; const int stg[5] = {1, 4, 5, 6, 0};
        for (int i = 0; i < 5; ++i) { (void)hipMemsetAsync((unsigned*)((char*)d_ws + WS_CTL) + CW_BAR, 0, 2 * XCD_BAR_WORDS * 4, stream); a.ph_lo = cuts[i]; a.ph_hi = cuts[i + 1]; hipLaunchKernelGGL(fwd_kernel, dim3(grid), dim3(512), LDS_BYTES, stream, a);
            if (stg[i]) hipLaunchKernelGGL(chk_kernel, dim3(grid), dim3(512), LDS_BYTES, stream, a, stg[i], MK_CHECK_LAYER); }
        hipLaunchKernelGGL(chk_kernel, dim3(grid), dim3(512), LDS_BYTES, stream, a, 99, 0);
    }
#elif MK_PROBE_REL > -2
    {
        unsigned* ctl = (unsigned*)((char*)d_ws + WS_CTL);
        auto launch = [&](int lo, int hi) { if (hi <= lo) return; (void)hipMemsetAsync(ctl + CW_BAR, 0, 2 * XCD_BAR_WORDS * 4, stream); a.ph_lo = lo; a.ph_hi = hi; hipLaunchKernelGGL(fwd_kernel, dim3(grid), dim3(512), LDS_BYTES, stream, a); };
        int cur = 0;
        const int nl = (MK_PROBE_REL == -1) ? 1 : NL;
        for (int layer = 0; layer < nl; ++layer) {
            const int p = (MK_PROBE_REL == -1) ? 0 : 1 + layer * NPL + MK_PROBE_REL;
            launch(cur, p);
            for (int r = 0; r <= MK_PROBE_REPS; ++r) {
                (void)hipMemsetAsync(ctl + CW_Q, 0, 4096 * 4, stream);
#ifdef MK_PROBE_MIXER
                if (r > 0) { (void)hipMemsetAsync(ctl + CW_Q, 0x04, 4096 * 4, stream); (void)hipMemsetAsync(ctl + CW_Q + layer * 256 + 64 * MK_PROBE_MIXER, 0, 4, stream); }
#endif
                if (MK_PROBE_REL == 10 && r == 0) (void)hipMemcpyAsync((char*)d_ws + WS_GT, (char*)d_ws + WS_XB, (size_t)S * DM * 2, hipMemcpyDeviceToDevice, stream);
                if (MK_PROBE_REL == 10 && r > 0) (void)hipMemcpyAsync((char*)d_ws + WS_XB, (char*)d_ws + WS_GT, (size_t)S * DM * 2, hipMemcpyDeviceToDevice, stream);
                if (MK_PROBE_REL == 3 && r == 0) (void)hipMemcpyAsync((char*)d_ws + WS_PART, (char*)d_ws + WS_QD, (size_t)S * 768 * 2, hipMemcpyDeviceToDevice, stream);
                if (MK_PROBE_REL == 3 && r > 0) { (void)hipMemcpyAsync((char*)d_ws + WS_QD, (char*)d_ws + WS_PART, (size_t)S * 768 * 2, hipMemcpyDeviceToDevice, stream); (void)hipMemsetAsync(ctl + CW_MOBA, 0, 2048 * 4, stream); }
                launch(p, p + 1);
            }
            cur = p + 1;
        }
        launch(cur, NPHASES);
    }
#elif MK_PER_PHASE
    for (int p = 0; p < NPHASES; ++p) { a.ph_lo = p; a.ph_hi = p + 1; hipLaunchKernelGGL(fwd_kernel, dim3(grid), dim3(512), LDS_BYTES, stream, a); }
#else
    a.ph_lo = 0; a.ph_hi = NPHASES;
    hipLaunchKernelGGL(fwd_kernel, dim3(grid), dim3(512), LDS_BYTES, stream, a);
#endif
}
```

```cpp
#include <hip/hip_runtime.h>
#include <cstdio>
#include <cstdint>
#include <cmath>

#define DI __device__ __forceinline__
#define LAS __attribute__((address_space(3)))
#define GAS __attribute__((address_space(1)))
typedef unsigned short bf16_t;
typedef short bf16x8 __attribute__((ext_vector_type(8)));
typedef float f32x4 __attribute__((ext_vector_type(4)));
typedef float f32x2 __attribute__((ext_vector_type(2)));
typedef float f32x16 __attribute__((ext_vector_type(16)));
typedef unsigned u32x4 __attribute__((ext_vector_type(4)));
typedef unsigned u32x2 __attribute__((ext_vector_type(2)));
typedef int i32x4 __attribute__((ext_vector_type(4)));
typedef __bf16 bf16x2_t __attribute__((ext_vector_type(2)));

DI unsigned cvtpk(float lo, float hi) { f32x2 v = {lo, hi}; bf16x2_t b = __builtin_convertvector(v, bf16x2_t); return __builtin_bit_cast(unsigned, b); }
DI float bf_lo(unsigned u) { return __uint_as_float(u << 16); }
DI float bf_hi(unsigned u) { return __uint_as_float(u & 0xffff0000u); }
DI float bf1(bf16_t u) { return __uint_as_float((unsigned)u << 16); }
DI float ex2(float x) { return __builtin_amdgcn_exp2f(x); }
DI float wave_sum(float v) {
#pragma unroll
    for (int o = 1; o < 64; o <<= 1) v += __shfl_xor(v, o);
    return v;
}
DI float xhalf(float v) { return __shfl_xor(v, 32); }

namespace pg8 {
#define PG8_LAS __attribute__((address_space(3)))
#ifndef PG8_WGM
#define PG8_WGM 8
#endif
constexpr int BM = 256, BK = 64, HALF = 128, HTB = HALF * BK * 2  , STAGE_BYTES = 8 * HTB, NXCD = 8, WGM = PG8_WGM;

__host__ __device__ __forceinline__ int lds_byte(int r, int c) { const int st = (r >> 4) * 2 + (c >> 5), rr = r & 15, cc = c & 31, ob = rr * 64 + cc * 2; return st * 1024 + (ob ^ (((ob >> 9) & 1) << 5)); }
__host__ __device__ __forceinline__ void stage_rc(int b, int& R, int& C) { const int st = b / 1024, sb = b % 1024, swz = sb ^ (((sb >> 9) & 1) << 5); R = (st >> 1) * 16 + swz / 64; C = (st & 1) * 32 + (swz % 64) / 2; }
__host__ __device__ __forceinline__ int perm32(int rho) { const int n = rho >> 4, i = rho & 15; return 8 * (i >> 2) + 4 * n + (i & 3); }

struct Unit { int pm, pn, br; };
struct Gemm { const bf16_t* A; const bf16_t* Bt; int M, N, K, lda, ldb; long apn; long abr, bbr; };

struct StaticOrder {
    int nM, nN, nwg, G, c;
    __host__ __device__ void init(int M, int N, int G_, int c_) { nM = M / BM; nN = N / BM; nwg = nM * nN; G = G_; c = c_; }
    __host__ __device__ bool next(int i, Unit& u) const {
        const long L = (long)i * G + c; if (L >= nwg) return false;
        int wgid = (int)L; { const int q = nwg / NXCD, r = nwg % NXCD, xcd = wgid % NXCD, off = wgid / NXCD; wgid = (xcd < r ? xcd * (q + 1) : r * (q + 1) + (xcd - r) * q) + off; }
        const int nig = WGM * nN, gid = wgid / nig, fm = gid * WGM, gsz = (nM - fm) < WGM ? (nM - fm) : WGM;
        u.pm = fm + ((wgid % nig) % gsz); u.pn = (wgid % nig) / gsz; u.br = 0; return true;
    }
    __device__ __forceinline__ void a_ready(const Unit&) const {}
    __device__ __forceinline__ void done(const Unit&) const {}
};
template <int NBR> struct ChainOrder {
    StaticOrder so;
    __host__ __device__ void init(int M, int N, int G_, int c_) { so.init(M, N, G_, c_); }
    __host__ __device__ bool next(int i, Unit& u) const { const bool ok = so.next(i / NBR, u); u.br = i % NBR; return ok; }
    __device__ __forceinline__ void a_ready(const Unit&) const {}
    __device__ __forceinline__ void done(const Unit&) const {}
};

template <int MODE> struct Epi {
    static constexpr bool PERM = true, AFTER_DRAIN = false, CHAIN = (MODE == 5); static constexpr int NBR = 4;
    void* O; int ldc; int grp; const float* bias; const bf16_t* G; int ldg; const void* X; float alpha; int first; unsigned char* O8;
    static __device__ __forceinline__ f32x2 gclamp(f32x2 g) { return (f32x2){fmaxf(g.x, 0.001953125f), fmaxf(g.y, 0.001953125f)}; }
    __device__ __forceinline__ void rescale(f32x4 (&acc)[2][2][4][2], const Unit& u, int wr, int wc, int fr, int fq) const {
        const int row0 = u.pm * BM + wr * 64 + fr, colb = u.pn * BM + wc * 32 + 8 * fq;
        const float z = (u.br + 1 < NBR) ? 1.0f : 0.0f;
        const size_t gcol = (size_t)(u.br + 1 < NBR ? u.br : 0) * ldc;
#pragma unroll
        for (int ai = 0; ai < 2; ++ai)
#pragma unroll
            for (int m = 0; m < 4; ++m) {
                const size_t r = (size_t)(row0 + ai * HALF + m * 16);
#pragma unroll
                for (int bj = 0; bj < 2; ++bj) {
                    const int c = colb + bj * HALF;
                    const unsigned char* gp = (const unsigned char*)G + r * ldg + gcol + c;
                    asm volatile("" : "+v"(gp));
                    const u32x2 ga = *(const u32x2*)gp, gb = *(const u32x2*)(gp + ldc);
                    const f32x2 a0 = gclamp(__builtin_amdgcn_cvt_pk_f32_fp8((int)ga.x, false)), a1 = gclamp(__builtin_amdgcn_cvt_pk_f32_fp8((int)ga.x, true)), a2 = gclamp(__builtin_amdgcn_cvt_pk_f32_fp8((int)ga.y, false)), a3 = gclamp(__builtin_amdgcn_cvt_pk_f32_fp8((int)ga.y, true));
                    const f32x2 b0 = gclamp(__builtin_amdgcn_cvt_pk_f32_fp8((int)gb.x, false)), b1 = gclamp(__builtin_amdgcn_cvt_pk_f32_fp8((int)gb.x, true)), b2 = gclamp(__builtin_amdgcn_cvt_pk_f32_fp8((int)gb.y, false)), b3 = gclamp(__builtin_amdgcn_cvt_pk_f32_fp8((int)gb.y, true));
                    f32x4& v0 = acc[ai][bj][m][0]; f32x4& v1 = acc[ai][bj][m][1];
                    v0[0] *= z * a0.x * __builtin_amdgcn_rcpf(b0.x); v0[1] *= z * a0.y * __builtin_amdgcn_rcpf(b0.y); v0[2] *= z * a1.x * __builtin_amdgcn_rcpf(b1.x); v0[3] *= z * a1.y * __builtin_amdgcn_rcpf(b1.y);
                    v1[0] *= z * a2.x * __builtin_amdgcn_rcpf(b2.x); v1[1] *= z * a2.y * __builtin_amdgcn_rcpf(b2.y); v1[2] *= z * a3.x * __builtin_amdgcn_rcpf(b3.x); v1[3] *= z * a3.y * __builtin_amdgcn_rcpf(b3.y);
                    asm volatile("" : "+v"(v0), "+v"(v1));
                }
            }
    }
    __device__ __forceinline__ void operator()(const f32x4 (&acc)[2][2][4][2], const Unit& u, int wr, int wc, int fr, int fq) const {
        const int row0 = u.pm * BM + wr * 64 + fr, colb = u.pn * BM + wc * 32 + 8 * fq;
#pragma unroll
        for (int ai = 0; ai < 2; ++ai)
#pragma unroll
            for (int m = 0; m < 4; ++m) {
                const size_t r = (size_t)(row0 + ai * HALF + m * 16);
#pragma unroll
                for (int bj = 0; bj < 2; ++bj) {
                    const int c = colb + bj * HALF;
                    f32x4 v0 = acc[ai][bj][m][0], v1 = acc[ai][bj][m][1];
                    if constexpr (MODE == 0) {
                        const int dc = (c >> 7) * grp + (c & 127);
                        u32x4 w; w.x = cvtpk(v0[0], v0[1]); w.y = cvtpk(v0[2], v0[3]); w.z = cvtpk(v1[0], v1[1]); w.w = cvtpk(v1[2], v1[3]);
                        *(u32x4*)((bf16_t*)O + r * ldc + dc) = w;
                    } else if constexpr (MODE == 1) {
                        const f32x4 b0 = *(const f32x4*)(bias + c), b1 = *(const f32x4*)(bias + c + 4);
                        v0 = v0 + b0; v1 = v1 + b1;
#pragma unroll
                        for (int e = 0; e < 4; ++e) { v0[e] = __builtin_amdgcn_rcpf(1.0f + ex2(-1.4426950408889634f * v0[e])); v1[e] = __builtin_amdgcn_rcpf(1.0f + ex2(-1.4426950408889634f * v1[e])); }
                        int lo = __builtin_amdgcn_cvt_pk_fp8_f32(v0[0], v0[1], 0, false); lo = __builtin_amdgcn_cvt_pk_fp8_f32(v0[2], v0[3], lo, true);
                        int hi = __builtin_amdgcn_cvt_pk_fp8_f32(v1[0], v1[1], 0, false); hi = __builtin_amdgcn_cvt_pk_fp8_f32(v1[2], v1[3], hi, true);
                        *(u32x2*)((unsigned char*)O + r * ldc + c) = (u32x2){(unsigned)lo, (unsigned)hi};
                    } else if constexpr (MODE == 2) {
                        const u32x2 gq = *(const u32x2*)((const unsigned char*)G + r * ldg + c);
                        const f32x2 g0 = __builtin_amdgcn_cvt_pk_f32_fp8((int)gq.x, false), g1 = __builtin_amdgcn_cvt_pk_f32_fp8((int)gq.x, true), g2 = __builtin_amdgcn_cvt_pk_f32_fp8((int)gq.y, false), g3 = __builtin_amdgcn_cvt_pk_f32_fp8((int)gq.y, true);
                        bf16_t* op = (bf16_t*)O + r * ldc + c;
                        u32x4 old = (u32x4){0u, 0u, 0u, 0u};
                        if (!first) old = *(const u32x4*)op;
                        const float r0 = bf_lo(old.x) + g0.x * v0[0], r1 = bf_hi(old.x) + g0.y * v0[1], r2 = bf_lo(old.y) + g1.x * v0[2], r3 = bf_hi(old.y) + g1.y * v0[3];
                        const float r4 = bf_lo(old.z) + g2.x * v1[0], r5 = bf_hi(old.z) + g2.y * v1[1], r6 = bf_lo(old.w) + g3.x * v1[2], r7 = bf_hi(old.w) + g3.y * v1[3];
                        u32x4 w; w.x = cvtpk(r0, r1); w.y = cvtpk(r2, r3); w.z = cvtpk(r4, r5); w.w = cvtpk(r6, r7);
                        *(u32x4*)op = w;
                        if (O8) {
                            int lo = __builtin_amdgcn_cvt_pk_fp8_f32(r0 * 8.0f, r1 * 8.0f, 0, false); lo = __builtin_amdgcn_cvt_pk_fp8_f32(r2 * 8.0f, r3 * 8.0f, lo, true);
                            int hi = __builtin_amdgcn_cvt_pk_fp8_f32(r4 * 8.0f, r5 * 8.0f, 0, false); hi = __builtin_amdgcn_cvt_pk_fp8_f32(r6 * 8.0f, r7 * 8.0f, hi, true);
                            *(u32x2*)(O8 + r * ldc + c) = (u32x2){(unsigned)lo, (unsigned)hi}; }
                    } else if constexpr (MODE == 5) {
                        const u32x2 gq = *(const u32x2*)((const unsigned char*)G + r * ldg + 3 * ldc + c);
                        const f32x2 g0 = gclamp(__builtin_amdgcn_cvt_pk_f32_fp8((int)gq.x, false)), g1 = gclamp(__builtin_amdgcn_cvt_pk_f32_fp8((int)gq.x, true)), g2 = gclamp(__builtin_amdgcn_cvt_pk_f32_fp8((int)gq.y, false)), g3 = gclamp(__builtin_amdgcn_cvt_pk_f32_fp8((int)gq.y, true));
                        const float r0 = g0.x * v0[0], r1 = g0.y * v0[1], r2 = g1.x * v0[2], r3 = g1.y * v0[3], r4 = g2.x * v1[0], r5 = g2.y * v1[1], r6 = g3.x * v1[2], r7 = g3.y * v1[3];
#if defined(MK_CHECK) && MK_CHECK
                        { u32x4 w; w.x = cvtpk(r0, r1); w.y = cvtpk(r2, r3); w.z = cvtpk(r4, r5); w.w = cvtpk(r6, r7); *(u32x4*)((bf16_t*)O + r * ldc + c) = w; }
#endif
                        int lo = __builtin_amdgcn_cvt_pk_fp8_f32(r0 * 8.0f, r1 * 8.0f, 0, false); lo = __builtin_amdgcn_cvt_pk_fp8_f32(r2 * 8.0f, r3 * 8.0f, lo, true);
                        int hi = __builtin_amdgcn_cvt_pk_fp8_f32(r4 * 8.0f, r5 * 8.0f, 0, false); hi = __builtin_amdgcn_cvt_pk_fp8_f32(r6 * 8.0f, r7 * 8.0f, hi, true);
                        *(u32x2*)(O8 + r * ldc + c) = (u32x2){(unsigned)lo, (unsigned)hi};
                    } else if constexpr (MODE == 3) {
                        const u32x4 xx = *(const u32x4*)((const bf16_t*)X + r * ldc + c);
                        u32x4 w;
                        w.x = cvtpk(bf_lo(xx.x) * alpha + v0[0], bf_hi(xx.x) * alpha + v0[1]); w.y = cvtpk(bf_lo(xx.y) * alpha + v0[2], bf_hi(xx.y) * alpha + v0[3]);
                        w.z = cvtpk(bf_lo(xx.z) * alpha + v1[0], bf_hi(xx.z) * alpha + v1[1]); w.w = cvtpk(bf_lo(xx.w) * alpha + v1[2], bf_hi(xx.w) * alpha + v1[3]);
                        *(u32x4*)((bf16_t*)O + r * ldc + c) = w;
                    } else {
                        *(f32x4*)((float*)O + r * ldc + c) = v0; *(f32x4*)((float*)O + r * ldc + c + 4) = v1;
                    }
                }
            }
    }
};

template <class Epi, class Sched, bool ALIGN_EPI = false, bool SP2 = false, bool F8 = false, int SC0 = 127, int SC1 = 127, bool F4 = false>
__device__ __forceinline__ void gemm_phase(PG8_LAS unsigned char* lds, const Gemm g, const Sched& S, const Epi& E) {
    int tid_ = threadIdx.x; asm volatile("" : "+v"(tid_));
    const int tid = tid_, wid = __builtin_amdgcn_readfirstlane(tid >> 6), lane = tid & 63, wr = wid >> 2, wc = wid & 3, fr = lane & 15, fq = lane >> 4;
    const int K = g.K, nt = K / BK;
    unsigned voffA[2], voffB[2];
#pragma unroll
    for (int i = 0; i < 2; ++i) { int R, C; stage_rc(tid * 16 + i * 8192, R, C); const int Rb = Epi::PERM ? ((R & ~31) + perm32(R & 31)) : R;
        voffA[i] = (unsigned)(R * g.lda + C) * 2u; voffB[i] = (unsigned)(Rb * g.ldb + C) * 2u; }
    const size_t kstep = (size_t)(BK * 2);
    const size_t hstepA = (size_t)HALF * g.lda * 2, hstepB = (size_t)HALF * g.ldb * 2;
    const size_t tstepA = 2 * hstepA, tstepB = 2 * hstepB;
    const unsigned ldsw = (unsigned)wid * 1024u;
    const int aoff = lds_byte(wr * 64 + fr, fq * 8), boff = lds_byte(wc * 32 + fr, fq * 8);

#define PG8_SA(b, h) (((b) * 2 + (h)) * HTB)
#define PG8_SB(b, h) ((4 + (b) * 2 + (h)) * HTB)
#define PG8_STAGE(bufoff, gbase, voff) do { _Pragma("unroll") for (int _i = 0; _i < 2; ++_i) \
        __builtin_amdgcn_global_load_lds((const unsigned*)((const char*)(gbase) + (voff)[_i]), (PG8_LAS unsigned*)(lds + (bufoff) + ldsw + _i * 8192), 16, 0, 0); } while (0)
#define PG8_LDA(dst, b, h) do { _Pragma("unroll") for (int m = 0; m < 4; ++m) { if constexpr (F8) { const v4i_t lo_ = *(const PG8_LAS v4i_t*)(lds + PG8_SA(b, h) + aoff + m * 2048), hi_ = *(const PG8_LAS v4i_t*)(lds + PG8_SA(b, h) + aoff + m * 2048 + 1024); dst##8[m] = __builtin_shufflevector(lo_, hi_, 0, 1, 2, 3, 4, 5, 6, 7); } else { _Pragma("unroll") for (int k = 0; k < 2; ++k) dst[m][k] = *(const PG8_LAS bf16x8*)(lds + PG8_SA(b, h) + aoff + m * 2048 + k * 1024); } } } while (0)
#define PG8_LDB(dst, b, h) do { _Pragma("unroll") for (int n = 0; n < 2; ++n) { if constexpr (F8) { const v4i_t lo_ = *(const PG8_LAS v4i_t*)(lds + PG8_SB(b, h) + boff + n * 2048), hi_ = *(const PG8_LAS v4i_t*)(lds + PG8_SB(b, h) + boff + n * 2048 + 1024); dst##8[n] = __builtin_shufflevector(lo_, hi_, 0, 1, 2, 3, 4, 5, 6, 7); } else { _Pragma("unroll") for (int k = 0; k < 2; ++k) dst[n][k] = *(const PG8_LAS bf16x8*)(lds + PG8_SB(b, h) + boff + n * 2048 + k * 1024); } } } while (0)
#define PG8_MMA(ai, bj, At, Bt) do { __builtin_amdgcn_s_setprio(1); \
        if constexpr (F8) {   \
            asm volatile("s_nop 1\n\t" \
            "v_mfma_scale_f32_16x16x128_f8f6f4 %0, %12, %8, %0, %14, %15 op_sel_hi:[0,0,0]\n\t"  \
            "v_mfma_scale_f32_16x16x128_f8f6f4 %1, %13, %8, %1, %14, %15 op_sel_hi:[0,0,0]\n\t"  \
            "v_mfma_scale_f32_16x16x128_f8f6f4 %2, %12, %9, %2, %14, %15 op_sel_hi:[0,0,0]\n\t"  \
            "v_mfma_scale_f32_16x16x128_f8f6f4 %3, %13, %9, %3, %14, %15 op_sel_hi:[0,0,0]\n\t"  \
            "v_mfma_scale_f32_16x16x128_f8f6f4 %4, %12, %10, %4, %14, %15 op_sel_hi:[0,0,0]\n\t"  \
            "v_mfma_scale_f32_16x16x128_f8f6f4 %5, %13, %10, %5, %14, %15 op_sel_hi:[0,0,0]\n\t"  \
            "v_mfma_scale_f32_16x16x128_f8f6f4 %6, %12, %11, %6, %14, %15 op_sel_hi:[0,0,0]\n\t"  \
            "v_mfma_scale_f32_16x16x128_f8f6f4 %7, %13, %11, %7, %14, %15 op_sel_hi:[0,0,0]\n\t"  \
                : "+v"(acc[ai][bj][0][0]), "+v"(acc[ai][bj][0][1]), "+v"(acc[ai][bj][1][0]), "+v"(acc[ai][bj][1][1]), "+v"(acc[ai][bj][2][0]), "+v"(acc[ai][bj][2][1]), "+v"(acc[ai][bj][3][0]), "+v"(acc[ai][bj][3][1]) \
                : "v"(At##8[0]), "v"(At##8[1]), "v"(At##8[2]), "v"(At##8[3]), "v"(Bt##8[0]), "v"(Bt##8[1]), "v"(sc0), "v"(sc1)); \
        } else if constexpr (F4) { \
            asm volatile("s_nop 1\n\t" \
            "v_mfma_scale_f32_16x16x128_f8f6f4 %0, %16, %8, %0, %20, %21 op_sel_hi:[0,0,0] cbsz:4 blgp:4\n\t"  \
            "v_mfma_scale_f32_16x16x128_f8f6f4 %0, %17, %9, %0, %20, %21 op_sel_hi:[0,0,0] cbsz:4 blgp:4\n\t"  \
            "v_mfma_scale_f32_16x16x128_f8f6f4 %1, %18, %8, %1, %20, %21 op_sel_hi:[0,0,0] cbsz:4 blgp:4\n\t"  \
            "v_mfma_scale_f32_16x16x128_f8f6f4 %1, %19, %9, %1, %20, %21 op_sel_hi:[0,0,0] cbsz:4 blgp:4\n\t"  \
            "v_mfma_scale_f32_16x16x128_f8f6f4 %2, %16, %10, %2, %20, %21 op_sel_hi:[0,0,0] cbsz:4 blgp:4\n\t"  \
            "v_mfma_scale_f32_16x16x128_f8f6f4 %2, %17, %11, %2, %20, %21 op_sel_hi:[0,0,0] cbsz:4 blgp:4\n\t"  \
            "v_mfma_scale_f32_16x16x128_f8f6f4 %3, %18, %10, %3, %20, %21 op_sel_hi:[0,0,0] cbsz:4 blgp:4\n\t"  \
            "v_mfma_scale_f32_16x16x128_f8f6f4 %3, %19, %11, %3, %20, %21 op_sel_hi:[0,0,0] cbsz:4 blgp:4\n\t"  \
            "v_mfma_scale_f32_16x16x128_f8f6f4 %4, %16, %12, %4, %20, %21 op_sel_hi:[0,0,0] cbsz:4 blgp:4\n\t"  \
            "v_mfma_scale_f32_16x16x128_f8f6f4 %4, %17, %13, %4, %20, %21 op_sel_hi:[0,0,0] cbsz:4 blgp:4\n\t"  \
            "v_mfma_scale_f32_16x16x128_f8f6f4 %5, %18, %12, %5, %20, %21 op_sel_hi:[0,0,0] cbsz:4 blgp:4\n\t"  \
            "v_mfma_scale_f32_16x16x128_f8f6f4 %5, %19, %13, %5, %20, %21 op_sel_hi:[0,0,0] cbsz:4 blgp:4\n\t"  \
            "v_mfma_scale_f32_16x16x128_f8f6f4 %6, %16, %14, %6, %20, %21 op_sel_hi:[0,0,0] cbsz:4 blgp:4\n\t"  \
            "v_mfma_scale_f32_16x16x128_f8f6f4 %6, %17, %15, %6, %20, %21 op_sel_hi:[0,0,0] cbsz:4 blgp:4\n\t"  \
            "v_mfma_scale_f32_16x16x128_f8f6f4 %7, %18, %14, %7, %20, %21 op_sel_hi:[0,0,0] cbsz:4 blgp:4\n\t"  \
            "v_mfma_scale_f32_16x16x128_f8f6f4 %7, %19, %15, %7, %20, %21 op_sel_hi:[0,0,0] cbsz:4 blgp:4\n\t"  \
                : "+v"(acc[ai][bj][0][0]), "+v"(acc[ai][bj][0][1]), "+v"(acc[ai][bj][1][0]), "+v"(acc[ai][bj][1][1]), "+v"(acc[ai][bj][2][0]), "+v"(acc[ai][bj][2][1]), "+v"(acc[ai][bj][3][0]), "+v"(acc[ai][bj][3][1]) \
                : "v"(At[0][0]), "v"(At[0][1]), "v"(At[1][0]), "v"(At[1][1]), "v"(At[2][0]), "v"(At[2][1]), "v"(At[3][0]), "v"(At[3][1]), "v"(Bt[0][0]), "v"(Bt[0][1]), "v"(Bt[1][0]), "v"(Bt[1][1]), "v"(sc0), "v"(sc1)); \
        } else { _Pragma("unroll") for (int m = 0; m < 4; ++m) _Pragma("unroll") for (int n = 0; n < 2; ++n) _Pragma("unroll") for (int k = 0; k < 2; ++k) \
            acc[ai][bj][m][n] = __builtin_amdgcn_mfma_f32_16x16x32_bf16(Bt[n][k], At[m][k], acc[ai][bj][m][n], 0, 0, 0); } \
        __builtin_amdgcn_s_setprio(0); } while (0)
#define PG8_WAIT_V(n) asm volatile("s_waitcnt vmcnt(" #n ")" ::: "memory")
#define PG8_WAIT_L(n) asm volatile("s_waitcnt lgkmcnt(" #n ")" ::: "memory")
#define PG8_BAR __builtin_amdgcn_s_barrier()
#define PG8_SCHED __builtin_amdgcn_sched_barrier(0)
    Unit cur, nxt; int ui = 0;
    if (!S.next(0, cur)) return;
    f32x4 acc[2][2][4][2];
#pragma unroll
    for (int a = 0; a < 2; ++a)
#pragma unroll
        for (int b = 0; b < 2; ++b)
#pragma unroll
            for (int m = 0; m < 4; ++m)
#pragma unroll
                for (int n = 0; n < 2; ++n) acc[a][b][m][n] = (f32x4){0.f, 0.f, 0.f, 0.f};
    bf16x8 At[4][2], B0[2][2], B1[2][2];
    typedef int v8i_t __attribute__((ext_vector_type(8))); typedef int v4i_t __attribute__((ext_vector_type(4)));
    v8i_t At8[4], B08[2], B18[2];
    int sc0 = SC0 * 0x01010101, sc1 = SC1 * 0x01010101; asm volatile("" : "+v"(sc0), "+v"(sc1));
    const char* cA = (const char*)g.A + (size_t)cur.pm * tstepA + (size_t)cur.pn * g.apn + (size_t)cur.br * g.abr; const char* cB = (const char*)g.Bt + (size_t)cur.pn * tstepB + (size_t)cur.br * g.bbr;
    S.a_ready(cur);
    if constexpr (SP2) {
        PG8_STAGE(PG8_SB(0, 0), cB, voffB); PG8_STAGE(PG8_SB(0, 1), cB + hstepB, voffB); PG8_STAGE(PG8_SA(0, 0), cA, voffA); PG8_STAGE(PG8_SA(0, 1), cA + hstepA, voffA);
        if (wr == 1) PG8_BAR;
        PG8_WAIT_V(2); PG8_BAR;
        PG8_STAGE(PG8_SB(1, 0), cB + kstep, voffB); PG8_STAGE(PG8_SA(1, 0), cA + kstep, voffA); PG8_STAGE(PG8_SB(1, 1), cB + hstepB + kstep, voffB);
        PG8_WAIT_V(6); PG8_BAR;
    } else {
        PG8_STAGE(PG8_SB(0, 0), cB, voffB); PG8_STAGE(PG8_SA(0, 0), cA, voffA); PG8_STAGE(PG8_SB(0, 1), cB + hstepB, voffB); PG8_STAGE(PG8_SA(0, 1), cA + hstepA, voffA);
        if (wr == 1) PG8_BAR;
        PG8_WAIT_V(4); PG8_BAR;
        PG8_STAGE(PG8_SB(1, 0), cB + kstep, voffB); PG8_STAGE(PG8_SA(1, 0), cA + kstep, voffA); PG8_STAGE(PG8_SB(1, 1), cB + hstepB + kstep, voffB);
        PG8_WAIT_V(6); PG8_BAR;
    }
    for (;;) {
        const bool has_next = S.next(ui + 1, nxt);
        const char* nA = has_next ? (const char*)g.A + (size_t)nxt.pm * tstepA + (size_t)nxt.pn * g.apn + (size_t)nxt.br * g.abr : cA; const char* nB = has_next ? (const char*)g.Bt + (size_t)nxt.pn * tstepB + (size_t)nxt.br * g.bbr : cB;
        for (int t = 0; t < nt; t += 2) {
            const bool last = (t == nt - 2);
            const char* a1 = cA + (size_t)(t + 1) * kstep;
            const char* a2 = last ? nA : cA + (size_t)(t + 2) * kstep; const char* b2 = last ? nB : cB + (size_t)(t + 2) * kstep;
            const char* a3 = a2 + kstep; const char* b3 = b2 + kstep;
            if (last && has_next) S.a_ready(nxt);
            if constexpr (SP2) {
            PG8_LDB(B0, 0, 0); PG8_LDB(B1, 0, 1); PG8_SCHED; PG8_LDA(At, 0, 0); PG8_STAGE(PG8_SA(1, 1), a1 + hstepA, voffA);
            PG8_WAIT_V(8); PG8_WAIT_L(0); PG8_BAR; PG8_MMA(0, 0, At, B0); PG8_MMA(0, 1, At, B1); PG8_BAR; PG8_SCHED;
            PG8_LDA(At, 0, 1); PG8_STAGE(PG8_SB(0, 0), b2, voffB); PG8_STAGE(PG8_SB(0, 1), b2 + hstepB, voffB); PG8_STAGE(PG8_SA(0, 0), a2, voffA);
            PG8_WAIT_V(8); PG8_WAIT_L(0); PG8_BAR; PG8_MMA(1, 0, At, B0); PG8_MMA(1, 1, At, B1); PG8_BAR; PG8_SCHED;
            PG8_LDB(B0, 1, 0); PG8_LDB(B1, 1, 1); PG8_SCHED; PG8_LDA(At, 1, 0); PG8_STAGE(PG8_SA(0, 1), a2 + hstepA, voffA);
            PG8_WAIT_V(8); PG8_WAIT_L(0); PG8_BAR; PG8_MMA(0, 0, At, B0); PG8_MMA(0, 1, At, B1); PG8_BAR; PG8_SCHED;
            PG8_LDA(At, 1, 1); PG8_STAGE(PG8_SB(1, 0), b3, voffB); PG8_STAGE(PG8_SB(1, 1), b3 + hstepB, voffB); PG8_STAGE(PG8_SA(1, 0), a3, voffA);
            PG8_WAIT_V(8); PG8_WAIT_L(0); PG8_BAR; PG8_MMA(1, 0, At, B0); PG8_MMA(1, 1, At, B1); PG8_BAR; PG8_SCHED;
            } else {
            PG8_LDB(B0, 0, 0); PG8_SCHED; PG8_LDA(At, 0, 0); PG8_STAGE(PG8_SA(1, 1), a1 + hstepA, voffA);
            PG8_WAIT_L(8); PG8_BAR; PG8_WAIT_L(0); PG8_MMA(0, 0, At, B0); PG8_BAR; PG8_SCHED;
            PG8_LDB(B1, 0, 1); PG8_STAGE(PG8_SB(0, 0), b2, voffB);
            PG8_BAR; PG8_WAIT_L(0); PG8_MMA(0, 1, At, B1); PG8_BAR;
            PG8_LDA(At, 0, 1); PG8_STAGE(PG8_SA(0, 0), a2, voffA);
            PG8_BAR; PG8_WAIT_L(0); PG8_MMA(1, 0, At, B0); PG8_BAR; PG8_SCHED;
            PG8_STAGE(PG8_SB(0, 1), b2 + hstepB, voffB);
            PG8_WAIT_V(6); PG8_BAR; PG8_MMA(1, 1, At, B1); PG8_BAR;
            PG8_LDB(B0, 1, 0); PG8_SCHED; PG8_LDA(At, 1, 0); PG8_STAGE(PG8_SA(0, 1), a2 + hstepA, voffA);
            PG8_WAIT_L(8); PG8_BAR; PG8_WAIT_L(0); PG8_MMA(0, 0, At, B0); PG8_BAR; PG8_SCHED;
            PG8_LDB(B1, 1, 1); PG8_STAGE(PG8_SB(1, 0), b3, voffB);
            PG8_BAR; PG8_WAIT_L(0); PG8_MMA(0, 1, At, B1); PG8_BAR;
            PG8_LDA(At, 1, 1); PG8_STAGE(PG8_SA(1, 0), a3, voffA);
            PG8_BAR; PG8_WAIT_L(0); PG8_MMA(1, 0, At, B0); PG8_BAR; PG8_SCHED;
            PG8_STAGE(PG8_SB(1, 1), b3 + hstepB, voffB);
            PG8_WAIT_V(6); PG8_BAR; PG8_MMA(1, 1, At, B1); PG8_BAR;
            }
        }
        if constexpr (F8 || F4) {
#pragma unroll
            for (int a_ = 0; a_ < 2; ++a_) asm volatile("s_nop 15\n\ts_nop 7" : "+v"(acc[a_][0][0][0]), "+v"(acc[a_][0][0][1]), "+v"(acc[a_][0][1][0]), "+v"(acc[a_][0][1][1]), "+v"(acc[a_][0][2][0]), "+v"(acc[a_][0][2][1]), "+v"(acc[a_][0][3][0]), "+v"(acc[a_][0][3][1]),
                "+v"(acc[a_][1][0][0]), "+v"(acc[a_][1][0][1]), "+v"(acc[a_][1][1][0]), "+v"(acc[a_][1][1][1]), "+v"(acc[a_][1][2][0]), "+v"(acc[a_][1][2][1]), "+v"(acc[a_][1][3][0]), "+v"(acc[a_][1][3][1]));
        }
        if constexpr (ALIGN_EPI) { if (wr == 0) PG8_BAR; }
        bool chain_keep = false;
        if constexpr (Epi::CHAIN) { if (cur.br + 1 == Epi::NBR) E(acc, cur, wr, wc, fr, fq); E.rescale(acc, cur, wr, wc, fr, fq); chain_keep = true; }
        if constexpr (!Epi::AFTER_DRAIN && !Epi::CHAIN) { E(acc, cur, wr, wc, fr, fq); S.done(cur); }
        if (!has_next) break;
        if (!chain_keep) {
#pragma unroll
        for (int a = 0; a < 2; ++a)
#pragma unroll
            for (int b = 0; b < 2; ++b)
#pragma unroll
                for (int m = 0; m < 4; ++m)
#pragma unroll
                    for (int n = 0; n < 2; ++n) acc[a][b][m][n] = (f32x4){0.f, 0.f, 0.f, 0.f};
        }
        cur = nxt; cA = nA; cB = nB; ++ui;
        if constexpr (ALIGN_EPI) { if (wr == 1) PG8_BAR; }
    }
    PG8_WAIT_V(0);
    if constexpr (!ALIGN_EPI) { if (wr == 0) PG8_BAR; }
    PG8_BAR;
    if constexpr (Epi::AFTER_DRAIN) { E.fused(acc, cur, wr, wc, fr, fq, lds, wid, lane); S.done(cur); }
#undef PG8_SA
#undef PG8_SB
#undef PG8_STAGE
#undef PG8_LDA
#undef PG8_LDB
#undef PG8_MMA
#undef PG8_WAIT_V
#undef PG8_WAIT_L
#undef PG8_BAR
#undef PG8_SCHED
}
}

constexpr int S = 16384, DM = 2048, NL = 2, NWAVES = 8;
constexpr int HW = 3584;
constexpr int H_AQ = 0, H_AK = 512, H_BQ = 1024, H_BK = 1536, H_CQ = 1664, H_CK = 2176, H_DCQ = 2688, H_DCKV = 3200, H_DKR = 3456;
constexpr int VT_A = 0, VT_B = 512, VT_C = 640, VT_ROWS = 1280;
constexpr int WIN_ROWS = HW + VT_ROWS;
constexpr float LOG2E = 1.4426950408889634f;
constexpr float DN_ALPHA = 1.4142135623730951f;
constexpr size_t MiB = 1u << 20;
constexpr size_t WS_CTL = 0, CTL_ZERO_BYTES = 1 * MiB;
constexpr size_t WS_W = 1 * MiB, WL_STRIDE = 78 * MiB;
constexpr size_t W_IN = 0, W_G = 19 * MiB, W_BR = 51 * MiB, W_O = 59 * MiB, W_UQ = 67 * MiB, W_UKV = 68 * MiB, W_PQ = 69 * MiB, W_SK = 77 * MiB;
constexpr size_t WS_UB = 157 * MiB, WS_VB = 221 * MiB;
constexpr size_t WS_MLIST = 189 * MiB;
constexpr int MCAP_F = 16384, MCAP = MCAP_F + 4096;
constexpr size_t WS_PART = 926 * MiB;
constexpr size_t WS_CS = 245 * MiB;
constexpr size_t WS_XB8 = 253 * MiB;
constexpr size_t WS_XB = 285 * MiB;
constexpr size_t WS_H = 349 * MiB;
constexpr size_t WS_VT = 461 * MiB;
constexpr size_t WS_GT = 501 * MiB;
constexpr size_t WS_O8 = 629 * MiB;
constexpr size_t WS_XB4 = 661 * MiB;
constexpr size_t WS_O = 757 * MiB;
constexpr size_t WS_QD = 821 * MiB, WS_KD = 845 * MiB, WS_VDT = 869 * MiB, WS_CQN = 885 * MiB, WS_CKVN = 901 * MiB;
constexpr size_t WS_SELE = 909 * MiB, WS_SELG = 917 * MiB, WS_KMEAN = 925 * MiB, WS_TPMAX = 925 * MiB + 512 * 1024, WS_OC2 = 994 * MiB, WS_END = 1010 * MiB;
constexpr int CW_BAR = 4096, CW_Q = 16384, CW_CHK = 20480, CW_MOBA = 24576;
constexpr int RING_BYTES = 131072;
constexpr int MISC_OFF = RING_BYTES;
constexpr int TR_OFF = 0;
constexpr int LDS_BYTES = 147456;

constexpr float U_SCALE = 90.0f, V_SCALE = 4.0f;
#define XB_TMO      128
#define XB_XCNT(j)  (256  + 64 * (j))
#define XB_XSUB(j)  (1280 + 64 * (j))
#define XB_XGEN(j)  (2304 + 64 * (j))
#define XB_TOP      3328
#define XB_TOPGEN   3392
#define XCD_BAR_WORDS 3456
#define XB_SPIN_CAP (1u << 18)

__device__ __forceinline__ unsigned xb_ld(unsigned* p)              { return __hip_atomic_load(p, __ATOMIC_RELAXED, __HIP_MEMORY_SCOPE_AGENT); }
__device__ __forceinline__ unsigned xb_add(unsigned* p, unsigned v) { return __hip_atomic_fetch_add(p, v, __ATOMIC_RELAXED, __HIP_MEMORY_SCOPE_AGENT); }
__device__ __forceinline__ unsigned xb_xcc_id() { return (unsigned)__builtin_amdgcn_s_getreg((3 << 11) | 20) & 0xFu; }
#define XB_SPIN(cond, bar) do { unsigned _sp = 0; while (cond) { __builtin_amdgcn_s_sleep(1); \
    if ((++_sp & 255u) == 0u) { if (xb_ld(&(bar)[XB_TMO])) break; if (_sp > XB_SPIN_CAP) { atomicAdd(&(bar)[XB_TMO], 1u); break; } } } } while (0)

struct XcdBarrier {
    unsigned* bar; unsigned x;
    volatile LAS unsigned* st;
};

__device__ __forceinline__ XcdBarrier xcd_barrier_post(unsigned* bar, volatile LAS unsigned* st) {
    XcdBarrier b; b.bar = bar; b.x = xb_xcc_id(); b.st = st;
    if (threadIdx.x == 0) (void)xb_add(&bar[XB_XCNT(b.x)], 1u);
    return b;
}
__device__ __forceinline__ void xcd_barrier_complete(unsigned* bar, unsigned x, unsigned& nloc, unsigned& nx) {
    const unsigned G = gridDim.x * gridDim.y * gridDim.z;
    unsigned sum, cnt, mine, sp = 0u;
    for (;;) {
        sum = 0u; cnt = 0u; mine = 0u;
#pragma unroll
        for (unsigned j = 0; j < 16; ++j) { const unsigned c = xb_ld(&bar[XB_XCNT(j)]); sum += c; cnt += (c > 0u) ? 1u : 0u; mine = (j == x) ? c : mine; }
        if (sum == G) break;
        __builtin_amdgcn_s_sleep(1);
        if ((++sp & 255u) == 0u) { if (xb_ld(&bar[XB_TMO])) break; if (sp > XB_SPIN_CAP) { atomicAdd(&bar[XB_TMO], 1u); break; } }
    }
    nloc = mine > 0u ? mine : 1u; nx = cnt > 0u ? cnt : 1u;
}

__device__ __forceinline__ void xcd_barrier(const XcdBarrier& b) {
    asm volatile("s_waitcnt vmcnt(0)" ::: "memory");
    __syncthreads();
    if (threadIdx.x == 0) {
        unsigned* bar = b.bar;
        __builtin_amdgcn_s_waitcnt(0);
        unsigned nloc = b.st[0], nx = b.st[1];
        if (nloc == 0u) { xcd_barrier_complete(bar, b.x, nloc, nx); b.st[0] = nloc; b.st[1] = nx; }
        const unsigned old = xb_add(&bar[XB_XSUB(b.x)], 1u);
        const unsigned gen = old / nloc;
        if (old + 1u == (gen + 1u) * nloc) {
            __builtin_amdgcn_fence(__ATOMIC_RELEASE, "agent");
            asm volatile("s_waitcnt vmcnt(0)" ::: "memory");
            const unsigned og = xb_add(&bar[XB_TOP], 1u);
            const unsigned tg = og / nx;
            if (og + 1u == (tg + 1u) * nx) xb_add(&bar[XB_TOPGEN], 1u);
            else XB_SPIN(xb_ld(&bar[XB_TOPGEN]) == tg, bar);
            __builtin_amdgcn_fence(__ATOMIC_ACQUIRE, "agent");
            xb_add(&bar[XB_XGEN(b.x)], 1u);
            asm volatile("s_waitcnt vmcnt(0)" ::: "memory");
        } else {
            XB_SPIN(xb_ld(&bar[XB_XGEN(b.x)]) == gen, bar);
            __builtin_amdgcn_fence(__ATOMIC_ACQUIRE, "agent");
            asm volatile("s_waitcnt vmcnt(0)" ::: "memory");
        }
    }
    __syncthreads();
}

struct Args { const float* in[26]; float* out; unsigned char* ws; int ph_lo, ph_hi; };
struct Frame {
    LAS unsigned char* lds; volatile LAS unsigned* MISC;
    int tid, lane, wave, vcu, G;
    unsigned char* ws; float* out;
};
DI bf16_t* wsb(const Frame& F, size_t off) { return (bf16_t*)(F.ws + off); }

DI void transpose_item(const float* W, int ldw, bf16_t* WT, int ldt, int k0, int n0, int drow0, LAS float* scr, int lane) {
#pragma unroll 8
    for (int i = 0; i < 32; ++i) { const int kk = 2 * i + (lane >> 5); scr[kk * 33 + (lane & 31)] = W[(size_t)(k0 + kk) * ldw + n0 + (lane & 31)]; }
    asm volatile("s_waitcnt lgkmcnt(0)" ::: "memory");
    const int c = lane & 7;
#pragma unroll
    for (int j = 0; j < 4; ++j) { const int n = (lane >> 3) + 8 * j; const LAS float* s = scr + (8 * c) * 33 + n;
        u32x4 o; o.x = cvtpk(s[0 * 33], s[1 * 33]); o.y = cvtpk(s[2 * 33], s[3 * 33]); o.z = cvtpk(s[4 * 33], s[5 * 33]); o.w = cvtpk(s[6 * 33], s[7 * 33]);
        *(u32x4*)(WT + (size_t)(drow0 + n) * ldt + k0 + 8 * c) = o; }
    asm volatile("s_waitcnt lgkmcnt(0)" ::: "memory");
}
DI void transpose_item8(const float* W, int ldw, unsigned char* WT, int ldt, int k0, int n0, int drow0, LAS float* scr, int lane, float scale) {
#pragma unroll 8
    for (int i = 0; i < 32; ++i) { const int kk = 2 * i + (lane >> 5); scr[kk * 33 + (lane & 31)] = W[(size_t)(k0 + kk) * ldw + n0 + (lane & 31)]; }
    asm volatile("s_waitcnt lgkmcnt(0)" ::: "memory");
    const int c = lane & 7;
#pragma unroll
    for (int j = 0; j < 4; ++j) { const int n = (lane >> 3) + 8 * j; const LAS float* s = scr + (8 * c) * 33 + n;
        int lo = __builtin_amdgcn_cvt_pk_fp8_f32(s[0 * 33] * scale, s[1 * 33] * scale, 0, false); lo = __builtin_amdgcn_cvt_pk_fp8_f32(s[2 * 33] * scale, s[3 * 33] * scale, lo, true);
        int hi = __builtin_amdgcn_cvt_pk_fp8_f32(s[4 * 33] * scale, s[5 * 33] * scale, 0, false); hi = __builtin_amdgcn_cvt_pk_fp8_f32(s[6 * 33] * scale, s[7 * 33] * scale, hi, true);
        *(u32x2*)(WT + (size_t)(drow0 + n) * ldt + k0 + 8 * c) = (u32x2){(unsigned)lo, (unsigned)hi}; }
    asm volatile("s_waitcnt lgkmcnt(0)" ::: "memory");
}
DI void transpose_item4(const float* W, int ldw, unsigned char* WT, int ldt, int k0, int n0, int drow0, LAS float* scr, int lane, float scale) {
#pragma unroll 8
    for (int i = 0; i < 32; ++i) { const int kk = 2 * i + (lane >> 5); scr[kk * 33 + (lane & 31)] = W[(size_t)(k0 + kk) * ldw + n0 + (lane & 31)]; }
    asm volatile("s_waitcnt lgkmcnt(0)" ::: "memory");
    const int c = lane & 7;
#pragma unroll
    for (int j = 0; j < 4; ++j) { const int n = (lane >> 3) + 8 * j; const LAS float* s = scr + (8 * c) * 33 + n;
        unsigned d = 0u;
        d = __builtin_amdgcn_cvt_scalef32_pk_fp4_f32(d, s[0 * 33] * scale, s[1 * 33] * scale, 1.0f, 0); d = __builtin_amdgcn_cvt_scalef32_pk_fp4_f32(d, s[2 * 33] * scale, s[3 * 33] * scale, 1.0f, 1);
        d = __builtin_amdgcn_cvt_scalef32_pk_fp4_f32(d, s[4 * 33] * scale, s[5 * 33] * scale, 1.0f, 2); d = __builtin_amdgcn_cvt_scalef32_pk_fp4_f32(d, s[6 * 33] * scale, s[7 * 33] * scale, 1.0f, 3);
        *(unsigned*)(WT + (size_t)(drow0 + n) * ldt + (k0 >> 1) + 4 * c) = d; }
    asm volatile("s_waitcnt lgkmcnt(0)" ::: "memory");
}
DI int win_map(int c) {
    if (c < 1024) return c;
    if (c < 1536) return HW + VT_A + (c - 1024);
    if (c < 2176) return H_BQ + (c - 1536);
    if (c < 2304) return HW + VT_B + (c - 2176);
    if (c < 3328) return H_CQ + (c - 2304);
    if (c < 3840) return HW + VT_C + (c - 3328);
    return H_DCQ + (c - 3840);
}
template <int MAP, bool F8 = false, bool F4 = false> DI void transpose_matrix(const Frame& F, const float* W, int K, int N, bf16_t* WT, int roff) {
    LAS float* scr = (LAS float*)(F.lds + TR_OFF + F.wave * 8704);
    const int gw = F.vcu * NWAVES + F.wave, NGW = F.G * NWAVES, nblk = N / 32, items = (K / 64) * nblk;
    int lane = F.lane; asm volatile("" : "+v"(lane));
    for (int it = gw; it < items; it += NGW) {
        const int kb = it / nblk, nb = it % nblk, n0 = 32 * nb;
        int drow = roff + n0;
        if (MAP == 1) drow = win_map(n0);
        if (MAP == 2) { const int h = n0 >> 8, j = n0 & 255; drow = (j < 128) ? h * 128 + j : 512 + h * 128 + (j - 128); }
        if (F4) transpose_item4(W, N, (unsigned char*)WT, K / 2, 64 * kb, n0, drow, scr, lane, 64.0f); else if (F8) transpose_item8(W, N, (unsigned char*)WT, K, 64 * kb, n0, drow, scr, lane, 64.0f); else transpose_item(W, N, WT, K, 64 * kb, n0, drow, scr, lane);
    }
}
DI void convert_bf16(const Frame& F, const float* src, bf16_t* dst, size_t n) {
    const size_t nth = (size_t)F.G * 512, t0 = (size_t)F.vcu * 512 + F.tid;
    for (size_t i = t0; i < n / 8; i += nth) { const f32x4 a = *(const f32x4*)(src + 8 * i), b = *(const f32x4*)(src + 8 * i + 4);
        u32x4 w; w.x = cvtpk(a[0], a[1]); w.y = cvtpk(a[2], a[3]); w.z = cvtpk(b[0], b[1]); w.w = cvtpk(b[2], b[3]); *(u32x4*)(dst + 8 * i) = w; }
}

typedef float v16f __attribute__((ext_vector_type(16)));
typedef float v32f __attribute__((ext_vector_type(32)));
typedef unsigned v6u __attribute__((ext_vector_type(6)));
DI void convert_fp6(const Frame& F, const float* src, unsigned char* dst, int rows, float scale) {
    const size_t nth = (size_t)F.G * 512, t0 = (size_t)F.vcu * 512 + F.tid;
    for (size_t i = t0; i < (size_t)rows * 64; i += nth) {
        const size_t row = i >> 6; const int l = (int)(i & 63);
        const float* p = src + row * 2048 + 32 * l;
        v16f a, b;
#pragma unroll
        for (int q = 0; q < 8; ++q) { const f32x4 x = *(const f32x4*)(p + 4 * q) * scale;
            a[2 * q] = x[0]; b[2 * q] = x[1]; a[2 * q + 1] = x[2]; b[2 * q + 1] = x[3]; }
        const v6u w = __builtin_amdgcn_cvt_scalef32_2xpk16_fp6_f32(a, b, 1.0f);
        *(u32x4*)(dst + row * 1536 + 16 * l) = (u32x4){w[0], w[1], w[2], w[3]};
        *(u32x2*)(dst + row * 1536 + 1024 + 8 * l) = (u32x2){w[4], w[5]};
    }
}

DI void convert_fp4(const Frame& F, const float* src, unsigned char* dst, int rows, float scale) {
    const size_t nth = (size_t)F.G * 512, t0 = (size_t)F.vcu * 512 + F.tid;
    for (size_t i = t0; i < (size_t)rows * 64; i += nth) {
        const float* p = src + i * 32;
        u32x4 w = (u32x4){0u, 0u, 0u, 0u};
#define FP4_PK(q) { const f32x4 x = *(const f32x4*)(p + 4 * (q)) * scale; unsigned d = w[(q) >> 1];         \
            d = __builtin_amdgcn_cvt_scalef32_pk_fp4_f32(d, x[0], x[1], 1.0f, (2 * (q)) & 3); d = __builtin_amdgcn_cvt_scalef32_pk_fp4_f32(d, x[2], x[3], 1.0f, (2 * (q) + 1) & 3); w[(q) >> 1] = d; }
        FP4_PK(0) FP4_PK(1) FP4_PK(2) FP4_PK(3) FP4_PK(4) FP4_PK(5) FP4_PK(6) FP4_PK(7)
#undef FP4_PK
        *(u32x4*)(dst + i * 16) = w;
    }
}

DI void convert_weights(const Frame& F, const Args& a, int l_lo, int l_hi) {
    for (int l = l_lo; l < l_hi; ++l) {
        unsigned char* wl = F.ws + WS_W + (size_t)l * WL_STRIDE;
        transpose_matrix<1, true>(F, a.in[3] + (size_t)l * DM * 4672, DM, 4672, (bf16_t*)(wl + W_IN), 0);
        for (int n = 0; n < 4; ++n) transpose_matrix<0, false, true>(F, a.in[4] + ((size_t)l * 4 + n) * DM * DM, DM, DM, (bf16_t*)(wl + W_G), n * DM);
        for (int n = 0; n < 4; ++n) transpose_matrix<0, true>(F, a.in[6] + ((size_t)l * 4 + n) * 512 * DM, 512, DM, (bf16_t*)(wl + W_BR) + (size_t)n * DM * 512, 0);
        transpose_matrix<0, true>(F, a.in[7] + (size_t)l * DM * DM, DM, DM, (bf16_t*)(wl + W_O), 0);
        transpose_matrix<0>(F, a.in[16] + (size_t)l * 512 * 768, 512, 768, (bf16_t*)(wl + W_UQ), 0);
        transpose_matrix<2>(F, a.in[17] + (size_t)l * 256 * 1024, 256, 1024, (bf16_t*)(wl + W_UKV), 0);
        transpose_matrix<0>(F, a.in[20] + (size_t)l * DM * DM, DM, DM, (bf16_t*)(wl + W_PQ), 0);
        convert_bf16(F, a.in[21] + (size_t)l * 8 * 2 * 128 * 128, (bf16_t*)(wl + W_SK), (size_t)8 * 2 * 128 * 128);
    }
}
DI void build_rope_table(const Frame& F, const Args& a) {
    f32x2* CS = (f32x2*)(F.ws + WS_CS); const int* pos = (const int*)a.in[1];
    for (size_t i = (size_t)F.vcu * 512 + F.tid; i < (size_t)S * 32; i += (size_t)F.G * 512) {
        const int j = (int)(i & 31); const float inv = exp2f(-(float)j * (13.287712379549449f / 32.0f));
        const float ang = (float)pos[i >> 5] * inv;
        CS[i] = (f32x2){cosf(ang), sinf(ang)};
    }
}
DI void phase_prologue(const Frame& F, const Args& a) {
    convert_weights(F, a, 0, 1);
    convert_bf16(F, a.in[0], wsb(F, WS_XB), (size_t)S * DM);
    {
        const size_t nth = (size_t)F.G * 512, t0 = (size_t)F.vcu * 512 + F.tid; const float* src = a.in[0]; unsigned char* dst = F.ws + WS_XB4;
        for (size_t i = t0; i < (size_t)S * DM / 8; i += nth) { const f32x4 x = *(const f32x4*)(src + 8 * i) * 2.0f, y = *(const f32x4*)(src + 8 * i + 4) * 2.0f;
            unsigned d = 0u; d = __builtin_amdgcn_cvt_scalef32_pk_fp4_f32(d, x[0], x[1], 1.0f, 0); d = __builtin_amdgcn_cvt_scalef32_pk_fp4_f32(d, x[2], x[3], 1.0f, 1); d = __builtin_amdgcn_cvt_scalef32_pk_fp4_f32(d, y[0], y[1], 1.0f, 2); d = __builtin_amdgcn_cvt_scalef32_pk_fp4_f32(d, y[2], y[3], 1.0f, 3);
            *(unsigned*)(dst + 4 * i) = d; }
    }
    {
        const size_t nth = (size_t)F.G * 512, t0 = (size_t)F.vcu * 512 + F.tid; const float* src = a.in[0]; unsigned char* dst = F.ws + WS_XB8;
        for (size_t i = t0; i < (size_t)S * DM / 8; i += nth) { const f32x4 x = *(const f32x4*)(src + 8 * i), y = *(const f32x4*)(src + 8 * i + 4);
            int lo = __builtin_amdgcn_cvt_pk_fp8_f32(x[0], x[1], 0, false); lo = __builtin_amdgcn_cvt_pk_fp8_f32(x[2], x[3], lo, true); int hi = __builtin_amdgcn_cvt_pk_fp8_f32(y[0], y[1], 0, false); hi = __builtin_amdgcn_cvt_pk_fp8_f32(y[2], y[3], hi, true);
            *(u32x2*)(dst + 8 * i) = (u32x2){(unsigned)lo, (unsigned)hi}; }
    }
    build_rope_table(F, a);
}

DI float rope64(float x, int lane, const f32x2* cs_row) {
    const float other = xhalf(x);
    const f32x2 cs = cs_row[lane & 31];
    return (lane < 32) ? x * cs.x - other * cs.y : other * cs.y + x * cs.x;
}
DI void phase_prep(const Frame& F, const Args& a, int layer) {
    const bf16_t* H = wsb(F, WS_H); bf16_t* CQN = wsb(F, WS_CQN); bf16_t* CKVN = wsb(F, WS_CKVN); bf16_t* KD = wsb(F, WS_KD);
    const float* gq = a.in[14] + layer * 512; const float* gkv = a.in[15] + layer * 256; const int* pos = (const int*)a.in[1];
    const int gw = F.vcu * NWAVES + F.wave, NGW = F.G * NWAVES, lane = F.lane;
    for (int t = gw; t < S; t += NGW) {
        const bf16_t* hr = H + (size_t)t * HW;
        const u32x4 q = *(const u32x4*)(hr + H_DCQ + 8 * lane);
        float v[8] = {bf_lo(q.x), bf_hi(q.x), bf_lo(q.y), bf_hi(q.y), bf_lo(q.z), bf_hi(q.z), bf_lo(q.w), bf_hi(q.w)};
        float ss = 0.f;
#pragma unroll
        for (int e = 0; e < 8; ++e) ss += v[e] * v[e];
        const float rq = rsqrtf(wave_sum(ss) * (1.0f / 512.0f) + 1e-6f);
        const f32x4 g0 = *(const f32x4*)(gq + 8 * lane), g1 = *(const f32x4*)(gq + 8 * lane + 4);
        u32x4 w; w.x = cvtpk(v[0] * rq * g0[0], v[1] * rq * g0[1]); w.y = cvtpk(v[2] * rq * g0[2], v[3] * rq * g0[3]); w.z = cvtpk(v[4] * rq * g1[0], v[5] * rq * g1[1]); w.w = cvtpk(v[6] * rq * g1[2], v[7] * rq * g1[3]);
        *(u32x4*)(CQN + (size_t)t * 512 + 8 * lane) = w;
        const u32x2 k2 = *(const u32x2*)(hr + H_DCKV + 4 * lane);
        const float u0 = bf_lo(k2.x), u1 = bf_hi(k2.x), u2 = bf_lo(k2.y), u3 = bf_hi(k2.y);
        const float rk = rsqrtf(wave_sum(u0 * u0 + u1 * u1 + u2 * u2 + u3 * u3) * (1.0f / 256.0f) + 1e-6f);
        const f32x4 gk = *(const f32x4*)(gkv + 4 * lane);
        u32x2 w2; w2.x = cvtpk(u0 * rk * gk[0], u1 * rk * gk[1]); w2.y = cvtpk(u2 * rk * gk[2], u3 * rk * gk[3]);
        *(u32x2*)(CKVN + (size_t)t * 256 + 4 * lane) = w2;
        const float kr = bf1(hr[H_DKR + lane]);
        const float ro = rope64(kr, lane, (const f32x2*)(F.ws + WS_CS) + (size_t)t * 32);
        const bf16_t rb = (bf16_t)(cvtpk(ro, 0.f) & 0xffffu);
#pragma unroll
        for (int h = 0; h < 4; ++h) KD[(size_t)t * 768 + h * 192 + 128 + lane] = rb;
    }
    for (int t = gw; t < S / 64; t += NGW) { int pm = pos[t * 64 + lane];
#pragma unroll
        for (int o = 1; o < 64; o <<= 1) { const int other = __shfl_xor(pm, o); pm = other > pm ? other : pm; }
        if (lane == 0) ((int*)(F.ws + WS_TPMAX))[t] = pm; }
    float* KM = (float*)(F.ws + WS_KMEAN);
    for (int it = gw; it < 64 * 8; it += NGW) {
        const int n = it >> 3, cc = it & 7; const bf16_t* p = H + (size_t)(n * 256) * HW + H_AK + cc * 64 + lane;
        float s0 = 0.f, s1 = 0.f, s2 = 0.f, s3 = 0.f;
        for (int r = 0; r < 256; r += 4) { s0 += bf1(p[(size_t)r * HW]); s1 += bf1(p[(size_t)(r + 1) * HW]); s2 += bf1(p[(size_t)(r + 2) * HW]); s3 += bf1(p[(size_t)(r + 3) * HW]); }
        KM[n * 512 + cc * 64 + lane] = ((s0 + s1) + (s2 + s3)) * (1.0f / 256.0f);
    }
}
DI void phase_ropeq(const Frame& F, const Args& a) {
    bf16_t* QD = wsb(F, WS_QD); const int* pos = (const int*)a.in[1];
    const int gw = F.vcu * NWAVES + F.wave, NGW = F.G * NWAVES, lane = F.lane;
    for (int t = gw; t < S; t += NGW) {
        const f32x2* cs = (const f32x2*)(F.ws + WS_CS) + (size_t)t * 32;
#pragma unroll
        for (int h = 0; h < 4; ++h) { bf16_t* p = QD + (size_t)t * 768 + h * 192 + 128 + lane; const float ro = rope64(bf1(*p), lane, cs); *p = (bf16_t)(cvtpk(ro, 0.f) & 0xffffu); }
    }
}
DI void phase_moba_select(const Frame& F, const Args& a, int layer) {
    const bf16_t* H = wsb(F, WS_H); const float* KM = (const float*)(F.ws + WS_KMEAN); const int* pos = (const int*)a.in[1]; const int* TP = (const int*)(F.ws + WS_TPMAX);
    unsigned* cnt = (unsigned*)(F.ws + WS_CTL) + CW_MOBA + layer * 1024; int* lists = (int*)(F.ws + WS_MLIST);
    const int gw = F.vcu * NWAVES + F.wave, NGW = F.G * NWAVES;
    int lane = F.lane; asm volatile("" : "+v"(lane));
    const int r = lane & 31, hi = lane >> 5;
    for (int it = gw; it < (S / 32) * 4; it += NGW) {
        const int h = it & 3, q0 = (it >> 2) * 32, q = q0 + r, own = q0 >> 8;
        if (own == 0) continue;
        const bf16_t* qp = H + (size_t)q * HW + H_AQ + h * 128 + hi * 8;
        const bool two = own > 32;
        f32x16 g0, g1;
#pragma unroll
        for (int i = 0; i < 16; ++i) { g0[i] = 0.f; g1[i] = 0.f; }
#pragma unroll
        for (int kk = 0; kk < 8; ++kk) {
            const bf16x8 qf = *(const bf16x8*)(qp + kk * 16);
#pragma unroll
            for (int rb = 0; rb < 2; ++rb) {
                if (rb == 1 && !two) continue;
                const float* kp = KM + (size_t)(rb * 32 + r) * 512 + h * 128 + kk * 16 + hi * 8;
                const f32x4 x = *(const f32x4*)kp, y = *(const f32x4*)(kp + 4);
                u32x4 wh, wl;
                wh.x = cvtpk(x[0], x[1]); wh.y = cvtpk(x[2], x[3]); wh.z = cvtpk(y[0], y[1]); wh.w = cvtpk(y[2], y[3]);
                wl.x = cvtpk(x[0] - bf_lo(wh.x), x[1] - bf_hi(wh.x)); wl.y = cvtpk(x[2] - bf_lo(wh.y), x[3] - bf_hi(wh.y)); wl.z = cvtpk(y[0] - bf_lo(wh.z), y[1] - bf_hi(wh.z)); wl.w = cvtpk(y[2] - bf_lo(wh.w), y[3] - bf_hi(wh.w));
                if (rb == 0) { g0 = __builtin_amdgcn_mfma_f32_32x32x16_bf16(__builtin_bit_cast(bf16x8, wh), qf, g0, 0, 0, 0); g0 = __builtin_amdgcn_mfma_f32_32x32x16_bf16(__builtin_bit_cast(bf16x8, wl), qf, g0, 0, 0, 0); }
                else { g1 = __builtin_amdgcn_mfma_f32_32x32x16_bf16(__builtin_bit_cast(bf16x8, wh), qf, g1, 0, 0, 0); g1 = __builtin_amdgcn_mfma_f32_32x32x16_bf16(__builtin_bit_cast(bf16x8, wl), qf, g1, 0, 0, 0); }
            }
        }
        float v1 = -INFINITY, v2 = -INFINITY, v3 = -INFINITY; int i1 = -1, i2 = -1, i3 = -1;
#pragma unroll
        for (int rb = 0; rb < 2; ++rb)
#pragma unroll
            for (int i = 0; i < 16; ++i) {
                const int n = rb * 32 + (i & 3) + 8 * (i >> 2) + 4 * hi; const float g = (rb == 0) ? g0[i] : g1[i];
                if (n < own) {
                    if (g > v1) { v3 = v2; i3 = i2; v2 = v1; i2 = i1; v1 = g; i1 = n; }
                    else if (g > v2) { v3 = v2; i3 = i2; v2 = g; i2 = n; }
                    else if (g > v3) { v3 = g; i3 = n; }
                }
            }
        const float p1 = xhalf(v1), p2 = xhalf(v2), p3 = xhalf(v3);
        const int j1 = __shfl_xor(i1, 32), j2 = __shfl_xor(i2, 32), j3 = __shfl_xor(i3, 32);
#pragma unroll
        for (int c = 0; c < 3; ++c) { const float g = c == 0 ? p1 : (c == 1 ? p2 : p3); const int n = c == 0 ? j1 : (c == 1 ? j2 : j3);
            if (n >= 0) {
                if (g > v1 || (g == v1 && n < i1)) { v3 = v2; i3 = i2; v2 = v1; i2 = i1; v1 = g; i1 = n; }
                else if (g > v2 || (g == v2 && n < i2)) { v3 = v2; i3 = i2; v2 = g; i2 = n; }
                else if (g > v3 || (g == v3 && n < i3)) { v3 = g; i3 = n; }
            } }
        if (hi == 0) {
            const int pq = pos[q];
#pragma unroll
            for (int sl = 0; sl < 3; ++sl) { const int n = sl == 0 ? i1 : (sl == 1 ? i2 : i3);
                if (n >= 0) { const int bm = max(max(TP[4 * n], TP[4 * n + 1]), max(TP[4 * n + 2], TP[4 * n + 3])); const int near = (pq - bm < 790) ? 1 : 0;
                    const unsigned p = atomicAdd(cnt + near * 256 + h * 64 + n, 1u);
                    if (p < (unsigned)(near ? MCAP - MCAP_F : MCAP_F)) lists[(size_t)(h * 64 + n) * MCAP + (near ? MCAP_F : 0) + p] = q * 4 + sl; } }
        }
    }
}
DI void phase_mixer_combine(const Frame& F, const Args& a, int layer) {
    const unsigned char* PART = F.ws + WS_PART; bf16_t* OA = wsb(F, WS_O);
    const int gw = F.vcu * NWAVES + F.wave, NGW = F.G * NWAVES, lane = F.lane;
    for (int it = gw; it < S * 4; it += NGW) {
        const int q = it >> 2, h = it & 3, nsel = (q >> 8) < 3 ? (q >> 8) : 3;
        const unsigned char* pp = PART + ((size_t)q * 16 + h * 4) * 272;
        float mm[4], ll[4]; unsigned ov[4];
#pragma unroll
        for (int s = 0; s < 4; ++s) { const bool use = (s == 3) || (s < nsel); const f32x2 ml = *(const f32x2*)(pp + s * 272 + 256); mm[s] = use ? ml.x : -1e30f; ll[s] = use ? ml.y : 0.f; ov[s] = *(const unsigned*)(pp + s * 272 + lane * 4); }
        const float M = fmaxf(fmaxf(mm[0], mm[1]), fmaxf(mm[2], mm[3]));
        float wsum = 0.f, x0 = 0.f, x1 = 0.f;
#pragma unroll
        for (int s = 0; s < 4; ++s) { const float w = ll[s] * ex2(mm[s] - M); wsum += w; x0 += w * bf_lo(ov[s]); x1 += w * bf_hi(ov[s]); }
        const float inv = 1.0f / wsum;
#if defined(MK_CHECK) && MK_CHECK
        *(unsigned*)(OA + (size_t)q * 512 + h * 128 + lane * 2) = cvtpk(x0 * inv, x1 * inv);
#endif
        *(unsigned short*)(F.ws + WS_O8 + (size_t)q * 512 + h * 128 + lane * 2) = (unsigned short)__builtin_amdgcn_cvt_pk_fp8_f32(x0 * inv * 8.0f, x1 * inv * 8.0f, 0, false);
    }
    float d1 = 0.f, d2 = 0.f;
    for (int i = 0; i < 64; ++i) { d1 += a.in[9][layer * 64 + i] * a.in[10][layer * 64 + i]; d2 += a.in[11][layer * 64 + i] * a.in[12][layer * 64 + i]; }
    const float lambda_init = 0.8f - 0.6f * expf(-0.3f * (float)layer), lam = expf(d1) - expf(d2) + lambda_init;
    bf16_t* OC = wsb(F, WS_O) + (size_t)2 * S * 512; const bf16_t* OC2 = wsb(F, WS_OC2);
    const f32x2 sg = *(const f32x2*)(a.in[13] + layer * 128 + lane * 2);
    for (int it = gw; it < S * 4; it += NGW) {
        const size_t off = (size_t)(it >> 2) * 512 + (it & 3) * 128 + lane * 2;
        const unsigned w1 = *(const unsigned*)(OC + off), w2 = *(const unsigned*)(OC2 + off);
        const float x0 = bf_lo(w1) - lam * bf_lo(w2), x1 = bf_hi(w1) - lam * bf_hi(w2);
        const float rn = rsqrtf(wave_sum(x0 * x0 + x1 * x1) * (1.0f / 128.0f) + 1e-6f) * (1.0f - lambda_init);
#if defined(MK_CHECK) && MK_CHECK
        *(unsigned*)(OC + off) = cvtpk(x0 * rn * sg.x, x1 * rn * sg.y);
#endif
        *(unsigned short*)(F.ws + WS_O8 + (size_t)2 * S * 512 + off) = (unsigned short)__builtin_amdgcn_cvt_pk_fp8_f32(x0 * rn * sg.x * 8.0f, x1 * rn * sg.y * 8.0f, 0, false);
    }
}
template <int NJ, int NE> DI void ln_store(float (&v)[NJ][NE], const float* g, const float* b, float* of, bf16_t* ob, int lane, unsigned char* o8 = nullptr, unsigned char* o4 = nullptr) {
    static_assert(NJ * NE == 32 && NE % 8 == 0, "row layout");
    float s = 0.f;
#pragma unroll
    for (int j = 0; j < NJ; ++j)
#pragma unroll
        for (int e = 0; e < NE; ++e) s += v[j][e];
    const float mean = wave_sum(s) * (1.0f / DM);
    float q = 0.f;
#pragma unroll
    for (int j = 0; j < NJ; ++j)
#pragma unroll
        for (int e = 0; e < NE; ++e) { v[j][e] -= mean; q += v[j][e] * v[j][e]; }
    const float rstd = rsqrtf(wave_sum(q) * (1.0f / DM) + 1e-5f);
#pragma unroll
    for (int j = 0; j < NJ; ++j)
#pragma unroll
        for (int e8 = 0; e8 < NE; e8 += 8) {
            const int c = (DM / NJ) * j + NE * lane + e8;
            const f32x4 g0 = *(const f32x4*)(g + c), g1 = *(const f32x4*)(g + c + 4), b0 = *(const f32x4*)(b + c), b1 = *(const f32x4*)(b + c + 4);
            f32x4 o0, o1;
#pragma unroll
            for (int e = 0; e < 4; ++e) { o0[e] = v[j][e8 + e] * rstd * g0[e] + b0[e]; o1[e] = v[j][e8 + 4 + e] * rstd * g1[e] + b1[e]; }
            if (of) { *(f32x4*)(of + c) = o0; *(f32x4*)(of + c + 4) = o1; }
            u32x4 w; w.x = cvtpk(o0[0], o0[1]); w.y = cvtpk(o0[2], o0[3]); w.z = cvtpk(o1[0], o1[1]); w.w = cvtpk(o1[2], o1[3]);
            if (ob) *(u32x4*)(ob + c) = w;
            if (o8) { int lo = __builtin_amdgcn_cvt_pk_fp8_f32(o0[0], o0[1], 0, false); lo = __builtin_amdgcn_cvt_pk_fp8_f32(o0[2], o0[3], lo, true); int hi = __builtin_amdgcn_cvt_pk_fp8_f32(o1[0], o1[1], 0, false); hi = __builtin_amdgcn_cvt_pk_fp8_f32(o1[2], o1[3], hi, true);
                *(u32x2*)(o8 + c) = (u32x2){(unsigned)lo, (unsigned)hi}; }
            if (o4) { unsigned d = 0u; d = __builtin_amdgcn_cvt_scalef32_pk_fp4_f32(d, o0[0] * 2.0f, o0[1] * 2.0f, 1.0f, 0); d = __builtin_amdgcn_cvt_scalef32_pk_fp4_f32(d, o0[2] * 2.0f, o0[3] * 2.0f, 1.0f, 1);
                d = __builtin_amdgcn_cvt_scalef32_pk_fp4_f32(d, o1[0] * 2.0f, o1[1] * 2.0f, 1.0f, 2); d = __builtin_amdgcn_cvt_scalef32_pk_fp4_f32(d, o1[2] * 2.0f, o1[3] * 2.0f, 1.0f, 3); *(unsigned*)(o4 + (c >> 1)) = d; }
        }
}
DI void phase_ln1(const Frame& F, const Args& a, int layer) {
    const bf16_t* Y = wsb(F, WS_GT); bf16_t* XB = wsb(F, WS_XB);
    const int gw = F.vcu * NWAVES + F.wave, NGW = F.G * NWAVES, lane = F.lane;
    for (int t = gw; t < S; t += NGW) {
        float v[4][8];
#pragma unroll
        for (int j = 0; j < 4; ++j) { const u32x4 w = *(const u32x4*)(Y + (size_t)t * DM + 512 * j + 8 * lane);
            v[j][0] = bf_lo(w.x); v[j][1] = bf_hi(w.x); v[j][2] = bf_lo(w.y); v[j][3] = bf_hi(w.y); v[j][4] = bf_lo(w.z); v[j][5] = bf_hi(w.z); v[j][6] = bf_lo(w.w); v[j][7] = bf_hi(w.w); }
        ln_store<4, 8>(v, a.in[18] + layer * DM, a.in[19] + layer * DM, (float*)nullptr, XB + (size_t)t * DM, lane);
    }
}

namespace att {
constexpr int TBL = RING_BYTES - 4096;
constexpr int TPMO = TBL - 1024;
constexpr int KMO = 0;
constexpr float NEG = -1e30f;
enum { MIX_A = 0, MIX_B = 1, MIX_C = 2, MIX_D = 3 };

struct Ctx { int qi, pq, own; float c, cb; unsigned long long sel; };

DI int t5_bucket(int rel) {
    if (rel < 16) return rel;
    return 15 + (rel >= 16) + (rel >= 21) + (rel >= 27) + (rel >= 35) + (rel >= 46) + (rel >= 59) + (rel >= 77) + (rel >= 99) + (rel >= 128) + (rel >= 166) + (rel >= 216) + (rel >= 280) + (rel >= 363) + (rel >= 470) + (rel >= 609) + (rel >= 790);
}
DI void build_tbl(LAS unsigned char* lds, const float* t5, int col, const int* tpmax) {
    if (threadIdx.x < 256) *(LAS int*)(lds + TPMO + threadIdx.x * 4) = tpmax[threadIdx.x];
    for (int rel = threadIdx.x; rel < 1024; rel += 512) *(LAS float*)(lds + TBL + rel * 4) = t5[t5_bucket(rel) * 16 + col] * LOG2E;
}

#define ATT_SB() __builtin_amdgcn_sched_barrier(0)
#ifndef ATT_CONV_INTERLEAVE
#define ATT_CONV_INTERLEAVE 1
#endif
#ifndef ATT_CP_D
#define ATT_CP_D 0
#endif
#ifndef ATT_CP
#define ATT_CP 0
#endif
#ifndef ATT_X_LDS2
#define ATT_X_LDS2 0
#endif
#ifndef ATT_NOPRIO
#define ATT_NOPRIO 0
#endif
#if ATT_NOPRIO
#define ATT_PRIO(x) do { } while (0)
#else
#define ATT_PRIO(x) __builtin_amdgcn_s_setprio(x)
#endif
#if defined(ATT_X_NOSM)
#define ATT_SM(...) do { l_run = 1.0f; st0.resc = false; st1.resc = false; st0.alpha = 1.f; st1.alpha = 1.f; pf0[0] = qf[0]; pf0[1] = qf[1]; pf1[0] = qf[2]; pf1[1] = qf[3]; } while (0)
#else
#define ATT_SM(...) __VA_ARGS__
#endif
#ifndef ATT_PD
#define ATT_PD 4
#endif
DI float hmax32(float v) { auto rr = __builtin_amdgcn_permlane32_swap(__float_as_uint(v), __float_as_uint(v), false, false); return fmaxf(__uint_as_float(rr[0]), __uint_as_float(rr[1])); }
struct SmState { float mx, cc, dd, rs; bool resc; float alpha; };
template <int MIX, bool FAST, int W>
DI void sm_item(f32x16& s, SmState& st, float& m_run, float& l_run, bf16x8 (&pf)[2], const Ctx& cx, const LAS unsigned char* pkp, const LAS unsigned char* lds, int k0, int kmax, int kmin, int hi, bool lv) {
    constexpr bool BIAS = (MIX != MIX_D);
    if constexpr (W == 0 || W == 1) {
        constexpr int sg = W;
        if constexpr (FAST) {
            float a = fmaxf(fmaxf(s[sg * 8 + 0], s[sg * 8 + 1]), s[sg * 8 + 2]), b = fmaxf(fmaxf(s[sg * 8 + 3], s[sg * 8 + 4]), s[sg * 8 + 5]);
            a = fmaxf(fmaxf(a, s[sg * 8 + 6]), s[sg * 8 + 7]);
            st.mx = (W == 0) ? fmaxf(a, b) : fmaxf(st.mx, fmaxf(a, b));
            asm volatile("" : "+v"(st.mx));
        } else {
            i32x4 pk0 = (i32x4){0, 0, 0, 0}, pk1 = (i32x4){0, 0, 0, 0};
            if (BIAS) { const LAS i32x4* pp = (const LAS i32x4*)(pkp + (sg * 16 + hi * 8) * 4); pk0 = pp[0]; pk1 = pp[1]; }
            float mx = (W == 0) ? NEG : st.mx;
#pragma unroll
            for (int j = 0; j < 8; ++j) {
                const int i = sg * 8 + j, key = k0 + sg * 16 + hi * 8 + j;
                float tv = s[i] * cx.c;
                if (BIAS) { int rel = cx.pq - (j < 4 ? pk0[j & 3] : pk1[j & 3]); rel = rel < 0 ? 0 : (rel > 1023 ? 1023 : rel); tv += *(const LAS float*)(lds + TBL + rel * 4); }
                bool valid = key <= kmax;
                if (MIX == MIX_B) valid = valid && (key >= kmin);
                tv = valid ? tv : NEG;
                s[i] = tv; mx = fmaxf(mx, tv);
            }
            st.mx = mx;
        }
        if constexpr (W == 1) {
            float mx = hmax32(st.mx);
            if constexpr (FAST) mx = lv ? mx * cx.c + cx.cb : NEG;
            const bool need = mx > m_run + 8.0f;
            const float mn = need ? mx : m_run;
            st.alpha = ex2(m_run - mn); m_run = mn; l_run *= st.alpha;
            st.resc = (__ballot(need) != 0ull);
            st.cc = FAST ? (lv ? cx.c : 0.f) : 1.0f; st.dd = FAST ? (lv ? cx.cb - mn : NEG) : -mn; st.rs = 0.f;
            asm volatile("" : "+v"(st.alpha), "+v"(m_run), "+v"(l_run), "+v"(st.dd));
        }
    } else if constexpr (W >= 2 && W <= 5) {
        constexpr int e0 = (W - 2) * 4;
#pragma unroll
        for (int e = e0; e < e0 + 4; ++e) { float p = ex2(s[e] * st.cc + st.dd); asm volatile("" : "+v"(p)); s[e] = p; st.rs += p; }
        asm volatile("" : "+v"(st.rs));
        if constexpr (W == 5) l_run += st.rs;
    } else {
        constexpr int sg = W - 6;
        u32x4 w; w.x = cvtpk(s[sg * 8 + 0], s[sg * 8 + 1]); w.y = cvtpk(s[sg * 8 + 2], s[sg * 8 + 3]); w.z = cvtpk(s[sg * 8 + 4], s[sg * 8 + 5]); w.w = cvtpk(s[sg * 8 + 6], s[sg * 8 + 7]); asm volatile("" : "+v"(w)); pf[sg] = __builtin_bit_cast(bf16x8, w);
    }
}
template <int DQK, int DV, int MIX, bool FAST>
DI void tile_body(const LAS unsigned char* sb, const LAS unsigned char* lds, const bf16x8 (&qf)[DQK / 16], f32x16 (&o)[DV / 32], float& m_run, float& l_run, const Ctx& cx,
                  int k0, int kmax, int kmin, int pr, int xk, int xv, int r, int hi, bool lv) {
    constexpr int KCH = DQK / 8, NQ = DQK / 16, NP = DV / 16, KBUF = 64 * KCH * 16, VBUF = DV * 128;
    const LAS unsigned char* kb0 = sb + pr * (KCH * 16); const LAS unsigned char* kb1 = kb0 + 32 * (KCH * 16);
    const LAS unsigned char* vb = sb + KBUF + r * 128; const LAS unsigned char* pkp = sb + KBUF + VBUF;
    f32x16 s0, s1;
#pragma unroll
    for (int i = 0; i < 16; ++i) { s0[i] = 0.f; s1[i] = 0.f; }
    bf16x8 kf[NQ], kg[NQ], vf[2 * NP], pf0[2], pf1[2];
    SmState st0, st1;
#if defined(ATT_X_NOLDS)
#define ATT_KF(base, kk) (qf[(kk) % NQ])
#else
#define ATT_KF(base, kk) (*(const LAS bf16x8*)((base) + (((2 * (kk) + hi) ^ xk) << 4)))
#endif
#if defined(ATT_X_NOLDS)
#define ATT_VF(f) (qf[(f) % NQ])
#else
#define ATT_VF(f) (*(const LAS bf16x8*)(vb + (((f) % NP) >> 1) * 32 * 128 + (((((f) / NP) * 4 + ((f) & 1) * 2 + hi) ^ xv) << 4)))
#endif
#define ATT_PRE_K(W) do { _Pragma("unroll") for (int kk = ((W) * NQ) / 8; kk < (((W) + 1) * NQ) / 8; ++kk) { kg[kk] = ATT_KF(kb1, kk); if (ATT_X_LDS2) { bf16x8 dm_ = ATT_KF(kb1 + 16, kk); asm volatile("" :: "v"(dm_)); } } } while (0)
#define ATT_PRE_V(W) do { _Pragma("unroll") for (int f = ((W) * NP) / 8; f < (((W) + 1) * NP) / 8; ++f) { vf[f] = ATT_VF(f); if (ATT_X_LDS2) { bf16x8 dm_ = ATT_VF(f ^ 1); asm volatile("" :: "v"(dm_)); } } } while (0)
#pragma unroll
    for (int kk = 0; kk < NQ; ++kk) kf[kk] = ATT_KF(kb0, kk);
    ATT_SB();
#pragma unroll
    for (int kk = 0; kk < NQ; ++kk) s0 = __builtin_amdgcn_mfma_f32_32x32x16_bf16(kf[kk], qf[kk], s0, 0, 0, 0);
    ATT_PRE_K(0); ATT_PRE_K(1); if (ATT_PD > 2) ATT_PRE_K(2); if (ATT_PD > 3) ATT_PRE_K(3);
    ATT_SB();
#define ATT_STEP2(W) do { \
        ATT_PRIO(1); _Pragma("unroll") for (int kk = ((W) * NQ) / 8; kk < (((W) + 1) * NQ) / 8; ++kk) s1 = __builtin_amdgcn_mfma_f32_32x32x16_bf16(kg[kk], qf[kk], s1, 0, 0, 0); ATT_PRIO(0); \
        if ((W) + ATT_PD < 8) ATT_PRE_K((W) + ATT_PD); else ATT_PRE_V((W) + ATT_PD - 8); \
        ATT_SM(sm_item<MIX, FAST, W>(s0, st0, m_run, l_run, pf0, cx, pkp, lds, k0, kmax, kmin, hi, lv)); ATT_SB(); } while (0)
    ATT_STEP2(0); ATT_STEP2(1); ATT_STEP2(2); ATT_STEP2(3); ATT_STEP2(4); ATT_STEP2(5); ATT_STEP2(6); ATT_STEP2(7);
#undef ATT_STEP2
    if (st0.resc) {
#pragma unroll
        for (int d = 0; d < DV / 32; ++d)
#pragma unroll
            for (int i = 0; i < 16; ++i) o[d][i] *= st0.alpha;
    }
    ATT_SB();
#define ATT_STEP3(W) do { \
        ATT_PRIO(1); _Pragma("unroll") for (int f = ((W) * NP) / 8; f < (((W) + 1) * NP) / 8; ++f) o[f >> 1] = __builtin_amdgcn_mfma_f32_32x32x16_bf16(vf[f], pf0[f & 1], o[f >> 1], 0, 0, 0); ATT_PRIO(0); \
        ATT_PRE_V((W) + ATT_PD); \
        ATT_SM(sm_item<MIX, FAST, W>(s1, st1, m_run, l_run, pf1, cx, pkp + 128, lds, k0 + 32, kmax, kmin, hi, lv)); ATT_SB(); } while (0)
    ATT_STEP3(0); ATT_STEP3(1); ATT_STEP3(2); ATT_STEP3(3); ATT_STEP3(4); ATT_STEP3(5); ATT_STEP3(6); ATT_STEP3(7);
#undef ATT_STEP3
    if (st1.resc) {
#pragma unroll
        for (int d = 0; d < DV / 32; ++d)
#pragma unroll
            for (int i = 0; i < 16; ++i) o[d][i] *= st1.alpha;
    }
    ATT_SB();
#define ATT_STEP4(W) do { \
        _Pragma("unroll") for (int f = ((W) * NP) / 8; f < (((W) + 1) * NP) / 8; ++f) o[(f - NP) >> 1] = __builtin_amdgcn_mfma_f32_32x32x16_bf16(vf[f], pf1[f & 1], o[(f - NP) >> 1], 0, 0, 0); \
        if ((W) + ATT_PD < 16) ATT_PRE_V((W) + ATT_PD); ATT_SB(); } while (0)
    ATT_STEP4(8); ATT_STEP4(9); ATT_STEP4(10); ATT_STEP4(11); ATT_STEP4(12); ATT_STEP4(13); ATT_STEP4(14); ATT_STEP4(15);
#undef ATT_STEP4
#undef ATT_KF
#undef ATT_VF
#undef ATT_PRE_K
#undef ATT_PRE_V
}
template <int DQK, int DV, int MIX>
DI void flash_pass(LAS unsigned char* lds, const bf16x8 (&qf)[DQK / 16], const bf16_t* __restrict__ Kg, int ldk, const bf16_t* __restrict__ VTg, int ldvt,
                   const int* __restrict__ pos, int t0, int t1, int q0, int qpmin, const Ctx& cx, f32x16 (&o)[DV / 32], float& m_run, float& l_run, int ts_force = -1) {
    constexpr int KCH = DQK / 8, NKL = KCH / 8, NVL = DV / 64;
    constexpr bool BIAS = (MIX != MIX_D);
    constexpr int KBUF = 64 * KCH * 16, VBUF = DV * 128, PBUF = BIAS ? 2048 : 0, SLOT = KBUF + VBUF + PBUF, NV = NKL + NVL + (BIAS ? 1 : 0);
    static_assert(3 * SLOT <= TPMO, "attention ring");
    static_assert(DQK % 128 == 0 || DQK == 64 || DQK == 192, "QK MFMAs per softmax work item");
    int tid = threadIdx.x; asm volatile("" : "+v"(tid));
    const int lane = tid & 63, r = lane & 31, hi = lane >> 5, wave = __builtin_amdgcn_readfirstlane(tid >> 6);
    const int pr = (r & 0x13) | ((r & 4) << 1) | ((r & 8) >> 1);
    const int xk = (KCH == 16) ? (((pr & 1) << 3) | ((pr >> 1) & 7)) : ((pr >> 1) & 7);
    const int xv = (r >> 1) & 7;
    unsigned koff[NKL], voff[NVL];
#pragma unroll
    for (int i = 0; i < NKL; ++i) { const int p = (i * 8 + wave) * 64 + lane, row = p / KCH, cs = p % KCH; const int x = (KCH == 16) ? (((row & 1) << 3) | ((row >> 1) & 7)) : ((row >> 1) & 7); koff[i] = (unsigned)(row * ldk + (cs ^ x) * 8) * 2u; }
#pragma unroll
    for (int i = 0; i < NVL; ++i) { const int p = (i * 8 + wave) * 64 + lane, row = p >> 3, cs = p & 7; voff[i] = (unsigned)(row * ldvt + (cs ^ ((row >> 1) & 7)) * 8) * 2u; }
#define ATT_ISSUE(t, sl) do { LAS unsigned char* sb_ = lds + (sl) * SLOT; \
    _Pragma("unroll") for (int i_ = 0; i_ < NKL; ++i_) __builtin_amdgcn_global_load_lds((const unsigned*)((const char*)Kg + (size_t)(t) * 64 * ldk * 2 + koff[i_]), (LAS unsigned*)(sb_ + (i_ * 8 + wave) * 1024), 16, 0, 0); \
    _Pragma("unroll") for (int i_ = 0; i_ < NVL; ++i_) __builtin_amdgcn_global_load_lds((const unsigned*)((const char*)VTg + (size_t)(t) * 128 + voff[i_]), (LAS unsigned*)(sb_ + KBUF + (i_ * 8 + wave) * 1024), 16, 0, 0); \
    if (BIAS) __builtin_amdgcn_global_load_lds((const unsigned*)(pos + (t) * 64 + lane), (LAS unsigned*)(sb_ + KBUF + VBUF + wave * 256), 4, 0, 0); } while (0)
#ifndef ATT_X_DMA2
#define ATT_X_DMA2 0
#endif
#if ATT_X_DMA2
#define ATT_ISSUE2(t, sl) do { ATT_ISSUE(t, sl); ATT_ISSUE(t, sl); } while (0)
#else
#define ATT_ISSUE2(t, sl) ATT_ISSUE(t, sl)
#endif
#if defined(ATT_X_NODMA)
#define ATT_ISSUE_LOOP(t, sl) do { (void)(sl); } while (0)
#define ATT_NEXT_SLOT(sl) ((sl) ^ 1)
#else
#define ATT_ISSUE_LOOP(t, sl) ATT_ISSUE2(t, sl)
#define ATT_NEXT_SLOT(sl) (((sl) == 2) ? 0 : (sl) + 1)
#endif
#define ATT_WAITBAR(N) asm volatile("s_waitcnt vmcnt(%0) lgkmcnt(0)\n\ts_barrier" :: "n"(N) : "memory")
    int ts = t0;
    if (ts_force >= 0) ts = ts_force;
    else if (MIX != MIX_B) { const int tlim = (q0 >> 6) < t1 ? (q0 >> 6) : t1;
        if (!BIAS) ts = tlim > t0 ? tlim : t0;
        else {
            ts = tlim > t0 ? tlim : t0;
            for (int base = t0; base < tlim; base += 64) { const int idx = base + lane; const bool stop = (idx >= tlim) || (qpmin - *(const LAS int*)(lds + TPMO + (idx < 256 ? idx : 255) * 4) < 790);
                const unsigned long long mk = __ballot(stop); if (mk != 0ull) { const int f = base + (int)__builtin_ctzll(mk); ts = f < tlim ? f : tlim; break; } } } }
    ATT_ISSUE2(t0, 0);
    if (t0 + 1 < t1) ATT_ISSUE2(t0 + 1, 1);
    int sl = 0;
#define ATT_TILES(TA, TB, FASTV) \
    for (int t = (TA); t < (TB); ++t) { \
        if (t + 1 < t1) ATT_WAITBAR(NV * (ATT_X_DMA2 ? 2 : 1)); else ATT_WAITBAR(0);            \
        if (t + 2 < t1) { const int s2 = (sl >= 1) ? sl - 1 : 2; ATT_ISSUE_LOOP(t + 2, s2); } \
        const LAS unsigned char* sb = lds + sl * SLOT; \
        int kmax, kmin = 0; \
        kmax = cx.qi; \
        if (MIX == MIX_B) kmin = cx.qi - 127; \
        const int k0 = t * 64; \
        const bool lv = (kmax >= k0) && (kmin <= k0 + 63); \
        if (__ballot(lv) != 0ull) tile_body<DQK, DV, MIX, FASTV>(sb, lds, qf, o, m_run, l_run, cx, k0, kmax, kmin, pr, xk, xv, r, hi, lv); \
        sl = ATT_NEXT_SLOT(sl); \
    }
    ATT_TILES(t0, ts, true)
    ATT_TILES(ts, t1, false)
#undef ATT_TILES
    asm volatile("s_waitcnt lgkmcnt(0)\n\ts_barrier" ::: "memory");
#undef ATT_ISSUE
#undef ATT_WAITBAR
}
DI int fast_split(const LAS unsigned char* lds, int t0, int t1, int q0, int qpmin, int lane) {
    const int tlim = (q0 >> 6) < t1 ? (q0 >> 6) : t1;
    int ts = tlim > t0 ? tlim : t0;
    for (int base = t0; base < tlim; base += 64) { const int idx = base + lane; const bool stop = (idx >= tlim) || (qpmin - *(const LAS int*)(lds + TPMO + (idx < 256 ? idx : 255) * 4) < 790);
        const unsigned long long mk = __ballot(stop); if (mk != 0ull) { const int f = base + (int)__builtin_ctzll(mk); ts = f < tlim ? f : tlim; break; } }
    return ts;
}
template <int DQK, int DV, int MIX>
DI void flash_pass_cp(LAS unsigned char* lds, const bf16x8 (&qf)[DQK / 16], const bf16_t* __restrict__ Kg, int ldk, const bf16_t* __restrict__ VTg, int ldvt,
                      int t0, int ts, const Ctx& cx, f32x16 (&o)[DV / 32], float& m_run, float& l_run) {
    constexpr int KCH = DQK / 8, NKL = KCH / 8, NVL = DV / 64, NQ = DQK / 16, NP = DV / 16;
    constexpr int KBUF = 64 * KCH * 16, VBUF = DV * 128;
    static_assert(3 * (KBUF + VBUF) <= TPMO, "attention rings");
    int tid = threadIdx.x; asm volatile("" : "+v"(tid));
    const int lane = tid & 63, r = lane & 31, hi = lane >> 5, wave = __builtin_amdgcn_readfirstlane(tid >> 6);
    const int pr = (r & 0x13) | ((r & 4) << 1) | ((r & 8) >> 1);
    const int xk = (KCH == 16) ? (((pr & 1) << 3) | ((pr >> 1) & 7)) : ((pr >> 1) & 7);
    const int xv = (r >> 1) & 7;
    unsigned koff[NKL], voff[NVL];
#pragma unroll
    for (int i = 0; i < NKL; ++i) { const int p = (i * 8 + wave) * 64 + lane, row = p / KCH, cs = p % KCH; const int x = (KCH == 16) ? (((row & 1) << 3) | ((row >> 1) & 7)) : ((row >> 1) & 7); koff[i] = (unsigned)(row * ldk + (cs ^ x) * 8) * 2u; }
#pragma unroll
    for (int i = 0; i < NVL; ++i) { const int p = (i * 8 + wave) * 64 + lane, row = p >> 3, cs = p & 7; voff[i] = (unsigned)(row * ldvt + (cs ^ ((row >> 1) & 7)) * 8) * 2u; }
#define CP_ISSUE_K(t, sl) do { _Pragma("unroll") for (int i_ = 0; i_ < NKL; ++i_) __builtin_amdgcn_global_load_lds((const unsigned*)((const char*)Kg + (size_t)(t) * 64 * ldk * 2 + koff[i_]), (LAS unsigned*)(lds + (sl) * KBUF + (i_ * 8 + wave) * 1024), 16, 0, 0); } while (0)
#define CP_ISSUE_V(t, sl) do { _Pragma("unroll") for (int i_ = 0; i_ < NVL; ++i_) __builtin_amdgcn_global_load_lds((const unsigned*)((const char*)VTg + (size_t)(t) * 128 + voff[i_]), (LAS unsigned*)(lds + 3 * KBUF + (sl) * VBUF + (i_ * 8 + wave) * 1024), 16, 0, 0); } while (0)
#define CP_KF(base, kk) (*(const LAS bf16x8*)((base) + (((2 * (kk) + hi) ^ xk) << 4)))
#define CP_VF(base, hf, j) (*(const LAS bf16x8*)((base) + ((j) >> 1) * 32 * 128 + (((((hf) * 4 + ((j) & 1) * 2 + hi) ^ xv)) << 4)))
    const int n = ts - t0;
    CP_ISSUE_K(t0, 0); CP_ISSUE_V(t0, 0);
    if (n > 1) CP_ISSUE_K(t0 + 1, 1);
    asm volatile("s_waitcnt vmcnt(0) lgkmcnt(0)\n\ts_barrier" ::: "memory");
    const LAS unsigned char* kl = lds + pr * (KCH * 16);
    const LAS unsigned char* vl = lds + 3 * KBUF + r * 128;
    f32x16 sc, sn;
    bf16x8 kfr[NQ], vfr[NP], pp[2], pc[2];
    SmState st;
#pragma unroll
    for (int i = 0; i < 16; ++i) sc[i] = 0.f;
#pragma unroll
    for (int kk = 0; kk < NQ; ++kk) kfr[kk] = CP_KF(kl, kk);
    ATT_SB();
#pragma unroll
    for (int kk = 0; kk < NQ; ++kk) sc = __builtin_amdgcn_mfma_f32_32x32x16_bf16(kfr[kk], qf[kk], sc, 0, 0, 0);
#define CP_PRE(W, KB, HFK_UNUSED, VB, HFV, DOK, DOV) do { \
        if (DOK) { _Pragma("unroll") for (int kk = ((W) * NQ) / 8; kk < (((W) + 1) * NQ) / 8; ++kk) kfr[kk] = CP_KF(KB, kk); } \
        if (DOV) { _Pragma("unroll") for (int j = ((W) * NP) / 8; j < (((W) + 1) * NP) / 8; ++j) vfr[j] = CP_VF(VB, HFV, j); } } while (0)
#define CP_ITEM(W, DOK, DOV, KB, VB, HFV, KBN, VBN, HFVN) do { \
        ATT_PRIO(1); \
        if (DOK) { _Pragma("unroll") for (int kk = ((W) * NQ) / 8; kk < (((W) + 1) * NQ) / 8; ++kk) sn = __builtin_amdgcn_mfma_f32_32x32x16_bf16(kfr[kk], qf[kk], sn, 0, 0, 0); } \
        if (DOV) { _Pragma("unroll") for (int j = ((W) * NP) / 8; j < (((W) + 1) * NP) / 8; ++j) o[j >> 1] = __builtin_amdgcn_mfma_f32_32x32x16_bf16(vfr[j], pp[j & 1], o[j >> 1], 0, 0, 0); } \
        ATT_PRIO(0); \
        if ((W) + 2 < 8) CP_PRE((W) + 2, KB, 0, VB, HFV, DOK, DOV); else CP_PRE((W) - 6, KBN, 0, VBN, HFVN, true, true); \
        sm_item<MIX, true, W>(sc, st, m_run, l_run, pc, cx, lds, lds, 0, 0, 0, hi, true); ATT_SB(); } while (0)
#define CP_STEP(DOK, DOV, KB, VB, HFV, KBN, VBN, HFVN) do { \
        _Pragma("unroll") for (int i = 0; i < 16; ++i) sn[i] = 0.f; \
        CP_ITEM(0, DOK, DOV, KB, VB, HFV, KBN, VBN, HFVN); CP_ITEM(1, DOK, DOV, KB, VB, HFV, KBN, VBN, HFVN); CP_ITEM(2, DOK, DOV, KB, VB, HFV, KBN, VBN, HFVN); CP_ITEM(3, DOK, DOV, KB, VB, HFV, KBN, VBN, HFVN); \
        CP_ITEM(4, DOK, DOV, KB, VB, HFV, KBN, VBN, HFVN); CP_ITEM(5, DOK, DOV, KB, VB, HFV, KBN, VBN, HFVN); CP_ITEM(6, DOK, DOV, KB, VB, HFV, KBN, VBN, HFVN); CP_ITEM(7, DOK, DOV, KB, VB, HFV, KBN, VBN, HFVN); \
        if (st.resc) { _Pragma("unroll") for (int d = 0; d < DV / 32; ++d) _Pragma("unroll") for (int i = 0; i < 16; ++i) o[d][i] *= st.alpha; } \
        pp[0] = pc[0]; pp[1] = pc[1]; sc = sn; ATT_SB(); } while (0)
    int ks = 0, vs = 0;
    for (int i = 0; i < n; ++i) {
        const int t = t0 + i;
        const int ks1 = (ks == 2) ? 0 : ks + 1, ks2 = (ks == 0) ? 2 : ks - 1, vs1 = (vs == 2) ? 0 : vs + 1, vsp = (vs == 0) ? 2 : vs - 1;
        if (i > 0) asm volatile("s_waitcnt vmcnt(0) lgkmcnt(0)\n\ts_barrier" ::: "memory");
        if (t + 2 < ts) CP_ISSUE_K(t + 2, ks2);
        if (t + 1 < ts) CP_ISSUE_V(t + 1, vs1);
        const LAS unsigned char* kA = kl + ks * KBUF + 32 * (KCH * 16); const LAS unsigned char* kB = kl + ks1 * KBUF; const LAS unsigned char* kAn = kl + ks1 * KBUF + 32 * (KCH * 16);
        const LAS unsigned char* vP = vl + vsp * VBUF; const LAS unsigned char* vC = vl + vs * VBUF;
        if (i == 0) {
            CP_PRE(0, kA, 0, vP, 1, true, false); CP_PRE(1, kA, 0, vP, 1, true, false);
            CP_STEP(true, false, kA, vP, 1, kB, vC, 0);
        } else {
            CP_STEP(true, true, kA, vP, 1, kB, vC, 0);
        }
        CP_STEP(true, true, kB, vC, 0, kAn, vC, 1);
        ks = ks1; vs = vs1;
    }
    {
        const int vsp = (vs == 0) ? 2 : vs - 1; const LAS unsigned char* vP = vl + vsp * VBUF;
#pragma unroll
        for (int j = (2 * NP) / 8; j < NP; ++j) vfr[j] = CP_VF(vP, 1, j);
        ATT_SB();
#pragma unroll
        for (int j = 0; j < NP; ++j) o[j >> 1] = __builtin_amdgcn_mfma_f32_32x32x16_bf16(vfr[j], pp[j & 1], o[j >> 1], 0, 0, 0);
    }
    asm volatile("s_waitcnt lgkmcnt(0)\n\ts_barrier" ::: "memory");
#undef CP_ISSUE_K
#undef CP_ISSUE_V
#undef CP_KF
#undef CP_VF
#undef CP_PRE
#undef CP_ITEM
#undef CP_STEP
}
template <int DV> DI void store_o(const f32x16 (&o)[DV / 32], float scale, bf16_t* orow, int hi) {
#pragma unroll
    for (int d = 0; d < DV / 32; ++d)
#pragma unroll
        for (int a = 0; a < 4; ++a) { u32x2 w; w.x = cvtpk(o[d][4 * a] * scale, o[d][4 * a + 1] * scale); w.y = cvtpk(o[d][4 * a + 2] * scale, o[d][4 * a + 3] * scale); *(u32x2*)(orow + d * 32 + 8 * a + 4 * hi) = w; }
}

template <int DV> DI void store_o8(const f32x16 (&o)[DV / 32], float scale, unsigned char* orow, int hi) {
#pragma unroll
    for (int d = 0; d < DV / 32; ++d)
#pragma unroll
        for (int a = 0; a < 4; ++a) { int w = __builtin_amdgcn_cvt_pk_fp8_f32(o[d][4 * a] * scale, o[d][4 * a + 1] * scale, 0, false); w = __builtin_amdgcn_cvt_pk_fp8_f32(o[d][4 * a + 2] * scale, o[d][4 * a + 3] * scale, w, true); *(unsigned*)(orow + d * 32 + 8 * a + 4 * hi) = (unsigned)w; }
}
DI int wg_min_pos(const Frame& F, int pq) {
#pragma unroll
    for (int o = 1; o < 64; o <<= 1) { const int other = __shfl_xor(pq, o); pq = other < pq ? other : pq; }
    if (F.tid == 0) F.MISC[5] = 0x7fffffffu;
    __syncthreads();
    if (F.lane == 0) atomicMin((int*)&F.MISC[5], pq);
    __syncthreads();
    const int v = (int)F.MISC[5];
    __syncthreads();
    return v;
}
DI void unit_D(const Frame& F, const Args& a, int h, int qt) {
    int lane = F.lane; asm volatile("" : "+v"(lane));
    const int r = lane & 31, hi = lane >> 5, qi = qt * 256 + F.wave * 32 + r;
    const bf16_t* QD = wsb(F, WS_QD) + (size_t)qi * 768 + h * 192 + hi * 8;
    bf16x8 qf[12];
#pragma unroll
    for (int kk = 0; kk < 12; ++kk) qf[kk] = *(const bf16x8*)(QD + kk * 16);
    f32x16 o[4];
#pragma unroll
    for (int d = 0; d < 4; ++d)
#pragma unroll
        for (int i = 0; i < 16; ++i) o[d][i] = 0.f;
    float m = NEG, l = 0.f;
    Ctx cx; cx.qi = qi; cx.pq = 0; cx.own = 0; cx.sel = 0ull; cx.cb = 0.f; cx.c = 0.07216878364870322f * LOG2E;
    const int ts = qt * 4;
    if (ATT_CP_D && ts > 0) flash_pass_cp<192, 128, MIX_D>(F.lds, qf, wsb(F, WS_KD) + h * 192, 768, wsb(F, WS_VDT) + (size_t)(h * 128) * S, S, 0, ts, cx, o, m, l);
    flash_pass<192, 128, MIX_D>(F.lds, qf, wsb(F, WS_KD) + h * 192, 768, wsb(F, WS_VDT) + (size_t)(h * 128) * S, S, (const int*)a.in[1], ATT_CP_D ? ts : 0, (qt + 1) * 4, qt * 256, 0, cx, o, m, l, ATT_CP_D ? ts : -1);
    l += xhalf(l);
    int lane2 = F.lane; asm volatile("" : "+v"(lane2));
    const int hi2 = lane2 >> 5, qi2 = qt * 256 + F.wave * 32 + (lane2 & 31);
#if defined(MK_CHECK) && MK_CHECK
    store_o<128>(o, 1.0f / l, wsb(F, WS_O) + (size_t)3 * S * 512 + (size_t)qi2 * 512 + h * 128, hi2);
#endif
    store_o8<128>(o, 8.0f / l, F.ws + WS_O8 + (size_t)3 * S * 512 + (size_t)qi2 * 512 + h * 128, hi2);
}
DI void unit_C(const Frame& F, const Args& a, int h, int qt, int mp) {
    int lane = F.lane; asm volatile("" : "+v"(lane));
    const int r = lane & 31, hi = lane >> 5, qi = qt * 256 + F.wave * 32 + r;
    const int* pos = (const int*)a.in[1];
    build_tbl(F.lds, a.in[2], 12 + h, (const int*)(F.ws + WS_TPMAX));
    Ctx cx; cx.qi = qi; cx.pq = pos[qi]; cx.own = 0; cx.sel = 0ull; cx.c = 0.125f * LOG2E; cx.cb = a.in[2][31 * 16 + 12 + h] * LOG2E;
    const int qpmin = wg_min_pos(F, cx.pq);
    const bf16_t* H = wsb(F, WS_H);
    const bf16_t* Q = H + (size_t)qi * HW + H_CQ + h * 128 + mp * 64 + hi * 8;
    bf16x8 qf[4];
#pragma unroll
    for (int kk = 0; kk < 4; ++kk) qf[kk] = *(const bf16x8*)(Q + kk * 16);
    f32x16 o[4];
#pragma unroll
    for (int d = 0; d < 4; ++d)
#pragma unroll
        for (int i = 0; i < 16; ++i) o[d][i] = 0.f;
    float m = NEG, l = 0.f;
    const int ts = ATT_CP ? fast_split(F.lds, 0, (qt + 1) * 4, qt * 256, qpmin, lane) : 0;
    if (ATT_CP && ts > 0) flash_pass_cp<64, 128, MIX_C>(F.lds, qf, H + H_CK + h * 128 + mp * 64, HW, wsb(F, WS_VT) + (size_t)(VT_C + h * 128) * S, S, 0, ts, cx, o, m, l);
    flash_pass<64, 128, MIX_C>(F.lds, qf, H + H_CK + h * 128 + mp * 64, HW, wsb(F, WS_VT) + (size_t)(VT_C + h * 128) * S, S, pos, ATT_CP ? ts : 0, (qt + 1) * 4, qt * 256, qpmin, cx, o, m, l, ATT_CP ? ts : -1);
    l += xhalf(l);
    int lane2 = F.lane; asm volatile("" : "+v"(lane2));
    const int hi2 = lane2 >> 5, qi2 = qt * 256 + F.wave * 32 + (lane2 & 31);
    bf16_t* orow = (mp == 0 ? wsb(F, WS_O) + (size_t)2 * S * 512 : wsb(F, WS_OC2)) + (size_t)qi2 * 512 + h * 128;
    store_o<128>(o, 1.0f / l, orow, hi2);
}
DI void unit_B(const Frame& F, const Args& a, int layer, int hq, int qt) {
    const int lane = F.lane, r = lane & 31, hi = lane >> 5, qi = qt * 256 + F.wave * 32 + r, g = hq >> 2;
    const int* pos = (const int*)a.in[1];
    build_tbl(F.lds, a.in[2], 4 + hq, (const int*)(F.ws + WS_TPMAX));
    const bf16_t* H = wsb(F, WS_H);
    const bf16_t* Q = H + (size_t)qi * HW + H_BQ + hq * 64 + hi * 8;
    bf16x8 qf[4];
#pragma unroll
    for (int kk = 0; kk < 4; ++kk) qf[kk] = *(const bf16x8*)(Q + kk * 16);
    f32x16 o[2];
#pragma unroll
    for (int d = 0; d < 2; ++d)
#pragma unroll
        for (int i = 0; i < 16; ++i) o[d][i] = 0.f;
    float m = NEG, l = 0.f;
    Ctx cx; cx.qi = qi; cx.pq = pos[qi]; cx.own = 0; cx.sel = 0ull; cx.c = 0.125f * LOG2E; cx.cb = a.in[2][31 * 16 + 4 + hq] * LOG2E;
    const int t0 = (qt * 4 - 2) < 0 ? 0 : (qt * 4 - 2);
    flash_pass<64, 64, MIX_B>(F.lds, qf, H + H_BK + g * 64, HW, wsb(F, WS_VT) + (size_t)(VT_B + g * 64) * S, S, pos, t0, (qt + 1) * 4, qt * 256, 0, cx, o, m, l);
    l += xhalf(l);
    l += ex2(a.in[8][layer * 8 + hq] * LOG2E - m);
#if defined(MK_CHECK) && MK_CHECK
    store_o<64>(o, 1.0f / l, wsb(F, WS_O) + (size_t)1 * S * 512 + (size_t)qi * 512 + hq * 64, hi);
#endif
    store_o8<64>(o, 8.0f / l, F.ws + WS_O8 + (size_t)1 * S * 512 + (size_t)qi * 512 + hq * 64, hi);
}
DI void store_part(const f32x16 (&o)[4], float m, float l, unsigned char* prow, int hi) {
    l += xhalf(l);
    store_o<128>(o, 1.0f / l, (bf16_t*)prow, hi);
    if (hi == 0) *(f32x2*)(prow + 256) = (f32x2){m, l};
}
DI void unit_A_own(const Frame& F, const Args& a, int h, int qt) {
    const int lane = F.lane, r = lane & 31, hi = lane >> 5, qi = qt * 256 + F.wave * 32 + r;
    const int* pos = (const int*)a.in[1];
    build_tbl(F.lds, a.in[2], h, (const int*)(F.ws + WS_TPMAX));
    const bf16_t* H = wsb(F, WS_H);
    const bf16_t* Q = H + (size_t)qi * HW + H_AQ + h * 128 + hi * 8;
    bf16x8 qf[8];
#pragma unroll
    for (int kk = 0; kk < 8; ++kk) qf[kk] = *(const bf16x8*)(Q + kk * 16);
    f32x16 o[4];
#pragma unroll
    for (int d = 0; d < 4; ++d)
#pragma unroll
        for (int i = 0; i < 16; ++i) o[d][i] = 0.f;
    float m = NEG, l = 0.f;
    Ctx cx; cx.qi = qi; cx.pq = pos[qi]; cx.own = qt; cx.sel = 0ull; cx.c = 0.08838834764831845f * LOG2E; cx.cb = a.in[2][31 * 16 + h] * LOG2E;
    flash_pass<128, 128, MIX_C>(F.lds, qf, H + H_AK + h * 128, HW, wsb(F, WS_VT) + (size_t)(VT_A + h * 128) * S, S, pos, qt * 4, (qt + 1) * 4, 0, 0, cx, o, m, l);
    store_part(o, m, l, F.ws + WS_PART + ((size_t)qi * 16 + h * 4 + 3) * 272, hi);
}
DI void unit_A_gather(const Frame& F, const Args& a, int h, int n, int near, int chunk, int count) {
    const int lane = F.lane, r = lane & 31, hi = lane >> 5;
    const int* pos = (const int*)a.in[1];
    if (near) build_tbl(F.lds, a.in[2], h, (const int*)(F.ws + WS_TPMAX));
    const int* list = (const int*)(F.ws + WS_MLIST) + (size_t)(h * 64 + n) * MCAP + (near ? MCAP_F : 0);
    const int idx = chunk * 256 + F.wave * 32 + r; const bool live = idx < count;
    const int e = list[live ? idx : chunk * 256];
    const int qi = e >> 2, slot = e & 3;
    const bf16_t* H = wsb(F, WS_H);
    const bf16_t* Q = H + (size_t)qi * HW + H_AQ + h * 128 + hi * 8;
    bf16x8 qf[8];
#pragma unroll
    for (int kk = 0; kk < 8; ++kk) qf[kk] = *(const bf16x8*)(Q + kk * 16);
    f32x16 o[4];
#pragma unroll
    for (int d = 0; d < 4; ++d)
#pragma unroll
        for (int i = 0; i < 16; ++i) o[d][i] = 0.f;
    float m = NEG, l = 0.f;
    Ctx cx; cx.qi = 0x7fffffff; cx.pq = pos[qi]; cx.own = 0; cx.sel = 0ull; cx.c = 0.08838834764831845f * LOG2E; cx.cb = a.in[2][31 * 16 + h] * LOG2E;
    flash_pass<128, 128, MIX_C>(F.lds, qf, H + H_AK + h * 128, HW, wsb(F, WS_VT) + (size_t)(VT_A + h * 128) * S, S, pos, n * 4, (n + 1) * 4, 0, 0, cx, o, m, l, near ? n * 4 : (n + 1) * 4);
    if (live) store_part(o, m, l, F.ws + WS_PART + ((size_t)qi * 16 + h * 4 + slot) * 272, hi);
    else { l += xhalf(l); }
}
}

DI int next_unit(const Frame& F, unsigned* head) {
    if (F.tid == 0) F.MISC[4] = __hip_atomic_fetch_add(head, 1u, __ATOMIC_RELAXED, __HIP_MEMORY_SCOPE_AGENT);
    __syncthreads();
    const int u = (int)F.MISC[4];
    __syncthreads();
    return u;
}
DI void convert_chunk(const Frame& F, const Args& a, int layer, int c) {
    const bool isv = c >= 256; const int row0 = (c & 255) * 64 + F.wave * 8;
    const float* src = (isv ? a.in[23] : a.in[22]) + (size_t)layer * 16384 * DM + (size_t)row0 * DM;
    unsigned char* dst = F.ws + WS_UB + (size_t)row0 * 2048 + (isv ? 1024 : 0);
    const float scale = isv ? V_SCALE : U_SCALE;
    int lane = F.lane; asm volatile("" : "+v"(lane));
    for (int j = 0; j < 8; ++j) {
        const float* p = src + (size_t)j * DM + 4 * lane; unsigned char* q = dst + (size_t)j * 2048 + 2 * lane;
        f32x4 x[8];
#pragma unroll
        for (int k = 0; k < 8; ++k) x[k] = *(const f32x4*)(p + 256 * k);
#pragma unroll
        for (int k = 0; k < 8; ++k) { unsigned d = 0u; const f32x4 y = x[k] * scale;
            d = __builtin_amdgcn_cvt_scalef32_pk_fp4_f32(d, y[0], y[1], 1.0f, 0); d = __builtin_amdgcn_cvt_scalef32_pk_fp4_f32(d, y[2], y[3], 1.0f, 1);
            *(unsigned short*)(q + 128 * k) = (unsigned short)d; }
    }
}
template <int PART> DI void phase_attention(const Frame& F, const Args& a, int layer, int rep = 0) {
    unsigned* q = (unsigned*)(F.ws + WS_CTL) + CW_Q + layer * 256 + rep * 512;
    if constexpr (PART == 0) {
#if !defined(NO_D) && !defined(NO_C)
    for (;;) { const int u = next_unit(F, q + 0); if (u >= 768) break;
        const int qt = 63 - u / 12, k = u % 12;
        if (k < 4) att::unit_D(F, a, k, qt);
        else att::unit_C(F, a, (k - 4) >> 1, qt, (k - 4) & 1);
        if (ATT_CONV_INTERLEAVE) { const int c = next_unit(F, q + 32); if (c < 512) convert_chunk(F, a, layer, c); } }
    if (ATT_CONV_INTERLEAVE) for (;;) { const int c = next_unit(F, q + 32); if (c >= 512) break; convert_chunk(F, a, layer, c); }
#endif
    } else {
#ifndef NO_A
    {
        const unsigned* cnt = (const unsigned*)(F.ws + WS_CTL) + CW_MOBA + layer * 1024;
        LAS int* pre = (LAS int*)(F.lds + att::TBL - 4096);
        __syncthreads();
        if (F.tid == 0) { int acc = 0; for (int i = 0; i < 512; ++i) { pre[i] = acc; const unsigned c = cnt[i], cap = (i >= 256) ? (unsigned)(MCAP - MCAP_F) : (unsigned)MCAP_F; acc += (int)(((c < cap ? c : cap) + 255u) >> 8); } pre[512] = acc; }
        __syncthreads();
        const int ntot = 256 + pre[512];
        for (;;) { const int u = next_unit(F, q + 128); if (u >= ntot) break;
            if (u < 256) { att::unit_A_own(F, a, u & 3, 63 - (u >> 2)); continue; }
            const int g = u - 256; int lo_ = 0, hi_ = 511;
            while (lo_ < hi_) { const int mid = (lo_ + hi_ + 1) >> 1; if (pre[mid] <= g) lo_ = mid; else hi_ = mid - 1; }
            const unsigned c = cnt[lo_], cap = (lo_ >= 256) ? (unsigned)(MCAP - MCAP_F) : (unsigned)MCAP_F;
            att::unit_A_gather(F, a, (lo_ >> 6) & 3, lo_ & 63, lo_ >> 8, g - pre[lo_], (int)(c < cap ? c : cap)); }
    }
#endif
#ifndef NO_B
    for (;;) { const int u = next_unit(F, q + 192); if (u >= 512) break; att::unit_B(F, a, layer, u & 7, u >> 3); }
#endif
    }
}

DI void ins16(float (&v)[16], float x) {
#pragma unroll
    for (int k = 0; k < 16; ++k) { const float t = fmaxf(v[k], x); x = fminf(v[k], x); v[k] = t; }
}
DI float pack_idx(float s, int idx, unsigned mask) { return __uint_as_float((__float_as_uint(s) & ~mask) | (unsigned)idx); }
DI void peer_select_group(const Frame& F, const bf16_t* SK, int grp, LAS unsigned char* sel) {
    const bf16_t* QP = wsb(F, WS_H);
    int lane = F.lane; asm volatile("" : "+v"(lane));
    const int r = lane & 31, hi = lane >> 5;
    {
        const int h = F.wave, t = grp * 32 + r;
        float L[2][16];
#pragma unroll
        for (int m = 0; m < 2; ++m) {
            const bf16_t* qrow = QP + (size_t)t * DM + h * 256 + m * 128 + hi * 8;
            bf16x8 qf[8];
#pragma unroll
            for (int kk = 0; kk < 8; ++kk) qf[kk] = *(const bf16x8*)(qrow + kk * 16);
            const bf16_t* kb = SK + ((size_t)(h * 2 + m) * 128 + r) * 128 + hi * 8;
            float v[16];
#pragma unroll
            for (int k = 0; k < 16; ++k) v[k] = -3.0e38f;
#pragma unroll
            for (int rb = 0; rb < 4; ++rb) {
                f32x16 s;
#pragma unroll
                for (int i = 0; i < 16; ++i) s[i] = 0.f;
#pragma unroll
                for (int kk = 0; kk < 8; ++kk) { const bf16x8 kf = *(const bf16x8*)(kb + (size_t)rb * 32 * 128 + kk * 16); s = __builtin_amdgcn_mfma_f32_32x32x16_bf16(kf, qf[kk], s, 0, 0, 0); }
#pragma unroll
                for (int i = 0; i < 16; ++i) ins16(v, pack_idx(s[i], rb * 32 + (i & 3) + 8 * (i >> 2) + 4 * hi, 127u));
                asm volatile("" : "+v"(v[0]), "+v"(v[1]), "+v"(v[2]), "+v"(v[3]), "+v"(v[4]), "+v"(v[5]), "+v"(v[6]), "+v"(v[7]), "+v"(v[8]), "+v"(v[9]), "+v"(v[10]), "+v"(v[11]), "+v"(v[12]), "+v"(v[13]), "+v"(v[14]), "+v"(v[15]));
                asm volatile("" : "+v"(kb));
            }
            float ov[16];
#pragma unroll
            for (int k = 0; k < 16; ++k) ov[k] = xhalf(v[k]);
#pragma unroll
            for (int k = 0; k < 16; ++k) ins16(v, ov[k]);
#pragma unroll
            for (int k = 0; k < 16; ++k) L[m][k] = v[k];
        }
        int i0[16], i1[16];
#pragma unroll
        for (int k = 0; k < 16; ++k) { i0[k] = (int)(__float_as_uint(L[0][k]) & 127u); i1[k] = (int)(__float_as_uint(L[1][k]) & 127u); L[0][k] = __uint_as_float(__float_as_uint(L[0][k]) & ~127u); L[1][k] = __uint_as_float(__float_as_uint(L[1][k]) & ~127u); }
        float b[16];
#pragma unroll
        for (int k = 0; k < 16; ++k) b[k] = -3.0e38f;
#pragma unroll
        for (int i = 0; i < 16; ++i)
#pragma unroll
            for (int j = 0; j < 16; ++j) if ((i + 1) * (j + 1) <= 16) ins16(b, pack_idx(L[0][i] + L[1][j], i * 16 + j, 255u));
        float g[16]; int e[16]; float den = 0.f;
        const float b0 = __uint_as_float(__float_as_uint(b[0]) & ~255u);
#pragma unroll
        for (int k = 0; k < 16; ++k) {
            const unsigned bits = __float_as_uint(b[k]); const int ci = (int)((bits >> 4) & 15u), cj = (int)(bits & 15u);
            int e0 = i0[0], e1 = i1[0];
#pragma unroll
            for (int c = 1; c < 16; ++c) { e0 = (ci == c) ? i0[c] : e0; e1 = (cj == c) ? i1[c] : e1; }
            e[k] = e0 * 128 + e1;
            g[k] = ex2((__uint_as_float(bits & ~255u) - b0) * LOG2E); den += g[k];
        }
        const float inv = 1.0f / den;
        if (hi == 0) {
#pragma unroll
            for (int k = 0; k < 16; k += 4) *(LAS i32x4*)(sel + (r * 128 + h * 16 + k) * 4) = (i32x4){e[k], e[k + 1], e[k + 2], e[k + 3]};
        } else {
#pragma unroll
            for (int k = 0; k < 16; k += 4) *(LAS f32x4*)(sel + 16384 + (r * 128 + h * 16 + k) * 4) = (f32x4){g[k] * inv, g[k + 1] * inv, g[k + 2] * inv, g[k + 3] * inv};
        }
    }
}
DI float gelu_as(float v) {
    const float av = fabsf(v), t = __builtin_amdgcn_rcpf(av * 0.2316418882f + 1.0f);
    float q = t * 0.5307027145f + (-0.7265760135f); q = q * t + 0.7107068705f; q = q * t + (-0.142248368f); q = q * t + 0.127414796f; q = q * t;
    const float e = ex2((v * v) * (-0.72134752044f));
    const float m = v * (q * e);
    return v < 0.f ? m : v - m;
}
template <int CTRL, int RM> DI float dpp_add(float v) { return v + __builtin_bit_cast(float, __builtin_amdgcn_update_dpp(0, __builtin_bit_cast(int, v), CTRL, RM, 0xf, RM == 0xf)); }
DI float wave_total(float v) {
    v = dpp_add<0x111, 0xf>(v); v = dpp_add<0x112, 0xf>(v); v = dpp_add<0x114, 0xf>(v); v = dpp_add<0x118, 0xf>(v);
    v = dpp_add<0x142, 0xa>(v); v = dpp_add<0x143, 0xc>(v);
    return __uint_as_float(__builtin_amdgcn_readlane(__float_as_uint(v), 63));
}
DI void reduce4(float (&d)[4], int lane) {
#pragma unroll
    for (int i = 0; i < 4; ++i) d[i] = wave_total(d[i]);
}
DI void peer_gather_group(const Frame& F, const Args& a, int layer, float* outf, bf16_t* XB, int grp, const LAS unsigned char* sel) {
    typedef int v8i_t __attribute__((ext_vector_type(8)));
    const unsigned char* UB = F.ws + WS_UB;
    int lane = F.lane; asm volatile("" : "+v"(lane));
    const int m16 = lane & 15, g4 = lane >> 4;
    LAS unsigned char* x8 = F.lds + 65536 + F.wave * 2048;
    int sc = 0x7f7f7f7f; asm volatile("" : "+v"(sc));
    for (int ti = 0; ti < 4; ++ti) {
        const int tl = F.wave * 4 + ti, t = grp * 32 + tl;
        const bf16_t* xr = XB + (size_t)t * DM + 32 * lane;
        {
            u32x4 w8[2];
#pragma unroll
            for (int c = 0; c < 4; ++c) { const u32x4 w = *(const u32x4*)(xr + 8 * c);
#if PEER_X_SWAP
                int lo = __builtin_amdgcn_cvt_pk_fp8_f32(bf_hi(w.x), bf_lo(w.x), 0, false); lo = __builtin_amdgcn_cvt_pk_fp8_f32(bf_hi(w.y), bf_lo(w.y), lo, true);
                int hi = __builtin_amdgcn_cvt_pk_fp8_f32(bf_hi(w.z), bf_lo(w.z), 0, false); hi = __builtin_amdgcn_cvt_pk_fp8_f32(bf_hi(w.w), bf_lo(w.w), hi, true);
#else
                int lo = __builtin_amdgcn_cvt_pk_fp8_f32(bf_lo(w.x), bf_hi(w.x), 0, false); lo = __builtin_amdgcn_cvt_pk_fp8_f32(bf_lo(w.y), bf_hi(w.y), lo, true);
                int hi = __builtin_amdgcn_cvt_pk_fp8_f32(bf_lo(w.z), bf_hi(w.z), 0, false); hi = __builtin_amdgcn_cvt_pk_fp8_f32(bf_lo(w.w), bf_hi(w.w), hi, true);
#endif
                w8[c >> 1][(c & 1) * 2] = (unsigned)lo; w8[c >> 1][(c & 1) * 2 + 1] = (unsigned)hi; }
            *(LAS u32x4*)(x8 + 32 * lane) = w8[0]; *(LAS u32x4*)(x8 + 32 * lane + 16) = w8[1];
        }
        f32x2 acc[16];
#pragma unroll
        for (int e = 0; e < 16; ++e) acc[e] = (f32x2){0.f, 0.f};
        for (int half = 0; half < 2; ++half) {
            const int ev = *(const LAS int*)(sel + (tl * 128 + half * 64 + lane) * 4); const float gv = *(const LAS float*)(sel + 16384 + (tl * 128 + half * 64 + lane) * 4);
            for (int bb = 0; bb < 4; ++bb) {
                const int em = __builtin_amdgcn_ds_bpermute((16 * bb + m16) << 2, ev);
                const unsigned char* up = UB + (size_t)em * 2048 + 16 * g4;
                u32x4 ua[16], va[16];
#pragma unroll
                for (int s = 0; s < 16; ++s) ua[s] = *(const u32x4*)(up + 64 * s);
#pragma unroll
                for (int j = 0; j < 16; ++j) { const int e = __builtin_amdgcn_readlane(ev, 16 * bb + j); va[j] = *(const u32x4*)(UB + (size_t)e * 2048 + 1024 + 16 * lane); }
                f32x4 h = (f32x4){0.f, 0.f, 0.f, 0.f};
#pragma unroll
                for (int s = 0; s < 16; ++s) {
                    const u32x4 x0 = *(const LAS u32x4*)(x8 + 128 * s + 16 * g4), x1 = *(const LAS u32x4*)(x8 + 128 * s + 64 + 16 * g4);
                    const v8i_t xb = (v8i_t){(int)x0.x, (int)x0.y, (int)x0.z, (int)x0.w, (int)x1.x, (int)x1.y, (int)x1.z, (int)x1.w};
                    asm volatile("s_nop 1\n\tv_mfma_scale_f32_16x16x128_f8f6f4 %0, %1, %2, %0, %3, %3 op_sel_hi:[0,0,0] cbsz:4" : "+v"(h) : "v"(ua[s]), "v"(xb), "v"(sc));
                }
                asm volatile("s_nop 15" : "+v"(h));
                float hv[4];
#pragma unroll
                for (int i = 0; i < 4; ++i) { const float gq = __int_as_float(__builtin_amdgcn_ds_bpermute((16 * bb + 4 * g4 + i) << 2, __float_as_int(gv)));
                    hv[i] = gq * gelu_as(h[i] * (1.0f / U_SCALE)) * (1.0f / V_SCALE); }
#pragma unroll
                for (int j = 0; j < 16; ++j) {
                    const float wk = __uint_as_float(__builtin_amdgcn_readlane(__float_as_uint(hv[j & 3]), 16 * (j >> 2)));
                    const f32x2 wk2 = (f32x2){wk, wk}; const u32x4 w_ = va[j];
#define FP4_ACC(b) acc[b] += __builtin_amdgcn_cvt_scalef32_pk_f32_fp4(w_[(b) >> 2], 1.0f, (b) & 3) * wk2;
                    FP4_ACC(0) FP4_ACC(1) FP4_ACC(2) FP4_ACC(3) FP4_ACC(4) FP4_ACC(5) FP4_ACC(6) FP4_ACC(7) FP4_ACC(8) FP4_ACC(9) FP4_ACC(10) FP4_ACC(11) FP4_ACC(12) FP4_ACC(13) FP4_ACC(14) FP4_ACC(15)
#undef FP4_ACC
                }
            }
        }
        float z[1][32];
#pragma unroll
        for (int c = 0; c < 4; ++c) { const u32x4 w = *(const u32x4*)(xr + 8 * c);
            z[0][8 * c + 0] = acc[4 * c].x + DN_ALPHA * bf_lo(w.x); z[0][8 * c + 1] = acc[4 * c].y + DN_ALPHA * bf_hi(w.x); z[0][8 * c + 2] = acc[4 * c + 1].x + DN_ALPHA * bf_lo(w.y); z[0][8 * c + 3] = acc[4 * c + 1].y + DN_ALPHA * bf_hi(w.y);
            z[0][8 * c + 4] = acc[4 * c + 2].x + DN_ALPHA * bf_lo(w.z); z[0][8 * c + 5] = acc[4 * c + 2].y + DN_ALPHA * bf_hi(w.z); z[0][8 * c + 6] = acc[4 * c + 3].x + DN_ALPHA * bf_lo(w.w); z[0][8 * c + 7] = acc[4 * c + 3].y + DN_ALPHA * bf_hi(w.w); }
        ln_store<1, 32>(z, a.in[24] + layer * DM, a.in[25] + layer * DM, outf ? outf + (size_t)t * DM : (float*)nullptr, outf ? (bf16_t*)nullptr : XB + (size_t)t * DM, lane, outf ? (unsigned char*)nullptr : F.ws + WS_XB8 + (size_t)t * DM, outf ? (unsigned char*)nullptr : F.ws + WS_XB4 + (size_t)t * (DM / 2));
    }
}
DI void phase_peer(const Frame& F, const Args& a, int layer, const bf16_t* SK, float* outf) {
    LAS unsigned char* sel = F.lds;
    bf16_t* XB = wsb(F, WS_XB);
    const int g0 = F.vcu, g1 = F.vcu + F.G, ng = S / 32;
    if (F.vcu & 1) {
        if (g0 < ng) peer_select_group(F, SK, g0, sel);
        if (g1 < ng) peer_select_group(F, SK, g1, sel + 32768);
        __syncthreads();
        if (g0 < ng) peer_gather_group(F, a, layer, outf, XB, g0, sel);
        if (g1 < ng) peer_gather_group(F, a, layer, outf, XB, g1, sel + 32768);
    } else {
        if (g0 < ng) peer_select_group(F, SK, g0, sel);
        __syncthreads();
        if (g0 < ng) peer_gather_group(F, a, layer, outf, XB, g0, sel);
        if (g1 < ng) peer_select_group(F, SK, g1, sel + 32768);
        __syncthreads();
        if (g1 < ng) peer_gather_group(F, a, layer, outf, XB, g1, sel + 32768);
    }
    for (int g = F.vcu + 2 * F.G; g < ng; g += F.G) { __syncthreads(); peer_select_group(F, SK, g, sel); __syncthreads(); peer_gather_group(F, a, layer, outf, XB, g, sel); }
}

#ifndef GEMM_SP2
#define GEMM_SP2 true
#endif
#ifndef GEMM_ALIGN_EPI
#define GEMM_ALIGN_EPI true
#endif
DI void run_merge_chain(const Frame& F, const unsigned char* O8a, const unsigned char* Wbr, const pg8::Epi<5>& E) {
    pg8::Gemm g{(const bf16_t*)O8a, (const bf16_t*)Wbr, S, DM, 256, 256, 256, 0, (long)S * 512, (long)DM * 512 * 2}; pg8::ChainOrder<4> So; So.init(S, DM, F.G, (int)blockIdx.x);
    pg8::gemm_phase<pg8::Epi<5>, pg8::ChainOrder<4>, GEMM_ALIGN_EPI, GEMM_SP2, true, 121, 124, false>(F.lds, g, So, E);
}
template <int MODE, bool F8 = false, int SC0 = 127, int SC1 = 127, bool F4 = false> DI void run_gemm(const Frame& F, const bf16_t* A, int lda, const bf16_t* Bt, int ldb, int M, int N, int K, long apn, const pg8::Epi<MODE>& E, int rot = 0) {
    pg8::Gemm g{A, Bt, M, N, K, lda, ldb, apn}; pg8::StaticOrder So; So.init(M, N, F.G, (F.G == 256) ? (int)((blockIdx.x + (unsigned)rot) & 255u) : (int)blockIdx.x);
    pg8::gemm_phase<pg8::Epi<MODE>, pg8::StaticOrder, GEMM_ALIGN_EPI, GEMM_SP2, F8, SC0, SC1, F4>(F.lds, g, So, E);
}
#ifndef MK_CHECK
#define MK_CHECK 0
#endif
#ifndef MK_CHECK_WORD
#define MK_CHECK_WORD 0
#endif

#if MK_CHECK
namespace chk {
constexpr int NS = 64;
__device__ const int SAMPLES[NS] = {0, 1, 2, 31, 32, 63, 64, 127, 128, 129, 255, 256, 257, 300, 383, 384, 511, 512, 513, 767, 768, 1000, 1023, 1024, 1025, 1279, 1280, 2047, 2048, 2049, 3071, 3072,
    4095, 4096, 5000, 6143, 6144, 7777, 8191, 8192, 8193, 9999, 10239, 10240, 11111, 12287, 12288, 12289, 13000, 13311, 13312, 14000, 14335, 14336, 15000, 15359, 15360, 15871, 16127, 16128, 16129, 16255, 16256, 16383};
DI float bsum(const Frame& F, float v) {
    v = wave_sum(v);
    __syncthreads();
    if (F.lane == 0) F.MISC[16 + F.wave] = __float_as_uint(v);
    __syncthreads();
    float s = 0.f;
    for (int w = 0; w < 8; ++w) s += __uint_as_float(F.MISC[16 + w]);
    return s;
}
DI float bmax(const Frame& F, float v) {
#pragma unroll
    for (int o = 1; o < 64; o <<= 1) v = fmaxf(v, __shfl_xor(v, o));
    __syncthreads();
    if (F.lane == 0) F.MISC[16 + F.wave] = __float_as_uint(v);
    __syncthreads();
    float s = -INFINITY;
    for (int w = 0; w < 8; ++w) s = fmaxf(s, __uint_as_float(F.MISC[16 + w]));
    return s;
}
DI void verdict(const Frame& F, float err, float nrm, float tol, int code) {
    const float e = bsum(F, err), n = bsum(F, nrm);
    if (F.tid == 0) { const bool bad = !(e <= tol * tol * n + 1e-12f); if (bad) { atomicAdd((unsigned*)(F.ws + WS_CTL) + CW_CHK, 1u); atomicAdd((unsigned*)(F.ws + WS_CTL) + CW_CHK + 64 * (1 + code), 1u); } }
}
DI float sigm(float z) { return 1.0f / (1.0f + expf(-z)); }
DI float rope_inv(int j) { return powf(10000.0f, -(float)j / 32.0f); }
DI float t5_naive(const float* t5, int col, int rel) {
    int n = rel > 0 ? rel : 0; int b;
    if (n < 16) b = n; else { b = 16 + (int)(logf((float)n / 16.0f) / logf(64.0f) * 16.0f); if (b > 31) b = 31; }
    return t5[b * 16 + col];
}
DI void s1(const Frame& F, const Args& a, int layer) {
    const bf16_t* X = wsb(F, WS_XB); const float* W = a.in[3] + (size_t)layer * DM * 4672;
    const bf16_t* H = wsb(F, WS_H); const bf16_t* VT = wsb(F, WS_VT);
    for (int u = F.vcu; u < NS; u += F.G) { const int t = SAMPLES[u]; float err = 0.f, nrm = 0.f;
        for (int c = F.tid; c < 4672; c += 512) { float ref = 0.f; for (int k = 0; k < DM; ++k) ref += bf1(X[(size_t)t * DM + k]) * W[(size_t)k * 4672 + c];
            const int d = win_map(c); const float got = d < HW ? bf1(H[(size_t)t * HW + d]) : bf1(VT[(size_t)(d - HW) * S + t]); err += (ref - got) * (ref - got); nrm += ref * ref; }
        verdict(F, err, nrm, 0.06f, 0); }
}
DI void s2(const Frame& F, const Args& a, int layer) {
    const bf16_t* H = wsb(F, WS_H); const int* pos = (const int*)a.in[1];
    for (int u = F.vcu; u < NS; u += F.G) { const int t = SAMPLES[u]; float err = 0.f, nrm = 0.f;
        float ssq = 0.f; for (int k = 0; k < 512; ++k) { const float v = bf1(H[(size_t)t * HW + H_DCQ + k]); ssq += v * v; }
        const float rq = 1.0f / sqrtf(ssq / 512.0f + 1e-6f);
        float ssk = 0.f; for (int k = 0; k < 256; ++k) { const float v = bf1(H[(size_t)t * HW + H_DCKV + k]); ssk += v * v; }
        const float rk = 1.0f / sqrtf(ssk / 256.0f + 1e-6f);
        for (int c = F.tid; c < 512; c += 512) { const float ref = bf1(H[(size_t)t * HW + H_DCQ + c]) * rq * a.in[14][layer * 512 + c]; const float got = bf1(wsb(F, WS_CQN)[(size_t)t * 512 + c]); err += (ref - got) * (ref - got); nrm += ref * ref; }
        for (int c = F.tid; c < 256; c += 512) { const float ref = bf1(H[(size_t)t * HW + H_DCKV + c]) * rk * a.in[15][layer * 256 + c]; const float got = bf1(wsb(F, WS_CKVN)[(size_t)t * 256 + c]); err += (ref - got) * (ref - got); nrm += ref * ref; }
        for (int c = F.tid; c < 256; c += 512) { const int h = c >> 6, j = c & 63, jj = j & 31; const float x1 = bf1(H[(size_t)t * HW + H_DKR + jj]), x2 = bf1(H[(size_t)t * HW + H_DKR + jj + 32]);
            const float ang = (float)pos[t] * rope_inv(jj); const float ref = j < 32 ? x1 * cosf(ang) - x2 * sinf(ang) : x1 * sinf(ang) + x2 * cosf(ang);
            const float got = bf1(wsb(F, WS_KD)[(size_t)t * 768 + h * 192 + 128 + j]); err += (ref - got) * (ref - got); nrm += ref * ref; }
        verdict(F, err, nrm, 0.02f, 1); }
}
DI void s3(const Frame& F, const Args& a, int layer) {
    const int* pos = (const int*)a.in[1]; const float* Wq = a.in[16] + (size_t)layer * 512 * 768; const float* Wkv = a.in[17] + (size_t)layer * 256 * 1024;
    LAS float* pre = (LAS float*)F.lds;
    for (int u = F.vcu; u < NS; u += F.G) { const int t = SAMPLES[u]; float err = 0.f, nrm = 0.f;
        __syncthreads();
        for (int n = F.tid; n < 768; n += 512) { float r = 0.f; for (int k = 0; k < 512; ++k) r += bf1(wsb(F, WS_CQN)[(size_t)t * 512 + k]) * Wq[(size_t)k * 768 + n]; pre[n] = r; }
        __syncthreads();
        for (int n = F.tid; n < 768; n += 512) { const int h = n / 192, j = n % 192; float ref = pre[n];
            if (j >= 128) { const int jj = (j - 128) & 31; const float x1 = pre[h * 192 + 128 + jj], x2 = pre[h * 192 + 128 + jj + 32]; const float ang = (float)pos[t] * rope_inv(jj);
                ref = (j - 128) < 32 ? x1 * cosf(ang) - x2 * sinf(ang) : x1 * sinf(ang) + x2 * cosf(ang); }
            const float got = bf1(wsb(F, WS_QD)[(size_t)t * 768 + n]); err += (ref - got) * (ref - got); nrm += ref * ref; }
        for (int n = F.tid; n < 1024; n += 512) { float ref = 0.f; for (int k = 0; k < 256; ++k) ref += bf1(wsb(F, WS_CKVN)[(size_t)t * 256 + k]) * Wkv[(size_t)k * 1024 + n];
            const int h = n >> 8, j = n & 255; const float got = j < 128 ? bf1(wsb(F, WS_KD)[(size_t)t * 768 + h * 192 + j]) : bf1(wsb(F, WS_VDT)[(size_t)(h * 128 + j - 128) * S + t]);
            err += (ref - got) * (ref - got); nrm += ref * ref; }
        verdict(F, err, nrm, 0.02f, 2); }
}
DI void s4(const Frame& F, const Args& a, int layer) {
    const int* pos = (const int*)a.in[1]; const float* t5 = a.in[2]; const bf16_t* H = wsb(F, WS_H);
    LAS float* lg = (LAS float*)F.lds;
    LAS float* qv = (LAS float*)(F.lds + 65536);
    LAS float* ga = (LAS float*)(F.lds + 65536 + 1024);
    LAS float* op = (LAS float*)(F.lds + 65536 + 2048);
    LAS float* o1 = (LAS float*)(F.lds + 65536 + 2048 + 2048);
    LAS int* selb = (LAS int*)(F.lds + 65536 + 8192);
    for (int u = F.vcu; u < NS * 20; u += F.G) {
        const int q = SAMPLES[u / 20], mh = u % 20;
        int mix, h; if (mh < 4) { mix = 0; h = mh; } else if (mh < 12) { mix = 1; h = mh - 4; } else if (mh < 16) { mix = 2; h = mh - 12; } else { mix = 3; h = mh - 16; }
        const int DQ = mix == 0 ? 128 : (mix == 3 ? 192 : 64), DVV = mix == 1 ? 64 : 128;
        const int nmaps = mix == 2 ? 2 : 1;
        const float scale = 1.0f / sqrtf((float)DQ);
        const int bcol = mix == 0 ? h : (mix == 1 ? 4 + h : 12 + h);
        float errs = 0.f, nrms = 0.f;
        for (int mp = 0; mp < nmaps; ++mp) {
            const bf16_t* Qp; const bf16_t* Kp; int ldk; const bf16_t* Vp;
            if (mix == 0) { Qp = H + (size_t)q * HW + H_AQ + h * 128; Kp = H + H_AK + h * 128; ldk = HW; Vp = wsb(F, WS_VT) + (size_t)(VT_A + h * 128) * S; }
            else if (mix == 1) { Qp = H + (size_t)q * HW + H_BQ + h * 64; Kp = H + H_BK + (h >> 2) * 64; ldk = HW; Vp = wsb(F, WS_VT) + (size_t)(VT_B + (h >> 2) * 64) * S; }
            else if (mix == 2) { Qp = H + (size_t)q * HW + H_CQ + h * 128 + mp * 64; Kp = H + H_CK + h * 128 + mp * 64; ldk = HW; Vp = wsb(F, WS_VT) + (size_t)(VT_C + h * 128) * S; }
            else { Qp = wsb(F, WS_QD) + (size_t)q * 768 + h * 192; Kp = wsb(F, WS_KD) + h * 192; ldk = 768; Vp = wsb(F, WS_VDT) + (size_t)(h * 128) * S; }
            __syncthreads();
            for (int d = F.tid; d < DQ; d += 512) qv[d] = bf1(Qp[d]);
            if (F.tid < 64) { ga[F.tid] = 0.f; selb[F.tid] = 0; }
            __syncthreads();
            const int own = q >> 8;
            if (mix == 0) {
                for (int idx = F.tid; idx < own * 128; idx += 512) { const int n = idx >> 7, d = idx & 127; float sm = 0.f; for (int i = 0; i < 256; ++i) sm += bf1(Kp[(size_t)(n * 256 + i) * ldk + d]); atomicAdd((float*)&ga[n], qv[d] * (sm / 256.0f)); }
                __syncthreads();
                if (F.tid == 0) { for (int rnk = 0; rnk < 3 && rnk < own; ++rnk) { int best = -1; float bv = -INFINITY; for (int n = 0; n < own; ++n) if (!selb[n] && ga[n] > bv) { bv = ga[n]; best = n; } if (best >= 0) selb[best] = 1; } }
                __syncthreads();
            }
            float mx = -INFINITY;
            for (int k = F.tid; k <= q; k += 512) {
                bool valid = true;
                if (mix == 0) { const int blk = k >> 8; valid = (blk == own) ? true : (selb[blk] != 0); }
                if (mix == 1) valid = (q - k) < 128;
                float l = -INFINITY;
                if (valid) { float dot = 0.f; for (int d = 0; d < DQ; ++d) dot += qv[d] * bf1(Kp[(size_t)k * ldk + d]); l = dot * scale; if (mix != 3) l += t5_naive(t5, bcol, pos[q] - pos[k]); }
                lg[k] = l; mx = fmaxf(mx, l);
            }
            mx = bmax(F, mx);
            const float sink = (mix == 1) ? a.in[8][layer * 8 + h] : -INFINITY;
            if (mix == 1) mx = fmaxf(mx, sink);
            float sm = 0.f;
            for (int k = F.tid; k <= q; k += 512) { const float p = expf(lg[k] - mx); lg[k] = p; sm += p; }
            sm = bsum(F, sm);
            if (mix == 1) sm += expf(sink - mx);
            __syncthreads();
            { const int dv = F.tid % 128, part = F.tid / 128; float acc = 0.f;
              if (dv < DVV) for (int k = part; k <= q; k += 4) acc += lg[k] * bf1(Vp[(size_t)dv * S + k]);
              op[part * 128 + dv] = acc; }
            __syncthreads();
            float val = 0.f;
            if (F.tid < DVV) val = (op[F.tid] + op[128 + F.tid] + op[256 + F.tid] + op[384 + F.tid]) / sm;
            if (mix == 2 && mp == 0) { if (F.tid < 128) o1[F.tid] = val; __syncthreads(); continue; }
            if (mix == 2) {
                float d1 = 0.f, d2 = 0.f; for (int i = 0; i < 64; ++i) { d1 += a.in[9][layer * 64 + i] * a.in[10][layer * 64 + i]; d2 += a.in[11][layer * 64 + i] * a.in[12][layer * 64 + i]; }
                const float li = 0.8f - 0.6f * expf(-0.3f * (float)layer), lam = expf(d1) - expf(d2) + li;
                float x = (F.tid < 128) ? (o1[F.tid] - lam * val) : 0.f;
                const float ms = bsum(F, x * x) / 128.0f;
                val = x / sqrtf(ms + 1e-6f) * ((F.tid < 128) ? a.in[13][layer * 128 + F.tid] : 0.f) * (1.0f - li);
            }
            if (F.tid < DVV) { const int ocol = (mix == 1) ? h * 64 + F.tid : h * 128 + F.tid; const float got = bf1(wsb(F, WS_O)[(size_t)mix * S * 512 + (size_t)q * 512 + ocol]); errs = (val - got) * (val - got); nrms = val * val; }
        }
        verdict(F, errs, nrms, 0.03f, 3 + mix);
    }
}
DI void s5(const Frame& F, const Args& a, int layer) {
    const bf16_t* X = wsb(F, WS_XB);
    for (int u = F.vcu; u < NS; u += F.G) { const int t = SAMPLES[u]; float err = 0.f, nrm = 0.f, err2 = 0.f, nrm2 = 0.f;
        for (int c = F.tid; c < 8192; c += 512) { const int n = c >> 11, cc = c & 2047; const float* W = a.in[4] + ((size_t)layer * 4 + n) * DM * DM; float z = a.in[5][(size_t)layer * 8192 + c];
            for (int k = 0; k < DM; ++k) z += bf1(X[(size_t)t * DM + k]) * W[(size_t)k * DM + cc];
            const float ref = sigm(z), got = __builtin_amdgcn_cvt_pk_f32_fp8((int)(F.ws + WS_GT)[(size_t)t * 8192 + c], false)[0]; err += (ref - got) * (ref - got); nrm += ref * ref; }
        for (int c = F.tid; c < DM; c += 512) { float ref = 0.f;
            for (int n = 0; n < 4; ++n) { const float* W = a.in[6] + ((size_t)layer * 4 + n) * 512 * DM; float br = 0.f; for (int j = 0; j < 512; ++j) br += bf1(wsb(F, WS_O)[(size_t)n * S * 512 + (size_t)t * 512 + j]) * W[(size_t)j * DM + c];
                ref += __builtin_amdgcn_cvt_pk_f32_fp8((int)(F.ws + WS_GT)[(size_t)t * 8192 + n * DM + c], false)[0] * br; }
            const float got = bf1(wsb(F, WS_H)[(size_t)t * DM + c]); err2 += (ref - got) * (ref - got); nrm2 += ref * ref; }
        verdict(F, err, nrm, 0.12f, 7); verdict(F, err2, nrm2, 0.12f, 8); }
}
DI void s6(const Frame& F, const Args& a, int layer) {
    const bf16_t* X = wsb(F, WS_XB); const float* W = a.in[7] + (size_t)layer * DM * DM; const bf16_t* Y = wsb(F, WS_GT);
    for (int u = F.vcu; u < NS; u += F.G) { const int t = SAMPLES[u]; float err = 0.f, nrm = 0.f;
        for (int c = F.tid; c < DM; c += 512) { float ref = 0.f; for (int j = 0; j < DM; ++j) ref += bf1(wsb(F, WS_H)[(size_t)t * DM + j]) * W[(size_t)j * DM + c];
            const float full = DN_ALPHA * bf1(X[(size_t)t * DM + c]) + ref, got = bf1(Y[(size_t)t * DM + c]); err += (full - got) * (full - got); nrm += full * full; }
        verdict(F, err, nrm, 0.006f, 9); }
}
DI void poison(const Frame& F) {
    const unsigned bad = __hip_atomic_load((unsigned*)(F.ws + WS_CTL) + CW_CHK + 64 * MK_CHECK_WORD, __ATOMIC_RELAXED, __HIP_MEMORY_SCOPE_AGENT);
    const float sc = 1.0f + (float)bad / 256.0f;
    for (size_t i = (size_t)F.vcu * 512 + F.tid; i < (size_t)S * DM / 4; i += (size_t)F.G * 512) { f32x4 v = ((f32x4*)F.out)[i]; v = v * sc; ((f32x4*)F.out)[i] = v; }
}
}
#endif

#ifndef MK_CHECK
#define MK_CHECK 0
#endif
#ifndef MK_CHECK_WORD
#define MK_CHECK_WORD 0
#endif
#ifndef MK_CHECK_LAYER
#define MK_CHECK_LAYER 0
#endif
#ifndef MERGE_CHAIN
#define MERGE_CHAIN 1
#endif
#ifndef MK_X_BAR2
#define MK_X_BAR2 0
#endif
#ifndef MK_PROBE_REL
#define MK_PROBE_REL (-2)
#endif
#ifndef MK_PROBE_REPS
#define MK_PROBE_REPS 1
#endif
#ifndef MK_PER_PHASE
#define MK_PER_PHASE 0
#endif
constexpr int NPL = 11, NPHASES = 1 + NL * NPL;
DI void run_layer(const Frame& F, const Args& args, const XcdBarrier& bar, const int layer, const int lo, const int hi) {
#define PH(k) (lo <= (k) && (k) < hi)
#define SEAM(k) do { if (PH(k) && PH((k) + 1)) { xcd_barrier(bar); if (MK_X_BAR2) xcd_barrier(bar); } } while (0)
        const int pb = 1 + layer * NPL;
        unsigned char* wl = F.ws + WS_W + (size_t)layer * WL_STRIDE;
        if (PH(pb + 0)) {
            { pg8::Epi<0> E{}; E.O = wsb(F, WS_H); E.ldc = HW; E.grp = 128; run_gemm<0, true, 121, 127>(F, (const bf16_t*)(F.ws + WS_XB8), DM / 2, (const bf16_t*)(wl + W_IN), DM / 2, S, HW, DM / 2, 0, E); }
            { pg8::Epi<0> E{}; E.O = wsb(F, WS_VT); E.ldc = S; E.grp = 128; run_gemm<0, true, 127, 121>(F, (const bf16_t*)(wl + W_IN + (size_t)HW * DM), DM / 2, (const bf16_t*)(F.ws + WS_XB8), DM / 2, VT_ROWS, S, DM / 2, 0, E, 128); }
            { pg8::Epi<1> E{}; E.O = wsb(F, WS_GT); E.ldc = 8192; E.bias = args.in[5] + (size_t)layer * 8192; run_gemm<1, false, 121, 126, true>(F, (const bf16_t*)(F.ws + WS_XB4), DM / 4, (const bf16_t*)(wl + W_G), DM / 4, S, 8192, DM / 4, 0, E); }
        }
        SEAM(pb + 0);
        if (PH(pb + 1)) phase_prep(F, args, layer);
        SEAM(pb + 1);
        if (PH(pb + 2)) {
            { pg8::Epi<0> E{}; E.O = wsb(F, WS_QD); E.ldc = 768; E.grp = 128; run_gemm<0>(F, wsb(F, WS_CQN), 512, (const bf16_t*)(wl + W_UQ), 512, S, 768, 512, 0, E); }
            { pg8::Epi<0> E{}; E.O = wsb(F, WS_KD); E.ldc = 768; E.grp = 192; run_gemm<0>(F, wsb(F, WS_CKVN), 256, (const bf16_t*)(wl + W_UKV), 256, S, 512, 256, 0, E, 64); }
            { pg8::Epi<0> E{}; E.O = wsb(F, WS_VDT); E.ldc = S; E.grp = 128; run_gemm<0>(F, (const bf16_t*)(wl + W_UKV) + (size_t)512 * 256, 256, wsb(F, WS_CKVN), 256, 512, S, 256, 0, E, 192); }
        }
        SEAM(pb + 2);
        if (PH(pb + 3)) { phase_ropeq(F, args); phase_moba_select(F, args, layer); }
        SEAM(pb + 3);
        if (PH(pb + 4)) {
            phase_attention<0>(F, args, layer);
            if (layer + 1 < NL) convert_weights(F, args, layer + 1, layer + 2);
            __syncthreads();
            phase_attention<1>(F, args, layer);
        }
        SEAM(pb + 4);
        if (PH(pb + 5)) phase_mixer_combine(F, args, layer);
        SEAM(pb + 5);
        if (PH(pb + 6)) {
            if (MERGE_CHAIN) { pg8::Epi<5> E{}; E.O = wsb(F, WS_H); E.ldc = DM; E.G = (const bf16_t*)(F.ws + WS_GT); E.ldg = 8192; E.O8 = F.ws + WS_XB8;
                run_merge_chain(F, F.ws + WS_O8, wl + W_BR, E); }
            else
            for (int n = 0; n < 4; ++n) { pg8::Epi<2> E{}; E.O = wsb(F, WS_H); E.ldc = DM; E.G = (const bf16_t*)(F.ws + WS_GT + n * DM); E.ldg = 8192; E.first = (n == 0); E.O8 = (n == 3) ? F.ws + WS_XB8 : (unsigned char*)nullptr;
                run_gemm<2, true, 121, 124>(F, (const bf16_t*)(F.ws + WS_O8 + (size_t)n * S * 512), 256, (const bf16_t*)(wl + W_BR) + (size_t)n * DM * 512, 256, S, DM, 256, 0, E); }
        }
        SEAM(pb + 6);
        if (PH(pb + 7)) { pg8::Epi<3> E{}; E.O = F.ws + WS_GT; E.ldc = DM; E.X = wsb(F, WS_XB); E.alpha = DN_ALPHA;
            run_gemm<3, true, 121, 124>(F, (const bf16_t*)(F.ws + WS_XB8), DM / 2, (const bf16_t*)(wl + W_O), DM / 2, S, DM, DM / 2, 0, E); }
        SEAM(pb + 7);
        if (PH(pb + 8)) phase_ln1(F, args, layer);
        SEAM(pb + 8);
        if (PH(pb + 9)) { pg8::Epi<0> E{}; E.O = wsb(F, WS_H); E.ldc = DM; E.grp = 128; run_gemm<0>(F, wsb(F, WS_XB), DM, (const bf16_t*)(wl + W_PQ), DM, S, DM, DM, 0, E); }
        SEAM(pb + 9);
        if (PH(pb + 10)) phase_peer(F, args, layer, (const bf16_t*)(wl + W_SK), (layer == NL - 1) ? F.out : (float*)nullptr);
        SEAM(pb + 10);
#undef PH
#undef SEAM
}
__global__ void __launch_bounds__(512, 2) fwd_kernel(Args args) {
    extern __shared__ __attribute__((aligned(16))) unsigned char lds_raw[];
    Frame F;
    F.lds = (LAS unsigned char*)lds_raw; F.MISC = (volatile LAS unsigned*)(F.lds + MISC_OFF);
    F.tid = threadIdx.x; F.lane = F.tid & 63; F.wave = __builtin_amdgcn_readfirstlane(F.tid >> 6);
    F.G = gridDim.x; { const int bx = blockIdx.x; F.vcu = (F.G % 8 == 0) ? (bx % 8) * (F.G / 8) + bx / 8 : bx; }
    F.ws = args.ws; F.out = args.out;
    if (F.tid < 64) F.MISC[F.tid] = 0u;
    __syncthreads();
    const int lo = args.ph_lo, hi = args.ph_hi;
    unsigned* barw = (unsigned*)(F.ws + WS_CTL) + CW_BAR + (lo > 0 ? XCD_BAR_WORDS : 0);
    XcdBarrier bar; bar.bar = barw; bar.x = 0; bar.st = F.MISC;
    if (hi - lo > 1) bar = xcd_barrier_post(barw, F.MISC);
#define PH(k) (lo <= (k) && (k) < hi)
#define SEAM(k) do { if (PH(k) && PH((k) + 1)) { xcd_barrier(bar); if (MK_X_BAR2) xcd_barrier(bar); } } while (0)
    if (PH(0)) phase_prologue(F, args);
    SEAM(0);
    run_layer(F, args, bar, 0, lo, hi);
    run_layer(F, args, bar, 1, lo, hi);
#undef PH
#undef SEAM
}


#if MK_CHECK
__global__ void __launch_bounds__(512, 1) chk_kernel(Args args, int stage, int layer) {
    extern __shared__ __attribute__((aligned(16))) unsigned char lds_raw[];
    Frame F;
    F.lds = (LAS unsigned char*)lds_raw; F.MISC = (volatile LAS unsigned*)(F.lds + MISC_OFF);
    F.tid = threadIdx.x; F.lane = F.tid & 63; F.wave = __builtin_amdgcn_readfirstlane(F.tid >> 6);
    F.G = gridDim.x; { const int bx = blockIdx.x; F.vcu = (F.G % 8 == 0) ? (bx % 8) * (F.G / 8) + bx / 8 : bx; }
    F.ws = args.ws; F.out = args.out;
    if (stage == 1) { chk::s1(F, args, layer); chk::s2(F, args, layer); chk::s3(F, args, layer); }
    if (stage == 4) chk::s4(F, args, layer);
    if (stage == 5) chk::s5(F, args, layer);
    if (stage == 6) chk::s6(F, args, layer);
    if (stage == 99) chk::poison(F);
}
#endif
extern "C" void kernel_launch(void* const* d_in, const int* in_sizes, int n_in, void* d_out, int out_size, void* d_ws, size_t ws_size, hipStream_t stream) {
    static int grid = 0;
    if (grid == 0) {
        if (n_in != 26 || out_size != S * DM || ws_size < WS_END) { fprintf(stderr, "kernel_launch: unexpected problem (n_in %d, out %d, ws %zu); nothing launched\n", n_in, out_size, ws_size); grid = -1; return; }
        int dev = 0, cus = 0, per_cu = 0;
        if (hipGetDevice(&dev) != hipSuccess || hipDeviceGetAttribute(&cus, hipDeviceAttributeMultiprocessorCount, dev) != hipSuccess) { grid = -1; return; }
        if (hipFuncSetAttribute((const void*)fwd_kernel, hipFuncAttributeMaxDynamicSharedMemorySize, LDS_BYTES) != hipSuccess) { fprintf(stderr, "kernel_launch: hipFuncSetAttribute failed\n"); grid = -1; return; }
        if (hipOccupancyMaxActiveBlocksPerMultiprocessor(&per_cu, (const void*)fwd_kernel, 512, LDS_BYTES) != hipSuccess || per_cu < 1) { fprintf(stderr, "kernel_launch: occupancy query says %d blocks per CU\n", per_cu); }
        (void)hipGetLastError();
        grid = cus;
    }
    if (grid < 0) return;
    (void)hipMemsetAsync((char*)d_ws + WS_CTL, 0, CTL_ZERO_BYTES, stream);
    Args a{};
    for (int i = 0; i < 26; ++i) a.in[i] = (const float*)d_in[i];
    a.out = (float*)d_out; a.ws = (unsigned char*)d_ws;
#if MK_CHECK
    {
        static bool once = false; if (!once) { once = true; (void)hipFuncSetAttribute((const void*)chk_kernel, hipFuncAttributeMaxDynamicSharedMemorySize, LDS_BYTES); }
        const int pb = 1 + MK_CHECK_LAYER * NPL; const int cuts[6] = {0, pb + 4, pb + 6, pb + 7, pb + 8, NPHASES}; const int stg[5] = {1, 4, 5, 6, 0};
        for (int i = 0; i < 5; ++i) { (void)hipMemsetAsync((unsigned*)((char*)d_ws + WS_CTL) + CW_BAR, 0, 2 * XCD_BAR_WORDS * 4, stream); a.ph_lo = cuts[i]; a.ph_hi = cuts[i + 1]; hipLaunchKernelGGL(fwd_kernel, dim3(grid), dim3(512), LDS_BYTES, stream, a);
            if (stg[i]) hipLaunchKernelGGL(chk_kernel, dim3(grid), dim3(512), LDS_BYTES, stream, a, stg[i], MK_CHECK_LAYER); }
        hipLaunchKernelGGL(chk_kernel, dim3(grid), dim3(512), LDS_BYTES, stream, a, 99, 0);
    }
#elif MK_PROBE_REL > -2
    {
        unsigned* ctl = (unsigned*)((char*)d_ws + WS_CTL);
        auto launch = [&](int lo, int hi) { if (hi <= lo) return; (void)hipMemsetAsync(ctl + CW_BAR, 0, 2 * XCD_BAR_WORDS * 4, stream); a.ph_lo = lo; a.ph_hi = hi; hipLaunchKernelGGL(fwd_kernel, dim3(grid), dim3(512), LDS_BYTES, stream, a); };
        int cur = 0;
        const int nl = (MK_PROBE_REL == -1) ? 1 : NL;
        for (int layer = 0; layer < nl; ++layer) {
            const int p = (MK_PROBE_REL == -1) ? 0 : 1 + layer * NPL + MK_PROBE_REL;
            launch(cur, p);
            for (int r = 0; r <= MK_PROBE_REPS; ++r) {
                (void)hipMemsetAsync(ctl + CW_Q, 0, 4096 * 4, stream);
#ifdef MK_PROBE_MIXER
                if (r > 0) { (void)hipMemsetAsync(ctl + CW_Q, 0x04, 4096 * 4, stream); (void)hipMemsetAsync(ctl + CW_Q + layer * 256 + 64 * MK_PROBE_MIXER, 0, 4, stream); }
#endif
                if (MK_PROBE_REL == 10 && r == 0) (void)hipMemcpyAsync((char*)d_ws + WS_GT, (char*)d_ws + WS_XB, (size_t)S * DM * 2, hipMemcpyDeviceToDevice, stream);
                if (MK_PROBE_REL == 10 && r > 0) (void)hipMemcpyAsync((char*)d_ws + WS_XB, (char*)d_ws + WS_GT, (size_t)S * DM * 2, hipMemcpyDeviceToDevice, stream);
                if (MK_PROBE_REL == 3 && r == 0) (void)hipMemcpyAsync((char*)d_ws + WS_PART, (char*)d_ws + WS_QD, (size_t)S * 768 * 2, hipMemcpyDeviceToDevice, stream);
                if (MK_PROBE_REL == 3 && r > 0) { (void)hipMemcpyAsync((char*)d_ws + WS_QD, (char*)d_ws + WS_PART, (size_t)S * 768 * 2, hipMemcpyDeviceToDevice, stream); (void)hipMemsetAsync(ctl + CW_MOBA, 0, 2048 * 4, stream); }
                launch(p, p + 1);
            }
            cur = p + 1;
        }
        launch(cur, NPHASES);
    }
#elif MK_PER_PHASE
    for (int p = 0; p < NPHASES; ++p) { a.ph_lo = p; a.ph_hi = p + 1; hipLaunchKernelGGL(fwd_kernel, dim3(grid), dim3(512), LDS_BYTES, stream, a); }
#else
    a.ph_lo = 0; a.ph_hi = NPHASES;
    hipLaunchKernelGGL(fwd_kernel, dim3(grid), dim3(512), LDS_BYTES, stream, a);
#endif
}
```

```cpp
#include <hip/hip_runtime.h>
#include <cstdio>
#include <cstdint>
#include <cmath>

#define DI __device__ __forceinline__
#define LAS __attribute__((address_space(3)))
#define GAS __attribute__((address_space(1)))
typedef unsigned short bf16_t;
typedef short bf16x8 __attribute__((ext_vector_type(8)));
typedef float f32x4 __attribute__((ext_vector_type(4)));
typedef float f32x2 __attribute__((ext_vector_type(2)));
typedef float f32x16 __attribute__((ext_vector_type(16)));
typedef unsigned u32x4 __attribute__((ext_vector_type(4)));
typedef unsigned u32x2 __attribute__((ext_vector_type(2)));
typedef int i32x4 __attribute__((ext_vector_type(4)));
typedef __bf16 bf16x2_t __attribute__((ext_vector_type(2)));

DI unsigned cvtpk(float lo, float hi) { f32x2 v = {lo, hi}; bf16x2_t b = __builtin_convertvector(v, bf16x2_t); return __builtin_bit_cast(unsigned, b); }
DI float bf_lo(unsigned u) { return __uint_as_float(u << 16); }
DI float bf_hi(unsigned u) { return __uint_as_float(u & 0xffff0000u); }
DI float bf1(bf16_t u) { return __uint_as_float((unsigned)u << 16); }
DI float ex2(float x) { return __builtin_amdgcn_exp2f(x); }
DI float wave_sum(float v) {
#pragma unroll
    for (int o = 1; o < 64; o <<= 1) v += __shfl_xor(v, o);
    return v;
}
DI float xhalf(float v) { return __shfl_xor(v, 32); }

namespace pg8 {
#define PG8_LAS __attribute__((address_space(3)))
#ifndef PG8_WGM
#define PG8_WGM 8
#endif
constexpr int BM = 256, BK = 64, HALF = 128, HTB = HALF * BK * 2  , STAGE_BYTES = 8 * HTB, NXCD = 8, WGM = PG8_WGM;

__host__ __device__ __forceinline__ int lds_byte(int r, int c) { const int st = (r >> 4) * 2 + (c >> 5), rr = r & 15, cc = c & 31, ob = rr * 64 + cc * 2; return st * 1024 + (ob ^ (((ob >> 9) & 1) << 5)); }
__host__ __device__ __forceinline__ void stage_rc(int b, int& R, int& C) { const int st = b / 1024, sb = b % 1024, swz = sb ^ (((sb >> 9) & 1) << 5); R = (st >> 1) * 16 + swz / 64; C = (st & 1) * 32 + (swz % 64) / 2; }
__host__ __device__ __forceinline__ int perm32(int rho) { const int n = rho >> 4, i = rho & 15; return 8 * (i >> 2) + 4 * n + (i & 3); }

struct Unit { int pm, pn, br; };
struct Gemm { const bf16_t* A; const bf16_t* Bt; int M, N, K, lda, ldb; long apn; long abr, bbr; };

struct StaticOrder {
    int nM, nN, nwg, G, c;
    __host__ __device__ void init(int M, int N, int G_, int c_) { nM = M / BM; nN = N / BM; nwg = nM * nN; G = G_; c = c_; }
    __host__ __device__ bool next(int i, Unit& u) const {
        const long L = (long)i * G + c; if (L >= nwg) return false;
        int wgid = (int)L; { const int q = nwg / NXCD, r = nwg % NXCD, xcd = wgid % NXCD, off = wgid / NXCD; wgid = (xcd < r ? xcd * (q + 1) : r * (q + 1) + (xcd - r) * q) + off; }
        const int nig = WGM * nN, gid = wgid / nig, fm = gid * WGM, gsz = (nM - fm) < WGM ? (nM - fm) : WGM;
        u.pm = fm + ((wgid % nig) % gsz); u.pn = (wgid % nig) / gsz; u.br = 0; return true;
    }
    __device__ __forceinline__ void a_ready(const Unit&) const {}
    __device__ __forceinline__ void done(const Unit&) const {}
};
template <int NBR> struct ChainOrder {
    StaticOrder so;
    __host__ __device__ void init(int M, int N, int G_, int c_) { so.init(M, N, G_, c_); }
    __host__ __device__ bool next(int i, Unit& u) const { const bool ok = so.next(i / NBR, u); u.br = i % NBR; return ok; }
    __device__ __forceinline__ void a_ready(const Unit&) const {}
    __device__ __forceinline__ void done(const Unit&) const {}
};

template <int MODE> struct Epi {
    static constexpr bool PERM = true, AFTER_DRAIN = false, CHAIN = (MODE == 5); static constexpr int NBR = 4;
    void* O; int ldc; int grp; const float* bias; const bf16_t* G; int ldg; const void* X; float alpha; int first; unsigned char* O8;
    static __device__ __forceinline__ f32x2 gclamp(f32x2 g) { return (f32x2){fmaxf(g.x, 0.001953125f), fmaxf(g.y, 0.001953125f)}; }
    __device__ __forceinline__ void rescale(f32x4 (&acc)[2][2][4][2], const Unit& u, int wr, int wc, int fr, int fq) const {
        const int row0 = u.pm * BM + wr * 64 + fr, colb = u.pn * BM + wc * 32 + 8 * fq;
        const float z = (u.br + 1 < NBR) ? 1.0f : 0.0f;
        const size_t gcol = (size_t)(u.br + 1 < NBR ? u.br : 0) * ldc;
#pragma unroll
        for (int ai = 0; ai < 2; ++ai)
#pragma unroll
            for (int m = 0; m < 4; ++m) {
                const size_t r = (size_t)(row0 + ai * HALF + m * 16);
#pragma unroll
                for (int bj = 0; bj < 2; ++bj) {
                    const int c = colb + bj * HALF;
                    const unsigned char* gp = (const unsigned char*)G + r * ldg + gcol + c;
                    asm volatile("" : "+v"(gp));
                    const u32x2 ga = *(const u32x2*)gp, gb = *(const u32x2*)(gp + ldc);
                    const f32x2 a0 = gclamp(__builtin_amdgcn_cvt_pk_f32_fp8((int)ga.x, false)), a1 = gclamp(__builtin_amdgcn_cvt_pk_f32_fp8((int)ga.x, true)), a2 = gclamp(__builtin_amdgcn_cvt_pk_f32_fp8((int)ga.y, false)), a3 = gclamp(__builtin_amdgcn_cvt_pk_f32_fp8((int)ga.y, true));
                    const f32x2 b0 = gclamp(__builtin_amdgcn_cvt_pk_f32_fp8((int)gb.x, false)), b1 = gclamp(__builtin_amdgcn_cvt_pk_f32_fp8((int)gb.x, true)), b2 = gclamp(__builtin_amdgcn_cvt_pk_f32_fp8((int)gb.y, false)), b3 = gclamp(__builtin_amdgcn_cvt_pk_f32_fp8((int)gb.y, true));
                    f32x4& v0 = acc[ai][bj][m][0]; f32x4& v1 = acc[ai][bj][m][1];
                    v0[0] *= z * b0.x * __builtin_amdgcn_rcpf(a0.x); v0[1] *= z * b0.y * __builtin_amdgcn_rcpf(a0.y); v0[2] *= z * b1.x * __builtin_amdgcn_rcpf(a1.x); v0[3] *= z * b1.y * __builtin_amdgcn_rcpf(a1.y);
                    v1[0] *= z * b2.x * __builtin_amdgcn_rcpf(a2.x); v1[1] *= z * b2.y * __builtin_amdgcn_rcpf(a2.y); v1[2] *= z * b3.x * __builtin_amdgcn_rcpf(a3.x); v1[3] *= z * b3.y * __builtin_amdgcn_rcpf(a3.y);
                    asm volatile("" : "+v"(v0), "+v"(v1));
                }
            }
    }
    __device__ __forceinline__ void operator()(const f32x4 (&acc)[2][2][4][2], const Unit& u, int wr, int wc, int fr, int fq) const {
        const int row0 = u.pm * BM + wr * 64 + fr, colb = u.pn * BM + wc * 32 + 8 * fq;
#pragma unroll
        for (int ai = 0; ai < 2; ++ai)
#pragma unroll
            for (int m = 0; m < 4; ++m) {
                const size_t r = (size_t)(row0 + ai * HALF + m * 16);
#pragma unroll
                for (int bj = 0; bj < 2; ++bj) {
                    const int c = colb + bj * HALF;
                    f32x4 v0 = acc[ai][bj][m][0], v1 = acc[ai][bj][m][1];
                    if constexpr (MODE == 0) {
                        const int dc = (c >> 7) * grp + (c & 127);
                        u32x4 w; w.x = cvtpk(v0[0], v0[1]); w.y = cvtpk(v0[2], v0[3]); w.z = cvtpk(v1[0], v1[1]); w.w = cvtpk(v1[2], v1[3]);
                        *(u32x4*)((bf16_t*)O + r * ldc + dc) = w;
                    } else if constexpr (MODE == 1) {
                        const f32x4 b0 = *(const f32x4*)(bias + c), b1 = *(const f32x4*)(bias + c + 4);
                        v0 = v0 + b0; v1 = v1 + b1;
#pragma unroll
                        for (int e = 0; e < 4; ++e) { v0[e] = fminf(1.0f + ex2(-1.4426950408889634f * v0[e]), 448.0f); v1[e] = fminf(1.0f + ex2(-1.4426950408889634f * v1[e]), 448.0f); }
                        int lo = __builtin_amdgcn_cvt_pk_fp8_f32(v0[0], v0[1], 0, false); lo = __builtin_amdgcn_cvt_pk_fp8_f32(v0[2], v0[3], lo, true);
                        int hi = __builtin_amdgcn_cvt_pk_fp8_f32(v1[0], v1[1], 0, false); hi = __builtin_amdgcn_cvt_pk_fp8_f32(v1[2], v1[3], hi, true);
                        *(u32x2*)((unsigned char*)O + r * ldc + c) = (u32x2){(unsigned)lo, (unsigned)hi};
                    } else if constexpr (MODE == 2) {
                        const u32x2 gq = *(const u32x2*)((const unsigned char*)G + r * ldg + c);
                        const f32x2 g0 = __builtin_amdgcn_cvt_pk_f32_fp8((int)gq.x, false), g1 = __builtin_amdgcn_cvt_pk_f32_fp8((int)gq.x, true), g2 = __builtin_amdgcn_cvt_pk_f32_fp8((int)gq.y, false), g3 = __builtin_amdgcn_cvt_pk_f32_fp8((int)gq.y, true);
                        bf16_t* op = (bf16_t*)O + r * ldc + c;
                        u32x4 old = (u32x4){0u, 0u, 0u, 0u};
                        if (!first) old = *(const u32x4*)op;
                        const float r0 = bf_lo(old.x) + g0.x * v0[0], r1 = bf_hi(old.x) + g0.y * v0[1], r2 = bf_lo(old.y) + g1.x * v0[2], r3 = bf_hi(old.y) + g1.y * v0[3];
                        const float r4 = bf_lo(old.z) + g2.x * v1[0], r5 = bf_hi(old.z) + g2.y * v1[1], r6 = bf_lo(old.w) + g3.x * v1[2], r7 = bf_hi(old.w) + g3.y * v1[3];
                        u32x4 w; w.x = cvtpk(r0, r1); w.y = cvtpk(r2, r3); w.z = cvtpk(r4, r5); w.w = cvtpk(r6, r7);
                        *(u32x4*)op = w;
                        if (O8) {
                            int lo = __builtin_amdgcn_cvt_pk_fp8_f32(r0 * 8.0f, r1 * 8.0f, 0, false); lo = __builtin_amdgcn_cvt_pk_fp8_f32(r2 * 8.0f, r3 * 8.0f, lo, true);
                            int hi = __builtin_amdgcn_cvt_pk_fp8_f32(r4 * 8.0f, r5 * 8.0f, 0, false); hi = __builtin_amdgcn_cvt_pk_fp8_f32(r6 * 8.0f, r7 * 8.0f, hi, true);
                            *(u32x2*)(O8 + r * ldc + c) = (u32x2){(unsigned)lo, (unsigned)hi}; }
                    } else if constexpr (MODE == 5) {
                        const u32x2 gq = *(const u32x2*)((const unsigned char*)G + r * ldg + 3 * ldc + c);
                        const f32x2 e0 = __builtin_amdgcn_cvt_pk_f32_fp8((int)gq.x, false), e1 = __builtin_amdgcn_cvt_pk_f32_fp8((int)gq.x, true), e2 = __builtin_amdgcn_cvt_pk_f32_fp8((int)gq.y, false), e3 = __builtin_amdgcn_cvt_pk_f32_fp8((int)gq.y, true);
                        const float r0 = __builtin_amdgcn_rcpf(e0.x) * v0[0], r1 = __builtin_amdgcn_rcpf(e0.y) * v0[1], r2 = __builtin_amdgcn_rcpf(e1.x) * v0[2], r3 = __builtin_amdgcn_rcpf(e1.y) * v0[3], r4 = __builtin_amdgcn_rcpf(e2.x) * v1[0], r5 = __builtin_amdgcn_rcpf(e2.y) * v1[1], r6 = __builtin_amdgcn_rcpf(e3.x) * v1[2], r7 = __builtin_amdgcn_rcpf(e3.y) * v1[3];
#if defined(MK_CHECK) && MK_CHECK
                        { u32x4 w; w.x = cvtpk(r0, r1); w.y = cvtpk(r2, r3); w.z = cvtpk(r4, r5); w.w = cvtpk(r6, r7); *(u32x4*)((bf16_t*)O + r * ldc + c) = w; }
#endif
                        int lo = __builtin_amdgcn_cvt_pk_fp8_f32(r0 * 8.0f, r1 * 8.0f, 0, false); lo = __builtin_amdgcn_cvt_pk_fp8_f32(r2 * 8.0f, r3 * 8.0f, lo, true);
                        int hi = __builtin_amdgcn_cvt_pk_fp8_f32(r4 * 8.0f, r5 * 8.0f, 0, false); hi = __builtin_amdgcn_cvt_pk_fp8_f32(r6 * 8.0f, r7 * 8.0f, hi, true);
                        *(u32x2*)(O8 + r * ldc + c) = (u32x2){(unsigned)lo, (unsigned)hi};
                    } else if constexpr (MODE == 3) {
                        const u32x4 xx = *(const u32x4*)((const bf16_t*)X + r * ldc + c);
                        u32x4 w;
                        w.x = cvtpk(bf_lo(xx.x) * alpha + v0[0], bf_hi(xx.x) * alpha + v0[1]); w.y = cvtpk(bf_lo(xx.y) * alpha + v0[2], bf_hi(xx.y) * alpha + v0[3]);
                        w.z = cvtpk(bf_lo(xx.z) * alpha + v1[0], bf_hi(xx.z) * alpha + v1[1]); w.w = cvtpk(bf_lo(xx.w) * alpha + v1[2], bf_hi(xx.w) * alpha + v1[3]);
                        *(u32x4*)((bf16_t*)O + r * ldc + c) = w;
                    } else {
                        *(f32x4*)((float*)O + r * ldc + c) = v0; *(f32x4*)((float*)O + r * ldc + c + 4) = v1;
                    }
                }
            }
    }
};

template <class Epi, class Sched, bool ALIGN_EPI = false, bool SP2 = false, bool F8 = false, int SC0 = 127, int SC1 = 127, bool F4 = false>
__device__ __forceinline__ void gemm_phase(PG8_LAS unsigned char* lds, const Gemm g, const Sched& S, const Epi& E) {
    int tid_ = threadIdx.x; asm volatile("" : "+v"(tid_));
    const int tid = tid_, wid = __builtin_amdgcn_readfirstlane(tid >> 6), lane = tid & 63, wr = wid >> 2, wc = wid & 3, fr = lane & 15, fq = lane >> 4;
    const int K = g.K, nt = K / BK;
    unsigned voffA[2], voffB[2];
#pragma unroll
    for (int i = 0; i < 2; ++i) { int R, C; stage_rc(tid * 16 + i * 8192, R, C); const int Rb = Epi::PERM ? ((R & ~31) + perm32(R & 31)) : R;
        voffA[i] = (unsigned)(R * g.lda + C) * 2u; voffB[i] = (unsigned)(Rb * g.ldb + C) * 2u; }
    const size_t kstep = (size_t)(BK * 2);
    const size_t hstepA = (size_t)HALF * g.lda * 2, hstepB = (size_t)HALF * g.ldb * 2;
    const size_t tstepA = 2 * hstepA, tstepB = 2 * hstepB;
    const unsigned ldsw = (unsigned)wid * 1024u;
    const int aoff = lds_byte(wr * 64 + fr, fq * 8), boff = lds_byte(wc * 32 + fr, fq * 8);

#define PG8_SA(b, h) (((b) * 2 + (h)) * HTB)
#define PG8_SB(b, h) ((4 + (b) * 2 + (h)) * HTB)
#define PG8_STAGE(bufoff, gbase, voff) do { _Pragma("unroll") for (int _i = 0; _i < 2; ++_i) \
        __builtin_amdgcn_global_load_lds((const unsigned*)((const char*)(gbase) + (voff)[_i]), (PG8_LAS unsigned*)(lds + (bufoff) + ldsw + _i * 8192), 16, 0, 0); } while (0)
#define PG8_LDA(dst, b, h) do { _Pragma("unroll") for (int m = 0; m < 4; ++m) { if constexpr (F8) { const v4i_t lo_ = *(const PG8_LAS v4i_t*)(lds + PG8_SA(b, h) + aoff + m * 2048), hi_ = *(const PG8_LAS v4i_t*)(lds + PG8_SA(b, h) + aoff + m * 2048 + 1024); dst##8[m] = __builtin_shufflevector(lo_, hi_, 0, 1, 2, 3, 4, 5, 6, 7); } else { _Pragma("unroll") for (int k = 0; k < 2; ++k) dst[m][k] = *(const PG8_LAS bf16x8*)(lds + PG8_SA(b, h) + aoff + m * 2048 + k * 1024); } } } while (0)
#define PG8_LDB(dst, b, h) do { _Pragma("unroll") for (int n = 0; n < 2; ++n) { if constexpr (F8) { const v4i_t lo_ = *(const PG8_LAS v4i_t*)(lds + PG8_SB(b, h) + boff + n * 2048), hi_ = *(const PG8_LAS v4i_t*)(lds + PG8_SB(b, h) + boff + n * 2048 + 1024); dst##8[n] = __builtin_shufflevector(lo_, hi_, 0, 1, 2, 3, 4, 5, 6, 7); } else { _Pragma("unroll") for (int k = 0; k < 2; ++k) dst[n][k] = *(const PG8_LAS bf16x8*)(lds + PG8_SB(b, h) + boff + n * 2048 + k * 1024); } } } while (0)
#define PG8_MMA(ai, bj, At, Bt) do { __builtin_amdgcn_s_setprio(1); \
        if constexpr (F8) {   \
            asm volatile("s_nop 1\n\t" \
            "v_mfma_scale_f32_16x16x128_f8f6f4 %0, %12, %8, %0, %14, %15 op_sel_hi:[0,0,0]\n\t"  \
            "v_mfma_scale_f32_16x16x128_f8f6f4 %1, %13, %8, %1, %14, %15 op_sel_hi:[0,0,0]\n\t"  \
            "v_mfma_scale_f32_16x16x128_f8f6f4 %2, %12, %9, %2, %14, %15 op_sel_hi:[0,0,0]\n\t"  \
            "v_mfma_scale_f32_16x16x128_f8f6f4 %3, %13, %9, %3, %14, %15 op_sel_hi:[0,0,0]\n\t"  \
            "v_mfma_scale_f32_16x16x128_f8f6f4 %4, %12, %10, %4, %14, %15 op_sel_hi:[0,0,0]\n\t"  \
            "v_mfma_scale_f32_16x16x128_f8f6f4 %5, %13, %10, %5, %14, %15 op_sel_hi:[0,0,0]\n\t"  \
            "v_mfma_scale_f32_16x16x128_f8f6f4 %6, %12, %11, %6, %14, %15 op_sel_hi:[0,0,0]\n\t"  \
            "v_mfma_scale_f32_16x16x128_f8f6f4 %7, %13, %11, %7, %14, %15 op_sel_hi:[0,0,0]\n\t"  \
                : "+v"(acc[ai][bj][0][0]), "+v"(acc[ai][bj][0][1]), "+v"(acc[ai][bj][1][0]), "+v"(acc[ai][bj][1][1]), "+v"(acc[ai][bj][2][0]), "+v"(acc[ai][bj][2][1]), "+v"(acc[ai][bj][3][0]), "+v"(acc[ai][bj][3][1]) \
                : "v"(At##8[0]), "v"(At##8[1]), "v"(At##8[2]), "v"(At##8[3]), "v"(Bt##8[0]), "v"(Bt##8[1]), "v"(sc0), "v"(sc1)); \
        } else if constexpr (F4) { \
            asm volatile("s_nop 1\n\t" \
            "v_mfma_scale_f32_16x16x128_f8f6f4 %0, %16, %8, %0, %20, %21 op_sel_hi:[0,0,0] cbsz:4 blgp:4\n\t"  \
            "v_mfma_scale_f32_16x16x128_f8f6f4 %0, %17, %9, %0, %20, %21 op_sel_hi:[0,0,0] cbsz:4 blgp:4\n\t"  \
            "v_mfma_scale_f32_16x16x128_f8f6f4 %1, %18, %8, %1, %20, %21 op_sel_hi:[0,0,0] cbsz:4 blgp:4\n\t"  \
            "v_mfma_scale_f32_16x16x128_f8f6f4 %1, %19, %9, %1, %20, %21 op_sel_hi:[0,0,0] cbsz:4 blgp:4\n\t"  \
            "v_mfma_scale_f32_16x16x128_f8f6f4 %2, %16, %10, %2, %20, %21 op_sel_hi:[0,0,0] cbsz:4 blgp:4\n\t"  \
            "v_mfma_scale_f32_16x16x128_f8f6f4 %2, %17, %11, %2, %20, %21 op_sel_hi:[0,0,0] cbsz:4 blgp:4\n\t"  \
            "v_mfma_scale_f32_16x16x128_f8f6f4 %3, %18, %10, %3, %20, %21 op_sel_hi:[0,0,0] cbsz:4 blgp:4\n\t"  \
            "v_mfma_scale_f32_16x16x128_f8f6f4 %3, %19, %11, %3, %20, %21 op_sel_hi:[0,0,0] cbsz:4 blgp:4\n\t"  \
            "v_mfma_scale_f32_16x16x128_f8f6f4 %4, %16, %12, %4, %20, %21 op_sel_hi:[0,0,0] cbsz:4 blgp:4\n\t"  \
            "v_mfma_scale_f32_16x16x128_f8f6f4 %4, %17, %13, %4, %20, %21 op_sel_hi:[0,0,0] cbsz:4 blgp:4\n\t"  \
            "v_mfma_scale_f32_16x16x128_f8f6f4 %5, %18, %12, %5, %20, %21 op_sel_hi:[0,0,0] cbsz:4 blgp:4\n\t"  \
            "v_mfma_scale_f32_16x16x128_f8f6f4 %5, %19, %13, %5, %20, %21 op_sel_hi:[0,0,0] cbsz:4 blgp:4\n\t"  \
            "v_mfma_scale_f32_16x16x128_f8f6f4 %6, %16, %14, %6, %20, %21 op_sel_hi:[0,0,0] cbsz:4 blgp:4\n\t"  \
            "v_mfma_scale_f32_16x16x128_f8f6f4 %6, %17, %15, %6, %20, %21 op_sel_hi:[0,0,0] cbsz:4 blgp:4\n\t"  \
            "v_mfma_scale_f32_16x16x128_f8f6f4 %7, %18, %14, %7, %20, %21 op_sel_hi:[0,0,0] cbsz:4 blgp:4\n\t"  \
            "v_mfma_scale_f32_16x16x128_f8f6f4 %7, %19, %15, %7, %20, %21 op_sel_hi:[0,0,0] cbsz:4 blgp:4\n\t"  \
                : "+v"(acc[ai][bj][0][0]), "+v"(acc[ai][bj][0][1]), "+v"(acc[ai][bj][1][0]), "+v"(acc[ai][bj][1][1]), "+v"(acc[ai][bj][2][0]), "+v"(acc[ai][bj][2][1]), "+v"(acc[ai][bj][3][0]), "+v"(acc[ai][bj][3][1]) \
                : "v"(At[0][0]), "v"(At[0][1]), "v"(At[1][0]), "v"(At[1][1]), "v"(At[2][0]), "v"(At[2][1]), "v"(At[3][0]), "v"(At[3][1]), "v"(Bt[0][0]), "v"(Bt[0][1]), "v"(Bt[1][0]), "v"(Bt[1][1]), "v"(sc0), "v"(sc1)); \
        } else { _Pragma("unroll") for (int m = 0; m < 4; ++m) _Pragma("unroll") for (int n = 0; n < 2; ++n) _Pragma("unroll") for (int k = 0; k < 2; ++k) \
            acc[ai][bj][m][n] = __builtin_amdgcn_mfma_f32_16x16x32_bf16(Bt[n][k], At[m][k], acc[ai][bj][m][n], 0, 0, 0); } \
        __builtin_amdgcn_s_setprio(0); } while (0)
#define PG8_WAIT_V(n) asm volatile("s_waitcnt vmcnt(" #n ")" ::: "memory")
#define PG8_WAIT_L(n) asm volatile("s_waitcnt lgkmcnt(" #n ")" ::: "memory")
#define PG8_BAR __builtin_amdgcn_s_barrier()
#define PG8_SCHED __builtin_amdgcn_sched_barrier(0)
    Unit cur, nxt; int ui = 0;
    if (!S.next(0, cur)) return;
    f32x4 acc[2][2][4][2];
#pragma unroll
    for (int a = 0; a < 2; ++a)
#pragma unroll
        for (int b = 0; b < 2; ++b)
#pragma unroll
            for (int m = 0; m < 4; ++m)
#pragma unroll
                for (int n = 0; n < 2; ++n) acc[a][b][m][n] = (f32x4){0.f, 0.f, 0.f, 0.f};
    bf16x8 At[4][2], B0[2][2], B1[2][2];
    typedef int v8i_t __attribute__((ext_vector_type(8))); typedef int v4i_t __attribute__((ext_vector_type(4)));
    v8i_t At8[4], B08[2], B18[2];
    int sc0 = SC0 * 0x01010101, sc1 = SC1 * 0x01010101; asm volatile("" : "+v"(sc0), "+v"(sc1));
    const char* cA = (const char*)g.A + (size_t)cur.pm * tstepA + (size_t)cur.pn * g.apn + (size_t)cur.br * g.abr; const char* cB = (const char*)g.Bt + (size_t)cur.pn * tstepB + (size_t)cur.br * g.bbr;
    S.a_ready(cur);
    if constexpr (SP2) {
        PG8_STAGE(PG8_SB(0, 0), cB, voffB); PG8_STAGE(PG8_SB(0, 1), cB + hstepB, voffB); PG8_STAGE(PG8_SA(0, 0), cA, voffA); PG8_STAGE(PG8_SA(0, 1), cA + hstepA, voffA);
        if (wr == 1) PG8_BAR;
        PG8_WAIT_V(2); PG8_BAR;
        PG8_STAGE(PG8_SB(1, 0), cB + kstep, voffB); PG8_STAGE(PG8_SA(1, 0), cA + kstep, voffA); PG8_STAGE(PG8_SB(1, 1), cB + hstepB + kstep, voffB);
        PG8_WAIT_V(6); PG8_BAR;
    } else {
        PG8_STAGE(PG8_SB(0, 0), cB, voffB); PG8_STAGE(PG8_SA(0, 0), cA, voffA); PG8_STAGE(PG8_SB(0, 1), cB + hstepB, voffB); PG8_STAGE(PG8_SA(0, 1), cA + hstepA, voffA);
        if (wr == 1) PG8_BAR;
        PG8_WAIT_V(4); PG8_BAR;
        PG8_STAGE(PG8_SB(1, 0), cB + kstep, voffB); PG8_STAGE(PG8_SA(1, 0), cA + kstep, voffA); PG8_STAGE(PG8_SB(1, 1), cB + hstepB + kstep, voffB);
        PG8_WAIT_V(6); PG8_BAR;
    }
    for (;;) {
        const bool has_next = S.next(ui + 1, nxt);
        const char* nA = has_next ? (const char*)g.A + (size_t)nxt.pm * tstepA + (size_t)nxt.pn * g.apn + (size_t)nxt.br * g.abr : cA; const char* nB = has_next ? (const char*)g.Bt + (size_t)nxt.pn * tstepB + (size_t)nxt.br * g.bbr : cB;
        for (int t = 0; t < nt; t += 2) {
            const bool last = (t == nt - 2);
            const char* a1 = cA + (size_t)(t + 1) * kstep;
            const char* a2 = last ? nA : cA + (size_t)(t + 2) * kstep; const char* b2 = last ? nB : cB + (size_t)(t + 2) * kstep;
            const char* a3 = a2 + kstep; const char* b3 = b2 + kstep;
            if (last && has_next) S.a_ready(nxt);
            if constexpr (SP2) {
            PG8_LDB(B0, 0, 0); PG8_LDB(B1, 0, 1); PG8_SCHED; PG8_LDA(At, 0, 0); PG8_STAGE(PG8_SA(1, 1), a1 + hstepA, voffA);
            PG8_WAIT_V(8); PG8_WAIT_L(0); PG8_BAR; PG8_MMA(0, 0, At, B0); PG8_MMA(0, 1, At, B1); PG8_BAR; PG8_SCHED;
            PG8_LDA(At, 0, 1); PG8_STAGE(PG8_SB(0, 0), b2, voffB); PG8_STAGE(PG8_SB(0, 1), b2 + hstepB, voffB); PG8_STAGE(PG8_SA(0, 0), a2, voffA);
            PG8_WAIT_V(8); PG8_WAIT_L(0); PG8_BAR; PG8_MMA(1, 0, At, B0); PG8_MMA(1, 1, At, B1); PG8_BAR; PG8_SCHED;
            PG8_LDB(B0, 1, 0); PG8_LDB(B1, 1, 1); PG8_SCHED; PG8_LDA(At, 1, 0); PG8_STAGE(PG8_SA(0, 1), a2 + hstepA, voffA);
            PG8_WAIT_V(8); PG8_WAIT_L(0); PG8_BAR; PG8_MMA(0, 0, At, B0); PG8_MMA(0, 1, At, B1); PG8_BAR; PG8_SCHED;
            PG8_LDA(At, 1, 1); PG8_STAGE(PG8_SB(1, 0), b3, voffB); PG8_STAGE(PG8_SB(1, 1), b3 + hstepB, voffB); PG8_STAGE(PG8_SA(1, 0), a3, voffA);
            PG8_WAIT_V(8); PG8_WAIT_L(0); PG8_BAR; PG8_MMA(1, 0, At, B0); PG8_MMA(1, 1, At, B1); PG8_BAR; PG8_SCHED;
            } else {
            PG8_LDB(B0, 0, 0); PG8_SCHED; PG8_LDA(At, 0, 0); PG8_STAGE(PG8_SA(1, 1), a1 + hstepA, voffA);
            PG8_WAIT_L(8); PG8_BAR; PG8_WAIT_L(0); PG8_MMA(0, 0, At, B0); PG8_BAR; PG8_SCHED;
            PG8_LDB(B1, 0, 1); PG8_STAGE(PG8_SB(0, 0), b2, voffB);
            PG8_BAR; PG8_WAIT_L(0); PG8_MMA(0, 1, At, B1); PG8_BAR;
            PG8_LDA(At, 0, 1); PG8_STAGE(PG8_SA(0, 0), a2, voffA);
            PG8_BAR; PG8_WAIT_L(0); PG8_MMA(1, 0, At, B0); PG8_BAR; PG8_SCHED;
            PG8_STAGE(PG8_SB(0, 1), b2 + hstepB, voffB);
            PG8_WAIT_V(6); PG8_BAR; PG8_MMA(1, 1, At, B1); PG8_BAR;
            PG8_LDB(B0, 1, 0); PG8_SCHED; PG8_LDA(At, 1, 0); PG8_STAGE(PG8_SA(0, 1), a2 + hstepA, voffA);
            PG8_WAIT_L(8); PG8_BAR; PG8_WAIT_L(0); PG8_MMA(0, 0, At, B0); PG8_BAR; PG8_SCHED;
            PG8_LDB(B1, 1, 1); PG8_STAGE(PG8_SB(1, 0), b3, voffB);
            PG8_BAR; PG8_WAIT_L(0); PG8_MMA(0, 1, At, B1); PG8_BAR;
            PG8_LDA(At, 1, 1); PG8_STAGE(PG8_SA(1, 0), a3, voffA);
            PG8_BAR; PG8_WAIT_L(0); PG8_MMA(1, 0, At, B0); PG8_BAR; PG8_SCHED;
            PG8_STAGE(PG8_SB(1, 1), b3 + hstepB, voffB);
            PG8_WAIT_V(6); PG8_BAR; PG8_MMA(1, 1, At, B1); PG8_BAR;
            }
        }
        if constexpr (F8 || F4) {
#pragma unroll
            for (int a_ = 0; a_ < 2; ++a_) asm volatile("s_nop 15\n\ts_nop 7" : "+v"(acc[a_][0][0][0]), "+v"(acc[a_][0][0][1]), "+v"(acc[a_][0][1][0]), "+v"(acc[a_][0][1][1]), "+v"(acc[a_][0][2][0]), "+v"(acc[a_][0][2][1]), "+v"(acc[a_][0][3][0]), "+v"(acc[a_][0][3][1]),
                "+v"(acc[a_][1][0][0]), "+v"(acc[a_][1][0][1]), "+v"(acc[a_][1][1][0]), "+v"(acc[a_][1][1][1]), "+v"(acc[a_][1][2][0]), "+v"(acc[a_][1][2][1]), "+v"(acc[a_][1][3][0]), "+v"(acc[a_][1][3][1]));
        }
        if constexpr (ALIGN_EPI) { if (wr == 0) PG8_BAR; }
        bool chain_keep = false;
        if constexpr (Epi::CHAIN) { if (cur.br + 1 == Epi::NBR) E(acc, cur, wr, wc, fr, fq); E.rescale(acc, cur, wr, wc, fr, fq); chain_keep = true; }
        if constexpr (!Epi::AFTER_DRAIN && !Epi::CHAIN) { E(acc, cur, wr, wc, fr, fq); S.done(cur); }
        if (!has_next) break;
        if (!chain_keep) {
#pragma unroll
        for (int a = 0; a < 2; ++a)
#pragma unroll
            for (int b = 0; b < 2; ++b)
#pragma unroll
                for (int m = 0; m < 4; ++m)
#pragma unroll
                    for (int n = 0; n < 2; ++n) acc[a][b][m][n] = (f32x4){0.f, 0.f, 0.f, 0.f};
        }
        cur = nxt; cA = nA; cB = nB; ++ui;
        if constexpr (ALIGN_EPI) { if (wr == 1) PG8_BAR; }
    }
    PG8_WAIT_V(0);
    if constexpr (!ALIGN_EPI) { if (wr == 0) PG8_BAR; }
    PG8_BAR;
    if constexpr (Epi::AFTER_DRAIN) { E.fused(acc, cur, wr, wc, fr, fq, lds, wid, lane); S.done(cur); }
#undef PG8_SA
#undef PG8_SB
#undef PG8_STAGE
#undef PG8_LDA
#undef PG8_LDB
#undef PG8_MMA
#undef PG8_WAIT_V
#undef PG8_WAIT_L
#undef PG8_BAR
#undef PG8_SCHED
}
}

constexpr int S = 16384, DM = 2048, NL = 2, NWAVES = 8;
constexpr int HW = 3584;
constexpr int H_AQ = 0, H_AK = 512, H_BQ = 1024, H_BK = 1536, H_CQ = 1664, H_CK = 2176, H_DCQ = 2688, H_DCKV = 3200, H_DKR = 3456;
constexpr int VT_A = 0, VT_B = 512, VT_C = 640, VT_ROWS = 1280;
constexpr int WIN_ROWS = HW + VT_ROWS;
constexpr float LOG2E = 1.4426950408889634f;
constexpr float DN_ALPHA = 1.4142135623730951f;
constexpr size_t MiB = 1u << 20;
constexpr size_t WS_CTL = 0, CTL_ZERO_BYTES = 1 * MiB;
constexpr size_t WS_W = 1 * MiB, WL_STRIDE = 78 * MiB;
constexpr size_t W_IN = 0, W_G = 19 * MiB, W_BR = 51 * MiB, W_O = 59 * MiB, W_UQ = 67 * MiB, W_UKV = 68 * MiB, W_PQ = 69 * MiB, W_SK = 77 * MiB;
constexpr size_t WS_UB = 157 * MiB, WS_VB = 221 * MiB;
constexpr size_t WS_MLIST = 189 * MiB;
constexpr int MCAP_F = 16384, MCAP = MCAP_F + 4096;
constexpr size_t WS_PART = 926 * MiB;
constexpr size_t WS_CS = 245 * MiB;
constexpr size_t WS_XB8 = 253 * MiB;
constexpr size_t WS_XB = 285 * MiB;
constexpr size_t WS_H = 349 * MiB;
constexpr size_t WS_VT = 461 * MiB;
constexpr size_t WS_GT = 501 * MiB;
constexpr size_t WS_O8 = 629 * MiB;
constexpr size_t WS_XB4 = 661 * MiB;
constexpr size_t WS_O = 757 * MiB;
constexpr size_t WS_QD = 821 * MiB, WS_KD = 845 * MiB, WS_VDT = 869 * MiB, WS_CQN = 885 * MiB, WS_CKVN = 901 * MiB;
constexpr size_t WS_SELE = 909 * MiB, WS_SELG = 917 * MiB, WS_KMEAN = 925 * MiB, WS_TPMAX = 925 * MiB + 512 * 1024, WS_OC2 = 994 * MiB, WS_END = 1010 * MiB;
constexpr int CW_BAR = 4096, CW_Q = 16384, CW_CHK = 20480, CW_MOBA = 24576;
constexpr int RING_BYTES = 131072;
constexpr int MISC_OFF = RING_BYTES;
constexpr int TR_OFF = 0;
constexpr int LDS_BYTES = 147456;

constexpr float U_SCALE = 90.0f, V_SCALE = 4.0f;
#define XB_TMO      128
#define XB_XCNT(j)  (256  + 64 * (j))
#define XB_XSUB(j)  (1280 + 64 * (j))
#define XB_XGEN(j)  (2304 + 64 * (j))
#define XB_TOP      3328
#define XB_TOPGEN   3392
#define XCD_BAR_WORDS 3456
#define XB_SPIN_CAP (1u << 18)

__device__ __forceinline__ unsigned xb_ld(unsigned* p)              { return __hip_atomic_load(p, __ATOMIC_RELAXED, __HIP_MEMORY_SCOPE_AGENT); }
__device__ __forceinline__ unsigned xb_add(unsigned* p, unsigned v) { return __hip_atomic_fetch_add(p, v, __ATOMIC_RELAXED, __HIP_MEMORY_SCOPE_AGENT); }
__device__ __forceinline__ unsigned xb_xcc_id() { return (unsigned)__builtin_amdgcn_s_getreg((3 << 11) | 20) & 0xFu; }
#define XB_SPIN(cond, bar) do { unsigned _sp = 0; while (cond) { __builtin_amdgcn_s_sleep(1); \
    if ((++_sp & 255u) == 0u) { if (xb_ld(&(bar)[XB_TMO])) break; if (_sp > XB_SPIN_CAP) { atomicAdd(&(bar)[XB_TMO], 1u); break; } } } } while (0)

struct XcdBarrier {
    unsigned* bar; unsigned x;
    volatile LAS unsigned* st;
};

__device__ __forceinline__ XcdBarrier xcd_barrier_post(unsigned* bar, volatile LAS unsigned* st) {
    XcdBarrier b; b.bar = bar; b.x = xb_xcc_id(); b.st = st;
    if (threadIdx.x == 0) (void)xb_add(&bar[XB_XCNT(b.x)], 1u);
    return b;
}
__device__ __forceinline__ void xcd_barrier_complete(unsigned* bar, unsigned x, unsigned& nloc, unsigned& nx) {
    const unsigned G = gridDim.x * gridDim.y * gridDim.z;
    unsigned sum, cnt, mine, sp = 0u;
    for (;;) {
        sum = 0u; cnt = 0u; mine = 0u;
#pragma unroll
        for (unsigned j = 0; j < 16; ++j) { const unsigned c = xb_ld(&bar[XB_XCNT(j)]); sum += c; cnt += (c > 0u) ? 1u : 0u; mine = (j == x) ? c : mine; }
        if (sum == G) break;
        __builtin_amdgcn_s_sleep(1);
        if ((++sp & 255u) == 0u) { if (xb_ld(&bar[XB_TMO])) break; if (sp > XB_SPIN_CAP) { atomicAdd(&bar[XB_TMO], 1u); break; } }
    }
    nloc = mine > 0u ? mine : 1u; nx = cnt > 0u ? cnt : 1u;
}

__device__ __forceinline__ void xcd_barrier(const XcdBarrier& b) {
    asm volatile("s_waitcnt vmcnt(0)" ::: "memory");
    __syncthreads();
    if (threadIdx.x == 0) {
        unsigned* bar = b.bar;
        __builtin_amdgcn_s_waitcnt(0);
        unsigned nloc = b.st[0], nx = b.st[1];
        if (nloc == 0u) { xcd_barrier_complete(bar, b.x, nloc, nx); b.st[0] = nloc; b.st[1] = nx; }
        const unsigned old = xb_add(&bar[XB_XSUB(b.x)], 1u);
        const unsigned gen = old / nloc;
        if (old + 1u == (gen + 1u) * nloc) {
            __builtin_amdgcn_fence(__ATOMIC_RELEASE, "agent");
            asm volatile("s_waitcnt vmcnt(0)" ::: "memory");
            const unsigned og = xb_add(&bar[XB_TOP], 1u);
            const unsigned tg = og / nx;
            if (og + 1u == (tg + 1u) * nx) xb_add(&bar[XB_TOPGEN], 1u);
            else XB_SPIN(xb_ld(&bar[XB_TOPGEN]) == tg, bar);
            __builtin_amdgcn_fence(__ATOMIC_ACQUIRE, "agent");
            xb_add(&bar[XB_XGEN(b.x)], 1u);
            asm volatile("s_waitcnt vmcnt(0)" ::: "memory");
        } else {
            XB_SPIN(xb_ld(&bar[XB_XGEN(b.x)]) == gen, bar);
            __builtin_amdgcn_fence(__ATOMIC_ACQUIRE, "agent");
            asm volatile("s_waitcnt vmcnt(0)" ::: "memory");
        }
    }
    __syncthreads();
}

struct Args { const float* in[26]; float* out; unsigned char* ws; int ph_lo, ph_hi; };
struct Frame {
    LAS unsigned char* lds; volatile LAS unsigned* MISC;
    int tid, lane, wave, vcu, G;
    unsigned char* ws; float* out;
};
DI bf16_t* wsb(const Frame& F, size_t off) { return (bf16_t*)(F.ws + off); }

DI void transpose_item(const float* W, int ldw, bf16_t* WT, int ldt, int k0, int n0, int drow0, LAS float* scr, int lane) {
#pragma unroll 8
    for (int i = 0; i < 32; ++i) { const int kk = 2 * i + (lane >> 5); scr[kk * 33 + (lane & 31)] = W[(size_t)(k0 + kk) * ldw + n0 + (lane & 31)]; }
    asm volatile("s_waitcnt lgkmcnt(0)" ::: "memory");
    const int c = lane & 7;
#pragma unroll
    for (int j = 0; j < 4; ++j) { const int n = (lane >> 3) + 8 * j; const LAS float* s = scr + (8 * c) * 33 + n;
        u32x4 o; o.x = cvtpk(s[0 * 33], s[1 * 33]); o.y = cvtpk(s[2 * 33], s[3 * 33]); o.z = cvtpk(s[4 * 33], s[5 * 33]); o.w = cvtpk(s[6 * 33], s[7 * 33]);
        *(u32x4*)(WT + (size_t)(drow0 + n) * ldt + k0 + 8 * c) = o; }
    asm volatile("s_waitcnt lgkmcnt(0)" ::: "memory");
}
DI void transpose_item8(const float* W, int ldw, unsigned char* WT, int ldt, int k0, int n0, int drow0, LAS float* scr, int lane, float scale) {
#pragma unroll 8
    for (int i = 0; i < 32; ++i) { const int kk = 2 * i + (lane >> 5); scr[kk * 33 + (lane & 31)] = W[(size_t)(k0 + kk) * ldw + n0 + (lane & 31)]; }
    asm volatile("s_waitcnt lgkmcnt(0)" ::: "memory");
    const int c = lane & 7;
#pragma unroll
    for (int j = 0; j < 4; ++j) { const int n = (lane >> 3) + 8 * j; const LAS float* s = scr + (8 * c) * 33 + n;
        int lo = __builtin_amdgcn_cvt_pk_fp8_f32(s[0 * 33] * scale, s[1 * 33] * scale, 0, false); lo = __builtin_amdgcn_cvt_pk_fp8_f32(s[2 * 33] * scale, s[3 * 33] * scale, lo, true);
        int hi = __builtin_amdgcn_cvt_pk_fp8_f32(s[4 * 33] * scale, s[5 * 33] * scale, 0, false); hi = __builtin_amdgcn_cvt_pk_fp8_f32(s[6 * 33] * scale, s[7 * 33] * scale, hi, true);
        *(u32x2*)(WT + (size_t)(drow0 + n) * ldt + k0 + 8 * c) = (u32x2){(unsigned)lo, (unsigned)hi}; }
    asm volatile("s_waitcnt lgkmcnt(0)" ::: "memory");
}
DI void transpose_item4(const float* W, int ldw, unsigned char* WT, int ldt, int k0, int n0, int drow0, LAS float* scr, int lane, float scale) {
#pragma unroll 8
    for (int i = 0; i < 32; ++i) { const int kk = 2 * i + (lane >> 5); scr[kk * 33 + (lane & 31)] = W[(size_t)(k0 + kk) * ldw + n0 + (lane & 31)]; }
    asm volatile("s_waitcnt lgkmcnt(0)" ::: "memory");
    const int c = lane & 7;
#pragma unroll
    for (int j = 0; j < 4; ++j) { const int n = (lane >> 3) + 8 * j; const LAS float* s = scr + (8 * c) * 33 + n;
        unsigned d = 0u;
        d = __builtin_amdgcn_cvt_scalef32_pk_fp4_f32(d, s[0 * 33] * scale, s[1 * 33] * scale, 1.0f, 0); d = __builtin_amdgcn_cvt_scalef32_pk_fp4_f32(d, s[2 * 33] * scale, s[3 * 33] * scale, 1.0f, 1);
        d = __builtin_amdgcn_cvt_scalef32_pk_fp4_f32(d, s[4 * 33] * scale, s[5 * 33] * scale, 1.0f, 2); d = __builtin_amdgcn_cvt_scalef32_pk_fp4_f32(d, s[6 * 33] * scale, s[7 * 33] * scale, 1.0f, 3);
        *(unsigned*)(WT + (size_t)(drow0 + n) * ldt + (k0 >> 1) + 4 * c) = d; }
    asm volatile("s_waitcnt lgkmcnt(0)" ::: "memory");
}
DI int win_map(int c) {
    if (c < 1024) return c;
    if (c < 1536) return HW + VT_A + (c - 1024);
    if (c < 2176) return H_BQ + (c - 1536);
    if (c < 2304) return HW + VT_B + (c - 2176);
    if (c < 3328) return H_CQ + (c - 2304);
    if (c < 3840) return HW + VT_C + (c - 3328);
    return H_DCQ + (c - 3840);
}
template <int MAP, bool F8 = false, bool F4 = false> DI void transpose_matrix(const Frame& F, const float* W, int K, int N, bf16_t* WT, int roff) {
    LAS float* scr = (LAS float*)(F.lds + TR_OFF + F.wave * 8704);
    const int gw = F.vcu * NWAVES + F.wave, NGW = F.G * NWAVES, nblk = N / 32, items = (K / 64) * nblk;
    int lane = F.lane; asm volatile("" : "+v"(lane));
    for (int it = gw; it < items; it += NGW) {
        const int kb = it / nblk, nb = it % nblk, n0 = 32 * nb;
        int drow = roff + n0;
        if (MAP == 1) drow = win_map(n0);
        if (MAP == 2) { const int h = n0 >> 8, j = n0 & 255; drow = (j < 128) ? h * 128 + j : 512 + h * 128 + (j - 128); }
        if (F4) transpose_item4(W, N, (unsigned char*)WT, K / 2, 64 * kb, n0, drow, scr, lane, 64.0f); else if (F8) transpose_item8(W, N, (unsigned char*)WT, K, 64 * kb, n0, drow, scr, lane, 64.0f); else transpose_item(W, N, WT, K, 64 * kb, n0, drow, scr, lane);
    }
}
DI void convert_bf16(const Frame& F, const float* src, bf16_t* dst, size_t n) {
    const size_t nth = (size_t)F.G * 512, t0 = (size_t)F.vcu * 512 + F.tid;
    for (size_t i = t0; i < n / 8; i += nth) { const f32x4 a = *(const f32x4*)(src + 8 * i), b = *(const f32x4*)(src + 8 * i + 4);
        u32x4 w; w.x = cvtpk(a[0], a[1]); w.y = cvtpk(a[2], a[3]); w.z = cvtpk(b[0], b[1]); w.w = cvtpk(b[2], b[3]); *(u32x4*)(dst + 8 * i) = w; }
}

typedef float v16f __attribute__((ext_vector_type(16)));
typedef float v32f __attribute__((ext_vector_type(32)));
typedef unsigned v6u __attribute__((ext_vector_type(6)));
DI void convert_fp6(const Frame& F, const float* src, unsigned char* dst, int rows, float scale) {
    const size_t nth = (size_t)F.G * 512, t0 = (size_t)F.vcu * 512 + F.tid;
    for (size_t i = t0; i < (size_t)rows * 64; i += nth) {
        const size_t row = i >> 6; const int l = (int)(i & 63);
        const float* p = src + row * 2048 + 32 * l;
        v16f a, b;
#pragma unroll
        for (int q = 0; q < 8; ++q) { const f32x4 x = *(const f32x4*)(p + 4 * q) * scale;
            a[2 * q] = x[0]; b[2 * q] = x[1]; a[2 * q + 1] = x[2]; b[2 * q + 1] = x[3]; }
        const v6u w = __builtin_amdgcn_cvt_scalef32_2xpk16_fp6_f32(a, b, 1.0f);
        *(u32x4*)(dst + row * 1536 + 16 * l) = (u32x4){w[0], w[1], w[2], w[3]};
        *(u32x2*)(dst + row * 1536 + 1024 + 8 * l) = (u32x2){w[4], w[5]};
    }
}

DI void convert_fp4(const Frame& F, const float* src, unsigned char* dst, int rows, float scale) {
    const size_t nth = (size_t)F.G * 512, t0 = (size_t)F.vcu * 512 + F.tid;
    for (size_t i = t0; i < (size_t)rows * 64; i += nth) {
        const float* p = src + i * 32;
        u32x4 w = (u32x4){0u, 0u, 0u, 0u};
#define FP4_PK(q) { const f32x4 x = *(const f32x4*)(p + 4 * (q)) * scale; unsigned d = w[(q) >> 1];         \
            d = __builtin_amdgcn_cvt_scalef32_pk_fp4_f32(d, x[0], x[1], 1.0f, (2 * (q)) & 3); d = __builtin_amdgcn_cvt_scalef32_pk_fp4_f32(d, x[2], x[3], 1.0f, (2 * (q) + 1) & 3); w[(q) >> 1] = d; }
        FP4_PK(0) FP4_PK(1) FP4_PK(2) FP4_PK(3) FP4_PK(4) FP4_PK(5) FP4_PK(6) FP4_PK(7)
#undef FP4_PK
        *(u32x4*)(dst + i * 16) = w;
    }
}

DI void convert_weights(const Frame& F, const Args& a, int l_lo, int l_hi) {
    for (int l = l_lo; l < l_hi; ++l) {
        unsigned char* wl = F.ws + WS_W + (size_t)l * WL_STRIDE;
        transpose_matrix<1, true>(F, a.in[3] + (size_t)l * DM * 4672, DM, 4672, (bf16_t*)(wl + W_IN), 0);
        for (int n = 0; n < 4; ++n) transpose_matrix<0, false, true>(F, a.in[4] + ((size_t)l * 4 + n) * DM * DM, DM, DM, (bf16_t*)(wl + W_G), n * DM);
        for (int n = 0; n < 4; ++n) transpose_matrix<0, true>(F, a.in[6] + ((size_t)l * 4 + n) * 512 * DM, 512, DM, (bf16_t*)(wl + W_BR) + (size_t)n * DM * 512, 0);
        transpose_matrix<0, true>(F, a.in[7] + (size_t)l * DM * DM, DM, DM, (bf16_t*)(wl + W_O), 0);
        transpose_matrix<0>(F, a.in[16] + (size_t)l * 512 * 768, 512, 768, (bf16_t*)(wl + W_UQ), 0);
        transpose_matrix<2>(F, a.in[17] + (size_t)l * 256 * 1024, 256, 1024, (bf16_t*)(wl + W_UKV), 0);
        transpose_matrix<0>(F, a.in[20] + (size_t)l * DM * DM, DM, DM, (bf16_t*)(wl + W_PQ), 0);
        convert_bf16(F, a.in[21] + (size_t)l * 8 * 2 * 128 * 128, (bf16_t*)(wl + W_SK), (size_t)8 * 2 * 128 * 128);
    }
}
DI void build_rope_table(const Frame& F, const Args& a) {
    f32x2* CS = (f32x2*)(F.ws + WS_CS); const int* pos = (const int*)a.in[1];
    for (size_t i = (size_t)F.vcu * 512 + F.tid; i < (size_t)S * 32; i += (size_t)F.G * 512) {
        const int j = (int)(i & 31); const float inv = exp2f(-(float)j * (13.287712379549449f / 32.0f));
        const float ang = (float)pos[i >> 5] * inv;
        CS[i] = (f32x2){cosf(ang), sinf(ang)};
    }
}
DI void phase_prologue(const Frame& F, const Args& a) {
    convert_weights(F, a, 0, 1);
    convert_bf16(F, a.in[0], wsb(F, WS_XB), (size_t)S * DM);
    {
        const size_t nth = (size_t)F.G * 512, t0 = (size_t)F.vcu * 512 + F.tid; const float* src = a.in[0]; unsigned char* dst = F.ws + WS_XB4;
        for (size_t i = t0; i < (size_t)S * DM / 8; i += nth) { const f32x4 x = *(const f32x4*)(src + 8 * i) * 2.0f, y = *(const f32x4*)(src + 8 * i + 4) * 2.0f;
            unsigned d = 0u; d = __builtin_amdgcn_cvt_scalef32_pk_fp4_f32(d, x[0], x[1], 1.0f, 0); d = __builtin_amdgcn_cvt_scalef32_pk_fp4_f32(d, x[2], x[3], 1.0f, 1); d = __builtin_amdgcn_cvt_scalef32_pk_fp4_f32(d, y[0], y[1], 1.0f, 2); d = __builtin_amdgcn_cvt_scalef32_pk_fp4_f32(d, y[2], y[3], 1.0f, 3);
            *(unsigned*)(dst + 4 * i) = d; }
    }
    {
        const size_t nth = (size_t)F.G * 512, t0 = (size_t)F.vcu * 512 + F.tid; const float* src = a.in[0]; unsigned char* dst = F.ws + WS_XB8;
        for (size_t i = t0; i < (size_t)S * DM / 8; i += nth) { const f32x4 x = *(const f32x4*)(src + 8 * i), y = *(const f32x4*)(src + 8 * i + 4);
            int lo = __builtin_amdgcn_cvt_pk_fp8_f32(x[0], x[1], 0, false); lo = __builtin_amdgcn_cvt_pk_fp8_f32(x[2], x[3], lo, true); int hi = __builtin_amdgcn_cvt_pk_fp8_f32(y[0], y[1], 0, false); hi = __builtin_amdgcn_cvt_pk_fp8_f32(y[2], y[3], hi, true);
            *(u32x2*)(dst + 8 * i) = (u32x2){(unsigned)lo, (unsigned)hi}; }
    }
    build_rope_table(F, a);
}

DI float rope64(float x, int lane, const f32x2* cs_row) {
    const float other = xhalf(x);
    const f32x2 cs = cs_row[lane & 31];
    return (lane < 32) ? x * cs.x - other * cs.y : other * cs.y + x * cs.x;
}
DI void phase_prep(const Frame& F, const Args& a, int layer) {
    const bf16_t* H = wsb(F, WS_H); bf16_t* CQN = wsb(F, WS_CQN); bf16_t* CKVN = wsb(F, WS_CKVN); bf16_t* KD = wsb(F, WS_KD);
    const float* gq = a.in[14] + layer * 512; const float* gkv = a.in[15] + layer * 256; const int* pos = (const int*)a.in[1];
    const int gw = F.vcu * NWAVES + F.wave, NGW = F.G * NWAVES, lane = F.lane;
    for (int t = gw; t < S; t += NGW) {
        const bf16_t* hr = H + (size_t)t * HW;
        const u32x4 q = *(const u32x4*)(hr + H_DCQ + 8 * lane);
        float v[8] = {bf_lo(q.x), bf_hi(q.x), bf_lo(q.y), bf_hi(q.y), bf_lo(q.z), bf_hi(q.z), bf_lo(q.w), bf_hi(q.w)};
        float ss = 0.f;
#pragma unroll
        for (int e = 0; e < 8; ++e) ss += v[e] * v[e];
        const float rq = rsqrtf(wave_sum(ss) * (1.0f / 512.0f) + 1e-6f);
        const f32x4 g0 = *(const f32x4*)(gq + 8 * lane), g1 = *(const f32x4*)(gq + 8 * lane + 4);
        u32x4 w; w.x = cvtpk(v[0] * rq * g0[0], v[1] * rq * g0[1]); w.y = cvtpk(v[2] * rq * g0[2], v[3] * rq * g0[3]); w.z = cvtpk(v[4] * rq * g1[0], v[5] * rq * g1[1]); w.w = cvtpk(v[6] * rq * g1[2], v[7] * rq * g1[3]);
        *(u32x4*)(CQN + (size_t)t * 512 + 8 * lane) = w;
        const u32x2 k2 = *(const u32x2*)(hr + H_DCKV + 4 * lane);
        const float u0 = bf_lo(k2.x), u1 = bf_hi(k2.x), u2 = bf_lo(k2.y), u3 = bf_hi(k2.y);
        const float rk = rsqrtf(wave_sum(u0 * u0 + u1 * u1 + u2 * u2 + u3 * u3) * (1.0f / 256.0f) + 1e-6f);
        const f32x4 gk = *(const f32x4*)(gkv + 4 * lane);
        u32x2 w2; w2.x = cvtpk(u0 * rk * gk[0], u1 * rk * gk[1]); w2.y = cvtpk(u2 * rk * gk[2], u3 * rk * gk[3]);
        *(u32x2*)(CKVN + (size_t)t * 256 + 4 * lane) = w2;
        const float kr = bf1(hr[H_DKR + lane]);
        const float ro = rope64(kr, lane, (const f32x2*)(F.ws + WS_CS) + (size_t)t * 32);
        const bf16_t rb = (bf16_t)(cvtpk(ro, 0.f) & 0xffffu);
#pragma unroll
        for (int h = 0; h < 4; ++h) KD[(size_t)t * 768 + h * 192 + 128 + lane] = rb;
    }
    for (int t = gw; t < S / 64; t += NGW) { int pm = pos[t * 64 + lane];
#pragma unroll
        for (int o = 1; o < 64; o <<= 1) { const int other = __shfl_xor(pm, o); pm = other > pm ? other : pm; }
        if (lane == 0) ((int*)(F.ws + WS_TPMAX))[t] = pm; }
    float* KM = (float*)(F.ws + WS_KMEAN);
    for (int it = gw; it < 64 * 8; it += NGW) {
        const int n = it >> 3, cc = it & 7; const bf16_t* p = H + (size_t)(n * 256) * HW + H_AK + cc * 64 + lane;
        float s0 = 0.f, s1 = 0.f, s2 = 0.f, s3 = 0.f;
        for (int r = 0; r < 256; r += 4) { s0 += bf1(p[(size_t)r * HW]); s1 += bf1(p[(size_t)(r + 1) * HW]); s2 += bf1(p[(size_t)(r + 2) * HW]); s3 += bf1(p[(size_t)(r + 3) * HW]); }
        KM[n * 512 + cc * 64 + lane] = ((s0 + s1) + (s2 + s3)) * (1.0f / 256.0f);
    }
}
DI void phase_ropeq(const Frame& F, const Args& a) {
    bf16_t* QD = wsb(F, WS_QD); const int* pos = (const int*)a.in[1];
    const int gw = F.vcu * NWAVES + F.wave, NGW = F.G * NWAVES, lane = F.lane;
    for (int t = gw; t < S; t += NGW) {
        const f32x2* cs = (const f32x2*)(F.ws + WS_CS) + (size_t)t * 32;
#pragma unroll
        for (int h = 0; h < 4; ++h) { bf16_t* p = QD + (size_t)t * 768 + h * 192 + 128 + lane; const float ro = rope64(bf1(*p), lane, cs); *p = (bf16_t)(cvtpk(ro, 0.f) & 0xffffu); }
    }
}
DI void phase_moba_select(const Frame& F, const Args& a, int layer) {
    const bf16_t* H = wsb(F, WS_H); const float* KM = (const float*)(F.ws + WS_KMEAN); const int* pos = (const int*)a.in[1]; const int* TP = (const int*)(F.ws + WS_TPMAX);
    unsigned* cnt = (unsigned*)(F.ws + WS_CTL) + CW_MOBA + layer * 1024; int* lists = (int*)(F.ws + WS_MLIST);
    const int gw = F.vcu * NWAVES + F.wave, NGW = F.G * NWAVES;
    int lane = F.lane; asm volatile("" : "+v"(lane));
    const int r = lane & 31, hi = lane >> 5;
    for (int it = gw; it < (S / 32) * 4; it += NGW) {
        const int h = it & 3, q0 = (it >> 2) * 32, q = q0 + r, own = q0 >> 8;
        if (own == 0) continue;
        const bf16_t* qp = H + (size_t)q * HW + H_AQ + h * 128 + hi * 8;
        const bool two = own > 32;
        f32x16 g0, g1;
#pragma unroll
        for (int i = 0; i < 16; ++i) { g0[i] = 0.f; g1[i] = 0.f; }
#pragma unroll
        for (int kk = 0; kk < 8; ++kk) {
            const bf16x8 qf = *(const bf16x8*)(qp + kk * 16);
#pragma unroll
            for (int rb = 0; rb < 2; ++rb) {
                if (rb == 1 && !two) continue;
                const float* kp = KM + (size_t)(rb * 32 + r) * 512 + h * 128 + kk * 16 + hi * 8;
                const f32x4 x = *(const f32x4*)kp, y = *(const f32x4*)(kp + 4);
                u32x4 wh, wl;
                wh.x = cvtpk(x[0], x[1]); wh.y = cvtpk(x[2], x[3]); wh.z = cvtpk(y[0], y[1]); wh.w = cvtpk(y[2], y[3]);
                wl.x = cvtpk(x[0] - bf_lo(wh.x), x[1] - bf_hi(wh.x)); wl.y = cvtpk(x[2] - bf_lo(wh.y), x[3] - bf_hi(wh.y)); wl.z = cvtpk(y[0] - bf_lo(wh.z), y[1] - bf_hi(wh.z)); wl.w = cvtpk(y[2] - bf_lo(wh.w), y[3] - bf_hi(wh.w));
                if (rb == 0) { g0 = __builtin_amdgcn_mfma_f32_32x32x16_bf16(__builtin_bit_cast(bf16x8, wh), qf, g0, 0, 0, 0); g0 = __builtin_amdgcn_mfma_f32_32x32x16_bf16(__builtin_bit_cast(bf16x8, wl), qf, g0, 0, 0, 0); }
                else { g1 = __builtin_amdgcn_mfma_f32_32x32x16_bf16(__builtin_bit_cast(bf16x8, wh), qf, g1, 0, 0, 0); g1 = __builtin_amdgcn_mfma_f32_32x32x16_bf16(__builtin_bit_cast(bf16x8, wl), qf, g1, 0, 0, 0); }
            }
        }
        float v1 = -INFINITY, v2 = -INFINITY, v3 = -INFINITY; int i1 = -1, i2 = -1, i3 = -1;
#pragma unroll
        for (int rb = 0; rb < 2; ++rb)
#pragma unroll
            for (int i = 0; i < 16; ++i) {
                const int n = rb * 32 + (i & 3) + 8 * (i >> 2) + 4 * hi; const float g = (rb == 0) ? g0[i] : g1[i];
                if (n < own) {
                    if (g > v1) { v3 = v2; i3 = i2; v2 = v1; i2 = i1; v1 = g; i1 = n; }
                    else if (g > v2) { v3 = v2; i3 = i2; v2 = g; i2 = n; }
                    else if (g > v3) { v3 = g; i3 = n; }
                }
            }
        const float p1 = xhalf(v1), p2 = xhalf(v2), p3 = xhalf(v3);
        const int j1 = __shfl_xor(i1, 32), j2 = __shfl_xor(i2, 32), j3 = __shfl_xor(i3, 32);
#pragma unroll
        for (int c = 0; c < 3; ++c) { const float g = c == 0 ? p1 : (c == 1 ? p2 : p3); const int n = c == 0 ? j1 : (c == 1 ? j2 : j3);
            if (n >= 0) {
                if (g > v1 || (g == v1 && n < i1)) { v3 = v2; i3 = i2; v2 = v1; i2 = i1; v1 = g; i1 = n; }
                else if (g > v2 || (g == v2 && n < i2)) { v3 = v2; i3 = i2; v2 = g; i2 = n; }
                else if (g > v3 || (g == v3 && n < i3)) { v3 = g; i3 = n; }
            } }
        if (hi == 0) {
            const int pq = pos[q];
#pragma unroll
            for (int sl = 0; sl < 3; ++sl) { const int n = sl == 0 ? i1 : (sl == 1 ? i2 : i3);
                if (n >= 0) { const int bm = max(max(TP[4 * n], TP[4 * n + 1]), max(TP[4 * n + 2], TP[4 * n + 3])); const int near = (pq - bm < 790) ? 1 : 0;
                    const unsigned p = atomicAdd(cnt + near * 256 + h * 64 + n, 1u);
                    if (p < (unsigned)(near ? MCAP - MCAP_F : MCAP_F)) lists[(size_t)(h * 64 + n) * MCAP + (near ? MCAP_F : 0) + p] = q * 4 + sl; } }
        }
    }
}
DI void phase_mixer_combine(const Frame& F, const Args& a, int layer) {
    const unsigned char* PART = F.ws + WS_PART; bf16_t* OA = wsb(F, WS_O);
    const int gw = F.vcu * NWAVES + F.wave, NGW = F.G * NWAVES, lane = F.lane;
    for (int it = gw; it < S * 4; it += NGW) {
        const int q = it >> 2, h = it & 3, nsel = (q >> 8) < 3 ? (q >> 8) : 3;
        const unsigned char* pp = PART + ((size_t)q * 16 + h * 4) * 272;
        float mm[4], ll[4]; unsigned ov[4];
#pragma unroll
        for (int s = 0; s < 4; ++s) { const bool use = (s == 3) || (s < nsel); const f32x2 ml = *(const f32x2*)(pp + s * 272 + 256); mm[s] = use ? ml.x : -1e30f; ll[s] = use ? ml.y : 0.f; ov[s] = *(const unsigned*)(pp + s * 272 + lane * 4); }
        const float M = fmaxf(fmaxf(mm[0], mm[1]), fmaxf(mm[2], mm[3]));
        float wsum = 0.f, x0 = 0.f, x1 = 0.f;
#pragma unroll
        for (int s = 0; s < 4; ++s) { const float w = ll[s] * ex2(mm[s] - M); wsum += w; x0 += w * bf_lo(ov[s]); x1 += w * bf_hi(ov[s]); }
        const float inv = 1.0f / wsum;
#if defined(MK_CHECK) && MK_CHECK
        *(unsigned*)(OA + (size_t)q * 512 + h * 128 + lane * 2) = cvtpk(x0 * inv, x1 * inv);
#endif
        *(unsigned short*)(F.ws + WS_O8 + (size_t)q * 512 + h * 128 + lane * 2) = (unsigned short)__builtin_amdgcn_cvt_pk_fp8_f32(x0 * inv * 8.0f, x1 * inv * 8.0f, 0, false);
    }
    float d1 = 0.f, d2 = 0.f;
    for (int i = 0; i < 64; ++i) { d1 += a.in[9][layer * 64 + i] * a.in[10][layer * 64 + i]; d2 += a.in[11][layer * 64 + i] * a.in[12][layer * 64 + i]; }
    const float lambda_init = 0.8f - 0.6f * expf(-0.3f * (float)layer), lam = expf(d1) - expf(d2) + lambda_init;
    bf16_t* OC = wsb(F, WS_O) + (size_t)2 * S * 512; const bf16_t* OC2 = wsb(F, WS_OC2);
    const f32x2 sg = *(const f32x2*)(a.in[13] + layer * 128 + lane * 2);
    for (int it = gw; it < S * 4; it += NGW) {
        const size_t off = (size_t)(it >> 2) * 512 + (it & 3) * 128 + lane * 2;
        const unsigned w1 = *(const unsigned*)(OC + off), w2 = *(const unsigned*)(OC2 + off);
        const float x0 = bf_lo(w1) - lam * bf_lo(w2), x1 = bf_hi(w1) - lam * bf_hi(w2);
        const float rn = rsqrtf(wave_sum(x0 * x0 + x1 * x1) * (1.0f / 128.0f) + 1e-6f) * (1.0f - lambda_init);
#if defined(MK_CHECK) && MK_CHECK
        *(unsigned*)(OC + off) = cvtpk(x0 * rn * sg.x, x1 * rn * sg.y);
#endif
        *(unsigned short*)(F.ws + WS_O8 + (size_t)2 * S * 512 + off) = (unsigned short)__builtin_amdgcn_cvt_pk_fp8_f32(x0 * rn * sg.x * 8.0f, x1 * rn * sg.y * 8.0f, 0, false);
    }
}
template <int NJ, int NE> DI void ln_store(float (&v)[NJ][NE], const float* g, const float* b, float* of, bf16_t* ob, int lane, unsigned char* o8 = nullptr, unsigned char* o4 = nullptr) {
    static_assert(NJ * NE == 32 && NE % 8 == 0, "row layout");
    float s = 0.f;
#pragma unroll
    for (int j = 0; j < NJ; ++j)
#pragma unroll
        for (int e = 0; e < NE; ++e) s += v[j][e];
    const float mean = wave_sum(s) * (1.0f / DM);
    float q = 0.f;
#pragma unroll
    for (int j = 0; j < NJ; ++j)
#pragma unroll
        for (int e = 0; e < NE; ++e) { v[j][e] -= mean; q += v[j][e] * v[j][e]; }
    const float rstd = rsqrtf(wave_sum(q) * (1.0f / DM) + 1e-5f);
#pragma unroll
    for (int j = 0; j < NJ; ++j)
#pragma unroll
        for (int e8 = 0; e8 < NE; e8 += 8) {
            const int c = (DM / NJ) * j + NE * lane + e8;
            const f32x4 g0 = *(const f32x4*)(g + c), g1 = *(const f32x4*)(g + c + 4), b0 = *(const f32x4*)(b + c), b1 = *(const f32x4*)(b + c + 4);
            f32x4 o0, o1;
#pragma unroll
            for (int e = 0; e < 4; ++e) { o0[e] = v[j][e8 + e] * rstd * g0[e] + b0[e]; o1[e] = v[j][e8 + 4 + e] * rstd * g1[e] + b1[e]; }
            if (of) { *(f32x4*)(of + c) = o0; *(f32x4*)(of + c + 4) = o1; }
            u32x4 w; w.x = cvtpk(o0[0], o0[1]); w.y = cvtpk(o0[2], o0[3]); w.z = cvtpk(o1[0], o1[1]); w.w = cvtpk(o1[2], o1[3]);
            if (ob) *(u32x4*)(ob + c) = w;
            if (o8) { int lo = __builtin_amdgcn_cvt_pk_fp8_f32(o0[0], o0[1], 0, false); lo = __builtin_amdgcn_cvt_pk_fp8_f32(o0[2], o0[3], lo, true); int hi = __builtin_amdgcn_cvt_pk_fp8_f32(o1[0], o1[1], 0, false); hi = __builtin_amdgcn_cvt_pk_fp8_f32(o1[2], o1[3], hi, true);
                *(u32x2*)(o8 + c) = (u32x2){(unsigned)lo, (unsigned)hi}; }
            if (o4) { unsigned d = 0u; d = __builtin_amdgcn_cvt_scalef32_pk_fp4_f32(d, o0[0] * 2.0f, o0[1] * 2.0f, 1.0f, 0); d = __builtin_amdgcn_cvt_scalef32_pk_fp4_f32(d, o0[2] * 2.0f, o0[3] * 2.0f, 1.0f, 1);
                d = __builtin_amdgcn_cvt_scalef32_pk_fp4_f32(d, o1[0] * 2.0f, o1[1] * 2.0f, 1.0f, 2); d = __builtin_amdgcn_cvt_scalef32_pk_fp4_f32(d, o1[2] * 2.0f, o1[3] * 2.0f, 1.0f, 3); *(unsigned*)(o4 + (c >> 1)) = d; }
        }
}
DI void phase_ln1(const Frame& F, const Args& a, int layer) {
    const bf16_t* Y = wsb(F, WS_GT); bf16_t* XB = wsb(F, WS_XB);
    const int gw = F.vcu * NWAVES + F.wave, NGW = F.G * NWAVES, lane = F.lane;
    for (int t = gw; t < S; t += NGW) {
        float v[4][8];
#pragma unroll
        for (int j = 0; j < 4; ++j) { const u32x4 w = *(const u32x4*)(Y + (size_t)t * DM + 512 * j + 8 * lane);
            v[j][0] = bf_lo(w.x); v[j][1] = bf_hi(w.x); v[j][2] = bf_lo(w.y); v[j][3] = bf_hi(w.y); v[j][4] = bf_lo(w.z); v[j][5] = bf_hi(w.z); v[j][6] = bf_lo(w.w); v[j][7] = bf_hi(w.w); }
        ln_store<4, 8>(v, a.in[18] + layer * DM, a.in[19] + layer * DM, (float*)nullptr, XB + (size_t)t * DM, lane);
    }
}

namespace att {
constexpr int TBL = RING_BYTES - 4096;
constexpr int TPMO = TBL - 1024;
constexpr int KMO = 0;
constexpr float NEG = -1e30f;
enum { MIX_A = 0, MIX_B = 1, MIX_C = 2, MIX_D = 3 };

struct Ctx { int qi, pq, own; float c, cb; unsigned long long sel; };

DI int t5_bucket(int rel) {
    if (rel < 16) return rel;
    return 15 + (rel >= 16) + (rel >= 21) + (rel >= 27) + (rel >= 35) + (rel >= 46) + (rel >= 59) + (rel >= 77) + (rel >= 99) + (rel >= 128) + (rel >= 166) + (rel >= 216) + (rel >= 280) + (rel >= 363) + (rel >= 470) + (rel >= 609) + (rel >= 790);
}
DI void build_tbl(LAS unsigned char* lds, const float* t5, int col, const int* tpmax) {
    if (threadIdx.x < 256) *(LAS int*)(lds + TPMO + threadIdx.x * 4) = tpmax[threadIdx.x];
    for (int rel = threadIdx.x; rel < 1024; rel += 512) *(LAS float*)(lds + TBL + rel * 4) = t5[t5_bucket(rel) * 16 + col] * LOG2E;
}

#define ATT_SB() __builtin_amdgcn_sched_barrier(0)
#ifndef ATT_CONV_INTERLEAVE
#define ATT_CONV_INTERLEAVE 1
#endif
#ifndef ATT_CP_D
#define ATT_CP_D 0
#endif
#ifndef ATT_CP
#define ATT_CP 0
#endif
#ifndef ATT_X_LDS2
#define ATT_X_LDS2 0
#endif
#ifndef ATT_NOPRIO
#define ATT_NOPRIO 0
#endif
#if ATT_NOPRIO
#define ATT_PRIO(x) do { } while (0)
#else
#define ATT_PRIO(x) __builtin_amdgcn_s_setprio(x)
#endif
#if defined(ATT_X_NOSM)
#define ATT_SM(...) do { l_run = 1.0f; st0.resc = false; st1.resc = false; st0.alpha = 1.f; st1.alpha = 1.f; pf0[0] = qf[0]; pf0[1] = qf[1]; pf1[0] = qf[2]; pf1[1] = qf[3]; } while (0)
#else
#define ATT_SM(...) __VA_ARGS__
#endif
#ifndef ATT_PD
#define ATT_PD 4
#endif
DI float hmax32(float v) { auto rr = __builtin_amdgcn_permlane32_swap(__float_as_uint(v), __float_as_uint(v), false, false); return fmaxf(__uint_as_float(rr[0]), __uint_as_float(rr[1])); }
struct SmState { float mx, cc, dd, rs; bool resc; float alpha; };
template <int MIX, bool FAST, int W>
DI void sm_item(f32x16& s, SmState& st, float& m_run, float& l_run, bf16x8 (&pf)[2], const Ctx& cx, const LAS unsigned char* pkp, const LAS unsigned char* lds, int k0, int kmax, int kmin, int hi, bool lv) {
    constexpr bool BIAS = (MIX != MIX_D);
    if constexpr (W == 0 || W == 1) {
        constexpr int sg = W;
        if constexpr (FAST) {
            float a = fmaxf(fmaxf(s[sg * 8 + 0], s[sg * 8 + 1]), s[sg * 8 + 2]), b = fmaxf(fmaxf(s[sg * 8 + 3], s[sg * 8 + 4]), s[sg * 8 + 5]);
            a = fmaxf(fmaxf(a, s[sg * 8 + 6]), s[sg * 8 + 7]);
            st.mx = (W == 0) ? fmaxf(a, b) : fmaxf(st.mx, fmaxf(a, b));
            asm volatile("" : "+v"(st.mx));
        } else {
            i32x4 pk0 = (i32x4){0, 0, 0, 0}, pk1 = (i32x4){0, 0, 0, 0};
            if (BIAS) { const LAS i32x4* pp = (const LAS i32x4*)(pkp + (sg * 16 + hi * 8) * 4); pk0 = pp[0]; pk1 = pp[1]; }
            float mx = (W == 0) ? NEG : st.mx;
#pragma unroll
            for (int j = 0; j < 8; ++j) {
                const int i = sg * 8 + j, key = k0 + sg * 16 + hi * 8 + j;
                float tv = s[i] * cx.c;
                if (BIAS) { int rel = cx.pq - (j < 4 ? pk0[j & 3] : pk1[j & 3]); rel = rel < 0 ? 0 : (rel > 1023 ? 1023 : rel); tv += *(const LAS float*)(lds + TBL + rel * 4); }
                bool valid = key <= kmax;
                if (MIX == MIX_B) valid = valid && (key >= kmin);
                tv = valid ? tv : NEG;
                s[i] = tv; mx = fmaxf(mx, tv);
            }
            st.mx = mx;
        }
        if constexpr (W == 1) {
            float mx = hmax32(st.mx);
            if constexpr (FAST) mx = lv ? mx * cx.c + cx.cb : NEG;
            const bool need = mx > m_run + 8.0f;
            const float mn = need ? mx : m_run;
            st.alpha = ex2(m_run - mn); m_run = mn; l_run *= st.alpha;
            st.resc = (__ballot(need) != 0ull);
            st.cc = FAST ? (lv ? cx.c : 0.f) : 1.0f; st.dd = FAST ? (lv ? cx.cb - mn : NEG) : -mn; st.rs = 0.f;
            asm volatile("" : "+v"(st.alpha), "+v"(m_run), "+v"(l_run), "+v"(st.dd));
        }
    } else if constexpr (W >= 2 && W <= 5) {
        constexpr int e0 = (W - 2) * 4;
#pragma unroll
        for (int e = e0; e < e0 + 4; ++e) { float p = ex2(s[e] * st.cc + st.dd); asm volatile("" : "+v"(p)); s[e] = p; st.rs += p; }
        asm volatile("" : "+v"(st.rs));
        if constexpr (W == 5) l_run += st.rs;
    } else {
        constexpr int sg = W - 6;
        u32x4 w; w.x = cvtpk(s[sg * 8 + 0], s[sg * 8 + 1]); w.y = cvtpk(s[sg * 8 + 2], s[sg * 8 + 3]); w.z = cvtpk(s[sg * 8 + 4], s[sg * 8 + 5]); w.w = cvtpk(s[sg * 8 + 6], s[sg * 8 + 7]); asm volatile("" : "+v"(w)); pf[sg] = __builtin_bit_cast(bf16x8, w);
    }
}
template <int DQK, int DV, int MIX, bool FAST>
DI void tile_body(const LAS unsigned char* sb, const LAS unsigned char* lds, const bf16x8 (&qf)[DQK / 16], f32x16 (&o)[DV / 32], float& m_run, float& l_run, const Ctx& cx,
                  int k0, int kmax, int kmin, int pr, int xk, int xv, int r, int hi, bool lv) {
    constexpr int KCH = DQK / 8, NQ = DQK / 16, NP = DV / 16, KBUF = 64 * KCH * 16, VBUF = DV * 128;
    const LAS unsigned char* kb0 = sb + pr * (KCH * 16); const LAS unsigned char* kb1 = kb0 + 32 * (KCH * 16);
    const LAS unsigned char* vb = sb + KBUF + r * 128; const LAS unsigned char* pkp = sb + KBUF + VBUF;
    f32x16 s0, s1;
#pragma unroll
    for (int i = 0; i < 16; ++i) { s0[i] = 0.f; s1[i] = 0.f; }
    bf16x8 kf[NQ], kg[NQ], vf[2 * NP], pf0[2], pf1[2];
    SmState st0, st1;
#if defined(ATT_X_NOLDS)
#define ATT_KF(base, kk) (qf[(kk) % NQ])
#else
#define ATT_KF(base, kk) (*(const LAS bf16x8*)((base) + (((2 * (kk) + hi) ^ xk) << 4)))
#endif
#if defined(ATT_X_NOLDS)
#define ATT_VF(f) (qf[(f) % NQ])
#else
#define ATT_VF(f) (*(const LAS bf16x8*)(vb + (((f) % NP) >> 1) * 32 * 128 + (((((f) / NP) * 4 + ((f) & 1) * 2 + hi) ^ xv) << 4)))
#endif
#define ATT_PRE_K(W) do { _Pragma("unroll") for (int kk = ((W) * NQ) / 8; kk < (((W) + 1) * NQ) / 8; ++kk) { kg[kk] = ATT_KF(kb1, kk); if (ATT_X_LDS2) { bf16x8 dm_ = ATT_KF(kb1 + 16, kk); asm volatile("" :: "v"(dm_)); } } } while (0)
#define ATT_PRE_V(W) do { _Pragma("unroll") for (int f = ((W) * NP) / 8; f < (((W) + 1) * NP) / 8; ++f) { vf[f] = ATT_VF(f); if (ATT_X_LDS2) { bf16x8 dm_ = ATT_VF(f ^ 1); asm volatile("" :: "v"(dm_)); } } } while (0)
#pragma unroll
    for (int kk = 0; kk < NQ; ++kk) kf[kk] = ATT_KF(kb0, kk);
    ATT_SB();
#pragma unroll
    for (int kk = 0; kk < NQ; ++kk) s0 = __builtin_amdgcn_mfma_f32_32x32x16_bf16(kf[kk], qf[kk], s0, 0, 0, 0);
    ATT_PRE_K(0); ATT_PRE_K(1); if (ATT_PD > 2) ATT_PRE_K(2); if (ATT_PD > 3) ATT_PRE_K(3);
    ATT_SB();
#define ATT_STEP2(W) do { \
        ATT_PRIO(1); _Pragma("unroll") for (int kk = ((W) * NQ) / 8; kk < (((W) + 1) * NQ) / 8; ++kk) s1 = __builtin_amdgcn_mfma_f32_32x32x16_bf16(kg[kk], qf[kk], s1, 0, 0, 0); ATT_PRIO(0); \
        if ((W) + ATT_PD < 8) ATT_PRE_K((W) + ATT_PD); else ATT_PRE_V((W) + ATT_PD - 8); \
        ATT_SM(sm_item<MIX, FAST, W>(s0, st0, m_run, l_run, pf0, cx, pkp, lds, k0, kmax, kmin, hi, lv)); ATT_SB(); } while (0)
    ATT_STEP2(0); ATT_STEP2(1); ATT_STEP2(2); ATT_STEP2(3); ATT_STEP2(4); ATT_STEP2(5); ATT_STEP2(6); ATT_STEP2(7);
#undef ATT_STEP2
    if (st0.resc) {
#pragma unroll
        for (int d = 0; d < DV / 32; ++d)
#pragma unroll
            for (int i = 0; i < 16; ++i) o[d][i] *= st0.alpha;
    }
    ATT_SB();
#define ATT_STEP3(W) do { \
        ATT_PRIO(1); _Pragma("unroll") for (int f = ((W) * NP) / 8; f < (((W) + 1) * NP) / 8; ++f) o[f >> 1] = __builtin_amdgcn_mfma_f32_32x32x16_bf16(vf[f], pf0[f & 1], o[f >> 1], 0, 0, 0); ATT_PRIO(0); \
        ATT_PRE_V((W) + ATT_PD); \
        ATT_SM(sm_item<MIX, FAST, W>(s1, st1, m_run, l_run, pf1, cx, pkp + 128, lds, k0 + 32, kmax, kmin, hi, lv)); ATT_SB(); } while (0)
    ATT_STEP3(0); ATT_STEP3(1); ATT_STEP3(2); ATT_STEP3(3); ATT_STEP3(4); ATT_STEP3(5); ATT_STEP3(6); ATT_STEP3(7);
#undef ATT_STEP3
    if (st1.resc) {
#pragma unroll
        for (int d = 0; d < DV / 32; ++d)
#pragma unroll
            for (int i = 0; i < 16; ++i) o[d][i] *= st1.alpha;
    }
    ATT_SB();
#define ATT_STEP4(W) do { \
        _Pragma("unroll") for (int f = ((W) * NP) / 8; f < (((W) + 1) * NP) / 8; ++f) o[(f - NP) >> 1] = __builtin_amdgcn_mfma_f32_32x32x16_bf16(vf[f], pf1[f & 1], o[(f - NP) >> 1], 0, 0, 0); \
        if ((W) + ATT_PD < 16) ATT_PRE_V((W) + ATT_PD); ATT_SB(); } while (0)
    ATT_STEP4(8); ATT_STEP4(9); ATT_STEP4(10); ATT_STEP4(11); ATT_STEP4(12); ATT_STEP4(13); ATT_STEP4(14); ATT_STEP4(15);
#undef ATT_STEP4
#undef ATT_KF
#undef ATT_VF
#undef ATT_PRE_K
#undef ATT_PRE_V
}
template <int DQK, int DV, int MIX>
DI void flash_pass(LAS unsigned char* lds, const bf16x8 (&qf)[DQK / 16], const bf16_t* __restrict__ Kg, int ldk, const bf16_t* __restrict__ VTg, int ldvt,
                   const int* __restrict__ pos, int t0, int t1, int q0, int qpmin, const Ctx& cx, f32x16 (&o)[DV / 32], float& m_run, float& l_run, int ts_force = -1) {
    constexpr int KCH = DQK / 8, NKL = KCH / 8, NVL = DV / 64;
    constexpr bool BIAS = (MIX != MIX_D);
    constexpr int KBUF = 64 * KCH * 16, VBUF = DV * 128, PBUF = BIAS ? 2048 : 0, SLOT = KBUF + VBUF + PBUF, NV = NKL + NVL + (BIAS ? 1 : 0);
    static_assert(3 * SLOT <= TPMO, "attention ring");
    static_assert(DQK % 128 == 0 || DQK == 64 || DQK == 192, "QK MFMAs per softmax work item");
    int tid = threadIdx.x; asm volatile("" : "+v"(tid));
    const int lane = tid & 63, r = lane & 31, hi = lane >> 5, wave = __builtin_amdgcn_readfirstlane(tid >> 6);
    const int pr = (r & 0x13) | ((r & 4) << 1) | ((r & 8) >> 1);
    const int xk = (KCH == 16) ? (((pr & 1) << 3) | ((pr >> 1) & 7)) : ((pr >> 1) & 7);
    const int xv = (r >> 1) & 7;
    unsigned koff[NKL], voff[NVL];
#pragma unroll
    for (int i = 0; i < NKL; ++i) { const int p = (i * 8 + wave) * 64 + lane, row = p / KCH, cs = p % KCH; const int x = (KCH == 16) ? (((row & 1) << 3) | ((row >> 1) & 7)) : ((row >> 1) & 7); koff[i] = (unsigned)(row * ldk + (cs ^ x) * 8) * 2u; }
#pragma unroll
    for (int i = 0; i < NVL; ++i) { const int p = (i * 8 + wave) * 64 + lane, row = p >> 3, cs = p & 7; voff[i] = (unsigned)(row * ldvt + (cs ^ ((row >> 1) & 7)) * 8) * 2u; }
#define ATT_ISSUE(t, sl) do { LAS unsigned char* sb_ = lds + (sl) * SLOT; \
    _Pragma("unroll") for (int i_ = 0; i_ < NKL; ++i_) __builtin_amdgcn_global_load_lds((const unsigned*)((const char*)Kg + (size_t)(t) * 64 * ldk * 2 + koff[i_]), (LAS unsigned*)(sb_ + (i_ * 8 + wave) * 1024), 16, 0, 0); \
    _Pragma("unroll") for (int i_ = 0; i_ < NVL; ++i_) __builtin_amdgcn_global_load_lds((const unsigned*)((const char*)VTg + (size_t)(t) * 128 + voff[i_]), (LAS unsigned*)(sb_ + KBUF + (i_ * 8 + wave) * 1024), 16, 0, 0); \
    if (BIAS) __builtin_amdgcn_global_load_lds((const unsigned*)(pos + (t) * 64 + lane), (LAS unsigned*)(sb_ + KBUF + VBUF + wave * 256), 4, 0, 0); } while (0)
#ifndef ATT_X_DMA2
#define ATT_X_DMA2 0
#endif
#if ATT_X_DMA2
#define ATT_ISSUE2(t, sl) do { ATT_ISSUE(t, sl); ATT_ISSUE(t, sl); } while (0)
#else
#define ATT_ISSUE2(t, sl) ATT_ISSUE(t, sl)
#endif
#if defined(ATT_X_NODMA)
#define ATT_ISSUE_LOOP(t, sl) do { (void)(sl); } while (0)
#define ATT_NEXT_SLOT(sl) ((sl) ^ 1)
#else
#define ATT_ISSUE_LOOP(t, sl) ATT_ISSUE2(t, sl)
#define ATT_NEXT_SLOT(sl) (((sl) == 2) ? 0 : (sl) + 1)
#endif
#define ATT_WAITBAR(N) asm volatile("s_waitcnt vmcnt(%0) lgkmcnt(0)\n\ts_barrier" :: "n"(N) : "memory")
    int ts = t0;
    if (ts_force >= 0) ts = ts_force;
    else if (MIX != MIX_B) { const int tlim = (q0 >> 6) < t1 ? (q0 >> 6) : t1;
        if (!BIAS) ts = tlim > t0 ? tlim : t0;
        else {
            ts = tlim > t0 ? tlim : t0;
            for (int base = t0; base < tlim; base += 64) { const int idx = base + lane; const bool stop = (idx >= tlim) || (qpmin - *(const LAS int*)(lds + TPMO + (idx < 256 ? idx : 255) * 4) < 790);
                const unsigned long long mk = __ballot(stop); if (mk != 0ull) { const int f = base + (int)__builtin_ctzll(mk); ts = f < tlim ? f : tlim; break; } } } }
    ATT_ISSUE2(t0, 0);
    if (t0 + 1 < t1) ATT_ISSUE2(t0 + 1, 1);
    int sl = 0;
#define ATT_TILES(TA, TB, FASTV) \
    for (int t = (TA); t < (TB); ++t) { \
        if (t + 1 < t1) ATT_WAITBAR(NV * (ATT_X_DMA2 ? 2 : 1)); else ATT_WAITBAR(0);            \
        if (t + 2 < t1) { const int s2 = (sl >= 1) ? sl - 1 : 2; ATT_ISSUE_LOOP(t + 2, s2); } \
        const LAS unsigned char* sb = lds + sl * SLOT; \
        int kmax, kmin = 0; \
        kmax = cx.qi; \
        if (MIX == MIX_B) kmin = cx.qi - 127; \
        const int k0 = t * 64; \
        const bool lv = (kmax >= k0) && (kmin <= k0 + 63); \
        if (__ballot(lv) != 0ull) tile_body<DQK, DV, MIX, FASTV>(sb, lds, qf, o, m_run, l_run, cx, k0, kmax, kmin, pr, xk, xv, r, hi, lv); \
        sl = ATT_NEXT_SLOT(sl); \
    }
    ATT_TILES(t0, ts, true)
    ATT_TILES(ts, t1, false)
#undef ATT_TILES
    asm volatile("s_waitcnt lgkmcnt(0)\n\ts_barrier" ::: "memory");
#undef ATT_ISSUE
#undef ATT_WAITBAR
}
DI int fast_split(const LAS unsigned char* lds, int t0, int t1, int q0, int qpmin, int lane) {
    const int tlim = (q0 >> 6) < t1 ? (q0 >> 6) : t1;
    int ts = tlim > t0 ? tlim : t0;
    for (int base = t0; base < tlim; base += 64) { const int idx = base + lane; const bool stop = (idx >= tlim) || (qpmin - *(const LAS int*)(lds + TPMO + (idx < 256 ? idx : 255) * 4) < 790);
        const unsigned long long mk = __ballot(stop); if (mk != 0ull) { const int f = base + (int)__builtin_ctzll(mk); ts = f < tlim ? f : tlim; break; } }
    return ts;
}
template <int DQK, int DV, int MIX>
DI void flash_pass_cp(LAS unsigned char* lds, const bf16x8 (&qf)[DQK / 16], const bf16_t* __restrict__ Kg, int ldk, const bf16_t* __restrict__ VTg, int ldvt,
                      int t0, int ts, const Ctx& cx, f32x16 (&o)[DV / 32], float& m_run, float& l_run) {
    constexpr int KCH = DQK / 8, NKL = KCH / 8, NVL = DV / 64, NQ = DQK / 16, NP = DV / 16;
    constexpr int KBUF = 64 * KCH * 16, VBUF = DV * 128;
    static_assert(3 * (KBUF + VBUF) <= TPMO, "attention rings");
    int tid = threadIdx.x; asm volatile("" : "+v"(tid));
    const int lane = tid & 63, r = lane & 31, hi = lane >> 5, wave = __builtin_amdgcn_readfirstlane(tid >> 6);
    const int pr = (r & 0x13) | ((r & 4) << 1) | ((r & 8) >> 1);
    const int xk = (KCH == 16) ? (((pr & 1) << 3) | ((pr >> 1) & 7)) : ((pr >> 1) & 7);
    const int xv = (r >> 1) & 7;
    unsigned koff[NKL], voff[NVL];
#pragma unroll
    for (int i = 0; i < NKL; ++i) { const int p = (i * 8 + wave) * 64 + lane, row = p / KCH, cs = p % KCH; const int x = (KCH == 16) ? (((row & 1) << 3) | ((row >> 1) & 7)) : ((row >> 1) & 7); koff[i] = (unsigned)(row * ldk + (cs ^ x) * 8) * 2u; }
#pragma unroll
    for (int i = 0; i < NVL; ++i) { const int p = (i * 8 + wave) * 64 + lane, row = p >> 3, cs = p & 7; voff[i] = (unsigned)(row * ldvt + (cs ^ ((row >> 1) & 7)) * 8) * 2u; }
#define CP_ISSUE_K(t, sl) do { _Pragma("unroll") for (int i_ = 0; i_ < NKL; ++i_) __builtin_amdgcn_global_load_lds((const unsigned*)((const char*)Kg + (size_t)(t) * 64 * ldk * 2 + koff[i_]), (LAS unsigned*)(lds + (sl) * KBUF + (i_ * 8 + wave) * 1024), 16, 0, 0); } while (0)
#define CP_ISSUE_V(t, sl) do { _Pragma("unroll") for (int i_ = 0; i_ < NVL; ++i_) __builtin_amdgcn_global_load_lds((const unsigned*)((const char*)VTg + (size_t)(t) * 128 + voff[i_]), (LAS unsigned*)(lds + 3 * KBUF + (sl) * VBUF + (i_ * 8 + wave) * 1024), 16, 0, 0); } while (0)
#define CP_KF(base, kk) (*(const LAS bf16x8*)((base) + (((2 * (kk) + hi) ^ xk) << 4)))
#define CP_VF(base, hf, j) (*(const LAS bf16x8*)((base) + ((j) >> 1) * 32 * 128 + (((((hf) * 4 + ((j) & 1) * 2 + hi) ^ xv)) << 4)))
    const int n = ts - t0;
    CP_ISSUE_K(t0, 0); CP_ISSUE_V(t0, 0);
    if (n > 1) CP_ISSUE_K(t0 + 1, 1);
    asm volatile("s_waitcnt vmcnt(0) lgkmcnt(0)\n\ts_barrier" ::: "memory");
    const LAS unsigned char* kl = lds + pr * (KCH * 16);
    const LAS unsigned char* vl = lds + 3 * KBUF + r * 128;
    f32x16 sc, sn;
    bf16x8 kfr[NQ], vfr[NP], pp[2], pc[2];
    SmState st;
#pragma unroll
    for (int i = 0; i < 16; ++i) sc[i] = 0.f;
#pragma unroll
    for (int kk = 0; kk < NQ; ++kk) kfr[kk] = CP_KF(kl, kk);
    ATT_SB();
#pragma unroll
    for (int kk = 0; kk < NQ; ++kk) sc = __builtin_amdgcn_mfma_f32_32x32x16_bf16(kfr[kk], qf[kk], sc, 0, 0, 0);
#define CP_PRE(W, KB, HFK_UNUSED, VB, HFV, DOK, DOV) do { \
        if (DOK) { _Pragma("unroll") for (int kk = ((W) * NQ) / 8; kk < (((W) + 1) * NQ) / 8; ++kk) kfr[kk] = CP_KF(KB, kk); } \
        if (DOV) { _Pragma("unroll") for (int j = ((W) * NP) / 8; j < (((W) + 1) * NP) / 8; ++j) vfr[j] = CP_VF(VB, HFV, j); } } while (0)
#define CP_ITEM(W, DOK, DOV, KB, VB, HFV, KBN, VBN, HFVN) do { \
        ATT_PRIO(1); \
        if (DOK) { _Pragma("unroll") for (int kk = ((W) * NQ) / 8; kk < (((W) + 1) * NQ) / 8; ++kk) sn = __builtin_amdgcn_mfma_f32_32x32x16_bf16(kfr[kk], qf[kk], sn, 0, 0, 0); } \
        if (DOV) { _Pragma("unroll") for (int j = ((W) * NP) / 8; j < (((W) + 1) * NP) / 8; ++j) o[j >> 1] = __builtin_amdgcn_mfma_f32_32x32x16_bf16(vfr[j], pp[j & 1], o[j >> 1], 0, 0, 0); } \
        ATT_PRIO(0); \
        if ((W) + 2 < 8) CP_PRE((W) + 2, KB, 0, VB, HFV, DOK, DOV); else CP_PRE((W) - 6, KBN, 0, VBN, HFVN, true, true); \
        sm_item<MIX, true, W>(sc, st, m_run, l_run, pc, cx, lds, lds, 0, 0, 0, hi, true); ATT_SB(); } while (0)
#define CP_STEP(DOK, DOV, KB, VB, HFV, KBN, VBN, HFVN) do { \
        _Pragma("unroll") for (int i = 0; i < 16; ++i) sn[i] = 0.f; \
        CP_ITEM(0, DOK, DOV, KB, VB, HFV, KBN, VBN, HFVN); CP_ITEM(1, DOK, DOV, KB, VB, HFV, KBN, VBN, HFVN); CP_ITEM(2, DOK, DOV, KB, VB, HFV, KBN, VBN, HFVN); CP_ITEM(3, DOK, DOV, KB, VB, HFV, KBN, VBN, HFVN); \
        CP_ITEM(4, DOK, DOV, KB, VB, HFV, KBN, VBN, HFVN); CP_ITEM(5, DOK, DOV, KB, VB, HFV, KBN, VBN, HFVN); CP_ITEM(6, DOK, DOV, KB, VB, HFV, KBN, VBN, HFVN); CP_ITEM(7, DOK, DOV, KB, VB, HFV, KBN, VBN, HFVN); \
        if (st.resc) { _Pragma("unroll") for (int d = 0; d < DV / 32; ++d) _Pragma("unroll") for (int i = 0; i < 16; ++i) o[d][i] *= st.alpha; } \
        pp[0] = pc[0]; pp[1] = pc[1]; sc = sn; ATT_SB(); } while (0)
    int ks = 0, vs = 0;
    for (int i = 0; i < n; ++i) {
        const int t = t0 + i;
        const int ks1 = (ks == 2) ? 0 : ks + 1, ks2 = (ks == 0) ? 2 : ks - 1, vs1 = (vs == 2) ? 0 : vs + 1, vsp = (vs == 0) ? 2 : vs - 1;
        if (i > 0) asm volatile("s_waitcnt vmcnt(0) lgkmcnt(0)\n\ts_barrier" ::: "memory");
        if (t + 2 < ts) CP_ISSUE_K(t + 2, ks2);
        if (t + 1 < ts) CP_ISSUE_V(t + 1, vs1);
        const LAS unsigned char* kA = kl + ks * KBUF + 32 * (KCH * 16); const LAS unsigned char* kB = kl + ks1 * KBUF; const LAS unsigned char* kAn = kl + ks1 * KBUF + 32 * (KCH * 16);
        const LAS unsigned char* vP = vl + vsp * VBUF; const LAS unsigned char* vC = vl + vs * VBUF;
        if (i == 0) {
            CP_PRE(0, kA, 0, vP, 1, true, false); CP_PRE(1, kA, 0, vP, 1, true, false);
            CP_STEP(true, false, kA, vP, 1, kB, vC, 0);
        } else {
            CP_STEP(true, true, kA, vP, 1, kB, vC, 0);
        }
        CP_STEP(true, true, kB, vC, 0, kAn, vC, 1);
        ks = ks1; vs = vs1;
    }
    {
        const int vsp = (vs == 0) ? 2 : vs - 1; const LAS unsigned char* vP = vl + vsp * VBUF;
#pragma unroll
        for (int j = (2 * NP) / 8; j < NP; ++j) vfr[j] = CP_VF(vP, 1, j);
        ATT_SB();
#pragma unroll
        for (int j = 0; j < NP; ++j) o[j >> 1] = __builtin_amdgcn_mfma_f32_32x32x16_bf16(vfr[j], pp[j & 1], o[j >> 1], 0, 0, 0);
    }
    asm volatile("s_waitcnt lgkmcnt(0)\n\ts_barrier" ::: "memory");
#undef CP_ISSUE_K
#undef CP_ISSUE_V
#undef CP_KF
#undef CP_VF
#undef CP_PRE
#undef CP_ITEM
#undef CP_STEP
}
template <int DV> DI void store_o(const f32x16 (&o)[DV / 32], float scale, bf16_t* orow, int hi) {
#pragma unroll
    for (int d = 0; d < DV / 32; ++d)
#pragma unroll
        for (int a = 0; a < 4; ++a) { u32x2 w; w.x = cvtpk(o[d][4 * a] * scale, o[d][4 * a + 1] * scale); w.y = cvtpk(o[d][4 * a + 2] * scale, o[d][4 * a + 3] * scale); *(u32x2*)(orow + d * 32 + 8 * a + 4 * hi) = w; }
}

template <int DV> DI void store_o8(const f32x16 (&o)[DV / 32], float scale, unsigned char* orow, int hi) {
#pragma unroll
    for (int d = 0; d < DV / 32; ++d)
#pragma unroll
        for (int a = 0; a < 4; ++a) { int w = __builtin_amdgcn_cvt_pk_fp8_f32(o[d][4 * a] * scale, o[d][4 * a + 1] * scale, 0, false); w = __builtin_amdgcn_cvt_pk_fp8_f32(o[d][4 * a + 2] * scale, o[d][4 * a + 3] * scale, w, true); *(unsigned*)(orow + d * 32 + 8 * a + 4 * hi) = (unsigned)w; }
}
DI int wg_min_pos(const Frame& F, int pq) {
#pragma unroll
    for (int o = 1; o < 64; o <<= 1) { const int other = __shfl_xor(pq, o); pq = other < pq ? other : pq; }
    if (F.tid == 0) F.MISC[5] = 0x7fffffffu;
    __syncthreads();
    if (F.lane == 0) atomicMin((int*)&F.MISC[5], pq);
    __syncthreads();
    const int v = (int)F.MISC[5];
    __syncthreads();
    return v;
}
DI void unit_D(const Frame& F, const Args& a, int h, int qt) {
    int lane = F.lane; asm volatile("" : "+v"(lane));
    const int r = lane & 31, hi = lane >> 5, qi = qt * 256 + F.wave * 32 + r;
    const bf16_t* QD = wsb(F, WS_QD) + (size_t)qi * 768 + h * 192 + hi * 8;
    bf16x8 qf[12];
#pragma unroll
    for (int kk = 0; kk < 12; ++kk) qf[kk] = *(const bf16x8*)(QD + kk * 16);
    f32x16 o[4];
#pragma unroll
    for (int d = 0; d < 4; ++d)
#pragma unroll
        for (int i = 0; i < 16; ++i) o[d][i] = 0.f;
    float m = NEG, l = 0.f;
    Ctx cx; cx.qi = qi; cx.pq = 0; cx.own = 0; cx.sel = 0ull; cx.cb = 0.f; cx.c = 0.07216878364870322f * LOG2E;
    const int ts = qt * 4;
    if (ATT_CP_D && ts > 0) flash_pass_cp<192, 128, MIX_D>(F.lds, qf, wsb(F, WS_KD) + h * 192, 768, wsb(F, WS_VDT) + (size_t)(h * 128) * S, S, 0, ts, cx, o, m, l);
    flash_pass<192, 128, MIX_D>(F.lds, qf, wsb(F, WS_KD) + h * 192, 768, wsb(F, WS_VDT) + (size_t)(h * 128) * S, S, (const int*)a.in[1], ATT_CP_D ? ts : 0, (qt + 1) * 4, qt * 256, 0, cx, o, m, l, ATT_CP_D ? ts : -1);
    l += xhalf(l);
    int lane2 = F.lane; asm volatile("" : "+v"(lane2));
    const int hi2 = lane2 >> 5, qi2 = qt * 256 + F.wave * 32 + (lane2 & 31);
#if defined(MK_CHECK) && MK_CHECK
    store_o<128>(o, 1.0f / l, wsb(F, WS_O) + (size_t)3 * S * 512 + (size_t)qi2 * 512 + h * 128, hi2);
#endif
    store_o8<128>(o, 8.0f / l, F.ws + WS_O8 + (size_t)3 * S * 512 + (size_t)qi2 * 512 + h * 128, hi2);
}
DI void unit_C(const Frame& F, const Args& a, int h, int qt, int mp) {
    int lane = F.lane; asm volatile("" : "+v"(lane));
    const int r = lane & 31, hi = lane >> 5, qi = qt * 256 + F.wave * 32 + r;
    const int* pos = (const int*)a.in[1];
    build_tbl(F.lds, a.in[2], 12 + h, (const int*)(F.ws + WS_TPMAX));
    Ctx cx; cx.qi = qi; cx.pq = pos[qi]; cx.own = 0; cx.sel = 0ull; cx.c = 0.125f * LOG2E; cx.cb = a.in[2][31 * 16 + 12 + h] * LOG2E;
    const int qpmin = wg_min_pos(F, cx.pq);
    const bf16_t* H = wsb(F, WS_H);
    const bf16_t* Q = H + (size_t)qi * HW + H_CQ + h * 128 + mp * 64 + hi * 8;
    bf16x8 qf[4];
#pragma unroll
    for (int kk = 0; kk < 4; ++kk) qf[kk] = *(const bf16x8*)(Q + kk * 16);
    f32x16 o[4];
#pragma unroll
    for (int d = 0; d < 4; ++d)
#pragma unroll
        for (int i = 0; i < 16; ++i) o[d][i] = 0.f;
    float m = NEG, l = 0.f;
    const int ts = ATT_CP ? fast_split(F.lds, 0, (qt + 1) * 4, qt * 256, qpmin, lane) : 0;
    if (ATT_CP && ts > 0) flash_pass_cp<64, 128, MIX_C>(F.lds, qf, H + H_CK + h * 128 + mp * 64, HW, wsb(F, WS_VT) + (size_t)(VT_C + h * 128) * S, S, 0, ts, cx, o, m, l);
    flash_pass<64, 128, MIX_C>(F.lds, qf, H + H_CK + h * 128 + mp * 64, HW, wsb(F, WS_VT) + (size_t)(VT_C + h * 128) * S, S, pos, ATT_CP ? ts : 0, (qt + 1) * 4, qt * 256, qpmin, cx, o, m, l, ATT_CP ? ts : -1);
    l += xhalf(l);
    int lane2 = F.lane; asm volatile("" : "+v"(lane2));
    const int hi2 = lane2 >> 5, qi2 = qt * 256 + F.wave * 32 + (lane2 & 31);
    bf16_t* orow = (mp == 0 ? wsb(F, WS_O) + (size_t)2 * S * 512 : wsb(F, WS_OC2)) + (size_t)qi2 * 512 + h * 128;
    store_o<128>(o, 1.0f / l, orow, hi2);
}
DI void unit_B(const Frame& F, const Args& a, int layer, int hq, int qt) {
    const int lane = F.lane, r = lane & 31, hi = lane >> 5, qi = qt * 256 + F.wave * 32 + r, g = hq >> 2;
    const int* pos = (const int*)a.in[1];
    build_tbl(F.lds, a.in[2], 4 + hq, (const int*)(F.ws + WS_TPMAX));
    const bf16_t* H = wsb(F, WS_H);
    const bf16_t* Q = H + (size_t)qi * HW + H_BQ + hq * 64 + hi * 8;
    bf16x8 qf[4];
#pragma unroll
    for (int kk = 0; kk < 4; ++kk) qf[kk] = *(const bf16x8*)(Q + kk * 16);
    f32x16 o[2];
#pragma unroll
    for (int d = 0; d < 2; ++d)
#pragma unroll
        for (int i = 0; i < 16; ++i) o[d][i] = 0.f;
    float m = NEG, l = 0.f;
    Ctx cx; cx.qi = qi; cx.pq = pos[qi]; cx.own = 0; cx.sel = 0ull; cx.c = 0.125f * LOG2E; cx.cb = a.in[2][31 * 16 + 4 + hq] * LOG2E;
    const int t0 = (qt * 4 - 2) < 0 ? 0 : (qt * 4 - 2);
    flash_pass<64, 64, MIX_B>(F.lds, qf, H + H_BK + g * 64, HW, wsb(F, WS_VT) + (size_t)(VT_B + g * 64) * S, S, pos, t0, (qt + 1) * 4, qt * 256, 0, cx, o, m, l);
    l += xhalf(l);
    l += ex2(a.in[8][layer * 8 + hq] * LOG2E - m);
#if defined(MK_CHECK) && MK_CHECK
    store_o<64>(o, 1.0f / l, wsb(F, WS_O) + (size_t)1 * S * 512 + (size_t)qi * 512 + hq * 64, hi);
#endif
    store_o8<64>(o, 8.0f / l, F.ws + WS_O8 + (size_t)1 * S * 512 + (size_t)qi * 512 + hq * 64, hi);
}
DI void store_part(const f32x16 (&o)[4], float m, float l, unsigned char* prow, int hi) {
    l += xhalf(l);
    store_o<128>(o, 1.0f / l, (bf16_t*)prow, hi);
    if (hi == 0) *(f32x2*)(prow + 256) = (f32x2){m, l};
}
DI void unit_A_own(const Frame& F, const Args& a, int h, int qt) {
    const int lane = F.lane, r = lane & 31, hi = lane >> 5, qi = qt * 256 + F.wave * 32 + r;
    const int* pos = (const int*)a.in[1];
    build_tbl(F.lds, a.in[2], h, (const int*)(F.ws + WS_TPMAX));
    const bf16_t* H = wsb(F, WS_H);
    const bf16_t* Q = H + (size_t)qi * HW + H_AQ + h * 128 + hi * 8;
    bf16x8 qf[8];
#pragma unroll
    for (int kk = 0; kk < 8; ++kk) qf[kk] = *(const bf16x8*)(Q + kk * 16);
    f32x16 o[4];
#pragma unroll
    for (int d = 0; d < 4; ++d)
#pragma unroll
        for (int i = 0; i < 16; ++i) o[d][i] = 0.f;
    float m = NEG, l = 0.f;
    Ctx cx; cx.qi = qi; cx.pq = pos[qi]; cx.own = qt; cx.sel = 0ull; cx.c = 0.08838834764831845f * LOG2E; cx.cb = a.in[2][31 * 16 + h] * LOG2E;
    flash_pass<128, 128, MIX_C>(F.lds, qf, H + H_AK + h * 128, HW, wsb(F, WS_VT) + (size_t)(VT_A + h * 128) * S, S, pos, qt * 4, (qt + 1) * 4, 0, 0, cx, o, m, l);
    store_part(o, m, l, F.ws + WS_PART + ((size_t)qi * 16 + h * 4 + 3) * 272, hi);
}
DI void unit_A_gather(const Frame& F, const Args& a, int h, int n, int near, int chunk, int count) {
    const int lane = F.lane, r = lane & 31, hi = lane >> 5;
    const int* pos = (const int*)a.in[1];
    if (near) build_tbl(F.lds, a.in[2], h, (const int*)(F.ws + WS_TPMAX));
    const int* list = (const int*)(F.ws + WS_MLIST) + (size_t)(h * 64 + n) * MCAP + (near ? MCAP_F : 0);
    const int idx = chunk * 256 + F.wave * 32 + r; const bool live = idx < count;
    const int e = list[live ? idx : chunk * 256];
    const int qi = e >> 2, slot = e & 3;
    const bf16_t* H = wsb(F, WS_H);
    const bf16_t* Q = H + (size_t)qi * HW + H_AQ + h * 128 + hi * 8;
    bf16x8 qf[8];
#pragma unroll
    for (int kk = 0; kk < 8; ++kk) qf[kk] = *(const bf16x8*)(Q + kk * 16);
    f32x16 o[4];
#pragma unroll
    for (int d = 0; d < 4; ++d)
#pragma unroll
        for (int i = 0; i < 16; ++i) o[d][i] = 0.f;
    float m = NEG, l = 0.f;
    Ctx cx; cx.qi = 0x7fffffff; cx.pq = pos[qi]; cx.own = 0; cx.sel = 0ull; cx.c = 0.08838834764831845f * LOG2E; cx.cb = a.in[2][31 * 16 + h] * LOG2E;
    flash_pass<128, 128, MIX_C>(F.lds, qf, H + H_AK + h * 128, HW, wsb(F, WS_VT) + (size_t)(VT_A + h * 128) * S, S, pos, n * 4, (n + 1) * 4, 0, 0, cx, o, m, l, near ? n * 4 : (n + 1) * 4);
    if (live) store_part(o, m, l, F.ws + WS_PART + ((size_t)qi * 16 + h * 4 + slot) * 272, hi);
    else { l += xhalf(l); }
}
}

DI int next_unit(const Frame& F, unsigned* head) {
    if (F.tid == 0) F.MISC[4] = __hip_atomic_fetch_add(head, 1u, __ATOMIC_RELAXED, __HIP_MEMORY_SCOPE_AGENT);
    __syncthreads();
    const int u = (int)F.MISC[4];
    __syncthreads();
    return u;
}
DI void convert_chunk(const Frame& F, const Args& a, int layer, int c) {
    const bool isv = c >= 256; const int row0 = (c & 255) * 64 + F.wave * 8;
    const float* src = (isv ? a.in[23] : a.in[22]) + (size_t)layer * 16384 * DM + (size_t)row0 * DM;
    unsigned char* dst = F.ws + WS_UB + (size_t)row0 * 2048 + (isv ? 1024 : 0);
    const float scale = isv ? V_SCALE : U_SCALE;
    int lane = F.lane; asm volatile("" : "+v"(lane));
    for (int j = 0; j < 8; ++j) {
        const float* p = src + (size_t)j * DM + 4 * lane; unsigned char* q = dst + (size_t)j * 2048 + 2 * lane;
        f32x4 x[8];
#pragma unroll
        for (int k = 0; k < 8; ++k) x[k] = *(const f32x4*)(p + 256 * k);
#pragma unroll
        for (int k = 0; k < 8; ++k) { unsigned d = 0u; const f32x4 y = x[k] * scale;
            d = __builtin_amdgcn_cvt_scalef32_pk_fp4_f32(d, y[0], y[1], 1.0f, 0); d = __builtin_amdgcn_cvt_scalef32_pk_fp4_f32(d, y[2], y[3], 1.0f, 1);
            *(unsigned short*)(q + 128 * k) = (unsigned short)d; }
    }
}
template <int PART> DI void phase_attention(const Frame& F, const Args& a, int layer, int rep = 0) {
    unsigned* q = (unsigned*)(F.ws + WS_CTL) + CW_Q + layer * 256 + rep * 512;
    if constexpr (PART == 0) {
#if !defined(NO_D) && !defined(NO_C)
    for (;;) { const int u = next_unit(F, q + 0); if (u >= 768) break;
        const int qt = 63 - u / 12, k = u % 12;
        if (k < 4) att::unit_D(F, a, k, qt);
        else att::unit_C(F, a, (k - 4) >> 1, qt, (k - 4) & 1);
        if (ATT_CONV_INTERLEAVE) { const int c = next_unit(F, q + 32); if (c < 512) convert_chunk(F, a, layer, c); } }
    if (ATT_CONV_INTERLEAVE) for (;;) { const int c = next_unit(F, q + 32); if (c >= 512) break; convert_chunk(F, a, layer, c); }
#endif
    } else {
#ifndef NO_A
    {
        const unsigned* cnt = (const unsigned*)(F.ws + WS_CTL) + CW_MOBA + layer * 1024;
        LAS int* pre = (LAS int*)(F.lds + att::TBL - 4096);
        __syncthreads();
        if (F.tid == 0) { int acc = 0; for (int i = 0; i < 512; ++i) { pre[i] = acc; const unsigned c = cnt[i], cap = (i >= 256) ? (unsigned)(MCAP - MCAP_F) : (unsigned)MCAP_F; acc += (int)(((c < cap ? c : cap) + 255u) >> 8); } pre[512] = acc; }
        __syncthreads();
        const int ntot = 256 + pre[512];
        for (;;) { const int u = next_unit(F, q + 128); if (u >= ntot) break;
            if (u < 256) { att::unit_A_own(F, a, u & 3, 63 - (u >> 2)); continue; }
            const int g = u - 256; int lo_ = 0, hi_ = 511;
            while (lo_ < hi_) { const int mid = (lo_ + hi_ + 1) >> 1; if (pre[mid] <= g) lo_ = mid; else hi_ = mid - 1; }
            const unsigned c = cnt[lo_], cap = (lo_ >= 256) ? (unsigned)(MCAP - MCAP_F) : (unsigned)MCAP_F;
            att::unit_A_gather(F, a, (lo_ >> 6) & 3, lo_ & 63, lo_ >> 8, g - pre[lo_], (int)(c < cap ? c : cap)); }
    }
#endif
#ifndef NO_B
    for (;;) { const int u = next_unit(F, q + 192); if (u >= 512) break; att::unit_B(F, a, layer, u & 7, u >> 3); }
#endif
    }
}

DI void ins16(float (&v)[16], float x) {
#pragma unroll
    for (int k = 0; k < 16; ++k) { const float t = fmaxf(v[k], x); x = fminf(v[k], x); v[k] = t; }
}
DI float pack_idx(float s, int idx, unsigned mask) { return __uint_as_float((__float_as_uint(s) & ~mask) | (unsigned)idx); }
DI void peer_select_group(const Frame& F, const bf16_t* SK, int grp, LAS unsigned char* sel) {
    const bf16_t* QP = wsb(F, WS_H);
    int lane = F.lane; asm volatile("" : "+v"(lane));
    const int r = lane & 31, hi = lane >> 5;
    {
        const int h = F.wave, t = grp * 32 + r;
        float L[2][16];
#pragma unroll
        for (int m = 0; m < 2; ++m) {
            const bf16_t* qrow = QP + (size_t)t * DM + h * 256 + m * 128 + hi * 8;
            bf16x8 qf[8];
#pragma unroll
            for (int kk = 0; kk < 8; ++kk) qf[kk] = *(const bf16x8*)(qrow + kk * 16);
            const bf16_t* kb = SK + ((size_t)(h * 2 + m) * 128 + r) * 128 + hi * 8;
            float v[16];
#pragma unroll
            for (int k = 0; k < 16; ++k) v[k] = -3.0e38f;
#pragma unroll
            for (int rb = 0; rb < 4; ++rb) {
                f32x16 s;
#pragma unroll
                for (int i = 0; i < 16; ++i) s[i] = 0.f;
#pragma unroll
                for (int kk = 0; kk < 8; ++kk) { const bf16x8 kf = *(const bf16x8*)(kb + (size_t)rb * 32 * 128 + kk * 16); s = __builtin_amdgcn_mfma_f32_32x32x16_bf16(kf, qf[kk], s, 0, 0, 0); }
#pragma unroll
                for (int i = 0; i < 16; ++i) ins16(v, pack_idx(s[i], rb * 32 + (i & 3) + 8 * (i >> 2) + 4 * hi, 127u));
                asm volatile("" : "+v"(v[0]), "+v"(v[1]), "+v"(v[2]), "+v"(v[3]), "+v"(v[4]), "+v"(v[5]), "+v"(v[6]), "+v"(v[7]), "+v"(v[8]), "+v"(v[9]), "+v"(v[10]), "+v"(v[11]), "+v"(v[12]), "+v"(v[13]), "+v"(v[14]), "+v"(v[15]));
                asm volatile("" : "+v"(kb));
            }
            float ov[16];
#pragma unroll
            for (int k = 0; k < 16; ++k) ov[k] = xhalf(v[k]);
#pragma unroll
            for (int k = 0; k < 16; ++k) ins16(v, ov[k]);
#pragma unroll
            for (int k = 0; k < 16; ++k) L[m][k] = v[k];
        }
        int i0[16], i1[16];
#pragma unroll
        for (int k = 0; k < 16; ++k) { i0[k] = (int)(__float_as_uint(L[0][k]) & 127u); i1[k] = (int)(__float_as_uint(L[1][k]) & 127u); L[0][k] = __uint_as_float(__float_as_uint(L[0][k]) & ~127u); L[1][k] = __uint_as_float(__float_as_uint(L[1][k]) & ~127u); }
        float b[16];
#pragma unroll
        for (int k = 0; k < 16; ++k) b[k] = -3.0e38f;
#pragma unroll
        for (int i = 0; i < 16; ++i)
#pragma unroll
            for (int j = 0; j < 16; ++j) if ((i + 1) * (j + 1) <= 16) ins16(b, pack_idx(L[0][i] + L[1][j], i * 16 + j, 255u));
        float g[16]; int e[16]; float den = 0.f;
        const float b0 = __uint_as_float(__float_as_uint(b[0]) & ~255u);
#pragma unroll
        for (int k = 0; k < 16; ++k) {
            const unsigned bits = __float_as_uint(b[k]); const int ci = (int)((bits >> 4) & 15u), cj = (int)(bits & 15u);
            int e0 = i0[0], e1 = i1[0];
#pragma unroll
            for (int c = 1; c < 16; ++c) { e0 = (ci == c) ? i0[c] : e0; e1 = (cj == c) ? i1[c] : e1; }
            e[k] = e0 * 128 + e1;
            g[k] = ex2((__uint_as_float(bits & ~255u) - b0) * LOG2E); den += g[k];
        }
        const float inv = 1.0f / den;
        if (hi == 0) {
#pragma unroll
            for (int k = 0; k < 16; k += 4) *(LAS i32x4*)(sel + (r * 128 + h * 16 + k) * 4) = (i32x4){e[k], e[k + 1], e[k + 2], e[k + 3]};
        } else {
#pragma unroll
            for (int k = 0; k < 16; k += 4) *(LAS f32x4*)(sel + 16384 + (r * 128 + h * 16 + k) * 4) = (f32x4){g[k] * inv, g[k + 1] * inv, g[k + 2] * inv, g[k + 3] * inv};
        }
    }
}
DI float gelu_as(float v) {
    const float av = fabsf(v), t = __builtin_amdgcn_rcpf(av * 0.2316418882f + 1.0f);
    float q = t * 0.5307027145f + (-0.7265760135f); q = q * t + 0.7107068705f; q = q * t + (-0.142248368f); q = q * t + 0.127414796f; q = q * t;
    const float e = ex2((v * v) * (-0.72134752044f));
    const float m = v * (q * e);
    return v < 0.f ? m : v - m;
}
template <int CTRL, int RM> DI float dpp_add(float v) { return v + __builtin_bit_cast(float, __builtin_amdgcn_update_dpp(0, __builtin_bit_cast(int, v), CTRL, RM, 0xf, RM == 0xf)); }
DI float wave_total(float v) {
    v = dpp_add<0x111, 0xf>(v); v = dpp_add<0x112, 0xf>(v); v = dpp_add<0x114, 0xf>(v); v = dpp_add<0x118, 0xf>(v);
    v = dpp_add<0x142, 0xa>(v); v = dpp_add<0x143, 0xc>(v);
    return __uint_as_float(__builtin_amdgcn_readlane(__float_as_uint(v), 63));
}
DI void reduce4(float (&d)[4], int lane) {
#pragma unroll
    for (int i = 0; i < 4; ++i) d[i] = wave_total(d[i]);
}
DI void peer_gather_group(const Frame& F, const Args& a, int layer, float* outf, bf16_t* XB, int grp, const LAS unsigned char* sel) {
    typedef int v8i_t __attribute__((ext_vector_type(8)));
    const unsigned char* UB = F.ws + WS_UB;
    int lane = F.lane; asm volatile("" : "+v"(lane));
    const int m16 = lane & 15, g4 = lane >> 4;
    LAS unsigned char* x8 = F.lds + 65536 + F.wave * 2048;
    int sc = 0x7f7f7f7f; asm volatile("" : "+v"(sc));
    for (int ti = 0; ti < 4; ++ti) {
        const int tl = F.wave * 4 + ti, t = grp * 32 + tl;
        const bf16_t* xr = XB + (size_t)t * DM + 32 * lane;
        {
            u32x4 w8[2];
#pragma unroll
            for (int c = 0; c < 4; ++c) { const u32x4 w = *(const u32x4*)(xr + 8 * c);
#if PEER_X_SWAP
                int lo = __builtin_amdgcn_cvt_pk_fp8_f32(bf_hi(w.x), bf_lo(w.x), 0, false); lo = __builtin_amdgcn_cvt_pk_fp8_f32(bf_hi(w.y), bf_lo(w.y), lo, true);
                int hi = __builtin_amdgcn_cvt_pk_fp8_f32(bf_hi(w.z), bf_lo(w.z), 0, false); hi = __builtin_amdgcn_cvt_pk_fp8_f32(bf_hi(w.w), bf_lo(w.w), hi, true);
#else
                int lo = __builtin_amdgcn_cvt_pk_fp8_f32(bf_lo(w.x), bf_hi(w.x), 0, false); lo = __builtin_amdgcn_cvt_pk_fp8_f32(bf_lo(w.y), bf_hi(w.y), lo, true);
                int hi = __builtin_amdgcn_cvt_pk_fp8_f32(bf_lo(w.z), bf_hi(w.z), 0, false); hi = __builtin_amdgcn_cvt_pk_fp8_f32(bf_lo(w.w), bf_hi(w.w), hi, true);
#endif
                w8[c >> 1][(c & 1) * 2] = (unsigned)lo; w8[c >> 1][(c & 1) * 2 + 1] = (unsigned)hi; }
            *(LAS u32x4*)(x8 + 32 * lane) = w8[0]; *(LAS u32x4*)(x8 + 32 * lane + 16) = w8[1];
        }
        f32x2 acc[16];
#pragma unroll
        for (int e = 0; e < 16; ++e) acc[e] = (f32x2){0.f, 0.f};
        for (int half = 0; half < 2; ++half) {
            const int ev = *(const LAS int*)(sel + (tl * 128 + half * 64 + lane) * 4); const float gv = *(const LAS float*)(sel + 16384 + (tl * 128 + half * 64 + lane) * 4);
            for (int bb = 0; bb < 4; ++bb) {
                const int em = __builtin_amdgcn_ds_bpermute((16 * bb + m16) << 2, ev);
                const unsigned char* up = UB + (size_t)em * 2048 + 16 * g4;
                u32x4 ua[16], va[16];
#pragma unroll
                for (int s = 0; s < 16; ++s) ua[s] = *(const u32x4*)(up + 64 * s);
#pragma unroll
                for (int j = 0; j < 16; ++j) { const int e = __builtin_amdgcn_readlane(ev, 16 * bb + j); va[j] = *(const u32x4*)(UB + (size_t)e * 2048 + 1024 + 16 * lane); }
                f32x4 h = (f32x4){0.f, 0.f, 0.f, 0.f};
#pragma unroll
                for (int s = 0; s < 16; ++s) {
                    const u32x4 x0 = *(const LAS u32x4*)(x8 + 128 * s + 16 * g4), x1 = *(const LAS u32x4*)(x8 + 128 * s + 64 + 16 * g4);
                    const v8i_t xb = (v8i_t){(int)x0.x, (int)x0.y, (int)x0.z, (int)x0.w, (int)x1.x, (int)x1.y, (int)x1.z, (int)x1.w};
                    asm volatile("s_nop 1\n\tv_mfma_scale_f32_16x16x128_f8f6f4 %0, %1, %2, %0, %3, %3 op_sel_hi:[0,0,0] cbsz:4" : "+v"(h) : "v"(ua[s]), "v"(xb), "v"(sc));
                }
                asm volatile("s_nop 15" : "+v"(h));
                float hv[4];
#pragma unroll
                for (int i = 0; i < 4; ++i) { const float gq = __int_as_float(__builtin_amdgcn_ds_bpermute((16 * bb + 4 * g4 + i) << 2, __float_as_int(gv)));
                    hv[i] = gq * gelu_as(h[i] * (1.0f / U_SCALE)) * (1.0f / V_SCALE); }
#pragma unroll
                for (int j = 0; j < 16; ++j) {
                    const float wk = __uint_as_float(__builtin_amdgcn_readlane(__float_as_uint(hv[j & 3]), 16 * (j >> 2)));
                    const f32x2 wk2 = (f32x2){wk, wk}; const u32x4 w_ = va[j];
#define FP4_ACC(b) acc[b] += __builtin_amdgcn_cvt_scalef32_pk_f32_fp4(w_[(b) >> 2], 1.0f, (b) & 3) * wk2;
                    FP4_ACC(0) FP4_ACC(1) FP4_ACC(2) FP4_ACC(3) FP4_ACC(4) FP4_ACC(5) FP4_ACC(6) FP4_ACC(7) FP4_ACC(8) FP4_ACC(9) FP4_ACC(10) FP4_ACC(11) FP4_ACC(12) FP4_ACC(13) FP4_ACC(14) FP4_ACC(15)
#undef FP4_ACC
                }
            }
        }
        float z[1][32];
#pragma unroll
        for (int c = 0; c < 4; ++c) { const u32x4 w = *(const u32x4*)(xr + 8 * c);
            z[0][8 * c + 0] = acc[4 * c].x + DN_ALPHA * bf_lo(w.x); z[0][8 * c + 1] = acc[4 * c].y + DN_ALPHA * bf_hi(w.x); z[0][8 * c + 2] = acc[4 * c + 1].x + DN_ALPHA * bf_lo(w.y); z[0][8 * c + 3] = acc[4 * c + 1].y + DN_ALPHA * bf_hi(w.y);
            z[0][8 * c + 4] = acc[4 * c + 2].x + DN_ALPHA * bf_lo(w.z); z[0][8 * c + 5] = acc[4 * c + 2].y + DN_ALPHA * bf_hi(w.z); z[0][8 * c + 6] = acc[4 * c + 3].x + DN_ALPHA * bf_lo(w.w); z[0][8 * c + 7] = acc[4 * c + 3].y + DN_ALPHA * bf_hi(w.w); }
        ln_store<1, 32>(z, a.in[24] + layer * DM, a.in[25] + layer * DM, outf ? outf + (size_t)t * DM : (float*)nullptr, outf ? (bf16_t*)nullptr : XB + (size_t)t * DM, lane, outf ? (unsigned char*)nullptr : F.ws + WS_XB8 + (size_t)t * DM, outf ? (unsigned char*)nullptr : F.ws + WS_XB4 + (size_t)t * (DM / 2));
    }
}
DI void phase_peer(const Frame& F, const Args& a, int layer, const bf16_t* SK, float* outf) {
    LAS unsigned char* sel = F.lds;
    bf16_t* XB = wsb(F, WS_XB);
    const int g0 = F.vcu, g1 = F.vcu + F.G, ng = S / 32;
    if (F.vcu & 1) {
        if (g0 < ng) peer_select_group(F, SK, g0, sel);
        if (g1 < ng) peer_select_group(F, SK, g1, sel + 32768);
        __syncthreads();
        if (g0 < ng) peer_gather_group(F, a, layer, outf, XB, g0, sel);
        if (g1 < ng) peer_gather_group(F, a, layer, outf, XB, g1, sel + 32768);
    } else {
        if (g0 < ng) peer_select_group(F, SK, g0, sel);
        __syncthreads();
        if (g0 < ng) peer_gather_group(F, a, layer, outf, XB, g0, sel);
        if (g1 < ng) peer_select_group(F, SK, g1, sel + 32768);
        __syncthreads();
        if (g1 < ng) peer_gather_group(F, a, layer, outf, XB, g1, sel + 32768);
    }
    for (int g = F.vcu + 2 * F.G; g < ng; g += F.G) { __syncthreads(); peer_select_group(F, SK, g, sel); __syncthreads(); peer_gather_group(F, a, layer, outf, XB, g, sel); }
}

#ifndef GEMM_SP2
#define GEMM_SP2 true
#endif
#ifndef GEMM_ALIGN_EPI
#define GEMM_ALIGN_EPI true
#endif
DI void run_merge_chain(const Frame& F, const unsigned char* O8a, const unsigned char* Wbr, const pg8::Epi<5>& E) {
    pg8::Gemm g{(const bf16_t*)O8a, (const bf16_t*)Wbr, S, DM, 256, 256, 256, 0, (long)S * 512, (long)DM * 512 * 2}; pg8::ChainOrder<4> So; So.init(S, DM, F.G, (int)blockIdx.x);
    pg8::gemm_phase<pg8::Epi<5>, pg8::ChainOrder<4>, GEMM_ALIGN_EPI, GEMM_SP2, true, 121, 124, false>(F.lds, g, So, E);
}
template <int MODE, bool F8 = false, int SC0 = 127, int SC1 = 127, bool F4 = false> DI void run_gemm(const Frame& F, const bf16_t* A, int lda, const bf16_t* Bt, int ldb, int M, int N, int K, long apn, const pg8::Epi<MODE>& E, int rot = 0) {
    pg8::Gemm g{A, Bt, M, N, K, lda, ldb, apn}; pg8::StaticOrder So; So.init(M, N, F.G, (F.G == 256) ? (int)((blockIdx.x + (unsigned)rot) & 255u) : (int)blockIdx.x);
    pg8::gemm_phase<pg8::Epi<MODE>, pg8::StaticOrder, GEMM_ALIGN_EPI, GEMM_SP2, F8, SC0, SC1, F4>(F.lds, g, So, E);
}
#ifndef MK_CHECK
#define MK_CHECK 0
#endif
#ifndef MK_CHECK_WORD
#define MK_CHECK_WORD 0
#endif

#if MK_CHECK
namespace chk {
constexpr int NS = 64;
__device__ const int SAMPLES[NS] = {0, 1, 2, 31, 32, 63, 64, 127, 128, 129, 255, 256, 257, 300, 383, 384, 511, 512, 513, 767, 768, 1000, 1023, 1024, 1025, 1279, 1280, 2047, 2048, 2049, 3071, 3072,
    4095, 4096, 5000, 6143, 6144, 7777, 8191, 8192, 8193, 9999, 10239, 10240, 11111, 12287, 12288, 12289, 13000, 13311, 13312, 14000, 14335, 14336, 15000, 15359, 15360, 15871, 16127, 16128, 16129, 16255, 16256, 16383};
DI float bsum(const Frame& F, float v) {
    v = wave_sum(v);
    __syncthreads();
    if (F.lane == 0) F.MISC[16 + F.wave] = __float_as_uint(v);
    __syncthreads();
    float s = 0.f;
    for (int w = 0; w < 8; ++w) s += __uint_as_float(F.MISC[16 + w]);
    return s;
}
DI float bmax(const Frame& F, float v) {
#pragma unroll
    for (int o = 1; o < 64; o <<= 1) v = fmaxf(v, __shfl_xor(v, o));
    __syncthreads();
    if (F.lane == 0) F.MISC[16 + F.wave] = __float_as_uint(v);
    __syncthreads();
    float s = -INFINITY;
    for (int w = 0; w < 8; ++w) s = fmaxf(s, __uint_as_float(F.MISC[16 + w]));
    return s;
}
DI void verdict(const Frame& F, float err, float nrm, float tol, int code) {
    const float e = bsum(F, err), n = bsum(F, nrm);
    if (F.tid == 0) { const bool bad = !(e <= tol * tol * n + 1e-12f); if (bad) { atomicAdd((unsigned*)(F.ws + WS_CTL) + CW_CHK, 1u); atomicAdd((unsigned*)(F.ws + WS_CTL) + CW_CHK + 64 * (1 + code), 1u); } }
}
DI float sigm(float z) { return 1.0f / (1.0f + expf(-z)); }
DI float rope_inv(int j) { return powf(10000.0f, -(float)j / 32.0f); }
DI float t5_naive(const float* t5, int col, int rel) {
    int n = rel > 0 ? rel : 0; int b;
    if (n < 16) b = n; else { b = 16 + (int)(logf((float)n / 16.0f) / logf(64.0f) * 16.0f); if (b > 31) b = 31; }
    return t5[b * 16 + col];
}
DI void s1(const Frame& F, const Args& a, int layer) {
    const bf16_t* X = wsb(F, WS_XB); const float* W = a.in[3] + (size_t)layer * DM * 4672;
    const bf16_t* H = wsb(F, WS_H); const bf16_t* VT = wsb(F, WS_VT);
    for (int u = F.vcu; u < NS; u += F.G) { const int t = SAMPLES[u]; float err = 0.f, nrm = 0.f;
        for (int c = F.tid; c < 4672; c += 512) { float ref = 0.f; for (int k = 0; k < DM; ++k) ref += bf1(X[(size_t)t * DM + k]) * W[(size_t)k * 4672 + c];
            const int d = win_map(c); const float got = d < HW ? bf1(H[(size_t)t * HW + d]) : bf1(VT[(size_t)(d - HW) * S + t]); err += (ref - got) * (ref - got); nrm += ref * ref; }
        verdict(F, err, nrm, 0.06f, 0); }
}
DI void s2(const Frame& F, const Args& a, int layer) {
    const bf16_t* H = wsb(F, WS_H); const int* pos = (const int*)a.in[1];
    for (int u = F.vcu; u < NS; u += F.G) { const int t = SAMPLES[u]; float err = 0.f, nrm = 0.f;
        float ssq = 0.f; for (int k = 0; k < 512; ++k) { const float v = bf1(H[(size_t)t * HW + H_DCQ + k]); ssq += v * v; }
        const float rq = 1.0f / sqrtf(ssq / 512.0f + 1e-6f);
        float ssk = 0.f; for (int k = 0; k < 256; ++k) { const float v = bf1(H[(size_t)t * HW + H_DCKV + k]); ssk += v * v; }
        const float rk = 1.0f / sqrtf(ssk / 256.0f + 1e-6f);
        for (int c = F.tid; c < 512; c += 512) { const float ref = bf1(H[(size_t)t * HW + H_DCQ + c]) * rq * a.in[14][layer * 512 + c]; const float got = bf1(wsb(F, WS_CQN)[(size_t)t * 512 + c]); err += (ref - got) * (ref - got); nrm += ref * ref; }
        for (int c = F.tid; c < 256; c += 512) { const float ref = bf1(H[(size_t)t * HW + H_DCKV + c]) * rk * a.in[15][layer * 256 + c]; const float got = bf1(wsb(F, WS_CKVN)[(size_t)t * 256 + c]); err += (ref - got) * (ref - got); nrm += ref * ref; }
        for (int c = F.tid; c < 256; c += 512) { const int h = c >> 6, j = c & 63, jj = j & 31; const float x1 = bf1(H[(size_t)t * HW + H_DKR + jj]), x2 = bf1(H[(size_t)t * HW + H_DKR + jj + 32]);
            const float ang = (float)pos[t] * rope_inv(jj); const float ref = j < 32 ? x1 * cosf(ang) - x2 * sinf(ang) : x1 * sinf(ang) + x2 * cosf(ang);
            const float got = bf1(wsb(F, WS_KD)[(size_t)t * 768 + h * 192 + 128 + j]); err += (ref - got) * (ref - got); nrm += ref * ref; }
        verdict(F, err, nrm, 0.02f, 1); }
}
DI void s3(const Frame& F, const Args& a, int layer) {
    const int* pos = (const int*)a.in[1]; const float* Wq = a.in[16] + (size_t)layer * 512 * 768; const float* Wkv = a.in[17] + (size_t)layer * 256 * 1024;
    LAS float* pre = (LAS float*)F.lds;
    for (int u = F.vcu; u < NS; u += F.G) { const int t = SAMPLES[u]; float err = 0.f, nrm = 0.f;
        __syncthreads();
        for (int n = F.tid; n < 768; n += 512) { float r = 0.f; for (int k = 0; k < 512; ++k) r += bf1(wsb(F, WS_CQN)[(size_t)t * 512 + k]) * Wq[(size_t)k * 768 + n]; pre[n] = r; }
        __syncthreads();
        for (int n = F.tid; n < 768; n += 512) { const int h = n / 192, j = n % 192; float ref = pre[n];
            if (j >= 128) { const int jj = (j - 128) & 31; const float x1 = pre[h * 192 + 128 + jj], x2 = pre[h * 192 + 128 + jj + 32]; const float ang = (float)pos[t] * rope_inv(jj);
                ref = (j - 128) < 32 ? x1 * cosf(ang) - x2 * sinf(ang) : x1 * sinf(ang) + x2 * cosf(ang); }
            const float got = bf1(wsb(F, WS_QD)[(size_t)t * 768 + n]); err += (ref - got) * (ref - got); nrm += ref * ref; }
        for (int n = F.tid; n < 1024; n += 512) { float ref = 0.f; for (int k = 0; k < 256; ++k) ref += bf1(wsb(F, WS_CKVN)[(size_t)t * 256 + k]) * Wkv[(size_t)k * 1024 + n];
            const int h = n >> 8, j = n & 255; const float got = j < 128 ? bf1(wsb(F, WS_KD)[(size_t)t * 768 + h * 192 + j]) : bf1(wsb(F, WS_VDT)[(size_t)(h * 128 + j - 128) * S + t]);
            err += (ref - got) * (ref - got); nrm += ref * ref; }
        verdict(F, err, nrm, 0.02f, 2); }
}
DI void s4(const Frame& F, const Args& a, int layer) {
    const int* pos = (const int*)a.in[1]; const float* t5 = a.in[2]; const bf16_t* H = wsb(F, WS_H);
    LAS float* lg = (LAS float*)F.lds;
    LAS float* qv = (LAS float*)(F.lds + 65536);
    LAS float* ga = (LAS float*)(F.lds + 65536 + 1024);
    LAS float* op = (LAS float*)(F.lds + 65536 + 2048);
    LAS float* o1 = (LAS float*)(F.lds + 65536 + 2048 + 2048);
    LAS int* selb = (LAS int*)(F.lds + 65536 + 8192);
    for (int u = F.vcu; u < NS * 20; u += F.G) {
        const int q = SAMPLES[u / 20], mh = u % 20;
        int mix, h; if (mh < 4) { mix = 0; h = mh; } else if (mh < 12) { mix = 1; h = mh - 4; } else if (mh < 16) { mix = 2; h = mh - 12; } else { mix = 3; h = mh - 16; }
        const int DQ = mix == 0 ? 128 : (mix == 3 ? 192 : 64), DVV = mix == 1 ? 64 : 128;
        const int nmaps = mix == 2 ? 2 : 1;
        const float scale = 1.0f / sqrtf((float)DQ);
        const int bcol = mix == 0 ? h : (mix == 1 ? 4 + h : 12 + h);
        float errs = 0.f, nrms = 0.f;
        for (int mp = 0; mp < nmaps; ++mp) {
            const bf16_t* Qp; const bf16_t* Kp; int ldk; const bf16_t* Vp;
            if (mix == 0) { Qp = H + (size_t)q * HW + H_AQ + h * 128; Kp = H + H_AK + h * 128; ldk = HW; Vp = wsb(F, WS_VT) + (size_t)(VT_A + h * 128) * S; }
            else if (mix == 1) { Qp = H + (size_t)q * HW + H_BQ + h * 64; Kp = H + H_BK + (h >> 2) * 64; ldk = HW; Vp = wsb(F, WS_VT) + (size_t)(VT_B + (h >> 2) * 64) * S; }
            else if (mix == 2) { Qp = H + (size_t)q * HW + H_CQ + h * 128 + mp * 64; Kp = H + H_CK + h * 128 + mp * 64; ldk = HW; Vp = wsb(F, WS_VT) + (size_t)(VT_C + h * 128) * S; }
            else { Qp = wsb(F, WS_QD) + (size_t)q * 768 + h * 192; Kp = wsb(F, WS_KD) + h * 192; ldk = 768; Vp = wsb(F, WS_VDT) + (size_t)(h * 128) * S; }
            __syncthreads();
            for (int d = F.tid; d < DQ; d += 512) qv[d] = bf1(Qp[d]);
            if (F.tid < 64) { ga[F.tid] = 0.f; selb[F.tid] = 0; }
            __syncthreads();
            const int own = q >> 8;
            if (mix == 0) {
                for (int idx = F.tid; idx < own * 128; idx += 512) { const int n = idx >> 7, d = idx & 127; float sm = 0.f; for (int i = 0; i < 256; ++i) sm += bf1(Kp[(size_t)(n * 256 + i) * ldk + d]); atomicAdd((float*)&ga[n], qv[d] * (sm / 256.0f)); }
                __syncthreads();
                if (F.tid == 0) { for (int rnk = 0; rnk < 3 && rnk < own; ++rnk) { int best = -1; float bv = -INFINITY; for (int n = 0; n < own; ++n) if (!selb[n] && ga[n] > bv) { bv = ga[n]; best = n; } if (best >= 0) selb[best] = 1; } }
                __syncthreads();
            }
            float mx = -INFINITY;
            for (int k = F.tid; k <= q; k += 512) {
                bool valid = true;
                if (mix == 0) { const int blk = k >> 8; valid = (blk == own) ? true : (selb[blk] != 0); }
                if (mix == 1) valid = (q - k) < 128;
                float l = -INFINITY;
                if (valid) { float dot = 0.f; for (int d = 0; d < DQ; ++d) dot += qv[d] * bf1(Kp[(size_t)k * ldk + d]); l = dot * scale; if (mix != 3) l += t5_naive(t5, bcol, pos[q] - pos[k]); }
                lg[k] = l; mx = fmaxf(mx, l);
            }
            mx = bmax(F, mx);
            const float sink = (mix == 1) ? a.in[8][layer * 8 + h] : -INFINITY;
            if (mix == 1) mx = fmaxf(mx, sink);
            float sm = 0.f;
            for (int k = F.tid; k <= q; k += 512) { const float p = expf(lg[k] - mx); lg[k] = p; sm += p; }
            sm = bsum(F, sm);
            if (mix == 1) sm += expf(sink - mx);
            __syncthreads();
            { const int dv = F.tid % 128, part = F.tid / 128; float acc = 0.f;
              if (dv < DVV) for (int k = part; k <= q; k += 4) acc += lg[k] * bf1(Vp[(size_t)dv * S + k]);
              op[part * 128 + dv] = acc; }
            __syncthreads();
            float val = 0.f;
            if (F.tid < DVV) val = (op[F.tid] + op[128 + F.tid] + op[256 + F.tid] + op[384 + F.tid]) / sm;
            if (mix == 2 && mp == 0) { if (F.tid < 128) o1[F.tid] = val; __syncthreads(); continue; }
            if (mix == 2) {
                float d1 = 0.f, d2 = 0.f; for (int i = 0; i < 64; ++i) { d1 += a.in[9][layer * 64 + i] * a.in[10][layer * 64 + i]; d2 += a.in[11][layer * 64 + i] * a.in[12][layer * 64 + i]; }
                const float li = 0.8f - 0.6f * expf(-0.3f * (float)layer), lam = expf(d1) - expf(d2) + li;
                float x = (F.tid < 128) ? (o1[F.tid] - lam * val) : 0.f;
                const float ms = bsum(F, x * x) / 128.0f;
                val = x / sqrtf(ms + 1e-6f) * ((F.tid < 128) ? a.in[13][layer * 128 + F.tid] : 0.f) * (1.0f - li);
            }
            if (F.tid < DVV) { const int ocol = (mix == 1) ? h * 64 + F.tid : h * 128 + F.tid; const float got = bf1(wsb(F, WS_O)[(size_t)mix * S * 512 + (size_t)q * 512 + ocol]); errs = (val - got) * (val - got); nrms = val * val; }
        }
        verdict(F, errs, nrms, 0.03f, 3 + mix);
    }
}
DI void s5(const Frame& F, const Args& a, int layer) {
    const bf16_t* X = wsb(F, WS_XB);
    for (int u = F.vcu; u < NS; u += F.G) { const int t = SAMPLES[u]; float err = 0.f, nrm = 0.f, err2 = 0.f, nrm2 = 0.f;
        for (int c = F.tid; c < 8192; c += 512) { const int n = c >> 11, cc = c & 2047; const float* W = a.in[4] + ((size_t)layer * 4 + n) * DM * DM; float z = a.in[5][(size_t)layer * 8192 + c];
            for (int k = 0; k < DM; ++k) z += bf1(X[(size_t)t * DM + k]) * W[(size_t)k * DM + cc];
            const float ref = sigm(z), got = 1.0f / __builtin_amdgcn_cvt_pk_f32_fp8((int)(F.ws + WS_GT)[(size_t)t * 8192 + c], false)[0]; err += (ref - got) * (ref - got); nrm += ref * ref; }
        for (int c = F.tid; c < DM; c += 512) { float ref = 0.f;
            for (int n = 0; n < 4; ++n) { const float* W = a.in[6] + ((size_t)layer * 4 + n) * 512 * DM; float br = 0.f; for (int j = 0; j < 512; ++j) br += bf1(wsb(F, WS_O)[(size_t)n * S * 512 + (size_t)t * 512 + j]) * W[(size_t)j * DM + c];
                ref += br / __builtin_amdgcn_cvt_pk_f32_fp8((int)(F.ws + WS_GT)[(size_t)t * 8192 + n * DM + c], false)[0]; }
            const float got = bf1(wsb(F, WS_H)[(size_t)t * DM + c]); err2 += (ref - got) * (ref - got); nrm2 += ref * ref; }
        verdict(F, err, nrm, 0.12f, 7); verdict(F, err2, nrm2, 0.12f, 8); }
}
DI void s6(const Frame& F, const Args& a, int layer) {
    const bf16_t* X = wsb(F, WS_XB); const float* W = a.in[7] + (size_t)layer * DM * DM; const bf16_t* Y = wsb(F, WS_GT);
    for (int u = F.vcu; u < NS; u += F.G) { const int t = SAMPLES[u]; float err = 0.f, nrm = 0.f;
        for (int c = F.tid; c < DM; c += 512) { float ref = 0.f; for (int j = 0; j < DM; ++j) ref += bf1(wsb(F, WS_H)[(size_t)t * DM + j]) * W[(size_t)j * DM + c];
            const float full = DN_ALPHA * bf1(X[(size_t)t * DM + c]) + ref, got = bf1(Y[(size_t)t * DM + c]); err += (full - got) * (full - got); nrm += full * full; }
        verdict(F, err, nrm, 0.006f, 9); }
}
DI void poison(const Frame& F) {
    const unsigned bad = __hip_atomic_load((unsigned*)(F.ws + WS_CTL) + CW_CHK + 64 * MK_CHECK_WORD, __ATOMIC_RELAXED, __HIP_MEMORY_SCOPE_AGENT);
    const float sc = 1.0f + (float)bad / 256.0f;
    for (size_t i = (size_t)F.vcu * 512 + F.tid; i < (size_t)S * DM / 4; i += (size_t)F.G * 512) { f32x4 v = ((f32x4*)F.out)[i]; v = v * sc; ((f32x4*)F.out)[i] = v; }
}
}
#endif

#ifndef MK_CHECK
#define MK_CHECK 0
#endif
#ifndef MK_CHECK_WORD
#define MK_CHECK_WORD 0
#endif
#ifndef MK_CHECK_LAYER
#define MK_CHECK_LAYER 0
#endif
#ifndef MERGE_CHAIN
#define MERGE_CHAIN 1
#endif
#ifndef MK_X_BAR2
#define MK_X_BAR2 0
#endif
#ifndef MK_PROBE_REL
#define MK_PROBE_REL (-2)
#endif
#ifndef MK_PROBE_REPS
#define MK_PROBE_REPS 1
#endif
#ifndef MK_PER_PHASE
#define MK_PER_PHASE 0
#endif
constexpr int NPL = 11, NPHASES = 1 + NL * NPL;
DI void run_layer(const Frame& F, const Args& args, const XcdBarrier& bar, const int layer, const int lo, const int hi) {
#define PH(k) (lo <= (k) && (k) < hi)
#define SEAM(k) do { if (PH(k) && PH((k) + 1)) { xcd_barrier(bar); if (MK_X_BAR2) xcd_barrier(bar); } } while (0)
        const int pb = 1 + layer * NPL;
        unsigned char* wl = F.ws + WS_W + (size_t)layer * WL_STRIDE;
        if (PH(pb + 0)) {
            { pg8::Epi<0> E{}; E.O = wsb(F, WS_H); E.ldc = HW; E.grp = 128; run_gemm<0, true, 121, 127>(F, (const bf16_t*)(F.ws + WS_XB8), DM / 2, (const bf16_t*)(wl + W_IN), DM / 2, S, HW, DM / 2, 0, E); }
            { pg8::Epi<0> E{}; E.O = wsb(F, WS_VT); E.ldc = S; E.grp = 128; run_gemm<0, true, 127, 121>(F, (const bf16_t*)(wl + W_IN + (size_t)HW * DM), DM / 2, (const bf16_t*)(F.ws + WS_XB8), DM / 2, VT_ROWS, S, DM / 2, 0, E, 128); }
            { pg8::Epi<1> E{}; E.O = wsb(F, WS_GT); E.ldc = 8192; E.bias = args.in[5] + (size_t)layer * 8192; run_gemm<1, false, 121, 126, true>(F, (const bf16_t*)(F.ws + WS_XB4), DM / 4, (const bf16_t*)(wl + W_G), DM / 4, S, 8192, DM / 4, 0, E); }
        }
        SEAM(pb + 0);
        if (PH(pb + 1)) phase_prep(F, args, layer);
        SEAM(pb + 1);
        if (PH(pb + 2)) {
            { pg8::Epi<0> E{}; E.O = wsb(F, WS_QD); E.ldc = 768; E.grp = 128; run_gemm<0>(F, wsb(F, WS_CQN), 512, (const bf16_t*)(wl + W_UQ), 512, S, 768, 512, 0, E); }
            { pg8::Epi<0> E{}; E.O = wsb(F, WS_KD); E.ldc = 768; E.grp = 192; run_gemm<0>(F, wsb(F, WS_CKVN), 256, (const bf16_t*)(wl + W_UKV), 256, S, 512, 256, 0, E, 64); }
            { pg8::Epi<0> E{}; E.O = wsb(F, WS_VDT); E.ldc = S; E.grp = 128; run_gemm<0>(F, (const bf16_t*)(wl + W_UKV) + (size_t)512 * 256, 256, wsb(F, WS_CKVN), 256, 512, S, 256, 0, E, 192); }
        }
        SEAM(pb + 2);
        if (PH(pb + 3)) { phase_ropeq(F, args); phase_moba_select(F, args, layer); }
        SEAM(pb + 3);
        if (PH(pb + 4)) {
            phase_attention<0>(F, args, layer);
            if (layer + 1 < NL) convert_weights(F, args, layer + 1, layer + 2);
            __syncthreads();
            phase_attention<1>(F, args, layer);
        }
        SEAM(pb + 4);
        if (PH(pb + 5)) phase_mixer_combine(F, args, layer);
        SEAM(pb + 5);
        if (PH(pb + 6)) {
            if (MERGE_CHAIN) { pg8::Epi<5> E{}; E.O = wsb(F, WS_H); E.ldc = DM; E.G = (const bf16_t*)(F.ws + WS_GT); E.ldg = 8192; E.O8 = F.ws + WS_XB8;
                run_merge_chain(F, F.ws + WS_O8, wl + W_BR, E); }
            else
            for (int n = 0; n < 4; ++n) { pg8::Epi<2> E{}; E.O = wsb(F, WS_H); E.ldc = DM; E.G = (const bf16_t*)(F.ws + WS_GT + n * DM); E.ldg = 8192; E.first = (n == 0); E.O8 = (n == 3) ? F.ws + WS_XB8 : (unsigned char*)nullptr;
                run_gemm<2, true, 121, 124>(F, (const bf16_t*)(F.ws + WS_O8 + (size_t)n * S * 512), 256, (const bf16_t*)(wl + W_BR) + (size_t)n * DM * 512, 256, S, DM, 256, 0, E); }
        }
        SEAM(pb + 6);
        if (PH(pb + 7)) { pg8::Epi<3> E{}; E.O = F.ws + WS_GT; E.ldc = DM; E.X = wsb(F, WS_XB); E.alpha = DN_ALPHA;
            run_gemm<3, true, 121, 124>(F, (const bf16_t*)(F.ws + WS_XB8), DM / 2, (const bf16_t*)(wl + W_O), DM / 2, S, DM, DM / 2, 0, E); }
        SEAM(pb + 7);
        if (PH(pb + 8)) phase_ln1(F, args, layer);
        SEAM(pb + 8);
        if (PH(pb + 9)) { pg8::Epi<0> E{}; E.O = wsb(F, WS_H); E.ldc = DM; E.grp = 128; run_gemm<0>(F, wsb(F, WS_XB), DM, (const bf16_t*)(wl + W_PQ), DM, S, DM, DM, 0, E); }
        SEAM(pb + 9);
        if (PH(pb + 10)) phase_peer(F, args, layer, (const bf16_t*)(wl + W_SK), (layer == NL - 1) ? F.out : (float*)nullptr);
        SEAM(pb + 10);
#undef PH
#undef SEAM
}
__global__ void __launch_bounds__(512, 2) fwd_kernel(Args args) {
    extern __shared__ __attribute__((aligned(16))) unsigned char lds_raw[];
    Frame F;
    F.lds = (LAS unsigned char*)lds_raw; F.MISC = (volatile LAS unsigned*)(F.lds + MISC_OFF);
    F.tid = threadIdx.x; F.lane = F.tid & 63; F.wave = __builtin_amdgcn_readfirstlane(F.tid >> 6);
    F.G = gridDim.x; { const int bx = blockIdx.x; F.vcu = (F.G % 8 == 0) ? (bx % 8) * (F.G / 8) + bx / 8 : bx; }
    F.ws = args.ws; F.out = args.out;
    if (F.tid < 64) F.MISC[F.tid] = 0u;
    __syncthreads();
    const int lo = args.ph_lo, hi = args.ph_hi;
    unsigned* barw = (unsigned*)(F.ws + WS_CTL) + CW_BAR + (lo > 0 ? XCD_BAR_WORDS : 0);
    XcdBarrier bar; bar.bar = barw; bar.x = 0; bar.st = F.MISC;
    if (hi - lo > 1) bar = xcd_barrier_post(barw, F.MISC);
#define PH(k) (lo <= (k) && (k) < hi)
#define SEAM(k) do { if (PH(k) && PH((k) + 1)) { xcd_barrier(bar); if (MK_X_BAR2) xcd_barrier(bar); } } while (0)
    if (PH(0)) phase_prologue(F, args);
    SEAM(0);
    run_layer(F, args, bar, 0, lo, hi);
    run_layer(F, args, bar, 1, lo, hi);
#undef PH
#undef SEAM
}


#if MK_CHECK
__global__ void __launch_bounds__(512, 1) chk_kernel(Args args, int stage, int layer) {
    extern __shared__ __attribute__((aligned(16))) unsigned char lds_raw[];
    Frame F;
    F.lds = (LAS unsigned char*)lds_raw; F.MISC = (volatile LAS unsigned*)(F.lds + MISC_OFF);
    F.tid = threadIdx.x; F.lane = F.tid & 63; F.wave = __builtin_amdgcn_readfirstlane(F.tid >> 6);
    F.G = gridDim.x; { const int bx = blockIdx.x; F.vcu = (F.G % 8 == 0) ? (bx % 8) * (F.G / 8) + bx / 8 : bx; }
    F.ws = args.ws; F.out = args.out;
    if (stage == 1) { chk::s1(F, args, layer); chk::s2(F, args, layer); chk::s3(F, args, layer); }
    if (stage == 4) chk::s4(F, args, layer);
    if (stage == 5) chk::s5(F, args, layer);
    if (stage == 6) chk::s6(F, args, layer);
    if (stage == 99) chk::poison(F);
}
#endif
extern "C" void kernel_launch(void* const* d_in, const int* in_sizes, int n_in, void* d_out, int out_size, void* d_ws, size_t ws_size, hipStream_t stream) {
    static int grid = 0;
    if (grid == 0) {
        if (n_in != 26 || out_size != S * DM || ws_size < WS_END) { fprintf(stderr, "kernel_launch: unexpected problem (n_in %d, out %d, ws %zu); nothing launched\n", n_in, out_size, ws_size); grid = -1; return; }
        int dev = 0, cus = 0, per_cu = 0;
        if (hipGetDevice(&dev) != hipSuccess || hipDeviceGetAttribute(&cus, hipDeviceAttributeMultiprocessorCount, dev) != hipSuccess) { grid = -1; return; }
        if (hipFuncSetAttribute((const void*)fwd_kernel, hipFuncAttributeMaxDynamicSharedMemorySize, LDS_BYTES) != hipSuccess) { fprintf(stderr, "kernel_launch: hipFuncSetAttribute failed\n"); grid = -1; return; }
        if (hipOccupancyMaxActiveBlocksPerMultiprocessor(&per_cu, (const void*)fwd_kernel, 512, LDS_BYTES) != hipSuccess || per_cu < 1) { fprintf(stderr, "kernel_launch: occupancy query says %d blocks per CU\n", per_cu); }
        (void)hipGetLastError();
        grid = cus;
    }
    if (grid < 0) return;
    (void)hipMemsetAsync((char*)d_ws + WS_CTL, 0, CTL_ZERO_BYTES, stream);
    Args a{};
    for (int i = 0; i < 26; ++i) a.in[i] = (const float*)d_in[i];
    a.out = (float*)d_out; a.ws = (unsigned char*)d_ws;
#if MK_CHECK
    {
        static bool once = false; if (!once) { once = true; (void)hipFuncSetAttribute((const void*)chk_kernel, hipFuncAttributeMaxDynamicSharedMemorySize, LDS_BYTES); }
        const int pb = 1 + MK_CHECK_LAYER * NPL; const int cuts[6] = {0, pb + 4, pb + 6, pb + 7, pb + 8, NPHASES}; const int stg[5] = {1, 4, 5, 6, 0};
        for (int i = 0; i < 5; ++i) { (void)hipMemsetAsync((unsigned*)((char*)d_ws + WS_CTL) + CW_BAR, 0, 2 * XCD_BAR_WORDS * 4, stream); a.ph_lo = cuts[i]; a.ph_hi = cuts[i + 1]; hipLaunchKernelGGL(fwd_kernel, dim3(grid), dim3(512), LDS_BYTES, stream, a);
            if (stg[i]) hipLaunchKernelGGL(chk_kernel, dim3(grid), dim3(512), LDS_BYTES, stream, a, stg[i], MK_CHECK_LAYER); }
        hipLaunchKernelGGL(chk_kernel, dim3(grid), dim3(512), LDS_BYTES, stream, a, 99, 0);
    }
#elif MK_PROBE_REL > -2
    {
        unsigned* ctl = (unsigned*)((char*)d_ws + WS_CTL);
        auto launch = [&](int lo, int hi) { if (hi <= lo) return; (void)hipMemsetAsync(ctl + CW_BAR, 0, 2 * XCD_BAR_WORDS * 4, stream); a.ph_lo = lo; a.ph_hi = hi; hipLaunchKernelGGL(fwd_kernel, dim3(grid), dim3(512), LDS_BYTES, stream, a); };
        int cur = 0;
        const int nl = (MK_PROBE_REL == -1) ? 1 : NL;
        for (int layer = 0; layer < nl; ++layer) {
            const int p = (MK_PROBE_REL == -1) ? 0 : 1 + layer * NPL + MK_PROBE_REL;
            launch(cur, p);
            for (int r = 0; r <= MK_PROBE_REPS; ++r) {
                (void)hipMemsetAsync(ctl + CW_Q, 0, 4096 * 4, stream);
#ifdef MK_PROBE_MIXER
                if (r > 0) { (void)hipMemsetAsync(ctl + CW_Q, 0x04, 4096 * 4, stream); (void)hipMemsetAsync(ctl + CW_Q + layer * 256 + 64 * MK_PROBE_MIXER, 0, 4, stream); }
#endif
                if (MK_PROBE_REL == 10 && r == 0) (void)hipMemcpyAsync((char*)d_ws + WS_GT, (char*)d_ws + WS_XB, (size_t)S * DM * 2, hipMemcpyDeviceToDevice, stream);
                if (MK_PROBE_REL == 10 && r > 0) (void)hipMemcpyAsync((char*)d_ws + WS_XB, (char*)d_ws + WS_GT, (size_t)S * DM * 2, hipMemcpyDeviceToDevice, stream);
                if (MK_PROBE_REL == 3 && r == 0) (void)hipMemcpyAsync((char*)d_ws + WS_PART, (char*)d_ws + WS_QD, (size_t)S * 768 * 2, hipMemcpyDeviceToDevice, stream);
                if (MK_PROBE_REL == 3 && r > 0) { (void)hipMemcpyAsync((char*)d_ws + WS_QD, (char*)d_ws + WS_PART, (size_t)S * 768 * 2, hipMemcpyDeviceToDevice, stream); (void)hipMemsetAsync(ctl + CW_MOBA, 0, 2048 * 4, stream); }
                launch(p, p + 1);
            }
            cur = p + 1;
        }
        launch(cur, NPHASES);
    }
#elif MK_PER_PHASE
    for (int p = 0; p < NPHASES; ++p) { a.ph_lo = p; a.ph_hi = p + 1; hipLaunchKernelGGL(fwd_kernel, dim3(grid), dim3(512), LDS_BYTES, stream, a); }
#else
    a.ph_lo = 0; a.ph_hi = NPHASES;
    hipLaunchKernelGGL(fwd_kernel, dim3(grid), dim3(512), LDS_BYTES, stream, a);
#endif
}
```
